# Optimizing an MI355X kernel written in HIP

```python
import jax, jax.numpy as jnp
from jax import lax
import numpy as np

D_MODEL = 2048
BATCH = 4
SEQ = 2048
DEPTH = 1
DEC_BATCH = 128
DEC_SEQ = 8
PAST_LEN = 16384
PAGE_SIZE = 128

MIX_WIDTH = D_MODEL
POOL_WIDTH = MIX_WIDTH // 2
POOL_WINDOWS = (2, 4, 8, 16)
POOL_GROUPS = len(POOL_WINDOWS)
POOL_GROUP_DIM = POOL_WIDTH // POOL_GROUPS
POOL_CACHE = max(POOL_WINDOWS) - 1
HG_WIDTH = MIX_WIDTH - POOL_WIDTH
HG_HEAD_DIM = 128
HG_HEADS = HG_WIDTH // HG_HEAD_DIM
CHUNK = 16
D_FF = ((8 * D_MODEL // 3 + 255) // 256) * 256
IN_COLS = POOL_WIDTH + 4 * HG_WIDTH
EPS = 1e-6

kernel_name = "hybrid_pool_hgrn2_decode_step"


def rms_norm(x, g):
    x32 = x.astype(jnp.float32)
    y = x32 * lax.rsqrt(jnp.mean(x32 * x32, axis=-1, keepdims=True) + EPS)
    return (y * g.astype(jnp.float32)).astype(x.dtype)


def pool_mix(u, prev, pos0, w_pool, pool_scale):
    B, T, _ = u.shape
    full = jnp.concatenate([prev.astype(u.dtype), u], axis=1)
    cs = jnp.cumsum(full.astype(jnp.float32), axis=1)
    cs = jnp.concatenate([jnp.zeros((B, 1, POOL_WIDTH), jnp.float32), cs], axis=1)
    end = cs[:, POOL_CACHE + 1:]
    pos = pos0 + jnp.arange(T)
    means = []
    for gi, w in enumerate(POOL_WINDOWS):
        sl = slice(gi * POOL_GROUP_DIM, (gi + 1) * POOL_GROUP_DIM)
        start = cs[:, POOL_CACHE + 1 - w:POOL_CACHE + 1 - w + T, sl]
        cnt = jnp.minimum(pos + 1, w).astype(jnp.float32)[None, :, None]
        means.append((end[..., sl] - start) / cnt)
    pooled = jnp.concatenate(means, axis=-1) - u.astype(jnp.float32)
    pooled = pooled.reshape(B, T, POOL_GROUPS, POOL_GROUP_DIM)
    out = jnp.einsum('btgc,gcd->btgd', pooled, w_pool.astype(jnp.float32))
    out = out.reshape(B, T, POOL_WIDTH) * pool_scale.astype(jnp.float32)
    return out.astype(u.dtype), full[:, -POOL_CACHE:]


def hgrn2_recurrence(q, k, v, logf, S0):
    B, T, H, K = q.shape
    V = v.shape[-1]
    pad = (-T) % CHUNK
    n = (T + pad) // CHUNK

    def prep(a):
        a = jnp.pad(a.astype(jnp.float32), ((0, 0), (0, pad), (0, 0), (0, 0)))
        return a.reshape(B, n, CHUNK, H, a.shape[-1]).transpose(1, 0, 3, 2, 4)

    qs, ks, vs, gs = prep(q), prep(k), prep(v), prep(logf)
    causal = jnp.tril(jnp.ones((CHUNK, CHUNK), bool))[:, :, None]

    def step(S, inp):
        qc, kc, vc, gc = inp
        b = jnp.cumsum(gc, axis=2)
        diff = b[:, :, :, None, :] - b[:, :, None, :, :]
        decay = jnp.exp(jnp.where(causal, diff, -jnp.inf))
        scores = jnp.einsum('bhtk,bhsk,bhtsk->bhts', qc, kc, decay)
        o = (jnp.einsum('bhts,bhsv->bhtv', scores, vc)
             + jnp.einsum('bhtk,bhkv->bhtv', qc * jnp.exp(b), S))
        b_last = b[:, :, -1:, :]
        S = (jnp.exp(b_last[:, :, 0, :])[..., None] * S
             + jnp.einsum('bhsk,bhsv->bhkv', kc * jnp.exp(b_last - b), vc))
        return S, o

    S, o = lax.scan(step, S0.astype(jnp.float32), (qs, ks, vs, gs))
    o = o.transpose(1, 0, 3, 2, 4).reshape(B, n * CHUNK, H, V)[:, :T]
    return o, S


def run_group(x, pool_prev, S_prev, pos0, lbs, norm1, w_in, w_pool, pool_scale,
              hg_norm, w_o, norm2, w_gate, w_up, w_down, norm_f):
    B, T, _ = x.shape
    pools, states = [], []
    for l in range(DEPTH):
        h = rms_norm(x, norm1[l])
        z = h @ w_in[l]
        u, q, f, i, g = jnp.split(
            z, [POOL_WIDTH, POOL_WIDTH + HG_WIDTH, POOL_WIDTH + 2 * HG_WIDTH,
                POOL_WIDTH + 3 * HG_WIDTH], axis=-1)
        pool_out, pool_new = pool_mix(u, pool_prev[l], pos0, w_pool[l], pool_scale[l])
        lb = lbs[l]
        forget = lb + (1.0 - lb) * jax.nn.sigmoid(f.astype(jnp.float32))
        logf = jnp.log(forget)
        k_in = 1.0 - forget
        q_f = jax.nn.silu(q.astype(jnp.float32))
        heads = lambda a: a.reshape(B, T, HG_HEADS, HG_HEAD_DIM)
        o, S_new = hgrn2_recurrence(heads(q_f), heads(k_in), heads(i), heads(logf), S_prev[l])
        o = o * lax.rsqrt(jnp.mean(o * o, axis=-1, keepdims=True) + EPS)
        o = o * hg_norm[l].astype(jnp.float32).reshape(HG_HEADS, HG_HEAD_DIM)
        o = o.reshape(B, T, HG_WIDTH) * jax.nn.silu(g.astype(jnp.float32))
        mix = jnp.concatenate([pool_out, o.astype(x.dtype)], axis=-1) @ w_o[l]
        x = x + mix
        h2 = rms_norm(x, norm2[l])
        x = x + (jax.nn.silu(h2 @ w_gate[l]) * (h2 @ w_up[l])) @ w_down[l]
        pools.append(pool_new)
        states.append(S_new.astype(S_prev.dtype))
    return rms_norm(x, norm_f), jnp.stack(pools), jnp.stack(states)


def setup_inputs(seed: int = 0) -> dict:
    key = jax.random.key(seed)
    ks = jax.random.split(key, 20)
    nrm = lambda k, s, sc: jax.random.normal(k, s, jnp.float32) * sc
    return {
        "x_prompt": nrm(ks[0], (BATCH, SEQ, D_MODEL), 1.0),
        "x_sample": nrm(ks[1], (DEC_BATCH, DEC_SEQ, D_MODEL), 1.0),
        "cache_pool": nrm(ks[2], (DEPTH, DEC_BATCH, POOL_CACHE, POOL_WIDTH), 1.0),
        "state_hgrn": nrm(ks[3], (DEPTH, DEC_BATCH, HG_HEADS, HG_HEAD_DIM, HG_HEAD_DIM), 0.3),
        "lb_param": nrm(ks[4], (DEPTH + 1, HG_WIDTH), 0.1),
        "norm1": 1.0 + nrm(ks[5], (DEPTH, D_MODEL), 0.02),
        "w_in": nrm(ks[6], (DEPTH, D_MODEL, IN_COLS), D_MODEL ** -0.5),
        "w_pool": nrm(ks[7], (DEPTH, POOL_GROUPS, POOL_GROUP_DIM, POOL_GROUP_DIM), POOL_GROUP_DIM ** -0.5),
        "pool_scale": 1.0 + nrm(ks[8], (DEPTH, POOL_WIDTH), 0.02),
        "hg_norm": 1.0 + nrm(ks[9], (DEPTH, HG_WIDTH), 0.02),
        "w_o": nrm(ks[10], (DEPTH, MIX_WIDTH, D_MODEL), MIX_WIDTH ** -0.5),
        "norm2": 1.0 + nrm(ks[11], (DEPTH, D_MODEL), 0.02),
        "w_gate": nrm(ks[12], (DEPTH, D_MODEL, D_FF), D_MODEL ** -0.5),
        "w_up": nrm(ks[13], (DEPTH, D_MODEL, D_FF), D_MODEL ** -0.5),
        "w_down": nrm(ks[14], (DEPTH, D_FF, D_MODEL), D_FF ** -0.5),
        "norm_f": 1.0 + nrm(ks[15], (D_MODEL,), 0.02),
    }


def reference(x_prompt, x_sample, cache_pool, state_hgrn, lb_param, norm1, w_in, w_pool,
              pool_scale, hg_norm, w_o, norm2, w_gate, w_up, w_down, norm_f):
    lbs = jnp.cumsum(jax.nn.softmax(lb_param.astype(jnp.float32), axis=0), axis=0)
    weights = (norm1, w_in, w_pool, pool_scale, hg_norm, w_o, norm2, w_gate, w_up, w_down, norm_f)
    pool_zero = jnp.zeros((DEPTH, BATCH, POOL_CACHE, POOL_WIDTH), x_prompt.dtype)
    state_zero = jnp.zeros((DEPTH, BATCH, HG_HEADS, HG_HEAD_DIM, HG_HEAD_DIM), state_hgrn.dtype)
    y_prompt, pool_state_prompt, hgrn_state_prompt = run_group(
        x_prompt, pool_zero, state_zero, 0, lbs, *weights)
    y_sample, pool_state_sample, hgrn_state_sample = run_group(
        x_sample, cache_pool, state_hgrn, PAST_LEN, lbs, *weights)
    return (y_prompt, y_sample, pool_state_prompt, hgrn_state_prompt, pool_state_sample, hgrn_state_sample)
```

```cpp
#include <hip/hip_runtime.h>
#include <cstdio>
#include <cstdint>

constexpr int D = 2048, NB = 4, SEQ = 2048, DB = 128, DS = 8;
constexpr int MP = NB * SEQ, MS = DB * DS, M = MP + MS;
constexpr int PW = 1024, HW = 1024, HD = 128, NH = 8, PC = 15;
constexpr int DFF = 5632, INC = 5120;
constexpr float EPS = 1e-6f;
constexpr int PAST = 16384;

constexpr size_t O_Y = 0;
constexpr size_t O_PSP = (size_t)M * D;
constexpr size_t O_HSP = O_PSP + (size_t)NB * PC * PW;
constexpr size_t O_PSS = O_HSP + (size_t)NB * NH * HD * HD;
constexpr size_t O_HSS = O_PSS + (size_t)DB * PC * PW;

__device__ __forceinline__ float sigmoidf_(float x) { return 1.f / (1.f + __expf(-x)); }
__device__ __forceinline__ float siluf_(float x) { return x / (1.f + __expf(-x)); }

__device__ __forceinline__ float wave_sum(float v) {
#pragma unroll
    for (int o = 1; o < 64; o <<= 1) v += __shfl_xor(v, o);
    return v;
}

__global__ void k_rmsnorm(const float* __restrict__ xa, const float* __restrict__ xb, int rows_a, const float* __restrict__ g, float* __restrict__ out, int rows) {
    const int wave = (blockIdx.x * blockDim.x + threadIdx.x) >> 6, lane = threadIdx.x & 63;
    if (wave >= rows) return;
    const float* x = wave < rows_a ? xa + (size_t)wave * D : xb + (size_t)(wave - rows_a) * D;
    float s = 0.f;
    for (int c = lane; c < D; c += 64) { const float v = x[c]; s += v * v; }
    s = wave_sum(s);
    const float r = rsqrtf(s / D + EPS);
    for (int c = lane; c < D; c += 64) out[(size_t)wave * D + c] = x[c] * r * g[c];
}

template <int MODE>
__global__ void __launch_bounds__(256) k_gemm(const float* __restrict__ A, int lda, const float* __restrict__ B, const float* __restrict__ B2, int ldb,
                                               float* C, int ldc, int K, const float* ra, const float* rb, int rows_a, int ldr) {
    __shared__ float As[16][64 + 4];
    __shared__ float Bs[16][64 + 4];
    __shared__ float Bs2[MODE == 2 ? 16 : 1][64 + 4];
    const int tid = threadIdx.x, tx = tid & 15, ty = tid >> 4;
    const int m0 = blockIdx.y * 64, n0 = blockIdx.x * 64;
    float acc[4][4] = {}, acc2[4][4] = {};
    for (int k0 = 0; k0 < K; k0 += 16) {
        {
            const int r = tid >> 2, kk = (tid & 3) * 4;
            const float4 v = *(const float4*)(A + (size_t)(m0 + r) * lda + k0 + kk);
            As[kk + 0][r] = v.x; As[kk + 1][r] = v.y; As[kk + 2][r] = v.z; As[kk + 3][r] = v.w;
        }
        {
            const int kk = tid >> 4, c = (tid & 15) * 4;
            const float4 v = *(const float4*)(B + (size_t)(k0 + kk) * ldb + n0 + c);
            *(float4*)&Bs[kk][c] = v;
            if (MODE == 2) { const float4 w = *(const float4*)(B2 + (size_t)(k0 + kk) * ldb + n0 + c); *(float4*)&Bs2[kk][c] = w; }
        }
        __syncthreads();
#pragma unroll
        for (int kk = 0; kk < 16; ++kk) {
            const float4 a = *(const float4*)&As[kk][ty * 4];
            const float4 b = *(const float4*)&Bs[kk][tx * 4];
            const float av[4] = {a.x, a.y, a.z, a.w}, bv[4] = {b.x, b.y, b.z, b.w};
#pragma unroll
            for (int i = 0; i < 4; ++i)
#pragma unroll
                for (int j = 0; j < 4; ++j) acc[i][j] += av[i] * bv[j];
            if (MODE == 2) {
                const float4 b2 = *(const float4*)&Bs2[kk][tx * 4];
                const float bw[4] = {b2.x, b2.y, b2.z, b2.w};
#pragma unroll
                for (int i = 0; i < 4; ++i)
#pragma unroll
                    for (int j = 0; j < 4; ++j) acc2[i][j] += av[i] * bw[j];
            }
        }
        __syncthreads();
    }
#pragma unroll
    for (int i = 0; i < 4; ++i) {
        const int m = m0 + ty * 4 + i;
        float4 o;
        float* ov = (float*)&o;
#pragma unroll
        for (int j = 0; j < 4; ++j) {
            float v = acc[i][j];
            if (MODE == 2) v = siluf_(acc[i][j]) * acc2[i][j];
            ov[j] = v;
        }
        if (MODE == 1) {
            const float* r = (rb == nullptr || m < rows_a) ? ra + (size_t)m * ldr : rb + (size_t)(m - rows_a) * ldr;
            const float4 rv = *(const float4*)(r + n0 + tx * 4);
            o.x += rv.x; o.y += rv.y; o.z += rv.z; o.w += rv.w;
        }
        *(float4*)(C + (size_t)m * ldc + n0 + tx * 4) = o;
    }
}

__global__ void k_pool(const float* __restrict__ z, const float* __restrict__ cache_pool, float* __restrict__ pooled, float* __restrict__ out) {
    const int idx = blockIdx.x * blockDim.x + threadIdx.x;
    if (idx >= M * PW) return;
    const int m = idx / PW, c = idx % PW, g = c / 256, w = 2 << g;
    float s = 0.f, cnt;
    if (m < MP) {
        const int t = m % SEQ;
        for (int j = 0; j < w; ++j) if (t - j >= 0) s += z[(size_t)(m - j) * INC + c];
        cnt = (float)min(t + 1, w);
        if (t >= SEQ - PC) out[O_PSP + ((size_t)(m / SEQ) * PC + (t - (SEQ - PC))) * PW + c] = z[(size_t)m * INC + c];
    } else {
        const int ms = m - MP, b = ms / DS, t = ms % DS;
        for (int j = 0; j < w; ++j) {
            const int tt = t - j;
            s += tt >= 0 ? z[(size_t)(m - j) * INC + c] : cache_pool[((size_t)b * PC + (PC + tt)) * PW + c];
        }
        cnt = (float)w;
        out[O_PSS + ((size_t)b * PC + 7 + t) * PW + c] = z[(size_t)m * INC + c];
        if (t < 7) out[O_PSS + ((size_t)b * PC + t) * PW + c] = cache_pool[((size_t)b * PC + 8 + t) * PW + c];
    }
    pooled[(size_t)m * PW + c] = s / cnt - z[(size_t)m * INC + c];
}

__global__ void k_pool_scale(float* __restrict__ mix, const float* __restrict__ ps) {
    const int idx = blockIdx.x * blockDim.x + threadIdx.x;
    if (idx >= M * PW) return;
    const int m = idx / PW, c = idx % PW;
    mix[(size_t)m * D + c] *= ps[c];
}

__global__ void __launch_bounds__(128) k_hgrn(const float* __restrict__ z, const float* __restrict__ lbp, const float* __restrict__ hgn, const float* __restrict__ S0all,
                                               float* __restrict__ mix, float* __restrict__ out) {
    __shared__ float sq[HD], sf[HD], sk[HD], red[2];
    const int chain = blockIdx.x, v = threadIdx.x;
    int row0, T; const float* S0 = nullptr; float* Sout;
    int h;
    if (chain < NB * NH) { const int b = chain / NH; h = chain % NH; row0 = b * SEQ; T = SEQ; Sout = out + O_HSP + (size_t)chain * HD * HD; }
    else { const int c2 = chain - NB * NH, b = c2 / NH; h = c2 % NH; row0 = MP + b * DS; T = DS; S0 = S0all + (size_t)c2 * HD * HD; Sout = out + O_HSS + (size_t)c2 * HD * HD; }
    float S[HD];
#pragma unroll
    for (int k = 0; k < HD; ++k) S[k] = S0 ? S0[(size_t)k * HD + v] : 0.f;
    const int ch = h * HD + v;
    const float lb = 1.f / (1.f + __expf(lbp[HW + ch] - lbp[ch]));
    const float gn = hgn[ch];
    for (int t = 0; t < T; ++t) {
        const float* zr = z + (size_t)(row0 + t) * INC;
        const float q = zr[PW + ch], f = zr[PW + HW + ch], iv = zr[PW + 2 * HW + ch], g = zr[PW + 3 * HW + ch];
        const float forget = lb + (1.f - lb) * sigmoidf_(f);
        __syncthreads();
        sq[v] = siluf_(q); sf[v] = forget; sk[v] = 1.f - forget;
        __syncthreads();
        float o = 0.f;
#pragma unroll
        for (int k = 0; k < HD; ++k) { S[k] = sf[k] * S[k] + sk[k] * iv; o += sq[k] * S[k]; }
        float ss = wave_sum(o * o);
        if ((v & 63) == 0) red[v >> 6] = ss;
        __syncthreads();
        ss = red[0] + red[1];
        const float r = rsqrtf(ss / HD + EPS);
        mix[(size_t)(row0 + t) * D + PW + ch] = o * r * gn * siluf_(g);
    }
#pragma unroll
    for (int k = 0; k < HD; ++k) Sout[(size_t)k * HD + v] = S[k];
}

__global__ void k_final(float* __restrict__ y, const float* __restrict__ g) {
    const int wave = (blockIdx.x * blockDim.x + threadIdx.x) >> 6, lane = threadIdx.x & 63;
    if (wave >= M) return;
    float* x = y + (size_t)wave * D;
    float s = 0.f;
    for (int c = lane; c < D; c += 64) { const float v = x[c]; s += v * v; }
    s = wave_sum(s);
    const float r = rsqrtf(s / D + EPS);
    for (int c = lane; c < D; c += 64) x[c] = x[c] * r * g[c];
}

extern "C" void kernel_launch(void* const* d_in, const int* in_sizes, int n_in, void* d_out, int out_size, void* d_ws, size_t ws_size, hipStream_t stream) {
    const float* x_prompt = (const float*)d_in[0];
    const float* x_sample = (const float*)d_in[1];
    const float* cache_pool = (const float*)d_in[2];
    const float* state_hgrn = (const float*)d_in[3];
    const float* lb_param = (const float*)d_in[4];
    const float* norm1 = (const float*)d_in[5];
    const float* w_in = (const float*)d_in[6];
    const float* w_pool = (const float*)d_in[7];
    const float* pool_scale = (const float*)d_in[8];
    const float* hg_norm = (const float*)d_in[9];
    const float* w_o = (const float*)d_in[10];
    const float* norm2 = (const float*)d_in[11];
    const float* w_gate = (const float*)d_in[12];
    const float* w_up = (const float*)d_in[13];
    const float* w_down = (const float*)d_in[14];
    const float* norm_f = (const float*)d_in[15];
    float* out = (float*)d_out;
    char* ws = (char*)d_ws;
    float* R1 = (float*)ws;
    float* R3 = (float*)(ws + (size_t)M * D * 4);
    float* R2 = (float*)(ws + (size_t)M * D * 4 + (size_t)M * PW * 4);
    float* y = out + O_Y;

    k_rmsnorm<<<M / 4, 256, 0, stream>>>(x_prompt, x_sample, MP, norm1, R1, M);
    k_gemm<0><<<dim3(INC / 64, M / 64), 256, 0, stream>>>(R1, D, w_in, nullptr, INC, R2, INC, D, nullptr, nullptr, 0, 0);
    k_pool<<<(M * PW + 255) / 256, 256, 0, stream>>>(R2, cache_pool, R3, out);
    for (int g = 0; g < 4; ++g)
        k_gemm<0><<<dim3(256 / 64, M / 64), 256, 0, stream>>>(R3 + g * 256, PW, w_pool + (size_t)g * 256 * 256, nullptr, 256, R1 + g * 256, D, 256, nullptr, nullptr, 0, 0);
    k_pool_scale<<<(M * PW + 255) / 256, 256, 0, stream>>>(R1, pool_scale);
    k_hgrn<<<NB * NH + DB * NH, 128, 0, stream>>>(R2, lb_param, hg_norm, state_hgrn, R1, out);
    k_gemm<1><<<dim3(D / 64, M / 64), 256, 0, stream>>>(R1, D, w_o, nullptr, D, y, D, D, x_prompt, x_sample, MP, D);
    k_rmsnorm<<<M / 4, 256, 0, stream>>>(y, y + (size_t)MP * D, MP, norm2, R1, M);
    k_gemm<2><<<dim3(DFF / 64, M / 64), 256, 0, stream>>>(R1, D, w_gate, w_up, DFF, R2, DFF, D, nullptr, nullptr, 0, 0);
    k_gemm<1><<<dim3(D / 64, M / 64), 256, 0, stream>>>(R2, DFF, w_down, nullptr, D, y, D, DFF, y, nullptr, 0, D);
    k_final<<<M / 4, 256, 0, stream>>>(y, norm_f);
}
```

```cpp
#include <hip/hip_runtime.h>
#include <hip/hip_cooperative_groups.h>
#include <cstdio>
#include <cstdint>
namespace cg = cooperative_groups;

constexpr int D = 2048, NB = 4, SEQ = 2048, DB = 128, DS = 8;
constexpr int MP = NB * SEQ, MS = DB * DS, M = MP + MS;
constexpr int PW = 1024, HW = 1024, HD = 128, NH = 8, PC = 15;
constexpr int DFF = 5632, INC = 5120;
constexpr float EPS = 1e-6f;
constexpr size_t O_Y = 0;
constexpr size_t O_PSP = (size_t)M * D;
constexpr size_t O_HSP = O_PSP + (size_t)NB * PC * PW;
constexpr size_t O_PSS = O_HSP + (size_t)NB * NH * HD * HD;
constexpr size_t O_HSS = O_PSS + (size_t)DB * PC * PW;

namespace pg8 {
#define PG8_LAS __attribute__((address_space(3)))
typedef unsigned short bf16_t;
typedef short bf16x8 __attribute__((ext_vector_type(8)));
typedef float f32x4 __attribute__((ext_vector_type(4)));
typedef unsigned u32x4 __attribute__((ext_vector_type(4)));
constexpr int BM = 256, BK = 64, HALF = 128, HTB = HALF * BK * 2  , STAGE_BYTES = 8 * HTB, NXCD = 8, WGM = 8;

__host__ __device__ __forceinline__ int lds_byte(int r, int c) { const int st = (r >> 4) * 2 + (c >> 5), rr = r & 15, cc = c & 31, ob = rr * 64 + cc * 2; return st * 1024 + (ob ^ (((ob >> 9) & 1) << 5)); }
__host__ __device__ __forceinline__ void stage_rc(int b, int& R, int& C) { const int st = b / 1024, sb = b % 1024, swz = sb ^ (((sb >> 9) & 1) << 5); R = (st >> 1) * 16 + swz / 64; C = (st & 1) * 32 + (swz % 64) / 2; }
__host__ __device__ __forceinline__ int perm32(int rho) { const int n = rho >> 4, i = rho & 15; return 8 * (i >> 2) + 4 * n + (i & 3); }

struct Unit { int pm, pn; };
struct Gemm { const bf16_t* A; const bf16_t* Bt; int M, N, K; };

struct StaticOrder {
    int nM, nN, nwg, G, c;
    __host__ __device__ void init(int M, int N, int G_, int c_) { nM = M / BM; nN = N / BM; nwg = nM * nN; G = G_; c = c_; }
    __host__ __device__ bool next(int i, Unit& u) const {
        const long L = (long)i * G + c; if (L >= nwg) return false;
        int wgid = (int)L; { const int q = nwg / NXCD, r = nwg % NXCD, xcd = wgid % NXCD, off = wgid / NXCD; wgid = (xcd < r ? xcd * (q + 1) : r * (q + 1) + (xcd - r) * q) + off; }
        const int nig = WGM * nN, gid = wgid / nig, fm = gid * WGM, gsz = (nM - fm) < WGM ? (nM - fm) : WGM;
        u.pm = fm + ((wgid % nig) % gsz); u.pn = (wgid % nig) / gsz; return true;
    }
    __device__ __forceinline__ void a_ready(const Unit&) const {}
    __device__ __forceinline__ void done(const Unit&) const {}
};
__device__ __forceinline__ unsigned cvt_pk_bf16(float lo, float hi) { unsigned r; asm volatile("v_cvt_pk_bf16_f32 %0, %1, %2" : "=v"(r) : "v"(lo), "v"(hi)); return r; }
__device__ __forceinline__ float sigm(float x) { return __builtin_amdgcn_rcpf(1.f + __expf(-x)); }
__device__ __forceinline__ float silu(float x) { return x * __builtin_amdgcn_rcpf(1.f + __expf(-x)); }
typedef unsigned u32x2 __attribute__((ext_vector_type(2)));

struct EpiZ {
    static constexpr bool PERM = true, AFTER_DRAIN = false;
    bf16_t* zb; float* lf; const float* rstd1; const float* lbv; float* out;
    __device__ __forceinline__ void operator()(const f32x4 (&acc)[2][2][4][2], const Unit& u, int wr, int wc, int fr, int fq) const {
        const int kind = u.pn >> 2;
        const int row0 = u.pm * BM + wr * 64 + fr;
        const int cc0 = (u.pn & 3) * 256 + wc * 32 + 8 * fq;
        f32x4 lb[2][2];
        if (kind == 2) {
#pragma unroll
            for (int bj = 0; bj < 2; ++bj)
#pragma unroll
                for (int n = 0; n < 2; ++n) lb[bj][n] = *(const f32x4*)(lbv + cc0 + bj * HALF + 4 * n);
        }
#pragma unroll
        for (int ai = 0; ai < 2; ++ai)
#pragma unroll
            for (int m = 0; m < 4; ++m) {
                const int row = row0 + ai * HALF + m * 16;
                const float r = rstd1[row];
#pragma unroll
                for (int bj = 0; bj < 2; ++bj) {
                    const int cc = cc0 + bj * HALF;
                    f32x4 v0 = acc[ai][bj][m][0] * r, v1 = acc[ai][bj][m][1] * r;
                    if (kind == 2) {
#pragma unroll
                        for (int j = 0; j < 4; ++j) {
                            v0[j] = __logf(lb[bj][0][j] + (1.f - lb[bj][0][j]) * sigm(v0[j]));
                            v1[j] = __logf(lb[bj][1][j] + (1.f - lb[bj][1][j]) * sigm(v1[j]));
                        }
                        float* p = lf + (size_t)row * HW + cc;
                        *(f32x4*)p = v0; *(f32x4*)(p + 4) = v1;
                    } else {
                        if (kind == 0) {
                            float* dst = nullptr;
                            if (row >= MP) { const int ms = row - MP; dst = out + O_PSS + ((size_t)(ms >> 3) * PC + 7 + (ms & 7)) * PW + cc; }
                            else { const int t = row & (SEQ - 1); if (t >= SEQ - PC) dst = out + O_PSP + ((size_t)(row >> 11) * PC + (t - (SEQ - PC))) * PW + cc; }
                            if (dst) { *(f32x4*)dst = v0; *(f32x4*)(dst + 4) = v1; }
                        }
                        if (kind == 1 || kind == 4) {
#pragma unroll
                            for (int j = 0; j < 4; ++j) { v0[j] = silu(v0[j]); v1[j] = silu(v1[j]); }
                        }
                        u32x4 w; w.x = cvt_pk_bf16(v0[0], v0[1]); w.y = cvt_pk_bf16(v0[2], v0[3]); w.z = cvt_pk_bf16(v1[0], v1[1]); w.w = cvt_pk_bf16(v1[2], v1[3]);
                        *(u32x4*)(zb + (size_t)row * INC + kind * 1024 + cc) = w;
                    }
                }
            }
    }
};

struct EpiX1 {
    static constexpr bool PERM = false, AFTER_DRAIN = false;
    const float* xp; const float* xs; float* y; bf16_t* x1b; float* rowsq;
    __device__ __forceinline__ void operator()(const f32x4 (&acc)[2][2][4][2], const Unit& u, int wr, int wc, int fr, int fq) const {
        const int row0 = u.pm * BM + wr * 64 + fr, col0 = u.pn * BM + wc * 32 + 4 * fq;
#pragma unroll
        for (int ai = 0; ai < 2; ++ai)
#pragma unroll
            for (int m = 0; m < 4; ++m) {
                const int row = row0 + ai * HALF + m * 16;
                const float* xr = (row < MP ? xp + (size_t)row * D : xs + (size_t)(row - MP) * D) + col0;
                float* yr = y + (size_t)row * D + col0; bf16_t* br = x1b + (size_t)row * D + col0;
                float s = 0.f;
#pragma unroll
                for (int bj = 0; bj < 2; ++bj)
#pragma unroll
                    for (int n = 0; n < 2; ++n) {
                        const f32x4 v = *(const f32x4*)(xr + bj * HALF + n * 16) + acc[ai][bj][m][n];
                        *(f32x4*)(yr + bj * HALF + n * 16) = v;
                        u32x2 w; w.x = cvt_pk_bf16(v[0], v[1]); w.y = cvt_pk_bf16(v[2], v[3]);
                        *(u32x2*)(br + bj * HALF + n * 16) = w;
                        s += (v[0] * v[0] + v[1] * v[1]) + (v[2] * v[2] + v[3] * v[3]);
                    }
                s += __shfl_xor(s, 16); s += __shfl_xor(s, 32);
                if (fq == 0) atomicAdd(rowsq + row, s);
            }
    }
};

struct EpiAct {
    static constexpr bool PERM = true, AFTER_DRAIN = false;
    bf16_t* act; const float* rowsq;
    __device__ __forceinline__ void operator()(const f32x4 (&acc)[2][2][4][2], const Unit& u, int wr, int wc, int fr, int fq) const {
        const int row0 = u.pm * BM + wr * 64 + fr, col0 = u.pn * HALF + wc * 32 + 8 * fq;
#pragma unroll
        for (int ai = 0; ai < 2; ++ai)
#pragma unroll
            for (int m = 0; m < 4; ++m) {
                const int row = row0 + ai * HALF + m * 16;
                const float r = rsqrtf(rowsq[row] * (1.f / D) + EPS);
                u32x4 w; unsigned* wp = (unsigned*)&w;
#pragma unroll
                for (int n = 0; n < 2; ++n) {
                    const f32x4 g = acc[ai][0][m][n] * r, up = acc[ai][1][m][n] * r;
                    f32x4 a;
#pragma unroll
                    for (int j = 0; j < 4; ++j) a[j] = silu(g[j]) * up[j];
                    wp[2 * n] = cvt_pk_bf16(a[0], a[1]); wp[2 * n + 1] = cvt_pk_bf16(a[2], a[3]);
                }
                *(u32x4*)(act + (size_t)row * DFF + col0) = w;
            }
    }
};

struct EpiX2 {
    static constexpr bool PERM = false, AFTER_DRAIN = false;
    float* y; float* rowsq;
    __device__ __forceinline__ void operator()(const f32x4 (&acc)[2][2][4][2], const Unit& u, int wr, int wc, int fr, int fq) const {
        const int row0 = u.pm * BM + wr * 64 + fr, col0 = u.pn * BM + wc * 32 + 4 * fq;
#pragma unroll
        for (int ai = 0; ai < 2; ++ai)
#pragma unroll
            for (int m = 0; m < 4; ++m) {
                const int row = row0 + ai * HALF + m * 16;
                float* yr = y + (size_t)row * D + col0;
                float s = 0.f;
#pragma unroll
                for (int bj = 0; bj < 2; ++bj)
#pragma unroll
                    for (int n = 0; n < 2; ++n) {
                        const f32x4 v = *(const f32x4*)(yr + bj * HALF + n * 16) + acc[ai][bj][m][n];
                        *(f32x4*)(yr + bj * HALF + n * 16) = v;
                        s += (v[0] * v[0] + v[1] * v[1]) + (v[2] * v[2] + v[3] * v[3]);
                    }
                s += __shfl_xor(s, 16); s += __shfl_xor(s, 32);
                if (fq == 0) atomicAdd(rowsq + row, s);
            }
    }
};
template <class Epi, class Sched, bool ALIGN_EPI = false, bool SP2 = false>
__device__ __forceinline__ void gemm_phase(PG8_LAS unsigned char* lds, const Gemm g, const Sched& S, const Epi& E) {
    int tid_ = threadIdx.x; asm volatile("" : "+v"(tid_));
    const int tid = tid_, wid = __builtin_amdgcn_readfirstlane(tid >> 6), lane = tid & 63, wr = wid >> 2, wc = wid & 3, fr = lane & 15, fq = lane >> 4;
    const int K = g.K, nt = K / BK;
    unsigned voffA[2], voffB[2];
#pragma unroll
    for (int i = 0; i < 2; ++i) { int R, C; stage_rc(tid * 16 + i * 8192, R, C); const int Rb = Epi::PERM ? ((R & ~31) + perm32(R & 31)) : R;
        voffA[i] = (unsigned)(R * K + C) * 2u; voffB[i] = (unsigned)(Rb * K + C) * 2u; }
    const size_t kstep = (size_t)(BK * 2);
    const size_t hstep = (size_t)HALF * K * 2;
    const size_t tstep = 2 * hstep;
    const unsigned ldsw = (unsigned)wid * 1024u;
    const int aoff = lds_byte(wr * 64 + fr, fq * 8), boff = lds_byte(wc * 32 + fr, fq * 8);
#define PG8_SA(b, h) (((b) * 2 + (h)) * HTB)
#define PG8_SB(b, h) ((4 + (b) * 2 + (h)) * HTB)
#define PG8_STAGE(bufoff, gbase, voff) do { _Pragma("unroll") for (int _i = 0; _i < 2; ++_i) \
        __builtin_amdgcn_global_load_lds((const unsigned*)((const char*)(gbase) + (voff)[_i]), (PG8_LAS unsigned*)(lds + (bufoff) + ldsw + _i * 8192), 16, 0, 0); } while (0)
#define PG8_LDA(dst, b, h) do { _Pragma("unroll") for (int m = 0; m < 4; ++m) _Pragma("unroll") for (int k = 0; k < 2; ++k) dst[m][k] = *(const PG8_LAS bf16x8*)(lds + PG8_SA(b, h) + aoff + m * 2048 + k * 1024); } while (0)
#define PG8_LDB(dst, b, h) do { _Pragma("unroll") for (int n = 0; n < 2; ++n) _Pragma("unroll") for (int k = 0; k < 2; ++k) dst[n][k] = *(const PG8_LAS bf16x8*)(lds + PG8_SB(b, h) + boff + n * 2048 + k * 1024); } while (0)
#define PG8_MMA(ai, bj, At, Bt) do { __builtin_amdgcn_s_setprio(1); _Pragma("unroll") for (int m = 0; m < 4; ++m) _Pragma("unroll") for (int n = 0; n < 2; ++n) _Pragma("unroll") for (int k = 0; k < 2; ++k) \
        acc[ai][bj][m][n] = __builtin_amdgcn_mfma_f32_16x16x32_bf16(Bt[n][k], At[m][k], acc[ai][bj][m][n], 0, 0, 0); __builtin_amdgcn_s_setprio(0); } while (0)
#define PG8_WAIT_V(n) asm volatile("s_waitcnt vmcnt(" #n ")" ::: "memory")
#define PG8_WAIT_L(n) asm volatile("s_waitcnt lgkmcnt(" #n ")" ::: "memory")
#define PG8_BAR __builtin_amdgcn_s_barrier()
#define PG8_SCHED __builtin_amdgcn_sched_barrier(0)
    Unit cur, nxt; int ui = 0;
    if (!S.next(0, cur)) return;
    f32x4 acc[2][2][4][2];
#pragma unroll
    for (int a = 0; a < 2; ++a)
#pragma unroll
        for (int b = 0; b < 2; ++b)
#pragma unroll
            for (int m = 0; m < 4; ++m)
#pragma unroll
                for (int n = 0; n < 2; ++n) acc[a][b][m][n] = (f32x4){0.f, 0.f, 0.f, 0.f};
    bf16x8 At[4][2], B0[2][2], B1[2][2];
    const char* cA = (const char*)g.A + (size_t)cur.pm * tstep; const char* cB = (const char*)g.Bt + (size_t)cur.pn * tstep;
    S.a_ready(cur);
    if constexpr (SP2) {
        PG8_STAGE(PG8_SB(0, 0), cB, voffB); PG8_STAGE(PG8_SB(0, 1), cB + hstep, voffB); PG8_STAGE(PG8_SA(0, 0), cA, voffA); PG8_STAGE(PG8_SA(0, 1), cA + hstep, voffA);
        if (wr == 1) PG8_BAR;
        PG8_WAIT_V(2); PG8_BAR;
        PG8_STAGE(PG8_SB(1, 0), cB + kstep, voffB); PG8_STAGE(PG8_SA(1, 0), cA + kstep, voffA); PG8_STAGE(PG8_SB(1, 1), cB + hstep + kstep, voffB);
        PG8_WAIT_V(6); PG8_BAR;
    } else {
        PG8_STAGE(PG8_SB(0, 0), cB, voffB); PG8_STAGE(PG8_SA(0, 0), cA, voffA); PG8_STAGE(PG8_SB(0, 1), cB + hstep, voffB); PG8_STAGE(PG8_SA(0, 1), cA + hstep, voffA);
        if (wr == 1) PG8_BAR;
        PG8_WAIT_V(4); PG8_BAR;
        PG8_STAGE(PG8_SB(1, 0), cB + kstep, voffB); PG8_STAGE(PG8_SA(1, 0), cA + kstep, voffA); PG8_STAGE(PG8_SB(1, 1), cB + hstep + kstep, voffB);
        PG8_WAIT_V(6); PG8_BAR;
    }
    for (;;) {
        const bool has_next = S.next(ui + 1, nxt);
        const char* nA = has_next ? (const char*)g.A + (size_t)nxt.pm * tstep : cA; const char* nB = has_next ? (const char*)g.Bt + (size_t)nxt.pn * tstep : cB;
        for (int t = 0; t < nt; t += 2) {
            const bool last = (t == nt - 2);
            const char* a1 = cA + (size_t)(t + 1) * kstep;
            const char* a2 = last ? nA : cA + (size_t)(t + 2) * kstep; const char* b2 = last ? nB : cB + (size_t)(t + 2) * kstep;
            const char* a3 = a2 + kstep; const char* b3 = b2 + kstep;
            if (last && has_next) S.a_ready(nxt);
            if constexpr (SP2) {
            PG8_LDB(B0, 0, 0); PG8_LDB(B1, 0, 1); PG8_SCHED; PG8_LDA(At, 0, 0); PG8_STAGE(PG8_SA(1, 1), a1 + hstep, voffA);
            PG8_WAIT_V(8); PG8_WAIT_L(0); PG8_BAR; PG8_MMA(0, 0, At, B0); PG8_MMA(0, 1, At, B1); PG8_BAR; PG8_SCHED;
            PG8_LDA(At, 0, 1); PG8_STAGE(PG8_SB(0, 0), b2, voffB); PG8_STAGE(PG8_SB(0, 1), b2 + hstep, voffB); PG8_STAGE(PG8_SA(0, 0), a2, voffA);
            PG8_WAIT_V(8); PG8_WAIT_L(0); PG8_BAR; PG8_MMA(1, 0, At, B0); PG8_MMA(1, 1, At, B1); PG8_BAR; PG8_SCHED;
            PG8_LDB(B0, 1, 0); PG8_LDB(B1, 1, 1); PG8_SCHED; PG8_LDA(At, 1, 0); PG8_STAGE(PG8_SA(0, 1), a2 + hstep, voffA);
            PG8_WAIT_V(8); PG8_WAIT_L(0); PG8_BAR; PG8_MMA(0, 0, At, B0); PG8_MMA(0, 1, At, B1); PG8_BAR; PG8_SCHED;
            PG8_LDA(At, 1, 1); PG8_STAGE(PG8_SB(1, 0), b3, voffB); PG8_STAGE(PG8_SB(1, 1), b3 + hstep, voffB); PG8_STAGE(PG8_SA(1, 0), a3, voffA);
            PG8_WAIT_V(8); PG8_WAIT_L(0); PG8_BAR; PG8_MMA(1, 0, At, B0); PG8_MMA(1, 1, At, B1); PG8_BAR; PG8_SCHED;
            } else {
            PG8_LDB(B0, 0, 0); PG8_SCHED; PG8_LDA(At, 0, 0); PG8_STAGE(PG8_SA(1, 1), a1 + hstep, voffA);
            PG8_WAIT_L(8); PG8_BAR; PG8_WAIT_L(0); PG8_MMA(0, 0, At, B0); PG8_BAR; PG8_SCHED;
            PG8_LDB(B1, 0, 1); PG8_STAGE(PG8_SB(0, 0), b2, voffB);
            PG8_BAR; PG8_WAIT_L(0); PG8_MMA(0, 1, At, B1); PG8_BAR;
            PG8_LDA(At, 0, 1); PG8_STAGE(PG8_SA(0, 0), a2, voffA);
            PG8_BAR; PG8_WAIT_L(0); PG8_MMA(1, 0, At, B0); PG8_BAR; PG8_SCHED;
            PG8_STAGE(PG8_SB(0, 1), b2 + hstep, voffB);
            PG8_WAIT_V(6); PG8_BAR; PG8_MMA(1, 1, At, B1); PG8_BAR;
            PG8_LDB(B0, 1, 0); PG8_SCHED; PG8_LDA(At, 1, 0); PG8_STAGE(PG8_SA(0, 1), a2 + hstep, voffA);
            PG8_WAIT_L(8); PG8_BAR; PG8_WAIT_L(0); PG8_MMA(0, 0, At, B0); PG8_BAR; PG8_SCHED;
            PG8_LDB(B1, 1, 1); PG8_STAGE(PG8_SB(1, 0), b3, voffB);
            PG8_BAR; PG8_WAIT_L(0); PG8_MMA(0, 1, At, B1); PG8_BAR;
            PG8_LDA(At, 1, 1); PG8_STAGE(PG8_SA(1, 0), a3, voffA);
            PG8_BAR; PG8_WAIT_L(0); PG8_MMA(1, 0, At, B0); PG8_BAR; PG8_SCHED;
            PG8_STAGE(PG8_SB(1, 1), b3 + hstep, voffB);
            PG8_WAIT_V(6); PG8_BAR; PG8_MMA(1, 1, At, B1); PG8_BAR;
            }
        }
        if constexpr (ALIGN_EPI) { if (wr == 0) PG8_BAR; }
        if constexpr (!Epi::AFTER_DRAIN) { E(acc, cur, wr, wc, fr, fq); S.done(cur); }
        if (!has_next) break;
#pragma unroll
        for (int a = 0; a < 2; ++a)
#pragma unroll
            for (int b = 0; b < 2; ++b)
#pragma unroll
                for (int m = 0; m < 4; ++m)
#pragma unroll
                    for (int n = 0; n < 2; ++n) acc[a][b][m][n] = (f32x4){0.f, 0.f, 0.f, 0.f};
        cur = nxt; cA = nA; cB = nB; ++ui;
        if constexpr (ALIGN_EPI) { if (wr == 1) PG8_BAR; }
    }
    PG8_WAIT_V(0);
    if constexpr (!ALIGN_EPI) { if (wr == 0) PG8_BAR; }
    PG8_BAR;
    if constexpr (Epi::AFTER_DRAIN) { E.fused(acc, cur, wr, wc, fr, fq, lds, wid, lane); S.done(cur); }
#undef PG8_SA
#undef PG8_SB
#undef PG8_STAGE
#undef PG8_LDA
#undef PG8_LDB
#undef PG8_MMA
#undef PG8_WAIT_V
#undef PG8_WAIT_L
#undef PG8_BAR
#undef PG8_SCHED
}
}
#define LAS __attribute__((address_space(3)))
typedef unsigned short bf16;
using pg8::f32x4; using pg8::u32x4; using pg8::u32x2; using pg8::bf16x8; using pg8::cvt_pk_bf16;

#ifndef ONE_LAUNCH
#define ONE_LAUNCH 1
#endif
constexpr int NWAVES = 8, NPHASE = 7;
constexpr int LDS_BYTES = 147456;
constexpr size_t MiB = 1u << 20;
constexpr size_t WS_CTL = 0, CTL_ZERO_BYTES = 1 * MiB;
constexpr size_t WS_WIN = 1 * MiB;
constexpr size_t WS_WO = 21 * MiB;
constexpr size_t WS_WGU = 29 * MiB;
constexpr size_t WS_WD = 73 * MiB;
constexpr size_t WS_WP = 95 * MiB;
constexpr size_t WS_MISC = 96 * MiB;
constexpr size_t WS_XB = 97 * MiB;
constexpr size_t WS_ZB = 133 * MiB;
constexpr size_t WS_LF = 223 * MiB;
constexpr size_t WS_ACT = WS_ZB;
constexpr size_t WS_MIX = 259 * MiB;
constexpr size_t WS_END = 295 * MiB;
constexpr int CW_RSQ2 = 4096, CW_RSQ3 = 4096 + M;

__device__ __forceinline__ float wave_sum(float v) {
#pragma unroll
    for (int o = 1; o < 64; o <<= 1) v += __shfl_xor(v, o);
    return v;
}
__device__ __forceinline__ float bf2f(bf16 b) { return __builtin_bit_cast(float, (unsigned)b << 16); }
__device__ __forceinline__ bf16 f2bf(float f) { unsigned u = __builtin_bit_cast(unsigned, f); return (bf16)((u + 0x7fffu + ((u >> 16) & 1u)) >> 16); }

struct Args { const float* in[16]; float* out; unsigned char* ws; int ph_lo, ph_hi; };

__device__ __forceinline__ void p0_item(const float* W, int K, int N, bf16* WT, int mode, const float* sk, const float* sn, LAS float* scr, int item, int lane) {
    const int nblk = N / 32, kb = item / nblk, nb = item % nblk, k0 = 64 * kb, n0 = 32 * nb;
    const int drow0 = mode == 0 ? n0 : ((n0 >> 7) * 256 + (n0 & 127) + (mode == 2 ? 128 : 0));
#pragma unroll 8
    for (int i = 0; i < 32; ++i) { const int kk = 2 * i + (lane >> 5); float w = W[(size_t)(k0 + kk) * N + n0 + (lane & 31)]; if (sk) w *= sk[k0 + kk]; scr[kk * 33 + (lane & 31)] = w; }
    asm volatile("s_waitcnt lgkmcnt(0)" ::: "memory");
    const int c = lane & 7;
#pragma unroll
    for (int j = 0; j < 4; ++j) { const int n = (lane >> 3) + 8 * j; const LAS float* s = scr + (8 * c) * 33 + n; const float f = sn ? sn[n0 + n] : 1.f;
        u32x4 o; o.x = cvt_pk_bf16(s[0 * 33] * f, s[1 * 33] * f); o.y = cvt_pk_bf16(s[2 * 33] * f, s[3 * 33] * f); o.z = cvt_pk_bf16(s[4 * 33] * f, s[5 * 33] * f); o.w = cvt_pk_bf16(s[6 * 33] * f, s[7 * 33] * f);
        *(u32x4*)(WT + (size_t)(drow0 + n) * K + k0 + 8 * c) = o; }
    asm volatile("s_waitcnt lgkmcnt(0)" ::: "memory");
}

__device__ __forceinline__ void phase0(LAS unsigned char* lds, const Args& a, int vcu, int G) {
    const int tid = threadIdx.x, lane = tid & 63, wave = tid >> 6;
    unsigned char* ws = a.ws;
    LAS float* scr = (LAS float*)(lds + wave * 16384);
    const int gw = vcu * NWAVES + wave, NGW = G * NWAVES;
    constexpr int I_IN = (D / 64) * (INC / 32), I_O = (D / 64) * (D / 32), I_G = (D / 64) * (DFF / 32), I_D = (DFF / 64) * (D / 32), I_P = (256 / 64) * (256 / 32);
    constexpr int NITEMS = I_IN + I_O + 2 * I_G + I_D + 4 * I_P;
    for (int it = gw; it < NITEMS; it += NGW) {
        int r = it;
        if (r < I_IN) { p0_item(a.in[6], D, INC, (bf16*)(ws + WS_WIN), 0, a.in[5], nullptr, scr, r, lane); continue; } r -= I_IN;
        if (r < I_O) { p0_item(a.in[10], D, D, (bf16*)(ws + WS_WO), 0, nullptr, nullptr, scr, r, lane); continue; } r -= I_O;
        if (r < I_G) { p0_item(a.in[12], D, DFF, (bf16*)(ws + WS_WGU), 1, a.in[11], nullptr, scr, r, lane); continue; } r -= I_G;
        if (r < I_G) { p0_item(a.in[13], D, DFF, (bf16*)(ws + WS_WGU), 2, a.in[11], nullptr, scr, r, lane); continue; } r -= I_G;
        if (r < I_D) { p0_item(a.in[14], DFF, D, (bf16*)(ws + WS_WD), 0, nullptr, nullptr, scr, r, lane); continue; } r -= I_D;
        { const int g = r / I_P; p0_item(a.in[7] + (size_t)g * 65536, 256, 256, (bf16*)(ws + WS_WP) + (size_t)g * 65536, 0, nullptr, a.in[8] + g * 256, scr, r % I_P, lane); }
    }
    float* rstd1 = (float*)(ws + WS_MISC); bf16* xb = (bf16*)(ws + WS_XB);
    for (int m = gw; m < M; m += NGW) {
        const float* xrow = m < MP ? a.in[0] + (size_t)m * D : a.in[1] + (size_t)(m - MP) * D;
        f32x4 v[8]; float s = 0.f;
#pragma unroll
        for (int j = 0; j < 8; ++j) { v[j] = ((const f32x4*)xrow)[lane + 64 * j]; s += (v[j][0] * v[j][0] + v[j][1] * v[j][1]) + (v[j][2] * v[j][2] + v[j][3] * v[j][3]); }
        s = wave_sum(s);
        if (lane == 0) rstd1[m] = rsqrtf(s * (1.f / D) + EPS);
#pragma unroll
        for (int j = 0; j < 8; ++j) { u32x2 w; w.x = cvt_pk_bf16(v[j][0], v[j][1]); w.y = cvt_pk_bf16(v[j][2], v[j][3]); ((u32x2*)(xb + (size_t)m * D))[lane + 64 * j] = w; }
    }
    const int gt = vcu * (NWAVES * 64) + tid, NGT = G * NWAVES * 64;
    float* lbv = (float*)(ws + WS_MISC) + M;
    for (int c = gt; c < HW; c += NGT) lbv[c] = 1.f / (1.f + __expf(a.in[4][HW + c] - a.in[4][c]));
    for (int i = gt; i < DB * 7 * PW; i += NGT) { const int b = i / (7 * PW), rem = i % (7 * PW); a.out[O_PSS + (size_t)b * PC * PW + rem] = a.in[2][(size_t)b * PC * PW + 8 * PW + rem]; }
}

__device__ __forceinline__ void pool_item(LAS unsigned char* lds, int item, const bf16* zb, const float* cache, const bf16* WpT, bf16* mixb) {
    const int tile = item >> 2, g = item & 3, m0 = tile * 64, w = 2 << g;
    const int tid = threadIdx.x, c = tid & 255, rh = tid >> 8;
    constexpr int LDA = 264;
    LAS bf16* A = (LAS bf16*)lds;
    const int col = g * 256 + c;
    const float inv_w = 1.f / (float)w;
    if (m0 < MP) {
        int m = m0 + rh * 32, t = m & (SEQ - 1);
        float s = 0.f;
        for (int j = 0; j < w; ++j) if (t - j >= 0) s += bf2f(zb[(size_t)(m - j) * INC + col]);
        for (int r = 0; r < 32; ++r, ++m, ++t) {
            const float um = bf2f(zb[(size_t)m * INC + col]);
            if (r > 0) s += um - (t - w >= 0 ? bf2f(zb[(size_t)(m - w) * INC + col]) : 0.f);
            const float cnt = (float)min(t + 1, w);
            A[(rh * 32 + r) * LDA + c] = f2bf(s / cnt - um);
        }
    } else {
        for (int r = 0; r < 32; ++r) {
            const int m = m0 + rh * 32 + r, ms = m - MP, b = ms >> 3, t = ms & 7;
            float s = 0.f;
            for (int j = 0; j < w; ++j) { const int tt = t - j; s += tt >= 0 ? bf2f(zb[(size_t)(m - j) * INC + col]) : cache[((size_t)b * PC + PC + tt) * PW + col]; }
            A[(rh * 32 + r) * LDA + c] = f2bf(s * inv_w - bf2f(zb[(size_t)m * INC + col]));
        }
    }
    __syncthreads();
    const int wave = tid >> 6, lane = tid & 63, fr = lane & 15, fq = lane >> 4, n0 = wave * 32;
    f32x4 acc[4][2];
#pragma unroll
    for (int i = 0; i < 4; ++i)
#pragma unroll
        for (int j = 0; j < 2; ++j) acc[i][j] = (f32x4){0.f, 0.f, 0.f, 0.f};
#pragma unroll 2
    for (int ks = 0; ks < 8; ++ks) {
        bf16x8 wf[2], af[4];
#pragma unroll
        for (int nt = 0; nt < 2; ++nt) wf[nt] = *(const bf16x8*)(WpT + (size_t)(g * 256 + n0 + nt * 16 + fr) * 256 + ks * 32 + fq * 8);
#pragma unroll
        for (int mt = 0; mt < 4; ++mt) af[mt] = *(const LAS bf16x8*)(A + (mt * 16 + fr) * LDA + ks * 32 + fq * 8);
#pragma unroll
        for (int mt = 0; mt < 4; ++mt)
#pragma unroll
            for (int nt = 0; nt < 2; ++nt) acc[mt][nt] = __builtin_amdgcn_mfma_f32_16x16x32_bf16(wf[nt], af[mt], acc[mt][nt], 0, 0, 0);
    }
#pragma unroll
    for (int mt = 0; mt < 4; ++mt)
#pragma unroll
        for (int nt = 0; nt < 2; ++nt) {
            u32x2 o; o.x = cvt_pk_bf16(acc[mt][nt][0], acc[mt][nt][1]); o.y = cvt_pk_bf16(acc[mt][nt][2], acc[mt][nt][3]);
            *(u32x2*)(mixb + (size_t)(m0 + mt * 16 + fr) * D + g * 256 + n0 + nt * 16 + 4 * fq) = o;
        }
    __syncthreads();
}

__device__ __forceinline__ void chain_run(LAS unsigned char* lds, const bf16* zb, const float* lf, const float* hgn, const float* S0, float* Sout, bf16* mixb, int row0, int T, int h) {
    const int tid = threadIdx.x, v = tid & 127, kq = tid >> 7, wave = tid >> 6, lane = tid & 63;
    LAS float* sq = (LAS float*)lds; LAS float* sf = sq + 1024; LAS float* sk = sf + 1024; LAS float* sv = sk + 1024; LAS float* red = sv + 1024;
    float S[32];
#pragma unroll
    for (int k = 0; k < 32; ++k) S[k] = S0 ? S0[(size_t)(kq * 32 + k) * HD + v] : 0.f;
    for (int t0 = 0; t0 < T; t0 += 8) {
        for (int i = tid; i < 1024; i += 512) {
            const int t = i >> 7, ch = i & 127; const size_t row = (size_t)(row0 + t0 + t);
            const float f = __expf(lf[row * HW + h * HD + ch]);
            sq[i] = bf2f(zb[row * INC + PW + h * HD + ch]); sf[i] = f; sk[i] = 1.f - f;
        }
        if (tid < 128 * 8 / 2 * 0 + 512) { const int i0 = tid, i1 = tid + 512;
            sv[i0] = bf2f(zb[(size_t)(row0 + t0 + (i0 >> 7)) * INC + PW + 2 * HW + h * HD + (i0 & 127)]);
            sv[i1] = bf2f(zb[(size_t)(row0 + t0 + (i1 >> 7)) * INC + PW + 2 * HW + h * HD + (i1 & 127)]); }
        __syncthreads();
#pragma unroll 1
        for (int t = 0; t < 8; ++t) {
            float o = 0.f; const float vt = sv[t * 128 + v];
            const LAS float* pf = sf + t * 128 + kq * 32; const LAS float* pk = sk + t * 128 + kq * 32; const LAS float* pq = sq + t * 128 + kq * 32;
#pragma unroll
            for (int k = 0; k < 32; ++k) { S[k] = pf[k] * S[k] + pk[k] * vt; o += pq[k] * S[k]; }
            red[(kq * 8 + t) * 128 + v] = o;
        }
        __syncthreads();
        {
            const int t = wave; const size_t row = (size_t)(row0 + t0 + t);
            float o0 = 0.f, o1 = 0.f;
#pragma unroll
            for (int q4 = 0; q4 < 4; ++q4) { o0 += red[(q4 * 8 + t) * 128 + lane]; o1 += red[(q4 * 8 + t) * 128 + lane + 64]; }
            const float ss = wave_sum(o0 * o0 + o1 * o1), r = rsqrtf(ss * (1.f / HD) + EPS);
            const int ch0 = h * HD + lane, ch1 = ch0 + 64;
            mixb[row * D + PW + ch0] = f2bf(o0 * r * hgn[ch0] * bf2f(zb[row * INC + PW + 3 * HW + ch0]));
            mixb[row * D + PW + ch1] = f2bf(o1 * r * hgn[ch1] * bf2f(zb[row * INC + PW + 3 * HW + ch1]));
        }
    }
#pragma unroll
    for (int k = 0; k < 32; ++k) Sout[(size_t)(kq * 32 + k) * HD + v] = S[k];
}

__device__ __forceinline__ void phase2(LAS unsigned char* lds, const Args& a, int bid, int G) {
    unsigned char* ws = a.ws;
    const bf16* zb = (const bf16*)(ws + WS_ZB); const float* lf = (const float*)(ws + WS_LF); bf16* mixb = (bf16*)(ws + WS_MIX);
    constexpr int NPC = NB * NH, NSC = DB * NH, NPOOL = (M / 64) * 4;
    int first, step;
    if (G >= 2 * NPC) {
        if (bid < NPC) { chain_run(lds, zb, lf, a.in[9], nullptr, a.out + O_HSP + (size_t)bid * HD * HD, mixb, (bid / NH) * SEQ, SEQ, bid % NH); return; }
        first = bid - NPC; step = G - NPC;
    } else {
        for (int c = bid; c < NPC; c += G) chain_run(lds, zb, lf, a.in[9], nullptr, a.out + O_HSP + (size_t)c * HD * HD, mixb, (c / NH) * SEQ, SEQ, c % NH);
        first = bid; step = G;
    }
    for (int it = first; it < NSC + NPOOL; it += step) {
        if (it < NSC) { const int b = it / NH, h = it % NH; chain_run(lds, zb, lf, a.in[9], a.in[3] + (size_t)it * HD * HD, a.out + O_HSS + (size_t)it * HD * HD, mixb, MP + b * DS, DS, h); __syncthreads(); }
        else pool_item(lds, it - NSC, zb, a.in[2], (const bf16*)(ws + WS_WP), mixb);
    }
}

__device__ __forceinline__ void phase6(const Args& a, int vcu, int G) {
    const int tid = threadIdx.x, lane = tid & 63, wave = tid >> 6;
    const int gw = vcu * NWAVES + wave, NGW = G * NWAVES;
    const float* rsq3 = (const float*)(a.ws + WS_CTL) + CW_RSQ3;
    for (int m = gw; m < M; m += NGW) {
        float* yr = a.out + O_Y + (size_t)m * D;
        const float r = rsqrtf(rsq3[m] * (1.f / D) + EPS);
#pragma unroll
        for (int j = 0; j < 8; ++j) { const f32x4 v = ((const f32x4*)yr)[lane + 64 * j], g = ((const f32x4*)a.in[15])[lane + 64 * j]; ((f32x4*)yr)[lane + 64 * j] = v * r * g; }
    }
}

__global__ void __launch_bounds__(NWAVES * 64, 2) mega(Args a) {
    extern __shared__ __attribute__((aligned(16))) unsigned char lds_raw[];
    LAS unsigned char* lds = (LAS unsigned char*)lds_raw;
    const int G = gridDim.x, bid = blockIdx.x;
    const int vcu = (G % 8 == 0) ? (bid % 8) * (G / 8) + bid / 8 : bid;
    unsigned char* ws = a.ws;
    float* ctlf = (float*)(ws + WS_CTL);
    const int lo = a.ph_lo, hi = a.ph_hi;
#if ONE_LAUNCH
    cg::grid_group grid = cg::this_grid();
#define GRID_BAR() grid.sync()
#else
#define GRID_BAR() do {} while (0)
#endif
#ifndef PH_MASK
#define PH_MASK 0x7f
#endif
#define IN(k) (((PH_MASK >> (k)) & 1) && lo <= (k) && (k) < hi)
#define BOTH(k) (IN(k) && IN((k) + 1))
    if (IN(0)) { phase0(lds, a, vcu, G); if (BOTH(0)) GRID_BAR(); }
    if (IN(1)) {
        pg8::Gemm g{(const bf16*)(ws + WS_XB), (const bf16*)(ws + WS_WIN), M, INC, D}; pg8::StaticOrder S; S.init(M, INC, G, bid);
        pg8::EpiZ E{(bf16*)(ws + WS_ZB), (float*)(ws + WS_LF), (const float*)(ws + WS_MISC), (const float*)(ws + WS_MISC) + M, a.out};
        pg8::gemm_phase<pg8::EpiZ, pg8::StaticOrder, true, true>(lds, g, S, E);
        if (BOTH(1)) GRID_BAR();
    }
    if (IN(2)) { phase2(lds, a, bid, G); if (BOTH(2)) GRID_BAR(); }
    if (IN(3)) {
        pg8::Gemm g{(const bf16*)(ws + WS_MIX), (const bf16*)(ws + WS_WO), M, D, D}; pg8::StaticOrder S; S.init(M, D, G, bid);
        pg8::EpiX1 E{a.in[0], a.in[1], a.out + O_Y, (bf16*)(ws + WS_XB), ctlf + CW_RSQ2};
        pg8::gemm_phase<pg8::EpiX1, pg8::StaticOrder, true, true>(lds, g, S, E);
        if (BOTH(3)) GRID_BAR();
    }
    if (IN(4)) {
        pg8::Gemm g{(const bf16*)(ws + WS_XB), (const bf16*)(ws + WS_WGU), M, 2 * DFF, D}; pg8::StaticOrder S; S.init(M, 2 * DFF, G, bid);
        pg8::EpiAct E{(bf16*)(ws + WS_ACT), ctlf + CW_RSQ2};
        pg8::gemm_phase<pg8::EpiAct, pg8::StaticOrder, true, true>(lds, g, S, E);
        if (BOTH(4)) GRID_BAR();
    }
    if (IN(5)) {
        pg8::Gemm g{(const bf16*)(ws + WS_ACT), (const bf16*)(ws + WS_WD), M, D, DFF}; pg8::StaticOrder S; S.init(M, D, G, bid);
        pg8::EpiX2 E{a.out + O_Y, ctlf + CW_RSQ3};
        pg8::gemm_phase<pg8::EpiX2, pg8::StaticOrder, true, true>(lds, g, S, E);
        if (BOTH(5)) GRID_BAR();
    }
    if (IN(6)) phase6(a, vcu, G);
#undef IN
#undef BOTH
}

extern "C" void kernel_launch(void* const* d_in, const int* in_sizes, int n_in, void* d_out, int out_size, void* d_ws, size_t ws_size, hipStream_t stream) {
    static int grid = 0;
    if (grid == 0) {
        if (n_in != 16 || ws_size < WS_END) { fprintf(stderr, "kernel_launch: unexpected n_in %d / ws_size %zu\n", n_in, ws_size); grid = -1; return; }
        int dev = 0, cus = 0, per_cu = 0;
        hipGetDevice(&dev);
        hipDeviceGetAttribute(&cus, hipDeviceAttributeMultiprocessorCount, dev);
        hipFuncSetAttribute((const void*)mega, hipFuncAttributeMaxDynamicSharedMemorySize, LDS_BYTES);
        hipOccupancyMaxActiveBlocksPerMultiprocessor(&per_cu, (const void*)mega, NWAVES * 64, LDS_BYTES);
        if (per_cu < 1) { fprintf(stderr, "kernel_launch: occupancy query says %d blocks per CU\n", per_cu); grid = -1; return; }
        grid = cus;
    }
    if (grid < 0) return;
    hipMemsetAsync((char*)d_ws + WS_CTL, 0, CTL_ZERO_BYTES, stream);
    Args a{};
    for (int i = 0; i < 16; ++i) a.in[i] = (const float*)d_in[i];
    a.out = (float*)d_out; a.ws = (unsigned char*)d_ws;
#if ONE_LAUNCH
    a.ph_lo = 0; a.ph_hi = NPHASE;
    void* args[] = {&a};
    hipError_t e = hipLaunchCooperativeKernel((const void*)mega, dim3(grid), dim3(NWAVES * 64), args, LDS_BYTES, stream);
    if (e != hipSuccess) fprintf(stderr, "cooperative launch failed: %s (grid %d)\n", hipGetErrorString(e), grid);
#else
    for (int p = 0; p < NPHASE; ++p) { a.ph_lo = p; a.ph_hi = p + 1; hipLaunchKernelGGL(mega, dim3(grid), dim3(NWAVES * 64), LDS_BYTES, stream, a); }
#endif
}
```

```cpp
#include <hip/hip_runtime.h>
#include <hip/hip_cooperative_groups.h>
#include <cstdio>
#include <cstdint>
namespace cg = cooperative_groups;

constexpr int D = 2048, NB = 4, SEQ = 2048, DB = 128, DS = 8;
constexpr int MP = NB * SEQ, MS = DB * DS, M = MP + MS;
constexpr int PW = 1024, HW = 1024, HD = 128, NH = 8, PC = 15;
constexpr int DFF = 5632, INC = 5120;
constexpr float EPS = 1e-6f;
constexpr size_t O_Y = 0;
constexpr size_t O_PSP = (size_t)M * D;
constexpr size_t O_HSP = O_PSP + (size_t)NB * PC * PW;
constexpr size_t O_PSS = O_HSP + (size_t)NB * NH * HD * HD;
constexpr size_t O_HSS = O_PSS + (size_t)DB * PC * PW;

namespace pg8 {
#define PG8_LAS __attribute__((address_space(3)))
typedef unsigned short bf16_t;
typedef short bf16x8 __attribute__((ext_vector_type(8)));
typedef float f32x4 __attribute__((ext_vector_type(4)));
typedef unsigned u32x4 __attribute__((ext_vector_type(4)));
constexpr int BM = 256, BK = 64, HALF = 128, HTB = HALF * BK * 2  , STAGE_BYTES = 8 * HTB, NXCD = 8, WGM = 8;

__host__ __device__ __forceinline__ int lds_byte(int r, int c) { const int st = (r >> 4) * 2 + (c >> 5), rr = r & 15, cc = c & 31, ob = rr * 64 + cc * 2; return st * 1024 + (ob ^ (((ob >> 9) & 1) << 5)); }
__host__ __device__ __forceinline__ void stage_rc(int b, int& R, int& C) { const int st = b / 1024, sb = b % 1024, swz = sb ^ (((sb >> 9) & 1) << 5); R = (st >> 1) * 16 + swz / 64; C = (st & 1) * 32 + (swz % 64) / 2; }
__host__ __device__ __forceinline__ int perm32(int rho) { const int n = rho >> 4, i = rho & 15; return 8 * (i >> 2) + 4 * n + (i & 3); }

struct Unit { int pm, pn; };
struct Gemm { const bf16_t* A; const bf16_t* Bt; int M, N, K; };

struct StaticOrder {
    int nM, nN, nwg, G, c;
    __host__ __device__ void init(int M, int N, int G_, int c_) { nM = M / BM; nN = N / BM; nwg = nM * nN; G = G_; c = c_; }
    __host__ __device__ bool next(int i, Unit& u) const {
        const long L = (long)i * G + c; if (L >= nwg) return false;
        int wgid = (int)L; { const int q = nwg / NXCD, r = nwg % NXCD, xcd = wgid % NXCD, off = wgid / NXCD; wgid = (xcd < r ? xcd * (q + 1) : r * (q + 1) + (xcd - r) * q) + off; }
        const int nig = WGM * nN, gid = wgid / nig, fm = gid * WGM, gsz = (nM - fm) < WGM ? (nM - fm) : WGM;
        u.pm = fm + ((wgid % nig) % gsz); u.pn = (wgid % nig) / gsz; return true;
    }
    __device__ __forceinline__ void a_ready(const Unit&) const {}
    __device__ __forceinline__ void done(const Unit&) const {}
};
__device__ __forceinline__ unsigned cvt_pk_bf16(float lo, float hi) { unsigned r; asm volatile("v_cvt_pk_bf16_f32 %0, %1, %2" : "=v"(r) : "v"(lo), "v"(hi)); return r; }
__device__ __forceinline__ float sigm(float x) { return __builtin_amdgcn_rcpf(1.f + __expf(-x)); }
__device__ __forceinline__ float silu(float x) { return x * __builtin_amdgcn_rcpf(1.f + __expf(-x)); }
typedef unsigned u32x2 __attribute__((ext_vector_type(2)));

struct EpiZ {
    static constexpr bool PERM = true, AFTER_DRAIN = false;
    bf16_t* zb; float* lf; const float* rstd1; const float* lbv; float* out;
    __device__ __forceinline__ void operator()(const f32x4 (&acc)[2][2][4][2], const Unit& u, int wr, int wc, int fr, int fq) const {
        const int kind = u.pn >> 2;
        const int row0 = u.pm * BM + wr * 64 + fr;
        const int cc0 = (u.pn & 3) * 256 + wc * 32 + 8 * fq;
        f32x4 lb[2][2];
        if (kind == 2) {
#pragma unroll
            for (int bj = 0; bj < 2; ++bj)
#pragma unroll
                for (int n = 0; n < 2; ++n) lb[bj][n] = *(const f32x4*)(lbv + cc0 + bj * HALF + 4 * n);
        }
#pragma unroll
        for (int ai = 0; ai < 2; ++ai)
#pragma unroll
            for (int m = 0; m < 4; ++m) {
                const int row = row0 + ai * HALF + m * 16;
                const float r = rstd1[row];
#pragma unroll
                for (int bj = 0; bj < 2; ++bj) {
                    const int cc = cc0 + bj * HALF;
                    f32x4 v0 = acc[ai][bj][m][0] * r, v1 = acc[ai][bj][m][1] * r;
                    if (kind == 2) {
#pragma unroll
                        for (int j = 0; j < 4; ++j) {
                            v0[j] = __logf(lb[bj][0][j] + (1.f - lb[bj][0][j]) * sigm(v0[j]));
                            v1[j] = __logf(lb[bj][1][j] + (1.f - lb[bj][1][j]) * sigm(v1[j]));
                        }
                        float* p = lf + (size_t)row * HW + cc;
                        *(f32x4*)p = v0; *(f32x4*)(p + 4) = v1;
                    } else {
                        if (kind == 0) {
                            float* dst = nullptr;
                            if (row >= MP) { const int ms = row - MP; dst = out + O_PSS + ((size_t)(ms >> 3) * PC + 7 + (ms & 7)) * PW + cc; }
                            else { const int t = row & (SEQ - 1); if (t >= SEQ - PC) dst = out + O_PSP + ((size_t)(row >> 11) * PC + (t - (SEQ - PC))) * PW + cc; }
                            if (dst) { *(f32x4*)dst = v0; *(f32x4*)(dst + 4) = v1; }
                        }
                        if (kind == 1 || kind == 4) {
#pragma unroll
                            for (int j = 0; j < 4; ++j) { v0[j] = silu(v0[j]); v1[j] = silu(v1[j]); }
                        }
                        u32x4 w; w.x = cvt_pk_bf16(v0[0], v0[1]); w.y = cvt_pk_bf16(v0[2], v0[3]); w.z = cvt_pk_bf16(v1[0], v1[1]); w.w = cvt_pk_bf16(v1[2], v1[3]);
                        *(u32x4*)(zb + (size_t)row * INC + kind * 1024 + cc) = w;
                    }
                }
            }
    }
};

struct EpiX1 {
    static constexpr bool PERM = false, AFTER_DRAIN = false;
    const float* xp; const float* xs; float* y; bf16_t* x1b; float* rowsq;
    __device__ __forceinline__ void operator()(const f32x4 (&acc)[2][2][4][2], const Unit& u, int wr, int wc, int fr, int fq) const {
        const int row0 = u.pm * BM + wr * 64 + fr, col0 = u.pn * BM + wc * 32 + 4 * fq;
#pragma unroll
        for (int ai = 0; ai < 2; ++ai)
#pragma unroll
            for (int m = 0; m < 4; ++m) {
                const int row = row0 + ai * HALF + m * 16;
                const float* xr = (row < MP ? xp + (size_t)row * D : xs + (size_t)(row - MP) * D) + col0;
                float* yr = y + (size_t)row * D + col0; bf16_t* br = x1b + (size_t)row * D + col0;
                float s = 0.f;
#pragma unroll
                for (int bj = 0; bj < 2; ++bj)
#pragma unroll
                    for (int n = 0; n < 2; ++n) {
                        const f32x4 v = *(const f32x4*)(xr + bj * HALF + n * 16) + acc[ai][bj][m][n];
                        *(f32x4*)(yr + bj * HALF + n * 16) = v;
                        u32x2 w; w.x = cvt_pk_bf16(v[0], v[1]); w.y = cvt_pk_bf16(v[2], v[3]);
                        *(u32x2*)(br + bj * HALF + n * 16) = w;
                        s += (v[0] * v[0] + v[1] * v[1]) + (v[2] * v[2] + v[3] * v[3]);
                    }
                s += __shfl_xor(s, 16); s += __shfl_xor(s, 32);
                if (fq == 0) atomicAdd(rowsq + row, s);
            }
    }
};

struct EpiAct {
    static constexpr bool PERM = true, AFTER_DRAIN = false;
    bf16_t* act; const float* rowsq;
    __device__ __forceinline__ void operator()(const f32x4 (&acc)[2][2][4][2], const Unit& u, int wr, int wc, int fr, int fq) const {
        const int row0 = u.pm * BM + wr * 64 + fr, col0 = u.pn * HALF + wc * 32 + 8 * fq;
#pragma unroll
        for (int ai = 0; ai < 2; ++ai)
#pragma unroll
            for (int m = 0; m < 4; ++m) {
                const int row = row0 + ai * HALF + m * 16;
                const float r = rsqrtf(rowsq[row] * (1.f / D) + EPS);
                u32x4 w; unsigned* wp = (unsigned*)&w;
#pragma unroll
                for (int n = 0; n < 2; ++n) {
                    const f32x4 g = acc[ai][0][m][n] * r, up = acc[ai][1][m][n] * r;
                    f32x4 a;
#pragma unroll
                    for (int j = 0; j < 4; ++j) a[j] = silu(g[j]) * up[j];
                    wp[2 * n] = cvt_pk_bf16(a[0], a[1]); wp[2 * n + 1] = cvt_pk_bf16(a[2], a[3]);
                }
                *(u32x4*)(act + (size_t)row * DFF + col0) = w;
            }
    }
};

struct EpiX2 {
    static constexpr bool PERM = false, AFTER_DRAIN = false;
    float* y; float* rowsq;
    __device__ __forceinline__ void operator()(const f32x4 (&acc)[2][2][4][2], const Unit& u, int wr, int wc, int fr, int fq) const {
        const int row0 = u.pm * BM + wr * 64 + fr, col0 = u.pn * BM + wc * 32 + 4 * fq;
#pragma unroll
        for (int ai = 0; ai < 2; ++ai)
#pragma unroll
            for (int m = 0; m < 4; ++m) {
                const int row = row0 + ai * HALF + m * 16;
                float* yr = y + (size_t)row * D + col0;
                float s = 0.f;
#pragma unroll
                for (int bj = 0; bj < 2; ++bj)
#pragma unroll
                    for (int n = 0; n < 2; ++n) {
                        const f32x4 v = *(const f32x4*)(yr + bj * HALF + n * 16) + acc[ai][bj][m][n];
                        *(f32x4*)(yr + bj * HALF + n * 16) = v;
                        s += (v[0] * v[0] + v[1] * v[1]) + (v[2] * v[2] + v[3] * v[3]);
                    }
                s += __shfl_xor(s, 16); s += __shfl_xor(s, 32);
                if (fq == 0) atomicAdd(rowsq + row, s);
            }
    }
};
template <class Epi, class Sched, bool ALIGN_EPI = false, bool SP2 = false>
__device__ __forceinline__ void gemm_phase(PG8_LAS unsigned char* lds, const Gemm g, const Sched& S, const Epi& E) {
    int tid_ = threadIdx.x; asm volatile("" : "+v"(tid_));
    const int tid = tid_, wid = __builtin_amdgcn_readfirstlane(tid >> 6), lane = tid & 63, wr = wid >> 2, wc = wid & 3, fr = lane & 15, fq = lane >> 4;
    const int K = g.K, nt = K / BK;
    unsigned voffA[2], voffB[2];
#pragma unroll
    for (int i = 0; i < 2; ++i) { int R, C; stage_rc(tid * 16 + i * 8192, R, C); const int Rb = Epi::PERM ? ((R & ~31) + perm32(R & 31)) : R;
        voffA[i] = (unsigned)(R * K + C) * 2u; voffB[i] = (unsigned)(Rb * K + C) * 2u; }
    const size_t kstep = (size_t)(BK * 2);
    const size_t hstep = (size_t)HALF * K * 2;
    const size_t tstep = 2 * hstep;
    const unsigned ldsw = (unsigned)wid * 1024u;
    const int aoff = lds_byte(wr * 64 + fr, fq * 8), boff = lds_byte(wc * 32 + fr, fq * 8);
#define PG8_SA(b, h) (((b) * 2 + (h)) * HTB)
#define PG8_SB(b, h) ((4 + (b) * 2 + (h)) * HTB)
#define PG8_STAGE(bufoff, gbase, voff) do { _Pragma("unroll") for (int _i = 0; _i < 2; ++_i) \
        __builtin_amdgcn_global_load_lds((const unsigned*)((const char*)(gbase) + (voff)[_i]), (PG8_LAS unsigned*)(lds + (bufoff) + ldsw + _i * 8192), 16, 0, 0); } while (0)
#define PG8_LDA(dst, b, h) do { _Pragma("unroll") for (int m = 0; m < 4; ++m) _Pragma("unroll") for (int k = 0; k < 2; ++k) dst[m][k] = *(const PG8_LAS bf16x8*)(lds + PG8_SA(b, h) + aoff + m * 2048 + k * 1024); } while (0)
#define PG8_LDB(dst, b, h) do { _Pragma("unroll") for (int n = 0; n < 2; ++n) _Pragma("unroll") for (int k = 0; k < 2; ++k) dst[n][k] = *(const PG8_LAS bf16x8*)(lds + PG8_SB(b, h) + boff + n * 2048 + k * 1024); } while (0)
#define PG8_MMA(ai, bj, At, Bt) do { __builtin_amdgcn_s_setprio(1); _Pragma("unroll") for (int m = 0; m < 4; ++m) _Pragma("unroll") for (int n = 0; n < 2; ++n) _Pragma("unroll") for (int k = 0; k < 2; ++k) \
        acc[ai][bj][m][n] = __builtin_amdgcn_mfma_f32_16x16x32_bf16(Bt[n][k], At[m][k], acc[ai][bj][m][n], 0, 0, 0); __builtin_amdgcn_s_setprio(0); } while (0)
#define PG8_WAIT_V(n) asm volatile("s_waitcnt vmcnt(" #n ")" ::: "memory")
#define PG8_WAIT_L(n) asm volatile("s_waitcnt lgkmcnt(" #n ")" ::: "memory")
#define PG8_BAR __builtin_amdgcn_s_barrier()
#define PG8_SCHED __builtin_amdgcn_sched_barrier(0)
    Unit cur, nxt; int ui = 0;
    if (!S.next(0, cur)) return;
    f32x4 acc[2][2][4][2];
#pragma unroll
    for (int a = 0; a < 2; ++a)
#pragma unroll
        for (int b = 0; b < 2; ++b)
#pragma unroll
            for (int m = 0; m < 4; ++m)
#pragma unroll
                for (int n = 0; n < 2; ++n) acc[a][b][m][n] = (f32x4){0.f, 0.f, 0.f, 0.f};
    bf16x8 At[4][2], B0[2][2], B1[2][2];
    const char* cA = (const char*)g.A + (size_t)cur.pm * tstep; const char* cB = (const char*)g.Bt + (size_t)cur.pn * tstep;
    S.a_ready(cur);
    if constexpr (SP2) {
        PG8_STAGE(PG8_SB(0, 0), cB, voffB); PG8_STAGE(PG8_SB(0, 1), cB + hstep, voffB); PG8_STAGE(PG8_SA(0, 0), cA, voffA); PG8_STAGE(PG8_SA(0, 1), cA + hstep, voffA);
        if (wr == 1) PG8_BAR;
        PG8_WAIT_V(2); PG8_BAR;
        PG8_STAGE(PG8_SB(1, 0), cB + kstep, voffB); PG8_STAGE(PG8_SA(1, 0), cA + kstep, voffA); PG8_STAGE(PG8_SB(1, 1), cB + hstep + kstep, voffB);
        PG8_WAIT_V(6); PG8_BAR;
    } else {
        PG8_STAGE(PG8_SB(0, 0), cB, voffB); PG8_STAGE(PG8_SA(0, 0), cA, voffA); PG8_STAGE(PG8_SB(0, 1), cB + hstep, voffB); PG8_STAGE(PG8_SA(0, 1), cA + hstep, voffA);
        if (wr == 1) PG8_BAR;
        PG8_WAIT_V(4); PG8_BAR;
        PG8_STAGE(PG8_SB(1, 0), cB + kstep, voffB); PG8_STAGE(PG8_SA(1, 0), cA + kstep, voffA); PG8_STAGE(PG8_SB(1, 1), cB + hstep + kstep, voffB);
        PG8_WAIT_V(6); PG8_BAR;
    }
    for (;;) {
        const bool has_next = S.next(ui + 1, nxt);
        const char* nA = has_next ? (const char*)g.A + (size_t)nxt.pm * tstep : cA; const char* nB = has_next ? (const char*)g.Bt + (size_t)nxt.pn * tstep : cB;
        for (int t = 0; t < nt; t += 2) {
            const bool last = (t == nt - 2);
            const char* a1 = cA + (size_t)(t + 1) * kstep;
            const char* a2 = last ? nA : cA + (size_t)(t + 2) * kstep; const char* b2 = last ? nB : cB + (size_t)(t + 2) * kstep;
            const char* a3 = a2 + kstep; const char* b3 = b2 + kstep;
            if (last && has_next) S.a_ready(nxt);
            if constexpr (SP2) {
            PG8_LDB(B0, 0, 0); PG8_LDB(B1, 0, 1); PG8_SCHED; PG8_LDA(At, 0, 0); PG8_STAGE(PG8_SA(1, 1), a1 + hstep, voffA);
            PG8_WAIT_V(8); PG8_WAIT_L(0); PG8_BAR; PG8_MMA(0, 0, At, B0); PG8_MMA(0, 1, At, B1); PG8_BAR; PG8_SCHED;
            PG8_LDA(At, 0, 1); PG8_STAGE(PG8_SB(0, 0), b2, voffB); PG8_STAGE(PG8_SB(0, 1), b2 + hstep, voffB); PG8_STAGE(PG8_SA(0, 0), a2, voffA);
            PG8_WAIT_V(8); PG8_WAIT_L(0); PG8_BAR; PG8_MMA(1, 0, At, B0); PG8_MMA(1, 1, At, B1); PG8_BAR; PG8_SCHED;
            PG8_LDB(B0, 1, 0); PG8_LDB(B1, 1, 1); PG8_SCHED; PG8_LDA(At, 1, 0); PG8_STAGE(PG8_SA(0, 1), a2 + hstep, voffA);
            PG8_WAIT_V(8); PG8_WAIT_L(0); PG8_BAR; PG8_MMA(0, 0, At, B0); PG8_MMA(0, 1, At, B1); PG8_BAR; PG8_SCHED;
            PG8_LDA(At, 1, 1); PG8_STAGE(PG8_SB(1, 0), b3, voffB); PG8_STAGE(PG8_SB(1, 1), b3 + hstep, voffB); PG8_STAGE(PG8_SA(1, 0), a3, voffA);
            PG8_WAIT_V(8); PG8_WAIT_L(0); PG8_BAR; PG8_MMA(1, 0, At, B0); PG8_MMA(1, 1, At, B1); PG8_BAR; PG8_SCHED;
            } else {
            PG8_LDB(B0, 0, 0); PG8_SCHED; PG8_LDA(At, 0, 0); PG8_STAGE(PG8_SA(1, 1), a1 + hstep, voffA);
            PG8_WAIT_L(8); PG8_BAR; PG8_WAIT_L(0); PG8_MMA(0, 0, At, B0); PG8_BAR; PG8_SCHED;
            PG8_LDB(B1, 0, 1); PG8_STAGE(PG8_SB(0, 0), b2, voffB);
            PG8_BAR; PG8_WAIT_L(0); PG8_MMA(0, 1, At, B1); PG8_BAR;
            PG8_LDA(At, 0, 1); PG8_STAGE(PG8_SA(0, 0), a2, voffA);
            PG8_BAR; PG8_WAIT_L(0); PG8_MMA(1, 0, At, B0); PG8_BAR; PG8_SCHED;
            PG8_STAGE(PG8_SB(0, 1), b2 + hstep, voffB);
            PG8_WAIT_V(6); PG8_BAR; PG8_MMA(1, 1, At, B1); PG8_BAR;
            PG8_LDB(B0, 1, 0); PG8_SCHED; PG8_LDA(At, 1, 0); PG8_STAGE(PG8_SA(0, 1), a2 + hstep, voffA);
            PG8_WAIT_L(8); PG8_BAR; PG8_WAIT_L(0); PG8_MMA(0, 0, At, B0); PG8_BAR; PG8_SCHED;
            PG8_LDB(B1, 1, 1); PG8_STAGE(PG8_SB(1, 0), b3, voffB);
            PG8_BAR; PG8_WAIT_L(0); PG8_MMA(0, 1, At, B1); PG8_BAR;
            PG8_LDA(At, 1, 1); PG8_STAGE(PG8_SA(1, 0), a3, voffA);
            PG8_BAR; PG8_WAIT_L(0); PG8_MMA(1, 0, At, B0); PG8_BAR; PG8_SCHED;
            PG8_STAGE(PG8_SB(1, 1), b3 + hstep, voffB);
            PG8_WAIT_V(6); PG8_BAR; PG8_MMA(1, 1, At, B1); PG8_BAR;
            }
        }
        if constexpr (ALIGN_EPI) { if (wr == 0) PG8_BAR; }
        if constexpr (!Epi::AFTER_DRAIN) { E(acc, cur, wr, wc, fr, fq); S.done(cur); }
        if (!has_next) break;
#pragma unroll
        for (int a = 0; a < 2; ++a)
#pragma unroll
            for (int b = 0; b < 2; ++b)
#pragma unroll
                for (int m = 0; m < 4; ++m)
#pragma unroll
                    for (int n = 0; n < 2; ++n) acc[a][b][m][n] = (f32x4){0.f, 0.f, 0.f, 0.f};
        cur = nxt; cA = nA; cB = nB; ++ui;
        if constexpr (ALIGN_EPI) { if (wr == 1) PG8_BAR; }
    }
    PG8_WAIT_V(0);
    if constexpr (!ALIGN_EPI) { if (wr == 0) PG8_BAR; }
    PG8_BAR;
    if constexpr (Epi::AFTER_DRAIN) { E.fused(acc, cur, wr, wc, fr, fq, lds, wid, lane); S.done(cur); }
#undef PG8_SA
#undef PG8_SB
#undef PG8_STAGE
#undef PG8_LDA
#undef PG8_LDB
#undef PG8_MMA
#undef PG8_WAIT_V
#undef PG8_WAIT_L
#undef PG8_BAR
#undef PG8_SCHED
}
}
#define LAS __attribute__((address_space(3)))
typedef unsigned short bf16;
using pg8::f32x4; using pg8::u32x4; using pg8::u32x2; using pg8::bf16x8; using pg8::cvt_pk_bf16;

#ifndef ONE_LAUNCH
#define ONE_LAUNCH 1
#endif
constexpr int NWAVES = 8, NPHASE = 7;
constexpr int LDS_BYTES = 147456;
constexpr size_t MiB = 1u << 20;
constexpr size_t WS_CTL = 0, CTL_ZERO_BYTES = 1 * MiB;
constexpr size_t WS_WIN = 1 * MiB;
constexpr size_t WS_WO = 21 * MiB;
constexpr size_t WS_WGU = 29 * MiB;
constexpr size_t WS_WD = 73 * MiB;
constexpr size_t WS_WP = 95 * MiB;
constexpr size_t WS_MISC = 96 * MiB;
constexpr size_t WS_XB = 97 * MiB;
constexpr size_t WS_ZB = 133 * MiB;
constexpr size_t WS_LF = 223 * MiB;
constexpr size_t WS_ACT = WS_ZB;
constexpr size_t WS_MIX = 259 * MiB;
constexpr size_t WS_END = 295 * MiB;
constexpr int CW_RSQ2 = 4096, CW_RSQ3 = 4096 + M;

__device__ __forceinline__ float wave_sum(float v) {
#pragma unroll
    for (int o = 1; o < 64; o <<= 1) v += __shfl_xor(v, o);
    return v;
}
__device__ __forceinline__ float bf2f(bf16 b) { return __builtin_bit_cast(float, (unsigned)b << 16); }
__device__ __forceinline__ bf16 f2bf(float f) { unsigned u = __builtin_bit_cast(unsigned, f); return (bf16)((u + 0x7fffu + ((u >> 16) & 1u)) >> 16); }

struct Args { const float* in[16]; float* out; unsigned char* ws; int ph_lo, ph_hi; };

__device__ __forceinline__ void p0_item(const float* W, int K, int N, bf16* WT, int mode, const float* sk, const float* sn, LAS float* scr, int item, int lane) {
    const int nblk = N / 32, kb = item / nblk, nb = item % nblk, k0 = 64 * kb, n0 = 32 * nb;
    const int drow0 = mode == 0 ? n0 : ((n0 >> 7) * 256 + (n0 & 127) + (mode == 2 ? 128 : 0));
#pragma unroll 8
    for (int i = 0; i < 32; ++i) { const int kk = 2 * i + (lane >> 5); float w = W[(size_t)(k0 + kk) * N + n0 + (lane & 31)]; if (sk) w *= sk[k0 + kk]; scr[kk * 33 + (lane & 31)] = w; }
    asm volatile("s_waitcnt lgkmcnt(0)" ::: "memory");
    const int c = lane & 7;
#pragma unroll
    for (int j = 0; j < 4; ++j) { const int n = (lane >> 3) + 8 * j; const LAS float* s = scr + (8 * c) * 33 + n; const float f = sn ? sn[n0 + n] : 1.f;
        u32x4 o; o.x = cvt_pk_bf16(s[0 * 33] * f, s[1 * 33] * f); o.y = cvt_pk_bf16(s[2 * 33] * f, s[3 * 33] * f); o.z = cvt_pk_bf16(s[4 * 33] * f, s[5 * 33] * f); o.w = cvt_pk_bf16(s[6 * 33] * f, s[7 * 33] * f);
        *(u32x4*)(WT + (size_t)(drow0 + n) * K + k0 + 8 * c) = o; }
    asm volatile("s_waitcnt lgkmcnt(0)" ::: "memory");
}

__device__ __forceinline__ void phase0(LAS unsigned char* lds, const Args& a, int vcu, int G) {
    const int tid = threadIdx.x, lane = tid & 63, wave = tid >> 6;
    unsigned char* ws = a.ws;
    LAS float* scr = (LAS float*)(lds + wave * 16384);
    const int gw = vcu * NWAVES + wave, NGW = G * NWAVES;
    constexpr int I_IN = (D / 64) * (INC / 32), I_O = (D / 64) * (D / 32), I_G = (D / 64) * (DFF / 32), I_D = (DFF / 64) * (D / 32), I_P = (256 / 64) * (256 / 32);
    constexpr int NITEMS = I_IN + I_O + 2 * I_G + I_D + 4 * I_P;
    for (int it = gw; it < NITEMS; it += NGW) {
        int r = it;
        if (r < I_IN) { p0_item(a.in[6], D, INC, (bf16*)(ws + WS_WIN), 0, a.in[5], nullptr, scr, r, lane); continue; } r -= I_IN;
        if (r < I_O) { p0_item(a.in[10], D, D, (bf16*)(ws + WS_WO), 0, nullptr, nullptr, scr, r, lane); continue; } r -= I_O;
        if (r < I_G) { p0_item(a.in[12], D, DFF, (bf16*)(ws + WS_WGU), 1, a.in[11], nullptr, scr, r, lane); continue; } r -= I_G;
        if (r < I_G) { p0_item(a.in[13], D, DFF, (bf16*)(ws + WS_WGU), 2, a.in[11], nullptr, scr, r, lane); continue; } r -= I_G;
        if (r < I_D) { p0_item(a.in[14], DFF, D, (bf16*)(ws + WS_WD), 0, nullptr, nullptr, scr, r, lane); continue; } r -= I_D;
        { const int g = r / I_P; p0_item(a.in[7] + (size_t)g * 65536, 256, 256, (bf16*)(ws + WS_WP) + (size_t)g * 65536, 0, nullptr, a.in[8] + g * 256, scr, r % I_P, lane); }
    }
    float* rstd1 = (float*)(ws + WS_MISC); bf16* xb = (bf16*)(ws + WS_XB);
    for (int m = gw; m < M; m += NGW) {
        const float* xrow = m < MP ? a.in[0] + (size_t)m * D : a.in[1] + (size_t)(m - MP) * D;
        f32x4 v[8]; float s = 0.f;
#pragma unroll
        for (int j = 0; j < 8; ++j) { v[j] = ((const f32x4*)xrow)[lane + 64 * j]; s += (v[j][0] * v[j][0] + v[j][1] * v[j][1]) + (v[j][2] * v[j][2] + v[j][3] * v[j][3]); }
        s = wave_sum(s);
        if (lane == 0) rstd1[m] = rsqrtf(s * (1.f / D) + EPS);
#pragma unroll
        for (int j = 0; j < 8; ++j) { u32x2 w; w.x = cvt_pk_bf16(v[j][0], v[j][1]); w.y = cvt_pk_bf16(v[j][2], v[j][3]); ((u32x2*)(xb + (size_t)m * D))[lane + 64 * j] = w; }
    }
    const int gt = vcu * (NWAVES * 64) + tid, NGT = G * NWAVES * 64;
    float* lbv = (float*)(ws + WS_MISC) + M;
    for (int c = gt; c < HW; c += NGT) lbv[c] = 1.f / (1.f + __expf(a.in[4][HW + c] - a.in[4][c]));
    for (int i = gt; i < DB * 7 * PW; i += NGT) { const int b = i / (7 * PW), rem = i % (7 * PW); a.out[O_PSS + (size_t)b * PC * PW + rem] = a.in[2][(size_t)b * PC * PW + 8 * PW + rem]; }
}

__device__ __forceinline__ void pool_item(LAS unsigned char* lds, int item, const bf16* zb, const float* cache, const bf16* WpT, bf16* mixb) {
    const int tile = item >> 2, g = item & 3, m0 = tile * 64, w = 2 << g;
    const int tid = threadIdx.x, c = tid & 255, rh = tid >> 8;
    constexpr int LDA = 264;
    LAS bf16* A = (LAS bf16*)lds;
    const int col = g * 256 + c;
    const float inv_w = 1.f / (float)w;
    if (m0 < MP) {
        int m = m0 + rh * 32, t = m & (SEQ - 1);
        float s = 0.f;
        for (int j = 0; j < w; ++j) if (t - j >= 0) s += bf2f(zb[(size_t)(m - j) * INC + col]);
        for (int r = 0; r < 32; ++r, ++m, ++t) {
            const float um = bf2f(zb[(size_t)m * INC + col]);
            if (r > 0) s += um - (t - w >= 0 ? bf2f(zb[(size_t)(m - w) * INC + col]) : 0.f);
            const float cnt = (float)min(t + 1, w);
            A[(rh * 32 + r) * LDA + c] = f2bf(s / cnt - um);
        }
    } else {
        for (int r = 0; r < 32; ++r) {
            const int m = m0 + rh * 32 + r, ms = m - MP, b = ms >> 3, t = ms & 7;
            float s = 0.f;
            for (int j = 0; j < w; ++j) { const int tt = t - j; s += tt >= 0 ? bf2f(zb[(size_t)(m - j) * INC + col]) : cache[((size_t)b * PC + PC + tt) * PW + col]; }
            A[(rh * 32 + r) * LDA + c] = f2bf(s * inv_w - bf2f(zb[(size_t)m * INC + col]));
        }
    }
    __syncthreads();
    const int wave = tid >> 6, lane = tid & 63, fr = lane & 15, fq = lane >> 4, n0 = wave * 32;
    f32x4 acc[4][2];
#pragma unroll
    for (int i = 0; i < 4; ++i)
#pragma unroll
        for (int j = 0; j < 2; ++j) acc[i][j] = (f32x4){0.f, 0.f, 0.f, 0.f};
#pragma unroll 2
    for (int ks = 0; ks < 8; ++ks) {
        bf16x8 wf[2], af[4];
#pragma unroll
        for (int nt = 0; nt < 2; ++nt) wf[nt] = *(const bf16x8*)(WpT + (size_t)(g * 256 + n0 + nt * 16 + fr) * 256 + ks * 32 + fq * 8);
#pragma unroll
        for (int mt = 0; mt < 4; ++mt) af[mt] = *(const LAS bf16x8*)(A + (mt * 16 + fr) * LDA + ks * 32 + fq * 8);
#pragma unroll
        for (int mt = 0; mt < 4; ++mt)
#pragma unroll
            for (int nt = 0; nt < 2; ++nt) acc[mt][nt] = __builtin_amdgcn_mfma_f32_16x16x32_bf16(wf[nt], af[mt], acc[mt][nt], 0, 0, 0);
    }
#pragma unroll
    for (int mt = 0; mt < 4; ++mt)
#pragma unroll
        for (int nt = 0; nt < 2; ++nt) {
            u32x2 o; o.x = cvt_pk_bf16(acc[mt][nt][0], acc[mt][nt][1]); o.y = cvt_pk_bf16(acc[mt][nt][2], acc[mt][nt][3]);
            *(u32x2*)(mixb + (size_t)(m0 + mt * 16 + fr) * D + g * 256 + n0 + nt * 16 + 4 * fq) = o;
        }
    __syncthreads();
}

__device__ __forceinline__ void chain_run(LAS unsigned char* lds, const bf16* zb, const float* lf, const float* hgn, const float* S0, float* Sout, bf16* mixb, int row0, int T, int h) {
    const int tid = threadIdx.x, v = tid & 127, kq = tid >> 7, wave = tid >> 6, lane = tid & 63;
    LAS float* sq = (LAS float*)lds; LAS float* sf = sq + 1024; LAS float* sk = sf + 1024; LAS float* sv = sk + 1024; LAS float* red = sv + 1024;
    float S[32];
#pragma unroll
    for (int k = 0; k < 32; ++k) S[k] = S0 ? S0[(size_t)(kq * 32 + k) * HD + v] : 0.f;
    for (int t0 = 0; t0 < T; t0 += 8) {
        for (int i = tid; i < 1024; i += 512) {
            const int t = i >> 7, ch = i & 127; const size_t row = (size_t)(row0 + t0 + t);
            const float f = __expf(lf[row * HW + h * HD + ch]);
            sq[i] = bf2f(zb[row * INC + PW + h * HD + ch]); sf[i] = f; sk[i] = 1.f - f;
        }
        if (tid < 128 * 8 / 2 * 0 + 512) { const int i0 = tid, i1 = tid + 512;
            sv[i0] = bf2f(zb[(size_t)(row0 + t0 + (i0 >> 7)) * INC + PW + 2 * HW + h * HD + (i0 & 127)]);
            sv[i1] = bf2f(zb[(size_t)(row0 + t0 + (i1 >> 7)) * INC + PW + 2 * HW + h * HD + (i1 & 127)]); }
        __syncthreads();
#pragma unroll 1
        for (int t = 0; t < 8; ++t) {
            float o = 0.f; const float vt = sv[t * 128 + v];
            const LAS float* pf = sf + t * 128 + kq * 32; const LAS float* pk = sk + t * 128 + kq * 32; const LAS float* pq = sq + t * 128 + kq * 32;
#pragma unroll
            for (int k = 0; k < 32; ++k) { S[k] = pf[k] * S[k] + pk[k] * vt; o += pq[k] * S[k]; }
            red[(kq * 8 + t) * 128 + v] = o;
        }
        __syncthreads();
        {
            const int t = wave; const size_t row = (size_t)(row0 + t0 + t);
            float o0 = 0.f, o1 = 0.f;
#pragma unroll
            for (int q4 = 0; q4 < 4; ++q4) { o0 += red[(q4 * 8 + t) * 128 + lane]; o1 += red[(q4 * 8 + t) * 128 + lane + 64]; }
            const float ss = wave_sum(o0 * o0 + o1 * o1), r = rsqrtf(ss * (1.f / HD) + EPS);
            const int ch0 = h * HD + lane, ch1 = ch0 + 64;
            mixb[row * D + PW + ch0] = f2bf(o0 * r * hgn[ch0] * bf2f(zb[row * INC + PW + 3 * HW + ch0]));
            mixb[row * D + PW + ch1] = f2bf(o1 * r * hgn[ch1] * bf2f(zb[row * INC + PW + 3 * HW + ch1]));
        }
    }
#pragma unroll
    for (int k = 0; k < 32; ++k) Sout[(size_t)(kq * 32 + k) * HD + v] = S[k];
}


constexpr int CQS = 272, CTS = 144;
constexpr int L_Q = 0, L_K = L_Q + 64 * CQS, L_KT = L_K + 64 * CQS, L_VT = L_KT + 128 * CTS, L_ST = L_VT + 128 * CTS, L_P = L_ST + 128 * CQS,
              L_DS = L_P + 64 * CTS, L_TOT = L_DS + 512, L_RMS = L_TOT + 2048, L_CHAIN_END = L_RMS + 512;
static_assert(L_CHAIN_END <= 131072, "chain LDS");
__device__ __forceinline__ void chain_mfma(LAS unsigned char* lds, const bf16* zb, const float* lf, const float* hgn, float* Sout, bf16* mixb, int row0, int h) {
    const int tid = threadIdx.x, lane = tid & 63, wave = __builtin_amdgcn_readfirstlane(tid >> 6), fr = lane & 15, fq = lane >> 4;
    const int k = tid & 127, tg = tid >> 7;
    const size_t cq = PW + h * HD + k, cv = PW + 2 * HW + h * HD + k, cl = h * HD + k;
    LAS float* dS = (LAS float*)(lds + L_DS); LAS float* tot = (LAS float*)(lds + L_TOT); LAS float* rmsp = (LAS float*)(lds + L_RMS);
    f32x4 Sacc[8];
#pragma unroll
    for (int i = 0; i < 8; ++i) Sacc[i] = (f32x4){0.f, 0.f, 0.f, 0.f};
    for (int i = tid; i < 128 * CQS / 4; i += 512) ((LAS unsigned*)(lds + L_ST))[i] = 0u;
    float lfr[16]; bf16 sqr[16], vr[16];
    {
        float s = 0.f;
#pragma unroll
        for (int j = 0; j < 16; ++j) { const size_t row = (size_t)(row0 + 16 * tg + j); lfr[j] = lf[row * HW + cl]; sqr[j] = zb[row * INC + cq]; vr[j] = zb[row * INC + cv]; s += lfr[j]; }
        tot[tg * 128 + k] = s;
    }
    __syncthreads();
    for (int c = 0; c < SEQ / 64; ++c) {
        {
            float b = 0.f;
#pragma unroll
            for (int g = 0; g < 3; ++g) b += (g < tg) ? tot[g * 128 + k] : 0.f;
            unsigned ktp[8], vtp[8];
#pragma unroll
            for (int j = 0; j < 16; ++j) {
                b += lfr[j];
                const float f = __expf(lfr[j]), qt = bf2f(sqr[j]) * __expf(b), kt = (1.f - f) * __expf(-b);
                const bf16 qb = f2bf(qt), kb = f2bf(kt);
                const int t = 16 * tg + j;
                *(LAS bf16*)(lds + L_Q + t * CQS + k * 2) = qb;
                *(LAS bf16*)(lds + L_K + t * CQS + k * 2) = kb;
                if (j & 1) { ktp[j >> 1] |= (unsigned)kb << 16; vtp[j >> 1] |= (unsigned)vr[j] << 16; } else { ktp[j >> 1] = kb; vtp[j >> 1] = vr[j]; }
            }
            *(LAS u32x4*)(lds + L_KT + k * CTS + tg * 32) = (u32x4){ktp[0], ktp[1], ktp[2], ktp[3]};
            *(LAS u32x4*)(lds + L_KT + k * CTS + tg * 32 + 16) = (u32x4){ktp[4], ktp[5], ktp[6], ktp[7]};
            *(LAS u32x4*)(lds + L_VT + k * CTS + tg * 32) = (u32x4){vtp[0], vtp[1], vtp[2], vtp[3]};
            *(LAS u32x4*)(lds + L_VT + k * CTS + tg * 32 + 16) = (u32x4){vtp[4], vtp[5], vtp[6], vtp[7]};
            if (tg == 3) dS[k] = __expf(b);
        }
        __syncthreads();
        if (c + 1 < SEQ / 64) {
#pragma unroll
            for (int j = 0; j < 16; ++j) { const size_t row = (size_t)(row0 + 64 * (c + 1) + 16 * tg + j); lfr[j] = lf[row * HW + cl]; sqr[j] = zb[row * INC + cq]; vr[j] = zb[row * INC + cv]; }
        }
#pragma unroll
        for (int i = 0; i < 2; ++i) {
            const int ti = 2 * wave + i, tt = ti >> 2, st = ti & 3;
            f32x4 p = (f32x4){0.f, 0.f, 0.f, 0.f};
#pragma unroll
            for (int ks = 0; ks < 4; ++ks) {
                const bf16x8 ka = *(const LAS bf16x8*)(lds + L_K + (16 * st + fr) * CQS + (32 * ks + 8 * fq) * 2);
                const bf16x8 qb = *(const LAS bf16x8*)(lds + L_Q + (16 * tt + fr) * CQS + (32 * ks + 8 * fq) * 2);
                p = __builtin_amdgcn_mfma_f32_16x16x32_bf16(ka, qb, p, 0, 0, 0);
            }
            const int t = 16 * tt + fr, s0 = 16 * st + 4 * fq;
            u32x2 w; w.x = cvt_pk_bf16(s0 + 0 <= t ? p[0] : 0.f, s0 + 1 <= t ? p[1] : 0.f); w.y = cvt_pk_bf16(s0 + 2 <= t ? p[2] : 0.f, s0 + 3 <= t ? p[3] : 0.f);
            *(LAS u32x2*)(lds + L_P + t * CTS + s0 * 2) = w;
        }
        {
            bf16x8 vb[2];
#pragma unroll
            for (int ss = 0; ss < 2; ++ss) vb[ss] = *(const LAS bf16x8*)(lds + L_VT + (16 * wave + fr) * CTS + (32 * ss + 8 * fq) * 2);
#pragma unroll
            for (int kt = 0; kt < 8; ++kt)
#pragma unroll
                for (int ss = 0; ss < 2; ++ss) {
                    const bf16x8 ka = *(const LAS bf16x8*)(lds + L_KT + (16 * kt + fr) * CTS + (32 * ss + 8 * fq) * 2);
                    Sacc[kt] = __builtin_amdgcn_mfma_f32_16x16x32_bf16(ka, vb[ss], Sacc[kt], 0, 0, 0);
                }
        }
        __syncthreads();
        const int tt = wave & 3, vh = wave >> 2;
        f32x4 o[4];
        {
            bf16x8 pb[2], qb[4];
#pragma unroll
            for (int ss = 0; ss < 2; ++ss) pb[ss] = *(const LAS bf16x8*)(lds + L_P + (16 * tt + fr) * CTS + (32 * ss + 8 * fq) * 2);
#pragma unroll
            for (int ks = 0; ks < 4; ++ks) qb[ks] = *(const LAS bf16x8*)(lds + L_Q + (16 * tt + fr) * CQS + (32 * ks + 8 * fq) * 2);
#pragma unroll
            for (int i = 0; i < 4; ++i) {
                const int vrow = 16 * (4 * vh + i) + fr;
                f32x4 a = (f32x4){0.f, 0.f, 0.f, 0.f};
#pragma unroll
                for (int ss = 0; ss < 2; ++ss) a = __builtin_amdgcn_mfma_f32_16x16x32_bf16(*(const LAS bf16x8*)(lds + L_VT + vrow * CTS + (32 * ss + 8 * fq) * 2), pb[ss], a, 0, 0, 0);
#pragma unroll
                for (int ks = 0; ks < 4; ++ks) a = __builtin_amdgcn_mfma_f32_16x16x32_bf16(*(const LAS bf16x8*)(lds + L_ST + vrow * CQS + (32 * ks + 8 * fq) * 2), qb[ks], a, 0, 0, 0);
                o[i] = a;
            }
            float ss2 = 0.f;
#pragma unroll
            for (int i = 0; i < 4; ++i) ss2 += (o[i][0] * o[i][0] + o[i][1] * o[i][1]) + (o[i][2] * o[i][2] + o[i][3] * o[i][3]);
            ss2 += __shfl_xor(ss2, 16); ss2 += __shfl_xor(ss2, 32);
            if (fq == 0) rmsp[vh * 64 + 16 * tt + fr] = ss2;
        }
#pragma unroll
        for (int kt = 0; kt < 8; ++kt) Sacc[kt] = Sacc[kt] * *(const LAS f32x4*)(dS + 16 * kt + 4 * fq);
        if (c + 1 < SEQ / 64) {
            float s = 0.f;
#pragma unroll
            for (int j = 0; j < 16; ++j) s += lfr[j];
            tot[tg * 128 + k] = s;
        }
        __syncthreads();
        {
            const int tl = 16 * tt + fr; const size_t row = (size_t)(row0 + 64 * c + tl);
            const float r = rsqrtf((rmsp[tl] + rmsp[64 + tl]) * (1.f / HD) + EPS);
#pragma unroll
            for (int i = 0; i < 4; ++i) {
                const int ch = h * HD + 16 * (4 * vh + i) + 4 * fq;
                const f32x4 gn = *(const f32x4*)(hgn + ch);
                const u32x2 sg = *(const u32x2*)(zb + row * INC + PW + 3 * HW + ch);
                const float g0 = __builtin_bit_cast(float, sg.x << 16), g1 = __builtin_bit_cast(float, sg.x & 0xffff0000u), g2 = __builtin_bit_cast(float, sg.y << 16), g3 = __builtin_bit_cast(float, sg.y & 0xffff0000u);
                u32x2 w; w.x = cvt_pk_bf16(o[i][0] * r * gn[0] * g0, o[i][1] * r * gn[1] * g1); w.y = cvt_pk_bf16(o[i][2] * r * gn[2] * g2, o[i][3] * r * gn[3] * g3);
                *(u32x2*)(mixb + row * D + PW + ch) = w;
            }
        }
#pragma unroll
        for (int kt = 0; kt < 8; ++kt) {
            u32x2 w; w.x = cvt_pk_bf16(Sacc[kt][0], Sacc[kt][1]); w.y = cvt_pk_bf16(Sacc[kt][2], Sacc[kt][3]);
            *(LAS u32x2*)(lds + L_ST + (16 * wave + fr) * CQS + (16 * kt + 4 * fq) * 2) = w;
        }
    }
#pragma unroll
    for (int kt = 0; kt < 8; ++kt)
#pragma unroll
        for (int j = 0; j < 4; ++j) Sout[(size_t)(16 * kt + 4 * fq + j) * HD + 16 * wave + fr] = Sacc[kt][j];
    __syncthreads();
}

__device__ __forceinline__ void phase2(LAS unsigned char* lds, const Args& a, int bid, int G) {
    unsigned char* ws = a.ws;
    const bf16* zb = (const bf16*)(ws + WS_ZB); const float* lf = (const float*)(ws + WS_LF); bf16* mixb = (bf16*)(ws + WS_MIX);
    constexpr int NPC = NB * NH, NSC = DB * NH, NPOOL = (M / 64) * 4;
    int first, step;
    if (G >= 2 * NPC) {
        if (bid < NPC) { chain_mfma(lds, zb, lf, a.in[9], a.out + O_HSP + (size_t)bid * HD * HD, mixb, (bid / NH) * SEQ, bid % NH); return; }
        first = bid - NPC; step = G - NPC;
    } else {
        for (int c = bid; c < NPC; c += G) chain_mfma(lds, zb, lf, a.in[9], a.out + O_HSP + (size_t)c * HD * HD, mixb, (c / NH) * SEQ, c % NH);
        first = bid; step = G;
    }
    for (int it = first; it < NSC + NPOOL; it += step) {
        if (it < NSC) { const int b = it / NH, h = it % NH; chain_run(lds, zb, lf, a.in[9], a.in[3] + (size_t)it * HD * HD, a.out + O_HSS + (size_t)it * HD * HD, mixb, MP + b * DS, DS, h); __syncthreads(); }
        else pool_item(lds, it - NSC, zb, a.in[2], (const bf16*)(ws + WS_WP), mixb);
    }
}

__device__ __forceinline__ void phase6(const Args& a, int vcu, int G) {
    const int tid = threadIdx.x, lane = tid & 63, wave = tid >> 6;
    const int gw = vcu * NWAVES + wave, NGW = G * NWAVES;
    const float* rsq3 = (const float*)(a.ws + WS_CTL) + CW_RSQ3;
    for (int m = gw; m < M; m += NGW) {
        float* yr = a.out + O_Y + (size_t)m * D;
        const float r = rsqrtf(rsq3[m] * (1.f / D) + EPS);
#pragma unroll
        for (int j = 0; j < 8; ++j) { const f32x4 v = ((const f32x4*)yr)[lane + 64 * j], g = ((const f32x4*)a.in[15])[lane + 64 * j]; ((f32x4*)yr)[lane + 64 * j] = v * r * g; }
    }
}

__global__ void __launch_bounds__(NWAVES * 64, 2) mega(Args a) {
    extern __shared__ __attribute__((aligned(16))) unsigned char lds_raw[];
    LAS unsigned char* lds = (LAS unsigned char*)lds_raw;
    const int G = gridDim.x, bid = blockIdx.x;
    const int vcu = (G % 8 == 0) ? (bid % 8) * (G / 8) + bid / 8 : bid;
    unsigned char* ws = a.ws;
    float* ctlf = (float*)(ws + WS_CTL);
    const int lo = a.ph_lo, hi = a.ph_hi;
#if ONE_LAUNCH
    cg::grid_group grid = cg::this_grid();
#define GRID_BAR() grid.sync()
#else
#define GRID_BAR() do {} while (0)
#endif
#ifndef PH_MASK
#define PH_MASK 0x7f
#endif
#define IN(k) (((PH_MASK >> (k)) & 1) && lo <= (k) && (k) < hi)
#define BOTH(k) (IN(k) && IN((k) + 1))
    if (IN(0)) { phase0(lds, a, vcu, G); if (BOTH(0)) GRID_BAR(); }
    if (IN(1)) {
        pg8::Gemm g{(const bf16*)(ws + WS_XB), (const bf16*)(ws + WS_WIN), M, INC, D}; pg8::StaticOrder S; S.init(M, INC, G, bid);
        pg8::EpiZ E{(bf16*)(ws + WS_ZB), (float*)(ws + WS_LF), (const float*)(ws + WS_MISC), (const float*)(ws + WS_MISC) + M, a.out};
        pg8::gemm_phase<pg8::EpiZ, pg8::StaticOrder, true, true>(lds, g, S, E);
        if (BOTH(1)) GRID_BAR();
    }
    if (IN(2)) { phase2(lds, a, bid, G); if (BOTH(2)) GRID_BAR(); }
    if (IN(3)) {
        pg8::Gemm g{(const bf16*)(ws + WS_MIX), (const bf16*)(ws + WS_WO), M, D, D}; pg8::StaticOrder S; S.init(M, D, G, bid);
        pg8::EpiX1 E{a.in[0], a.in[1], a.out + O_Y, (bf16*)(ws + WS_XB), ctlf + CW_RSQ2};
        pg8::gemm_phase<pg8::EpiX1, pg8::StaticOrder, true, true>(lds, g, S, E);
        if (BOTH(3)) GRID_BAR();
    }
    if (IN(4)) {
        pg8::Gemm g{(const bf16*)(ws + WS_XB), (const bf16*)(ws + WS_WGU), M, 2 * DFF, D}; pg8::StaticOrder S; S.init(M, 2 * DFF, G, bid);
        pg8::EpiAct E{(bf16*)(ws + WS_ACT), ctlf + CW_RSQ2};
        pg8::gemm_phase<pg8::EpiAct, pg8::StaticOrder, true, true>(lds, g, S, E);
        if (BOTH(4)) GRID_BAR();
    }
    if (IN(5)) {
        pg8::Gemm g{(const bf16*)(ws + WS_ACT), (const bf16*)(ws + WS_WD), M, D, DFF}; pg8::StaticOrder S; S.init(M, D, G, bid);
        pg8::EpiX2 E{a.out + O_Y, ctlf + CW_RSQ3};
        pg8::gemm_phase<pg8::EpiX2, pg8::StaticOrder, true, true>(lds, g, S, E);
        if (BOTH(5)) GRID_BAR();
    }
    if (IN(6)) phase6(a, vcu, G);
#undef IN
#undef BOTH
}

extern "C" void kernel_launch(void* const* d_in, const int* in_sizes, int n_in, void* d_out, int out_size, void* d_ws, size_t ws_size, hipStream_t stream) {
    static int grid = 0;
    if (grid == 0) {
        if (n_in != 16 || ws_size < WS_END) { fprintf(stderr, "kernel_launch: unexpected n_in %d / ws_size %zu\n", n_in, ws_size); grid = -1; return; }
        int dev = 0, cus = 0, per_cu = 0;
        hipGetDevice(&dev);
        hipDeviceGetAttribute(&cus, hipDeviceAttributeMultiprocessorCount, dev);
        hipFuncSetAttribute((const void*)mega, hipFuncAttributeMaxDynamicSharedMemorySize, LDS_BYTES);
        hipOccupancyMaxActiveBlocksPerMultiprocessor(&per_cu, (const void*)mega, NWAVES * 64, LDS_BYTES);
        if (per_cu < 1) { fprintf(stderr, "kernel_launch: occupancy query says %d blocks per CU\n", per_cu); grid = -1; return; }
        grid = cus;
    }
    if (grid < 0) return;
    hipMemsetAsync((char*)d_ws + WS_CTL, 0, CTL_ZERO_BYTES, stream);
    Args a{};
    for (int i = 0; i < 16; ++i) a.in[i] = (const float*)d_in[i];
    a.out = (float*)d_out; a.ws = (unsigned char*)d_ws;
#if ONE_LAUNCH
    a.ph_lo = 0; a.ph_hi = NPHASE;
    void* args[] = {&a};
    hipError_t e = hipLaunchCooperativeKernel((const void*)mega, dim3(grid), dim3(NWAVES * 64), args, LDS_BYTES, stream);
    if (e != hipSuccess) fprintf(stderr, "cooperative launch failed: %s (grid %d)\n", hipGetErrorString(e), grid);
#else
    for (int p = 0; p < NPHASE; ++p) { a.ph_lo = p; a.ph_hi = p + 1; hipLaunchKernelGGL(mega, dim3(grid), dim3(NWAVES * 64), LDS_BYTES, stream, a); }
#endif
}
```

```cpp
#include <hip/hip_runtime.h>
#include <hip/hip_cooperative_groups.h>
#include <cstdio>
#include <cstdint>
namespace cg = cooperative_groups;

constexpr int D = 2048, NB = 4, SEQ = 2048, DB = 128, DS = 8;
constexpr int MP = NB * SEQ, MS = DB * DS, M = MP + MS;
constexpr int PW = 1024, HW = 1024, HD = 128, NH = 8, PC = 15;
constexpr int DFF = 5632, INC = 5120;
constexpr float EPS = 1e-6f;
constexpr size_t O_Y = 0;
constexpr size_t O_PSP = (size_t)M * D;
constexpr size_t O_HSP = O_PSP + (size_t)NB * PC * PW;
constexpr size_t O_PSS = O_HSP + (size_t)NB * NH * HD * HD;
constexpr size_t O_HSS = O_PSS + (size_t)DB * PC * PW;

namespace pg8 {
#define PG8_LAS __attribute__((address_space(3)))
typedef unsigned short bf16_t;
typedef short bf16x8 __attribute__((ext_vector_type(8)));
typedef float f32x4 __attribute__((ext_vector_type(4)));
typedef unsigned u32x4 __attribute__((ext_vector_type(4)));
constexpr int BM = 256, BK = 64, HALF = 128, HTB = HALF * BK * 2  , STAGE_BYTES = 8 * HTB, NXCD = 8, WGM = 8;

__host__ __device__ __forceinline__ int lds_byte(int r, int c) { const int st = (r >> 4) * 2 + (c >> 5), rr = r & 15, cc = c & 31, ob = rr * 64 + cc * 2; return st * 1024 + (ob ^ (((ob >> 9) & 1) << 5)); }
__host__ __device__ __forceinline__ void stage_rc(int b, int& R, int& C) { const int st = b / 1024, sb = b % 1024, swz = sb ^ (((sb >> 9) & 1) << 5); R = (st >> 1) * 16 + swz / 64; C = (st & 1) * 32 + (swz % 64) / 2; }
__host__ __device__ __forceinline__ int perm32(int rho) { const int n = rho >> 4, i = rho & 15; return 8 * (i >> 2) + 4 * n + (i & 3); }

struct Unit { int pm, pn; };
struct Gemm { const bf16_t* A; const bf16_t* Bt; int M, N, K; };

struct StaticOrder {
    int nM, nN, nwg, G, c;
    __host__ __device__ void init(int M, int N, int G_, int c_) { nM = M / BM; nN = N / BM; nwg = nM * nN; G = G_; c = c_; }
    __host__ __device__ bool next(int i, Unit& u) const {
        const long L = (long)i * G + c; if (L >= nwg) return false;
        int wgid = (int)L; { const int q = nwg / NXCD, r = nwg % NXCD, xcd = wgid % NXCD, off = wgid / NXCD; wgid = (xcd < r ? xcd * (q + 1) : r * (q + 1) + (xcd - r) * q) + off; }
        const int nig = WGM * nN, gid = wgid / nig, fm = gid * WGM, gsz = (nM - fm) < WGM ? (nM - fm) : WGM;
        u.pm = fm + ((wgid % nig) % gsz); u.pn = (wgid % nig) / gsz; return true;
    }
    __device__ __forceinline__ void a_ready(const Unit&) const {}
    __device__ __forceinline__ void done(const Unit&) const {}
};
__device__ __forceinline__ unsigned cvt_pk_bf16(float lo, float hi) { unsigned r; asm volatile("v_cvt_pk_bf16_f32 %0, %1, %2" : "=v"(r) : "v"(lo), "v"(hi)); return r; }
__device__ __forceinline__ float sigm(float x) { return __builtin_amdgcn_rcpf(1.f + __expf(-x)); }
__device__ __forceinline__ float silu(float x) { return x * __builtin_amdgcn_rcpf(1.f + __expf(-x)); }
typedef unsigned u32x2 __attribute__((ext_vector_type(2)));

struct EpiZ {
    static constexpr bool PERM = true, AFTER_DRAIN = false;
    bf16_t* zb; float* lf; const float* rstd1; const float* lbv; float* out;
    __device__ __forceinline__ void operator()(const f32x4 (&acc)[2][2][4][2], const Unit& u, int wr, int wc, int fr, int fq) const {
        const int kind = u.pn >> 2;
        const int row0 = u.pm * BM + wr * 64 + fr;
        const int cc0 = (u.pn & 3) * 256 + wc * 32 + 8 * fq;
        f32x4 lb[2][2];
        if (kind == 2) {
#pragma unroll
            for (int bj = 0; bj < 2; ++bj)
#pragma unroll
                for (int n = 0; n < 2; ++n) lb[bj][n] = *(const f32x4*)(lbv + cc0 + bj * HALF + 4 * n);
        }
#pragma unroll
        for (int ai = 0; ai < 2; ++ai)
#pragma unroll
            for (int m = 0; m < 4; ++m) {
                const int row = row0 + ai * HALF + m * 16;
                const float r = rstd1[row];
#pragma unroll
                for (int bj = 0; bj < 2; ++bj) {
                    const int cc = cc0 + bj * HALF;
                    f32x4 v0 = acc[ai][bj][m][0] * r, v1 = acc[ai][bj][m][1] * r;
                    if (kind == 2) {
#pragma unroll
                        for (int j = 0; j < 4; ++j) {
                            v0[j] = __logf(lb[bj][0][j] + (1.f - lb[bj][0][j]) * sigm(v0[j]));
                            v1[j] = __logf(lb[bj][1][j] + (1.f - lb[bj][1][j]) * sigm(v1[j]));
                        }
                        float* p = lf + (size_t)row * HW + cc;
                        *(f32x4*)p = v0; *(f32x4*)(p + 4) = v1;
                    } else {
                        if (kind == 0) {
                            float* dst = nullptr;
                            if (row >= MP) { const int ms = row - MP; dst = out + O_PSS + ((size_t)(ms >> 3) * PC + 7 + (ms & 7)) * PW + cc; }
                            else { const int t = row & (SEQ - 1); if (t >= SEQ - PC) dst = out + O_PSP + ((size_t)(row >> 11) * PC + (t - (SEQ - PC))) * PW + cc; }
                            if (dst) { *(f32x4*)dst = v0; *(f32x4*)(dst + 4) = v1; }
                        }
                        if (kind == 1 || kind == 4) {
#pragma unroll
                            for (int j = 0; j < 4; ++j) { v0[j] = silu(v0[j]); v1[j] = silu(v1[j]); }
                        }
                        u32x4 w; w.x = cvt_pk_bf16(v0[0], v0[1]); w.y = cvt_pk_bf16(v0[2], v0[3]); w.z = cvt_pk_bf16(v1[0], v1[1]); w.w = cvt_pk_bf16(v1[2], v1[3]);
                        *(u32x4*)(zb + (size_t)row * INC + kind * 1024 + cc) = w;
                    }
                }
            }
    }
};

template <bool DRY = false> struct EpiX1 {
    static constexpr bool PERM = false, AFTER_DRAIN = false;
    const float* xp; const float* xs; float* y; bf16_t* x1b; float* rowsq;
    __device__ __forceinline__ void operator()(const f32x4 (&acc)[2][2][4][2], const Unit& u, int wr, int wc, int fr, int fq) const {
        const int row0 = u.pm * BM + wr * 64 + fr, col0 = u.pn * BM + wc * 32 + 4 * fq;
#pragma unroll
        for (int ai = 0; ai < 2; ++ai)
#pragma unroll
            for (int m = 0; m < 4; ++m) {
                const int row = row0 + ai * HALF + m * 16;
                const float* xr = (row < MP ? xp + (size_t)row * D : xs + (size_t)(row - MP) * D) + col0;
                float* yr = y + (size_t)row * D + col0; bf16_t* br = x1b + (size_t)row * D + col0;
                float s = 0.f;
#pragma unroll
                for (int bj = 0; bj < 2; ++bj)
#pragma unroll
                    for (int n = 0; n < 2; ++n) {
                        const f32x4 v = *(const f32x4*)(xr + bj * HALF + n * 16) + acc[ai][bj][m][n];
                        *(f32x4*)(yr + bj * HALF + n * 16) = v;
                        u32x2 w; w.x = cvt_pk_bf16(v[0], v[1]); w.y = cvt_pk_bf16(v[2], v[3]);
                        *(u32x2*)(br + bj * HALF + n * 16) = w;
                        s += (v[0] * v[0] + v[1] * v[1]) + (v[2] * v[2] + v[3] * v[3]);
                    }
                s += __shfl_xor(s, 16); s += __shfl_xor(s, 32);
                if (fq == 0 && !DRY) atomicAdd(rowsq + row, s);
            }
    }
};

struct EpiAct {
    static constexpr bool PERM = true, AFTER_DRAIN = false;
    bf16_t* act; const float* rowsq;
    __device__ __forceinline__ void operator()(const f32x4 (&acc)[2][2][4][2], const Unit& u, int wr, int wc, int fr, int fq) const {
        const int row0 = u.pm * BM + wr * 64 + fr, col0 = u.pn * HALF + wc * 32 + 8 * fq;
#pragma unroll
        for (int ai = 0; ai < 2; ++ai)
#pragma unroll
            for (int m = 0; m < 4; ++m) {
                const int row = row0 + ai * HALF + m * 16;
                const float r = rsqrtf(rowsq[row] * (1.f / D) + EPS);
                u32x4 w; unsigned* wp = (unsigned*)&w;
#pragma unroll
                for (int n = 0; n < 2; ++n) {
                    const f32x4 g = acc[ai][0][m][n] * r, up = acc[ai][1][m][n] * r;
                    f32x4 a;
#pragma unroll
                    for (int j = 0; j < 4; ++j) a[j] = silu(g[j]) * up[j];
                    wp[2 * n] = cvt_pk_bf16(a[0], a[1]); wp[2 * n + 1] = cvt_pk_bf16(a[2], a[3]);
                }
                *(u32x4*)(act + (size_t)row * DFF + col0) = w;
            }
    }
};

template <bool DRY = false> struct EpiX2 {
    static constexpr bool PERM = false, AFTER_DRAIN = false;
    float* y; float* rowsq;
    __device__ __forceinline__ void operator()(const f32x4 (&acc)[2][2][4][2], const Unit& u, int wr, int wc, int fr, int fq) const {
        const int row0 = u.pm * BM + wr * 64 + fr, col0 = u.pn * BM + wc * 32 + 4 * fq;
#pragma unroll
        for (int ai = 0; ai < 2; ++ai)
#pragma unroll
            for (int m = 0; m < 4; ++m) {
                const int row = row0 + ai * HALF + m * 16;
                float* yr = y + (size_t)row * D + col0;
                float s = 0.f;
#pragma unroll
                for (int bj = 0; bj < 2; ++bj)
#pragma unroll
                    for (int n = 0; n < 2; ++n) {
                        const f32x4 v = *(const f32x4*)(yr + bj * HALF + n * 16) + (DRY ? acc[ai][bj][m][n] * 0.f : acc[ai][bj][m][n]);
                        *(f32x4*)(yr + bj * HALF + n * 16) = v;
                        s += (v[0] * v[0] + v[1] * v[1]) + (v[2] * v[2] + v[3] * v[3]);
                    }
                s += __shfl_xor(s, 16); s += __shfl_xor(s, 32);
                if (fq == 0 && !DRY) atomicAdd(rowsq + row, s);
            }
    }
};
template <class Epi, class Sched, bool ALIGN_EPI = false, bool SP2 = false>
__device__ __forceinline__ void gemm_phase(PG8_LAS unsigned char* lds, const Gemm g, const Sched& S, const Epi& E) {
    int tid_ = threadIdx.x; asm volatile("" : "+v"(tid_));
    const int tid = tid_, wid = __builtin_amdgcn_readfirstlane(tid >> 6), lane = tid & 63, wr = wid >> 2, wc = wid & 3, fr = lane & 15, fq = lane >> 4;
    const int K = g.K, nt = K / BK;
    unsigned voffA[2], voffB[2];
#pragma unroll
    for (int i = 0; i < 2; ++i) { int R, C; stage_rc(tid * 16 + i * 8192, R, C); const int Rb = Epi::PERM ? ((R & ~31) + perm32(R & 31)) : R;
        voffA[i] = (unsigned)(R * K + C) * 2u; voffB[i] = (unsigned)(Rb * K + C) * 2u; }
    const size_t kstep = (size_t)(BK * 2);
    const size_t hstep = (size_t)HALF * K * 2;
    const size_t tstep = 2 * hstep;
    const unsigned ldsw = (unsigned)wid * 1024u;
    const int aoff = lds_byte(wr * 64 + fr, fq * 8), boff = lds_byte(wc * 32 + fr, fq * 8);
#define PG8_SA(b, h) (((b) * 2 + (h)) * HTB)
#define PG8_SB(b, h) ((4 + (b) * 2 + (h)) * HTB)
#define PG8_STAGE(bufoff, gbase, voff) do { _Pragma("unroll") for (int _i = 0; _i < 2; ++_i) \
        __builtin_amdgcn_global_load_lds((const unsigned*)((const char*)(gbase) + (voff)[_i]), (PG8_LAS unsigned*)(lds + (bufoff) + ldsw + _i * 8192), 16, 0, 0); } while (0)
#define PG8_LDA(dst, b, h) do { _Pragma("unroll") for (int m = 0; m < 4; ++m) _Pragma("unroll") for (int k = 0; k < 2; ++k) dst[m][k] = *(const PG8_LAS bf16x8*)(lds + PG8_SA(b, h) + aoff + m * 2048 + k * 1024); } while (0)
#define PG8_LDB(dst, b, h) do { _Pragma("unroll") for (int n = 0; n < 2; ++n) _Pragma("unroll") for (int k = 0; k < 2; ++k) dst[n][k] = *(const PG8_LAS bf16x8*)(lds + PG8_SB(b, h) + boff + n * 2048 + k * 1024); } while (0)
#define PG8_MMA(ai, bj, At, Bt) do { __builtin_amdgcn_s_setprio(1); _Pragma("unroll") for (int m = 0; m < 4; ++m) _Pragma("unroll") for (int n = 0; n < 2; ++n) _Pragma("unroll") for (int k = 0; k < 2; ++k) \
        acc[ai][bj][m][n] = __builtin_amdgcn_mfma_f32_16x16x32_bf16(Bt[n][k], At[m][k], acc[ai][bj][m][n], 0, 0, 0); __builtin_amdgcn_s_setprio(0); } while (0)
#define PG8_WAIT_V(n) asm volatile("s_waitcnt vmcnt(" #n ")" ::: "memory")
#define PG8_WAIT_L(n) asm volatile("s_waitcnt lgkmcnt(" #n ")" ::: "memory")
#define PG8_BAR __builtin_amdgcn_s_barrier()
#define PG8_SCHED __builtin_amdgcn_sched_barrier(0)
    Unit cur, nxt; int ui = 0;
    if (!S.next(0, cur)) return;
    f32x4 acc[2][2][4][2];
#pragma unroll
    for (int a = 0; a < 2; ++a)
#pragma unroll
        for (int b = 0; b < 2; ++b)
#pragma unroll
            for (int m = 0; m < 4; ++m)
#pragma unroll
                for (int n = 0; n < 2; ++n) acc[a][b][m][n] = (f32x4){0.f, 0.f, 0.f, 0.f};
    bf16x8 At[4][2], B0[2][2], B1[2][2];
    const char* cA = (const char*)g.A + (size_t)cur.pm * tstep; const char* cB = (const char*)g.Bt + (size_t)cur.pn * tstep;
    S.a_ready(cur);
    if constexpr (SP2) {
        PG8_STAGE(PG8_SB(0, 0), cB, voffB); PG8_STAGE(PG8_SB(0, 1), cB + hstep, voffB); PG8_STAGE(PG8_SA(0, 0), cA, voffA); PG8_STAGE(PG8_SA(0, 1), cA + hstep, voffA);
        if (wr == 1) PG8_BAR;
        PG8_WAIT_V(2); PG8_BAR;
        PG8_STAGE(PG8_SB(1, 0), cB + kstep, voffB); PG8_STAGE(PG8_SA(1, 0), cA + kstep, voffA); PG8_STAGE(PG8_SB(1, 1), cB + hstep + kstep, voffB);
        PG8_WAIT_V(6); PG8_BAR;
    } else {
        PG8_STAGE(PG8_SB(0, 0), cB, voffB); PG8_STAGE(PG8_SA(0, 0), cA, voffA); PG8_STAGE(PG8_SB(0, 1), cB + hstep, voffB); PG8_STAGE(PG8_SA(0, 1), cA + hstep, voffA);
        if (wr == 1) PG8_BAR;
        PG8_WAIT_V(4); PG8_BAR;
        PG8_STAGE(PG8_SB(1, 0), cB + kstep, voffB); PG8_STAGE(PG8_SA(1, 0), cA + kstep, voffA); PG8_STAGE(PG8_SB(1, 1), cB + hstep + kstep, voffB);
        PG8_WAIT_V(6); PG8_BAR;
    }
    for (;;) {
        const bool has_next = S.next(ui + 1, nxt);
        const char* nA = has_next ? (const char*)g.A + (size_t)nxt.pm * tstep : cA; const char* nB = has_next ? (const char*)g.Bt + (size_t)nxt.pn * tstep : cB;
        for (int t = 0; t < nt; t += 2) {
            const bool last = (t == nt - 2);
            const char* a1 = cA + (size_t)(t + 1) * kstep;
            const char* a2 = last ? nA : cA + (size_t)(t + 2) * kstep; const char* b2 = last ? nB : cB + (size_t)(t + 2) * kstep;
            const char* a3 = a2 + kstep; const char* b3 = b2 + kstep;
            if (last && has_next) S.a_ready(nxt);
            if constexpr (SP2) {
            PG8_LDB(B0, 0, 0); PG8_LDB(B1, 0, 1); PG8_SCHED; PG8_LDA(At, 0, 0); PG8_STAGE(PG8_SA(1, 1), a1 + hstep, voffA);
            PG8_WAIT_V(8); PG8_WAIT_L(0); PG8_BAR; PG8_MMA(0, 0, At, B0); PG8_MMA(0, 1, At, B1); PG8_BAR; PG8_SCHED;
            PG8_LDA(At, 0, 1); PG8_STAGE(PG8_SB(0, 0), b2, voffB); PG8_STAGE(PG8_SB(0, 1), b2 + hstep, voffB); PG8_STAGE(PG8_SA(0, 0), a2, voffA);
            PG8_WAIT_V(8); PG8_WAIT_L(0); PG8_BAR; PG8_MMA(1, 0, At, B0); PG8_MMA(1, 1, At, B1); PG8_BAR; PG8_SCHED;
            PG8_LDB(B0, 1, 0); PG8_LDB(B1, 1, 1); PG8_SCHED; PG8_LDA(At, 1, 0); PG8_STAGE(PG8_SA(0, 1), a2 + hstep, voffA);
            PG8_WAIT_V(8); PG8_WAIT_L(0); PG8_BAR; PG8_MMA(0, 0, At, B0); PG8_MMA(0, 1, At, B1); PG8_BAR; PG8_SCHED;
            PG8_LDA(At, 1, 1); PG8_STAGE(PG8_SB(1, 0), b3, voffB); PG8_STAGE(PG8_SB(1, 1), b3 + hstep, voffB); PG8_STAGE(PG8_SA(1, 0), a3, voffA);
            PG8_WAIT_V(8); PG8_WAIT_L(0); PG8_BAR; PG8_MMA(1, 0, At, B0); PG8_MMA(1, 1, At, B1); PG8_BAR; PG8_SCHED;
            } else {
            PG8_LDB(B0, 0, 0); PG8_SCHED; PG8_LDA(At, 0, 0); PG8_STAGE(PG8_SA(1, 1), a1 + hstep, voffA);
            PG8_WAIT_L(8); PG8_BAR; PG8_WAIT_L(0); PG8_MMA(0, 0, At, B0); PG8_BAR; PG8_SCHED;
            PG8_LDB(B1, 0, 1); PG8_STAGE(PG8_SB(0, 0), b2, voffB);
            PG8_BAR; PG8_WAIT_L(0); PG8_MMA(0, 1, At, B1); PG8_BAR;
            PG8_LDA(At, 0, 1); PG8_STAGE(PG8_SA(0, 0), a2, voffA);
            PG8_BAR; PG8_WAIT_L(0); PG8_MMA(1, 0, At, B0); PG8_BAR; PG8_SCHED;
            PG8_STAGE(PG8_SB(0, 1), b2 + hstep, voffB);
            PG8_WAIT_V(6); PG8_BAR; PG8_MMA(1, 1, At, B1); PG8_BAR;
            PG8_LDB(B0, 1, 0); PG8_SCHED; PG8_LDA(At, 1, 0); PG8_STAGE(PG8_SA(0, 1), a2 + hstep, voffA);
            PG8_WAIT_L(8); PG8_BAR; PG8_WAIT_L(0); PG8_MMA(0, 0, At, B0); PG8_BAR; PG8_SCHED;
            PG8_LDB(B1, 1, 1); PG8_STAGE(PG8_SB(1, 0), b3, voffB);
            PG8_BAR; PG8_WAIT_L(0); PG8_MMA(0, 1, At, B1); PG8_BAR;
            PG8_LDA(At, 1, 1); PG8_STAGE(PG8_SA(1, 0), a3, voffA);
            PG8_BAR; PG8_WAIT_L(0); PG8_MMA(1, 0, At, B0); PG8_BAR; PG8_SCHED;
            PG8_STAGE(PG8_SB(1, 1), b3 + hstep, voffB);
            PG8_WAIT_V(6); PG8_BAR; PG8_MMA(1, 1, At, B1); PG8_BAR;
            }
        }
        if constexpr (ALIGN_EPI) { if (wr == 0) PG8_BAR; }
        if constexpr (!Epi::AFTER_DRAIN) { E(acc, cur, wr, wc, fr, fq); S.done(cur); }
        if (!has_next) break;
#pragma unroll
        for (int a = 0; a < 2; ++a)
#pragma unroll
            for (int b = 0; b < 2; ++b)
#pragma unroll
                for (int m = 0; m < 4; ++m)
#pragma unroll
                    for (int n = 0; n < 2; ++n) acc[a][b][m][n] = (f32x4){0.f, 0.f, 0.f, 0.f};
        cur = nxt; cA = nA; cB = nB; ++ui;
        if constexpr (ALIGN_EPI) { if (wr == 1) PG8_BAR; }
    }
    PG8_WAIT_V(0);
    if constexpr (!ALIGN_EPI) { if (wr == 0) PG8_BAR; }
    PG8_BAR;
    if constexpr (Epi::AFTER_DRAIN) { E.fused(acc, cur, wr, wc, fr, fq, lds, wid, lane); S.done(cur); }
#undef PG8_SA
#undef PG8_SB
#undef PG8_STAGE
#undef PG8_LDA
#undef PG8_LDB
#undef PG8_MMA
#undef PG8_WAIT_V
#undef PG8_WAIT_L
#undef PG8_BAR
#undef PG8_SCHED
}
}
#define LAS __attribute__((address_space(3)))
typedef unsigned short bf16;
using pg8::f32x4; using pg8::u32x4; using pg8::u32x2; using pg8::bf16x8; using pg8::cvt_pk_bf16;

#ifndef ONE_LAUNCH
#define ONE_LAUNCH 1
#endif
constexpr int NWAVES = 8, NPHASE = 7;
constexpr int LDS_BYTES = 147456;
constexpr size_t MiB = 1u << 20;
constexpr size_t WS_CTL = 0, CTL_ZERO_BYTES = 1 * MiB;
constexpr size_t WS_WIN = 1 * MiB;
constexpr size_t WS_WO = 21 * MiB;
constexpr size_t WS_WGU = 29 * MiB;
constexpr size_t WS_WD = 73 * MiB;
constexpr size_t WS_WP = 95 * MiB;
constexpr size_t WS_MISC = 96 * MiB;
constexpr size_t WS_XB = 97 * MiB;
constexpr size_t WS_ZB = 133 * MiB;
constexpr size_t WS_LF = 223 * MiB;
constexpr size_t WS_ACT = WS_ZB;
constexpr size_t WS_MIX = 259 * MiB;
constexpr size_t WS_END = 295 * MiB;
constexpr int CW_RSQ2 = 4096, CW_RSQ3 = 4096 + M;
constexpr int CW_BAR = 65536;
constexpr int MISC_OFF = 131072;
#ifndef USE_CG
#define USE_CG 0
#endif

__device__ __forceinline__ float wave_sum(float v) {
#pragma unroll
    for (int o = 1; o < 64; o <<= 1) v += __shfl_xor(v, o);
    return v;
}
__device__ __forceinline__ float bf2f(bf16 b) { return __builtin_bit_cast(float, (unsigned)b << 16); }
__device__ __forceinline__ bf16 f2bf(float f) { unsigned u = __builtin_bit_cast(unsigned, f); return (bf16)((u + 0x7fffu + ((u >> 16) & 1u)) >> 16); }

#define XB_TMO      128
#define XB_XCNT(j)  (256  + 64 * (j))
#define XB_XSUB(j)  (1280 + 64 * (j))
#define XB_XGEN(j)  (2304 + 64 * (j))
#define XB_TOP      3328
#define XB_TOPGEN   3392
#define XCD_BAR_WORDS 3456
#define XB_SPIN_CAP (1u << 18)

__device__ __forceinline__ unsigned xb_ld(unsigned* p)              { return __hip_atomic_load(p, __ATOMIC_RELAXED, __HIP_MEMORY_SCOPE_AGENT); }
__device__ __forceinline__ unsigned xb_add(unsigned* p, unsigned v) { return __hip_atomic_fetch_add(p, v, __ATOMIC_RELAXED, __HIP_MEMORY_SCOPE_AGENT); }
__device__ __forceinline__ unsigned xb_xcc_id() { return (unsigned)__builtin_amdgcn_s_getreg((3 << 11) | 20) & 0xFu; }
#define XB_SPIN(cond, bar) do { unsigned _sp = 0; while (cond) { __builtin_amdgcn_s_sleep(1); \
    if ((++_sp & 255u) == 0u) { if (xb_ld(&(bar)[XB_TMO])) break; if (_sp > XB_SPIN_CAP) { atomicAdd(&(bar)[XB_TMO], 1u); break; } } } } while (0)

struct XcdBarrier {
    unsigned* bar; unsigned x;
    volatile LAS unsigned* st;
};

__device__ __forceinline__ XcdBarrier xcd_barrier_post(unsigned* bar, volatile LAS unsigned* st) {
    XcdBarrier b; b.bar = bar; b.x = xb_xcc_id(); b.st = st;
    if (threadIdx.x == 0) (void)xb_add(&bar[XB_XCNT(b.x)], 1u);
    return b;
}
__device__ __forceinline__ void xcd_barrier_complete(unsigned* bar, unsigned x, unsigned& nloc, unsigned& nx) {
    const unsigned G = gridDim.x * gridDim.y * gridDim.z;
    unsigned sum, cnt, mine, sp = 0u;
    for (;;) {
        sum = 0u; cnt = 0u; mine = 0u;
#pragma unroll
        for (unsigned j = 0; j < 16; ++j) { const unsigned c = xb_ld(&bar[XB_XCNT(j)]); sum += c; cnt += (c > 0u) ? 1u : 0u; mine = (j == x) ? c : mine; }
        if (sum == G) break;
        __builtin_amdgcn_s_sleep(1);
        if ((++sp & 255u) == 0u) { if (xb_ld(&bar[XB_TMO])) break; if (sp > XB_SPIN_CAP) { atomicAdd(&bar[XB_TMO], 1u); break; } }
    }
    nloc = mine > 0u ? mine : 1u; nx = cnt > 0u ? cnt : 1u;
}

__device__ __forceinline__ void xcd_barrier(const XcdBarrier& b) {
    asm volatile("s_waitcnt vmcnt(0)" ::: "memory");
    __syncthreads();
    if (threadIdx.x == 0) {
        unsigned* bar = b.bar;
        __builtin_amdgcn_s_waitcnt(0);
        unsigned nloc = b.st[0], nx = b.st[1];
        if (nloc == 0u) { xcd_barrier_complete(bar, b.x, nloc, nx); b.st[0] = nloc; b.st[1] = nx; }
        const unsigned old = xb_add(&bar[XB_XSUB(b.x)], 1u);
        const unsigned gen = old / nloc;
        if (old + 1u == (gen + 1u) * nloc) {
            __builtin_amdgcn_fence(__ATOMIC_RELEASE, "agent");
            asm volatile("s_waitcnt vmcnt(0)" ::: "memory");
            const unsigned og = xb_add(&bar[XB_TOP], 1u);
            const unsigned tg = og / nx;
            if (og + 1u == (tg + 1u) * nx) xb_add(&bar[XB_TOPGEN], 1u);
            else XB_SPIN(xb_ld(&bar[XB_TOPGEN]) == tg, bar);
            __builtin_amdgcn_fence(__ATOMIC_ACQUIRE, "agent");
            xb_add(&bar[XB_XGEN(b.x)], 1u);
            asm volatile("s_waitcnt vmcnt(0)" ::: "memory");
        } else {
            XB_SPIN(xb_ld(&bar[XB_XGEN(b.x)]) == gen, bar);
            __builtin_amdgcn_fence(__ATOMIC_ACQUIRE, "agent");
            asm volatile("s_waitcnt vmcnt(0)" ::: "memory");
        }
    }
    __syncthreads();
}

struct Args { const float* in[16]; float* out; unsigned char* ws; int ph_lo, ph_hi; };

__device__ __forceinline__ void p0_item(const float* W, int K, int N, bf16* WT, int mode, const float* sk, const float* sn, LAS float* scr, int item, int lane) {
    const int nblk = N / 32, kb = item / nblk, nb = item % nblk, k0 = 64 * kb, n0 = 32 * nb;
    const int drow0 = mode == 0 ? n0 : ((n0 >> 7) * 256 + (n0 & 127) + (mode == 2 ? 128 : 0));
#pragma unroll 8
    for (int i = 0; i < 32; ++i) { const int kk = 2 * i + (lane >> 5); float w = W[(size_t)(k0 + kk) * N + n0 + (lane & 31)]; if (sk) w *= sk[k0 + kk]; scr[kk * 33 + (lane & 31)] = w; }
    asm volatile("s_waitcnt lgkmcnt(0)" ::: "memory");
    const int c = lane & 7;
#pragma unroll
    for (int j = 0; j < 4; ++j) { const int n = (lane >> 3) + 8 * j; const LAS float* s = scr + (8 * c) * 33 + n; const float f = sn ? sn[n0 + n] : 1.f;
        u32x4 o; o.x = cvt_pk_bf16(s[0 * 33] * f, s[1 * 33] * f); o.y = cvt_pk_bf16(s[2 * 33] * f, s[3 * 33] * f); o.z = cvt_pk_bf16(s[4 * 33] * f, s[5 * 33] * f); o.w = cvt_pk_bf16(s[6 * 33] * f, s[7 * 33] * f);
        *(u32x4*)(WT + (size_t)(drow0 + n) * K + k0 + 8 * c) = o; }
    asm volatile("s_waitcnt lgkmcnt(0)" ::: "memory");
}

__device__ __forceinline__ void phase0(LAS unsigned char* lds, const Args& a, int vcu, int G) {
    const int tid = threadIdx.x, lane = tid & 63, wave = tid >> 6;
    unsigned char* ws = a.ws;
    LAS float* scr = (LAS float*)(lds + wave * 16384);
    const int gw = vcu * NWAVES + wave, NGW = G * NWAVES;
    constexpr int I_IN = (D / 64) * (INC / 32), I_O = (D / 64) * (D / 32), I_G = (D / 64) * (DFF / 32), I_D = (DFF / 64) * (D / 32), I_P = (256 / 64) * (256 / 32);
    constexpr int NITEMS = I_IN + I_O + 2 * I_G + I_D + 4 * I_P;
    for (int it = gw; it < NITEMS; it += NGW) {
        int r = it;
        if (r < I_IN) { p0_item(a.in[6], D, INC, (bf16*)(ws + WS_WIN), 0, a.in[5], nullptr, scr, r, lane); continue; } r -= I_IN;
        if (r < I_O) { p0_item(a.in[10], D, D, (bf16*)(ws + WS_WO), 0, nullptr, nullptr, scr, r, lane); continue; } r -= I_O;
        if (r < I_G) { p0_item(a.in[12], D, DFF, (bf16*)(ws + WS_WGU), 1, a.in[11], nullptr, scr, r, lane); continue; } r -= I_G;
        if (r < I_G) { p0_item(a.in[13], D, DFF, (bf16*)(ws + WS_WGU), 2, a.in[11], nullptr, scr, r, lane); continue; } r -= I_G;
        if (r < I_D) { p0_item(a.in[14], DFF, D, (bf16*)(ws + WS_WD), 0, nullptr, nullptr, scr, r, lane); continue; } r -= I_D;
        { const int g = r / I_P; p0_item(a.in[7] + (size_t)g * 65536, 256, 256, (bf16*)(ws + WS_WP) + (size_t)g * 65536, 0, nullptr, a.in[8] + g * 256, scr, r % I_P, lane); }
    }
    float* rstd1 = (float*)(ws + WS_MISC); bf16* xb = (bf16*)(ws + WS_XB);
    for (int m = gw; m < M; m += NGW) {
        const float* xrow = m < MP ? a.in[0] + (size_t)m * D : a.in[1] + (size_t)(m - MP) * D;
        f32x4 v[8]; float s = 0.f;
#pragma unroll
        for (int j = 0; j < 8; ++j) { v[j] = ((const f32x4*)xrow)[lane + 64 * j]; s += (v[j][0] * v[j][0] + v[j][1] * v[j][1]) + (v[j][2] * v[j][2] + v[j][3] * v[j][3]); }
        s = wave_sum(s);
        if (lane == 0) rstd1[m] = rsqrtf(s * (1.f / D) + EPS);
#pragma unroll
        for (int j = 0; j < 8; ++j) { u32x2 w; w.x = cvt_pk_bf16(v[j][0], v[j][1]); w.y = cvt_pk_bf16(v[j][2], v[j][3]); ((u32x2*)(xb + (size_t)m * D))[lane + 64 * j] = w; }
    }
    const int gt = vcu * (NWAVES * 64) + tid, NGT = G * NWAVES * 64;
    float* lbv = (float*)(ws + WS_MISC) + M;
    for (int c = gt; c < HW; c += NGT) lbv[c] = 1.f / (1.f + __expf(a.in[4][HW + c] - a.in[4][c]));
    for (int i = gt; i < DB * 7 * PW; i += NGT) { const int b = i / (7 * PW), rem = i % (7 * PW); a.out[O_PSS + (size_t)b * PC * PW + rem] = a.in[2][(size_t)b * PC * PW + 8 * PW + rem]; }
}

__device__ __forceinline__ void pool_item(LAS unsigned char* lds, int item, const bf16* zb, const float* cache, const bf16* WpT, bf16* mixb) {
    const int tile = item >> 2, g = item & 3, m0 = tile * 64, w = 2 << g;
    const int tid = threadIdx.x, c = tid & 255, rh = tid >> 8;
    constexpr int LDA = 264;
    LAS bf16* A = (LAS bf16*)lds;
    const int col = g * 256 + c;
    const float inv_w = 1.f / (float)w;
    if (m0 < MP) {
        int m = m0 + rh * 32, t = m & (SEQ - 1);
        float s = 0.f;
        for (int j = 0; j < w; ++j) if (t - j >= 0) s += bf2f(zb[(size_t)(m - j) * INC + col]);
        for (int r = 0; r < 32; ++r, ++m, ++t) {
            const float um = bf2f(zb[(size_t)m * INC + col]);
            if (r > 0) s += um - (t - w >= 0 ? bf2f(zb[(size_t)(m - w) * INC + col]) : 0.f);
            const float cnt = (float)min(t + 1, w);
            A[(rh * 32 + r) * LDA + c] = f2bf(s / cnt - um);
        }
    } else {
        for (int r = 0; r < 32; ++r) {
            const int m = m0 + rh * 32 + r, ms = m - MP, b = ms >> 3, t = ms & 7;
            float s = 0.f;
            for (int j = 0; j < w; ++j) { const int tt = t - j; s += tt >= 0 ? bf2f(zb[(size_t)(m - j) * INC + col]) : cache[((size_t)b * PC + PC + tt) * PW + col]; }
            A[(rh * 32 + r) * LDA + c] = f2bf(s * inv_w - bf2f(zb[(size_t)m * INC + col]));
        }
    }
    __syncthreads();
    const int wave = tid >> 6, lane = tid & 63, fr = lane & 15, fq = lane >> 4, n0 = wave * 32;
    f32x4 acc[4][2];
#pragma unroll
    for (int i = 0; i < 4; ++i)
#pragma unroll
        for (int j = 0; j < 2; ++j) acc[i][j] = (f32x4){0.f, 0.f, 0.f, 0.f};
#pragma unroll 2
    for (int ks = 0; ks < 8; ++ks) {
        bf16x8 wf[2], af[4];
#pragma unroll
        for (int nt = 0; nt < 2; ++nt) wf[nt] = *(const bf16x8*)(WpT + (size_t)(g * 256 + n0 + nt * 16 + fr) * 256 + ks * 32 + fq * 8);
#pragma unroll
        for (int mt = 0; mt < 4; ++mt) af[mt] = *(const LAS bf16x8*)(A + (mt * 16 + fr) * LDA + ks * 32 + fq * 8);
#pragma unroll
        for (int mt = 0; mt < 4; ++mt)
#pragma unroll
            for (int nt = 0; nt < 2; ++nt) acc[mt][nt] = __builtin_amdgcn_mfma_f32_16x16x32_bf16(wf[nt], af[mt], acc[mt][nt], 0, 0, 0);
    }
#pragma unroll
    for (int mt = 0; mt < 4; ++mt)
#pragma unroll
        for (int nt = 0; nt < 2; ++nt) {
            u32x2 o; o.x = cvt_pk_bf16(acc[mt][nt][0], acc[mt][nt][1]); o.y = cvt_pk_bf16(acc[mt][nt][2], acc[mt][nt][3]);
            *(u32x2*)(mixb + (size_t)(m0 + mt * 16 + fr) * D + g * 256 + n0 + nt * 16 + 4 * fq) = o;
        }
    __syncthreads();
}

__device__ __forceinline__ void chain_run(LAS unsigned char* lds, const bf16* zb, const float* lf, const float* hgn, const float* S0, float* Sout, bf16* mixb, int row0, int T, int h) {
    const int tid = threadIdx.x, v = tid & 127, kq = tid >> 7, wave = tid >> 6, lane = tid & 63;
    LAS float* sq = (LAS float*)lds; LAS float* sf = sq + 1024; LAS float* sk = sf + 1024; LAS float* sv = sk + 1024; LAS float* red = sv + 1024;
    float S[32];
#pragma unroll
    for (int k = 0; k < 32; ++k) S[k] = S0 ? S0[(size_t)(kq * 32 + k) * HD + v] : 0.f;
    for (int t0 = 0; t0 < T; t0 += 8) {
        for (int i = tid; i < 1024; i += 512) {
            const int t = i >> 7, ch = i & 127; const size_t row = (size_t)(row0 + t0 + t);
            const float f = __expf(lf[row * HW + h * HD + ch]);
            sq[i] = bf2f(zb[row * INC + PW + h * HD + ch]); sf[i] = f; sk[i] = 1.f - f;
        }
        if (tid < 128 * 8 / 2 * 0 + 512) { const int i0 = tid, i1 = tid + 512;
            sv[i0] = bf2f(zb[(size_t)(row0 + t0 + (i0 >> 7)) * INC + PW + 2 * HW + h * HD + (i0 & 127)]);
            sv[i1] = bf2f(zb[(size_t)(row0 + t0 + (i1 >> 7)) * INC + PW + 2 * HW + h * HD + (i1 & 127)]); }
        __syncthreads();
#pragma unroll 1
        for (int t = 0; t < 8; ++t) {
            float o = 0.f; const float vt = sv[t * 128 + v];
            const LAS float* pf = sf + t * 128 + kq * 32; const LAS float* pk = sk + t * 128 + kq * 32; const LAS float* pq = sq + t * 128 + kq * 32;
#pragma unroll
            for (int k = 0; k < 32; ++k) { S[k] = pf[k] * S[k] + pk[k] * vt; o += pq[k] * S[k]; }
            red[(kq * 8 + t) * 128 + v] = o;
        }
        __syncthreads();
        {
            const int t = wave; const size_t row = (size_t)(row0 + t0 + t);
            float o0 = 0.f, o1 = 0.f;
#pragma unroll
            for (int q4 = 0; q4 < 4; ++q4) { o0 += red[(q4 * 8 + t) * 128 + lane]; o1 += red[(q4 * 8 + t) * 128 + lane + 64]; }
            const float ss = wave_sum(o0 * o0 + o1 * o1), r = rsqrtf(ss * (1.f / HD) + EPS);
            const int ch0 = h * HD + lane, ch1 = ch0 + 64;
            mixb[row * D + PW + ch0] = f2bf(o0 * r * hgn[ch0] * bf2f(zb[row * INC + PW + 3 * HW + ch0]));
            mixb[row * D + PW + ch1] = f2bf(o1 * r * hgn[ch1] * bf2f(zb[row * INC + PW + 3 * HW + ch1]));
        }
    }
#pragma unroll
    for (int k = 0; k < 32; ++k) Sout[(size_t)(kq * 32 + k) * HD + v] = S[k];
}


constexpr int CQS = 272, CTS = 144;
constexpr int L_Q = 0, L_K = L_Q + 64 * CQS, L_KT = L_K + 64 * CQS, L_VT = L_KT + 128 * CTS, L_ST = L_VT + 128 * CTS, L_P = L_ST + 128 * CQS,
              L_DS = L_P + 64 * CTS, L_TOT = L_DS + 512, L_RMS = L_TOT + 2048, L_CHAIN_END = L_RMS + 512;
static_assert(L_CHAIN_END <= 131072, "chain LDS");
__device__ __forceinline__ void chain_mfma(LAS unsigned char* lds, const bf16* zb, const float* lf, const float* hgn, float* Sout, bf16* mixb, int row0, int h) {
    const int tid = threadIdx.x, lane = tid & 63, wave = __builtin_amdgcn_readfirstlane(tid >> 6), fr = lane & 15, fq = lane >> 4;
    const int k = tid & 127, tg = tid >> 7;
    const size_t cq = PW + h * HD + k, cv = PW + 2 * HW + h * HD + k, cl = h * HD + k;
    LAS float* dS = (LAS float*)(lds + L_DS); LAS float* tot = (LAS float*)(lds + L_TOT); LAS float* rmsp = (LAS float*)(lds + L_RMS);
    f32x4 Sacc[8];
#pragma unroll
    for (int i = 0; i < 8; ++i) Sacc[i] = (f32x4){0.f, 0.f, 0.f, 0.f};
    for (int i = tid; i < 128 * CQS / 4; i += 512) ((LAS unsigned*)(lds + L_ST))[i] = 0u;
    float lfr[16]; bf16 sqr[16], vr[16];
    {
        float s = 0.f;
#pragma unroll
        for (int j = 0; j < 16; ++j) { const size_t row = (size_t)(row0 + 16 * tg + j); lfr[j] = lf[row * HW + cl]; sqr[j] = zb[row * INC + cq]; vr[j] = zb[row * INC + cv]; s += lfr[j]; }
        tot[tg * 128 + k] = s;
    }
    __syncthreads();
    for (int c = 0; c < SEQ / 64; ++c) {
        {
            float b = 0.f;
#pragma unroll
            for (int g = 0; g < 3; ++g) b += (g < tg) ? tot[g * 128 + k] : 0.f;
            unsigned ktp[8], vtp[8];
#pragma unroll
            for (int j = 0; j < 16; ++j) {
                b += lfr[j];
                const float f = __expf(lfr[j]), qt = bf2f(sqr[j]) * __expf(b), kt = (1.f - f) * __expf(-b);
                const bf16 qb = f2bf(qt), kb = f2bf(kt);
                const int t = 16 * tg + j;
                *(LAS bf16*)(lds + L_Q + t * CQS + k * 2) = qb;
                *(LAS bf16*)(lds + L_K + t * CQS + k * 2) = kb;
                if (j & 1) { ktp[j >> 1] |= (unsigned)kb << 16; vtp[j >> 1] |= (unsigned)vr[j] << 16; } else { ktp[j >> 1] = kb; vtp[j >> 1] = vr[j]; }
            }
            *(LAS u32x4*)(lds + L_KT + k * CTS + tg * 32) = (u32x4){ktp[0], ktp[1], ktp[2], ktp[3]};
            *(LAS u32x4*)(lds + L_KT + k * CTS + tg * 32 + 16) = (u32x4){ktp[4], ktp[5], ktp[6], ktp[7]};
            *(LAS u32x4*)(lds + L_VT + k * CTS + tg * 32) = (u32x4){vtp[0], vtp[1], vtp[2], vtp[3]};
            *(LAS u32x4*)(lds + L_VT + k * CTS + tg * 32 + 16) = (u32x4){vtp[4], vtp[5], vtp[6], vtp[7]};
            if (tg == 3) dS[k] = __expf(b);
        }
        __syncthreads();
        if (c + 1 < SEQ / 64) {
#pragma unroll
            for (int j = 0; j < 16; ++j) { const size_t row = (size_t)(row0 + 64 * (c + 1) + 16 * tg + j); lfr[j] = lf[row * HW + cl]; sqr[j] = zb[row * INC + cq]; vr[j] = zb[row * INC + cv]; }
        }
#pragma unroll
        for (int i = 0; i < 2; ++i) {
            const int ti = 2 * wave + i, tt = ti >> 2, st = ti & 3;
            f32x4 p = (f32x4){0.f, 0.f, 0.f, 0.f};
#pragma unroll
            for (int ks = 0; ks < 4; ++ks) {
                const bf16x8 ka = *(const LAS bf16x8*)(lds + L_K + (16 * st + fr) * CQS + (32 * ks + 8 * fq) * 2);
                const bf16x8 qb = *(const LAS bf16x8*)(lds + L_Q + (16 * tt + fr) * CQS + (32 * ks + 8 * fq) * 2);
                p = __builtin_amdgcn_mfma_f32_16x16x32_bf16(ka, qb, p, 0, 0, 0);
            }
            const int t = 16 * tt + fr, s0 = 16 * st + 4 * fq;
            u32x2 w; w.x = cvt_pk_bf16(s0 + 0 <= t ? p[0] : 0.f, s0 + 1 <= t ? p[1] : 0.f); w.y = cvt_pk_bf16(s0 + 2 <= t ? p[2] : 0.f, s0 + 3 <= t ? p[3] : 0.f);
            *(LAS u32x2*)(lds + L_P + t * CTS + s0 * 2) = w;
        }
        {
            bf16x8 vb[2];
#pragma unroll
            for (int ss = 0; ss < 2; ++ss) vb[ss] = *(const LAS bf16x8*)(lds + L_VT + (16 * wave + fr) * CTS + (32 * ss + 8 * fq) * 2);
#pragma unroll
            for (int kt = 0; kt < 8; ++kt)
#pragma unroll
                for (int ss = 0; ss < 2; ++ss) {
                    const bf16x8 ka = *(const LAS bf16x8*)(lds + L_KT + (16 * kt + fr) * CTS + (32 * ss + 8 * fq) * 2);
                    Sacc[kt] = __builtin_amdgcn_mfma_f32_16x16x32_bf16(ka, vb[ss], Sacc[kt], 0, 0, 0);
                }
        }
        __syncthreads();
        const int tt = wave & 3, vh = wave >> 2;
        f32x4 o[4];
        {
            bf16x8 pb[2], qb[4];
#pragma unroll
            for (int ss = 0; ss < 2; ++ss) pb[ss] = *(const LAS bf16x8*)(lds + L_P + (16 * tt + fr) * CTS + (32 * ss + 8 * fq) * 2);
#pragma unroll
            for (int ks = 0; ks < 4; ++ks) qb[ks] = *(const LAS bf16x8*)(lds + L_Q + (16 * tt + fr) * CQS + (32 * ks + 8 * fq) * 2);
#pragma unroll
            for (int i = 0; i < 4; ++i) {
                const int vrow = 16 * (4 * vh + i) + fr;
                f32x4 a = (f32x4){0.f, 0.f, 0.f, 0.f};
#pragma unroll
                for (int ss = 0; ss < 2; ++ss) a = __builtin_amdgcn_mfma_f32_16x16x32_bf16(*(const LAS bf16x8*)(lds + L_VT + vrow * CTS + (32 * ss + 8 * fq) * 2), pb[ss], a, 0, 0, 0);
#pragma unroll
                for (int ks = 0; ks < 4; ++ks) a = __builtin_amdgcn_mfma_f32_16x16x32_bf16(*(const LAS bf16x8*)(lds + L_ST + vrow * CQS + (32 * ks + 8 * fq) * 2), qb[ks], a, 0, 0, 0);
                o[i] = a;
            }
            float ss2 = 0.f;
#pragma unroll
            for (int i = 0; i < 4; ++i) ss2 += (o[i][0] * o[i][0] + o[i][1] * o[i][1]) + (o[i][2] * o[i][2] + o[i][3] * o[i][3]);
            ss2 += __shfl_xor(ss2, 16); ss2 += __shfl_xor(ss2, 32);
            if (fq == 0) rmsp[vh * 64 + 16 * tt + fr] = ss2;
        }
#pragma unroll
        for (int kt = 0; kt < 8; ++kt) Sacc[kt] = Sacc[kt] * *(const LAS f32x4*)(dS + 16 * kt + 4 * fq);
        if (c + 1 < SEQ / 64) {
            float s = 0.f;
#pragma unroll
            for (int j = 0; j < 16; ++j) s += lfr[j];
            tot[tg * 128 + k] = s;
        }
        __syncthreads();
        {
            const int tl = 16 * tt + fr; const size_t row = (size_t)(row0 + 64 * c + tl);
            const float r = rsqrtf((rmsp[tl] + rmsp[64 + tl]) * (1.f / HD) + EPS);
#pragma unroll
            for (int i = 0; i < 4; ++i) {
                const int ch = h * HD + 16 * (4 * vh + i) + 4 * fq;
                const f32x4 gn = *(const f32x4*)(hgn + ch);
                const u32x2 sg = *(const u32x2*)(zb + row * INC + PW + 3 * HW + ch);
                const float g0 = __builtin_bit_cast(float, sg.x << 16), g1 = __builtin_bit_cast(float, sg.x & 0xffff0000u), g2 = __builtin_bit_cast(float, sg.y << 16), g3 = __builtin_bit_cast(float, sg.y & 0xffff0000u);
                u32x2 w; w.x = cvt_pk_bf16(o[i][0] * r * gn[0] * g0, o[i][1] * r * gn[1] * g1); w.y = cvt_pk_bf16(o[i][2] * r * gn[2] * g2, o[i][3] * r * gn[3] * g3);
                *(u32x2*)(mixb + row * D + PW + ch) = w;
            }
        }
#pragma unroll
        for (int kt = 0; kt < 8; ++kt) {
            u32x2 w; w.x = cvt_pk_bf16(Sacc[kt][0], Sacc[kt][1]); w.y = cvt_pk_bf16(Sacc[kt][2], Sacc[kt][3]);
            *(LAS u32x2*)(lds + L_ST + (16 * wave + fr) * CQS + (16 * kt + 4 * fq) * 2) = w;
        }
    }
#pragma unroll
    for (int kt = 0; kt < 8; ++kt)
#pragma unroll
        for (int j = 0; j < 4; ++j) Sout[(size_t)(16 * kt + 4 * fq + j) * HD + 16 * wave + fr] = Sacc[kt][j];
    __syncthreads();
}

__device__ __forceinline__ void phase2(LAS unsigned char* lds, const Args& a, int bid, int G) {
    unsigned char* ws = a.ws;
    const bf16* zb = (const bf16*)(ws + WS_ZB); const float* lf = (const float*)(ws + WS_LF); bf16* mixb = (bf16*)(ws + WS_MIX);
    constexpr int NPC = NB * NH, NSC = DB * NH, NPOOL = (M / 64) * 4;
    int first, step;
    if (G >= 2 * NPC) {
        if (bid < NPC) { chain_mfma(lds, zb, lf, a.in[9], a.out + O_HSP + (size_t)bid * HD * HD, mixb, (bid / NH) * SEQ, bid % NH); return; }
        first = bid - NPC; step = G - NPC;
    } else {
        for (int c = bid; c < NPC; c += G) chain_mfma(lds, zb, lf, a.in[9], a.out + O_HSP + (size_t)c * HD * HD, mixb, (c / NH) * SEQ, c % NH);
        first = bid; step = G;
    }
    for (int it = first; it < NSC + NPOOL; it += step) {
        if (it < NSC) { const int b = it / NH, h = it % NH; chain_run(lds, zb, lf, a.in[9], a.in[3] + (size_t)it * HD * HD, a.out + O_HSS + (size_t)it * HD * HD, mixb, MP + b * DS, DS, h); __syncthreads(); }
        else pool_item(lds, it - NSC, zb, a.in[2], (const bf16*)(ws + WS_WP), mixb);
    }
}

__device__ __forceinline__ void phase6(const Args& a, int vcu, int G) {
    const int tid = threadIdx.x, lane = tid & 63, wave = tid >> 6;
    const int gw = vcu * NWAVES + wave, NGW = G * NWAVES;
    const float* rsq3 = (const float*)(a.ws + WS_CTL) + CW_RSQ3;
    for (int m = gw; m < M; m += NGW) {
        float* yr = a.out + O_Y + (size_t)m * D;
        const float r = rsqrtf(rsq3[m] * (1.f / D) + EPS);
#pragma unroll
        for (int j = 0; j < 8; ++j) { const f32x4 v = ((const f32x4*)yr)[lane + 64 * j], g = ((const f32x4*)a.in[15])[lane + 64 * j]; ((f32x4*)yr)[lane + 64 * j] = v * r * g; }
    }
}

__global__ void __launch_bounds__(NWAVES * 64, 2) mega(Args a) {
    extern __shared__ __attribute__((aligned(16))) unsigned char lds_raw[];
    LAS unsigned char* lds = (LAS unsigned char*)lds_raw;
    const int G = gridDim.x, bid = blockIdx.x;
    const int vcu = (G % 8 == 0) ? (bid % 8) * (G / 8) + bid / 8 : bid;
    unsigned char* ws = a.ws;
    float* ctlf = (float*)(ws + WS_CTL);
    const int lo = a.ph_lo, hi = a.ph_hi;
#if ONE_LAUNCH && USE_CG
    cg::grid_group grid = cg::this_grid();
#define GRID_BAR() grid.sync()
#elif ONE_LAUNCH
    volatile LAS unsigned* MISC = (volatile LAS unsigned*)(lds + MISC_OFF);
    if (threadIdx.x < 32) MISC[threadIdx.x] = 0u;
    __syncthreads();
    XcdBarrier bar = xcd_barrier_post((unsigned*)(ws + WS_CTL) + CW_BAR, MISC + 8);
#define GRID_BAR() xcd_barrier(bar)
#else
#define GRID_BAR() do {} while (0)
#endif
#ifndef PH_MASK
#define PH_MASK 0x7f
#endif
#define IN(k) (((PH_MASK >> (k)) & 1) && lo <= (k) && (k) < hi)
#define BOTH(k) (IN(k) && IN((k) + 1))
#ifndef REP_MASK
#define REP_MASK 0
#endif
#define REP(k) ((REP_MASK >> (k)) & 1)
    if (IN(0)) { if (REP(0)) { phase0(lds, a, vcu, G); __syncthreads(); } phase0(lds, a, vcu, G); if (BOTH(0)) GRID_BAR(); }
    if (IN(1)) {
        pg8::Gemm g{(const bf16*)(ws + WS_XB), (const bf16*)(ws + WS_WIN), M, INC, D}; pg8::StaticOrder S; S.init(M, INC, G, bid);
        pg8::EpiZ E{(bf16*)(ws + WS_ZB), (float*)(ws + WS_LF), (const float*)(ws + WS_MISC), (const float*)(ws + WS_MISC) + M, a.out};
        if (REP(1)) pg8::gemm_phase<pg8::EpiZ, pg8::StaticOrder, true, true>(lds, g, S, E);
        pg8::gemm_phase<pg8::EpiZ, pg8::StaticOrder, true, true>(lds, g, S, E);
        if (BOTH(1)) GRID_BAR();
    }
    if (IN(2)) { if (REP(2)) { phase2(lds, a, bid, G); __syncthreads(); } phase2(lds, a, bid, G); if (BOTH(2)) GRID_BAR(); }
    if (IN(3)) {
        pg8::Gemm g{(const bf16*)(ws + WS_MIX), (const bf16*)(ws + WS_WO), M, D, D}; pg8::StaticOrder S; S.init(M, D, G, bid);
        if (REP(3)) { pg8::EpiX1<true> E0{a.in[0], a.in[1], a.out + O_Y, (bf16*)(ws + WS_XB), ctlf + CW_RSQ2}; pg8::gemm_phase<pg8::EpiX1<true>, pg8::StaticOrder, true, true>(lds, g, S, E0); }
        pg8::EpiX1<false> E{a.in[0], a.in[1], a.out + O_Y, (bf16*)(ws + WS_XB), ctlf + CW_RSQ2};
        pg8::gemm_phase<pg8::EpiX1<false>, pg8::StaticOrder, true, true>(lds, g, S, E);
        if (BOTH(3)) GRID_BAR();
    }
    if (IN(4)) {
        pg8::Gemm g{(const bf16*)(ws + WS_XB), (const bf16*)(ws + WS_WGU), M, 2 * DFF, D}; pg8::StaticOrder S; S.init(M, 2 * DFF, G, bid);
        pg8::EpiAct E{(bf16*)(ws + WS_ACT), ctlf + CW_RSQ2};
        if (REP(4)) pg8::gemm_phase<pg8::EpiAct, pg8::StaticOrder, true, true>(lds, g, S, E);
        pg8::gemm_phase<pg8::EpiAct, pg8::StaticOrder, true, true>(lds, g, S, E);
        if (BOTH(4)) GRID_BAR();
    }
    if (IN(5)) {
        pg8::Gemm g{(const bf16*)(ws + WS_ACT), (const bf16*)(ws + WS_WD), M, D, DFF}; pg8::StaticOrder S; S.init(M, D, G, bid);
        if (REP(5)) { pg8::EpiX2<true> E0{a.out + O_Y, ctlf + CW_RSQ3}; pg8::gemm_phase<pg8::EpiX2<true>, pg8::StaticOrder, true, true>(lds, g, S, E0); }
        pg8::EpiX2<false> E{a.out + O_Y, ctlf + CW_RSQ3};
        pg8::gemm_phase<pg8::EpiX2<false>, pg8::StaticOrder, true, true>(lds, g, S, E);
        if (BOTH(5)) GRID_BAR();
    }
    if (IN(6)) phase6(a, vcu, G);
#undef IN
#undef BOTH
}

extern "C" void kernel_launch(void* const* d_in, const int* in_sizes, int n_in, void* d_out, int out_size, void* d_ws, size_t ws_size, hipStream_t stream) {
    static int grid = 0;
    if (grid == 0) {
        if (n_in != 16 || ws_size < WS_END) { fprintf(stderr, "kernel_launch: unexpected n_in %d / ws_size %zu\n", n_in, ws_size); grid = -1; return; }
        int dev = 0, cus = 0, per_cu = 0;
        hipGetDevice(&dev);
        hipDeviceGetAttribute(&cus, hipDeviceAttributeMultiprocessorCount, dev);
        hipFuncSetAttribute((const void*)mega, hipFuncAttributeMaxDynamicSharedMemorySize, LDS_BYTES);
        hipOccupancyMaxActiveBlocksPerMultiprocessor(&per_cu, (const void*)mega, NWAVES * 64, LDS_BYTES);
        if (per_cu < 1) { fprintf(stderr, "kernel_launch: occupancy query says %d blocks per CU\n", per_cu); grid = -1; return; }
        grid = cus;
    }
    if (grid < 0) return;
    hipMemsetAsync((char*)d_ws + WS_CTL, 0, CTL_ZERO_BYTES, stream);
    Args a{};
    for (int i = 0; i < 16; ++i) a.in[i] = (const float*)d_in[i];
    a.out = (float*)d_out; a.ws = (unsigned char*)d_ws;
#if ONE_LAUNCH
    a.ph_lo = 0; a.ph_hi = NPHASE;
    void* args[] = {&a};
#if USE_CG
    hipError_t e = hipLaunchCooperativeKernel((const void*)mega, dim3(grid), dim3(NWAVES * 64), args, LDS_BYTES, stream);
    if (e != hipSuccess) fprintf(stderr, "cooperative launch failed: %s (grid %d)\n", hipGetErrorString(e), grid);
#else
    (void)args; hipLaunchKernelGGL(mega, dim3(grid), dim3(NWAVES * 64), LDS_BYTES, stream, a);
#endif
#else
    for (int p = 0; p < NPHASE; ++p) { a.ph_lo = p; a.ph_hi = p + 1; hipLaunchKernelGGL(mega, dim3(grid), dim3(NWAVES * 64), LDS_BYTES, stream, a); }
#endif
}
```

```cpp
#include <hip/hip_runtime.h>
#include <hip/hip_cooperative_groups.h>
#include <cstdio>
#include <cstdint>
namespace cg = cooperative_groups;

constexpr int D = 2048, NB = 4, SEQ = 2048, DB = 128, DS = 8;
constexpr int MP = NB * SEQ, MS = DB * DS, M = MP + MS;
constexpr int PW = 1024, HW = 1024, HD = 128, NH = 8, PC = 15;
constexpr int DFF = 5632, INC = 5120;
constexpr float EPS = 1e-6f;
constexpr size_t O_Y = 0;
constexpr size_t O_PSP = (size_t)M * D;
constexpr size_t O_HSP = O_PSP + (size_t)NB * PC * PW;
constexpr size_t O_PSS = O_HSP + (size_t)NB * NH * HD * HD;
constexpr size_t O_HSS = O_PSS + (size_t)DB * PC * PW;

namespace pg8 {
#define PG8_LAS __attribute__((address_space(3)))
typedef unsigned short bf16_t;
typedef short bf16x8 __attribute__((ext_vector_type(8)));
typedef float f32x4 __attribute__((ext_vector_type(4)));
typedef unsigned u32x4 __attribute__((ext_vector_type(4)));
constexpr int BM = 256, BK = 64, HALF = 128, HTB = HALF * BK * 2  , STAGE_BYTES = 8 * HTB, NXCD = 8, WGM = 8;

__host__ __device__ __forceinline__ int lds_byte(int r, int c) { const int st = (r >> 4) * 2 + (c >> 5), rr = r & 15, cc = c & 31, ob = rr * 64 + cc * 2; return st * 1024 + (ob ^ (((ob >> 9) & 1) << 5)); }
__host__ __device__ __forceinline__ void stage_rc(int b, int& R, int& C) { const int st = b / 1024, sb = b % 1024, swz = sb ^ (((sb >> 9) & 1) << 5); R = (st >> 1) * 16 + swz / 64; C = (st & 1) * 32 + (swz % 64) / 2; }
__host__ __device__ __forceinline__ int perm32(int rho) { const int n = rho >> 4, i = rho & 15; return 8 * (i >> 2) + 4 * n + (i & 3); }

struct Unit { int pm, pn; };
struct Gemm { const bf16_t* A; const bf16_t* Bt; int M, N, K; };

struct StaticOrder {
    int nM, nN, nwg, G, c;
    __host__ __device__ void init(int M, int N, int G_, int c_) { nM = M / BM; nN = N / BM; nwg = nM * nN; G = G_; c = c_; }
    __host__ __device__ bool next(int i, Unit& u) const {
        const long L = (long)i * G + c; if (L >= nwg) return false;
        int wgid = (int)L; { const int q = nwg / NXCD, r = nwg % NXCD, xcd = wgid % NXCD, off = wgid / NXCD; wgid = (xcd < r ? xcd * (q + 1) : r * (q + 1) + (xcd - r) * q) + off; }
        const int nig = WGM * nN, gid = wgid / nig, fm = gid * WGM, gsz = (nM - fm) < WGM ? (nM - fm) : WGM;
        u.pm = fm + ((wgid % nig) % gsz); u.pn = (wgid % nig) / gsz; return true;
    }
    __device__ __forceinline__ void a_ready(const Unit&) const {}
    __device__ __forceinline__ void done(const Unit&) const {}
};
__device__ __forceinline__ unsigned cvt_pk_bf16(float lo, float hi) { unsigned r; asm volatile("v_cvt_pk_bf16_f32 %0, %1, %2" : "=v"(r) : "v"(lo), "v"(hi)); return r; }
__device__ __forceinline__ float sigm(float x) { return __builtin_amdgcn_rcpf(1.f + __expf(-x)); }
__device__ __forceinline__ float silu(float x) { return x * __builtin_amdgcn_rcpf(1.f + __expf(-x)); }
typedef unsigned u32x2 __attribute__((ext_vector_type(2)));

struct EpiZ {
    static constexpr bool PERM = true, AFTER_DRAIN = false;
    bf16_t* zb; float* lf; const float* rstd1; const float* lbv; float* out;
    __device__ __forceinline__ void operator()(const f32x4 (&acc)[2][2][4][2], const Unit& u, int wr, int wc, int fr, int fq) const {
        const int kind = u.pn >> 2;
        const int row0 = u.pm * BM + wr * 64 + fr;
        const int cc0 = (u.pn & 3) * 256 + wc * 32 + 8 * fq;
        f32x4 lb[2][2];
        if (kind == 2) {
#pragma unroll
            for (int bj = 0; bj < 2; ++bj)
#pragma unroll
                for (int n = 0; n < 2; ++n) lb[bj][n] = *(const f32x4*)(lbv + cc0 + bj * HALF + 4 * n);
        }
#pragma unroll
        for (int ai = 0; ai < 2; ++ai)
#pragma unroll
            for (int m = 0; m < 4; ++m) {
                const int row = row0 + ai * HALF + m * 16;
                const float r = rstd1[row];
#pragma unroll
                for (int bj = 0; bj < 2; ++bj) {
                    const int cc = cc0 + bj * HALF;
                    f32x4 v0 = acc[ai][bj][m][0] * r, v1 = acc[ai][bj][m][1] * r;
                    if (kind == 2) {
#pragma unroll
                        for (int j = 0; j < 4; ++j) {
                            v0[j] = __logf(lb[bj][0][j] + (1.f - lb[bj][0][j]) * sigm(v0[j]));
                            v1[j] = __logf(lb[bj][1][j] + (1.f - lb[bj][1][j]) * sigm(v1[j]));
                        }
                        float* p = lf + (size_t)row * HW + cc;
                        *(f32x4*)p = v0; *(f32x4*)(p + 4) = v1;
                    } else {
                        if (kind == 0) {
                            float* dst = nullptr;
                            if (row >= MP) { const int ms = row - MP; dst = out + O_PSS + ((size_t)(ms >> 3) * PC + 7 + (ms & 7)) * PW + cc; }
                            else { const int t = row & (SEQ - 1); if (t >= SEQ - PC) dst = out + O_PSP + ((size_t)(row >> 11) * PC + (t - (SEQ - PC))) * PW + cc; }
                            if (dst) { *(f32x4*)dst = v0; *(f32x4*)(dst + 4) = v1; }
                        }
                        if (kind == 1 || kind == 4) {
#pragma unroll
                            for (int j = 0; j < 4; ++j) { v0[j] = silu(v0[j]); v1[j] = silu(v1[j]); }
                        }
                        u32x4 w; w.x = cvt_pk_bf16(v0[0], v0[1]); w.y = cvt_pk_bf16(v0[2], v0[3]); w.z = cvt_pk_bf16(v1[0], v1[1]); w.w = cvt_pk_bf16(v1[2], v1[3]);
                        *(u32x4*)(zb + (size_t)row * INC + kind * 1024 + cc) = w;
                    }
                }
            }
    }
};

template <bool DRY = false> struct EpiX1 {
    static constexpr bool PERM = false, AFTER_DRAIN = false;
    const float* xp; const float* xs; float* y; bf16_t* x1b; float* rowsq;
    __device__ __forceinline__ void operator()(const f32x4 (&acc)[2][2][4][2], const Unit& u, int wr, int wc, int fr, int fq) const {
        const int row0 = u.pm * BM + wr * 64 + fr, col0 = u.pn * BM + wc * 32 + 4 * fq;
#pragma unroll
        for (int ai = 0; ai < 2; ++ai)
#pragma unroll
            for (int m = 0; m < 4; ++m) {
                const int row = row0 + ai * HALF + m * 16;
                const float* xr = (row < MP ? xp + (size_t)row * D : xs + (size_t)(row - MP) * D) + col0;
                float* yr = y + (size_t)row * D + col0; bf16_t* br = x1b + (size_t)row * D + col0;
                float s = 0.f;
#pragma unroll
                for (int bj = 0; bj < 2; ++bj)
#pragma unroll
                    for (int n = 0; n < 2; ++n) {
                        const f32x4 v = *(const f32x4*)(xr + bj * HALF + n * 16) + acc[ai][bj][m][n];
                        *(f32x4*)(yr + bj * HALF + n * 16) = v;
                        u32x2 w; w.x = cvt_pk_bf16(v[0], v[1]); w.y = cvt_pk_bf16(v[2], v[3]);
                        *(u32x2*)(br + bj * HALF + n * 16) = w;
                        s += (v[0] * v[0] + v[1] * v[1]) + (v[2] * v[2] + v[3] * v[3]);
                    }
                s += __shfl_xor(s, 16); s += __shfl_xor(s, 32);
                if (fq == 0 && !DRY) atomicAdd(rowsq + row, s);
            }
    }
};

struct EpiAct {
    static constexpr bool PERM = true, AFTER_DRAIN = false;
    bf16_t* act; const float* rowsq;
    __device__ __forceinline__ void operator()(const f32x4 (&acc)[2][2][4][2], const Unit& u, int wr, int wc, int fr, int fq) const {
        const int row0 = u.pm * BM + wr * 64 + fr, col0 = u.pn * HALF + wc * 32 + 8 * fq;
#pragma unroll
        for (int ai = 0; ai < 2; ++ai)
#pragma unroll
            for (int m = 0; m < 4; ++m) {
                const int row = row0 + ai * HALF + m * 16;
                const float r = rsqrtf(rowsq[row] * (1.f / D) + EPS);
                u32x4 w; unsigned* wp = (unsigned*)&w;
#pragma unroll
                for (int n = 0; n < 2; ++n) {
                    const f32x4 g = acc[ai][0][m][n] * r, up = acc[ai][1][m][n] * r;
                    f32x4 a;
#pragma unroll
                    for (int j = 0; j < 4; ++j) a[j] = silu(g[j]) * up[j];
                    wp[2 * n] = cvt_pk_bf16(a[0], a[1]); wp[2 * n + 1] = cvt_pk_bf16(a[2], a[3]);
                }
                *(u32x4*)(act + (size_t)row * DFF + col0) = w;
            }
    }
};

template <bool DRY = false> struct EpiX2 {
    static constexpr bool PERM = false, AFTER_DRAIN = false;
    float* y; float* rowsq;
    __device__ __forceinline__ void operator()(const f32x4 (&acc)[2][2][4][2], const Unit& u, int wr, int wc, int fr, int fq) const {
        const int row0 = u.pm * BM + wr * 64 + fr, col0 = u.pn * BM + wc * 32 + 4 * fq;
#pragma unroll
        for (int ai = 0; ai < 2; ++ai)
#pragma unroll
            for (int m = 0; m < 4; ++m) {
                const int row = row0 + ai * HALF + m * 16;
                float* yr = y + (size_t)row * D + col0;
                float s = 0.f;
#pragma unroll
                for (int bj = 0; bj < 2; ++bj)
#pragma unroll
                    for (int n = 0; n < 2; ++n) {
                        const f32x4 v = *(const f32x4*)(yr + bj * HALF + n * 16) + (DRY ? acc[ai][bj][m][n] * 0.f : acc[ai][bj][m][n]);
                        *(f32x4*)(yr + bj * HALF + n * 16) = v;
                        s += (v[0] * v[0] + v[1] * v[1]) + (v[2] * v[2] + v[3] * v[3]);
                    }
                s += __shfl_xor(s, 16); s += __shfl_xor(s, 32);
                if (fq == 0 && !DRY) atomicAdd(rowsq + row, s);
            }
    }
};
template <class Epi, class Sched, bool ALIGN_EPI = false, bool SP2 = false>
__device__ __forceinline__ void gemm_phase(PG8_LAS unsigned char* lds, const Gemm g, const Sched& S, const Epi& E) {
    int tid_ = threadIdx.x; asm volatile("" : "+v"(tid_));
    const int tid = tid_, wid = __builtin_amdgcn_readfirstlane(tid >> 6), lane = tid & 63, wr = wid >> 2, wc = wid & 3, fr = lane & 15, fq = lane >> 4;
    const int K = g.K, nt = K / BK;
    unsigned voffA[2], voffB[2];
#pragma unroll
    for (int i = 0; i < 2; ++i) { int R, C; stage_rc(tid * 16 + i * 8192, R, C); const int Rb = Epi::PERM ? ((R & ~31) + perm32(R & 31)) : R;
        voffA[i] = (unsigned)(R * K + C) * 2u; voffB[i] = (unsigned)(Rb * K + C) * 2u; }
    const size_t kstep = (size_t)(BK * 2);
    const size_t hstep = (size_t)HALF * K * 2;
    const size_t tstep = 2 * hstep;
    const unsigned ldsw = (unsigned)wid * 1024u;
    const int aoff = lds_byte(wr * 64 + fr, fq * 8), boff = lds_byte(wc * 32 + fr, fq * 8);
#define PG8_SA(b, h) (((b) * 2 + (h)) * HTB)
#define PG8_SB(b, h) ((4 + (b) * 2 + (h)) * HTB)
#define PG8_STAGE(bufoff, gbase, voff) do { _Pragma("unroll") for (int _i = 0; _i < 2; ++_i) \
        __builtin_amdgcn_global_load_lds((const unsigned*)((const char*)(gbase) + (voff)[_i]), (PG8_LAS unsigned*)(lds + (bufoff) + ldsw + _i * 8192), 16, 0, 0); } while (0)
#define PG8_LDA(dst, b, h) do { _Pragma("unroll") for (int m = 0; m < 4; ++m) _Pragma("unroll") for (int k = 0; k < 2; ++k) dst[m][k] = *(const PG8_LAS bf16x8*)(lds + PG8_SA(b, h) + aoff + m * 2048 + k * 1024); } while (0)
#define PG8_LDB(dst, b, h) do { _Pragma("unroll") for (int n = 0; n < 2; ++n) _Pragma("unroll") for (int k = 0; k < 2; ++k) dst[n][k] = *(const PG8_LAS bf16x8*)(lds + PG8_SB(b, h) + boff + n * 2048 + k * 1024); } while (0)
#define PG8_MMA(ai, bj, At, Bt) do { __builtin_amdgcn_s_setprio(1); _Pragma("unroll") for (int m = 0; m < 4; ++m) _Pragma("unroll") for (int n = 0; n < 2; ++n) _Pragma("unroll") for (int k = 0; k < 2; ++k) \
        acc[ai][bj][m][n] = __builtin_amdgcn_mfma_f32_16x16x32_bf16(Bt[n][k], At[m][k], acc[ai][bj][m][n], 0, 0, 0); __builtin_amdgcn_s_setprio(0); } while (0)
#define PG8_WAIT_V(n) asm volatile("s_waitcnt vmcnt(" #n ")" ::: "memory")
#define PG8_WAIT_L(n) asm volatile("s_waitcnt lgkmcnt(" #n ")" ::: "memory")
#define PG8_BAR __builtin_amdgcn_s_barrier()
#define PG8_SCHED __builtin_amdgcn_sched_barrier(0)
    Unit cur, nxt; int ui = 0;
    if (!S.next(0, cur)) return;
    f32x4 acc[2][2][4][2];
#pragma unroll
    for (int a = 0; a < 2; ++a)
#pragma unroll
        for (int b = 0; b < 2; ++b)
#pragma unroll
            for (int m = 0; m < 4; ++m)
#pragma unroll
                for (int n = 0; n < 2; ++n) acc[a][b][m][n] = (f32x4){0.f, 0.f, 0.f, 0.f};
    bf16x8 At[4][2], B0[2][2], B1[2][2];
    const char* cA = (const char*)g.A + (size_t)cur.pm * tstep; const char* cB = (const char*)g.Bt + (size_t)cur.pn * tstep;
    S.a_ready(cur);
    if constexpr (SP2) {
        PG8_STAGE(PG8_SB(0, 0), cB, voffB); PG8_STAGE(PG8_SB(0, 1), cB + hstep, voffB); PG8_STAGE(PG8_SA(0, 0), cA, voffA); PG8_STAGE(PG8_SA(0, 1), cA + hstep, voffA);
        if (wr == 1) PG8_BAR;
        PG8_WAIT_V(2); PG8_BAR;
        PG8_STAGE(PG8_SB(1, 0), cB + kstep, voffB); PG8_STAGE(PG8_SA(1, 0), cA + kstep, voffA); PG8_STAGE(PG8_SB(1, 1), cB + hstep + kstep, voffB);
        PG8_WAIT_V(6); PG8_BAR;
    } else {
        PG8_STAGE(PG8_SB(0, 0), cB, voffB); PG8_STAGE(PG8_SA(0, 0), cA, voffA); PG8_STAGE(PG8_SB(0, 1), cB + hstep, voffB); PG8_STAGE(PG8_SA(0, 1), cA + hstep, voffA);
        if (wr == 1) PG8_BAR;
        PG8_WAIT_V(4); PG8_BAR;
        PG8_STAGE(PG8_SB(1, 0), cB + kstep, voffB); PG8_STAGE(PG8_SA(1, 0), cA + kstep, voffA); PG8_STAGE(PG8_SB(1, 1), cB + hstep + kstep, voffB);
        PG8_WAIT_V(6); PG8_BAR;
    }
    for (;;) {
        const bool has_next = S.next(ui + 1, nxt);
        const char* nA = has_next ? (const char*)g.A + (size_t)nxt.pm * tstep : cA; const char* nB = has_next ? (const char*)g.Bt + (size_t)nxt.pn * tstep : cB;
        for (int t = 0; t < nt; t += 2) {
            const bool last = (t == nt - 2);
            const char* a1 = cA + (size_t)(t + 1) * kstep;
            const char* a2 = last ? nA : cA + (size_t)(t + 2) * kstep; const char* b2 = last ? nB : cB + (size_t)(t + 2) * kstep;
            const char* a3 = a2 + kstep; const char* b3 = b2 + kstep;
            if (last && has_next) S.a_ready(nxt);
            if constexpr (SP2) {
            PG8_LDB(B0, 0, 0); PG8_LDB(B1, 0, 1); PG8_SCHED; PG8_LDA(At, 0, 0); PG8_STAGE(PG8_SA(1, 1), a1 + hstep, voffA);
            PG8_WAIT_V(8); PG8_WAIT_L(0); PG8_BAR; PG8_MMA(0, 0, At, B0); PG8_MMA(0, 1, At, B1); PG8_BAR; PG8_SCHED;
            PG8_LDA(At, 0, 1); PG8_STAGE(PG8_SB(0, 0), b2, voffB); PG8_STAGE(PG8_SB(0, 1), b2 + hstep, voffB); PG8_STAGE(PG8_SA(0, 0), a2, voffA);
            PG8_WAIT_V(8); PG8_WAIT_L(0); PG8_BAR; PG8_MMA(1, 0, At, B0); PG8_MMA(1, 1, At, B1); PG8_BAR; PG8_SCHED;
            PG8_LDB(B0, 1, 0); PG8_LDB(B1, 1, 1); PG8_SCHED; PG8_LDA(At, 1, 0); PG8_STAGE(PG8_SA(0, 1), a2 + hstep, voffA);
            PG8_WAIT_V(8); PG8_WAIT_L(0); PG8_BAR; PG8_MMA(0, 0, At, B0); PG8_MMA(0, 1, At, B1); PG8_BAR; PG8_SCHED;
            PG8_LDA(At, 1, 1); PG8_STAGE(PG8_SB(1, 0), b3, voffB); PG8_STAGE(PG8_SB(1, 1), b3 + hstep, voffB); PG8_STAGE(PG8_SA(1, 0), a3, voffA);
            PG8_WAIT_V(8); PG8_WAIT_L(0); PG8_BAR; PG8_MMA(1, 0, At, B0); PG8_MMA(1, 1, At, B1); PG8_BAR; PG8_SCHED;
            } else {
            PG8_LDB(B0, 0, 0); PG8_SCHED; PG8_LDA(At, 0, 0); PG8_STAGE(PG8_SA(1, 1), a1 + hstep, voffA);
            PG8_WAIT_L(8); PG8_BAR; PG8_WAIT_L(0); PG8_MMA(0, 0, At, B0); PG8_BAR; PG8_SCHED;
            PG8_LDB(B1, 0, 1); PG8_STAGE(PG8_SB(0, 0), b2, voffB);
            PG8_BAR; PG8_WAIT_L(0); PG8_MMA(0, 1, At, B1); PG8_BAR;
            PG8_LDA(At, 0, 1); PG8_STAGE(PG8_SA(0, 0), a2, voffA);
            PG8_BAR; PG8_WAIT_L(0); PG8_MMA(1, 0, At, B0); PG8_BAR; PG8_SCHED;
            PG8_STAGE(PG8_SB(0, 1), b2 + hstep, voffB);
            PG8_WAIT_V(6); PG8_BAR; PG8_MMA(1, 1, At, B1); PG8_BAR;
            PG8_LDB(B0, 1, 0); PG8_SCHED; PG8_LDA(At, 1, 0); PG8_STAGE(PG8_SA(0, 1), a2 + hstep, voffA);
            PG8_WAIT_L(8); PG8_BAR; PG8_WAIT_L(0); PG8_MMA(0, 0, At, B0); PG8_BAR; PG8_SCHED;
            PG8_LDB(B1, 1, 1); PG8_STAGE(PG8_SB(1, 0), b3, voffB);
            PG8_BAR; PG8_WAIT_L(0); PG8_MMA(0, 1, At, B1); PG8_BAR;
            PG8_LDA(At, 1, 1); PG8_STAGE(PG8_SA(1, 0), a3, voffA);
            PG8_BAR; PG8_WAIT_L(0); PG8_MMA(1, 0, At, B0); PG8_BAR; PG8_SCHED;
            PG8_STAGE(PG8_SB(1, 1), b3 + hstep, voffB);
            PG8_WAIT_V(6); PG8_BAR; PG8_MMA(1, 1, At, B1); PG8_BAR;
            }
        }
        if constexpr (ALIGN_EPI) { if (wr == 0) PG8_BAR; }
        if constexpr (!Epi::AFTER_DRAIN) { E(acc, cur, wr, wc, fr, fq); S.done(cur); }
        if (!has_next) break;
#pragma unroll
        for (int a = 0; a < 2; ++a)
#pragma unroll
            for (int b = 0; b < 2; ++b)
#pragma unroll
                for (int m = 0; m < 4; ++m)
#pragma unroll
                    for (int n = 0; n < 2; ++n) acc[a][b][m][n] = (f32x4){0.f, 0.f, 0.f, 0.f};
        cur = nxt; cA = nA; cB = nB; ++ui;
        if constexpr (ALIGN_EPI) { if (wr == 1) PG8_BAR; }
    }
    PG8_WAIT_V(0);
    if constexpr (!ALIGN_EPI) { if (wr == 0) PG8_BAR; }
    PG8_BAR;
    if constexpr (Epi::AFTER_DRAIN) { E.fused(acc, cur, wr, wc, fr, fq, lds, wid, lane); S.done(cur); }
#undef PG8_SA
#undef PG8_SB
#undef PG8_STAGE
#undef PG8_LDA
#undef PG8_LDB
#undef PG8_MMA
#undef PG8_WAIT_V
#undef PG8_WAIT_L
#undef PG8_BAR
#undef PG8_SCHED
}
}
#define LAS __attribute__((address_space(3)))
typedef unsigned short bf16;
using pg8::f32x4; using pg8::u32x4; using pg8::u32x2; using pg8::bf16x8; using pg8::cvt_pk_bf16;

#ifndef ONE_LAUNCH
#define ONE_LAUNCH 1
#endif
constexpr int NWAVES = 8, NPHASE = 7;
constexpr int LDS_BYTES = 147456;
constexpr size_t MiB = 1u << 20;
constexpr size_t WS_CTL = 0, CTL_ZERO_BYTES = 1 * MiB;
constexpr size_t WS_WIN = 1 * MiB;
constexpr size_t WS_WO = 21 * MiB;
constexpr size_t WS_WGU = 29 * MiB;
constexpr size_t WS_WD = 73 * MiB;
constexpr size_t WS_WP = 95 * MiB;
constexpr size_t WS_MISC = 96 * MiB;
constexpr size_t WS_XB = 97 * MiB;
constexpr size_t WS_ZB = 133 * MiB;
constexpr size_t WS_LF = 223 * MiB;
constexpr size_t WS_ACT = WS_ZB;
constexpr size_t WS_MIX = 259 * MiB;
constexpr size_t WS_END = 295 * MiB;
constexpr int CW_RSQ2 = 4096, CW_RSQ3 = 4096 + M;
constexpr int CW_BAR = 65536;
constexpr int MISC_OFF = 147456 - 256;
#ifndef USE_CG
#define USE_CG 0
#endif

__device__ __forceinline__ float wave_sum(float v) {
#pragma unroll
    for (int o = 1; o < 64; o <<= 1) v += __shfl_xor(v, o);
    return v;
}
__device__ __forceinline__ float bf2f(bf16 b) { return __builtin_bit_cast(float, (unsigned)b << 16); }
__device__ __forceinline__ bf16 f2bf(float f) { unsigned u = __builtin_bit_cast(unsigned, f); return (bf16)((u + 0x7fffu + ((u >> 16) & 1u)) >> 16); }

#define XB_TMO      128
#define XB_XCNT(j)  (256  + 64 * (j))
#define XB_XSUB(j)  (1280 + 64 * (j))
#define XB_XGEN(j)  (2304 + 64 * (j))
#define XB_TOP      3328
#define XB_TOPGEN   3392
#define XCD_BAR_WORDS 3456
#define XB_SPIN_CAP (1u << 18)

__device__ __forceinline__ unsigned xb_ld(unsigned* p)              { return __hip_atomic_load(p, __ATOMIC_RELAXED, __HIP_MEMORY_SCOPE_AGENT); }
__device__ __forceinline__ unsigned xb_add(unsigned* p, unsigned v) { return __hip_atomic_fetch_add(p, v, __ATOMIC_RELAXED, __HIP_MEMORY_SCOPE_AGENT); }
__device__ __forceinline__ unsigned xb_xcc_id() { return (unsigned)__builtin_amdgcn_s_getreg((3 << 11) | 20) & 0xFu; }
#define XB_SPIN(cond, bar) do { unsigned _sp = 0; while (cond) { __builtin_amdgcn_s_sleep(1); \
    if ((++_sp & 255u) == 0u) { if (xb_ld(&(bar)[XB_TMO])) break; if (_sp > XB_SPIN_CAP) { atomicAdd(&(bar)[XB_TMO], 1u); break; } } } } while (0)

struct XcdBarrier {
    unsigned* bar; unsigned x;
    volatile LAS unsigned* st;
};

__device__ __forceinline__ XcdBarrier xcd_barrier_post(unsigned* bar, volatile LAS unsigned* st) {
    XcdBarrier b; b.bar = bar; b.x = xb_xcc_id(); b.st = st;
    if (threadIdx.x == 0) (void)xb_add(&bar[XB_XCNT(b.x)], 1u);
    return b;
}
__device__ __forceinline__ void xcd_barrier_complete(unsigned* bar, unsigned x, unsigned& nloc, unsigned& nx) {
    const unsigned G = gridDim.x * gridDim.y * gridDim.z;
    unsigned sum, cnt, mine, sp = 0u;
    for (;;) {
        sum = 0u; cnt = 0u; mine = 0u;
#pragma unroll
        for (unsigned j = 0; j < 16; ++j) { const unsigned c = xb_ld(&bar[XB_XCNT(j)]); sum += c; cnt += (c > 0u) ? 1u : 0u; mine = (j == x) ? c : mine; }
        if (sum == G) break;
        __builtin_amdgcn_s_sleep(1);
        if ((++sp & 255u) == 0u) { if (xb_ld(&bar[XB_TMO])) break; if (sp > XB_SPIN_CAP) { atomicAdd(&bar[XB_TMO], 1u); break; } }
    }
    nloc = mine > 0u ? mine : 1u; nx = cnt > 0u ? cnt : 1u;
}

__device__ __forceinline__ void xcd_barrier(const XcdBarrier& b) {
    asm volatile("s_waitcnt vmcnt(0)" ::: "memory");
    __syncthreads();
    if (threadIdx.x == 0) {
        unsigned* bar = b.bar;
        __builtin_amdgcn_s_waitcnt(0);
        unsigned nloc = b.st[0], nx = b.st[1];
        if (nloc == 0u) { xcd_barrier_complete(bar, b.x, nloc, nx); b.st[0] = nloc; b.st[1] = nx; }
        const unsigned old = xb_add(&bar[XB_XSUB(b.x)], 1u);
        const unsigned gen = old / nloc;
        if (old + 1u == (gen + 1u) * nloc) {
            __builtin_amdgcn_fence(__ATOMIC_RELEASE, "agent");
            asm volatile("s_waitcnt vmcnt(0)" ::: "memory");
            const unsigned og = xb_add(&bar[XB_TOP], 1u);
            const unsigned tg = og / nx;
            if (og + 1u == (tg + 1u) * nx) xb_add(&bar[XB_TOPGEN], 1u);
            else XB_SPIN(xb_ld(&bar[XB_TOPGEN]) == tg, bar);
            __builtin_amdgcn_fence(__ATOMIC_ACQUIRE, "agent");
            xb_add(&bar[XB_XGEN(b.x)], 1u);
            asm volatile("s_waitcnt vmcnt(0)" ::: "memory");
        } else {
            XB_SPIN(xb_ld(&bar[XB_XGEN(b.x)]) == gen, bar);
            __builtin_amdgcn_fence(__ATOMIC_ACQUIRE, "agent");
            asm volatile("s_waitcnt vmcnt(0)" ::: "memory");
        }
    }
    __syncthreads();
}

struct Args { const float* in[16]; float* out; unsigned char* ws; int ph_lo, ph_hi; };

__device__ __forceinline__ void p0_item(const float* W, int K, int N, bf16* WT, int mode, const float* sk, const float* sn, LAS float* scr, int item, int lane) {
    const int nblk = N / 64, kb = item / nblk, nb = item % nblk, k0 = 64 * kb, n0 = 64 * nb;
    const int drow0 = mode == 0 ? n0 : ((n0 >> 7) * 256 + (n0 & 127) + (mode == 2 ? 128 : 0));
    const int r = lane >> 4, c4 = lane & 15;
    f32x4 v[16];
#pragma unroll
    for (int i = 0; i < 16; ++i) v[i] = *(const f32x4*)(W + (size_t)(k0 + 4 * i + r) * N + n0 + 4 * c4);
    if (sk) {
#pragma unroll
        for (int i = 0; i < 16; ++i) v[i] = v[i] * sk[k0 + 4 * i + r];
    }
#pragma unroll
    for (int i = 0; i < 16; ++i) { LAS float* d = scr + (4 * i + r) * 65 + 4 * c4; d[0] = v[i][0]; d[1] = v[i][1]; d[2] = v[i][2]; d[3] = v[i][3]; }
    asm volatile("s_waitcnt lgkmcnt(0)" ::: "memory");
    const int c = lane & 7, nn = lane >> 3;
#pragma unroll
    for (int j = 0; j < 8; ++j) { const int n = nn + 8 * j; const LAS float* s = scr + (8 * c) * 65 + n; const float f = sn ? sn[n0 + n] : 1.f;
        u32x4 o; o.x = cvt_pk_bf16(s[0 * 65] * f, s[1 * 65] * f); o.y = cvt_pk_bf16(s[2 * 65] * f, s[3 * 65] * f); o.z = cvt_pk_bf16(s[4 * 65] * f, s[5 * 65] * f); o.w = cvt_pk_bf16(s[6 * 65] * f, s[7 * 65] * f);
        *(u32x4*)(WT + (size_t)(drow0 + n) * K + k0 + 8 * c) = o; }
    asm volatile("s_waitcnt lgkmcnt(0)" ::: "memory");
}

__device__ __forceinline__ void phase0(LAS unsigned char* lds, const Args& a, int vcu, int G) {
    const int tid = threadIdx.x, lane = tid & 63, wave = tid >> 6;
    unsigned char* ws = a.ws;
    LAS float* scr = (LAS float*)(lds + wave * 16640);
    const int gw = vcu * NWAVES + wave, NGW = G * NWAVES;
    constexpr int I_IN = (D / 64) * (INC / 64), I_O = (D / 64) * (D / 64), I_G = (D / 64) * (DFF / 64), I_D = (DFF / 64) * (D / 64), I_P = (256 / 64) * (256 / 64);
    constexpr int NITEMS = I_IN + I_O + 2 * I_G + I_D + 4 * I_P;
    for (int it = gw; it < NITEMS; it += NGW) {
        int r = it;
        if (r < I_IN) { p0_item(a.in[6], D, INC, (bf16*)(ws + WS_WIN), 0, a.in[5], nullptr, scr, r, lane); continue; } r -= I_IN;
        if (r < I_O) { p0_item(a.in[10], D, D, (bf16*)(ws + WS_WO), 0, nullptr, nullptr, scr, r, lane); continue; } r -= I_O;
        if (r < I_G) { p0_item(a.in[12], D, DFF, (bf16*)(ws + WS_WGU), 1, a.in[11], nullptr, scr, r, lane); continue; } r -= I_G;
        if (r < I_G) { p0_item(a.in[13], D, DFF, (bf16*)(ws + WS_WGU), 2, a.in[11], nullptr, scr, r, lane); continue; } r -= I_G;
        if (r < I_D) { p0_item(a.in[14], DFF, D, (bf16*)(ws + WS_WD), 0, nullptr, nullptr, scr, r, lane); continue; } r -= I_D;
        { const int g = r / I_P; p0_item(a.in[7] + (size_t)g * 65536, 256, 256, (bf16*)(ws + WS_WP) + (size_t)g * 65536, 0, nullptr, a.in[8] + g * 256, scr, r % I_P, lane); }
    }
    float* rstd1 = (float*)(ws + WS_MISC); bf16* xb = (bf16*)(ws + WS_XB);
    for (int m = gw; m < M; m += NGW) {
        const float* xrow = m < MP ? a.in[0] + (size_t)m * D : a.in[1] + (size_t)(m - MP) * D;
        f32x4 v[8]; float s = 0.f;
#pragma unroll
        for (int j = 0; j < 8; ++j) { v[j] = ((const f32x4*)xrow)[lane + 64 * j]; s += (v[j][0] * v[j][0] + v[j][1] * v[j][1]) + (v[j][2] * v[j][2] + v[j][3] * v[j][3]); }
        s = wave_sum(s);
        if (lane == 0) rstd1[m] = rsqrtf(s * (1.f / D) + EPS);
#pragma unroll
        for (int j = 0; j < 8; ++j) { u32x2 w; w.x = cvt_pk_bf16(v[j][0], v[j][1]); w.y = cvt_pk_bf16(v[j][2], v[j][3]); ((u32x2*)(xb + (size_t)m * D))[lane + 64 * j] = w; }
    }
    const int gt = vcu * (NWAVES * 64) + tid, NGT = G * NWAVES * 64;
    float* lbv = (float*)(ws + WS_MISC) + M;
    for (int c = gt; c < HW; c += NGT) lbv[c] = 1.f / (1.f + __expf(a.in[4][HW + c] - a.in[4][c]));
    for (int i = gt; i < DB * 7 * PW; i += NGT) { const int b = i / (7 * PW), rem = i % (7 * PW); a.out[O_PSS + (size_t)b * PC * PW + rem] = a.in[2][(size_t)b * PC * PW + 8 * PW + rem]; }
}

__device__ __forceinline__ void pool_item(LAS unsigned char* lds, int item, const bf16* zb, const float* cache, const bf16* WpT, bf16* mixb) {
    const int tile = item >> 2, g = item & 3, m0 = tile * 64, w = 2 << g;
    const int tid = threadIdx.x, c = tid & 255, rh = tid >> 8;
    constexpr int LDA = 264;
    LAS bf16* A = (LAS bf16*)lds;
    const int col = g * 256 + c;
    const float inv_w = 1.f / (float)w;
    if (m0 < MP) {
        int m = m0 + rh * 32, t = m & (SEQ - 1);
        float s = 0.f;
        for (int j = 0; j < w; ++j) if (t - j >= 0) s += bf2f(zb[(size_t)(m - j) * INC + col]);
        for (int r = 0; r < 32; ++r, ++m, ++t) {
            const float um = bf2f(zb[(size_t)m * INC + col]);
            if (r > 0) s += um - (t - w >= 0 ? bf2f(zb[(size_t)(m - w) * INC + col]) : 0.f);
            const float cnt = (float)min(t + 1, w);
            A[(rh * 32 + r) * LDA + c] = f2bf(s / cnt - um);
        }
    } else {
        for (int r = 0; r < 32; ++r) {
            const int m = m0 + rh * 32 + r, ms = m - MP, b = ms >> 3, t = ms & 7;
            float s = 0.f;
            for (int j = 0; j < w; ++j) { const int tt = t - j; s += tt >= 0 ? bf2f(zb[(size_t)(m - j) * INC + col]) : cache[((size_t)b * PC + PC + tt) * PW + col]; }
            A[(rh * 32 + r) * LDA + c] = f2bf(s * inv_w - bf2f(zb[(size_t)m * INC + col]));
        }
    }
    __syncthreads();
    const int wave = tid >> 6, lane = tid & 63, fr = lane & 15, fq = lane >> 4, n0 = wave * 32;
    f32x4 acc[4][2];
#pragma unroll
    for (int i = 0; i < 4; ++i)
#pragma unroll
        for (int j = 0; j < 2; ++j) acc[i][j] = (f32x4){0.f, 0.f, 0.f, 0.f};
#pragma unroll 2
    for (int ks = 0; ks < 8; ++ks) {
        bf16x8 wf[2], af[4];
#pragma unroll
        for (int nt = 0; nt < 2; ++nt) wf[nt] = *(const bf16x8*)(WpT + (size_t)(g * 256 + n0 + nt * 16 + fr) * 256 + ks * 32 + fq * 8);
#pragma unroll
        for (int mt = 0; mt < 4; ++mt) af[mt] = *(const LAS bf16x8*)(A + (mt * 16 + fr) * LDA + ks * 32 + fq * 8);
#pragma unroll
        for (int mt = 0; mt < 4; ++mt)
#pragma unroll
            for (int nt = 0; nt < 2; ++nt) acc[mt][nt] = __builtin_amdgcn_mfma_f32_16x16x32_bf16(wf[nt], af[mt], acc[mt][nt], 0, 0, 0);
    }
#pragma unroll
    for (int mt = 0; mt < 4; ++mt)
#pragma unroll
        for (int nt = 0; nt < 2; ++nt) {
            u32x2 o; o.x = cvt_pk_bf16(acc[mt][nt][0], acc[mt][nt][1]); o.y = cvt_pk_bf16(acc[mt][nt][2], acc[mt][nt][3]);
            *(u32x2*)(mixb + (size_t)(m0 + mt * 16 + fr) * D + g * 256 + n0 + nt * 16 + 4 * fq) = o;
        }
    __syncthreads();
}

__device__ __forceinline__ void chain_run(LAS unsigned char* lds, const bf16* zb, const float* lf, const float* hgn, const float* S0, float* Sout, bf16* mixb, int row0, int T, int h) {
    const int tid = threadIdx.x, v = tid & 127, kq = tid >> 7, wave = tid >> 6, lane = tid & 63;
    LAS float* sq = (LAS float*)lds; LAS float* sf = sq + 1024; LAS float* sk = sf + 1024; LAS float* sv = sk + 1024; LAS float* red = sv + 1024;
    float S[32];
#pragma unroll
    for (int k = 0; k < 32; ++k) S[k] = S0 ? S0[(size_t)(kq * 32 + k) * HD + v] : 0.f;
    for (int t0 = 0; t0 < T; t0 += 8) {
        for (int i = tid; i < 1024; i += 512) {
            const int t = i >> 7, ch = i & 127; const size_t row = (size_t)(row0 + t0 + t);
            const float f = __expf(lf[row * HW + h * HD + ch]);
            sq[i] = bf2f(zb[row * INC + PW + h * HD + ch]); sf[i] = f; sk[i] = 1.f - f;
        }
        if (tid < 128 * 8 / 2 * 0 + 512) { const int i0 = tid, i1 = tid + 512;
            sv[i0] = bf2f(zb[(size_t)(row0 + t0 + (i0 >> 7)) * INC + PW + 2 * HW + h * HD + (i0 & 127)]);
            sv[i1] = bf2f(zb[(size_t)(row0 + t0 + (i1 >> 7)) * INC + PW + 2 * HW + h * HD + (i1 & 127)]); }
        __syncthreads();
#pragma unroll 1
        for (int t = 0; t < 8; ++t) {
            float o = 0.f; const float vt = sv[t * 128 + v];
            const LAS float* pf = sf + t * 128 + kq * 32; const LAS float* pk = sk + t * 128 + kq * 32; const LAS float* pq = sq + t * 128 + kq * 32;
#pragma unroll
            for (int k = 0; k < 32; ++k) { S[k] = pf[k] * S[k] + pk[k] * vt; o += pq[k] * S[k]; }
            red[(kq * 8 + t) * 128 + v] = o;
        }
        __syncthreads();
        {
            const int t = wave; const size_t row = (size_t)(row0 + t0 + t);
            float o0 = 0.f, o1 = 0.f;
#pragma unroll
            for (int q4 = 0; q4 < 4; ++q4) { o0 += red[(q4 * 8 + t) * 128 + lane]; o1 += red[(q4 * 8 + t) * 128 + lane + 64]; }
            const float ss = wave_sum(o0 * o0 + o1 * o1), r = rsqrtf(ss * (1.f / HD) + EPS);
            const int ch0 = h * HD + lane, ch1 = ch0 + 64;
            mixb[row * D + PW + ch0] = f2bf(o0 * r * hgn[ch0] * bf2f(zb[row * INC + PW + 3 * HW + ch0]));
            mixb[row * D + PW + ch1] = f2bf(o1 * r * hgn[ch1] * bf2f(zb[row * INC + PW + 3 * HW + ch1]));
        }
    }
#pragma unroll
    for (int k = 0; k < 32; ++k) Sout[(size_t)(kq * 32 + k) * HD + v] = S[k];
}


constexpr int CQS = 272, CTS = 144;
constexpr int L_Q = 0, L_K = L_Q + 64 * CQS, L_KT = L_K + 64 * CQS, L_VT = L_KT + 128 * CTS, L_ST = L_VT + 128 * CTS, L_P = L_ST + 128 * CQS,
              L_DS = L_P + 64 * CTS, L_TOT = L_DS + 512, L_RMS = L_TOT + 2048, L_CHAIN_END = L_RMS + 512;
static_assert(L_CHAIN_END <= 131072, "chain LDS");
__device__ __forceinline__ void chain_mfma(LAS unsigned char* lds, const bf16* zb, const float* lf, const float* hgn, float* Sout, bf16* mixb, int row0, int h) {
    const int tid = threadIdx.x, lane = tid & 63, wave = __builtin_amdgcn_readfirstlane(tid >> 6), fr = lane & 15, fq = lane >> 4;
    const int k = tid & 127, tg = tid >> 7;
    const size_t cq = PW + h * HD + k, cv = PW + 2 * HW + h * HD + k, cl = h * HD + k;
    LAS float* dS = (LAS float*)(lds + L_DS); LAS float* tot = (LAS float*)(lds + L_TOT); LAS float* rmsp = (LAS float*)(lds + L_RMS);
    f32x4 Sacc[8];
#pragma unroll
    for (int i = 0; i < 8; ++i) Sacc[i] = (f32x4){0.f, 0.f, 0.f, 0.f};
    for (int i = tid; i < 128 * CQS / 4; i += 512) ((LAS unsigned*)(lds + L_ST))[i] = 0u;
    float lfr[16]; bf16 sqr[16], vr[16];
    {
        float s = 0.f;
#pragma unroll
        for (int j = 0; j < 16; ++j) { const size_t row = (size_t)(row0 + 16 * tg + j); lfr[j] = lf[row * HW + cl]; sqr[j] = zb[row * INC + cq]; vr[j] = zb[row * INC + cv]; s += lfr[j]; }
        tot[tg * 128 + k] = s;
    }
    __syncthreads();
    f32x4 gnr[4];
#pragma unroll
    for (int i = 0; i < 4; ++i) gnr[i] = *(const f32x4*)(hgn + h * HD + 16 * (4 * (wave >> 2) + i) + 4 * fq);
    for (int c = 0; c < SEQ / 64; ++c) {
        {
            float b = 0.f;
#pragma unroll
            for (int g = 0; g < 3; ++g) b += (g < tg) ? tot[g * 128 + k] : 0.f;
            unsigned ktp[8], vtp[8];
#pragma unroll
            for (int j = 0; j < 16; ++j) {
                b += lfr[j];
                const float f = __expf(lfr[j]), qt = bf2f(sqr[j]) * __expf(b), kt = (1.f - f) * __expf(-b);
                const bf16 qb = f2bf(qt), kb = f2bf(kt);
                const int t = 16 * tg + j;
                *(LAS bf16*)(lds + L_Q + t * CQS + k * 2) = qb;
                *(LAS bf16*)(lds + L_K + t * CQS + k * 2) = kb;
                if (j & 1) { ktp[j >> 1] |= (unsigned)kb << 16; vtp[j >> 1] |= (unsigned)vr[j] << 16; } else { ktp[j >> 1] = kb; vtp[j >> 1] = vr[j]; }
            }
            *(LAS u32x4*)(lds + L_KT + k * CTS + tg * 32) = (u32x4){ktp[0], ktp[1], ktp[2], ktp[3]};
            *(LAS u32x4*)(lds + L_KT + k * CTS + tg * 32 + 16) = (u32x4){ktp[4], ktp[5], ktp[6], ktp[7]};
            *(LAS u32x4*)(lds + L_VT + k * CTS + tg * 32) = (u32x4){vtp[0], vtp[1], vtp[2], vtp[3]};
            *(LAS u32x4*)(lds + L_VT + k * CTS + tg * 32 + 16) = (u32x4){vtp[4], vtp[5], vtp[6], vtp[7]};
            if (tg == 3) dS[k] = __expf(b);
        }
        __syncthreads();
        u32x2 sgr[4];
#pragma unroll
        for (int i = 0; i < 4; ++i) sgr[i] = *(const u32x2*)(zb + (size_t)(row0 + 64 * c + 16 * (wave & 3) + fr) * INC + PW + 3 * HW + h * HD + 16 * (4 * (wave >> 2) + i) + 4 * fq);
        if (c + 1 < SEQ / 64) {
#pragma unroll
            for (int j = 0; j < 16; ++j) { const size_t row = (size_t)(row0 + 64 * (c + 1) + 16 * tg + j); lfr[j] = lf[row * HW + cl]; sqr[j] = zb[row * INC + cq]; vr[j] = zb[row * INC + cv]; }
        }
#pragma unroll
        for (int i = 0; i < 2; ++i) {
            const int ti = 2 * wave + i, tt = ti >> 2, st = ti & 3;
            f32x4 p = (f32x4){0.f, 0.f, 0.f, 0.f};
#pragma unroll
            for (int ks = 0; ks < 4; ++ks) {
                const bf16x8 ka = *(const LAS bf16x8*)(lds + L_K + (16 * st + fr) * CQS + (32 * ks + 8 * fq) * 2);
                const bf16x8 qb = *(const LAS bf16x8*)(lds + L_Q + (16 * tt + fr) * CQS + (32 * ks + 8 * fq) * 2);
                p = __builtin_amdgcn_mfma_f32_16x16x32_bf16(ka, qb, p, 0, 0, 0);
            }
            const int t = 16 * tt + fr, s0 = 16 * st + 4 * fq;
            u32x2 w; w.x = cvt_pk_bf16(s0 + 0 <= t ? p[0] : 0.f, s0 + 1 <= t ? p[1] : 0.f); w.y = cvt_pk_bf16(s0 + 2 <= t ? p[2] : 0.f, s0 + 3 <= t ? p[3] : 0.f);
            *(LAS u32x2*)(lds + L_P + t * CTS + s0 * 2) = w;
        }
        {
            bf16x8 vb[2];
#pragma unroll
            for (int ss = 0; ss < 2; ++ss) vb[ss] = *(const LAS bf16x8*)(lds + L_VT + (16 * wave + fr) * CTS + (32 * ss + 8 * fq) * 2);
#pragma unroll
            for (int kt = 0; kt < 8; ++kt)
#pragma unroll
                for (int ss = 0; ss < 2; ++ss) {
                    const bf16x8 ka = *(const LAS bf16x8*)(lds + L_KT + (16 * kt + fr) * CTS + (32 * ss + 8 * fq) * 2);
                    Sacc[kt] = __builtin_amdgcn_mfma_f32_16x16x32_bf16(ka, vb[ss], Sacc[kt], 0, 0, 0);
                }
        }
        __syncthreads();
        const int tt = wave & 3, vh = wave >> 2;
        f32x4 o[4];
        {
            bf16x8 pb[2], qb[4];
#pragma unroll
            for (int ss = 0; ss < 2; ++ss) pb[ss] = *(const LAS bf16x8*)(lds + L_P + (16 * tt + fr) * CTS + (32 * ss + 8 * fq) * 2);
#pragma unroll
            for (int ks = 0; ks < 4; ++ks) qb[ks] = *(const LAS bf16x8*)(lds + L_Q + (16 * tt + fr) * CQS + (32 * ks + 8 * fq) * 2);
#pragma unroll
            for (int i = 0; i < 4; ++i) {
                const int vrow = 16 * (4 * vh + i) + fr;
                f32x4 a = (f32x4){0.f, 0.f, 0.f, 0.f};
#pragma unroll
                for (int ss = 0; ss < 2; ++ss) a = __builtin_amdgcn_mfma_f32_16x16x32_bf16(*(const LAS bf16x8*)(lds + L_VT + vrow * CTS + (32 * ss + 8 * fq) * 2), pb[ss], a, 0, 0, 0);
#pragma unroll
                for (int ks = 0; ks < 4; ++ks) a = __builtin_amdgcn_mfma_f32_16x16x32_bf16(*(const LAS bf16x8*)(lds + L_ST + vrow * CQS + (32 * ks + 8 * fq) * 2), qb[ks], a, 0, 0, 0);
                o[i] = a;
            }
            float ss2 = 0.f;
#pragma unroll
            for (int i = 0; i < 4; ++i) ss2 += (o[i][0] * o[i][0] + o[i][1] * o[i][1]) + (o[i][2] * o[i][2] + o[i][3] * o[i][3]);
            ss2 += __shfl_xor(ss2, 16); ss2 += __shfl_xor(ss2, 32);
            if (fq == 0) rmsp[vh * 64 + 16 * tt + fr] = ss2;
        }
#pragma unroll
        for (int kt = 0; kt < 8; ++kt) Sacc[kt] = Sacc[kt] * *(const LAS f32x4*)(dS + 16 * kt + 4 * fq);
        if (c + 1 < SEQ / 64) {
            float s = 0.f;
#pragma unroll
            for (int j = 0; j < 16; ++j) s += lfr[j];
            tot[tg * 128 + k] = s;
        }
        __syncthreads();
        {
            const int tl = 16 * tt + fr; const size_t row = (size_t)(row0 + 64 * c + tl);
            const float r = rsqrtf((rmsp[tl] + rmsp[64 + tl]) * (1.f / HD) + EPS);
#pragma unroll
            for (int i = 0; i < 4; ++i) {
                const int ch = h * HD + 16 * (4 * vh + i) + 4 * fq;
                const f32x4 gn = gnr[i];
                const u32x2 sg = sgr[i];
                const float g0 = __builtin_bit_cast(float, sg.x << 16), g1 = __builtin_bit_cast(float, sg.x & 0xffff0000u), g2 = __builtin_bit_cast(float, sg.y << 16), g3 = __builtin_bit_cast(float, sg.y & 0xffff0000u);
                u32x2 w; w.x = cvt_pk_bf16(o[i][0] * r * gn[0] * g0, o[i][1] * r * gn[1] * g1); w.y = cvt_pk_bf16(o[i][2] * r * gn[2] * g2, o[i][3] * r * gn[3] * g3);
                *(u32x2*)(mixb + row * D + PW + ch) = w;
            }
        }
#pragma unroll
        for (int kt = 0; kt < 8; ++kt) {
            u32x2 w; w.x = cvt_pk_bf16(Sacc[kt][0], Sacc[kt][1]); w.y = cvt_pk_bf16(Sacc[kt][2], Sacc[kt][3]);
            *(LAS u32x2*)(lds + L_ST + (16 * wave + fr) * CQS + (16 * kt + 4 * fq) * 2) = w;
        }
    }
#pragma unroll
    for (int kt = 0; kt < 8; ++kt)
#pragma unroll
        for (int j = 0; j < 4; ++j) Sout[(size_t)(16 * kt + 4 * fq + j) * HD + 16 * wave + fr] = Sacc[kt][j];
    __syncthreads();
}

__device__ __forceinline__ void phase2(LAS unsigned char* lds, const Args& a, int bid, int G) {
    unsigned char* ws = a.ws;
    const bf16* zb = (const bf16*)(ws + WS_ZB); const float* lf = (const float*)(ws + WS_LF); bf16* mixb = (bf16*)(ws + WS_MIX);
    constexpr int NPC = NB * NH, NSC = DB * NH, NPOOL = (M / 64) * 4;
    int first, step;
    if (G >= 2 * NPC) {
        if (bid < NPC) { chain_mfma(lds, zb, lf, a.in[9], a.out + O_HSP + (size_t)bid * HD * HD, mixb, (bid / NH) * SEQ, bid % NH); return; }
        first = bid - NPC; step = G - NPC;
    } else {
        for (int c = bid; c < NPC; c += G) chain_mfma(lds, zb, lf, a.in[9], a.out + O_HSP + (size_t)c * HD * HD, mixb, (c / NH) * SEQ, c % NH);
        first = bid; step = G;
    }
    for (int it = first; it < NSC + NPOOL; it += step) {
        if (it < NSC) { const int b = it / NH, h = it % NH; chain_run(lds, zb, lf, a.in[9], a.in[3] + (size_t)it * HD * HD, a.out + O_HSS + (size_t)it * HD * HD, mixb, MP + b * DS, DS, h); __syncthreads(); }
        else pool_item(lds, it - NSC, zb, a.in[2], (const bf16*)(ws + WS_WP), mixb);
    }
}

__device__ __forceinline__ void phase6(const Args& a, int vcu, int G) {
    const int tid = threadIdx.x, lane = tid & 63, wave = tid >> 6;
    const int gw = vcu * NWAVES + wave, NGW = G * NWAVES;
    const float* rsq3 = (const float*)(a.ws + WS_CTL) + CW_RSQ3;
    for (int m = gw; m < M; m += NGW) {
        float* yr = a.out + O_Y + (size_t)m * D;
        const float r = rsqrtf(rsq3[m] * (1.f / D) + EPS);
#pragma unroll
        for (int j = 0; j < 8; ++j) { const f32x4 v = ((const f32x4*)yr)[lane + 64 * j], g = ((const f32x4*)a.in[15])[lane + 64 * j]; ((f32x4*)yr)[lane + 64 * j] = v * r * g; }
    }
}

__global__ void __launch_bounds__(NWAVES * 64, 2) mega(Args a) {
    extern __shared__ __attribute__((aligned(16))) unsigned char lds_raw[];
    LAS unsigned char* lds = (LAS unsigned char*)lds_raw;
    const int G = gridDim.x, bid = blockIdx.x;
    const int vcu = (G % 8 == 0) ? (bid % 8) * (G / 8) + bid / 8 : bid;
    unsigned char* ws = a.ws;
    float* ctlf = (float*)(ws + WS_CTL);
    const int lo = a.ph_lo, hi = a.ph_hi;
#if ONE_LAUNCH && USE_CG
    cg::grid_group grid = cg::this_grid();
#define GRID_BAR() grid.sync()
#elif ONE_LAUNCH
    volatile LAS unsigned* MISC = (volatile LAS unsigned*)(lds + MISC_OFF);
    if (threadIdx.x < 32) MISC[threadIdx.x] = 0u;
    __syncthreads();
    XcdBarrier bar = xcd_barrier_post((unsigned*)(ws + WS_CTL) + CW_BAR, MISC + 8);
#define GRID_BAR() xcd_barrier(bar)
#else
#define GRID_BAR() do {} while (0)
#endif
#ifndef PH_MASK
#define PH_MASK 0x7f
#endif
#define IN(k) (((PH_MASK >> (k)) & 1) && lo <= (k) && (k) < hi)
#define BOTH(k) (IN(k) && IN((k) + 1))
#ifndef REP_MASK
#define REP_MASK 0
#endif
#define REP(k) ((REP_MASK >> (k)) & 1)
    if (IN(0)) { if (REP(0)) { phase0(lds, a, vcu, G); __syncthreads(); } phase0(lds, a, vcu, G); if (BOTH(0)) GRID_BAR(); }
    if (IN(1)) {
        pg8::Gemm g{(const bf16*)(ws + WS_XB), (const bf16*)(ws + WS_WIN), M, INC, D}; pg8::StaticOrder S; S.init(M, INC, G, bid);
        pg8::EpiZ E{(bf16*)(ws + WS_ZB), (float*)(ws + WS_LF), (const float*)(ws + WS_MISC), (const float*)(ws + WS_MISC) + M, a.out};
        if (REP(1)) pg8::gemm_phase<pg8::EpiZ, pg8::StaticOrder, true, true>(lds, g, S, E);
        pg8::gemm_phase<pg8::EpiZ, pg8::StaticOrder, true, true>(lds, g, S, E);
        if (BOTH(1)) GRID_BAR();
    }
    if (IN(2)) { if (REP(2)) { phase2(lds, a, bid, G); __syncthreads(); } phase2(lds, a, bid, G); if (BOTH(2)) GRID_BAR(); }
    if (IN(3)) {
        pg8::Gemm g{(const bf16*)(ws + WS_MIX), (const bf16*)(ws + WS_WO), M, D, D}; pg8::StaticOrder S; S.init(M, D, G, bid);
        if (REP(3)) { pg8::EpiX1<true> E0{a.in[0], a.in[1], a.out + O_Y, (bf16*)(ws + WS_XB), ctlf + CW_RSQ2}; pg8::gemm_phase<pg8::EpiX1<true>, pg8::StaticOrder, true, true>(lds, g, S, E0); }
        pg8::EpiX1<false> E{a.in[0], a.in[1], a.out + O_Y, (bf16*)(ws + WS_XB), ctlf + CW_RSQ2};
        pg8::gemm_phase<pg8::EpiX1<false>, pg8::StaticOrder, true, true>(lds, g, S, E);
        if (BOTH(3)) GRID_BAR();
    }
    if (IN(4)) {
        pg8::Gemm g{(const bf16*)(ws + WS_XB), (const bf16*)(ws + WS_WGU), M, 2 * DFF, D}; pg8::StaticOrder S; S.init(M, 2 * DFF, G, bid);
        pg8::EpiAct E{(bf16*)(ws + WS_ACT), ctlf + CW_RSQ2};
        if (REP(4)) pg8::gemm_phase<pg8::EpiAct, pg8::StaticOrder, true, true>(lds, g, S, E);
        pg8::gemm_phase<pg8::EpiAct, pg8::StaticOrder, true, true>(lds, g, S, E);
        if (BOTH(4)) GRID_BAR();
    }
    if (IN(5)) {
        pg8::Gemm g{(const bf16*)(ws + WS_ACT), (const bf16*)(ws + WS_WD), M, D, DFF}; pg8::StaticOrder S; S.init(M, D, G, bid);
        if (REP(5)) { pg8::EpiX2<true> E0{a.out + O_Y, ctlf + CW_RSQ3}; pg8::gemm_phase<pg8::EpiX2<true>, pg8::StaticOrder, true, true>(lds, g, S, E0); }
        pg8::EpiX2<false> E{a.out + O_Y, ctlf + CW_RSQ3};
        pg8::gemm_phase<pg8::EpiX2<false>, pg8::StaticOrder, true, true>(lds, g, S, E);
        if (BOTH(5)) GRID_BAR();
    }
    if (IN(6)) phase6(a, vcu, G);
#undef IN
#undef BOTH
}

extern "C" void kernel_launch(void* const* d_in, const int* in_sizes, int n_in, void* d_out, int out_size, void* d_ws, size_t ws_size, hipStream_t stream) {
    static int grid = 0;
    if (grid == 0) {
        if (n_in != 16 || ws_size < WS_END) { fprintf(stderr, "kernel_launch: unexpected n_in %d / ws_size %zu\n", n_in, ws_size); grid = -1; return; }
        int dev = 0, cus = 0, per_cu = 0;
        hipGetDevice(&dev);
        hipDeviceGetAttribute(&cus, hipDeviceAttributeMultiprocessorCount, dev);
        hipFuncSetAttribute((const void*)mega, hipFuncAttributeMaxDynamicSharedMemorySize, LDS_BYTES);
        hipOccupancyMaxActiveBlocksPerMultiprocessor(&per_cu, (const void*)mega, NWAVES * 64, LDS_BYTES);
        if (per_cu < 1) { fprintf(stderr, "kernel_launch: occupancy query says %d blocks per CU\n", per_cu); grid = -1; return; }
        grid = cus;
    }
    if (grid < 0) return;
    hipMemsetAsync((char*)d_ws + WS_CTL, 0, CTL_ZERO_BYTES, stream);
    Args a{};
    for (int i = 0; i < 16; ++i) a.in[i] = (const float*)d_in[i];
    a.out = (float*)d_out; a.ws = (unsigned char*)d_ws;
#if ONE_LAUNCH
    a.ph_lo = 0; a.ph_hi = NPHASE;
    void* args[] = {&a};
#if USE_CG
    hipError_t e = hipLaunchCooperativeKernel((const void*)mega, dim3(grid), dim3(NWAVES * 64), args, LDS_BYTES, stream);
    if (e != hipSuccess) fprintf(stderr, "cooperative launch failed: %s (grid %d)\n", hipGetErrorString(e), grid);
#else
    (void)args; hipLaunchKernelGGL(mega, dim3(grid), dim3(NWAVES * 64), LDS_BYTES, stream, a);
#endif
#else
    for (int p = 0; p < NPHASE; ++p) { a.ph_lo = p; a.ph_hi = p + 1; hipLaunchKernelGGL(mega, dim3(grid), dim3(NWAVES * 64), LDS_BYTES, stream, a); }
#endif
}
```

```cpp
#include <hip/hip_runtime.h>
#include <hip/hip_cooperative_groups.h>
#include <cstdio>
#include <cstdint>
namespace cg = cooperative_groups;

constexpr int D = 2048, NB = 4, SEQ = 2048, DB = 128, DS = 8;
constexpr int MP = NB * SEQ, MS = DB * DS, M = MP + MS;
constexpr int PW = 1024, HW = 1024, HD = 128, NH = 8, PC = 15;
constexpr int DFF = 5632, INC = 5120;
constexpr float EPS = 1e-6f;
constexpr size_t O_Y = 0;
constexpr size_t O_PSP = (size_t)M * D;
constexpr size_t O_HSP = O_PSP + (size_t)NB * PC * PW;
constexpr size_t O_PSS = O_HSP + (size_t)NB * NH * HD * HD;
constexpr size_t O_HSS = O_PSS + (size_t)DB * PC * PW;

namespace pg8 {
#define PG8_LAS __attribute__((address_space(3)))
typedef unsigned short bf16_t;
typedef short bf16x8 __attribute__((ext_vector_type(8)));
typedef float f32x4 __attribute__((ext_vector_type(4)));
typedef unsigned u32x4 __attribute__((ext_vector_type(4)));
constexpr int BM = 256, BK = 64, HALF = 128, HTB = HALF * BK * 2  , STAGE_BYTES = 8 * HTB, NXCD = 8, WGM = 8;

__host__ __device__ __forceinline__ int lds_byte(int r, int c) { const int st = (r >> 4) * 2 + (c >> 5), rr = r & 15, cc = c & 31, ob = rr * 64 + cc * 2; return st * 1024 + (ob ^ (((ob >> 9) & 1) << 5)); }
__host__ __device__ __forceinline__ void stage_rc(int b, int& R, int& C) { const int st = b / 1024, sb = b % 1024, swz = sb ^ (((sb >> 9) & 1) << 5); R = (st >> 1) * 16 + swz / 64; C = (st & 1) * 32 + (swz % 64) / 2; }
__host__ __device__ __forceinline__ int perm32(int rho) { const int n = rho >> 4, i = rho & 15; return 8 * (i >> 2) + 4 * n + (i & 3); }

struct Unit { int pm, pn; };
struct Gemm { const bf16_t* A; const bf16_t* Bt; int M, N, K; };

struct StaticOrder {
    int nM, nN, nwg, G, c;
    __host__ __device__ void init(int M, int N, int G_, int c_) { nM = M / BM; nN = N / BM; nwg = nM * nN; G = G_; c = c_; }
    __host__ __device__ bool next(int i, Unit& u) const {
        const long L = (long)i * G + c; if (L >= nwg) return false;
        int wgid = (int)L; { const int q = nwg / NXCD, r = nwg % NXCD, xcd = wgid % NXCD, off = wgid / NXCD; wgid = (xcd < r ? xcd * (q + 1) : r * (q + 1) + (xcd - r) * q) + off; }
        const int nig = WGM * nN, gid = wgid / nig, fm = gid * WGM, gsz = (nM - fm) < WGM ? (nM - fm) : WGM;
        u.pm = fm + ((wgid % nig) % gsz); u.pn = (wgid % nig) / gsz; return true;
    }
    __device__ __forceinline__ void a_ready(const Unit&) const {}
    __device__ __forceinline__ void done(const Unit&) const {}
};
__device__ __forceinline__ unsigned cvt_pk_bf16(float lo, float hi) { unsigned r; asm volatile("v_cvt_pk_bf16_f32 %0, %1, %2" : "=v"(r) : "v"(lo), "v"(hi)); return r; }
__device__ __forceinline__ float sigm(float x) { return __builtin_amdgcn_rcpf(1.f + __expf(-x)); }
__device__ __forceinline__ float silu(float x) { return x * __builtin_amdgcn_rcpf(1.f + __expf(-x)); }
typedef unsigned u32x2 __attribute__((ext_vector_type(2)));

struct EpiZ {
    static constexpr bool PERM = true, AFTER_DRAIN = false;
    bf16_t* zb; float* lf; const float* rstd1; const float* lbv; float* out;
    __device__ __forceinline__ void operator()(const f32x4 (&acc)[2][2][4][2], const Unit& u, int wr, int wc, int fr, int fq) const {
        const int kind = u.pn >> 2;
        const int row0 = u.pm * BM + wr * 64 + fr;
        const int cc0 = (u.pn & 3) * 256 + wc * 32 + 8 * fq;
        f32x4 lb[2][2];
        if (kind == 2) {
#pragma unroll
            for (int bj = 0; bj < 2; ++bj)
#pragma unroll
                for (int n = 0; n < 2; ++n) lb[bj][n] = *(const f32x4*)(lbv + cc0 + bj * HALF + 4 * n);
        }
#pragma unroll
        for (int ai = 0; ai < 2; ++ai)
#pragma unroll
            for (int m = 0; m < 4; ++m) {
                const int row = row0 + ai * HALF + m * 16;
                const float r = rstd1[row];
#pragma unroll
                for (int bj = 0; bj < 2; ++bj) {
                    const int cc = cc0 + bj * HALF;
                    f32x4 v0 = acc[ai][bj][m][0] * r, v1 = acc[ai][bj][m][1] * r;
                    if (kind == 2) {
                        f32x4 k0, k1;
#pragma unroll
                        for (int j = 0; j < 4; ++j) {
                            const float f0 = lb[bj][0][j] + (1.f - lb[bj][0][j]) * sigm(v0[j]), f1 = lb[bj][1][j] + (1.f - lb[bj][1][j]) * sigm(v1[j]);
                            v0[j] = __log2f(f0); v1[j] = __log2f(f1); k0[j] = 1.f - f0; k1[j] = 1.f - f1;
                        }
                        float* p = lf + (size_t)row * HW + cc;
                        *(f32x4*)p = v0; *(f32x4*)(p + 4) = v1;
                        u32x4 w; w.x = cvt_pk_bf16(k0[0], k0[1]); w.y = cvt_pk_bf16(k0[2], k0[3]); w.z = cvt_pk_bf16(k1[0], k1[1]); w.w = cvt_pk_bf16(k1[2], k1[3]);
                        *(u32x4*)(zb + (size_t)row * INC + 2 * 1024 + cc) = w;
                    } else {
                        if (kind == 0) {
                            float* dst = nullptr;
                            if (row >= MP) { const int ms = row - MP; dst = out + O_PSS + ((size_t)(ms >> 3) * PC + 7 + (ms & 7)) * PW + cc; }
                            else { const int t = row & (SEQ - 1); if (t >= SEQ - PC) dst = out + O_PSP + ((size_t)(row >> 11) * PC + (t - (SEQ - PC))) * PW + cc; }
                            if (dst) { *(f32x4*)dst = v0; *(f32x4*)(dst + 4) = v1; }
                        }
                        if (kind == 1 || kind == 4) {
#pragma unroll
                            for (int j = 0; j < 4; ++j) { v0[j] = silu(v0[j]); v1[j] = silu(v1[j]); }
                        }
                        u32x4 w; w.x = cvt_pk_bf16(v0[0], v0[1]); w.y = cvt_pk_bf16(v0[2], v0[3]); w.z = cvt_pk_bf16(v1[0], v1[1]); w.w = cvt_pk_bf16(v1[2], v1[3]);
                        *(u32x4*)(zb + (size_t)row * INC + kind * 1024 + cc) = w;
                    }
                }
            }
    }
};

template <bool DRY = false> struct EpiX1 {
    static constexpr bool PERM = false, AFTER_DRAIN = false;
    const float* xp; const float* xs; float* y; bf16_t* x1b; float* rowsq;
    __device__ __forceinline__ void operator()(const f32x4 (&acc)[2][2][4][2], const Unit& u, int wr, int wc, int fr, int fq) const {
        const int row0 = u.pm * BM + wr * 64 + fr, col0 = u.pn * BM + wc * 32 + 4 * fq;
#pragma unroll
        for (int ai = 0; ai < 2; ++ai)
#pragma unroll
            for (int m = 0; m < 4; ++m) {
                const int row = row0 + ai * HALF + m * 16;
                const float* xr = (row < MP ? xp + (size_t)row * D : xs + (size_t)(row - MP) * D) + col0;
                float* yr = y + (size_t)row * D + col0; bf16_t* br = x1b + (size_t)row * D + col0;
                float s = 0.f;
#pragma unroll
                for (int bj = 0; bj < 2; ++bj)
#pragma unroll
                    for (int n = 0; n < 2; ++n) {
                        const f32x4 v = *(const f32x4*)(xr + bj * HALF + n * 16) + acc[ai][bj][m][n];
                        *(f32x4*)(yr + bj * HALF + n * 16) = v;
                        u32x2 w; w.x = cvt_pk_bf16(v[0], v[1]); w.y = cvt_pk_bf16(v[2], v[3]);
                        *(u32x2*)(br + bj * HALF + n * 16) = w;
                        s += (v[0] * v[0] + v[1] * v[1]) + (v[2] * v[2] + v[3] * v[3]);
                    }
                s += __shfl_xor(s, 16); s += __shfl_xor(s, 32);
                if (fq == 0 && !DRY) atomicAdd(rowsq + row, s);
            }
    }
};

struct EpiAct {
    static constexpr bool PERM = true, AFTER_DRAIN = false;
    bf16_t* act; const float* rowsq;
    __device__ __forceinline__ void operator()(const f32x4 (&acc)[2][2][4][2], const Unit& u, int wr, int wc, int fr, int fq) const {
        const int row0 = u.pm * BM + wr * 64 + fr, col0 = u.pn * HALF + wc * 32 + 8 * fq;
#pragma unroll
        for (int ai = 0; ai < 2; ++ai)
#pragma unroll
            for (int m = 0; m < 4; ++m) {
                const int row = row0 + ai * HALF + m * 16;
                const float r = rsqrtf(rowsq[row] * (1.f / D) + EPS);
                u32x4 w; unsigned* wp = (unsigned*)&w;
#pragma unroll
                for (int n = 0; n < 2; ++n) {
                    const f32x4 g = acc[ai][0][m][n] * r, up = acc[ai][1][m][n] * r;
                    f32x4 a;
#pragma unroll
                    for (int j = 0; j < 4; ++j) a[j] = silu(g[j]) * up[j];
                    wp[2 * n] = cvt_pk_bf16(a[0], a[1]); wp[2 * n + 1] = cvt_pk_bf16(a[2], a[3]);
                }
                *(u32x4*)(act + (size_t)row * DFF + col0) = w;
            }
    }
};

template <bool DRY = false> struct EpiX2 {
    static constexpr bool PERM = false, AFTER_DRAIN = false;
    float* y; float* rowsq;
    __device__ __forceinline__ void operator()(const f32x4 (&acc)[2][2][4][2], const Unit& u, int wr, int wc, int fr, int fq) const {
        const int row0 = u.pm * BM + wr * 64 + fr, col0 = u.pn * BM + wc * 32 + 4 * fq;
#pragma unroll
        for (int ai = 0; ai < 2; ++ai)
#pragma unroll
            for (int m = 0; m < 4; ++m) {
                const int row = row0 + ai * HALF + m * 16;
                float* yr = y + (size_t)row * D + col0;
                float s = 0.f;
#pragma unroll
                for (int bj = 0; bj < 2; ++bj)
#pragma unroll
                    for (int n = 0; n < 2; ++n) {
                        const f32x4 v = *(const f32x4*)(yr + bj * HALF + n * 16) + (DRY ? acc[ai][bj][m][n] * 0.f : acc[ai][bj][m][n]);
                        *(f32x4*)(yr + bj * HALF + n * 16) = v;
                        s += (v[0] * v[0] + v[1] * v[1]) + (v[2] * v[2] + v[3] * v[3]);
                    }
                s += __shfl_xor(s, 16); s += __shfl_xor(s, 32);
                if (fq == 0 && !DRY) atomicAdd(rowsq + row, s);
            }
    }
};
template <class Epi, class Sched, bool ALIGN_EPI = false, bool SP2 = false>
__device__ __forceinline__ void gemm_phase(PG8_LAS unsigned char* lds, const Gemm g, const Sched& S, const Epi& E) {
    int tid_ = threadIdx.x; asm volatile("" : "+v"(tid_));
    const int tid = tid_, wid = __builtin_amdgcn_readfirstlane(tid >> 6), lane = tid & 63, wr = wid >> 2, wc = wid & 3, fr = lane & 15, fq = lane >> 4;
    const int K = g.K, nt = K / BK;
    unsigned voffA[2], voffB[2];
#pragma unroll
    for (int i = 0; i < 2; ++i) { int R, C; stage_rc(tid * 16 + i * 8192, R, C); const int Rb = Epi::PERM ? ((R & ~31) + perm32(R & 31)) : R;
        voffA[i] = (unsigned)(R * K + C) * 2u; voffB[i] = (unsigned)(Rb * K + C) * 2u; }
    const size_t kstep = (size_t)(BK * 2);
    const size_t hstep = (size_t)HALF * K * 2;
    const size_t tstep = 2 * hstep;
    const unsigned ldsw = (unsigned)wid * 1024u;
    const int aoff = lds_byte(wr * 64 + fr, fq * 8), boff = lds_byte(wc * 32 + fr, fq * 8);
#define PG8_SA(b, h) (((b) * 2 + (h)) * HTB)
#define PG8_SB(b, h) ((4 + (b) * 2 + (h)) * HTB)
#define PG8_STAGE(bufoff, gbase, voff) do { _Pragma("unroll") for (int _i = 0; _i < 2; ++_i) \
        __builtin_amdgcn_global_load_lds((const unsigned*)((const char*)(gbase) + (voff)[_i]), (PG8_LAS unsigned*)(lds + (bufoff) + ldsw + _i * 8192), 16, 0, 0); } while (0)
#define PG8_LDA(dst, b, h) do { _Pragma("unroll") for (int m = 0; m < 4; ++m) _Pragma("unroll") for (int k = 0; k < 2; ++k) dst[m][k] = *(const PG8_LAS bf16x8*)(lds + PG8_SA(b, h) + aoff + m * 2048 + k * 1024); } while (0)
#define PG8_LDB(dst, b, h) do { _Pragma("unroll") for (int n = 0; n < 2; ++n) _Pragma("unroll") for (int k = 0; k < 2; ++k) dst[n][k] = *(const PG8_LAS bf16x8*)(lds + PG8_SB(b, h) + boff + n * 2048 + k * 1024); } while (0)
#define PG8_MMA(ai, bj, At, Bt) do { __builtin_amdgcn_s_setprio(1); _Pragma("unroll") for (int m = 0; m < 4; ++m) _Pragma("unroll") for (int n = 0; n < 2; ++n) _Pragma("unroll") for (int k = 0; k < 2; ++k) \
        acc[ai][bj][m][n] = __builtin_amdgcn_mfma_f32_16x16x32_bf16(Bt[n][k], At[m][k], acc[ai][bj][m][n], 0, 0, 0); __builtin_amdgcn_s_setprio(0); } while (0)
#define PG8_WAIT_V(n) asm volatile("s_waitcnt vmcnt(" #n ")" ::: "memory")
#define PG8_WAIT_L(n) asm volatile("s_waitcnt lgkmcnt(" #n ")" ::: "memory")
#define PG8_BAR __builtin_amdgcn_s_barrier()
#define PG8_SCHED __builtin_amdgcn_sched_barrier(0)
    Unit cur, nxt; int ui = 0;
    if (!S.next(0, cur)) return;
    f32x4 acc[2][2][4][2];
#pragma unroll
    for (int a = 0; a < 2; ++a)
#pragma unroll
        for (int b = 0; b < 2; ++b)
#pragma unroll
            for (int m = 0; m < 4; ++m)
#pragma unroll
                for (int n = 0; n < 2; ++n) acc[a][b][m][n] = (f32x4){0.f, 0.f, 0.f, 0.f};
    bf16x8 At[4][2], B0[2][2], B1[2][2];
    const char* cA = (const char*)g.A + (size_t)cur.pm * tstep; const char* cB = (const char*)g.Bt + (size_t)cur.pn * tstep;
    S.a_ready(cur);
    if constexpr (SP2) {
        PG8_STAGE(PG8_SB(0, 0), cB, voffB); PG8_STAGE(PG8_SB(0, 1), cB + hstep, voffB); PG8_STAGE(PG8_SA(0, 0), cA, voffA); PG8_STAGE(PG8_SA(0, 1), cA + hstep, voffA);
        if (wr == 1) PG8_BAR;
        PG8_WAIT_V(2); PG8_BAR;
        PG8_STAGE(PG8_SB(1, 0), cB + kstep, voffB); PG8_STAGE(PG8_SA(1, 0), cA + kstep, voffA); PG8_STAGE(PG8_SB(1, 1), cB + hstep + kstep, voffB);
        PG8_WAIT_V(6); PG8_BAR;
    } else {
        PG8_STAGE(PG8_SB(0, 0), cB, voffB); PG8_STAGE(PG8_SA(0, 0), cA, voffA); PG8_STAGE(PG8_SB(0, 1), cB + hstep, voffB); PG8_STAGE(PG8_SA(0, 1), cA + hstep, voffA);
        if (wr == 1) PG8_BAR;
        PG8_WAIT_V(4); PG8_BAR;
        PG8_STAGE(PG8_SB(1, 0), cB + kstep, voffB); PG8_STAGE(PG8_SA(1, 0), cA + kstep, voffA); PG8_STAGE(PG8_SB(1, 1), cB + hstep + kstep, voffB);
        PG8_WAIT_V(6); PG8_BAR;
    }
    for (;;) {
        const bool has_next = S.next(ui + 1, nxt);
        const char* nA = has_next ? (const char*)g.A + (size_t)nxt.pm * tstep : cA; const char* nB = has_next ? (const char*)g.Bt + (size_t)nxt.pn * tstep : cB;
        for (int t = 0; t < nt; t += 2) {
            const bool last = (t == nt - 2);
            const char* a1 = cA + (size_t)(t + 1) * kstep;
            const char* a2 = last ? nA : cA + (size_t)(t + 2) * kstep; const char* b2 = last ? nB : cB + (size_t)(t + 2) * kstep;
            const char* a3 = a2 + kstep; const char* b3 = b2 + kstep;
            if (last && has_next) S.a_ready(nxt);
            if constexpr (SP2) {
            PG8_LDB(B0, 0, 0); PG8_LDB(B1, 0, 1); PG8_SCHED; PG8_LDA(At, 0, 0); PG8_STAGE(PG8_SA(1, 1), a1 + hstep, voffA);
            PG8_WAIT_V(8); PG8_WAIT_L(0); PG8_BAR; PG8_MMA(0, 0, At, B0); PG8_MMA(0, 1, At, B1); PG8_BAR; PG8_SCHED;
            PG8_LDA(At, 0, 1); PG8_STAGE(PG8_SB(0, 0), b2, voffB); PG8_STAGE(PG8_SB(0, 1), b2 + hstep, voffB); PG8_STAGE(PG8_SA(0, 0), a2, voffA);
            PG8_WAIT_V(8); PG8_WAIT_L(0); PG8_BAR; PG8_MMA(1, 0, At, B0); PG8_MMA(1, 1, At, B1); PG8_BAR; PG8_SCHED;
            PG8_LDB(B0, 1, 0); PG8_LDB(B1, 1, 1); PG8_SCHED; PG8_LDA(At, 1, 0); PG8_STAGE(PG8_SA(0, 1), a2 + hstep, voffA);
            PG8_WAIT_V(8); PG8_WAIT_L(0); PG8_BAR; PG8_MMA(0, 0, At, B0); PG8_MMA(0, 1, At, B1); PG8_BAR; PG8_SCHED;
            PG8_LDA(At, 1, 1); PG8_STAGE(PG8_SB(1, 0), b3, voffB); PG8_STAGE(PG8_SB(1, 1), b3 + hstep, voffB); PG8_STAGE(PG8_SA(1, 0), a3, voffA);
            PG8_WAIT_V(8); PG8_WAIT_L(0); PG8_BAR; PG8_MMA(1, 0, At, B0); PG8_MMA(1, 1, At, B1); PG8_BAR; PG8_SCHED;
            } else {
            PG8_LDB(B0, 0, 0); PG8_SCHED; PG8_LDA(At, 0, 0); PG8_STAGE(PG8_SA(1, 1), a1 + hstep, voffA);
            PG8_WAIT_L(8); PG8_BAR; PG8_WAIT_L(0); PG8_MMA(0, 0, At, B0); PG8_BAR; PG8_SCHED;
            PG8_LDB(B1, 0, 1); PG8_STAGE(PG8_SB(0, 0), b2, voffB);
            PG8_BAR; PG8_WAIT_L(0); PG8_MMA(0, 1, At, B1); PG8_BAR;
            PG8_LDA(At, 0, 1); PG8_STAGE(PG8_SA(0, 0), a2, voffA);
            PG8_BAR; PG8_WAIT_L(0); PG8_MMA(1, 0, At, B0); PG8_BAR; PG8_SCHED;
            PG8_STAGE(PG8_SB(0, 1), b2 + hstep, voffB);
            PG8_WAIT_V(6); PG8_BAR; PG8_MMA(1, 1, At, B1); PG8_BAR;
            PG8_LDB(B0, 1, 0); PG8_SCHED; PG8_LDA(At, 1, 0); PG8_STAGE(PG8_SA(0, 1), a2 + hstep, voffA);
            PG8_WAIT_L(8); PG8_BAR; PG8_WAIT_L(0); PG8_MMA(0, 0, At, B0); PG8_BAR; PG8_SCHED;
            PG8_LDB(B1, 1, 1); PG8_STAGE(PG8_SB(1, 0), b3, voffB);
            PG8_BAR; PG8_WAIT_L(0); PG8_MMA(0, 1, At, B1); PG8_BAR;
            PG8_LDA(At, 1, 1); PG8_STAGE(PG8_SA(1, 0), a3, voffA);
            PG8_BAR; PG8_WAIT_L(0); PG8_MMA(1, 0, At, B0); PG8_BAR; PG8_SCHED;
            PG8_STAGE(PG8_SB(1, 1), b3 + hstep, voffB);
            PG8_WAIT_V(6); PG8_BAR; PG8_MMA(1, 1, At, B1); PG8_BAR;
            }
        }
        if constexpr (ALIGN_EPI) { if (wr == 0) PG8_BAR; }
        if constexpr (!Epi::AFTER_DRAIN) { E(acc, cur, wr, wc, fr, fq); S.done(cur); }
        if (!has_next) break;
#pragma unroll
        for (int a = 0; a < 2; ++a)
#pragma unroll
            for (int b = 0; b < 2; ++b)
#pragma unroll
                for (int m = 0; m < 4; ++m)
#pragma unroll
                    for (int n = 0; n < 2; ++n) acc[a][b][m][n] = (f32x4){0.f, 0.f, 0.f, 0.f};
        cur = nxt; cA = nA; cB = nB; ++ui;
        if constexpr (ALIGN_EPI) { if (wr == 1) PG8_BAR; }
    }
    PG8_WAIT_V(0);
    if constexpr (!ALIGN_EPI) { if (wr == 0) PG8_BAR; }
    PG8_BAR;
    if constexpr (Epi::AFTER_DRAIN) { E.fused(acc, cur, wr, wc, fr, fq, lds, wid, lane); S.done(cur); }
#undef PG8_SA
#undef PG8_SB
#undef PG8_STAGE
#undef PG8_LDA
#undef PG8_LDB
#undef PG8_MMA
#undef PG8_WAIT_V
#undef PG8_WAIT_L
#undef PG8_BAR
#undef PG8_SCHED
}
}
#define LAS __attribute__((address_space(3)))
typedef unsigned short bf16;
using pg8::f32x4; using pg8::u32x4; using pg8::u32x2; using pg8::bf16x8; using pg8::cvt_pk_bf16;

#ifndef ONE_LAUNCH
#define ONE_LAUNCH 1
#endif
constexpr int NWAVES = 8, NPHASE = 7;
constexpr int LDS_BYTES = 147456;
constexpr size_t MiB = 1u << 20;
constexpr size_t WS_CTL = 0, CTL_ZERO_BYTES = 1 * MiB;
constexpr size_t WS_WIN = 1 * MiB;
constexpr size_t WS_WO = 21 * MiB;
constexpr size_t WS_WGU = 29 * MiB;
constexpr size_t WS_WD = 73 * MiB;
constexpr size_t WS_WP = 95 * MiB;
constexpr size_t WS_MISC = 96 * MiB;
constexpr size_t WS_XB = 97 * MiB;
constexpr size_t WS_ZB = 133 * MiB;
constexpr size_t WS_LF = 223 * MiB;
constexpr size_t WS_ACT = WS_ZB;
constexpr size_t WS_MIX = 259 * MiB;
constexpr size_t WS_END = 295 * MiB;
constexpr int CW_RSQ2 = 4096, CW_RSQ3 = 4096 + M;
constexpr int CW_BAR = 65536;
constexpr int MISC_OFF = 147456 - 256;
#ifndef USE_CG
#define USE_CG 0
#endif

__device__ __forceinline__ float wave_sum(float v) {
#pragma unroll
    for (int o = 1; o < 64; o <<= 1) v += __shfl_xor(v, o);
    return v;
}
__device__ __forceinline__ float bf2f(bf16 b) { return __builtin_bit_cast(float, (unsigned)b << 16); }
__device__ __forceinline__ bf16 f2bf(float f) { unsigned u = __builtin_bit_cast(unsigned, f); return (bf16)((u + 0x7fffu + ((u >> 16) & 1u)) >> 16); }

#define XB_TMO      128
#define XB_XCNT(j)  (256  + 64 * (j))
#define XB_XSUB(j)  (1280 + 64 * (j))
#define XB_XGEN(j)  (2304 + 64 * (j))
#define XB_TOP      3328
#define XB_TOPGEN   3392
#define XCD_BAR_WORDS 3456
#define XB_SPIN_CAP (1u << 18)

__device__ __forceinline__ unsigned xb_ld(unsigned* p)              { return __hip_atomic_load(p, __ATOMIC_RELAXED, __HIP_MEMORY_SCOPE_AGENT); }
__device__ __forceinline__ unsigned xb_add(unsigned* p, unsigned v) { return __hip_atomic_fetch_add(p, v, __ATOMIC_RELAXED, __HIP_MEMORY_SCOPE_AGENT); }
__device__ __forceinline__ unsigned xb_xcc_id() { return (unsigned)__builtin_amdgcn_s_getreg((3 << 11) | 20) & 0xFu; }
#define XB_SPIN(cond, bar) do { unsigned _sp = 0; while (cond) { __builtin_amdgcn_s_sleep(1); \
    if ((++_sp & 255u) == 0u) { if (xb_ld(&(bar)[XB_TMO])) break; if (_sp > XB_SPIN_CAP) { atomicAdd(&(bar)[XB_TMO], 1u); break; } } } } while (0)

struct XcdBarrier {
    unsigned* bar; unsigned x;
    volatile LAS unsigned* st;
};

__device__ __forceinline__ XcdBarrier xcd_barrier_post(unsigned* bar, volatile LAS unsigned* st) {
    XcdBarrier b; b.bar = bar; b.x = xb_xcc_id(); b.st = st;
    if (threadIdx.x == 0) (void)xb_add(&bar[XB_XCNT(b.x)], 1u);
    return b;
}
__device__ __forceinline__ void xcd_barrier_complete(unsigned* bar, unsigned x, unsigned& nloc, unsigned& nx) {
    const unsigned G = gridDim.x * gridDim.y * gridDim.z;
    unsigned sum, cnt, mine, sp = 0u;
    for (;;) {
        sum = 0u; cnt = 0u; mine = 0u;
#pragma unroll
        for (unsigned j = 0; j < 16; ++j) { const unsigned c = xb_ld(&bar[XB_XCNT(j)]); sum += c; cnt += (c > 0u) ? 1u : 0u; mine = (j == x) ? c : mine; }
        if (sum == G) break;
        __builtin_amdgcn_s_sleep(1);
        if ((++sp & 255u) == 0u) { if (xb_ld(&bar[XB_TMO])) break; if (sp > XB_SPIN_CAP) { atomicAdd(&bar[XB_TMO], 1u); break; } }
    }
    nloc = mine > 0u ? mine : 1u; nx = cnt > 0u ? cnt : 1u;
}

__device__ __forceinline__ void xcd_barrier(const XcdBarrier& b) {
    asm volatile("s_waitcnt vmcnt(0)" ::: "memory");
    __syncthreads();
    if (threadIdx.x == 0) {
        unsigned* bar = b.bar;
        __builtin_amdgcn_s_waitcnt(0);
        unsigned nloc = b.st[0], nx = b.st[1];
        if (nloc == 0u) { xcd_barrier_complete(bar, b.x, nloc, nx); b.st[0] = nloc; b.st[1] = nx; }
        const unsigned old = xb_add(&bar[XB_XSUB(b.x)], 1u);
        const unsigned gen = old / nloc;
        if (old + 1u == (gen + 1u) * nloc) {
            __builtin_amdgcn_fence(__ATOMIC_RELEASE, "agent");
            asm volatile("s_waitcnt vmcnt(0)" ::: "memory");
            const unsigned og = xb_add(&bar[XB_TOP], 1u);
            const unsigned tg = og / nx;
            if (og + 1u == (tg + 1u) * nx) xb_add(&bar[XB_TOPGEN], 1u);
            else XB_SPIN(xb_ld(&bar[XB_TOPGEN]) == tg, bar);
            __builtin_amdgcn_fence(__ATOMIC_ACQUIRE, "agent");
            xb_add(&bar[XB_XGEN(b.x)], 1u);
            asm volatile("s_waitcnt vmcnt(0)" ::: "memory");
        } else {
            XB_SPIN(xb_ld(&bar[XB_XGEN(b.x)]) == gen, bar);
            __builtin_amdgcn_fence(__ATOMIC_ACQUIRE, "agent");
            asm volatile("s_waitcnt vmcnt(0)" ::: "memory");
        }
    }
    __syncthreads();
}

struct Args { const float* in[16]; float* out; unsigned char* ws; int ph_lo, ph_hi; };

__device__ __forceinline__ void p0_item(const float* W, int K, int N, bf16* WT, int mode, const float* sk, const float* sn, LAS float* scr, int item, int lane) {
    const int nblk = N / 64, kb = item / nblk, nb = item % nblk, k0 = 64 * kb, n0 = 64 * nb;
    const int drow0 = mode == 0 ? n0 : ((n0 >> 7) * 256 + (n0 & 127) + (mode == 2 ? 128 : 0));
    const int r = lane >> 4, c4 = lane & 15;
    f32x4 v[16];
#pragma unroll
    for (int i = 0; i < 16; ++i) v[i] = *(const f32x4*)(W + (size_t)(k0 + 4 * i + r) * N + n0 + 4 * c4);
    if (sk) {
#pragma unroll
        for (int i = 0; i < 16; ++i) v[i] = v[i] * sk[k0 + 4 * i + r];
    }
#pragma unroll
    for (int i = 0; i < 16; ++i) { LAS float* d = scr + (4 * i + r) * 65 + 4 * c4; d[0] = v[i][0]; d[1] = v[i][1]; d[2] = v[i][2]; d[3] = v[i][3]; }
    asm volatile("s_waitcnt lgkmcnt(0)" ::: "memory");
    const int c = lane & 7, nn = lane >> 3;
#pragma unroll
    for (int j = 0; j < 8; ++j) { const int n = nn + 8 * j; const LAS float* s = scr + (8 * c) * 65 + n; const float f = sn ? sn[n0 + n] : 1.f;
        u32x4 o; o.x = cvt_pk_bf16(s[0 * 65] * f, s[1 * 65] * f); o.y = cvt_pk_bf16(s[2 * 65] * f, s[3 * 65] * f); o.z = cvt_pk_bf16(s[4 * 65] * f, s[5 * 65] * f); o.w = cvt_pk_bf16(s[6 * 65] * f, s[7 * 65] * f);
        *(u32x4*)(WT + (size_t)(drow0 + n) * K + k0 + 8 * c) = o; }
    asm volatile("s_waitcnt lgkmcnt(0)" ::: "memory");
}

__device__ __forceinline__ void phase0(LAS unsigned char* lds, const Args& a, int vcu, int G) {
    const int tid = threadIdx.x, lane = tid & 63, wave = tid >> 6;
    unsigned char* ws = a.ws;
    LAS float* scr = (LAS float*)(lds + wave * 16640);
    const int gw = vcu * NWAVES + wave, NGW = G * NWAVES;
    constexpr int I_IN = (D / 64) * (INC / 64), I_O = (D / 64) * (D / 64), I_G = (D / 64) * (DFF / 64), I_D = (DFF / 64) * (D / 64), I_P = (256 / 64) * (256 / 64);
    constexpr int NITEMS = I_IN + I_O + 2 * I_G + I_D + 4 * I_P;
    for (int it = gw; it < NITEMS; it += NGW) {
        int r = it;
        if (r < I_IN) { p0_item(a.in[6], D, INC, (bf16*)(ws + WS_WIN), 0, a.in[5], nullptr, scr, r, lane); continue; } r -= I_IN;
        if (r < I_O) { p0_item(a.in[10], D, D, (bf16*)(ws + WS_WO), 0, nullptr, nullptr, scr, r, lane); continue; } r -= I_O;
        if (r < I_G) { p0_item(a.in[12], D, DFF, (bf16*)(ws + WS_WGU), 1, a.in[11], nullptr, scr, r, lane); continue; } r -= I_G;
        if (r < I_G) { p0_item(a.in[13], D, DFF, (bf16*)(ws + WS_WGU), 2, a.in[11], nullptr, scr, r, lane); continue; } r -= I_G;
        if (r < I_D) { p0_item(a.in[14], DFF, D, (bf16*)(ws + WS_WD), 0, nullptr, nullptr, scr, r, lane); continue; } r -= I_D;
        { const int g = r / I_P; p0_item(a.in[7] + (size_t)g * 65536, 256, 256, (bf16*)(ws + WS_WP) + (size_t)g * 65536, 0, nullptr, a.in[8] + g * 256, scr, r % I_P, lane); }
    }
    float* rstd1 = (float*)(ws + WS_MISC); bf16* xb = (bf16*)(ws + WS_XB);
    for (int m = gw; m < M; m += NGW) {
        const float* xrow = m < MP ? a.in[0] + (size_t)m * D : a.in[1] + (size_t)(m - MP) * D;
        f32x4 v[8]; float s = 0.f;
#pragma unroll
        for (int j = 0; j < 8; ++j) { v[j] = ((const f32x4*)xrow)[lane + 64 * j]; s += (v[j][0] * v[j][0] + v[j][1] * v[j][1]) + (v[j][2] * v[j][2] + v[j][3] * v[j][3]); }
        s = wave_sum(s);
        if (lane == 0) rstd1[m] = rsqrtf(s * (1.f / D) + EPS);
#pragma unroll
        for (int j = 0; j < 8; ++j) { u32x2 w; w.x = cvt_pk_bf16(v[j][0], v[j][1]); w.y = cvt_pk_bf16(v[j][2], v[j][3]); ((u32x2*)(xb + (size_t)m * D))[lane + 64 * j] = w; }
    }
    const int gt = vcu * (NWAVES * 64) + tid, NGT = G * NWAVES * 64;
    float* lbv = (float*)(ws + WS_MISC) + M;
    for (int c = gt; c < HW; c += NGT) lbv[c] = 1.f / (1.f + __expf(a.in[4][HW + c] - a.in[4][c]));
    for (int i = gt; i < DB * 7 * PW; i += NGT) { const int b = i / (7 * PW), rem = i % (7 * PW); a.out[O_PSS + (size_t)b * PC * PW + rem] = a.in[2][(size_t)b * PC * PW + 8 * PW + rem]; }
}

template <int W>
__device__ __forceinline__ void pool_fill(LAS bf16* A, int m0, int g, const bf16* zb, const float* cache) {
    const int tid = threadIdx.x, c = tid & 255, rh = tid >> 8;
    constexpr int LDA = 264;
    const int col = g * 256 + c;
    if (m0 < MP) {
        const int mb = m0 + rh * 32 - 15, tb = (m0 & (SEQ - 1)) + rh * 32 - 15;
        float ur[47];
#pragma unroll
        for (int i = 0; i < 47; ++i) ur[i] = (tb + i >= 0) ? bf2f(zb[(size_t)(mb + i) * INC + col]) : 0.f;
        float s = 0.f;
#pragma unroll
        for (int j = 1; j < W; ++j) s += ur[15 - j];
#pragma unroll
        for (int r = 0; r < 32; ++r) {
            s += ur[15 + r];
            const int t = tb + 15 + r;
            const float cnt = (float)min(t + 1, W);
            A[(rh * 32 + r) * LDA + c] = f2bf(s / cnt - ur[15 + r]);
            s -= ur[15 + r - (W - 1)];
        }
    } else {
#pragma unroll 1
        for (int bb = 0; bb < 4; ++bb) {
            const int r0 = rh * 32 + bb * 8, m = m0 + r0, b = (m - MP) >> 3;
            float hs[23];
#pragma unroll
            for (int i = 0; i < 15; ++i) hs[i] = cache[((size_t)b * PC + i) * PW + col];
#pragma unroll
            for (int i = 0; i < 8; ++i) hs[15 + i] = bf2f(zb[(size_t)(m + i) * INC + col]);
            float s = 0.f;
#pragma unroll
            for (int j = 1; j < W; ++j) s += hs[15 - j];
#pragma unroll
            for (int t = 0; t < 8; ++t) {
                s += hs[15 + t];
                A[(r0 + t) * LDA + c] = f2bf(s * (1.f / W) - hs[15 + t]);
                s -= hs[15 + t - (W - 1)];
            }
        }
    }
}
__device__ __forceinline__ void pool_item(LAS unsigned char* lds, int item, const bf16* zb, const float* cache, const bf16* WpT, bf16* mixb) {
    const int tile = item >> 2, g = item & 3, m0 = tile * 64;
    const int tid = threadIdx.x;
    constexpr int LDA = 264;
    LAS bf16* A = (LAS bf16*)lds;
    if (g == 0) pool_fill<2>(A, m0, g, zb, cache); else if (g == 1) pool_fill<4>(A, m0, g, zb, cache); else if (g == 2) pool_fill<8>(A, m0, g, zb, cache); else pool_fill<16>(A, m0, g, zb, cache);
    __syncthreads();
    const int wave = tid >> 6, lane = tid & 63, fr = lane & 15, fq = lane >> 4, n0 = wave * 32;
    f32x4 acc[4][2];
#pragma unroll
    for (int i = 0; i < 4; ++i)
#pragma unroll
        for (int j = 0; j < 2; ++j) acc[i][j] = (f32x4){0.f, 0.f, 0.f, 0.f};
#pragma unroll 2
    for (int ks = 0; ks < 8; ++ks) {
        bf16x8 wf[2], af[4];
#pragma unroll
        for (int nt = 0; nt < 2; ++nt) wf[nt] = *(const bf16x8*)(WpT + (size_t)(g * 256 + n0 + nt * 16 + fr) * 256 + ks * 32 + fq * 8);
#pragma unroll
        for (int mt = 0; mt < 4; ++mt) af[mt] = *(const LAS bf16x8*)(A + (mt * 16 + fr) * LDA + ks * 32 + fq * 8);
#pragma unroll
        for (int mt = 0; mt < 4; ++mt)
#pragma unroll
            for (int nt = 0; nt < 2; ++nt) acc[mt][nt] = __builtin_amdgcn_mfma_f32_16x16x32_bf16(wf[nt], af[mt], acc[mt][nt], 0, 0, 0);
    }
#pragma unroll
    for (int mt = 0; mt < 4; ++mt)
#pragma unroll
        for (int nt = 0; nt < 2; ++nt) {
            u32x2 o; o.x = cvt_pk_bf16(acc[mt][nt][0], acc[mt][nt][1]); o.y = cvt_pk_bf16(acc[mt][nt][2], acc[mt][nt][3]);
            *(u32x2*)(mixb + (size_t)(m0 + mt * 16 + fr) * D + g * 256 + n0 + nt * 16 + 4 * fq) = o;
        }
    __syncthreads();
}

struct SampleRegs { f32x4 S[8]; };
__device__ __forceinline__ void sample_load(SampleRegs& R, const float* S0) {
    const int tid = threadIdx.x, v4 = tid & 31, kq = tid >> 5;
#pragma unroll
    for (int kk = 0; kk < 8; ++kk) R.S[kk] = *(const f32x4*)(S0 + (size_t)(kq * 8 + kk) * HD + 4 * v4);
}
__device__ __forceinline__ void sample_run(LAS unsigned char* lds, SampleRegs& R, const bf16* zb, const float* lf, const float* hgn, float* Sout, bf16* mixb, int row0, int h) {
    const int tid = threadIdx.x, v4 = tid & 31, kq = tid >> 5, wave = tid >> 6, lane = tid & 63;
    LAS float* sq = (LAS float*)lds; LAS float* sf = sq + 1024; LAS float* sk = sf + 1024; LAS float* sv = sk + 1024; LAS float* red = sv + 1024;
    for (int i = tid; i < 1024; i += 512) {
        const int t = i >> 7, ch = i & 127; const size_t row = (size_t)(row0 + t);
        const float f = __builtin_amdgcn_exp2f(lf[row * HW + h * HD + ch]);
        sq[i] = bf2f(zb[row * INC + PW + h * HD + ch]); sf[i] = f; sk[i] = 1.f - f; sv[i] = bf2f(zb[row * INC + PW + 2 * HW + h * HD + ch]);
    }
    __syncthreads();
#pragma unroll 1
    for (int t = 0; t < 8; ++t) {
        const f32x4 vt = *(const LAS f32x4*)(sv + t * 128 + 4 * v4);
        f32x4 o = (f32x4){0.f, 0.f, 0.f, 0.f};
        const f32x4 f0 = *(const LAS f32x4*)(sf + t * 128 + kq * 8), f1 = *(const LAS f32x4*)(sf + t * 128 + kq * 8 + 4);
        const f32x4 k0 = *(const LAS f32x4*)(sk + t * 128 + kq * 8), k1 = *(const LAS f32x4*)(sk + t * 128 + kq * 8 + 4);
        const f32x4 q0 = *(const LAS f32x4*)(sq + t * 128 + kq * 8), q1 = *(const LAS f32x4*)(sq + t * 128 + kq * 8 + 4);
#pragma unroll
        for (int kk = 0; kk < 8; ++kk) {
            const float f = kk < 4 ? f0[kk & 3] : f1[kk & 3], kn = kk < 4 ? k0[kk & 3] : k1[kk & 3], q = kk < 4 ? q0[kk & 3] : q1[kk & 3];
            R.S[kk] = R.S[kk] * f + vt * kn;
            o = o + R.S[kk] * q;
        }
#pragma unroll
        for (int j = 0; j < 4; ++j) o[j] += __shfl_xor(o[j], 32);
        if (lane < 32) *(LAS f32x4*)(red + (wave * 8 + t) * 128 + 4 * v4) = o;
    }
#pragma unroll
    for (int kk = 0; kk < 8; ++kk) *(f32x4*)(Sout + (size_t)(kq * 8 + kk) * HD + 4 * v4) = R.S[kk];
    __syncthreads();
    {
        const int t = wave; const size_t row = (size_t)(row0 + t);
        float o0 = 0.f, o1 = 0.f;
#pragma unroll
        for (int w8 = 0; w8 < 8; ++w8) { o0 += red[(w8 * 8 + t) * 128 + lane]; o1 += red[(w8 * 8 + t) * 128 + lane + 64]; }
        const float ss = wave_sum(o0 * o0 + o1 * o1), r = rsqrtf(ss * (1.f / HD) + EPS);
        const int ch0 = h * HD + lane, ch1 = ch0 + 64;
        mixb[row * D + PW + ch0] = f2bf(o0 * r * hgn[ch0] * bf2f(zb[row * INC + PW + 3 * HW + ch0]));
        mixb[row * D + PW + ch1] = f2bf(o1 * r * hgn[ch1] * bf2f(zb[row * INC + PW + 3 * HW + ch1]));
    }
    __syncthreads();
}

constexpr int CQS = 272, CTS = 144;
constexpr int L_Q = 0, L_K = L_Q + 64 * CQS, L_KT = L_K + 64 * CQS, L_VT = L_KT + 128 * CTS, L_ST = L_VT + 128 * CTS, L_P = L_ST + 128 * CQS,
              L_DS = L_P + 64 * CTS, L_TOT = L_DS + 512, L_RMS = L_TOT + 2048, L_CHAIN_END = L_RMS + 512;
static_assert(L_CHAIN_END <= 131072, "chain LDS");
template <bool FULL>
__device__ __forceinline__ void seg_run(LAS unsigned char* lds, const bf16* zb, const float* lf, f32x4 (&Sacc)[8], float& segsum, const f32x4 (&gnr)[4], bf16* mixb, int rowb, int nsteps, int h) {
    const int tid = threadIdx.x, lane = tid & 63, wave = __builtin_amdgcn_readfirstlane(tid >> 6), fr = lane & 15, fq = lane >> 4;
    const int k = tid & 127, tg = tid >> 7;
    const size_t cq = PW + h * HD + k, ck = PW + HW + h * HD + k, cv = PW + 2 * HW + h * HD + k, cl = h * HD + k;
    LAS float* dS = (LAS float*)(lds + L_DS); LAS float* tot = (LAS float*)(lds + L_TOT); LAS float* rmsp = (LAS float*)(lds + L_RMS);
    float lfr[16]; bf16 sqr[16], knr[16], vr[16];
    {
        float s = 0.f;
#pragma unroll
        for (int j = 0; j < 16; ++j) { const size_t row = (size_t)(rowb + 16 * tg + j); lfr[j] = lf[row * HW + cl]; knr[j] = zb[row * INC + ck]; vr[j] = zb[row * INC + cv]; if (FULL) sqr[j] = zb[row * INC + cq]; s += lfr[j]; }
        tot[tg * 128 + k] = s;
    }
    if (FULL) {
#pragma unroll
        for (int kt = 0; kt < 8; ++kt) {
            u32x2 w; w.x = cvt_pk_bf16(Sacc[kt][0], Sacc[kt][1]); w.y = cvt_pk_bf16(Sacc[kt][2], Sacc[kt][3]);
            *(LAS u32x2*)(lds + L_ST + (16 * wave + fr) * CQS + (16 * kt + 4 * fq) * 2) = w;
        }
    }
    __syncthreads();
    for (int c = 0; c < nsteps; ++c) {
        {
            float b = 0.f;
#pragma unroll
            for (int g = 0; g < 3; ++g) b += (g < tg) ? tot[g * 128 + k] : 0.f;
            unsigned ktp[8], vtp[8];
#pragma unroll
            for (int jp = 0; jp < 8; ++jp) {
                const int j0 = 2 * jp, j1 = j0 + 1, t0 = 16 * tg + j0;
                const float b0 = b + lfr[j0], b1 = b0 + lfr[j1]; b = b1;
                const unsigned kp = cvt_pk_bf16(bf2f(knr[j0]) * __builtin_amdgcn_exp2f(-b0), bf2f(knr[j1]) * __builtin_amdgcn_exp2f(-b1));
                ktp[jp] = kp; vtp[jp] = (unsigned)vr[j0] | ((unsigned)vr[j1] << 16);
                if (FULL) {
                    const unsigned qp = cvt_pk_bf16(bf2f(sqr[j0]) * __builtin_amdgcn_exp2f(b0), bf2f(sqr[j1]) * __builtin_amdgcn_exp2f(b1));
                    *(LAS bf16*)(lds + L_Q + t0 * CQS + k * 2) = (bf16)(qp & 0xffffu); *(LAS bf16*)(lds + L_Q + (t0 + 1) * CQS + k * 2) = (bf16)(qp >> 16);
                    *(LAS bf16*)(lds + L_K + t0 * CQS + k * 2) = (bf16)(kp & 0xffffu); *(LAS bf16*)(lds + L_K + (t0 + 1) * CQS + k * 2) = (bf16)(kp >> 16);
                }
            }
            *(LAS u32x4*)(lds + L_KT + k * CTS + tg * 32) = (u32x4){ktp[0], ktp[1], ktp[2], ktp[3]};
            *(LAS u32x4*)(lds + L_KT + k * CTS + tg * 32 + 16) = (u32x4){ktp[4], ktp[5], ktp[6], ktp[7]};
            *(LAS u32x4*)(lds + L_VT + k * CTS + tg * 32) = (u32x4){vtp[0], vtp[1], vtp[2], vtp[3]};
            *(LAS u32x4*)(lds + L_VT + k * CTS + tg * 32 + 16) = (u32x4){vtp[4], vtp[5], vtp[6], vtp[7]};
            if (tg == 3) { dS[k] = __builtin_amdgcn_exp2f(b); segsum += b; }
        }
        __syncthreads();
        u32x2 sgr[4];
        if (FULL) {
#pragma unroll
            for (int i = 0; i < 4; ++i) sgr[i] = *(const u32x2*)(zb + (size_t)(rowb + 64 * c + 16 * (wave & 3) + fr) * INC + PW + 3 * HW + h * HD + 16 * (4 * (wave >> 2) + i) + 4 * fq);
        }
        if (c + 1 < nsteps) {
#pragma unroll
            for (int j = 0; j < 16; ++j) { const size_t row = (size_t)(rowb + 64 * (c + 1) + 16 * tg + j); lfr[j] = lf[row * HW + cl]; knr[j] = zb[row * INC + ck]; vr[j] = zb[row * INC + cv]; if (FULL) sqr[j] = zb[row * INC + cq]; }
        }
        if (FULL) {
#pragma unroll
            for (int i = 0; i < 2; ++i) {
                const int ti = 2 * wave + i, tt = ti >> 2, st = ti & 3;
                f32x4 p = (f32x4){0.f, 0.f, 0.f, 0.f};
#pragma unroll
                for (int ks = 0; ks < 4; ++ks) {
                    const bf16x8 ka = *(const LAS bf16x8*)(lds + L_K + (16 * st + fr) * CQS + (32 * ks + 8 * fq) * 2);
                    const bf16x8 qb = *(const LAS bf16x8*)(lds + L_Q + (16 * tt + fr) * CQS + (32 * ks + 8 * fq) * 2);
                    p = __builtin_amdgcn_mfma_f32_16x16x32_bf16(ka, qb, p, 0, 0, 0);
                }
                const int t = 16 * tt + fr, s0 = 16 * st + 4 * fq;
                u32x2 w; w.x = cvt_pk_bf16(s0 + 0 <= t ? p[0] : 0.f, s0 + 1 <= t ? p[1] : 0.f); w.y = cvt_pk_bf16(s0 + 2 <= t ? p[2] : 0.f, s0 + 3 <= t ? p[3] : 0.f);
                *(LAS u32x2*)(lds + L_P + t * CTS + s0 * 2) = w;
            }
        }
        {
            bf16x8 vb[2];
#pragma unroll
            for (int ss = 0; ss < 2; ++ss) vb[ss] = *(const LAS bf16x8*)(lds + L_VT + (16 * wave + fr) * CTS + (32 * ss + 8 * fq) * 2);
#pragma unroll
            for (int kt = 0; kt < 8; ++kt)
#pragma unroll
                for (int ss = 0; ss < 2; ++ss) {
                    const bf16x8 ka = *(const LAS bf16x8*)(lds + L_KT + (16 * kt + fr) * CTS + (32 * ss + 8 * fq) * 2);
                    Sacc[kt] = __builtin_amdgcn_mfma_f32_16x16x32_bf16(ka, vb[ss], Sacc[kt], 0, 0, 0);
                }
        }
        const int tt = wave & 3, vh = wave >> 2;
        f32x4 o[4];
        if (FULL) {
            __syncthreads();
            bf16x8 pb[2], qb[4];
#pragma unroll
            for (int ss = 0; ss < 2; ++ss) pb[ss] = *(const LAS bf16x8*)(lds + L_P + (16 * tt + fr) * CTS + (32 * ss + 8 * fq) * 2);
#pragma unroll
            for (int ks = 0; ks < 4; ++ks) qb[ks] = *(const LAS bf16x8*)(lds + L_Q + (16 * tt + fr) * CQS + (32 * ks + 8 * fq) * 2);
#pragma unroll
            for (int i = 0; i < 4; ++i) {
                const int vrow = 16 * (4 * vh + i) + fr;
                f32x4 a = (f32x4){0.f, 0.f, 0.f, 0.f};
#pragma unroll
                for (int ss = 0; ss < 2; ++ss) a = __builtin_amdgcn_mfma_f32_16x16x32_bf16(*(const LAS bf16x8*)(lds + L_VT + vrow * CTS + (32 * ss + 8 * fq) * 2), pb[ss], a, 0, 0, 0);
#pragma unroll
                for (int ks = 0; ks < 4; ++ks) a = __builtin_amdgcn_mfma_f32_16x16x32_bf16(*(const LAS bf16x8*)(lds + L_ST + vrow * CQS + (32 * ks + 8 * fq) * 2), qb[ks], a, 0, 0, 0);
                o[i] = a;
            }
            float ss2 = 0.f;
#pragma unroll
            for (int i = 0; i < 4; ++i) ss2 += (o[i][0] * o[i][0] + o[i][1] * o[i][1]) + (o[i][2] * o[i][2] + o[i][3] * o[i][3]);
            ss2 += __shfl_xor(ss2, 16); ss2 += __shfl_xor(ss2, 32);
            if (fq == 0) rmsp[vh * 64 + 16 * tt + fr] = ss2;
        }
#pragma unroll
        for (int kt = 0; kt < 8; ++kt) Sacc[kt] = Sacc[kt] * *(const LAS f32x4*)(dS + 16 * kt + 4 * fq);
        if (c + 1 < nsteps) {
            float s = 0.f;
#pragma unroll
            for (int j = 0; j < 16; ++j) s += lfr[j];
            tot[tg * 128 + k] = s;
        }
        __syncthreads();
        if (FULL) {
            const int tl = 16 * tt + fr; const size_t row = (size_t)(rowb + 64 * c + tl);
            const float r = rsqrtf((rmsp[tl] + rmsp[64 + tl]) * (1.f / HD) + EPS);
#pragma unroll
            for (int i = 0; i < 4; ++i) {
                const int ch = h * HD + 16 * (4 * vh + i) + 4 * fq;
                const f32x4 gn = gnr[i];
                const u32x2 sg = sgr[i];
                const float g0 = __builtin_bit_cast(float, sg.x << 16), g1 = __builtin_bit_cast(float, sg.x & 0xffff0000u), g2 = __builtin_bit_cast(float, sg.y << 16), g3 = __builtin_bit_cast(float, sg.y & 0xffff0000u);
                u32x2 w; w.x = cvt_pk_bf16(o[i][0] * r * gn[0] * g0, o[i][1] * r * gn[1] * g1); w.y = cvt_pk_bf16(o[i][2] * r * gn[2] * g2, o[i][3] * r * gn[3] * g3);
                *(u32x2*)(mixb + row * D + PW + ch) = w;
            }
#pragma unroll
            for (int kt = 0; kt < 8; ++kt) {
                u32x2 w; w.x = cvt_pk_bf16(Sacc[kt][0], Sacc[kt][1]); w.y = cvt_pk_bf16(Sacc[kt][2], Sacc[kt][3]);
                *(LAS u32x2*)(lds + L_ST + (16 * wave + fr) * CQS + (16 * kt + 4 * fq) * 2) = w;
            }
        }
    }
    __syncthreads();
}

constexpr int CW_FLAG = 32768;
__device__ __forceinline__ void prompt_segment(LAS unsigned char* lds, const Args& a, int chain, int seg, int nseg) {
    unsigned char* ws = a.ws;
    const bf16* zb = (const bf16*)(ws + WS_ZB); const float* lf = (const float*)(ws + WS_LF); bf16* mixb = (bf16*)(ws + WS_MIX);
    const int tid = threadIdx.x, lane = tid & 63, wave = __builtin_amdgcn_readfirstlane(tid >> 6), fr = lane & 15, fq = lane >> 4, k = tid & 127, tg = tid >> 7;
    const int b = chain / NH, h = chain % NH, seglen = SEQ / nseg, nsteps = seglen / 64, rowb = b * SEQ + seg * seglen;
    f32x4* slab = (f32x4*)(ws + WS_XB);
    float* dseg = (float*)(ws + WS_XB + 16 * MiB);
    unsigned* flags = (unsigned*)(ws + WS_CTL) + CW_FLAG;
    f32x4 gnr[4];
#pragma unroll
    for (int i = 0; i < 4; ++i) gnr[i] = *(const f32x4*)(a.in[9] + h * HD + 16 * (4 * (wave >> 2) + i) + 4 * fq);
    f32x4 Sacc[8];
#pragma unroll
    for (int i = 0; i < 8; ++i) Sacc[i] = (f32x4){0.f, 0.f, 0.f, 0.f};
    float segsum = 0.f;
    if (seg + 1 < nseg) {
        seg_run<false>(lds, zb, lf, Sacc, segsum, gnr, mixb, rowb, nsteps, h);
        f32x4* my = slab + (size_t)(chain * 8 + seg) * 4096;
#pragma unroll
        for (int kt = 0; kt < 8; ++kt) my[kt * 512 + tid] = Sacc[kt];
        if (tg == 3) dseg[(chain * 8 + seg) * 128 + k] = __builtin_amdgcn_exp2f(segsum);
        asm volatile("s_waitcnt vmcnt(0)" ::: "memory");
        __syncthreads();
        if (tid == 0) { __builtin_amdgcn_fence(__ATOMIC_RELEASE, "agent"); asm volatile("s_waitcnt vmcnt(0)" ::: "memory"); __hip_atomic_store(flags + 64 * (chain * 8 + seg), 1u, __ATOMIC_RELAXED, __HIP_MEMORY_SCOPE_AGENT); }
#pragma unroll
        for (int i = 0; i < 8; ++i) Sacc[i] = (f32x4){0.f, 0.f, 0.f, 0.f};
        segsum = 0.f;
    }
    if (seg > 0) {
        if (tid < 64) {
            for (int i = 0; i < seg; ++i) { unsigned sp = 0; while (__hip_atomic_load(flags + 64 * (chain * 8 + i), __ATOMIC_RELAXED, __HIP_MEMORY_SCOPE_AGENT) == 0u && ++sp < (1u << 22)) __builtin_amdgcn_s_sleep(2); }
            __builtin_amdgcn_fence(__ATOMIC_ACQUIRE, "agent");
            asm volatile("s_waitcnt vmcnt(0)" ::: "memory");
        }
        __syncthreads();
        for (int i = 0; i < seg; ++i) {
            const f32x4* rec = slab + (size_t)(chain * 8 + i) * 4096; const float* dd = dseg + (chain * 8 + i) * 128;
#pragma unroll
            for (int kt = 0; kt < 8; ++kt) Sacc[kt] = Sacc[kt] * *(const f32x4*)(dd + 16 * kt + 4 * fq) + rec[kt * 512 + tid];
        }
    }
    seg_run<true>(lds, zb, lf, Sacc, segsum, gnr, mixb, rowb, nsteps, h);
    if (seg + 1 == nseg) {
        float* Sout = a.out + O_HSP + (size_t)chain * HD * HD;
#pragma unroll
        for (int kt = 0; kt < 8; ++kt)
#pragma unroll
            for (int j = 0; j < 4; ++j) Sout[(size_t)(16 * kt + 4 * fq + j) * HD + 16 * wave + fr] = Sacc[kt][j];
    }
}

__device__ __forceinline__ void phase2(LAS unsigned char* lds, const Args& a, int bid, int G) {
    unsigned char* ws = a.ws;
    const bf16* zb = (const bf16*)(ws + WS_ZB); const float* lf = (const float*)(ws + WS_LF); bf16* mixb = (bf16*)(ws + WS_MIX);
    constexpr int NPC = NB * NH, NSC = DB * NH, NPOOL = (M / 64) * 4;
    const int nseg = (G >= 8 * NPC) ? 8 : (G >= 4 * NPC ? 4 : (G >= 2 * NPC ? 2 : 1));
    if (nseg > 1) { if (bid < nseg * NPC) prompt_segment(lds, a, bid / nseg, bid % nseg, nseg); }
    else for (int c = bid; c < NPC; c += G) prompt_segment(lds, a, c, 0, 1);
    SampleRegs cur, nxt;
    if (bid < NSC) sample_load(cur, a.in[3] + (size_t)bid * HD * HD);
    for (int it = bid; it < NSC + NPOOL; it += G) {
        if (it < NSC) {
            const bool pf = it + G < NSC;
            if (pf) sample_load(nxt, a.in[3] + (size_t)(it + G) * HD * HD);
            sample_run(lds, cur, zb, lf, a.in[9], a.out + O_HSS + (size_t)it * HD * HD, mixb, MP + (it / NH) * DS, it % NH);
            if (pf) {
#pragma unroll
                for (int kk = 0; kk < 8; ++kk) cur.S[kk] = nxt.S[kk];
            }
        }
        else pool_item(lds, it - NSC, zb, a.in[2], (const bf16*)(ws + WS_WP), mixb);
    }
}

__device__ __forceinline__ void phase6(const Args& a, int vcu, int G) {
    const int tid = threadIdx.x, lane = tid & 63, wave = tid >> 6;
    const int gw = vcu * NWAVES + wave, NGW = G * NWAVES;
    const float* rsq3 = (const float*)(a.ws + WS_CTL) + CW_RSQ3;
    for (int m = gw; m < M; m += NGW) {
        float* yr = a.out + O_Y + (size_t)m * D;
        const float r = rsqrtf(rsq3[m] * (1.f / D) + EPS);
#pragma unroll
        for (int j = 0; j < 8; ++j) { const f32x4 v = ((const f32x4*)yr)[lane + 64 * j], g = ((const f32x4*)a.in[15])[lane + 64 * j]; ((f32x4*)yr)[lane + 64 * j] = v * r * g; }
    }
}

__global__ void __launch_bounds__(NWAVES * 64, 2) mega(Args a) {
    extern __shared__ __attribute__((aligned(16))) unsigned char lds_raw[];
    LAS unsigned char* lds = (LAS unsigned char*)lds_raw;
    const int G = gridDim.x, bid = blockIdx.x;
    const int vcu = (G % 8 == 0) ? (bid % 8) * (G / 8) + bid / 8 : bid;
    unsigned char* ws = a.ws;
    float* ctlf = (float*)(ws + WS_CTL);
    const int lo = a.ph_lo, hi = a.ph_hi;
#if ONE_LAUNCH && USE_CG
    cg::grid_group grid = cg::this_grid();
#define GRID_BAR() grid.sync()
#elif ONE_LAUNCH
    volatile LAS unsigned* MISC = (volatile LAS unsigned*)(lds + MISC_OFF);
    if (threadIdx.x < 32) MISC[threadIdx.x] = 0u;
    __syncthreads();
    XcdBarrier bar = xcd_barrier_post((unsigned*)(ws + WS_CTL) + CW_BAR, MISC + 8);
#define GRID_BAR() xcd_barrier(bar)
#else
#define GRID_BAR() do {} while (0)
#endif
#ifndef PH_MASK
#define PH_MASK 0x7f
#endif
#define IN(k) (((PH_MASK >> (k)) & 1) && lo <= (k) && (k) < hi)
#define BOTH(k) (IN(k) && IN((k) + 1))
#ifndef REP_MASK
#define REP_MASK 0
#endif
#define REP(k) ((REP_MASK >> (k)) & 1)
    if (IN(0)) { if (REP(0)) { phase0(lds, a, vcu, G); __syncthreads(); } phase0(lds, a, vcu, G); if (BOTH(0)) GRID_BAR(); }
    if (IN(1)) {
        pg8::Gemm g{(const bf16*)(ws + WS_XB), (const bf16*)(ws + WS_WIN), M, INC, D}; pg8::StaticOrder S; S.init(M, INC, G, bid);
        pg8::EpiZ E{(bf16*)(ws + WS_ZB), (float*)(ws + WS_LF), (const float*)(ws + WS_MISC), (const float*)(ws + WS_MISC) + M, a.out};
        if (REP(1)) pg8::gemm_phase<pg8::EpiZ, pg8::StaticOrder, true, true>(lds, g, S, E);
        pg8::gemm_phase<pg8::EpiZ, pg8::StaticOrder, true, true>(lds, g, S, E);
        if (BOTH(1)) GRID_BAR();
    }
    if (IN(2)) { if (REP(2)) { phase2(lds, a, bid, G); __syncthreads(); } phase2(lds, a, bid, G); if (BOTH(2)) GRID_BAR(); }
    if (IN(3)) {
        pg8::Gemm g{(const bf16*)(ws + WS_MIX), (const bf16*)(ws + WS_WO), M, D, D}; pg8::StaticOrder S; S.init(M, D, G, bid);
        if (REP(3)) { pg8::EpiX1<true> E0{a.in[0], a.in[1], a.out + O_Y, (bf16*)(ws + WS_XB), ctlf + CW_RSQ2}; pg8::gemm_phase<pg8::EpiX1<true>, pg8::StaticOrder, true, true>(lds, g, S, E0); }
        pg8::EpiX1<false> E{a.in[0], a.in[1], a.out + O_Y, (bf16*)(ws + WS_XB), ctlf + CW_RSQ2};
        pg8::gemm_phase<pg8::EpiX1<false>, pg8::StaticOrder, true, true>(lds, g, S, E);
        if (BOTH(3)) GRID_BAR();
    }
    if (IN(4)) {
        pg8::Gemm g{(const bf16*)(ws + WS_XB), (const bf16*)(ws + WS_WGU), M, 2 * DFF, D}; pg8::StaticOrder S; S.init(M, 2 * DFF, G, bid);
        pg8::EpiAct E{(bf16*)(ws + WS_ACT), ctlf + CW_RSQ2};
        if (REP(4)) pg8::gemm_phase<pg8::EpiAct, pg8::StaticOrder, true, true>(lds, g, S, E);
        pg8::gemm_phase<pg8::EpiAct, pg8::StaticOrder, true, true>(lds, g, S, E);
        if (BOTH(4)) GRID_BAR();
    }
    if (IN(5)) {
        pg8::Gemm g{(const bf16*)(ws + WS_ACT), (const bf16*)(ws + WS_WD), M, D, DFF}; pg8::StaticOrder S; S.init(M, D, G, bid);
        if (REP(5)) { pg8::EpiX2<true> E0{a.out + O_Y, ctlf + CW_RSQ3}; pg8::gemm_phase<pg8::EpiX2<true>, pg8::StaticOrder, true, true>(lds, g, S, E0); }
        pg8::EpiX2<false> E{a.out + O_Y, ctlf + CW_RSQ3};
        pg8::gemm_phase<pg8::EpiX2<false>, pg8::StaticOrder, true, true>(lds, g, S, E);
        if (BOTH(5)) GRID_BAR();
    }
    if (IN(6)) phase6(a, vcu, G);
#undef IN
#undef BOTH
}

extern "C" void kernel_launch(void* const* d_in, const int* in_sizes, int n_in, void* d_out, int out_size, void* d_ws, size_t ws_size, hipStream_t stream) {
    static int grid = 0;
    if (grid == 0) {
        if (n_in != 16 || ws_size < WS_END) { fprintf(stderr, "kernel_launch: unexpected n_in %d / ws_size %zu\n", n_in, ws_size); grid = -1; return; }
        int dev = 0, cus = 0, per_cu = 0;
        hipGetDevice(&dev);
        hipDeviceGetAttribute(&cus, hipDeviceAttributeMultiprocessorCount, dev);
        hipFuncSetAttribute((const void*)mega, hipFuncAttributeMaxDynamicSharedMemorySize, LDS_BYTES);
        hipOccupancyMaxActiveBlocksPerMultiprocessor(&per_cu, (const void*)mega, NWAVES * 64, LDS_BYTES);
        if (per_cu < 1) { fprintf(stderr, "kernel_launch: occupancy query says %d blocks per CU\n", per_cu); grid = -1; return; }
        grid = cus;
    }
    if (grid < 0) return;
    hipMemsetAsync((char*)d_ws + WS_CTL, 0, CTL_ZERO_BYTES, stream);
    Args a{};
    for (int i = 0; i < 16; ++i) a.in[i] = (const float*)d_in[i];
    a.out = (float*)d_out; a.ws = (unsigned char*)d_ws;
#if ONE_LAUNCH
    a.ph_lo = 0; a.ph_hi = NPHASE;
    void* args[] = {&a};
#if USE_CG
    hipError_t e = hipLaunchCooperativeKernel((const void*)mega, dim3(grid), dim3(NWAVES * 64), args, LDS_BYTES, stream);
    if (e != hipSuccess) fprintf(stderr, "cooperative launch failed: %s (grid %d)\n", hipGetErrorString(e), grid);
#else
    (void)args; hipLaunchKernelGGL(mega, dim3(grid), dim3(NWAVES * 64), LDS_BYTES, stream, a);
#endif
#else
    for (int p = 0; p < NPHASE; ++p) { a.ph_lo = p; a.ph_hi = p + 1; hipLaunchKernelGGL(mega, dim3(grid), dim3(NWAVES * 64), LDS_BYTES, stream, a); }
#endif
}
```

```cpp
#include <hip/hip_runtime.h>
#include <hip/hip_cooperative_groups.h>
#include <cstdio>
#include <cstdint>
namespace cg = cooperative_groups;

constexpr int D = 2048, NB = 4, SEQ = 2048, DB = 128, DS = 8;
constexpr int MP = NB * SEQ, MS = DB * DS, M = MP + MS;
constexpr int PW = 1024, HW = 1024, HD = 128, NH = 8, PC = 15;
constexpr int DFF = 5632, INC = 5120;
constexpr float EPS = 1e-6f;
constexpr size_t O_Y = 0;
constexpr size_t O_PSP = (size_t)M * D;
constexpr size_t O_HSP = O_PSP + (size_t)NB * PC * PW;
constexpr size_t O_PSS = O_HSP + (size_t)NB * NH * HD * HD;
constexpr size_t O_HSS = O_PSS + (size_t)DB * PC * PW;

namespace pg8 {
#define PG8_LAS __attribute__((address_space(3)))
typedef unsigned short bf16_t;
typedef short bf16x8 __attribute__((ext_vector_type(8)));
typedef float f32x4 __attribute__((ext_vector_type(4)));
typedef unsigned u32x4 __attribute__((ext_vector_type(4)));
constexpr int BM = 256, BK = 64, HALF = 128, HTB = HALF * BK * 2  , STAGE_BYTES = 8 * HTB, NXCD = 8, WGM = 8;

__host__ __device__ __forceinline__ int lds_byte(int r, int c) { const int st = (r >> 4) * 2 + (c >> 5), rr = r & 15, cc = c & 31, ob = rr * 64 + cc * 2; return st * 1024 + (ob ^ (((ob >> 9) & 1) << 5)); }
__host__ __device__ __forceinline__ void stage_rc(int b, int& R, int& C) { const int st = b / 1024, sb = b % 1024, swz = sb ^ (((sb >> 9) & 1) << 5); R = (st >> 1) * 16 + swz / 64; C = (st & 1) * 32 + (swz % 64) / 2; }
__host__ __device__ __forceinline__ int perm32(int rho) { const int n = rho >> 4, i = rho & 15; return 8 * (i >> 2) + 4 * n + (i & 3); }

struct Unit { int pm, pn, kb, nk, tinfo; };
struct Gemm { const bf16_t* A; const bf16_t* Bt; int M, N, K; };

struct StaticOrder {
    int nM, nN, nwg, G, c;
    __host__ __device__ void init(int M, int N, int G_, int c_) { nM = M / BM; nN = N / BM; nwg = nM * nN; G = G_; c = c_; }
    __host__ __device__ bool next(int i, Unit& u) const {
        const long L = (long)i * G + c; if (L >= nwg) return false;
        int wgid = (int)L; { const int q = nwg / NXCD, r = nwg % NXCD, xcd = wgid % NXCD, off = wgid / NXCD; wgid = (xcd < r ? xcd * (q + 1) : r * (q + 1) + (xcd - r) * q) + off; }
        const int nig = WGM * nN, gid = wgid / nig, fm = gid * WGM, gsz = (nM - fm) < WGM ? (nM - fm) : WGM;
        u.pm = fm + ((wgid % nig) % gsz); u.pn = (wgid % nig) / gsz; u.kb = 0; u.nk = 0; u.tinfo = -1; return true;
    }
    __device__ __forceinline__ void a_ready(const Unit&) const {}
    __device__ __forceinline__ void done(const Unit&) const {}
};
__device__ __forceinline__ unsigned cvt_pk_bf16(float lo, float hi) { unsigned r; asm volatile("v_cvt_pk_bf16_f32 %0, %1, %2" : "=v"(r) : "v"(lo), "v"(hi)); return r; }
__device__ __forceinline__ float sigm(float x) { return __builtin_amdgcn_rcpf(1.f + __expf(-x)); }
__device__ __forceinline__ float silu(float x) { return x * __builtin_amdgcn_rcpf(1.f + __expf(-x)); }
typedef unsigned u32x2 __attribute__((ext_vector_type(2)));

struct EpiZ {
    static constexpr bool PERM = true, AFTER_DRAIN = false;
    bf16_t* zb; float* lf; const float* rstd1; const float* lbv; float* out;
    __device__ __forceinline__ void operator()(const f32x4 (&acc)[2][2][4][2], const Unit& u, int wr, int wc, int fr, int fq, unsigned gmask = 0xffu) const {
        const int kind = u.pn >> 2;
        const int row0 = u.pm * BM + wr * 64 + fr;
        const int cc0 = (u.pn & 3) * 256 + wc * 32 + 8 * fq;
        f32x4 lb[2][2];
        if (kind == 2) {
#pragma unroll
            for (int bj = 0; bj < 2; ++bj)
#pragma unroll
                for (int n = 0; n < 2; ++n) lb[bj][n] = *(const f32x4*)(lbv + cc0 + bj * HALF + 4 * n);
        }
#pragma unroll
        for (int ai = 0; ai < 2; ++ai)
#pragma unroll
            for (int m = 0; m < 4; ++m) {
                if (!((gmask >> (ai * 4 + m)) & 1u)) continue;
                const int row = row0 + ai * HALF + m * 16;
                const float r = rstd1[row];
#pragma unroll
                for (int bj = 0; bj < 2; ++bj) {
                    const int cc = cc0 + bj * HALF;
                    f32x4 v0 = acc[ai][bj][m][0] * r, v1 = acc[ai][bj][m][1] * r;
                    if (kind == 2) {
                        f32x4 k0, k1;
#pragma unroll
                        for (int j = 0; j < 4; ++j) {
                            const float f0 = lb[bj][0][j] + (1.f - lb[bj][0][j]) * sigm(v0[j]), f1 = lb[bj][1][j] + (1.f - lb[bj][1][j]) * sigm(v1[j]);
                            v0[j] = __log2f(f0); v1[j] = __log2f(f1); k0[j] = 1.f - f0; k1[j] = 1.f - f1;
                        }
                        float* p = lf + (size_t)row * HW + cc;
                        *(f32x4*)p = v0; *(f32x4*)(p + 4) = v1;
                        u32x4 w; w.x = cvt_pk_bf16(k0[0], k0[1]); w.y = cvt_pk_bf16(k0[2], k0[3]); w.z = cvt_pk_bf16(k1[0], k1[1]); w.w = cvt_pk_bf16(k1[2], k1[3]);
                        *(u32x4*)(zb + (size_t)row * INC + 2 * 1024 + cc) = w;
                    } else {
                        if (kind == 0) {
                            float* dst = nullptr;
                            if (row >= MP) { const int ms = row - MP; dst = out + O_PSS + ((size_t)(ms >> 3) * PC + 7 + (ms & 7)) * PW + cc; }
                            else { const int t = row & (SEQ - 1); if (t >= SEQ - PC) dst = out + O_PSP + ((size_t)(row >> 11) * PC + (t - (SEQ - PC))) * PW + cc; }
                            if (dst) { *(f32x4*)dst = v0; *(f32x4*)(dst + 4) = v1; }
                        }
                        if (kind == 1 || kind == 4) {
#pragma unroll
                            for (int j = 0; j < 4; ++j) { v0[j] = silu(v0[j]); v1[j] = silu(v1[j]); }
                        }
                        u32x4 w; w.x = cvt_pk_bf16(v0[0], v0[1]); w.y = cvt_pk_bf16(v0[2], v0[3]); w.z = cvt_pk_bf16(v1[0], v1[1]); w.w = cvt_pk_bf16(v1[2], v1[3]);
                        *(u32x4*)(zb + (size_t)row * INC + kind * 1024 + cc) = w;
                    }
                }
            }
    }
};

template <bool DRY = false> struct EpiX1 {
    static constexpr bool PERM = false, AFTER_DRAIN = false;
    const float* xp; const float* xs; float* y; bf16_t* x1b; float* rowsq;
    __device__ __forceinline__ void operator()(const f32x4 (&acc)[2][2][4][2], const Unit& u, int wr, int wc, int fr, int fq, unsigned gmask = 0xffu) const {
        const int row0 = u.pm * BM + wr * 64 + fr, col0 = u.pn * BM + wc * 32 + 4 * fq;
#pragma unroll
        for (int ai = 0; ai < 2; ++ai)
#pragma unroll
            for (int m = 0; m < 4; ++m) {
                if (!((gmask >> (ai * 4 + m)) & 1u)) continue;
                const int row = row0 + ai * HALF + m * 16;
                const float* xr = (row < MP ? xp + (size_t)row * D : xs + (size_t)(row - MP) * D) + col0;
                float* yr = y + (size_t)row * D + col0; bf16_t* br = x1b + (size_t)row * D + col0;
                float s = 0.f;
#pragma unroll
                for (int bj = 0; bj < 2; ++bj)
#pragma unroll
                    for (int n = 0; n < 2; ++n) {
                        const f32x4 v = *(const f32x4*)(xr + bj * HALF + n * 16) + acc[ai][bj][m][n];
                        *(f32x4*)(yr + bj * HALF + n * 16) = v;
                        u32x2 w; w.x = cvt_pk_bf16(v[0], v[1]); w.y = cvt_pk_bf16(v[2], v[3]);
                        *(u32x2*)(br + bj * HALF + n * 16) = w;
                        s += (v[0] * v[0] + v[1] * v[1]) + (v[2] * v[2] + v[3] * v[3]);
                    }
                s += __shfl_xor(s, 16); s += __shfl_xor(s, 32);
                if (fq == 0 && !DRY) atomicAdd(rowsq + row, s);
            }
    }
};

struct EpiAct {
    static constexpr bool PERM = true, AFTER_DRAIN = false;
    bf16_t* act; const float* rowsq;
    __device__ __forceinline__ void operator()(const f32x4 (&acc)[2][2][4][2], const Unit& u, int wr, int wc, int fr, int fq, unsigned gmask = 0xffu) const {
        const int row0 = u.pm * BM + wr * 64 + fr, col0 = u.pn * HALF + wc * 32 + 8 * fq;
#pragma unroll
        for (int ai = 0; ai < 2; ++ai)
#pragma unroll
            for (int m = 0; m < 4; ++m) {
                if (!((gmask >> (ai * 4 + m)) & 1u)) continue;
                const int row = row0 + ai * HALF + m * 16;
                const float r = rsqrtf(rowsq[row] * (1.f / D) + EPS);
                u32x4 w; unsigned* wp = (unsigned*)&w;
#pragma unroll
                for (int n = 0; n < 2; ++n) {
                    const f32x4 g = acc[ai][0][m][n] * r, up = acc[ai][1][m][n] * r;
                    f32x4 a;
#pragma unroll
                    for (int j = 0; j < 4; ++j) a[j] = silu(g[j]) * up[j];
                    wp[2 * n] = cvt_pk_bf16(a[0], a[1]); wp[2 * n + 1] = cvt_pk_bf16(a[2], a[3]);
                }
                *(u32x4*)(act + (size_t)row * DFF + col0) = w;
            }
    }
};

template <bool DRY = false> struct EpiX2 {
    static constexpr bool PERM = false, AFTER_DRAIN = false;
    float* y; float* rowsq;
    __device__ __forceinline__ void operator()(const f32x4 (&acc)[2][2][4][2], const Unit& u, int wr, int wc, int fr, int fq, unsigned gmask = 0xffu) const {
        const int row0 = u.pm * BM + wr * 64 + fr, col0 = u.pn * BM + wc * 32 + 4 * fq;
#pragma unroll
        for (int ai = 0; ai < 2; ++ai)
#pragma unroll
            for (int m = 0; m < 4; ++m) {
                if (!((gmask >> (ai * 4 + m)) & 1u)) continue;
                const int row = row0 + ai * HALF + m * 16;
                float* yr = y + (size_t)row * D + col0;
                float s = 0.f;
#pragma unroll
                for (int bj = 0; bj < 2; ++bj)
#pragma unroll
                    for (int n = 0; n < 2; ++n) {
                        const f32x4 v = *(const f32x4*)(yr + bj * HALF + n * 16) + (DRY ? acc[ai][bj][m][n] * 0.f : acc[ai][bj][m][n]);
                        *(f32x4*)(yr + bj * HALF + n * 16) = v;
                        s += (v[0] * v[0] + v[1] * v[1]) + (v[2] * v[2] + v[3] * v[3]);
                    }
                s += __shfl_xor(s, 16); s += __shfl_xor(s, 32);
                if (fq == 0 && !DRY) atomicAdd(rowsq + row, s);
            }
    }
};
template <class Epi, class Sched, bool ALIGN_EPI = false, bool SP2 = false>
__device__ __forceinline__ void gemm_phase(PG8_LAS unsigned char* lds, const Gemm g, const Sched& S, const Epi& E) {
    int tid_ = threadIdx.x; asm volatile("" : "+v"(tid_));
    const int tid = tid_, wid = __builtin_amdgcn_readfirstlane(tid >> 6), lane = tid & 63, wr = wid >> 2, wc = wid & 3, fr = lane & 15, fq = lane >> 4;
    const int K = g.K, nt = K / BK;
    unsigned voffA[2], voffB[2];
#pragma unroll
    for (int i = 0; i < 2; ++i) { int R, C; stage_rc(tid * 16 + i * 8192, R, C); const int Rb = Epi::PERM ? ((R & ~31) + perm32(R & 31)) : R;
        voffA[i] = (unsigned)(R * K + C) * 2u; voffB[i] = (unsigned)(Rb * K + C) * 2u; }
    const size_t kstep = (size_t)(BK * 2);
    const size_t hstep = (size_t)HALF * K * 2;
    const size_t tstep = 2 * hstep;
    const unsigned ldsw = (unsigned)wid * 1024u;
    const int aoff = lds_byte(wr * 64 + fr, fq * 8), boff = lds_byte(wc * 32 + fr, fq * 8);
#define PG8_SA(b, h) (((b) * 2 + (h)) * HTB)
#define PG8_SB(b, h) ((4 + (b) * 2 + (h)) * HTB)
#define PG8_STAGE(bufoff, gbase, voff) do { _Pragma("unroll") for (int _i = 0; _i < 2; ++_i) \
        __builtin_amdgcn_global_load_lds((const unsigned*)((const char*)(gbase) + (voff)[_i]), (PG8_LAS unsigned*)(lds + (bufoff) + ldsw + _i * 8192), 16, 0, 0); } while (0)
#define PG8_LDA(dst, b, h) do { _Pragma("unroll") for (int m = 0; m < 4; ++m) _Pragma("unroll") for (int k = 0; k < 2; ++k) dst[m][k] = *(const PG8_LAS bf16x8*)(lds + PG8_SA(b, h) + aoff + m * 2048 + k * 1024); } while (0)
#define PG8_LDB(dst, b, h) do { _Pragma("unroll") for (int n = 0; n < 2; ++n) _Pragma("unroll") for (int k = 0; k < 2; ++k) dst[n][k] = *(const PG8_LAS bf16x8*)(lds + PG8_SB(b, h) + boff + n * 2048 + k * 1024); } while (0)
#define PG8_MMA(ai, bj, At, Bt) do { __builtin_amdgcn_s_setprio(1); _Pragma("unroll") for (int m = 0; m < 4; ++m) _Pragma("unroll") for (int n = 0; n < 2; ++n) _Pragma("unroll") for (int k = 0; k < 2; ++k) \
        acc[ai][bj][m][n] = __builtin_amdgcn_mfma_f32_16x16x32_bf16(Bt[n][k], At[m][k], acc[ai][bj][m][n], 0, 0, 0); __builtin_amdgcn_s_setprio(0); } while (0)
#define PG8_WAIT_V(n) asm volatile("s_waitcnt vmcnt(" #n ")" ::: "memory")
#define PG8_WAIT_L(n) asm volatile("s_waitcnt lgkmcnt(" #n ")" ::: "memory")
#define PG8_BAR __builtin_amdgcn_s_barrier()
#define PG8_SCHED __builtin_amdgcn_sched_barrier(0)
    Unit cur, nxt; int ui = 0;
    if (!S.next(0, cur)) return;
    f32x4 acc[2][2][4][2];
#pragma unroll
    for (int a = 0; a < 2; ++a)
#pragma unroll
        for (int b = 0; b < 2; ++b)
#pragma unroll
            for (int m = 0; m < 4; ++m)
#pragma unroll
                for (int n = 0; n < 2; ++n) acc[a][b][m][n] = (f32x4){0.f, 0.f, 0.f, 0.f};
    bf16x8 At[4][2], B0[2][2], B1[2][2];
    const char* cA = (const char*)g.A + (size_t)cur.pm * tstep; const char* cB = (const char*)g.Bt + (size_t)cur.pn * tstep;
    S.a_ready(cur);
    if constexpr (SP2) {
        PG8_STAGE(PG8_SB(0, 0), cB, voffB); PG8_STAGE(PG8_SB(0, 1), cB + hstep, voffB); PG8_STAGE(PG8_SA(0, 0), cA, voffA); PG8_STAGE(PG8_SA(0, 1), cA + hstep, voffA);
        if (wr == 1) PG8_BAR;
        PG8_WAIT_V(2); PG8_BAR;
        PG8_STAGE(PG8_SB(1, 0), cB + kstep, voffB); PG8_STAGE(PG8_SA(1, 0), cA + kstep, voffA); PG8_STAGE(PG8_SB(1, 1), cB + hstep + kstep, voffB);
        PG8_WAIT_V(6); PG8_BAR;
    } else {
        PG8_STAGE(PG8_SB(0, 0), cB, voffB); PG8_STAGE(PG8_SA(0, 0), cA, voffA); PG8_STAGE(PG8_SB(0, 1), cB + hstep, voffB); PG8_STAGE(PG8_SA(0, 1), cA + hstep, voffA);
        if (wr == 1) PG8_BAR;
        PG8_WAIT_V(4); PG8_BAR;
        PG8_STAGE(PG8_SB(1, 0), cB + kstep, voffB); PG8_STAGE(PG8_SA(1, 0), cA + kstep, voffA); PG8_STAGE(PG8_SB(1, 1), cB + hstep + kstep, voffB);
        PG8_WAIT_V(6); PG8_BAR;
    }
    for (;;) {
        const bool has_next = S.next(ui + 1, nxt);
        const char* nA = has_next ? (const char*)g.A + (size_t)nxt.pm * tstep : cA; const char* nB = has_next ? (const char*)g.Bt + (size_t)nxt.pn * tstep : cB;
        for (int t = 0; t < nt; t += 2) {
            const bool last = (t == nt - 2);
            const char* a1 = cA + (size_t)(t + 1) * kstep;
            const char* a2 = last ? nA : cA + (size_t)(t + 2) * kstep; const char* b2 = last ? nB : cB + (size_t)(t + 2) * kstep;
            const char* a3 = a2 + kstep; const char* b3 = b2 + kstep;
            if (last && has_next) S.a_ready(nxt);
            if constexpr (SP2) {
            PG8_LDB(B0, 0, 0); PG8_LDB(B1, 0, 1); PG8_SCHED; PG8_LDA(At, 0, 0); PG8_STAGE(PG8_SA(1, 1), a1 + hstep, voffA);
            PG8_WAIT_V(8); PG8_WAIT_L(0); PG8_BAR; PG8_MMA(0, 0, At, B0); PG8_MMA(0, 1, At, B1); PG8_BAR; PG8_SCHED;
            PG8_LDA(At, 0, 1); PG8_STAGE(PG8_SB(0, 0), b2, voffB); PG8_STAGE(PG8_SB(0, 1), b2 + hstep, voffB); PG8_STAGE(PG8_SA(0, 0), a2, voffA);
            PG8_WAIT_V(8); PG8_WAIT_L(0); PG8_BAR; PG8_MMA(1, 0, At, B0); PG8_MMA(1, 1, At, B1); PG8_BAR; PG8_SCHED;
            PG8_LDB(B0, 1, 0); PG8_LDB(B1, 1, 1); PG8_SCHED; PG8_LDA(At, 1, 0); PG8_STAGE(PG8_SA(0, 1), a2 + hstep, voffA);
            PG8_WAIT_V(8); PG8_WAIT_L(0); PG8_BAR; PG8_MMA(0, 0, At, B0); PG8_MMA(0, 1, At, B1); PG8_BAR; PG8_SCHED;
            PG8_LDA(At, 1, 1); PG8_STAGE(PG8_SB(1, 0), b3, voffB); PG8_STAGE(PG8_SB(1, 1), b3 + hstep, voffB); PG8_STAGE(PG8_SA(1, 0), a3, voffA);
            PG8_WAIT_V(8); PG8_WAIT_L(0); PG8_BAR; PG8_MMA(1, 0, At, B0); PG8_MMA(1, 1, At, B1); PG8_BAR; PG8_SCHED;
            } else {
            PG8_LDB(B0, 0, 0); PG8_SCHED; PG8_LDA(At, 0, 0); PG8_STAGE(PG8_SA(1, 1), a1 + hstep, voffA);
            PG8_WAIT_L(8); PG8_BAR; PG8_WAIT_L(0); PG8_MMA(0, 0, At, B0); PG8_BAR; PG8_SCHED;
            PG8_LDB(B1, 0, 1); PG8_STAGE(PG8_SB(0, 0), b2, voffB);
            PG8_BAR; PG8_WAIT_L(0); PG8_MMA(0, 1, At, B1); PG8_BAR;
            PG8_LDA(At, 0, 1); PG8_STAGE(PG8_SA(0, 0), a2, voffA);
            PG8_BAR; PG8_WAIT_L(0); PG8_MMA(1, 0, At, B0); PG8_BAR; PG8_SCHED;
            PG8_STAGE(PG8_SB(0, 1), b2 + hstep, voffB);
            PG8_WAIT_V(6); PG8_BAR; PG8_MMA(1, 1, At, B1); PG8_BAR;
            PG8_LDB(B0, 1, 0); PG8_SCHED; PG8_LDA(At, 1, 0); PG8_STAGE(PG8_SA(0, 1), a2 + hstep, voffA);
            PG8_WAIT_L(8); PG8_BAR; PG8_WAIT_L(0); PG8_MMA(0, 0, At, B0); PG8_BAR; PG8_SCHED;
            PG8_LDB(B1, 1, 1); PG8_STAGE(PG8_SB(1, 0), b3, voffB);
            PG8_BAR; PG8_WAIT_L(0); PG8_MMA(0, 1, At, B1); PG8_BAR;
            PG8_LDA(At, 1, 1); PG8_STAGE(PG8_SA(1, 0), a3, voffA);
            PG8_BAR; PG8_WAIT_L(0); PG8_MMA(1, 0, At, B0); PG8_BAR; PG8_SCHED;
            PG8_STAGE(PG8_SB(1, 1), b3 + hstep, voffB);
            PG8_WAIT_V(6); PG8_BAR; PG8_MMA(1, 1, At, B1); PG8_BAR;
            }
        }
        if constexpr (ALIGN_EPI) { if (wr == 0) PG8_BAR; }
        if constexpr (!Epi::AFTER_DRAIN) { E(acc, cur, wr, wc, fr, fq); S.done(cur); }
        if (!has_next) break;
#pragma unroll
        for (int a = 0; a < 2; ++a)
#pragma unroll
            for (int b = 0; b < 2; ++b)
#pragma unroll
                for (int m = 0; m < 4; ++m)
#pragma unroll
                    for (int n = 0; n < 2; ++n) acc[a][b][m][n] = (f32x4){0.f, 0.f, 0.f, 0.f};
        cur = nxt; cA = nA; cB = nB; ++ui;
        if constexpr (ALIGN_EPI) { if (wr == 1) PG8_BAR; }
    }
    PG8_WAIT_V(0);
    if constexpr (!ALIGN_EPI) { if (wr == 0) PG8_BAR; }
    PG8_BAR;
    if constexpr (Epi::AFTER_DRAIN) { E.fused(acc, cur, wr, wc, fr, fq, lds, wid, lane); S.done(cur); }
#undef PG8_SA
#undef PG8_SB
#undef PG8_STAGE
#undef PG8_LDA
#undef PG8_LDB
#undef PG8_MMA
#undef PG8_WAIT_V
#undef PG8_WAIT_L
#undef PG8_BAR
#undef PG8_SCHED
}

struct HybridOrder {
    int nM, nN, nwg, G, c, nt, nfull, R, ns;
    __device__ __forceinline__ void init(int M, int N, int K, int G_, int c_, bool allow_split) {
        nM = M / BM; nN = N / BM; nwg = nM * nN; G = G_; c = c_; nt = K / BK; nfull = nwg / G; R = nwg - nfull * G;
        ns = (allow_split && R > 0 && (R % 8) == 0 && (G % 8) == 0) ? G / R : 1; if (ns > 8) ns = 8; if (ns > nt / 2) ns = nt / 2; if (ns < 2) ns = 1;
    }
    __device__ __forceinline__ void map(int L, Unit& u) const {
        int wgid = L; { const int q = nwg / NXCD, r = nwg % NXCD, xcd = wgid % NXCD, off = wgid / NXCD; wgid = (xcd < r ? xcd * (q + 1) : r * (q + 1) + (xcd - r) * q) + off; }
        const int nig = WGM * nN, gid = wgid / nig, fm = gid * WGM, gsz = (nM - fm) < WGM ? (nM - fm) : WGM;
        u.pm = fm + ((wgid % nig) % gsz); u.pn = (wgid % nig) / gsz;
    }
    __device__ __forceinline__ bool next(int i, Unit& u) const {
        if (i < nfull) { map(i * G + c, u); u.kb = 0; u.nk = nt; u.tinfo = -1; return true; }
        if (i > nfull || R == 0) return false;
        if (ns < 2) { const int L = i * G + c; if (L >= nwg) return false; map(L, u); u.kb = 0; u.nk = nt; u.tinfo = -1; return true; }
        const int x = c % 8, y = c / 8, tj = (y / ns) * 8 + x, slice = y % ns;
        if (tj >= R) return false;
        map(nfull * G + tj, u);
        const int pairs = nt / 2, base = pairs / ns, rem = pairs % ns, start = slice * base + (slice < rem ? slice : rem), mine = base + (slice < rem ? 1 : 0);
        u.kb = 2 * start; u.nk = 2 * mine; u.tinfo = (tj << 8) | (slice << 4) | ns; return true;
    }
};
struct TailCtx { f32x4* slab; unsigned* cnt; };

template <class Epi>
__device__ __forceinline__ void tail_fixup(f32x4 (&acc)[2][2][4][2], const Unit& u, const Epi& E, const TailCtx& T, int tid, int wr, int wc, int fr, int fq) {
    const int tj = u.tinfo >> 8, slice = (u.tinfo >> 4) & 15, ns = u.tinfo & 15;
    f32x4* mine = T.slab + (size_t)(tj * ns + slice) * (32 * 512);
#pragma unroll
    for (int ai = 0; ai < 2; ++ai)
#pragma unroll
        for (int bj = 0; bj < 2; ++bj)
#pragma unroll
            for (int m = 0; m < 4; ++m)
#pragma unroll
                for (int n = 0; n < 2; ++n) mine[(((ai * 2 + bj) * 4 + m) * 2 + n) * 512 + tid] = acc[ai][bj][m][n];
    asm volatile("s_waitcnt vmcnt(0)" ::: "memory");
    __syncthreads();
    if (tid == 0) { __builtin_amdgcn_fence(__ATOMIC_RELEASE, "agent"); asm volatile("s_waitcnt vmcnt(0)" ::: "memory"); __hip_atomic_fetch_add(T.cnt + 64 * tj, 1u, __ATOMIC_RELAXED, __HIP_MEMORY_SCOPE_AGENT); }
    if (tid < 64) {
        unsigned sp = 0;
        while (__hip_atomic_load(T.cnt + 64 * tj, __ATOMIC_RELAXED, __HIP_MEMORY_SCOPE_AGENT) < (unsigned)ns && ++sp < (1u << 22)) __builtin_amdgcn_s_sleep(2);
        __builtin_amdgcn_fence(__ATOMIC_ACQUIRE, "agent");
        asm volatile("s_waitcnt vmcnt(0)" ::: "memory");
    }
    __syncthreads();
    unsigned gmask = 0u;
    for (int g = slice; g < 8; g += ns) gmask |= 1u << g;
    const f32x4* tile = T.slab + (size_t)(tj * ns) * (32 * 512);
#pragma unroll
    for (int ai = 0; ai < 2; ++ai)
#pragma unroll
        for (int m = 0; m < 4; ++m) {
            if (!((gmask >> (ai * 4 + m)) & 1u)) continue;
#pragma unroll
            for (int bj = 0; bj < 2; ++bj)
#pragma unroll
                for (int n = 0; n < 2; ++n) {
                    const int idx = ((ai * 2 + bj) * 4 + m) * 2 + n;
                    f32x4 v = tile[idx * 512 + tid];
                    for (int sl = 1; sl < ns; ++sl) v = v + tile[(size_t)sl * (32 * 512) + idx * 512 + tid];
                    acc[ai][bj][m][n] = v;
                }
        }
    E(acc, u, wr, wc, fr, fq, gmask);
}

template <class Epi, class Sched>
__device__ __forceinline__ void gemm_phase2(PG8_LAS unsigned char* lds, const Gemm g, const Sched& S, const Epi& E, const TailCtx& T) {
    int tid_ = threadIdx.x; asm volatile("" : "+v"(tid_));
    const int tid = tid_, wid = __builtin_amdgcn_readfirstlane(tid >> 6), lane = tid & 63, wr = wid >> 2, wc = wid & 3, fr = lane & 15, fq = lane >> 4;
    const int K = g.K;
    unsigned voffA[2], voffB[2];
#pragma unroll
    for (int i = 0; i < 2; ++i) { int R, C; stage_rc(tid * 16 + i * 8192, R, C); const int Rb = Epi::PERM ? ((R & ~31) + perm32(R & 31)) : R;
        voffA[i] = (unsigned)(R * K + C) * 2u; voffB[i] = (unsigned)(Rb * K + C) * 2u; }
    const size_t kstep = (size_t)(BK * 2), hstep = (size_t)HALF * K * 2, tstep = 2 * hstep;
    const unsigned ldsw = (unsigned)wid * 1024u;
    const int aoff = lds_byte(wr * 64 + fr, fq * 8), boff = lds_byte(wc * 32 + fr, fq * 8);
#define PG8_SA(b, h) (((b) * 2 + (h)) * HTB)
#define PG8_SB(b, h) ((4 + (b) * 2 + (h)) * HTB)
#define PG8_STAGE(bufoff, gbase, voff) do { _Pragma("unroll") for (int _i = 0; _i < 2; ++_i) \
        __builtin_amdgcn_global_load_lds((const unsigned*)((const char*)(gbase) + (voff)[_i]), (PG8_LAS unsigned*)(lds + (bufoff) + ldsw + _i * 8192), 16, 0, 0); } while (0)
#define PG8_LDA(dst, b, h) do { _Pragma("unroll") for (int m = 0; m < 4; ++m) _Pragma("unroll") for (int k = 0; k < 2; ++k) dst[m][k] = *(const PG8_LAS bf16x8*)(lds + PG8_SA(b, h) + aoff + m * 2048 + k * 1024); } while (0)
#define PG8_LDB(dst, b, h) do { _Pragma("unroll") for (int n = 0; n < 2; ++n) _Pragma("unroll") for (int k = 0; k < 2; ++k) dst[n][k] = *(const PG8_LAS bf16x8*)(lds + PG8_SB(b, h) + boff + n * 2048 + k * 1024); } while (0)
#define PG8_MMA(ai, bj, At, Bt) do { __builtin_amdgcn_s_setprio(1); _Pragma("unroll") for (int m = 0; m < 4; ++m) _Pragma("unroll") for (int n = 0; n < 2; ++n) _Pragma("unroll") for (int k = 0; k < 2; ++k) \
        acc[ai][bj][m][n] = __builtin_amdgcn_mfma_f32_16x16x32_bf16(Bt[n][k], At[m][k], acc[ai][bj][m][n], 0, 0, 0); __builtin_amdgcn_s_setprio(0); } while (0)
#define PG8_WAIT_V(n) asm volatile("s_waitcnt vmcnt(" #n ")" ::: "memory")
#define PG8_WAIT_L(n) asm volatile("s_waitcnt lgkmcnt(" #n ")" ::: "memory")
#define PG8_BAR __builtin_amdgcn_s_barrier()
#define PG8_SCHED __builtin_amdgcn_sched_barrier(0)
    Unit cur, nxt; int ui = 0;
    if (!S.next(0, cur)) return;
    f32x4 acc[2][2][4][2];
#pragma unroll
    for (int a = 0; a < 2; ++a)
#pragma unroll
        for (int b = 0; b < 2; ++b)
#pragma unroll
            for (int m = 0; m < 4; ++m)
#pragma unroll
                for (int n = 0; n < 2; ++n) acc[a][b][m][n] = (f32x4){0.f, 0.f, 0.f, 0.f};
    bf16x8 At[4][2], B0[2][2], B1[2][2];
    const char* cA = (const char*)g.A + (size_t)cur.pm * tstep + (size_t)cur.kb * kstep; const char* cB = (const char*)g.Bt + (size_t)cur.pn * tstep + (size_t)cur.kb * kstep;
    PG8_STAGE(PG8_SB(0, 0), cB, voffB); PG8_STAGE(PG8_SB(0, 1), cB + hstep, voffB); PG8_STAGE(PG8_SA(0, 0), cA, voffA); PG8_STAGE(PG8_SA(0, 1), cA + hstep, voffA);
    if (wr == 1) PG8_BAR;
    PG8_WAIT_V(2); PG8_BAR;
    PG8_STAGE(PG8_SB(1, 0), cB + kstep, voffB); PG8_STAGE(PG8_SA(1, 0), cA + kstep, voffA); PG8_STAGE(PG8_SB(1, 1), cB + hstep + kstep, voffB);
    PG8_WAIT_V(6); PG8_BAR;
    for (;;) {
        const bool has_next = S.next(ui + 1, nxt);
        const char* nA = has_next ? (const char*)g.A + (size_t)nxt.pm * tstep + (size_t)nxt.kb * kstep : cA; const char* nB = has_next ? (const char*)g.Bt + (size_t)nxt.pn * tstep + (size_t)nxt.kb * kstep : cB;
        const int nt = cur.nk;
        for (int t = 0; t < nt; t += 2) {
            const bool last = (t == nt - 2);
            const char* a1 = cA + (size_t)(t + 1) * kstep;
            const char* a2 = last ? nA : cA + (size_t)(t + 2) * kstep; const char* b2 = last ? nB : cB + (size_t)(t + 2) * kstep;
            const char* a3 = a2 + kstep; const char* b3 = b2 + kstep;
            PG8_LDB(B0, 0, 0); PG8_LDB(B1, 0, 1); PG8_SCHED; PG8_LDA(At, 0, 0); PG8_STAGE(PG8_SA(1, 1), a1 + hstep, voffA);
            PG8_WAIT_V(8); PG8_WAIT_L(0); PG8_BAR; PG8_MMA(0, 0, At, B0); PG8_MMA(0, 1, At, B1); PG8_BAR; PG8_SCHED;
            PG8_LDA(At, 0, 1); PG8_STAGE(PG8_SB(0, 0), b2, voffB); PG8_STAGE(PG8_SB(0, 1), b2 + hstep, voffB); PG8_STAGE(PG8_SA(0, 0), a2, voffA);
            PG8_WAIT_V(8); PG8_WAIT_L(0); PG8_BAR; PG8_MMA(1, 0, At, B0); PG8_MMA(1, 1, At, B1); PG8_BAR; PG8_SCHED;
            PG8_LDB(B0, 1, 0); PG8_LDB(B1, 1, 1); PG8_SCHED; PG8_LDA(At, 1, 0); PG8_STAGE(PG8_SA(0, 1), a2 + hstep, voffA);
            PG8_WAIT_V(8); PG8_WAIT_L(0); PG8_BAR; PG8_MMA(0, 0, At, B0); PG8_MMA(0, 1, At, B1); PG8_BAR; PG8_SCHED;
            PG8_LDA(At, 1, 1); PG8_STAGE(PG8_SB(1, 0), b3, voffB); PG8_STAGE(PG8_SB(1, 1), b3 + hstep, voffB); PG8_STAGE(PG8_SA(1, 0), a3, voffA);
            PG8_WAIT_V(8); PG8_WAIT_L(0); PG8_BAR; PG8_MMA(1, 0, At, B0); PG8_MMA(1, 1, At, B1); PG8_BAR; PG8_SCHED;
        }
        if (wr == 0) PG8_BAR;
        if (cur.tinfo < 0) E(acc, cur, wr, wc, fr, fq);
        if (!has_next) break;
#pragma unroll
        for (int a = 0; a < 2; ++a)
#pragma unroll
            for (int b = 0; b < 2; ++b)
#pragma unroll
                for (int m = 0; m < 4; ++m)
#pragma unroll
                    for (int n = 0; n < 2; ++n) acc[a][b][m][n] = (f32x4){0.f, 0.f, 0.f, 0.f};
        cur = nxt; cA = nA; cB = nB; ++ui;
        if (wr == 1) PG8_BAR;
    }
    PG8_WAIT_V(0);
    PG8_BAR;
    if (cur.tinfo >= 0) tail_fixup(acc, cur, E, T, tid, wr, wc, fr, fq);
#undef PG8_SA
#undef PG8_SB
#undef PG8_STAGE
#undef PG8_LDA
#undef PG8_LDB
#undef PG8_MMA
#undef PG8_WAIT_V
#undef PG8_WAIT_L
#undef PG8_BAR
#undef PG8_SCHED
}
}
#define LAS __attribute__((address_space(3)))
typedef unsigned short bf16;
using pg8::f32x4; using pg8::u32x4; using pg8::u32x2; using pg8::bf16x8; using pg8::cvt_pk_bf16;

#ifndef ONE_LAUNCH
#define ONE_LAUNCH 1
#endif
constexpr int NWAVES = 8, NPHASE = 7;
constexpr int LDS_BYTES = 147456;
constexpr size_t MiB = 1u << 20;
constexpr size_t WS_CTL = 0, CTL_ZERO_BYTES = 1 * MiB;
constexpr size_t WS_WIN = 1 * MiB;
constexpr size_t WS_WO = 21 * MiB;
constexpr size_t WS_WGU = 29 * MiB;
constexpr size_t WS_WD = 73 * MiB;
constexpr size_t WS_WP = 95 * MiB;
constexpr size_t WS_MISC = 96 * MiB;
constexpr size_t WS_XB = 97 * MiB;
constexpr size_t WS_ZB = 133 * MiB;
constexpr size_t WS_LF = 223 * MiB;
constexpr size_t WS_ACT = WS_ZB;
constexpr size_t WS_MIX = 259 * MiB;
constexpr size_t WS_END = 296 * MiB;
constexpr int CW_RSQ2 = 4096, CW_RSQ3 = 4096 + M;
constexpr int CW_TAIL = 100000;
constexpr size_t WS_SLAB3 = WS_ACT, WS_SLAB45 = 232 * MiB;
constexpr int CW_BAR = 65536;
constexpr int MISC_OFF = 147456 - 256;
#ifndef USE_CG
#define USE_CG 0
#endif

__device__ __forceinline__ float wave_sum(float v) {
#pragma unroll
    for (int o = 1; o < 64; o <<= 1) v += __shfl_xor(v, o);
    return v;
}
__device__ __forceinline__ float bf2f(bf16 b) { return __builtin_bit_cast(float, (unsigned)b << 16); }
__device__ __forceinline__ bf16 f2bf(float f) { unsigned u = __builtin_bit_cast(unsigned, f); return (bf16)((u + 0x7fffu + ((u >> 16) & 1u)) >> 16); }

#define XB_TMO      128
#define XB_XCNT(j)  (256  + 64 * (j))
#define XB_XSUB(j)  (1280 + 64 * (j))
#define XB_XGEN(j)  (2304 + 64 * (j))
#define XB_TOP      3328
#define XB_TOPGEN   3392
#define XCD_BAR_WORDS 3456
#define XB_SPIN_CAP (1u << 18)

__device__ __forceinline__ unsigned xb_ld(unsigned* p)              { return __hip_atomic_load(p, __ATOMIC_RELAXED, __HIP_MEMORY_SCOPE_AGENT); }
__device__ __forceinline__ unsigned xb_add(unsigned* p, unsigned v) { return __hip_atomic_fetch_add(p, v, __ATOMIC_RELAXED, __HIP_MEMORY_SCOPE_AGENT); }
__device__ __forceinline__ unsigned xb_xcc_id() { return (unsigned)__builtin_amdgcn_s_getreg((3 << 11) | 20) & 0xFu; }
#define XB_SPIN(cond, bar) do { unsigned _sp = 0; while (cond) { __builtin_amdgcn_s_sleep(1); \
    if ((++_sp & 255u) == 0u) { if (xb_ld(&(bar)[XB_TMO])) break; if (_sp > XB_SPIN_CAP) { atomicAdd(&(bar)[XB_TMO], 1u); break; } } } } while (0)

struct XcdBarrier {
    unsigned* bar; unsigned x;
    volatile LAS unsigned* st;
};

__device__ __forceinline__ XcdBarrier xcd_barrier_post(unsigned* bar, volatile LAS unsigned* st) {
    XcdBarrier b; b.bar = bar; b.x = xb_xcc_id(); b.st = st;
    if (threadIdx.x == 0) (void)xb_add(&bar[XB_XCNT(b.x)], 1u);
    return b;
}
__device__ __forceinline__ void xcd_barrier_complete(unsigned* bar, unsigned x, unsigned& nloc, unsigned& nx) {
    const unsigned G = gridDim.x * gridDim.y * gridDim.z;
    unsigned sum, cnt, mine, sp = 0u;
    for (;;) {
        sum = 0u; cnt = 0u; mine = 0u;
#pragma unroll
        for (unsigned j = 0; j < 16; ++j) { const unsigned c = xb_ld(&bar[XB_XCNT(j)]); sum += c; cnt += (c > 0u) ? 1u : 0u; mine = (j == x) ? c : mine; }
        if (sum == G) break;
        __builtin_amdgcn_s_sleep(1);
        if ((++sp & 255u) == 0u) { if (xb_ld(&bar[XB_TMO])) break; if (sp > XB_SPIN_CAP) { atomicAdd(&bar[XB_TMO], 1u); break; } }
    }
    nloc = mine > 0u ? mine : 1u; nx = cnt > 0u ? cnt : 1u;
}

__device__ __forceinline__ void xcd_barrier(const XcdBarrier& b) {
    asm volatile("s_waitcnt vmcnt(0)" ::: "memory");
    __syncthreads();
    if (threadIdx.x == 0) {
        unsigned* bar = b.bar;
        __builtin_amdgcn_s_waitcnt(0);
        unsigned nloc = b.st[0], nx = b.st[1];
        if (nloc == 0u) { xcd_barrier_complete(bar, b.x, nloc, nx); b.st[0] = nloc; b.st[1] = nx; }
        const unsigned old = xb_add(&bar[XB_XSUB(b.x)], 1u);
        const unsigned gen = old / nloc;
        if (old + 1u == (gen + 1u) * nloc) {
            __builtin_amdgcn_fence(__ATOMIC_RELEASE, "agent");
            asm volatile("s_waitcnt vmcnt(0)" ::: "memory");
            const unsigned og = xb_add(&bar[XB_TOP], 1u);
            const unsigned tg = og / nx;
            if (og + 1u == (tg + 1u) * nx) xb_add(&bar[XB_TOPGEN], 1u);
            else XB_SPIN(xb_ld(&bar[XB_TOPGEN]) == tg, bar);
            __builtin_amdgcn_fence(__ATOMIC_ACQUIRE, "agent");
            xb_add(&bar[XB_XGEN(b.x)], 1u);
            asm volatile("s_waitcnt vmcnt(0)" ::: "memory");
        } else {
            XB_SPIN(xb_ld(&bar[XB_XGEN(b.x)]) == gen, bar);
            __builtin_amdgcn_fence(__ATOMIC_ACQUIRE, "agent");
            asm volatile("s_waitcnt vmcnt(0)" ::: "memory");
        }
    }
    __syncthreads();
}

struct Args { const float* in[16]; float* out; unsigned char* ws; int ph_lo, ph_hi; };

__device__ __forceinline__ void p0_item(const float* W, int K, int N, bf16* WT, int mode, const float* sk, const float* sn, LAS float* scr, int item, int lane) {
    const int nblk = N / 64, kb = item / nblk, nb = item % nblk, k0 = 64 * kb, n0 = 64 * nb;
    const int drow0 = mode == 0 ? n0 : ((n0 >> 7) * 256 + (n0 & 127) + (mode == 2 ? 128 : 0));
    const int r = lane >> 4, c4 = lane & 15;
    f32x4 v[16];
#pragma unroll
    for (int i = 0; i < 16; ++i) v[i] = *(const f32x4*)(W + (size_t)(k0 + 4 * i + r) * N + n0 + 4 * c4);
    if (sk) {
#pragma unroll
        for (int i = 0; i < 16; ++i) v[i] = v[i] * sk[k0 + 4 * i + r];
    }
#pragma unroll
    for (int i = 0; i < 16; ++i) { LAS float* d = scr + (4 * i + r) * 65 + 4 * c4; d[0] = v[i][0]; d[1] = v[i][1]; d[2] = v[i][2]; d[3] = v[i][3]; }
    asm volatile("s_waitcnt lgkmcnt(0)" ::: "memory");
    const int c = lane & 7, nn = lane >> 3;
#pragma unroll
    for (int j = 0; j < 8; ++j) { const int n = nn + 8 * j; const LAS float* s = scr + (8 * c) * 65 + n; const float f = sn ? sn[n0 + n] : 1.f;
        u32x4 o; o.x = cvt_pk_bf16(s[0 * 65] * f, s[1 * 65] * f); o.y = cvt_pk_bf16(s[2 * 65] * f, s[3 * 65] * f); o.z = cvt_pk_bf16(s[4 * 65] * f, s[5 * 65] * f); o.w = cvt_pk_bf16(s[6 * 65] * f, s[7 * 65] * f);
        *(u32x4*)(WT + (size_t)(drow0 + n) * K + k0 + 8 * c) = o; }
    asm volatile("s_waitcnt lgkmcnt(0)" ::: "memory");
}

__device__ __forceinline__ void phase0(LAS unsigned char* lds, const Args& a, int vcu, int G) {
    const int tid = threadIdx.x, lane = tid & 63, wave = tid >> 6;
    unsigned char* ws = a.ws;
    LAS float* scr = (LAS float*)(lds + wave * 16640);
    const int gw = vcu * NWAVES + wave, NGW = G * NWAVES;
    constexpr int I_IN = (D / 64) * (INC / 64), I_O = (D / 64) * (D / 64), I_G = (D / 64) * (DFF / 64), I_D = (DFF / 64) * (D / 64), I_P = (256 / 64) * (256 / 64);
    constexpr int NITEMS = I_IN + I_O + 2 * I_G + I_D + 4 * I_P;
    for (int it = gw; it < NITEMS; it += NGW) {
        int r = it;
        if (r < I_IN) { p0_item(a.in[6], D, INC, (bf16*)(ws + WS_WIN), 0, a.in[5], nullptr, scr, r, lane); continue; } r -= I_IN;
        if (r < I_O) { p0_item(a.in[10], D, D, (bf16*)(ws + WS_WO), 0, nullptr, nullptr, scr, r, lane); continue; } r -= I_O;
        if (r < I_G) { p0_item(a.in[12], D, DFF, (bf16*)(ws + WS_WGU), 1, a.in[11], nullptr, scr, r, lane); continue; } r -= I_G;
        if (r < I_G) { p0_item(a.in[13], D, DFF, (bf16*)(ws + WS_WGU), 2, a.in[11], nullptr, scr, r, lane); continue; } r -= I_G;
        if (r < I_D) { p0_item(a.in[14], DFF, D, (bf16*)(ws + WS_WD), 0, nullptr, nullptr, scr, r, lane); continue; } r -= I_D;
        { const int g = r / I_P; p0_item(a.in[7] + (size_t)g * 65536, 256, 256, (bf16*)(ws + WS_WP) + (size_t)g * 65536, 0, nullptr, a.in[8] + g * 256, scr, r % I_P, lane); }
    }
    float* rstd1 = (float*)(ws + WS_MISC); bf16* xb = (bf16*)(ws + WS_XB);
    for (int m = gw; m < M; m += NGW) {
        const float* xrow = m < MP ? a.in[0] + (size_t)m * D : a.in[1] + (size_t)(m - MP) * D;
        f32x4 v[8]; float s = 0.f;
#pragma unroll
        for (int j = 0; j < 8; ++j) { v[j] = ((const f32x4*)xrow)[lane + 64 * j]; s += (v[j][0] * v[j][0] + v[j][1] * v[j][1]) + (v[j][2] * v[j][2] + v[j][3] * v[j][3]); }
        s = wave_sum(s);
        if (lane == 0) rstd1[m] = rsqrtf(s * (1.f / D) + EPS);
#pragma unroll
        for (int j = 0; j < 8; ++j) { u32x2 w; w.x = cvt_pk_bf16(v[j][0], v[j][1]); w.y = cvt_pk_bf16(v[j][2], v[j][3]); ((u32x2*)(xb + (size_t)m * D))[lane + 64 * j] = w; }
    }
    const int gt = vcu * (NWAVES * 64) + tid, NGT = G * NWAVES * 64;
    float* lbv = (float*)(ws + WS_MISC) + M;
    for (int c = gt; c < HW; c += NGT) lbv[c] = 1.f / (1.f + __expf(a.in[4][HW + c] - a.in[4][c]));
    for (int i = gt; i < DB * 7 * PW; i += NGT) { const int b = i / (7 * PW), rem = i % (7 * PW); a.out[O_PSS + (size_t)b * PC * PW + rem] = a.in[2][(size_t)b * PC * PW + 8 * PW + rem]; }
}

template <int W>
__device__ __forceinline__ void pool_fill(LAS bf16* A, int m0, int g, const bf16* zb, const float* cache) {
    const int tid = threadIdx.x, c = tid & 255, rh = tid >> 8;
    constexpr int LDA = 264;
    const int col = g * 256 + c;
    if (m0 < MP) {
        const int mb = m0 + rh * 32 - 15, tb = (m0 & (SEQ - 1)) + rh * 32 - 15;
        float ur[47];
#pragma unroll
        for (int i = 0; i < 47; ++i) ur[i] = (tb + i >= 0) ? bf2f(zb[(size_t)(mb + i) * INC + col]) : 0.f;
        float s = 0.f;
#pragma unroll
        for (int j = 1; j < W; ++j) s += ur[15 - j];
#pragma unroll
        for (int r = 0; r < 32; ++r) {
            s += ur[15 + r];
            const int t = tb + 15 + r;
            const float cnt = (float)min(t + 1, W);
            A[(rh * 32 + r) * LDA + c] = f2bf(s / cnt - ur[15 + r]);
            s -= ur[15 + r - (W - 1)];
        }
    } else {
#pragma unroll 1
        for (int bb = 0; bb < 4; ++bb) {
            const int r0 = rh * 32 + bb * 8, m = m0 + r0, b = (m - MP) >> 3;
            float hs[23];
#pragma unroll
            for (int i = 0; i < 15; ++i) hs[i] = cache[((size_t)b * PC + i) * PW + col];
#pragma unroll
            for (int i = 0; i < 8; ++i) hs[15 + i] = bf2f(zb[(size_t)(m + i) * INC + col]);
            float s = 0.f;
#pragma unroll
            for (int j = 1; j < W; ++j) s += hs[15 - j];
#pragma unroll
            for (int t = 0; t < 8; ++t) {
                s += hs[15 + t];
                A[(r0 + t) * LDA + c] = f2bf(s * (1.f / W) - hs[15 + t]);
                s -= hs[15 + t - (W - 1)];
            }
        }
    }
}
__device__ __forceinline__ void pool_item(LAS unsigned char* lds, int item, const bf16* zb, const float* cache, const bf16* WpT, bf16* mixb) {
    const int tile = item >> 2, g = item & 3, m0 = tile * 64;
    const int tid = threadIdx.x;
    constexpr int LDA = 264;
    LAS bf16* A = (LAS bf16*)lds;
    if (g == 0) pool_fill<2>(A, m0, g, zb, cache); else if (g == 1) pool_fill<4>(A, m0, g, zb, cache); else if (g == 2) pool_fill<8>(A, m0, g, zb, cache); else pool_fill<16>(A, m0, g, zb, cache);
    __syncthreads();
    const int wave = tid >> 6, lane = tid & 63, fr = lane & 15, fq = lane >> 4, n0 = wave * 32;
    f32x4 acc[4][2];
#pragma unroll
    for (int i = 0; i < 4; ++i)
#pragma unroll
        for (int j = 0; j < 2; ++j) acc[i][j] = (f32x4){0.f, 0.f, 0.f, 0.f};
#pragma unroll 2
    for (int ks = 0; ks < 8; ++ks) {
        bf16x8 wf[2], af[4];
#pragma unroll
        for (int nt = 0; nt < 2; ++nt) wf[nt] = *(const bf16x8*)(WpT + (size_t)(g * 256 + n0 + nt * 16 + fr) * 256 + ks * 32 + fq * 8);
#pragma unroll
        for (int mt = 0; mt < 4; ++mt) af[mt] = *(const LAS bf16x8*)(A + (mt * 16 + fr) * LDA + ks * 32 + fq * 8);
#pragma unroll
        for (int mt = 0; mt < 4; ++mt)
#pragma unroll
            for (int nt = 0; nt < 2; ++nt) acc[mt][nt] = __builtin_amdgcn_mfma_f32_16x16x32_bf16(wf[nt], af[mt], acc[mt][nt], 0, 0, 0);
    }
#pragma unroll
    for (int mt = 0; mt < 4; ++mt)
#pragma unroll
        for (int nt = 0; nt < 2; ++nt) {
            u32x2 o; o.x = cvt_pk_bf16(acc[mt][nt][0], acc[mt][nt][1]); o.y = cvt_pk_bf16(acc[mt][nt][2], acc[mt][nt][3]);
            *(u32x2*)(mixb + (size_t)(m0 + mt * 16 + fr) * D + g * 256 + n0 + nt * 16 + 4 * fq) = o;
        }
    __syncthreads();
}

struct SampleRegs { f32x4 S[8]; };
__device__ __forceinline__ void sample_load(SampleRegs& R, const float* S0) {
    const int tid = threadIdx.x, v4 = tid & 31, kq = tid >> 5;
#pragma unroll
    for (int kk = 0; kk < 8; ++kk) R.S[kk] = *(const f32x4*)(S0 + (size_t)(kq * 8 + kk) * HD + 4 * v4);
}
__device__ __forceinline__ void sample_run(LAS unsigned char* lds, SampleRegs& R, const bf16* zb, const float* lf, const float* hgn, float* Sout, bf16* mixb, int row0, int h) {
    const int tid = threadIdx.x, v4 = tid & 31, kq = tid >> 5, wave = tid >> 6, lane = tid & 63;
    LAS float* sq = (LAS float*)lds; LAS float* sf = sq + 1024; LAS float* sk = sf + 1024; LAS float* sv = sk + 1024; LAS float* red = sv + 1024;
    for (int i = tid; i < 1024; i += 512) {
        const int t = i >> 7, ch = i & 127; const size_t row = (size_t)(row0 + t);
        const float f = __builtin_amdgcn_exp2f(lf[row * HW + h * HD + ch]);
        sq[i] = bf2f(zb[row * INC + PW + h * HD + ch]); sf[i] = f; sk[i] = 1.f - f; sv[i] = bf2f(zb[row * INC + PW + 2 * HW + h * HD + ch]);
    }
    __syncthreads();
#pragma unroll 1
    for (int t = 0; t < 8; ++t) {
        const f32x4 vt = *(const LAS f32x4*)(sv + t * 128 + 4 * v4);
        f32x4 o = (f32x4){0.f, 0.f, 0.f, 0.f};
        const f32x4 f0 = *(const LAS f32x4*)(sf + t * 128 + kq * 8), f1 = *(const LAS f32x4*)(sf + t * 128 + kq * 8 + 4);
        const f32x4 k0 = *(const LAS f32x4*)(sk + t * 128 + kq * 8), k1 = *(const LAS f32x4*)(sk + t * 128 + kq * 8 + 4);
        const f32x4 q0 = *(const LAS f32x4*)(sq + t * 128 + kq * 8), q1 = *(const LAS f32x4*)(sq + t * 128 + kq * 8 + 4);
#pragma unroll
        for (int kk = 0; kk < 8; ++kk) {
            const float f = kk < 4 ? f0[kk & 3] : f1[kk & 3], kn = kk < 4 ? k0[kk & 3] : k1[kk & 3], q = kk < 4 ? q0[kk & 3] : q1[kk & 3];
            R.S[kk] = R.S[kk] * f + vt * kn;
            o = o + R.S[kk] * q;
        }
#pragma unroll
        for (int j = 0; j < 4; ++j) o[j] += __shfl_xor(o[j], 32);
        if (lane < 32) *(LAS f32x4*)(red + (wave * 8 + t) * 128 + 4 * v4) = o;
    }
#pragma unroll
    for (int kk = 0; kk < 8; ++kk) *(f32x4*)(Sout + (size_t)(kq * 8 + kk) * HD + 4 * v4) = R.S[kk];
    __syncthreads();
    {
        const int t = wave; const size_t row = (size_t)(row0 + t);
        float o0 = 0.f, o1 = 0.f;
#pragma unroll
        for (int w8 = 0; w8 < 8; ++w8) { o0 += red[(w8 * 8 + t) * 128 + lane]; o1 += red[(w8 * 8 + t) * 128 + lane + 64]; }
        const float ss = wave_sum(o0 * o0 + o1 * o1), r = rsqrtf(ss * (1.f / HD) + EPS);
        const int ch0 = h * HD + lane, ch1 = ch0 + 64;
        mixb[row * D + PW + ch0] = f2bf(o0 * r * hgn[ch0] * bf2f(zb[row * INC + PW + 3 * HW + ch0]));
        mixb[row * D + PW + ch1] = f2bf(o1 * r * hgn[ch1] * bf2f(zb[row * INC + PW + 3 * HW + ch1]));
    }
    __syncthreads();
}

constexpr int CQS = 272, CTS = 144;
constexpr int L_Q = 0, L_K = L_Q + 64 * CQS, L_KT = L_K + 64 * CQS, L_VT = L_KT + 128 * CTS, L_ST = L_VT + 128 * CTS, L_P = L_ST + 128 * CQS,
              L_DS = L_P + 64 * CTS, L_TOT = L_DS + 512, L_RMS = L_TOT + 2048, L_CHAIN_END = L_RMS + 512;
static_assert(L_CHAIN_END <= 131072, "chain LDS");
template <bool FULL>
__device__ __forceinline__ void seg_run(LAS unsigned char* lds, const bf16* zb, const float* lf, f32x4 (&Sacc)[8], float& segsum, const f32x4 (&gnr)[4], bf16* mixb, int rowb, int nsteps, int h) {
    const int tid = threadIdx.x, lane = tid & 63, wave = __builtin_amdgcn_readfirstlane(tid >> 6), fr = lane & 15, fq = lane >> 4;
    const int k = tid & 127, tg = tid >> 7;
    const size_t cq = PW + h * HD + k, ck = PW + HW + h * HD + k, cv = PW + 2 * HW + h * HD + k, cl = h * HD + k;
    LAS float* dS = (LAS float*)(lds + L_DS); LAS float* tot = (LAS float*)(lds + L_TOT); LAS float* rmsp = (LAS float*)(lds + L_RMS);
    float lfr[16]; bf16 sqr[16], knr[16], vr[16];
    {
        float s = 0.f;
#pragma unroll
        for (int j = 0; j < 16; ++j) { const size_t row = (size_t)(rowb + 16 * tg + j); lfr[j] = lf[row * HW + cl]; knr[j] = zb[row * INC + ck]; vr[j] = zb[row * INC + cv]; if (FULL) sqr[j] = zb[row * INC + cq]; s += lfr[j]; }
        tot[tg * 128 + k] = s;
    }
    if (FULL) {
#pragma unroll
        for (int kt = 0; kt < 8; ++kt) {
            u32x2 w; w.x = cvt_pk_bf16(Sacc[kt][0], Sacc[kt][1]); w.y = cvt_pk_bf16(Sacc[kt][2], Sacc[kt][3]);
            *(LAS u32x2*)(lds + L_ST + (16 * wave + fr) * CQS + (16 * kt + 4 * fq) * 2) = w;
        }
    }
    __syncthreads();
    for (int c = 0; c < nsteps; ++c) {
        {
            float b = 0.f;
#pragma unroll
            for (int g = 0; g < 3; ++g) b += (g < tg) ? tot[g * 128 + k] : 0.f;
            unsigned ktp[8], vtp[8];
#pragma unroll
            for (int jp = 0; jp < 8; ++jp) {
                const int j0 = 2 * jp, j1 = j0 + 1, t0 = 16 * tg + j0;
                const float b0 = b + lfr[j0], b1 = b0 + lfr[j1]; b = b1;
                const unsigned kp = cvt_pk_bf16(bf2f(knr[j0]) * __builtin_amdgcn_exp2f(-b0), bf2f(knr[j1]) * __builtin_amdgcn_exp2f(-b1));
                ktp[jp] = kp; vtp[jp] = (unsigned)vr[j0] | ((unsigned)vr[j1] << 16);
                if (FULL) {
                    const unsigned qp = cvt_pk_bf16(bf2f(sqr[j0]) * __builtin_amdgcn_exp2f(b0), bf2f(sqr[j1]) * __builtin_amdgcn_exp2f(b1));
                    *(LAS bf16*)(lds + L_Q + t0 * CQS + k * 2) = (bf16)(qp & 0xffffu); *(LAS bf16*)(lds + L_Q + (t0 + 1) * CQS + k * 2) = (bf16)(qp >> 16);
                    *(LAS bf16*)(lds + L_K + t0 * CQS + k * 2) = (bf16)(kp & 0xffffu); *(LAS bf16*)(lds + L_K + (t0 + 1) * CQS + k * 2) = (bf16)(kp >> 16);
                }
            }
            *(LAS u32x4*)(lds + L_KT + k * CTS + tg * 32) = (u32x4){ktp[0], ktp[1], ktp[2], ktp[3]};
            *(LAS u32x4*)(lds + L_KT + k * CTS + tg * 32 + 16) = (u32x4){ktp[4], ktp[5], ktp[6], ktp[7]};
            *(LAS u32x4*)(lds + L_VT + k * CTS + tg * 32) = (u32x4){vtp[0], vtp[1], vtp[2], vtp[3]};
            *(LAS u32x4*)(lds + L_VT + k * CTS + tg * 32 + 16) = (u32x4){vtp[4], vtp[5], vtp[6], vtp[7]};
            if (tg == 3) { dS[k] = __builtin_amdgcn_exp2f(b); segsum += b; }
        }
        __syncthreads();
        u32x2 sgr[4];
        if (FULL) {
#pragma unroll
            for (int i = 0; i < 4; ++i) sgr[i] = *(const u32x2*)(zb + (size_t)(rowb + 64 * c + 16 * (wave & 3) + fr) * INC + PW + 3 * HW + h * HD + 16 * (4 * (wave >> 2) + i) + 4 * fq);
        }
        if (c + 1 < nsteps) {
#pragma unroll
            for (int j = 0; j < 16; ++j) { const size_t row = (size_t)(rowb + 64 * (c + 1) + 16 * tg + j); lfr[j] = lf[row * HW + cl]; knr[j] = zb[row * INC + ck]; vr[j] = zb[row * INC + cv]; if (FULL) sqr[j] = zb[row * INC + cq]; }
        }
        if (FULL) {
#pragma unroll
            for (int i = 0; i < 2; ++i) {
                const int ti = 2 * wave + i, tt = ti >> 2, st = ti & 3;
                f32x4 p = (f32x4){0.f, 0.f, 0.f, 0.f};
#pragma unroll
                for (int ks = 0; ks < 4; ++ks) {
                    const bf16x8 ka = *(const LAS bf16x8*)(lds + L_K + (16 * st + fr) * CQS + (32 * ks + 8 * fq) * 2);
                    const bf16x8 qb = *(const LAS bf16x8*)(lds + L_Q + (16 * tt + fr) * CQS + (32 * ks + 8 * fq) * 2);
                    p = __builtin_amdgcn_mfma_f32_16x16x32_bf16(ka, qb, p, 0, 0, 0);
                }
                const int t = 16 * tt + fr, s0 = 16 * st + 4 * fq;
                u32x2 w; w.x = cvt_pk_bf16(s0 + 0 <= t ? p[0] : 0.f, s0 + 1 <= t ? p[1] : 0.f); w.y = cvt_pk_bf16(s0 + 2 <= t ? p[2] : 0.f, s0 + 3 <= t ? p[3] : 0.f);
                *(LAS u32x2*)(lds + L_P + t * CTS + s0 * 2) = w;
            }
        }
        {
            bf16x8 vb[2];
#pragma unroll
            for (int ss = 0; ss < 2; ++ss) vb[ss] = *(const LAS bf16x8*)(lds + L_VT + (16 * wave + fr) * CTS + (32 * ss + 8 * fq) * 2);
#pragma unroll
            for (int kt = 0; kt < 8; ++kt)
#pragma unroll
                for (int ss = 0; ss < 2; ++ss) {
                    const bf16x8 ka = *(const LAS bf16x8*)(lds + L_KT + (16 * kt + fr) * CTS + (32 * ss + 8 * fq) * 2);
                    Sacc[kt] = __builtin_amdgcn_mfma_f32_16x16x32_bf16(ka, vb[ss], Sacc[kt], 0, 0, 0);
                }
        }
        const int tt = wave & 3, vh = wave >> 2;
        f32x4 o[4];
        if (FULL) {
            __syncthreads();
            bf16x8 pb[2], qb[4];
#pragma unroll
            for (int ss = 0; ss < 2; ++ss) pb[ss] = *(const LAS bf16x8*)(lds + L_P + (16 * tt + fr) * CTS + (32 * ss + 8 * fq) * 2);
#pragma unroll
            for (int ks = 0; ks < 4; ++ks) qb[ks] = *(const LAS bf16x8*)(lds + L_Q + (16 * tt + fr) * CQS + (32 * ks + 8 * fq) * 2);
#pragma unroll
            for (int i = 0; i < 4; ++i) {
                const int vrow = 16 * (4 * vh + i) + fr;
                f32x4 a = (f32x4){0.f, 0.f, 0.f, 0.f};
#pragma unroll
                for (int ss = 0; ss < 2; ++ss) a = __builtin_amdgcn_mfma_f32_16x16x32_bf16(*(const LAS bf16x8*)(lds + L_VT + vrow * CTS + (32 * ss + 8 * fq) * 2), pb[ss], a, 0, 0, 0);
#pragma unroll
                for (int ks = 0; ks < 4; ++ks) a = __builtin_amdgcn_mfma_f32_16x16x32_bf16(*(const LAS bf16x8*)(lds + L_ST + vrow * CQS + (32 * ks + 8 * fq) * 2), qb[ks], a, 0, 0, 0);
                o[i] = a;
            }
            float ss2 = 0.f;
#pragma unroll
            for (int i = 0; i < 4; ++i) ss2 += (o[i][0] * o[i][0] + o[i][1] * o[i][1]) + (o[i][2] * o[i][2] + o[i][3] * o[i][3]);
            ss2 += __shfl_xor(ss2, 16); ss2 += __shfl_xor(ss2, 32);
            if (fq == 0) rmsp[vh * 64 + 16 * tt + fr] = ss2;
        }
#pragma unroll
        for (int kt = 0; kt < 8; ++kt) Sacc[kt] = Sacc[kt] * *(const LAS f32x4*)(dS + 16 * kt + 4 * fq);
        if (c + 1 < nsteps) {
            float s = 0.f;
#pragma unroll
            for (int j = 0; j < 16; ++j) s += lfr[j];
            tot[tg * 128 + k] = s;
        }
        __syncthreads();
        if (FULL) {
            const int tl = 16 * tt + fr; const size_t row = (size_t)(rowb + 64 * c + tl);
            const float r = rsqrtf((rmsp[tl] + rmsp[64 + tl]) * (1.f / HD) + EPS);
#pragma unroll
            for (int i = 0; i < 4; ++i) {
                const int ch = h * HD + 16 * (4 * vh + i) + 4 * fq;
                const f32x4 gn = gnr[i];
                const u32x2 sg = sgr[i];
                const float g0 = __builtin_bit_cast(float, sg.x << 16), g1 = __builtin_bit_cast(float, sg.x & 0xffff0000u), g2 = __builtin_bit_cast(float, sg.y << 16), g3 = __builtin_bit_cast(float, sg.y & 0xffff0000u);
                u32x2 w; w.x = cvt_pk_bf16(o[i][0] * r * gn[0] * g0, o[i][1] * r * gn[1] * g1); w.y = cvt_pk_bf16(o[i][2] * r * gn[2] * g2, o[i][3] * r * gn[3] * g3);
                *(u32x2*)(mixb + row * D + PW + ch) = w;
            }
#pragma unroll
            for (int kt = 0; kt < 8; ++kt) {
                u32x2 w; w.x = cvt_pk_bf16(Sacc[kt][0], Sacc[kt][1]); w.y = cvt_pk_bf16(Sacc[kt][2], Sacc[kt][3]);
                *(LAS u32x2*)(lds + L_ST + (16 * wave + fr) * CQS + (16 * kt + 4 * fq) * 2) = w;
            }
        }
    }
    __syncthreads();
}

constexpr int CW_FLAG = 32768;
__device__ __forceinline__ void prompt_segment(LAS unsigned char* lds, const Args& a, int chain, int seg, int nseg) {
    unsigned char* ws = a.ws;
    const bf16* zb = (const bf16*)(ws + WS_ZB); const float* lf = (const float*)(ws + WS_LF); bf16* mixb = (bf16*)(ws + WS_MIX);
    const int tid = threadIdx.x, lane = tid & 63, wave = __builtin_amdgcn_readfirstlane(tid >> 6), fr = lane & 15, fq = lane >> 4, k = tid & 127, tg = tid >> 7;
    const int b = chain / NH, h = chain % NH, seglen = SEQ / nseg, nsteps = seglen / 64, rowb = b * SEQ + seg * seglen;
    f32x4* slab = (f32x4*)(ws + WS_XB);
    float* dseg = (float*)(ws + WS_XB + 16 * MiB);
    unsigned* flags = (unsigned*)(ws + WS_CTL) + CW_FLAG;
    f32x4 gnr[4];
#pragma unroll
    for (int i = 0; i < 4; ++i) gnr[i] = *(const f32x4*)(a.in[9] + h * HD + 16 * (4 * (wave >> 2) + i) + 4 * fq);
    f32x4 Sacc[8];
#pragma unroll
    for (int i = 0; i < 8; ++i) Sacc[i] = (f32x4){0.f, 0.f, 0.f, 0.f};
    float segsum = 0.f;
    if (seg + 1 < nseg) {
        seg_run<false>(lds, zb, lf, Sacc, segsum, gnr, mixb, rowb, nsteps, h);
        f32x4* my = slab + (size_t)(chain * 8 + seg) * 4096;
#pragma unroll
        for (int kt = 0; kt < 8; ++kt) my[kt * 512 + tid] = Sacc[kt];
        if (tg == 3) dseg[(chain * 8 + seg) * 128 + k] = __builtin_amdgcn_exp2f(segsum);
        asm volatile("s_waitcnt vmcnt(0)" ::: "memory");
        __syncthreads();
        if (tid == 0) { __builtin_amdgcn_fence(__ATOMIC_RELEASE, "agent"); asm volatile("s_waitcnt vmcnt(0)" ::: "memory"); __hip_atomic_store(flags + 64 * (chain * 8 + seg), 1u, __ATOMIC_RELAXED, __HIP_MEMORY_SCOPE_AGENT); }
#pragma unroll
        for (int i = 0; i < 8; ++i) Sacc[i] = (f32x4){0.f, 0.f, 0.f, 0.f};
        segsum = 0.f;
    }
    if (seg > 0) {
        if (tid < 64) {
            for (int i = 0; i < seg; ++i) { unsigned sp = 0; while (__hip_atomic_load(flags + 64 * (chain * 8 + i), __ATOMIC_RELAXED, __HIP_MEMORY_SCOPE_AGENT) == 0u && ++sp < (1u << 22)) __builtin_amdgcn_s_sleep(2); }
            __builtin_amdgcn_fence(__ATOMIC_ACQUIRE, "agent");
            asm volatile("s_waitcnt vmcnt(0)" ::: "memory");
        }
        __syncthreads();
        for (int i = 0; i < seg; ++i) {
            const f32x4* rec = slab + (size_t)(chain * 8 + i) * 4096; const float* dd = dseg + (chain * 8 + i) * 128;
#pragma unroll
            for (int kt = 0; kt < 8; ++kt) Sacc[kt] = Sacc[kt] * *(const f32x4*)(dd + 16 * kt + 4 * fq) + rec[kt * 512 + tid];
        }
    }
    seg_run<true>(lds, zb, lf, Sacc, segsum, gnr, mixb, rowb, nsteps, h);
    if (seg + 1 == nseg) {
        float* Sout = a.out + O_HSP + (size_t)chain * HD * HD;
#pragma unroll
        for (int kt = 0; kt < 8; ++kt)
#pragma unroll
            for (int j = 0; j < 4; ++j) Sout[(size_t)(16 * kt + 4 * fq + j) * HD + 16 * wave + fr] = Sacc[kt][j];
    }
}

__device__ __forceinline__ void phase2(LAS unsigned char* lds, const Args& a, int bid, int G, int parts = 7) {
    unsigned char* ws = a.ws;
    const bf16* zb = (const bf16*)(ws + WS_ZB); const float* lf = (const float*)(ws + WS_LF); bf16* mixb = (bf16*)(ws + WS_MIX);
    constexpr int NPC = NB * NH, NSC = DB * NH, NPOOL = (M / 64) * 4;
    const int nseg = (G >= 8 * NPC) ? 8 : (G >= 4 * NPC ? 4 : (G >= 2 * NPC ? 2 : 1));
    if (parts & 1) {
    if (nseg > 1) { if (bid < nseg * NPC) prompt_segment(lds, a, bid / nseg, bid % nseg, nseg); }
    else for (int c = bid; c < NPC; c += G) prompt_segment(lds, a, c, 0, 1);
    }
    SampleRegs cur, nxt;
    if (bid < NSC) sample_load(cur, a.in[3] + (size_t)bid * HD * HD);
    for (int it = bid; it < NSC + NPOOL; it += G) {
        if (it < NSC ? !(parts & 2) : !(parts & 4)) continue;
        if (it < NSC) {
            const bool pf = it + G < NSC;
            if (pf) sample_load(nxt, a.in[3] + (size_t)(it + G) * HD * HD);
            sample_run(lds, cur, zb, lf, a.in[9], a.out + O_HSS + (size_t)it * HD * HD, mixb, MP + (it / NH) * DS, it % NH);
            if (pf) {
#pragma unroll
                for (int kk = 0; kk < 8; ++kk) cur.S[kk] = nxt.S[kk];
            }
        }
        else pool_item(lds, it - NSC, zb, a.in[2], (const bf16*)(ws + WS_WP), mixb);
    }
}

__device__ __forceinline__ void phase6(const Args& a, int vcu, int G) {
    const int tid = threadIdx.x, lane = tid & 63, wave = tid >> 6;
    const int gw = vcu * NWAVES + wave, NGW = G * NWAVES;
    const float* rsq3 = (const float*)(a.ws + WS_CTL) + CW_RSQ3;
    for (int m = gw; m < M; m += NGW) {
        float* yr = a.out + O_Y + (size_t)m * D;
        const float r = rsqrtf(rsq3[m] * (1.f / D) + EPS);
#pragma unroll
        for (int j = 0; j < 8; ++j) { const f32x4 v = ((const f32x4*)yr)[lane + 64 * j], g = ((const f32x4*)a.in[15])[lane + 64 * j]; ((f32x4*)yr)[lane + 64 * j] = v * r * g; }
    }
}

__global__ void __launch_bounds__(NWAVES * 64, 2) mega(Args a) {
    extern __shared__ __attribute__((aligned(16))) unsigned char lds_raw[];
    LAS unsigned char* lds = (LAS unsigned char*)lds_raw;
    const int G = gridDim.x, bid = blockIdx.x;
    const int vcu = (G % 8 == 0) ? (bid % 8) * (G / 8) + bid / 8 : bid;
    unsigned char* ws = a.ws;
    float* ctlf = (float*)(ws + WS_CTL);
    const int lo = a.ph_lo, hi = a.ph_hi;
#if ONE_LAUNCH && USE_CG
    cg::grid_group grid = cg::this_grid();
#define GRID_BAR() grid.sync()
#elif ONE_LAUNCH
    volatile LAS unsigned* MISC = (volatile LAS unsigned*)(lds + MISC_OFF);
    if (threadIdx.x < 32) MISC[threadIdx.x] = 0u;
    __syncthreads();
    XcdBarrier bar = xcd_barrier_post((unsigned*)(ws + WS_CTL) + CW_BAR, MISC + 8);
#define GRID_BAR() xcd_barrier(bar)
#else
#define GRID_BAR() do {} while (0)
#endif
#ifndef PH_MASK
#define PH_MASK 0x7f
#endif
#define IN(k) (((PH_MASK >> (k)) & 1) && lo <= (k) && (k) < hi)
#define BOTH(k) (IN(k) && IN((k) + 1))
#ifndef REP_MASK
#define REP_MASK 0
#endif
#define REP(k) ((REP_MASK >> (k)) & 1)
#ifndef P2_REP_PARTS
#define P2_REP_PARTS 7
#endif
    if (IN(0)) { if (REP(0)) { phase0(lds, a, vcu, G); __syncthreads(); } phase0(lds, a, vcu, G); if (BOTH(0)) GRID_BAR(); }
    if (IN(1)) {
        pg8::Gemm g{(const bf16*)(ws + WS_XB), (const bf16*)(ws + WS_WIN), M, INC, D}; pg8::HybridOrder S; S.init(M, INC, D, G, bid, false);
        const pg8::TailCtx T{nullptr, nullptr};
        pg8::EpiZ E{(bf16*)(ws + WS_ZB), (float*)(ws + WS_LF), (const float*)(ws + WS_MISC), (const float*)(ws + WS_MISC) + M, a.out};
        if (REP(1)) pg8::gemm_phase2(lds, g, S, E, T);
        pg8::gemm_phase2(lds, g, S, E, T);
        if (BOTH(1)) GRID_BAR();
    }
    if (IN(2)) { if (REP(2)) { phase2(lds, a, bid, G, P2_REP_PARTS); __syncthreads(); } phase2(lds, a, bid, G); if (BOTH(2)) GRID_BAR(); }
    if (IN(3)) {
        pg8::Gemm g{(const bf16*)(ws + WS_MIX), (const bf16*)(ws + WS_WO), M, D, D}; pg8::HybridOrder S; S.init(M, D, D, G, bid, true);
        const pg8::TailCtx T{(f32x4*)(ws + WS_SLAB3), (unsigned*)(ws + WS_CTL) + CW_TAIL};
        if (REP(3)) { pg8::EpiX1<true> E0{a.in[0], a.in[1], a.out + O_Y, (bf16*)(ws + WS_XB), ctlf + CW_RSQ2}; pg8::gemm_phase2(lds, g, S, E0, T); }
        pg8::EpiX1<false> E{a.in[0], a.in[1], a.out + O_Y, (bf16*)(ws + WS_XB), ctlf + CW_RSQ2};
        pg8::gemm_phase2(lds, g, S, E, T);
        if (BOTH(3)) GRID_BAR();
    }
    if (IN(4)) {
        pg8::Gemm g{(const bf16*)(ws + WS_XB), (const bf16*)(ws + WS_WGU), M, 2 * DFF, D}; pg8::HybridOrder S; S.init(M, 2 * DFF, D, G, bid, true);
        const pg8::TailCtx T{(f32x4*)(ws + WS_SLAB45), (unsigned*)(ws + WS_CTL) + CW_TAIL + 4096};
        pg8::EpiAct E{(bf16*)(ws + WS_ACT), ctlf + CW_RSQ2};
        if (REP(4)) pg8::gemm_phase2(lds, g, S, E, T);
        pg8::gemm_phase2(lds, g, S, E, T);
        if (BOTH(4)) GRID_BAR();
    }
    if (IN(5)) {
        pg8::Gemm g{(const bf16*)(ws + WS_ACT), (const bf16*)(ws + WS_WD), M, D, DFF}; pg8::HybridOrder S; S.init(M, D, DFF, G, bid, true);
        const pg8::TailCtx T{(f32x4*)(ws + WS_SLAB45), (unsigned*)(ws + WS_CTL) + CW_TAIL + 8192};
        if (REP(5)) { pg8::EpiX2<true> E0{a.out + O_Y, ctlf + CW_RSQ3}; pg8::gemm_phase2(lds, g, S, E0, T); }
        pg8::EpiX2<false> E{a.out + O_Y, ctlf + CW_RSQ3};
        pg8::gemm_phase2(lds, g, S, E, T);
        if (BOTH(5)) GRID_BAR();
    }
    if (IN(6)) phase6(a, vcu, G);
#undef IN
#undef BOTH
}

extern "C" void kernel_launch(void* const* d_in, const int* in_sizes, int n_in, void* d_out, int out_size, void* d_ws, size_t ws_size, hipStream_t stream) {
    static int grid = 0;
    if (grid == 0) {
        if (n_in != 16 || ws_size < WS_END) { fprintf(stderr, "kernel_launch: unexpected n_in %d / ws_size %zu\n", n_in, ws_size); grid = -1; return; }
        int dev = 0, cus = 0, per_cu = 0;
        hipGetDevice(&dev);
        hipDeviceGetAttribute(&cus, hipDeviceAttributeMultiprocessorCount, dev);
        hipFuncSetAttribute((const void*)mega, hipFuncAttributeMaxDynamicSharedMemorySize, LDS_BYTES);
        hipOccupancyMaxActiveBlocksPerMultiprocessor(&per_cu, (const void*)mega, NWAVES * 64, LDS_BYTES);
        if (per_cu < 1) { fprintf(stderr, "kernel_launch: occupancy query says %d blocks per CU\n", per_cu); grid = -1; return; }
        grid = cus;
    }
    if (grid < 0) return;
    hipMemsetAsync((char*)d_ws + WS_CTL, 0, CTL_ZERO_BYTES, stream);
    Args a{};
    for (int i = 0; i < 16; ++i) a.in[i] = (const float*)d_in[i];
    a.out = (float*)d_out; a.ws = (unsigned char*)d_ws;
#if ONE_LAUNCH
    a.ph_lo = 0; a.ph_hi = NPHASE;
    void* args[] = {&a};
#if USE_CG
    hipError_t e = hipLaunchCooperativeKernel((const void*)mega, dim3(grid), dim3(NWAVES * 64), args, LDS_BYTES, stream);
    if (e != hipSuccess) fprintf(stderr, "cooperative launch failed: %s (grid %d)\n", hipGetErrorString(e), grid);
#else
    (void)args; hipLaunchKernelGGL(mega, dim3(grid), dim3(NWAVES * 64), LDS_BYTES, stream, a);
#endif
#else
    for (int p = 0; p < NPHASE; ++p) { a.ph_lo = p; a.ph_hi = p + 1; hipLaunchKernelGGL(mega, dim3(grid), dim3(NWAVES * 64), LDS_BYTES, stream, a); }
#endif
}
```

```cpp
#include <hip/hip_runtime.h>
#include <hip/hip_cooperative_groups.h>
#include <cstdio>
#include <cstdint>
namespace cg = cooperative_groups;

constexpr int D = 2048, NB = 4, SEQ = 2048, DB = 128, DS = 8;
constexpr int MP = NB * SEQ, MS = DB * DS, M = MP + MS;
constexpr int PW = 1024, HW = 1024, HD = 128, NH = 8, PC = 15;
constexpr int DFF = 5632, INC = 5120;
constexpr float EPS = 1e-6f;
constexpr size_t O_Y = 0;
constexpr size_t O_PSP = (size_t)M * D;
constexpr size_t O_HSP = O_PSP + (size_t)NB * PC * PW;
constexpr size_t O_PSS = O_HSP + (size_t)NB * NH * HD * HD;
constexpr size_t O_HSS = O_PSS + (size_t)DB * PC * PW;

namespace pg8 {
#define PG8_LAS __attribute__((address_space(3)))
typedef unsigned short bf16_t;
typedef short bf16x8 __attribute__((ext_vector_type(8)));
typedef float f32x4 __attribute__((ext_vector_type(4)));
typedef unsigned u32x4 __attribute__((ext_vector_type(4)));
constexpr int BM = 256, BK = 64, HALF = 128, HTB = HALF * BK * 2  , STAGE_BYTES = 8 * HTB, NXCD = 8, WGM = 8;

__host__ __device__ __forceinline__ int lds_byte(int r, int c) { const int st = (r >> 4) * 2 + (c >> 5), rr = r & 15, cc = c & 31, ob = rr * 64 + cc * 2; return st * 1024 + (ob ^ (((ob >> 9) & 1) << 5)); }
__host__ __device__ __forceinline__ void stage_rc(int b, int& R, int& C) { const int st = b / 1024, sb = b % 1024, swz = sb ^ (((sb >> 9) & 1) << 5); R = (st >> 1) * 16 + swz / 64; C = (st & 1) * 32 + (swz % 64) / 2; }
__host__ __device__ __forceinline__ int perm32(int rho) { const int n = rho >> 4, i = rho & 15; return 8 * (i >> 2) + 4 * n + (i & 3); }

struct Unit { int pm, pn, kb, nk, tinfo; };
struct Gemm { const bf16_t* A; const bf16_t* Bt; int M, N, K; };

struct StaticOrder {
    int nM, nN, nwg, G, c;
    __host__ __device__ void init(int M, int N, int G_, int c_) { nM = M / BM; nN = N / BM; nwg = nM * nN; G = G_; c = c_; }
    __host__ __device__ bool next(int i, Unit& u) const {
        const long L = (long)i * G + c; if (L >= nwg) return false;
        int wgid = (int)L; { const int q = nwg / NXCD, r = nwg % NXCD, xcd = wgid % NXCD, off = wgid / NXCD; wgid = (xcd < r ? xcd * (q + 1) : r * (q + 1) + (xcd - r) * q) + off; }
        const int nig = WGM * nN, gid = wgid / nig, fm = gid * WGM, gsz = (nM - fm) < WGM ? (nM - fm) : WGM;
        u.pm = fm + ((wgid % nig) % gsz); u.pn = (wgid % nig) / gsz; u.kb = 0; u.nk = 0; u.tinfo = -1; return true;
    }
    __device__ __forceinline__ void a_ready(const Unit&) const {}
    __device__ __forceinline__ void done(const Unit&) const {}
};
__device__ __forceinline__ unsigned cvt_pk_bf16(float lo, float hi) { unsigned r; asm volatile("v_cvt_pk_bf16_f32 %0, %1, %2" : "=v"(r) : "v"(lo), "v"(hi)); return r; }
__device__ __forceinline__ float sigm(float x) { return __builtin_amdgcn_rcpf(1.f + __expf(-x)); }
__device__ __forceinline__ float silu(float x) { return x * __builtin_amdgcn_rcpf(1.f + __expf(-x)); }
typedef unsigned u32x2 __attribute__((ext_vector_type(2)));

struct EpiZ {
    static constexpr bool PERM = true, AFTER_DRAIN = false;
    bf16_t* zb; float* lf; const float* rstd1; const float* lbv; float* out;
    __device__ __forceinline__ void operator()(const f32x4 (&acc)[2][2][4][2], const Unit& u, int wr, int wc, int fr, int fq, unsigned gmask = 0xffu) const {
        const int kind = u.pn >> 2;
        const int row0 = u.pm * BM + wr * 64 + fr;
        const int cc0 = (u.pn & 3) * 256 + wc * 32 + 8 * fq;
        f32x4 lb[2][2];
        if (kind == 2) {
#pragma unroll
            for (int bj = 0; bj < 2; ++bj)
#pragma unroll
                for (int n = 0; n < 2; ++n) lb[bj][n] = *(const f32x4*)(lbv + cc0 + bj * HALF + 4 * n);
        }
#pragma unroll
        for (int ai = 0; ai < 2; ++ai)
#pragma unroll
            for (int m = 0; m < 4; ++m) {
                if (!((gmask >> (ai * 4 + m)) & 1u)) continue;
                const int row = row0 + ai * HALF + m * 16;
                const float r = rstd1[row];
#pragma unroll
                for (int bj = 0; bj < 2; ++bj) {
                    const int cc = cc0 + bj * HALF;
                    f32x4 v0 = acc[ai][bj][m][0] * r, v1 = acc[ai][bj][m][1] * r;
                    if (kind == 2) {
                        f32x4 k0, k1;
#pragma unroll
                        for (int j = 0; j < 4; ++j) {
                            const float f0 = lb[bj][0][j] + (1.f - lb[bj][0][j]) * sigm(v0[j]), f1 = lb[bj][1][j] + (1.f - lb[bj][1][j]) * sigm(v1[j]);
                            v0[j] = __log2f(f0); v1[j] = __log2f(f1); k0[j] = 1.f - f0; k1[j] = 1.f - f1;
                        }
                        float* p = lf + (size_t)row * HW + cc;
                        *(f32x4*)p = v0; *(f32x4*)(p + 4) = v1;
                        u32x4 w; w.x = cvt_pk_bf16(k0[0], k0[1]); w.y = cvt_pk_bf16(k0[2], k0[3]); w.z = cvt_pk_bf16(k1[0], k1[1]); w.w = cvt_pk_bf16(k1[2], k1[3]);
                        *(u32x4*)(zb + (size_t)row * INC + 2 * 1024 + cc) = w;
                    } else {
                        if (kind == 0) {
                            float* dst = nullptr;
                            if (row >= MP) { const int ms = row - MP; dst = out + O_PSS + ((size_t)(ms >> 3) * PC + 7 + (ms & 7)) * PW + cc; }
                            else { const int t = row & (SEQ - 1); if (t >= SEQ - PC) dst = out + O_PSP + ((size_t)(row >> 11) * PC + (t - (SEQ - PC))) * PW + cc; }
                            if (dst) { *(f32x4*)dst = v0; *(f32x4*)(dst + 4) = v1; }
                        }
                        if (kind == 1 || kind == 4) {
#pragma unroll
                            for (int j = 0; j < 4; ++j) { v0[j] = silu(v0[j]); v1[j] = silu(v1[j]); }
                        }
                        u32x4 w; w.x = cvt_pk_bf16(v0[0], v0[1]); w.y = cvt_pk_bf16(v0[2], v0[3]); w.z = cvt_pk_bf16(v1[0], v1[1]); w.w = cvt_pk_bf16(v1[2], v1[3]);
                        *(u32x4*)(zb + (size_t)row * INC + kind * 1024 + cc) = w;
                    }
                }
            }
    }
};

template <bool DRY = false> struct EpiX1 {
    static constexpr bool PERM = false, AFTER_DRAIN = false;
    const float* xp; const float* xs; float* y; bf16_t* x1b; float* rowsq;
    __device__ __forceinline__ void operator()(const f32x4 (&acc)[2][2][4][2], const Unit& u, int wr, int wc, int fr, int fq, unsigned gmask = 0xffu) const {
        const int row0 = u.pm * BM + wr * 64 + fr, col0 = u.pn * BM + wc * 32 + 4 * fq;
#pragma unroll
        for (int ai = 0; ai < 2; ++ai)
#pragma unroll
            for (int m = 0; m < 4; ++m) {
                if (!((gmask >> (ai * 4 + m)) & 1u)) continue;
                const int row = row0 + ai * HALF + m * 16;
                const float* xr = (row < MP ? xp + (size_t)row * D : xs + (size_t)(row - MP) * D) + col0;
                bf16_t* br = x1b + (size_t)row * D + col0;
                float s = 0.f;
#pragma unroll
                for (int bj = 0; bj < 2; ++bj)
#pragma unroll
                    for (int n = 0; n < 2; ++n) {
                        const f32x4 v = *(const f32x4*)(xr + bj * HALF + n * 16) + acc[ai][bj][m][n];
                        u32x2 w; w.x = cvt_pk_bf16(v[0], v[1]); w.y = cvt_pk_bf16(v[2], v[3]);
                        *(u32x2*)(br + bj * HALF + n * 16) = w;
                        s += (v[0] * v[0] + v[1] * v[1]) + (v[2] * v[2] + v[3] * v[3]);
                    }
                s += __shfl_xor(s, 16); s += __shfl_xor(s, 32);
                if (fq == 0 && !DRY) atomicAdd(rowsq + row, s);
            }
    }
};

struct EpiAct {
    static constexpr bool PERM = true, AFTER_DRAIN = false;
    bf16_t* act; const float* rowsq;
    __device__ __forceinline__ void operator()(const f32x4 (&acc)[2][2][4][2], const Unit& u, int wr, int wc, int fr, int fq, unsigned gmask = 0xffu) const {
        const int row0 = u.pm * BM + wr * 64 + fr, col0 = u.pn * HALF + wc * 32 + 8 * fq;
#pragma unroll
        for (int ai = 0; ai < 2; ++ai)
#pragma unroll
            for (int m = 0; m < 4; ++m) {
                if (!((gmask >> (ai * 4 + m)) & 1u)) continue;
                const int row = row0 + ai * HALF + m * 16;
                const float r = rsqrtf(rowsq[row] * (1.f / D) + EPS);
                u32x4 w; unsigned* wp = (unsigned*)&w;
#pragma unroll
                for (int n = 0; n < 2; ++n) {
                    const f32x4 g = acc[ai][0][m][n] * r, up = acc[ai][1][m][n] * r;
                    f32x4 a;
#pragma unroll
                    for (int j = 0; j < 4; ++j) a[j] = silu(g[j]) * up[j];
                    wp[2 * n] = cvt_pk_bf16(a[0], a[1]); wp[2 * n + 1] = cvt_pk_bf16(a[2], a[3]);
                }
                *(u32x4*)(act + (size_t)row * DFF + col0) = w;
            }
    }
};

template <bool DRY = false> struct EpiX2 {
    static constexpr bool PERM = false, AFTER_DRAIN = false;
    float* y; float* rowsq; const bf16_t* x1b;
    __device__ __forceinline__ void operator()(const f32x4 (&acc)[2][2][4][2], const Unit& u, int wr, int wc, int fr, int fq, unsigned gmask = 0xffu) const {
        const int row0 = u.pm * BM + wr * 64 + fr, col0 = u.pn * BM + wc * 32 + 4 * fq;
#pragma unroll
        for (int ai = 0; ai < 2; ++ai)
#pragma unroll
            for (int m = 0; m < 4; ++m) {
                if (!((gmask >> (ai * 4 + m)) & 1u)) continue;
                const int row = row0 + ai * HALF + m * 16;
                float* yr = y + (size_t)row * D + col0;
                float s = 0.f;
#pragma unroll
                for (int bj = 0; bj < 2; ++bj)
#pragma unroll
                    for (int n = 0; n < 2; ++n) {
                        const u32x2 xw = *(const u32x2*)(x1b + (size_t)row * D + col0 + bj * HALF + n * 16);
                        const f32x4 x1 = (f32x4){__builtin_bit_cast(float, xw.x << 16), __builtin_bit_cast(float, xw.x & 0xffff0000u), __builtin_bit_cast(float, xw.y << 16), __builtin_bit_cast(float, xw.y & 0xffff0000u)};
                        const f32x4 v = x1 + acc[ai][bj][m][n];
                        *(f32x4*)(yr + bj * HALF + n * 16) = v;
                        s += (v[0] * v[0] + v[1] * v[1]) + (v[2] * v[2] + v[3] * v[3]);
                    }
                s += __shfl_xor(s, 16); s += __shfl_xor(s, 32);
                if (fq == 0 && !DRY) atomicAdd(rowsq + row, s);
            }
    }
};
template <class Epi, class Sched, bool ALIGN_EPI = false, bool SP2 = false>
__device__ __forceinline__ void gemm_phase(PG8_LAS unsigned char* lds, const Gemm g, const Sched& S, const Epi& E) {
    int tid_ = threadIdx.x; asm volatile("" : "+v"(tid_));
    const int tid = tid_, wid = __builtin_amdgcn_readfirstlane(tid >> 6), lane = tid & 63, wr = wid >> 2, wc = wid & 3, fr = lane & 15, fq = lane >> 4;
    const int K = g.K, nt = K / BK;
    unsigned voffA[2], voffB[2];
#pragma unroll
    for (int i = 0; i < 2; ++i) { int R, C; stage_rc(tid * 16 + i * 8192, R, C); const int Rb = Epi::PERM ? ((R & ~31) + perm32(R & 31)) : R;
        voffA[i] = (unsigned)(R * K + C) * 2u; voffB[i] = (unsigned)(Rb * K + C) * 2u; }
    const size_t kstep = (size_t)(BK * 2);
    const size_t hstep = (size_t)HALF * K * 2;
    const size_t tstep = 2 * hstep;
    const unsigned ldsw = (unsigned)wid * 1024u;
    const int aoff = lds_byte(wr * 64 + fr, fq * 8), boff = lds_byte(wc * 32 + fr, fq * 8);
#define PG8_SA(b, h) (((b) * 2 + (h)) * HTB)
#define PG8_SB(b, h) ((4 + (b) * 2 + (h)) * HTB)
#define PG8_STAGE(bufoff, gbase, voff) do { _Pragma("unroll") for (int _i = 0; _i < 2; ++_i) \
        __builtin_amdgcn_global_load_lds((const unsigned*)((const char*)(gbase) + (voff)[_i]), (PG8_LAS unsigned*)(lds + (bufoff) + ldsw + _i * 8192), 16, 0, 0); } while (0)
#define PG8_LDA(dst, b, h) do { _Pragma("unroll") for (int m = 0; m < 4; ++m) _Pragma("unroll") for (int k = 0; k < 2; ++k) dst[m][k] = *(const PG8_LAS bf16x8*)(lds + PG8_SA(b, h) + aoff + m * 2048 + k * 1024); } while (0)
#define PG8_LDB(dst, b, h) do { _Pragma("unroll") for (int n = 0; n < 2; ++n) _Pragma("unroll") for (int k = 0; k < 2; ++k) dst[n][k] = *(const PG8_LAS bf16x8*)(lds + PG8_SB(b, h) + boff + n * 2048 + k * 1024); } while (0)
#define PG8_MMA(ai, bj, At, Bt) do { __builtin_amdgcn_s_setprio(1); _Pragma("unroll") for (int m = 0; m < 4; ++m) _Pragma("unroll") for (int n = 0; n < 2; ++n) _Pragma("unroll") for (int k = 0; k < 2; ++k) \
        acc[ai][bj][m][n] = __builtin_amdgcn_mfma_f32_16x16x32_bf16(Bt[n][k], At[m][k], acc[ai][bj][m][n], 0, 0, 0); __builtin_amdgcn_s_setprio(0); } while (0)
#define PG8_WAIT_V(n) asm volatile("s_waitcnt vmcnt(" #n ")" ::: "memory")
#define PG8_WAIT_L(n) asm volatile("s_waitcnt lgkmcnt(" #n ")" ::: "memory")
#define PG8_BAR __builtin_amdgcn_s_barrier()
#define PG8_SCHED __builtin_amdgcn_sched_barrier(0)
    Unit cur, nxt; int ui = 0;
    if (!S.next(0, cur)) return;
    f32x4 acc[2][2][4][2];
#pragma unroll
    for (int a = 0; a < 2; ++a)
#pragma unroll
        for (int b = 0; b < 2; ++b)
#pragma unroll
            for (int m = 0; m < 4; ++m)
#pragma unroll
                for (int n = 0; n < 2; ++n) acc[a][b][m][n] = (f32x4){0.f, 0.f, 0.f, 0.f};
    bf16x8 At[4][2], B0[2][2], B1[2][2];
    const char* cA = (const char*)g.A + (size_t)cur.pm * tstep; const char* cB = (const char*)g.Bt + (size_t)cur.pn * tstep;
    S.a_ready(cur);
    if constexpr (SP2) {
        PG8_STAGE(PG8_SB(0, 0), cB, voffB); PG8_STAGE(PG8_SB(0, 1), cB + hstep, voffB); PG8_STAGE(PG8_SA(0, 0), cA, voffA); PG8_STAGE(PG8_SA(0, 1), cA + hstep, voffA);
        if (wr == 1) PG8_BAR;
        PG8_WAIT_V(2); PG8_BAR;
        PG8_STAGE(PG8_SB(1, 0), cB + kstep, voffB); PG8_STAGE(PG8_SA(1, 0), cA + kstep, voffA); PG8_STAGE(PG8_SB(1, 1), cB + hstep + kstep, voffB);
        PG8_WAIT_V(6); PG8_BAR;
    } else {
        PG8_STAGE(PG8_SB(0, 0), cB, voffB); PG8_STAGE(PG8_SA(0, 0), cA, voffA); PG8_STAGE(PG8_SB(0, 1), cB + hstep, voffB); PG8_STAGE(PG8_SA(0, 1), cA + hstep, voffA);
        if (wr == 1) PG8_BAR;
        PG8_WAIT_V(4); PG8_BAR;
        PG8_STAGE(PG8_SB(1, 0), cB + kstep, voffB); PG8_STAGE(PG8_SA(1, 0), cA + kstep, voffA); PG8_STAGE(PG8_SB(1, 1), cB + hstep + kstep, voffB);
        PG8_WAIT_V(6); PG8_BAR;
    }
    for (;;) {
        const bool has_next = S.next(ui + 1, nxt);
        const char* nA = has_next ? (const char*)g.A + (size_t)nxt.pm * tstep : cA; const char* nB = has_next ? (const char*)g.Bt + (size_t)nxt.pn * tstep : cB;
        for (int t = 0; t < nt; t += 2) {
            const bool last = (t == nt - 2);
            const char* a1 = cA + (size_t)(t + 1) * kstep;
            const char* a2 = last ? nA : cA + (size_t)(t + 2) * kstep; const char* b2 = last ? nB : cB + (size_t)(t + 2) * kstep;
            const char* a3 = a2 + kstep; const char* b3 = b2 + kstep;
            if (last && has_next) S.a_ready(nxt);
            if constexpr (SP2) {
            PG8_LDB(B0, 0, 0); PG8_LDB(B1, 0, 1); PG8_SCHED; PG8_LDA(At, 0, 0); PG8_STAGE(PG8_SA(1, 1), a1 + hstep, voffA);
            PG8_WAIT_V(8); PG8_WAIT_L(0); PG8_BAR; PG8_MMA(0, 0, At, B0); PG8_MMA(0, 1, At, B1); PG8_BAR; PG8_SCHED;
            PG8_LDA(At, 0, 1); PG8_STAGE(PG8_SB(0, 0), b2, voffB); PG8_STAGE(PG8_SB(0, 1), b2 + hstep, voffB); PG8_STAGE(PG8_SA(0, 0), a2, voffA);
            PG8_WAIT_V(8); PG8_WAIT_L(0); PG8_BAR; PG8_MMA(1, 0, At, B0); PG8_MMA(1, 1, At, B1); PG8_BAR; PG8_SCHED;
            PG8_LDB(B0, 1, 0); PG8_LDB(B1, 1, 1); PG8_SCHED; PG8_LDA(At, 1, 0); PG8_STAGE(PG8_SA(0, 1), a2 + hstep, voffA);
            PG8_WAIT_V(8); PG8_WAIT_L(0); PG8_BAR; PG8_MMA(0, 0, At, B0); PG8_MMA(0, 1, At, B1); PG8_BAR; PG8_SCHED;
            PG8_LDA(At, 1, 1); PG8_STAGE(PG8_SB(1, 0), b3, voffB); PG8_STAGE(PG8_SB(1, 1), b3 + hstep, voffB); PG8_STAGE(PG8_SA(1, 0), a3, voffA);
            PG8_WAIT_V(8); PG8_WAIT_L(0); PG8_BAR; PG8_MMA(1, 0, At, B0); PG8_MMA(1, 1, At, B1); PG8_BAR; PG8_SCHED;
            } else {
            PG8_LDB(B0, 0, 0); PG8_SCHED; PG8_LDA(At, 0, 0); PG8_STAGE(PG8_SA(1, 1), a1 + hstep, voffA);
            PG8_WAIT_L(8); PG8_BAR; PG8_WAIT_L(0); PG8_MMA(0, 0, At, B0); PG8_BAR; PG8_SCHED;
            PG8_LDB(B1, 0, 1); PG8_STAGE(PG8_SB(0, 0), b2, voffB);
            PG8_BAR; PG8_WAIT_L(0); PG8_MMA(0, 1, At, B1); PG8_BAR;
            PG8_LDA(At, 0, 1); PG8_STAGE(PG8_SA(0, 0), a2, voffA);
            PG8_BAR; PG8_WAIT_L(0); PG8_MMA(1, 0, At, B0); PG8_BAR; PG8_SCHED;
            PG8_STAGE(PG8_SB(0, 1), b2 + hstep, voffB);
            PG8_WAIT_V(6); PG8_BAR; PG8_MMA(1, 1, At, B1); PG8_BAR;
            PG8_LDB(B0, 1, 0); PG8_SCHED; PG8_LDA(At, 1, 0); PG8_STAGE(PG8_SA(0, 1), a2 + hstep, voffA);
            PG8_WAIT_L(8); PG8_BAR; PG8_WAIT_L(0); PG8_MMA(0, 0, At, B0); PG8_BAR; PG8_SCHED;
            PG8_LDB(B1, 1, 1); PG8_STAGE(PG8_SB(1, 0), b3, voffB);
            PG8_BAR; PG8_WAIT_L(0); PG8_MMA(0, 1, At, B1); PG8_BAR;
            PG8_LDA(At, 1, 1); PG8_STAGE(PG8_SA(1, 0), a3, voffA);
            PG8_BAR; PG8_WAIT_L(0); PG8_MMA(1, 0, At, B0); PG8_BAR; PG8_SCHED;
            PG8_STAGE(PG8_SB(1, 1), b3 + hstep, voffB);
            PG8_WAIT_V(6); PG8_BAR; PG8_MMA(1, 1, At, B1); PG8_BAR;
            }
        }
        if constexpr (ALIGN_EPI) { if (wr == 0) PG8_BAR; }
        if constexpr (!Epi::AFTER_DRAIN) { E(acc, cur, wr, wc, fr, fq); S.done(cur); }
        if (!has_next) break;
#pragma unroll
        for (int a = 0; a < 2; ++a)
#pragma unroll
            for (int b = 0; b < 2; ++b)
#pragma unroll
                for (int m = 0; m < 4; ++m)
#pragma unroll
                    for (int n = 0; n < 2; ++n) acc[a][b][m][n] = (f32x4){0.f, 0.f, 0.f, 0.f};
        cur = nxt; cA = nA; cB = nB; ++ui;
        if constexpr (ALIGN_EPI) { if (wr == 1) PG8_BAR; }
    }
    PG8_WAIT_V(0);
    if constexpr (!ALIGN_EPI) { if (wr == 0) PG8_BAR; }
    PG8_BAR;
    if constexpr (Epi::AFTER_DRAIN) { E.fused(acc, cur, wr, wc, fr, fq, lds, wid, lane); S.done(cur); }
#undef PG8_SA
#undef PG8_SB
#undef PG8_STAGE
#undef PG8_LDA
#undef PG8_LDB
#undef PG8_MMA
#undef PG8_WAIT_V
#undef PG8_WAIT_L
#undef PG8_BAR
#undef PG8_SCHED
}

struct HybridOrder {
    int nM, nN, nwg, G, c, nt, nfull, R, ns;
    __device__ __forceinline__ void init(int M, int N, int K, int G_, int c_, bool allow_split) {
        nM = M / BM; nN = N / BM; nwg = nM * nN; G = G_; c = c_; nt = K / BK; nfull = nwg / G; R = nwg - nfull * G;
        ns = (allow_split && R > 0 && (R % 8) == 0 && (G % 8) == 0) ? G / R : 1; if (ns > 8) ns = 8; if (ns > nt / 2) ns = nt / 2; if (ns < 2) ns = 1;
    }
    __device__ __forceinline__ void map(int L, Unit& u) const {
        int wgid = L; { const int q = nwg / NXCD, r = nwg % NXCD, xcd = wgid % NXCD, off = wgid / NXCD; wgid = (xcd < r ? xcd * (q + 1) : r * (q + 1) + (xcd - r) * q) + off; }
        const int nig = WGM * nN, gid = wgid / nig, fm = gid * WGM, gsz = (nM - fm) < WGM ? (nM - fm) : WGM;
        u.pm = fm + ((wgid % nig) % gsz); u.pn = (wgid % nig) / gsz;
    }
    __device__ __forceinline__ bool next(int i, Unit& u) const {
        if (i < nfull) { map(i * G + c, u); u.kb = 0; u.nk = nt; u.tinfo = -1; return true; }
        if (i > nfull || R == 0) return false;
        if (ns < 2) { const int L = i * G + c; if (L >= nwg) return false; map(L, u); u.kb = 0; u.nk = nt; u.tinfo = -1; return true; }
        const int x = c % 8, y = c / 8, tj = (y / ns) * 8 + x, slice = y % ns;
        if (tj >= R) return false;
        map(nfull * G + tj, u);
        const int pairs = nt / 2, base = pairs / ns, rem = pairs % ns, start = slice * base + (slice < rem ? slice : rem), mine = base + (slice < rem ? 1 : 0);
        u.kb = 2 * start; u.nk = 2 * mine; u.tinfo = (tj << 8) | (slice << 4) | ns; return true;
    }
};
struct TailCtx { f32x4* slab; unsigned* cnt; };

template <class Epi>
__device__ __forceinline__ void tail_fixup(f32x4 (&acc)[2][2][4][2], const Unit& u, const Epi& E, const TailCtx& T, int tid, int wr, int wc, int fr, int fq) {
    const int tj = u.tinfo >> 8, slice = (u.tinfo >> 4) & 15, ns = u.tinfo & 15;
    const __amdgpu_buffer_rsrc_t srs = __builtin_amdgcn_make_buffer_rsrc((void*)(T.slab + (size_t)(tj * ns + slice) * (32 * 512)), (short)0, 32 * 512 * 16, 0x00020000);
#pragma unroll
    for (int ai = 0; ai < 2; ++ai)
#pragma unroll
        for (int bj = 0; bj < 2; ++bj)
#pragma unroll
            for (int m = 0; m < 4; ++m)
#pragma unroll
                for (int n = 0; n < 2; ++n) __builtin_amdgcn_raw_buffer_store_b128(__builtin_bit_cast(u32x4, acc[ai][bj][m][n]), srs, (unsigned)(((((ai * 2 + bj) * 4 + m) * 2 + n) * 512 + tid) * 16), 0, 16);
    asm volatile("s_waitcnt vmcnt(0)" ::: "memory");
    __syncthreads();
    if (tid == 0) __hip_atomic_fetch_add(T.cnt + 64 * tj, 1u, __ATOMIC_RELAXED, __HIP_MEMORY_SCOPE_AGENT);
    if (tid < 64) {
        unsigned sp = 0;
        while (__hip_atomic_load(T.cnt + 64 * tj, __ATOMIC_RELAXED, __HIP_MEMORY_SCOPE_AGENT) < (unsigned)ns && ++sp < (1u << 22)) __builtin_amdgcn_s_sleep(2);
        __builtin_amdgcn_fence(__ATOMIC_ACQUIRE, "agent");
        asm volatile("s_waitcnt vmcnt(0)" ::: "memory");
    }
    __syncthreads();
    unsigned gmask = 0u;
    for (int g = slice; g < 8; g += ns) gmask |= 1u << g;
    const f32x4* tile = T.slab + (size_t)(tj * ns) * (32 * 512);
#pragma unroll
    for (int ai = 0; ai < 2; ++ai)
#pragma unroll
        for (int m = 0; m < 4; ++m) {
            if (!((gmask >> (ai * 4 + m)) & 1u)) continue;
#pragma unroll
            for (int bj = 0; bj < 2; ++bj)
#pragma unroll
                for (int n = 0; n < 2; ++n) {
                    const int idx = ((ai * 2 + bj) * 4 + m) * 2 + n;
                    f32x4 v = tile[idx * 512 + tid];
                    for (int sl = 1; sl < ns; ++sl) v = v + tile[(size_t)sl * (32 * 512) + idx * 512 + tid];
                    acc[ai][bj][m][n] = v;
                }
        }
    E(acc, u, wr, wc, fr, fq, gmask);
}

template <class Epi, class Sched>
__device__ __forceinline__ void gemm_phase2(PG8_LAS unsigned char* lds, const Gemm g, const Sched& S, const Epi& E, const TailCtx& T) {
    int tid_ = threadIdx.x; asm volatile("" : "+v"(tid_));
    const int tid = tid_, wid = __builtin_amdgcn_readfirstlane(tid >> 6), lane = tid & 63, wr = wid >> 2, wc = wid & 3, fr = lane & 15, fq = lane >> 4;
    const int K = g.K;
    unsigned voffA[2], voffB[2];
#pragma unroll
    for (int i = 0; i < 2; ++i) { int R, C; stage_rc(tid * 16 + i * 8192, R, C); const int Rb = Epi::PERM ? ((R & ~31) + perm32(R & 31)) : R;
        voffA[i] = (unsigned)(R * K + C) * 2u; voffB[i] = (unsigned)(Rb * K + C) * 2u; }
    const size_t kstep = (size_t)(BK * 2), hstep = (size_t)HALF * K * 2, tstep = 2 * hstep;
    const unsigned ldsw = (unsigned)wid * 1024u;
    const int aoff = lds_byte(wr * 64 + fr, fq * 8), boff = lds_byte(wc * 32 + fr, fq * 8);
#define PG8_SA(b, h) (((b) * 2 + (h)) * HTB)
#define PG8_SB(b, h) ((4 + (b) * 2 + (h)) * HTB)
#define PG8_STAGE(bufoff, gbase, voff) do { _Pragma("unroll") for (int _i = 0; _i < 2; ++_i) \
        __builtin_amdgcn_global_load_lds((const unsigned*)((const char*)(gbase) + (voff)[_i]), (PG8_LAS unsigned*)(lds + (bufoff) + ldsw + _i * 8192), 16, 0, 0); } while (0)
#define PG8_LDA(dst, b, h) do { _Pragma("unroll") for (int m = 0; m < 4; ++m) _Pragma("unroll") for (int k = 0; k < 2; ++k) dst[m][k] = *(const PG8_LAS bf16x8*)(lds + PG8_SA(b, h) + aoff + m * 2048 + k * 1024); } while (0)
#define PG8_LDB(dst, b, h) do { _Pragma("unroll") for (int n = 0; n < 2; ++n) _Pragma("unroll") for (int k = 0; k < 2; ++k) dst[n][k] = *(const PG8_LAS bf16x8*)(lds + PG8_SB(b, h) + boff + n * 2048 + k * 1024); } while (0)
#define PG8_MMA(ai, bj, At, Bt) do { __builtin_amdgcn_s_setprio(1); _Pragma("unroll") for (int m = 0; m < 4; ++m) _Pragma("unroll") for (int n = 0; n < 2; ++n) _Pragma("unroll") for (int k = 0; k < 2; ++k) \
        acc[ai][bj][m][n] = __builtin_amdgcn_mfma_f32_16x16x32_bf16(Bt[n][k], At[m][k], acc[ai][bj][m][n], 0, 0, 0); __builtin_amdgcn_s_setprio(0); } while (0)
#define PG8_WAIT_V(n) asm volatile("s_waitcnt vmcnt(" #n ")" ::: "memory")
#define PG8_WAIT_L(n) asm volatile("s_waitcnt lgkmcnt(" #n ")" ::: "memory")
#define PG8_BAR __builtin_amdgcn_s_barrier()
#define PG8_SCHED __builtin_amdgcn_sched_barrier(0)
    Unit cur, nxt; int ui = 0;
    if (!S.next(0, cur)) return;
    f32x4 acc[2][2][4][2];
#pragma unroll
    for (int a = 0; a < 2; ++a)
#pragma unroll
        for (int b = 0; b < 2; ++b)
#pragma unroll
            for (int m = 0; m < 4; ++m)
#pragma unroll
                for (int n = 0; n < 2; ++n) acc[a][b][m][n] = (f32x4){0.f, 0.f, 0.f, 0.f};
    bf16x8 At[4][2], B0[2][2], B1[2][2];
    const char* cA = (const char*)g.A + (size_t)cur.pm * tstep + (size_t)cur.kb * kstep; const char* cB = (const char*)g.Bt + (size_t)cur.pn * tstep + (size_t)cur.kb * kstep;
    PG8_STAGE(PG8_SB(0, 0), cB, voffB); PG8_STAGE(PG8_SB(0, 1), cB + hstep, voffB); PG8_STAGE(PG8_SA(0, 0), cA, voffA); PG8_STAGE(PG8_SA(0, 1), cA + hstep, voffA);
    if (wr == 1) PG8_BAR;
    PG8_WAIT_V(2); PG8_BAR;
    PG8_STAGE(PG8_SB(1, 0), cB + kstep, voffB); PG8_STAGE(PG8_SA(1, 0), cA + kstep, voffA); PG8_STAGE(PG8_SB(1, 1), cB + hstep + kstep, voffB);
    PG8_WAIT_V(6); PG8_BAR;
    for (;;) {
        const bool has_next = S.next(ui + 1, nxt);
        const char* nA = has_next ? (const char*)g.A + (size_t)nxt.pm * tstep + (size_t)nxt.kb * kstep : cA; const char* nB = has_next ? (const char*)g.Bt + (size_t)nxt.pn * tstep + (size_t)nxt.kb * kstep : cB;
        const int nt = cur.nk;
        for (int t = 0; t < nt; t += 2) {
            const bool last = (t == nt - 2);
            const char* a1 = cA + (size_t)(t + 1) * kstep;
            const char* a2 = last ? nA : cA + (size_t)(t + 2) * kstep; const char* b2 = last ? nB : cB + (size_t)(t + 2) * kstep;
            const char* a3 = a2 + kstep; const char* b3 = b2 + kstep;
            PG8_LDB(B0, 0, 0); PG8_LDB(B1, 0, 1); PG8_SCHED; PG8_LDA(At, 0, 0); PG8_STAGE(PG8_SA(1, 1), a1 + hstep, voffA);
            PG8_WAIT_V(8); PG8_WAIT_L(0); PG8_BAR; PG8_MMA(0, 0, At, B0); PG8_MMA(0, 1, At, B1); PG8_BAR; PG8_SCHED;
            PG8_LDA(At, 0, 1); PG8_STAGE(PG8_SB(0, 0), b2, voffB); PG8_STAGE(PG8_SB(0, 1), b2 + hstep, voffB); PG8_STAGE(PG8_SA(0, 0), a2, voffA);
            PG8_WAIT_V(8); PG8_WAIT_L(0); PG8_BAR; PG8_MMA(1, 0, At, B0); PG8_MMA(1, 1, At, B1); PG8_BAR; PG8_SCHED;
            PG8_LDB(B0, 1, 0); PG8_LDB(B1, 1, 1); PG8_SCHED; PG8_LDA(At, 1, 0); PG8_STAGE(PG8_SA(0, 1), a2 + hstep, voffA);
            PG8_WAIT_V(8); PG8_WAIT_L(0); PG8_BAR; PG8_MMA(0, 0, At, B0); PG8_MMA(0, 1, At, B1); PG8_BAR; PG8_SCHED;
            PG8_LDA(At, 1, 1); PG8_STAGE(PG8_SB(1, 0), b3, voffB); PG8_STAGE(PG8_SB(1, 1), b3 + hstep, voffB); PG8_STAGE(PG8_SA(1, 0), a3, voffA);
            PG8_WAIT_V(8); PG8_WAIT_L(0); PG8_BAR; PG8_MMA(1, 0, At, B0); PG8_MMA(1, 1, At, B1); PG8_BAR; PG8_SCHED;
        }
        if (wr == 0) PG8_BAR;
        if (cur.tinfo < 0) E(acc, cur, wr, wc, fr, fq);
        if (!has_next) break;
#pragma unroll
        for (int a = 0; a < 2; ++a)
#pragma unroll
            for (int b = 0; b < 2; ++b)
#pragma unroll
                for (int m = 0; m < 4; ++m)
#pragma unroll
                    for (int n = 0; n < 2; ++n) acc[a][b][m][n] = (f32x4){0.f, 0.f, 0.f, 0.f};
        cur = nxt; cA = nA; cB = nB; ++ui;
        if (wr == 1) PG8_BAR;
    }
    PG8_WAIT_V(0);
    PG8_BAR;
    if (cur.tinfo >= 0) tail_fixup(acc, cur, E, T, tid, wr, wc, fr, fq);
#undef PG8_SA
#undef PG8_SB
#undef PG8_STAGE
#undef PG8_LDA
#undef PG8_LDB
#undef PG8_MMA
#undef PG8_WAIT_V
#undef PG8_WAIT_L
#undef PG8_BAR
#undef PG8_SCHED
}
}
#define LAS __attribute__((address_space(3)))
typedef unsigned short bf16;
using pg8::f32x4; using pg8::u32x4; using pg8::u32x2; using pg8::bf16x8; using pg8::cvt_pk_bf16;

#ifndef ONE_LAUNCH
#define ONE_LAUNCH 1
#endif
constexpr int NWAVES = 8, NPHASE = 7;
constexpr int LDS_BYTES = 147456;
constexpr size_t MiB = 1u << 20;
constexpr size_t WS_CTL = 0, CTL_ZERO_BYTES = 1 * MiB;
constexpr size_t WS_WIN = 1 * MiB;
constexpr size_t WS_WO = 21 * MiB;
constexpr size_t WS_WGU = 29 * MiB;
constexpr size_t WS_WD = 73 * MiB;
constexpr size_t WS_WP = 95 * MiB;
constexpr size_t WS_MISC = 96 * MiB;
constexpr size_t WS_XB = 97 * MiB;
constexpr size_t WS_ZB = 133 * MiB;
constexpr size_t WS_LF = 223 * MiB;
constexpr size_t WS_ACT = WS_ZB;
constexpr size_t WS_MIX = 259 * MiB;
constexpr size_t WS_END = 296 * MiB;
constexpr int CW_RSQ2 = 4096, CW_RSQ3 = 4096 + M;
constexpr int CW_TAIL = 100000;
constexpr size_t WS_SLAB3 = WS_ACT, WS_SLAB45 = 232 * MiB;
constexpr int CW_BAR = 65536;
constexpr int MISC_OFF = 147456 - 256;
#ifndef USE_CG
#define USE_CG 0
#endif

__device__ __forceinline__ float wave_sum(float v) {
#pragma unroll
    for (int o = 1; o < 64; o <<= 1) v += __shfl_xor(v, o);
    return v;
}
__device__ __forceinline__ float bf2f(bf16 b) { return __builtin_bit_cast(float, (unsigned)b << 16); }
__device__ __forceinline__ bf16 f2bf(float f) { unsigned u = __builtin_bit_cast(unsigned, f); return (bf16)((u + 0x7fffu + ((u >> 16) & 1u)) >> 16); }

#define XB_TMO      128
#define XB_XCNT(j)  (256  + 64 * (j))
#define XB_XSUB(j)  (1280 + 64 * (j))
#define XB_XGEN(j)  (2304 + 64 * (j))
#define XB_TOP      3328
#define XB_TOPGEN   3392
#define XCD_BAR_WORDS 3456
#define XB_SPIN_CAP (1u << 18)

__device__ __forceinline__ unsigned xb_ld(unsigned* p)              { return __hip_atomic_load(p, __ATOMIC_RELAXED, __HIP_MEMORY_SCOPE_AGENT); }
__device__ __forceinline__ unsigned xb_add(unsigned* p, unsigned v) { return __hip_atomic_fetch_add(p, v, __ATOMIC_RELAXED, __HIP_MEMORY_SCOPE_AGENT); }
__device__ __forceinline__ unsigned xb_xcc_id() { return (unsigned)__builtin_amdgcn_s_getreg((3 << 11) | 20) & 0xFu; }
#define XB_SPIN(cond, bar) do { unsigned _sp = 0; while (cond) { __builtin_amdgcn_s_sleep(1); \
    if ((++_sp & 255u) == 0u) { if (xb_ld(&(bar)[XB_TMO])) break; if (_sp > XB_SPIN_CAP) { atomicAdd(&(bar)[XB_TMO], 1u); break; } } } } while (0)

struct XcdBarrier {
    unsigned* bar; unsigned x;
    volatile LAS unsigned* st;
};

__device__ __forceinline__ XcdBarrier xcd_barrier_post(unsigned* bar, volatile LAS unsigned* st) {
    XcdBarrier b; b.bar = bar; b.x = xb_xcc_id(); b.st = st;
    if (threadIdx.x == 0) (void)xb_add(&bar[XB_XCNT(b.x)], 1u);
    return b;
}
__device__ __forceinline__ void xcd_barrier_complete(unsigned* bar, unsigned x, unsigned& nloc, unsigned& nx) {
    const unsigned G = gridDim.x * gridDim.y * gridDim.z;
    unsigned sum, cnt, mine, sp = 0u;
    for (;;) {
        sum = 0u; cnt = 0u; mine = 0u;
#pragma unroll
        for (unsigned j = 0; j < 16; ++j) { const unsigned c = xb_ld(&bar[XB_XCNT(j)]); sum += c; cnt += (c > 0u) ? 1u : 0u; mine = (j == x) ? c : mine; }
        if (sum == G) break;
        __builtin_amdgcn_s_sleep(1);
        if ((++sp & 255u) == 0u) { if (xb_ld(&bar[XB_TMO])) break; if (sp > XB_SPIN_CAP) { atomicAdd(&bar[XB_TMO], 1u); break; } }
    }
    nloc = mine > 0u ? mine : 1u; nx = cnt > 0u ? cnt : 1u;
}

__device__ __forceinline__ void xcd_barrier(const XcdBarrier& b) {
    asm volatile("s_waitcnt vmcnt(0)" ::: "memory");
    __syncthreads();
    if (threadIdx.x == 0) {
        unsigned* bar = b.bar;
        __builtin_amdgcn_s_waitcnt(0);
        unsigned nloc = b.st[0], nx = b.st[1];
        if (nloc == 0u) { xcd_barrier_complete(bar, b.x, nloc, nx); b.st[0] = nloc; b.st[1] = nx; }
        const unsigned old = xb_add(&bar[XB_XSUB(b.x)], 1u);
        const unsigned gen = old / nloc;
        if (old + 1u == (gen + 1u) * nloc) {
            __builtin_amdgcn_fence(__ATOMIC_RELEASE, "agent");
            asm volatile("s_waitcnt vmcnt(0)" ::: "memory");
            const unsigned og = xb_add(&bar[XB_TOP], 1u);
            const unsigned tg = og / nx;
            if (og + 1u == (tg + 1u) * nx) xb_add(&bar[XB_TOPGEN], 1u);
            else XB_SPIN(xb_ld(&bar[XB_TOPGEN]) == tg, bar);
            __builtin_amdgcn_fence(__ATOMIC_ACQUIRE, "agent");
            xb_add(&bar[XB_XGEN(b.x)], 1u);
            asm volatile("s_waitcnt vmcnt(0)" ::: "memory");
        } else {
            XB_SPIN(xb_ld(&bar[XB_XGEN(b.x)]) == gen, bar);
            __builtin_amdgcn_fence(__ATOMIC_ACQUIRE, "agent");
            asm volatile("s_waitcnt vmcnt(0)" ::: "memory");
        }
    }
    __syncthreads();
}

struct Args { const float* in[16]; float* out; unsigned char* ws; int ph_lo, ph_hi; };

__device__ __forceinline__ void p0_item(const float* W, int K, int N, bf16* WT, int mode, const float* sk, const float* sn, LAS float* scr, int item, int lane) {
    const int nblk = N / 64, kb = item / nblk, nb = item % nblk, k0 = 64 * kb, n0 = 64 * nb;
    const int drow0 = mode == 0 ? n0 : ((n0 >> 7) * 256 + (n0 & 127) + (mode == 2 ? 128 : 0));
    const int r = lane >> 4, c4 = lane & 15;
    f32x4 v[16];
#pragma unroll
    for (int i = 0; i < 16; ++i) v[i] = *(const f32x4*)(W + (size_t)(k0 + 4 * i + r) * N + n0 + 4 * c4);
    if (sk) {
#pragma unroll
        for (int i = 0; i < 16; ++i) v[i] = v[i] * sk[k0 + 4 * i + r];
    }
#pragma unroll
    for (int i = 0; i < 16; ++i) { LAS float* d = scr + (4 * i + r) * 65 + 4 * c4; d[0] = v[i][0]; d[1] = v[i][1]; d[2] = v[i][2]; d[3] = v[i][3]; }
    asm volatile("s_waitcnt lgkmcnt(0)" ::: "memory");
    const int c = lane & 7, nn = lane >> 3;
#pragma unroll
    for (int j = 0; j < 8; ++j) { const int n = nn + 8 * j; const LAS float* s = scr + (8 * c) * 65 + n; const float f = sn ? sn[n0 + n] : 1.f;
        u32x4 o; o.x = cvt_pk_bf16(s[0 * 65] * f, s[1 * 65] * f); o.y = cvt_pk_bf16(s[2 * 65] * f, s[3 * 65] * f); o.z = cvt_pk_bf16(s[4 * 65] * f, s[5 * 65] * f); o.w = cvt_pk_bf16(s[6 * 65] * f, s[7 * 65] * f);
        *(u32x4*)(WT + (size_t)(drow0 + n) * K + k0 + 8 * c) = o; }
    asm volatile("s_waitcnt lgkmcnt(0)" ::: "memory");
}

__device__ __forceinline__ void phase0(LAS unsigned char* lds, const Args& a, int vcu, int G) {
    const int tid = threadIdx.x, lane = tid & 63, wave = tid >> 6;
    unsigned char* ws = a.ws;
    LAS float* scr = (LAS float*)(lds + wave * 16640);
    const int gw = vcu * NWAVES + wave, NGW = G * NWAVES;
    constexpr int I_IN = (D / 64) * (INC / 64), I_O = (D / 64) * (D / 64), I_G = (D / 64) * (DFF / 64), I_D = (DFF / 64) * (D / 64), I_P = (256 / 64) * (256 / 64);
    constexpr int NITEMS = I_IN + I_O + 2 * I_G + I_D + 4 * I_P;
    for (int it = gw; it < NITEMS; it += NGW) {
        int r = it;
        if (r < I_IN) { p0_item(a.in[6], D, INC, (bf16*)(ws + WS_WIN), 0, a.in[5], nullptr, scr, r, lane); continue; } r -= I_IN;
        if (r < I_O) { p0_item(a.in[10], D, D, (bf16*)(ws + WS_WO), 0, nullptr, nullptr, scr, r, lane); continue; } r -= I_O;
        if (r < I_G) { p0_item(a.in[12], D, DFF, (bf16*)(ws + WS_WGU), 1, a.in[11], nullptr, scr, r, lane); continue; } r -= I_G;
        if (r < I_G) { p0_item(a.in[13], D, DFF, (bf16*)(ws + WS_WGU), 2, a.in[11], nullptr, scr, r, lane); continue; } r -= I_G;
        if (r < I_D) { p0_item(a.in[14], DFF, D, (bf16*)(ws + WS_WD), 0, nullptr, nullptr, scr, r, lane); continue; } r -= I_D;
        { const int g = r / I_P; p0_item(a.in[7] + (size_t)g * 65536, 256, 256, (bf16*)(ws + WS_WP) + (size_t)g * 65536, 0, nullptr, a.in[8] + g * 256, scr, r % I_P, lane); }
    }
    float* rstd1 = (float*)(ws + WS_MISC); bf16* xb = (bf16*)(ws + WS_XB);
    for (int m = gw; m < M; m += NGW) {
        const float* xrow = m < MP ? a.in[0] + (size_t)m * D : a.in[1] + (size_t)(m - MP) * D;
        f32x4 v[8]; float s = 0.f;
#pragma unroll
        for (int j = 0; j < 8; ++j) { v[j] = ((const f32x4*)xrow)[lane + 64 * j]; s += (v[j][0] * v[j][0] + v[j][1] * v[j][1]) + (v[j][2] * v[j][2] + v[j][3] * v[j][3]); }
        s = wave_sum(s);
        if (lane == 0) rstd1[m] = rsqrtf(s * (1.f / D) + EPS);
#pragma unroll
        for (int j = 0; j < 8; ++j) { u32x2 w; w.x = cvt_pk_bf16(v[j][0], v[j][1]); w.y = cvt_pk_bf16(v[j][2], v[j][3]); ((u32x2*)(xb + (size_t)m * D))[lane + 64 * j] = w; }
    }
    const int gt = vcu * (NWAVES * 64) + tid, NGT = G * NWAVES * 64;
    float* lbv = (float*)(ws + WS_MISC) + M;
    for (int c = gt; c < HW; c += NGT) lbv[c] = 1.f / (1.f + __expf(a.in[4][HW + c] - a.in[4][c]));
    for (int i = gt; i < DB * 7 * PW; i += NGT) { const int b = i / (7 * PW), rem = i % (7 * PW); a.out[O_PSS + (size_t)b * PC * PW + rem] = a.in[2][(size_t)b * PC * PW + 8 * PW + rem]; }
}

template <int W>
__device__ __forceinline__ void pool_fill(LAS bf16* A, int m0, int g, const bf16* zb, const float* cache) {
    const int tid = threadIdx.x, c = tid & 255, rh = tid >> 8;
    constexpr int LDA = 264;
    const int col = g * 256 + c;
    if (m0 < MP) {
        const int mb = m0 + rh * 32 - 15, tb = (m0 & (SEQ - 1)) + rh * 32 - 15;
        float ur[47];
#pragma unroll
        for (int i = 0; i < 47; ++i) ur[i] = (tb + i >= 0) ? bf2f(zb[(size_t)(mb + i) * INC + col]) : 0.f;
        float s = 0.f;
#pragma unroll
        for (int j = 1; j < W; ++j) s += ur[15 - j];
#pragma unroll
        for (int r = 0; r < 32; ++r) {
            s += ur[15 + r];
            const int t = tb + 15 + r;
            const float cnt = (float)min(t + 1, W);
            A[(rh * 32 + r) * LDA + c] = f2bf(s / cnt - ur[15 + r]);
            s -= ur[15 + r - (W - 1)];
        }
    } else {
#pragma unroll 1
        for (int bb = 0; bb < 4; ++bb) {
            const int r0 = rh * 32 + bb * 8, m = m0 + r0, b = (m - MP) >> 3;
            float hs[23];
#pragma unroll
            for (int i = 0; i < 15; ++i) hs[i] = cache[((size_t)b * PC + i) * PW + col];
#pragma unroll
            for (int i = 0; i < 8; ++i) hs[15 + i] = bf2f(zb[(size_t)(m + i) * INC + col]);
            float s = 0.f;
#pragma unroll
            for (int j = 1; j < W; ++j) s += hs[15 - j];
#pragma unroll
            for (int t = 0; t < 8; ++t) {
                s += hs[15 + t];
                A[(r0 + t) * LDA + c] = f2bf(s * (1.f / W) - hs[15 + t]);
                s -= hs[15 + t - (W - 1)];
            }
        }
    }
}
__device__ __forceinline__ void pool_item(LAS unsigned char* lds, int item, const bf16* zb, const float* cache, const bf16* WpT, bf16* mixb) {
    const int tile = item >> 2, g = item & 3, m0 = tile * 64;
    const int tid = threadIdx.x;
    constexpr int LDA = 264;
    LAS bf16* A = (LAS bf16*)lds;
    if (g == 0) pool_fill<2>(A, m0, g, zb, cache); else if (g == 1) pool_fill<4>(A, m0, g, zb, cache); else if (g == 2) pool_fill<8>(A, m0, g, zb, cache); else pool_fill<16>(A, m0, g, zb, cache);
    __syncthreads();
    const int wave = tid >> 6, lane = tid & 63, fr = lane & 15, fq = lane >> 4, n0 = wave * 32;
    f32x4 acc[4][2];
#pragma unroll
    for (int i = 0; i < 4; ++i)
#pragma unroll
        for (int j = 0; j < 2; ++j) acc[i][j] = (f32x4){0.f, 0.f, 0.f, 0.f};
#pragma unroll 2
    for (int ks = 0; ks < 8; ++ks) {
        bf16x8 wf[2], af[4];
#pragma unroll
        for (int nt = 0; nt < 2; ++nt) wf[nt] = *(const bf16x8*)(WpT + (size_t)(g * 256 + n0 + nt * 16 + fr) * 256 + ks * 32 + fq * 8);
#pragma unroll
        for (int mt = 0; mt < 4; ++mt) af[mt] = *(const LAS bf16x8*)(A + (mt * 16 + fr) * LDA + ks * 32 + fq * 8);
#pragma unroll
        for (int mt = 0; mt < 4; ++mt)
#pragma unroll
            for (int nt = 0; nt < 2; ++nt) acc[mt][nt] = __builtin_amdgcn_mfma_f32_16x16x32_bf16(wf[nt], af[mt], acc[mt][nt], 0, 0, 0);
    }
#pragma unroll
    for (int mt = 0; mt < 4; ++mt)
#pragma unroll
        for (int nt = 0; nt < 2; ++nt) {
            u32x2 o; o.x = cvt_pk_bf16(acc[mt][nt][0], acc[mt][nt][1]); o.y = cvt_pk_bf16(acc[mt][nt][2], acc[mt][nt][3]);
            *(u32x2*)(mixb + (size_t)(m0 + mt * 16 + fr) * D + g * 256 + n0 + nt * 16 + 4 * fq) = o;
        }
    __syncthreads();
}

struct SampleRegs { f32x4 S[8]; };
__device__ __forceinline__ void sample_load(SampleRegs& R, const float* S0) {
    const int tid = threadIdx.x, v4 = tid & 31, kq = tid >> 5;
#pragma unroll
    for (int kk = 0; kk < 8; ++kk) R.S[kk] = *(const f32x4*)(S0 + (size_t)(kq * 8 + kk) * HD + 4 * v4);
}
__device__ __forceinline__ void sample_run(LAS unsigned char* lds, SampleRegs& R, const bf16* zb, const float* lf, const float* hgn, float* Sout, bf16* mixb, int row0, int h) {
    const int tid = threadIdx.x, v4 = tid & 31, kq = tid >> 5, wave = tid >> 6, lane = tid & 63;
    LAS float* sq = (LAS float*)lds; LAS float* sf = sq + 1024; LAS float* sk = sf + 1024; LAS float* sv = sk + 1024; LAS float* red = sv + 1024;
    for (int i = tid; i < 1024; i += 512) {
        const int t = i >> 7, ch = i & 127; const size_t row = (size_t)(row0 + t);
        const float f = __builtin_amdgcn_exp2f(lf[row * HW + h * HD + ch]);
        sq[i] = bf2f(zb[row * INC + PW + h * HD + ch]); sf[i] = f; sk[i] = 1.f - f; sv[i] = bf2f(zb[row * INC + PW + 2 * HW + h * HD + ch]);
    }
    __syncthreads();
#pragma unroll 1
    for (int t = 0; t < 8; ++t) {
        const f32x4 vt = *(const LAS f32x4*)(sv + t * 128 + 4 * v4);
        f32x4 o = (f32x4){0.f, 0.f, 0.f, 0.f};
        const f32x4 f0 = *(const LAS f32x4*)(sf + t * 128 + kq * 8), f1 = *(const LAS f32x4*)(sf + t * 128 + kq * 8 + 4);
        const f32x4 k0 = *(const LAS f32x4*)(sk + t * 128 + kq * 8), k1 = *(const LAS f32x4*)(sk + t * 128 + kq * 8 + 4);
        const f32x4 q0 = *(const LAS f32x4*)(sq + t * 128 + kq * 8), q1 = *(const LAS f32x4*)(sq + t * 128 + kq * 8 + 4);
#pragma unroll
        for (int kk = 0; kk < 8; ++kk) {
            const float f = kk < 4 ? f0[kk & 3] : f1[kk & 3], kn = kk < 4 ? k0[kk & 3] : k1[kk & 3], q = kk < 4 ? q0[kk & 3] : q1[kk & 3];
            R.S[kk] = R.S[kk] * f + vt * kn;
            o = o + R.S[kk] * q;
        }
#pragma unroll
        for (int j = 0; j < 4; ++j) o[j] += __shfl_xor(o[j], 32);
        if (lane < 32) *(LAS f32x4*)(red + (wave * 8 + t) * 128 + 4 * v4) = o;
    }
#pragma unroll
    for (int kk = 0; kk < 8; ++kk) *(f32x4*)(Sout + (size_t)(kq * 8 + kk) * HD + 4 * v4) = R.S[kk];
    __syncthreads();
    {
        const int t = wave; const size_t row = (size_t)(row0 + t);
        float o0 = 0.f, o1 = 0.f;
#pragma unroll
        for (int w8 = 0; w8 < 8; ++w8) { o0 += red[(w8 * 8 + t) * 128 + lane]; o1 += red[(w8 * 8 + t) * 128 + lane + 64]; }
        const float ss = wave_sum(o0 * o0 + o1 * o1), r = rsqrtf(ss * (1.f / HD) + EPS);
        const int ch0 = h * HD + lane, ch1 = ch0 + 64;
        mixb[row * D + PW + ch0] = f2bf(o0 * r * hgn[ch0] * bf2f(zb[row * INC + PW + 3 * HW + ch0]));
        mixb[row * D + PW + ch1] = f2bf(o1 * r * hgn[ch1] * bf2f(zb[row * INC + PW + 3 * HW + ch1]));
    }
    __syncthreads();
}

constexpr int CQS = 272, CTS = 144;
constexpr int L_Q = 0, L_K = L_Q + 64 * CQS, L_KT = L_K + 64 * CQS, L_VT = L_KT + 128 * CTS, L_ST = L_VT + 128 * CTS, L_P = L_ST + 128 * CQS,
              L_DS = L_P + 64 * CTS, L_TOT = L_DS + 512, L_RMS = L_TOT + 2048, L_CHAIN_END = L_RMS + 512;
static_assert(L_CHAIN_END <= 131072, "chain LDS");
template <bool FULL>
__device__ __forceinline__ void seg_run(LAS unsigned char* lds, const bf16* zb, const float* lf, f32x4 (&Sacc)[8], float& segsum, const f32x4 (&gnr)[4], bf16* mixb, int rowb, int nsteps, int h) {
    const int tid = threadIdx.x, lane = tid & 63, wave = __builtin_amdgcn_readfirstlane(tid >> 6), fr = lane & 15, fq = lane >> 4;
    const int k = tid & 127, tg = tid >> 7;
    const size_t cq = PW + h * HD + k, ck = PW + HW + h * HD + k, cv = PW + 2 * HW + h * HD + k, cl = h * HD + k;
    LAS float* dS = (LAS float*)(lds + L_DS); LAS float* tot = (LAS float*)(lds + L_TOT); LAS float* rmsp = (LAS float*)(lds + L_RMS);
    float lfr[16]; bf16 sqr[16], knr[16], vr[16];
    {
        float s = 0.f;
#pragma unroll
        for (int j = 0; j < 16; ++j) { const size_t row = (size_t)(rowb + 16 * tg + j); lfr[j] = lf[row * HW + cl]; knr[j] = zb[row * INC + ck]; vr[j] = zb[row * INC + cv]; if (FULL) sqr[j] = zb[row * INC + cq]; s += lfr[j]; }
        tot[tg * 128 + k] = s;
    }
    if (FULL) {
#pragma unroll
        for (int kt = 0; kt < 8; ++kt) {
            u32x2 w; w.x = cvt_pk_bf16(Sacc[kt][0], Sacc[kt][1]); w.y = cvt_pk_bf16(Sacc[kt][2], Sacc[kt][3]);
            *(LAS u32x2*)(lds + L_ST + (16 * wave + fr) * CQS + (16 * kt + 4 * fq) * 2) = w;
        }
    }
    __syncthreads();
    for (int c = 0; c < nsteps; ++c) {
        {
            float b = 0.f;
#pragma unroll
            for (int g = 0; g < 3; ++g) b += (g < tg) ? tot[g * 128 + k] : 0.f;
            unsigned ktp[8], vtp[8];
#pragma unroll
            for (int jp = 0; jp < 8; ++jp) {
                const int j0 = 2 * jp, j1 = j0 + 1, t0 = 16 * tg + j0;
                const float b0 = b + lfr[j0], b1 = b0 + lfr[j1]; b = b1;
                const unsigned kp = cvt_pk_bf16(bf2f(knr[j0]) * __builtin_amdgcn_exp2f(-b0), bf2f(knr[j1]) * __builtin_amdgcn_exp2f(-b1));
                ktp[jp] = kp; vtp[jp] = (unsigned)vr[j0] | ((unsigned)vr[j1] << 16);
                if (FULL) {
                    const unsigned qp = cvt_pk_bf16(bf2f(sqr[j0]) * __builtin_amdgcn_exp2f(b0), bf2f(sqr[j1]) * __builtin_amdgcn_exp2f(b1));
                    *(LAS bf16*)(lds + L_Q + t0 * CQS + k * 2) = (bf16)(qp & 0xffffu); *(LAS bf16*)(lds + L_Q + (t0 + 1) * CQS + k * 2) = (bf16)(qp >> 16);
                    *(LAS bf16*)(lds + L_K + t0 * CQS + k * 2) = (bf16)(kp & 0xffffu); *(LAS bf16*)(lds + L_K + (t0 + 1) * CQS + k * 2) = (bf16)(kp >> 16);
                }
            }
            *(LAS u32x4*)(lds + L_KT + k * CTS + tg * 32) = (u32x4){ktp[0], ktp[1], ktp[2], ktp[3]};
            *(LAS u32x4*)(lds + L_KT + k * CTS + tg * 32 + 16) = (u32x4){ktp[4], ktp[5], ktp[6], ktp[7]};
            *(LAS u32x4*)(lds + L_VT + k * CTS + tg * 32) = (u32x4){vtp[0], vtp[1], vtp[2], vtp[3]};
            *(LAS u32x4*)(lds + L_VT + k * CTS + tg * 32 + 16) = (u32x4){vtp[4], vtp[5], vtp[6], vtp[7]};
            if (tg == 3) { dS[k] = __builtin_amdgcn_exp2f(b); segsum += b; }
        }
        __syncthreads();
        u32x2 sgr[4];
        if (FULL) {
#pragma unroll
            for (int i = 0; i < 4; ++i) sgr[i] = *(const u32x2*)(zb + (size_t)(rowb + 64 * c + 16 * (wave & 3) + fr) * INC + PW + 3 * HW + h * HD + 16 * (4 * (wave >> 2) + i) + 4 * fq);
        }
        if (c + 1 < nsteps) {
#pragma unroll
            for (int j = 0; j < 16; ++j) { const size_t row = (size_t)(rowb + 64 * (c + 1) + 16 * tg + j); lfr[j] = lf[row * HW + cl]; knr[j] = zb[row * INC + ck]; vr[j] = zb[row * INC + cv]; if (FULL) sqr[j] = zb[row * INC + cq]; }
        }
        if (FULL) {
#pragma unroll
            for (int i = 0; i < 2; ++i) {
                const int ti = 2 * wave + i, tt = ti >> 2, st = ti & 3;
                f32x4 p = (f32x4){0.f, 0.f, 0.f, 0.f};
#pragma unroll
                for (int ks = 0; ks < 4; ++ks) {
                    const bf16x8 ka = *(const LAS bf16x8*)(lds + L_K + (16 * st + fr) * CQS + (32 * ks + 8 * fq) * 2);
                    const bf16x8 qb = *(const LAS bf16x8*)(lds + L_Q + (16 * tt + fr) * CQS + (32 * ks + 8 * fq) * 2);
                    p = __builtin_amdgcn_mfma_f32_16x16x32_bf16(ka, qb, p, 0, 0, 0);
                }
                const int t = 16 * tt + fr, s0 = 16 * st + 4 * fq;
                u32x2 w; w.x = cvt_pk_bf16(s0 + 0 <= t ? p[0] : 0.f, s0 + 1 <= t ? p[1] : 0.f); w.y = cvt_pk_bf16(s0 + 2 <= t ? p[2] : 0.f, s0 + 3 <= t ? p[3] : 0.f);
                *(LAS u32x2*)(lds + L_P + t * CTS + s0 * 2) = w;
            }
        }
        {
            bf16x8 vb[2];
#pragma unroll
            for (int ss = 0; ss < 2; ++ss) vb[ss] = *(const LAS bf16x8*)(lds + L_VT + (16 * wave + fr) * CTS + (32 * ss + 8 * fq) * 2);
#pragma unroll
            for (int kt = 0; kt < 8; ++kt)
#pragma unroll
                for (int ss = 0; ss < 2; ++ss) {
                    const bf16x8 ka = *(const LAS bf16x8*)(lds + L_KT + (16 * kt + fr) * CTS + (32 * ss + 8 * fq) * 2);
                    Sacc[kt] = __builtin_amdgcn_mfma_f32_16x16x32_bf16(ka, vb[ss], Sacc[kt], 0, 0, 0);
                }
        }
        const int tt = wave & 3, vh = wave >> 2;
        f32x4 o[4];
        if (FULL) {
            __syncthreads();
            bf16x8 pb[2], qb[4];
#pragma unroll
            for (int ss = 0; ss < 2; ++ss) pb[ss] = *(const LAS bf16x8*)(lds + L_P + (16 * tt + fr) * CTS + (32 * ss + 8 * fq) * 2);
#pragma unroll
            for (int ks = 0; ks < 4; ++ks) qb[ks] = *(const LAS bf16x8*)(lds + L_Q + (16 * tt + fr) * CQS + (32 * ks + 8 * fq) * 2);
#pragma unroll
            for (int i = 0; i < 4; ++i) {
                const int vrow = 16 * (4 * vh + i) + fr;
                f32x4 a = (f32x4){0.f, 0.f, 0.f, 0.f};
#pragma unroll
                for (int ss = 0; ss < 2; ++ss) a = __builtin_amdgcn_mfma_f32_16x16x32_bf16(*(const LAS bf16x8*)(lds + L_VT + vrow * CTS + (32 * ss + 8 * fq) * 2), pb[ss], a, 0, 0, 0);
#pragma unroll
                for (int ks = 0; ks < 4; ++ks) a = __builtin_amdgcn_mfma_f32_16x16x32_bf16(*(const LAS bf16x8*)(lds + L_ST + vrow * CQS + (32 * ks + 8 * fq) * 2), qb[ks], a, 0, 0, 0);
                o[i] = a;
            }
            float ss2 = 0.f;
#pragma unroll
            for (int i = 0; i < 4; ++i) ss2 += (o[i][0] * o[i][0] + o[i][1] * o[i][1]) + (o[i][2] * o[i][2] + o[i][3] * o[i][3]);
            ss2 += __shfl_xor(ss2, 16); ss2 += __shfl_xor(ss2, 32);
            if (fq == 0) rmsp[vh * 64 + 16 * tt + fr] = ss2;
        }
#pragma unroll
        for (int kt = 0; kt < 8; ++kt) Sacc[kt] = Sacc[kt] * *(const LAS f32x4*)(dS + 16 * kt + 4 * fq);
        if (c + 1 < nsteps) {
            float s = 0.f;
#pragma unroll
            for (int j = 0; j < 16; ++j) s += lfr[j];
            tot[tg * 128 + k] = s;
        }
        __syncthreads();
        if (FULL) {
            const int tl = 16 * tt + fr; const size_t row = (size_t)(rowb + 64 * c + tl);
            const float r = rsqrtf((rmsp[tl] + rmsp[64 + tl]) * (1.f / HD) + EPS);
#pragma unroll
            for (int i = 0; i < 4; ++i) {
                const int ch = h * HD + 16 * (4 * vh + i) + 4 * fq;
                const f32x4 gn = gnr[i];
                const u32x2 sg = sgr[i];
                const float g0 = __builtin_bit_cast(float, sg.x << 16), g1 = __builtin_bit_cast(float, sg.x & 0xffff0000u), g2 = __builtin_bit_cast(float, sg.y << 16), g3 = __builtin_bit_cast(float, sg.y & 0xffff0000u);
                u32x2 w; w.x = cvt_pk_bf16(o[i][0] * r * gn[0] * g0, o[i][1] * r * gn[1] * g1); w.y = cvt_pk_bf16(o[i][2] * r * gn[2] * g2, o[i][3] * r * gn[3] * g3);
                *(u32x2*)(mixb + row * D + PW + ch) = w;
            }
#pragma unroll
            for (int kt = 0; kt < 8; ++kt) {
                u32x2 w; w.x = cvt_pk_bf16(Sacc[kt][0], Sacc[kt][1]); w.y = cvt_pk_bf16(Sacc[kt][2], Sacc[kt][3]);
                *(LAS u32x2*)(lds + L_ST + (16 * wave + fr) * CQS + (16 * kt + 4 * fq) * 2) = w;
            }
        }
    }
    __syncthreads();
}

constexpr int CW_FLAG = 32768;
__device__ __forceinline__ void prompt_segment(LAS unsigned char* lds, const Args& a, int chain, int seg, int nseg) {
    unsigned char* ws = a.ws;
    const bf16* zb = (const bf16*)(ws + WS_ZB); const float* lf = (const float*)(ws + WS_LF); bf16* mixb = (bf16*)(ws + WS_MIX);
    const int tid = threadIdx.x, lane = tid & 63, wave = __builtin_amdgcn_readfirstlane(tid >> 6), fr = lane & 15, fq = lane >> 4, k = tid & 127, tg = tid >> 7;
    const int b = chain / NH, h = chain % NH, seglen = SEQ / nseg, nsteps = seglen / 64, rowb = b * SEQ + seg * seglen;
    f32x4* slab = (f32x4*)(ws + WS_XB);
    float* dseg = (float*)(ws + WS_XB + 16 * MiB);
    unsigned* flags = (unsigned*)(ws + WS_CTL) + CW_FLAG;
    f32x4 gnr[4];
#pragma unroll
    for (int i = 0; i < 4; ++i) gnr[i] = *(const f32x4*)(a.in[9] + h * HD + 16 * (4 * (wave >> 2) + i) + 4 * fq);
    f32x4 Sacc[8];
#pragma unroll
    for (int i = 0; i < 8; ++i) Sacc[i] = (f32x4){0.f, 0.f, 0.f, 0.f};
    float segsum = 0.f;
    if (seg + 1 < nseg) {
        seg_run<false>(lds, zb, lf, Sacc, segsum, gnr, mixb, rowb, nsteps, h);
        f32x4* my = slab + (size_t)(chain * 8 + seg) * 4096;
#pragma unroll
        for (int kt = 0; kt < 8; ++kt) my[kt * 512 + tid] = Sacc[kt];
        if (tg == 3) dseg[(chain * 8 + seg) * 128 + k] = __builtin_amdgcn_exp2f(segsum);
        asm volatile("s_waitcnt vmcnt(0)" ::: "memory");
        __syncthreads();
        if (tid == 0) { __builtin_amdgcn_fence(__ATOMIC_RELEASE, "agent"); asm volatile("s_waitcnt vmcnt(0)" ::: "memory"); __hip_atomic_store(flags + 64 * (chain * 8 + seg), 1u, __ATOMIC_RELAXED, __HIP_MEMORY_SCOPE_AGENT); }
#pragma unroll
        for (int i = 0; i < 8; ++i) Sacc[i] = (f32x4){0.f, 0.f, 0.f, 0.f};
        segsum = 0.f;
    }
    if (seg > 0) {
        if (tid < 64) {
            for (int i = 0; i < seg; ++i) { unsigned sp = 0; while (__hip_atomic_load(flags + 64 * (chain * 8 + i), __ATOMIC_RELAXED, __HIP_MEMORY_SCOPE_AGENT) == 0u && ++sp < (1u << 22)) __builtin_amdgcn_s_sleep(2); }
            __builtin_amdgcn_fence(__ATOMIC_ACQUIRE, "agent");
            asm volatile("s_waitcnt vmcnt(0)" ::: "memory");
        }
        __syncthreads();
        for (int i = 0; i < seg; ++i) {
            const f32x4* rec = slab + (size_t)(chain * 8 + i) * 4096; const float* dd = dseg + (chain * 8 + i) * 128;
#pragma unroll
            for (int kt = 0; kt < 8; ++kt) Sacc[kt] = Sacc[kt] * *(const f32x4*)(dd + 16 * kt + 4 * fq) + rec[kt * 512 + tid];
        }
    }
    seg_run<true>(lds, zb, lf, Sacc, segsum, gnr, mixb, rowb, nsteps, h);
    if (seg + 1 == nseg) {
        float* Sout = a.out + O_HSP + (size_t)chain * HD * HD;
#pragma unroll
        for (int kt = 0; kt < 8; ++kt)
#pragma unroll
            for (int j = 0; j < 4; ++j) Sout[(size_t)(16 * kt + 4 * fq + j) * HD + 16 * wave + fr] = Sacc[kt][j];
    }
}

__device__ __forceinline__ void phase2(LAS unsigned char* lds, const Args& a, int bid, int G, int parts = 7) {
    unsigned char* ws = a.ws;
    const bf16* zb = (const bf16*)(ws + WS_ZB); const float* lf = (const float*)(ws + WS_LF); bf16* mixb = (bf16*)(ws + WS_MIX);
    constexpr int NPC = NB * NH, NSC = DB * NH, NPOOL = (M / 64) * 4;
    const int nseg = (G >= 8 * NPC) ? 8 : (G >= 4 * NPC ? 4 : (G >= 2 * NPC ? 2 : 1));
    if (parts & 1) {
    if (nseg > 1) { if (bid < nseg * NPC) prompt_segment(lds, a, bid / nseg, bid % nseg, nseg); }
    else for (int c = bid; c < NPC; c += G) prompt_segment(lds, a, c, 0, 1);
    }
    SampleRegs cur, nxt;
    if (bid < NSC) sample_load(cur, a.in[3] + (size_t)bid * HD * HD);
    for (int it = bid; it < NSC + NPOOL; it += G) {
        if (it < NSC ? !(parts & 2) : !(parts & 4)) continue;
        if (it < NSC) {
            const bool pf = it + G < NSC;
            if (pf) sample_load(nxt, a.in[3] + (size_t)(it + G) * HD * HD);
            sample_run(lds, cur, zb, lf, a.in[9], a.out + O_HSS + (size_t)it * HD * HD, mixb, MP + (it / NH) * DS, it % NH);
            if (pf) {
#pragma unroll
                for (int kk = 0; kk < 8; ++kk) cur.S[kk] = nxt.S[kk];
            }
        }
        else pool_item(lds, it - NSC, zb, a.in[2], (const bf16*)(ws + WS_WP), mixb);
    }
}

__device__ __forceinline__ void phase6(const Args& a, int vcu, int G) {
    const int tid = threadIdx.x, lane = tid & 63, wave = tid >> 6;
    const int gw = vcu * NWAVES + wave, NGW = G * NWAVES;
    const float* rsq3 = (const float*)(a.ws + WS_CTL) + CW_RSQ3;
    for (int m = gw; m < M; m += NGW) {
        float* yr = a.out + O_Y + (size_t)m * D;
        const float r = rsqrtf(rsq3[m] * (1.f / D) + EPS);
#pragma unroll
        for (int j = 0; j < 8; ++j) { const f32x4 v = ((const f32x4*)yr)[lane + 64 * j], g = ((const f32x4*)a.in[15])[lane + 64 * j]; ((f32x4*)yr)[lane + 64 * j] = v * r * g; }
    }
}

__global__ void __launch_bounds__(NWAVES * 64, 2) mega(Args a) {
    extern __shared__ __attribute__((aligned(16))) unsigned char lds_raw[];
    LAS unsigned char* lds = (LAS unsigned char*)lds_raw;
    const int G = gridDim.x, bid = blockIdx.x;
    const int vcu = (G % 8 == 0) ? (bid % 8) * (G / 8) + bid / 8 : bid;
    unsigned char* ws = a.ws;
    float* ctlf = (float*)(ws + WS_CTL);
    const int lo = a.ph_lo, hi = a.ph_hi;
#if ONE_LAUNCH && USE_CG
    cg::grid_group grid = cg::this_grid();
#define GRID_BAR() grid.sync()
#elif ONE_LAUNCH
    volatile LAS unsigned* MISC = (volatile LAS unsigned*)(lds + MISC_OFF);
    if (threadIdx.x < 32) MISC[threadIdx.x] = 0u;
    __syncthreads();
    XcdBarrier bar = xcd_barrier_post((unsigned*)(ws + WS_CTL) + CW_BAR, MISC + 8);
#define GRID_BAR() xcd_barrier(bar)
#else
#define GRID_BAR() do {} while (0)
#endif
#ifndef PH_MASK
#define PH_MASK 0x7f
#endif
#define IN(k) (((PH_MASK >> (k)) & 1) && lo <= (k) && (k) < hi)
#define BOTH(k) (IN(k) && IN((k) + 1))
#ifndef REP_MASK
#define REP_MASK 0
#endif
#define REP(k) ((REP_MASK >> (k)) & 1)
#ifndef P2_REP_PARTS
#define P2_REP_PARTS 7
#endif
    if (IN(0)) { if (REP(0)) { phase0(lds, a, vcu, G); __syncthreads(); } phase0(lds, a, vcu, G); if (BOTH(0)) GRID_BAR(); }
    if (IN(1)) {
        pg8::Gemm g{(const bf16*)(ws + WS_XB), (const bf16*)(ws + WS_WIN), M, INC, D}; pg8::HybridOrder S; S.init(M, INC, D, G, bid, false);
        const pg8::TailCtx T{nullptr, nullptr};
        pg8::EpiZ E{(bf16*)(ws + WS_ZB), (float*)(ws + WS_LF), (const float*)(ws + WS_MISC), (const float*)(ws + WS_MISC) + M, a.out};
        if (REP(1)) pg8::gemm_phase2(lds, g, S, E, T);
        pg8::gemm_phase2(lds, g, S, E, T);
        if (BOTH(1)) GRID_BAR();
    }
    if (IN(2)) { if (REP(2)) { phase2(lds, a, bid, G, P2_REP_PARTS); __syncthreads(); } phase2(lds, a, bid, G); if (BOTH(2)) GRID_BAR(); }
    if (IN(3)) {
        pg8::Gemm g{(const bf16*)(ws + WS_MIX), (const bf16*)(ws + WS_WO), M, D, D}; pg8::HybridOrder S; S.init(M, D, D, G, bid, true);
        const pg8::TailCtx T{(f32x4*)(ws + WS_SLAB3), (unsigned*)(ws + WS_CTL) + CW_TAIL};
        if (REP(3)) { pg8::EpiX1<true> E0{a.in[0], a.in[1], a.out + O_Y, (bf16*)(ws + WS_XB), ctlf + CW_RSQ2}; pg8::gemm_phase2(lds, g, S, E0, T); }
        pg8::EpiX1<false> E{a.in[0], a.in[1], a.out + O_Y, (bf16*)(ws + WS_XB), ctlf + CW_RSQ2};
        pg8::gemm_phase2(lds, g, S, E, T);
        if (BOTH(3)) GRID_BAR();
    }
    if (IN(4)) {
        pg8::Gemm g{(const bf16*)(ws + WS_XB), (const bf16*)(ws + WS_WGU), M, 2 * DFF, D}; pg8::HybridOrder S; S.init(M, 2 * DFF, D, G, bid, true);
        const pg8::TailCtx T{(f32x4*)(ws + WS_SLAB45), (unsigned*)(ws + WS_CTL) + CW_TAIL + 4096};
        pg8::EpiAct E{(bf16*)(ws + WS_ACT), ctlf + CW_RSQ2};
        if (REP(4)) pg8::gemm_phase2(lds, g, S, E, T);
        pg8::gemm_phase2(lds, g, S, E, T);
        if (BOTH(4)) GRID_BAR();
    }
    if (IN(5)) {
        pg8::Gemm g{(const bf16*)(ws + WS_ACT), (const bf16*)(ws + WS_WD), M, D, DFF}; pg8::HybridOrder S; S.init(M, D, DFF, G, bid, true);
        const pg8::TailCtx T{(f32x4*)(ws + WS_SLAB45), (unsigned*)(ws + WS_CTL) + CW_TAIL + 8192};
        if (REP(5)) { pg8::EpiX2<true> E0{a.out + O_Y, ctlf + CW_RSQ3, (const bf16*)(ws + WS_XB)}; pg8::gemm_phase2(lds, g, S, E0, T); }
        pg8::EpiX2<false> E{a.out + O_Y, ctlf + CW_RSQ3, (const bf16*)(ws + WS_XB)};
        pg8::gemm_phase2(lds, g, S, E, T);
        if (BOTH(5)) GRID_BAR();
    }
    if (IN(6)) phase6(a, vcu, G);
#undef IN
#undef BOTH
}

extern "C" void kernel_launch(void* const* d_in, const int* in_sizes, int n_in, void* d_out, int out_size, void* d_ws, size_t ws_size, hipStream_t stream) {
    static int grid = 0;
    if (grid == 0) {
        if (n_in != 16 || ws_size < WS_END) { fprintf(stderr, "kernel_launch: unexpected n_in %d / ws_size %zu\n", n_in, ws_size); grid = -1; return; }
        int dev = 0, cus = 0, per_cu = 0;
        hipGetDevice(&dev);
        hipDeviceGetAttribute(&cus, hipDeviceAttributeMultiprocessorCount, dev);
        hipFuncSetAttribute((const void*)mega, hipFuncAttributeMaxDynamicSharedMemorySize, LDS_BYTES);
        hipOccupancyMaxActiveBlocksPerMultiprocessor(&per_cu, (const void*)mega, NWAVES * 64, LDS_BYTES);
        if (per_cu < 1) { fprintf(stderr, "kernel_launch: occupancy query says %d blocks per CU\n", per_cu); grid = -1; return; }
        grid = cus;
    }
    if (grid < 0) return;
    hipMemsetAsync((char*)d_ws + WS_CTL, 0, CTL_ZERO_BYTES, stream);
    Args a{};
    for (int i = 0; i < 16; ++i) a.in[i] = (const float*)d_in[i];
    a.out = (float*)d_out; a.ws = (unsigned char*)d_ws;
#if ONE_LAUNCH
    a.ph_lo = 0; a.ph_hi = NPHASE;
    void* args[] = {&a};
#if USE_CG
    hipError_t e = hipLaunchCooperativeKernel((const void*)mega, dim3(grid), dim3(NWAVES * 64), args, LDS_BYTES, stream);
    if (e != hipSuccess) fprintf(stderr, "cooperative launch failed: %s (grid %d)\n", hipGetErrorString(e), grid);
#else
    (void)args; hipLaunchKernelGGL(mega, dim3(grid), dim3(NWAVES * 64), LDS_BYTES, stream, a);
#endif
#else
    for (int p = 0; p < NPHASE; ++p) { a.ph_lo = p; a.ph_hi = p + 1; hipLaunchKernelGGL(mega, dim3(grid), dim3(NWAVES * 64), LDS_BYTES, stream, a); }
#endif
}
```

```cpp
#include <hip/hip_runtime.h>
#include <hip/hip_cooperative_groups.h>
#include <cstdio>
#include <cstdint>
namespace cg = cooperative_groups;

constexpr int D = 2048, NB = 4, SEQ = 2048, DB = 128, DS = 8;
constexpr int MP = NB * SEQ, MS = DB * DS, M = MP + MS;
constexpr int PW = 1024, HW = 1024, HD = 128, NH = 8, PC = 15;
constexpr int DFF = 5632, INC = 5120;
constexpr float EPS = 1e-6f;
constexpr size_t O_Y = 0;
constexpr size_t O_PSP = (size_t)M * D;
constexpr size_t O_HSP = O_PSP + (size_t)NB * PC * PW;
constexpr size_t O_PSS = O_HSP + (size_t)NB * NH * HD * HD;
constexpr size_t O_HSS = O_PSS + (size_t)DB * PC * PW;

namespace pg8 {
#define PG8_LAS __attribute__((address_space(3)))
typedef unsigned short bf16_t;
typedef short bf16x8 __attribute__((ext_vector_type(8)));
typedef float f32x4 __attribute__((ext_vector_type(4)));
typedef unsigned u32x4 __attribute__((ext_vector_type(4)));
constexpr int BM = 256, BK = 64, HALF = 128, HTB = HALF * BK * 2  , STAGE_BYTES = 8 * HTB, NXCD = 8, WGM = 8;

__host__ __device__ __forceinline__ int lds_byte(int r, int c) { const int st = (r >> 4) * 2 + (c >> 5), rr = r & 15, cc = c & 31, ob = rr * 64 + cc * 2; return st * 1024 + (ob ^ (((ob >> 9) & 1) << 5)); }
__host__ __device__ __forceinline__ void stage_rc(int b, int& R, int& C) { const int st = b / 1024, sb = b % 1024, swz = sb ^ (((sb >> 9) & 1) << 5); R = (st >> 1) * 16 + swz / 64; C = (st & 1) * 32 + (swz % 64) / 2; }
__host__ __device__ __forceinline__ int perm32(int rho) { const int n = rho >> 4, i = rho & 15; return 8 * (i >> 2) + 4 * n + (i & 3); }

struct Unit { int pm, pn, kb, nk, tinfo; };
struct Gemm { const bf16_t* A; const bf16_t* Bt; int M, N, K; };

struct StaticOrder {
    int nM, nN, nwg, G, c;
    __host__ __device__ void init(int M, int N, int G_, int c_) { nM = M / BM; nN = N / BM; nwg = nM * nN; G = G_; c = c_; }
    __host__ __device__ bool next(int i, Unit& u) const {
        const long L = (long)i * G + c; if (L >= nwg) return false;
        int wgid = (int)L; { const int q = nwg / NXCD, r = nwg % NXCD, xcd = wgid % NXCD, off = wgid / NXCD; wgid = (xcd < r ? xcd * (q + 1) : r * (q + 1) + (xcd - r) * q) + off; }
        const int nig = WGM * nN, gid = wgid / nig, fm = gid * WGM, gsz = (nM - fm) < WGM ? (nM - fm) : WGM;
        u.pm = fm + ((wgid % nig) % gsz); u.pn = (wgid % nig) / gsz; u.kb = 0; u.nk = 0; u.tinfo = -1; return true;
    }
    __device__ __forceinline__ void a_ready(const Unit&) const {}
    __device__ __forceinline__ void done(const Unit&) const {}
};
__device__ __forceinline__ unsigned cvt_pk_bf16(float lo, float hi) { unsigned r; asm volatile("v_cvt_pk_bf16_f32 %0, %1, %2" : "=v"(r) : "v"(lo), "v"(hi)); return r; }
__device__ __forceinline__ float sigm(float x) { return __builtin_amdgcn_rcpf(1.f + __expf(-x)); }
__device__ __forceinline__ float silu(float x) { return x * __builtin_amdgcn_rcpf(1.f + __expf(-x)); }
typedef unsigned u32x2 __attribute__((ext_vector_type(2)));
__device__ __forceinline__ float bflo_(unsigned w) { return __builtin_bit_cast(float, w << 16); }
__device__ __forceinline__ float bfhi_(unsigned w) { return __builtin_bit_cast(float, w & 0xffff0000u); }

struct EpiZ {
    static constexpr bool PERM = true, AFTER_DRAIN = false;
    bf16_t* zb; float* lf; const float* rstd1; const float* lbv; float* out;
    __device__ __forceinline__ void operator()(const f32x4 (&acc)[2][2][4][2], const Unit& u, int wr, int wc, int fr, int fq, unsigned gmask = 0xffu) const {
        const int kind = u.pn >> 2;
        const int row0 = u.pm * BM + wr * 64 + fr;
        const int cc0 = (u.pn & 3) * 256 + wc * 32 + 8 * fq;
        f32x4 lb[2][2];
        if (kind == 2) {
#pragma unroll
            for (int bj = 0; bj < 2; ++bj)
#pragma unroll
                for (int n = 0; n < 2; ++n) lb[bj][n] = *(const f32x4*)(lbv + cc0 + bj * HALF + 4 * n);
        }
#pragma unroll
        for (int ai = 0; ai < 2; ++ai)
#pragma unroll
            for (int m = 0; m < 4; ++m) {
                if (!((gmask >> (ai * 4 + m)) & 1u)) continue;
                const int row = row0 + ai * HALF + m * 16;
                const float r = rstd1[row];
#pragma unroll
                for (int bj = 0; bj < 2; ++bj) {
                    const int cc = cc0 + bj * HALF;
                    f32x4 v0 = acc[ai][bj][m][0] * r, v1 = acc[ai][bj][m][1] * r;
                    if (kind == 2) {
                        f32x4 k0, k1;
#pragma unroll
                        for (int j = 0; j < 4; ++j) {
                            const float f0 = lb[bj][0][j] + (1.f - lb[bj][0][j]) * sigm(v0[j]), f1 = lb[bj][1][j] + (1.f - lb[bj][1][j]) * sigm(v1[j]);
                            v0[j] = __log2f(f0); v1[j] = __log2f(f1); k0[j] = 1.f - f0; k1[j] = 1.f - f1;
                        }
                        float* p = lf + (size_t)row * HW + cc;
                        *(f32x4*)p = v0; *(f32x4*)(p + 4) = v1;
                        u32x4 w; w.x = cvt_pk_bf16(k0[0], k0[1]); w.y = cvt_pk_bf16(k0[2], k0[3]); w.z = cvt_pk_bf16(k1[0], k1[1]); w.w = cvt_pk_bf16(k1[2], k1[3]);
                        *(u32x4*)(zb + (size_t)row * INC + 2 * 1024 + cc) = w;
                    } else {
                        if (kind == 0) {
                            float* dst = nullptr;
                            if (row >= MP) { const int ms = row - MP; dst = out + O_PSS + ((size_t)(ms >> 3) * PC + 7 + (ms & 7)) * PW + cc; }
                            else { const int t = row & (SEQ - 1); if (t >= SEQ - PC) dst = out + O_PSP + ((size_t)(row >> 11) * PC + (t - (SEQ - PC))) * PW + cc; }
                            if (dst) { *(f32x4*)dst = v0; *(f32x4*)(dst + 4) = v1; }
                        }
                        if (kind == 1 || kind == 4) {
#pragma unroll
                            for (int j = 0; j < 4; ++j) { v0[j] = silu(v0[j]); v1[j] = silu(v1[j]); }
                        }
                        u32x4 w; w.x = cvt_pk_bf16(v0[0], v0[1]); w.y = cvt_pk_bf16(v0[2], v0[3]); w.z = cvt_pk_bf16(v1[0], v1[1]); w.w = cvt_pk_bf16(v1[2], v1[3]);
                        *(u32x4*)(zb + (size_t)row * INC + kind * 1024 + cc) = w;
                    }
                }
            }
    }
};

template <bool DRY = false> struct EpiX1 {
    static constexpr bool PERM = false, AFTER_DRAIN = false;
    const float* xp; const float* xs; float* y; bf16_t* x1b; float* rowsq;
    __device__ __forceinline__ void operator()(const f32x4 (&acc)[2][2][4][2], const Unit& u, int wr, int wc, int fr, int fq, unsigned gmask = 0xffu) const {
        const int row0 = u.pm * BM + wr * 64 + fr, col0 = u.pn * BM + wc * 32 + 4 * fq;
#pragma unroll
        for (int ai = 0; ai < 2; ++ai)
#pragma unroll
            for (int m = 0; m < 4; ++m) {
                if (!((gmask >> (ai * 4 + m)) & 1u)) continue;
                const int row = row0 + ai * HALF + m * 16;
                const float* xr = (row < MP ? xp + (size_t)row * D : xs + (size_t)(row - MP) * D) + col0;
                bf16_t* br = x1b + (size_t)row * D + col0;
                float s = 0.f;
#pragma unroll
                for (int bj = 0; bj < 2; ++bj)
#pragma unroll
                    for (int n = 0; n < 2; ++n) {
                        const f32x4 v = *(const f32x4*)(xr + bj * HALF + n * 16) + acc[ai][bj][m][n];
                        u32x2 w; w.x = cvt_pk_bf16(v[0], v[1]); w.y = cvt_pk_bf16(v[2], v[3]);
                        *(u32x2*)(br + bj * HALF + n * 16) = w;
                        s += (v[0] * v[0] + v[1] * v[1]) + (v[2] * v[2] + v[3] * v[3]);
                    }
                s += __shfl_xor(s, 16); s += __shfl_xor(s, 32);
                if (fq == 0 && !DRY) atomicAdd(rowsq + row, s);
            }
    }
};

struct EpiAct {
    static constexpr bool PERM = true, AFTER_DRAIN = false;
    bf16_t* act; const float* rowsq;
    __device__ __forceinline__ void operator()(const f32x4 (&acc)[2][2][4][2], const Unit& u, int wr, int wc, int fr, int fq, unsigned gmask = 0xffu) const {
        const int row0 = u.pm * BM + wr * 64 + fr, col0 = u.pn * HALF + wc * 32 + 8 * fq;
#pragma unroll
        for (int ai = 0; ai < 2; ++ai)
#pragma unroll
            for (int m = 0; m < 4; ++m) {
                if (!((gmask >> (ai * 4 + m)) & 1u)) continue;
                const int row = row0 + ai * HALF + m * 16;
                const float r = rsqrtf(rowsq[row] * (1.f / D) + EPS);
                u32x4 w; unsigned* wp = (unsigned*)&w;
#pragma unroll
                for (int n = 0; n < 2; ++n) {
                    const f32x4 g = acc[ai][0][m][n] * r, up = acc[ai][1][m][n] * r;
                    f32x4 a;
#pragma unroll
                    for (int j = 0; j < 4; ++j) a[j] = silu(g[j]) * up[j];
                    wp[2 * n] = cvt_pk_bf16(a[0], a[1]); wp[2 * n + 1] = cvt_pk_bf16(a[2], a[3]);
                }
                *(u32x4*)(act + (size_t)row * DFF + col0) = w;
            }
    }
};

template <bool DRY = false> struct EpiX2 {
    static constexpr bool PERM = true, AFTER_DRAIN = false;
    bf16_t* x2b; float* rowsq; const bf16_t* x1b;
    __device__ __forceinline__ void operator()(const f32x4 (&acc)[2][2][4][2], const Unit& u, int wr, int wc, int fr, int fq, unsigned gmask = 0xffu) const {
        const int row0 = u.pm * BM + wr * 64 + fr, col0 = u.pn * BM + wc * 32 + 8 * fq;
#pragma unroll
        for (int ai = 0; ai < 2; ++ai)
#pragma unroll
            for (int m = 0; m < 4; ++m) {
                if (!((gmask >> (ai * 4 + m)) & 1u)) continue;
                const int row = row0 + ai * HALF + m * 16;
                float s = 0.f;
#pragma unroll
                for (int bj = 0; bj < 2; ++bj) {
                    const u32x4 xw = *(const u32x4*)(x1b + (size_t)row * D + col0 + bj * HALF);
                    f32x4 v0 = (f32x4){bflo_(xw.x), bfhi_(xw.x), bflo_(xw.y), bfhi_(xw.y)} + acc[ai][bj][m][0];
                    f32x4 v1 = (f32x4){bflo_(xw.z), bfhi_(xw.z), bflo_(xw.w), bfhi_(xw.w)} + acc[ai][bj][m][1];
                    u32x4 w; w.x = cvt_pk_bf16(v0[0], v0[1]); w.y = cvt_pk_bf16(v0[2], v0[3]); w.z = cvt_pk_bf16(v1[0], v1[1]); w.w = cvt_pk_bf16(v1[2], v1[3]);
                    *(u32x4*)(x2b + (size_t)row * D + col0 + bj * HALF) = w;
                    s += (v0[0] * v0[0] + v0[1] * v0[1]) + (v0[2] * v0[2] + v0[3] * v0[3]) + (v1[0] * v1[0] + v1[1] * v1[1]) + (v1[2] * v1[2] + v1[3] * v1[3]);
                }
                s += __shfl_xor(s, 16); s += __shfl_xor(s, 32);
                if (fq == 0 && !DRY) atomicAdd(rowsq + row, s);
            }
    }
};
template <class Epi, class Sched, bool ALIGN_EPI = false, bool SP2 = false>
__device__ __forceinline__ void gemm_phase(PG8_LAS unsigned char* lds, const Gemm g, const Sched& S, const Epi& E) {
    int tid_ = threadIdx.x; asm volatile("" : "+v"(tid_));
    const int tid = tid_, wid = __builtin_amdgcn_readfirstlane(tid >> 6), lane = tid & 63, wr = wid >> 2, wc = wid & 3, fr = lane & 15, fq = lane >> 4;
    const int K = g.K, nt = K / BK;
    unsigned voffA[2], voffB[2];
#pragma unroll
    for (int i = 0; i < 2; ++i) { int R, C; stage_rc(tid * 16 + i * 8192, R, C); const int Rb = Epi::PERM ? ((R & ~31) + perm32(R & 31)) : R;
        voffA[i] = (unsigned)(R * K + C) * 2u; voffB[i] = (unsigned)(Rb * K + C) * 2u; }
    const size_t kstep = (size_t)(BK * 2);
    const size_t hstep = (size_t)HALF * K * 2;
    const size_t tstep = 2 * hstep;
    const unsigned ldsw = (unsigned)wid * 1024u;
    const int aoff = lds_byte(wr * 64 + fr, fq * 8), boff = lds_byte(wc * 32 + fr, fq * 8);
#define PG8_SA(b, h) (((b) * 2 + (h)) * HTB)
#define PG8_SB(b, h) ((4 + (b) * 2 + (h)) * HTB)
#define PG8_STAGE(bufoff, gbase, voff) do { _Pragma("unroll") for (int _i = 0; _i < 2; ++_i) \
        __builtin_amdgcn_global_load_lds((const unsigned*)((const char*)(gbase) + (voff)[_i]), (PG8_LAS unsigned*)(lds + (bufoff) + ldsw + _i * 8192), 16, 0, 0); } while (0)
#define PG8_LDA(dst, b, h) do { _Pragma("unroll") for (int m = 0; m < 4; ++m) _Pragma("unroll") for (int k = 0; k < 2; ++k) dst[m][k] = *(const PG8_LAS bf16x8*)(lds + PG8_SA(b, h) + aoff + m * 2048 + k * 1024); } while (0)
#define PG8_LDB(dst, b, h) do { _Pragma("unroll") for (int n = 0; n < 2; ++n) _Pragma("unroll") for (int k = 0; k < 2; ++k) dst[n][k] = *(const PG8_LAS bf16x8*)(lds + PG8_SB(b, h) + boff + n * 2048 + k * 1024); } while (0)
#define PG8_MMA(ai, bj, At, Bt) do { __builtin_amdgcn_s_setprio(1); _Pragma("unroll") for (int m = 0; m < 4; ++m) _Pragma("unroll") for (int n = 0; n < 2; ++n) _Pragma("unroll") for (int k = 0; k < 2; ++k) \
        acc[ai][bj][m][n] = __builtin_amdgcn_mfma_f32_16x16x32_bf16(Bt[n][k], At[m][k], acc[ai][bj][m][n], 0, 0, 0); __builtin_amdgcn_s_setprio(0); } while (0)
#define PG8_WAIT_V(n) asm volatile("s_waitcnt vmcnt(" #n ")" ::: "memory")
#define PG8_WAIT_L(n) asm volatile("s_waitcnt lgkmcnt(" #n ")" ::: "memory")
#define PG8_BAR __builtin_amdgcn_s_barrier()
#define PG8_SCHED __builtin_amdgcn_sched_barrier(0)
    Unit cur, nxt; int ui = 0;
    if (!S.next(0, cur)) return;
    f32x4 acc[2][2][4][2];
#pragma unroll
    for (int a = 0; a < 2; ++a)
#pragma unroll
        for (int b = 0; b < 2; ++b)
#pragma unroll
            for (int m = 0; m < 4; ++m)
#pragma unroll
                for (int n = 0; n < 2; ++n) acc[a][b][m][n] = (f32x4){0.f, 0.f, 0.f, 0.f};
    bf16x8 At[4][2], B0[2][2], B1[2][2];
    const char* cA = (const char*)g.A + (size_t)cur.pm * tstep; const char* cB = (const char*)g.Bt + (size_t)cur.pn * tstep;
    S.a_ready(cur);
    if constexpr (SP2) {
        PG8_STAGE(PG8_SB(0, 0), cB, voffB); PG8_STAGE(PG8_SB(0, 1), cB + hstep, voffB); PG8_STAGE(PG8_SA(0, 0), cA, voffA); PG8_STAGE(PG8_SA(0, 1), cA + hstep, voffA);
        if (wr == 1) PG8_BAR;
        PG8_WAIT_V(2); PG8_BAR;
        PG8_STAGE(PG8_SB(1, 0), cB + kstep, voffB); PG8_STAGE(PG8_SA(1, 0), cA + kstep, voffA); PG8_STAGE(PG8_SB(1, 1), cB + hstep + kstep, voffB);
        PG8_WAIT_V(6); PG8_BAR;
    } else {
        PG8_STAGE(PG8_SB(0, 0), cB, voffB); PG8_STAGE(PG8_SA(0, 0), cA, voffA); PG8_STAGE(PG8_SB(0, 1), cB + hstep, voffB); PG8_STAGE(PG8_SA(0, 1), cA + hstep, voffA);
        if (wr == 1) PG8_BAR;
        PG8_WAIT_V(4); PG8_BAR;
        PG8_STAGE(PG8_SB(1, 0), cB + kstep, voffB); PG8_STAGE(PG8_SA(1, 0), cA + kstep, voffA); PG8_STAGE(PG8_SB(1, 1), cB + hstep + kstep, voffB);
        PG8_WAIT_V(6); PG8_BAR;
    }
    for (;;) {
        const bool has_next = S.next(ui + 1, nxt);
        const char* nA = has_next ? (const char*)g.A + (size_t)nxt.pm * tstep : cA; const char* nB = has_next ? (const char*)g.Bt + (size_t)nxt.pn * tstep : cB;
        for (int t = 0; t < nt; t += 2) {
            const bool last = (t == nt - 2);
            const char* a1 = cA + (size_t)(t + 1) * kstep;
            const char* a2 = last ? nA : cA + (size_t)(t + 2) * kstep; const char* b2 = last ? nB : cB + (size_t)(t + 2) * kstep;
            const char* a3 = a2 + kstep; const char* b3 = b2 + kstep;
            if (last && has_next) S.a_ready(nxt);
            if constexpr (SP2) {
            PG8_LDB(B0, 0, 0); PG8_LDB(B1, 0, 1); PG8_SCHED; PG8_LDA(At, 0, 0); PG8_STAGE(PG8_SA(1, 1), a1 + hstep, voffA);
            PG8_WAIT_V(8); PG8_WAIT_L(0); PG8_BAR; PG8_MMA(0, 0, At, B0); PG8_MMA(0, 1, At, B1); PG8_BAR; PG8_SCHED;
            PG8_LDA(At, 0, 1); PG8_STAGE(PG8_SB(0, 0), b2, voffB); PG8_STAGE(PG8_SB(0, 1), b2 + hstep, voffB); PG8_STAGE(PG8_SA(0, 0), a2, voffA);
            PG8_WAIT_V(8); PG8_WAIT_L(0); PG8_BAR; PG8_MMA(1, 0, At, B0); PG8_MMA(1, 1, At, B1); PG8_BAR; PG8_SCHED;
            PG8_LDB(B0, 1, 0); PG8_LDB(B1, 1, 1); PG8_SCHED; PG8_LDA(At, 1, 0); PG8_STAGE(PG8_SA(0, 1), a2 + hstep, voffA);
            PG8_WAIT_V(8); PG8_WAIT_L(0); PG8_BAR; PG8_MMA(0, 0, At, B0); PG8_MMA(0, 1, At, B1); PG8_BAR; PG8_SCHED;
            PG8_LDA(At, 1, 1); PG8_STAGE(PG8_SB(1, 0), b3, voffB); PG8_STAGE(PG8_SB(1, 1), b3 + hstep, voffB); PG8_STAGE(PG8_SA(1, 0), a3, voffA);
            PG8_WAIT_V(8); PG8_WAIT_L(0); PG8_BAR; PG8_MMA(1, 0, At, B0); PG8_MMA(1, 1, At, B1); PG8_BAR; PG8_SCHED;
            } else {
            PG8_LDB(B0, 0, 0); PG8_SCHED; PG8_LDA(At, 0, 0); PG8_STAGE(PG8_SA(1, 1), a1 + hstep, voffA);
            PG8_WAIT_L(8); PG8_BAR; PG8_WAIT_L(0); PG8_MMA(0, 0, At, B0); PG8_BAR; PG8_SCHED;
            PG8_LDB(B1, 0, 1); PG8_STAGE(PG8_SB(0, 0), b2, voffB);
            PG8_BAR; PG8_WAIT_L(0); PG8_MMA(0, 1, At, B1); PG8_BAR;
            PG8_LDA(At, 0, 1); PG8_STAGE(PG8_SA(0, 0), a2, voffA);
            PG8_BAR; PG8_WAIT_L(0); PG8_MMA(1, 0, At, B0); PG8_BAR; PG8_SCHED;
            PG8_STAGE(PG8_SB(0, 1), b2 + hstep, voffB);
            PG8_WAIT_V(6); PG8_BAR; PG8_MMA(1, 1, At, B1); PG8_BAR;
            PG8_LDB(B0, 1, 0); PG8_SCHED; PG8_LDA(At, 1, 0); PG8_STAGE(PG8_SA(0, 1), a2 + hstep, voffA);
            PG8_WAIT_L(8); PG8_BAR; PG8_WAIT_L(0); PG8_MMA(0, 0, At, B0); PG8_BAR; PG8_SCHED;
            PG8_LDB(B1, 1, 1); PG8_STAGE(PG8_SB(1, 0), b3, voffB);
            PG8_BAR; PG8_WAIT_L(0); PG8_MMA(0, 1, At, B1); PG8_BAR;
            PG8_LDA(At, 1, 1); PG8_STAGE(PG8_SA(1, 0), a3, voffA);
            PG8_BAR; PG8_WAIT_L(0); PG8_MMA(1, 0, At, B0); PG8_BAR; PG8_SCHED;
            PG8_STAGE(PG8_SB(1, 1), b3 + hstep, voffB);
            PG8_WAIT_V(6); PG8_BAR; PG8_MMA(1, 1, At, B1); PG8_BAR;
            }
        }
        if constexpr (ALIGN_EPI) { if (wr == 0) PG8_BAR; }
        if constexpr (!Epi::AFTER_DRAIN) { E(acc, cur, wr, wc, fr, fq); S.done(cur); }
        if (!has_next) break;
#pragma unroll
        for (int a = 0; a < 2; ++a)
#pragma unroll
            for (int b = 0; b < 2; ++b)
#pragma unroll
                for (int m = 0; m < 4; ++m)
#pragma unroll
                    for (int n = 0; n < 2; ++n) acc[a][b][m][n] = (f32x4){0.f, 0.f, 0.f, 0.f};
        cur = nxt; cA = nA; cB = nB; ++ui;
        if constexpr (ALIGN_EPI) { if (wr == 1) PG8_BAR; }
    }
    PG8_WAIT_V(0);
    if constexpr (!ALIGN_EPI) { if (wr == 0) PG8_BAR; }
    PG8_BAR;
    if constexpr (Epi::AFTER_DRAIN) { E.fused(acc, cur, wr, wc, fr, fq, lds, wid, lane); S.done(cur); }
#undef PG8_SA
#undef PG8_SB
#undef PG8_STAGE
#undef PG8_LDA
#undef PG8_LDB
#undef PG8_MMA
#undef PG8_WAIT_V
#undef PG8_WAIT_L
#undef PG8_BAR
#undef PG8_SCHED
}

struct HybridOrder {
    int nM, nN, nwg, G, c, nt, nfull, R, ns;
    __device__ __forceinline__ void init(int M, int N, int K, int G_, int c_, bool allow_split) {
        nM = M / BM; nN = N / BM; nwg = nM * nN; G = G_; c = c_; nt = K / BK; nfull = nwg / G; R = nwg - nfull * G;
        ns = (allow_split && R > 0 && (R % 8) == 0 && (G % 8) == 0) ? G / R : 1; if (ns > 8) ns = 8; if (ns > nt / 2) ns = nt / 2; if (ns < 2) ns = 1;
    }
    __device__ __forceinline__ void map(int L, Unit& u) const {
        int wgid = L; { const int q = nwg / NXCD, r = nwg % NXCD, xcd = wgid % NXCD, off = wgid / NXCD; wgid = (xcd < r ? xcd * (q + 1) : r * (q + 1) + (xcd - r) * q) + off; }
        const int nig = WGM * nN, gid = wgid / nig, fm = gid * WGM, gsz = (nM - fm) < WGM ? (nM - fm) : WGM;
        u.pm = fm + ((wgid % nig) % gsz); u.pn = (wgid % nig) / gsz;
    }
    __device__ __forceinline__ bool next(int i, Unit& u) const {
        if (i < nfull) { map(i * G + c, u); u.kb = 0; u.nk = nt; u.tinfo = -1; return true; }
        if (i > nfull || R == 0) return false;
        if (ns < 2) { const int L = i * G + c; if (L >= nwg) return false; map(L, u); u.kb = 0; u.nk = nt; u.tinfo = -1; return true; }
        const int x = c % 8, y = c / 8, tj = (y / ns) * 8 + x, slice = y % ns;
        if (tj >= R) return false;
        map(nfull * G + tj, u);
        const int pairs = nt / 2, base = pairs / ns, rem = pairs % ns, start = slice * base + (slice < rem ? slice : rem), mine = base + (slice < rem ? 1 : 0);
        u.kb = 2 * start; u.nk = 2 * mine; u.tinfo = (tj << 8) | (slice << 4) | ns; return true;
    }
};
struct TailCtx { f32x4* slab; unsigned* cnt; };

template <class Epi>
__device__ __forceinline__ void tail_fixup(f32x4 (&acc)[2][2][4][2], const Unit& u, const Epi& E, const TailCtx& T, int tid, int wr, int wc, int fr, int fq) {
    const int tj = u.tinfo >> 8, slice = (u.tinfo >> 4) & 15, ns = u.tinfo & 15;
    const __amdgpu_buffer_rsrc_t srs = __builtin_amdgcn_make_buffer_rsrc((void*)(T.slab + (size_t)(tj * ns + slice) * (32 * 512)), (short)0, 32 * 512 * 16, 0x00020000);
#pragma unroll
    for (int ai = 0; ai < 2; ++ai)
#pragma unroll
        for (int bj = 0; bj < 2; ++bj)
#pragma unroll
            for (int m = 0; m < 4; ++m)
#pragma unroll
                for (int n = 0; n < 2; ++n) __builtin_amdgcn_raw_buffer_store_b128(__builtin_bit_cast(u32x4, acc[ai][bj][m][n]), srs, (unsigned)(((((ai * 2 + bj) * 4 + m) * 2 + n) * 512 + tid) * 16), 0, 16);
    asm volatile("s_waitcnt vmcnt(0)" ::: "memory");
    __syncthreads();
    if (tid == 0) __hip_atomic_fetch_add(T.cnt + 64 * tj, 1u, __ATOMIC_RELAXED, __HIP_MEMORY_SCOPE_AGENT);
    if (tid < 64) {
        unsigned sp = 0;
        while (__hip_atomic_load(T.cnt + 64 * tj, __ATOMIC_RELAXED, __HIP_MEMORY_SCOPE_AGENT) < (unsigned)ns && ++sp < (1u << 22)) __builtin_amdgcn_s_sleep(2);
        __builtin_amdgcn_fence(__ATOMIC_ACQUIRE, "agent");
        asm volatile("s_waitcnt vmcnt(0)" ::: "memory");
    }
    __syncthreads();
    unsigned gmask = 0u;
    for (int g = slice; g < 8; g += ns) gmask |= 1u << g;
    const f32x4* tile = T.slab + (size_t)(tj * ns) * (32 * 512);
#pragma unroll
    for (int ai = 0; ai < 2; ++ai)
#pragma unroll
        for (int m = 0; m < 4; ++m) {
            if (!((gmask >> (ai * 4 + m)) & 1u)) continue;
#pragma unroll
            for (int bj = 0; bj < 2; ++bj)
#pragma unroll
                for (int n = 0; n < 2; ++n) {
                    const int idx = ((ai * 2 + bj) * 4 + m) * 2 + n;
                    f32x4 v = tile[idx * 512 + tid];
                    for (int sl = 1; sl < ns; ++sl) v = v + tile[(size_t)sl * (32 * 512) + idx * 512 + tid];
                    acc[ai][bj][m][n] = v;
                }
        }
    E(acc, u, wr, wc, fr, fq, gmask);
}

template <class Epi, class Sched>
__device__ __forceinline__ void gemm_phase2(PG8_LAS unsigned char* lds, const Gemm g, const Sched& S, const Epi& E, const TailCtx& T) {
    int tid_ = threadIdx.x; asm volatile("" : "+v"(tid_));
    const int tid = tid_, wid = __builtin_amdgcn_readfirstlane(tid >> 6), lane = tid & 63, wr = wid >> 2, wc = wid & 3, fr = lane & 15, fq = lane >> 4;
    const int K = g.K;
    unsigned voffA[2], voffB[2];
#pragma unroll
    for (int i = 0; i < 2; ++i) { int R, C; stage_rc(tid * 16 + i * 8192, R, C); const int Rb = Epi::PERM ? ((R & ~31) + perm32(R & 31)) : R;
        voffA[i] = (unsigned)(R * K + C) * 2u; voffB[i] = (unsigned)(Rb * K + C) * 2u; }
    const size_t kstep = (size_t)(BK * 2), hstep = (size_t)HALF * K * 2, tstep = 2 * hstep;
    const unsigned ldsw = (unsigned)wid * 1024u;
    const int aoff = lds_byte(wr * 64 + fr, fq * 8), boff = lds_byte(wc * 32 + fr, fq * 8);
#define PG8_SA(b, h) (((b) * 2 + (h)) * HTB)
#define PG8_SB(b, h) ((4 + (b) * 2 + (h)) * HTB)
#define PG8_STAGE(bufoff, gbase, voff) do { _Pragma("unroll") for (int _i = 0; _i < 2; ++_i) \
        __builtin_amdgcn_global_load_lds((const unsigned*)((const char*)(gbase) + (voff)[_i]), (PG8_LAS unsigned*)(lds + (bufoff) + ldsw + _i * 8192), 16, 0, 0); } while (0)
#define PG8_LDA(dst, b, h) do { _Pragma("unroll") for (int m = 0; m < 4; ++m) _Pragma("unroll") for (int k = 0; k < 2; ++k) dst[m][k] = *(const PG8_LAS bf16x8*)(lds + PG8_SA(b, h) + aoff + m * 2048 + k * 1024); } while (0)
#define PG8_LDB(dst, b, h) do { _Pragma("unroll") for (int n = 0; n < 2; ++n) _Pragma("unroll") for (int k = 0; k < 2; ++k) dst[n][k] = *(const PG8_LAS bf16x8*)(lds + PG8_SB(b, h) + boff + n * 2048 + k * 1024); } while (0)
#define PG8_MMA(ai, bj, At, Bt) do { __builtin_amdgcn_s_setprio(1); _Pragma("unroll") for (int m = 0; m < 4; ++m) _Pragma("unroll") for (int n = 0; n < 2; ++n) _Pragma("unroll") for (int k = 0; k < 2; ++k) \
        acc[ai][bj][m][n] = __builtin_amdgcn_mfma_f32_16x16x32_bf16(Bt[n][k], At[m][k], acc[ai][bj][m][n], 0, 0, 0); __builtin_amdgcn_s_setprio(0); } while (0)
#define PG8_WAIT_V(n) asm volatile("s_waitcnt vmcnt(" #n ")" ::: "memory")
#define PG8_WAIT_L(n) asm volatile("s_waitcnt lgkmcnt(" #n ")" ::: "memory")
#define PG8_BAR __builtin_amdgcn_s_barrier()
#define PG8_SCHED __builtin_amdgcn_sched_barrier(0)
    Unit cur, nxt; int ui = 0;
    if (!S.next(0, cur)) return;
    f32x4 acc[2][2][4][2];
#pragma unroll
    for (int a = 0; a < 2; ++a)
#pragma unroll
        for (int b = 0; b < 2; ++b)
#pragma unroll
            for (int m = 0; m < 4; ++m)
#pragma unroll
                for (int n = 0; n < 2; ++n) acc[a][b][m][n] = (f32x4){0.f, 0.f, 0.f, 0.f};
    bf16x8 At[4][2], B0[2][2], B1[2][2];
    const char* cA = (const char*)g.A + (size_t)cur.pm * tstep + (size_t)cur.kb * kstep; const char* cB = (const char*)g.Bt + (size_t)cur.pn * tstep + (size_t)cur.kb * kstep;
    PG8_STAGE(PG8_SB(0, 0), cB, voffB); PG8_STAGE(PG8_SB(0, 1), cB + hstep, voffB); PG8_STAGE(PG8_SA(0, 0), cA, voffA); PG8_STAGE(PG8_SA(0, 1), cA + hstep, voffA);
    if (wr == 1) PG8_BAR;
    PG8_WAIT_V(2); PG8_BAR;
    PG8_STAGE(PG8_SB(1, 0), cB + kstep, voffB); PG8_STAGE(PG8_SA(1, 0), cA + kstep, voffA); PG8_STAGE(PG8_SB(1, 1), cB + hstep + kstep, voffB);
    PG8_WAIT_V(6); PG8_BAR;
    for (;;) {
        const bool has_next = S.next(ui + 1, nxt);
        const char* nA = has_next ? (const char*)g.A + (size_t)nxt.pm * tstep + (size_t)nxt.kb * kstep : cA; const char* nB = has_next ? (const char*)g.Bt + (size_t)nxt.pn * tstep + (size_t)nxt.kb * kstep : cB;
        const int nt = cur.nk;
        for (int t = 0; t < nt; t += 2) {
            const bool last = (t == nt - 2);
            const char* a1 = cA + (size_t)(t + 1) * kstep;
            const char* a2 = last ? nA : cA + (size_t)(t + 2) * kstep; const char* b2 = last ? nB : cB + (size_t)(t + 2) * kstep;
            const char* a3 = a2 + kstep; const char* b3 = b2 + kstep;
            PG8_LDB(B0, 0, 0); PG8_LDB(B1, 0, 1); PG8_SCHED; PG8_LDA(At, 0, 0); PG8_STAGE(PG8_SA(1, 1), a1 + hstep, voffA);
            PG8_WAIT_V(8); PG8_WAIT_L(0); PG8_BAR; PG8_MMA(0, 0, At, B0); PG8_MMA(0, 1, At, B1); PG8_BAR; PG8_SCHED;
            PG8_LDA(At, 0, 1); PG8_STAGE(PG8_SB(0, 0), b2, voffB); PG8_STAGE(PG8_SB(0, 1), b2 + hstep, voffB); PG8_STAGE(PG8_SA(0, 0), a2, voffA);
            PG8_WAIT_V(8); PG8_WAIT_L(0); PG8_BAR; PG8_MMA(1, 0, At, B0); PG8_MMA(1, 1, At, B1); PG8_BAR; PG8_SCHED;
            PG8_LDB(B0, 1, 0); PG8_LDB(B1, 1, 1); PG8_SCHED; PG8_LDA(At, 1, 0); PG8_STAGE(PG8_SA(0, 1), a2 + hstep, voffA);
            PG8_WAIT_V(8); PG8_WAIT_L(0); PG8_BAR; PG8_MMA(0, 0, At, B0); PG8_MMA(0, 1, At, B1); PG8_BAR; PG8_SCHED;
            PG8_LDA(At, 1, 1); PG8_STAGE(PG8_SB(1, 0), b3, voffB); PG8_STAGE(PG8_SB(1, 1), b3 + hstep, voffB); PG8_STAGE(PG8_SA(1, 0), a3, voffA);
            PG8_WAIT_V(8); PG8_WAIT_L(0); PG8_BAR; PG8_MMA(1, 0, At, B0); PG8_MMA(1, 1, At, B1); PG8_BAR; PG8_SCHED;
        }
        if (wr == 0) PG8_BAR;
        if (cur.tinfo < 0) E(acc, cur, wr, wc, fr, fq);
        if (!has_next) break;
#pragma unroll
        for (int a = 0; a < 2; ++a)
#pragma unroll
            for (int b = 0; b < 2; ++b)
#pragma unroll
                for (int m = 0; m < 4; ++m)
#pragma unroll
                    for (int n = 0; n < 2; ++n) acc[a][b][m][n] = (f32x4){0.f, 0.f, 0.f, 0.f};
        cur = nxt; cA = nA; cB = nB; ++ui;
        if (wr == 1) PG8_BAR;
    }
    PG8_WAIT_V(0);
    PG8_BAR;
    if (cur.tinfo >= 0) tail_fixup(acc, cur, E, T, tid, wr, wc, fr, fq);
#undef PG8_SA
#undef PG8_SB
#undef PG8_STAGE
#undef PG8_LDA
#undef PG8_LDB
#undef PG8_MMA
#undef PG8_WAIT_V
#undef PG8_WAIT_L
#undef PG8_BAR
#undef PG8_SCHED
}
}
#define LAS __attribute__((address_space(3)))
typedef unsigned short bf16;
using pg8::f32x4; using pg8::u32x4; using pg8::u32x2; using pg8::bf16x8; using pg8::cvt_pk_bf16;

#ifndef ONE_LAUNCH
#define ONE_LAUNCH 1
#endif
constexpr int NWAVES = 8, NPHASE = 7;
constexpr int LDS_BYTES = 147456;
constexpr size_t MiB = 1u << 20;
constexpr size_t WS_CTL = 0, CTL_ZERO_BYTES = 1 * MiB;
constexpr size_t WS_WIN = 1 * MiB;
constexpr size_t WS_WO = 21 * MiB;
constexpr size_t WS_WGU = 29 * MiB;
constexpr size_t WS_WD = 73 * MiB;
constexpr size_t WS_WP = 95 * MiB;
constexpr size_t WS_MISC = 96 * MiB;
constexpr size_t WS_XB = 97 * MiB;
constexpr size_t WS_ZB = 133 * MiB;
constexpr size_t WS_LF = 223 * MiB;
constexpr size_t WS_ACT = WS_ZB;
constexpr size_t WS_MIX = 259 * MiB;
constexpr size_t WS_X2B = WS_WGU;
constexpr size_t WS_END = 296 * MiB;
constexpr int CW_RSQ2 = 4096, CW_RSQ3 = 4096 + M;
constexpr int CW_TAIL = 100000;
constexpr size_t WS_SLAB3 = WS_ACT, WS_SLAB45 = 232 * MiB;
constexpr int CW_BAR = 65536;
constexpr int MISC_OFF = 147456 - 256;
#ifndef USE_CG
#define USE_CG 0
#endif

__device__ __forceinline__ float wave_sum(float v) {
#pragma unroll
    for (int o = 1; o < 64; o <<= 1) v += __shfl_xor(v, o);
    return v;
}
__device__ __forceinline__ float bflo(unsigned w) { return __builtin_bit_cast(float, w << 16); }
__device__ __forceinline__ float bfhi(unsigned w) { return __builtin_bit_cast(float, w & 0xffff0000u); }
__device__ __forceinline__ float bf2f(bf16 b) { return __builtin_bit_cast(float, (unsigned)b << 16); }
__device__ __forceinline__ bf16 f2bf(float f) { unsigned u = __builtin_bit_cast(unsigned, f); return (bf16)((u + 0x7fffu + ((u >> 16) & 1u)) >> 16); }

#define XB_TMO      128
#define XB_XCNT(j)  (256  + 64 * (j))
#define XB_XSUB(j)  (1280 + 64 * (j))
#define XB_XGEN(j)  (2304 + 64 * (j))
#define XB_TOP      3328
#define XB_TOPGEN   3392
#define XCD_BAR_WORDS 3456
#define XB_SPIN_CAP (1u << 18)

__device__ __forceinline__ unsigned xb_ld(unsigned* p)              { return __hip_atomic_load(p, __ATOMIC_RELAXED, __HIP_MEMORY_SCOPE_AGENT); }
__device__ __forceinline__ unsigned xb_add(unsigned* p, unsigned v) { return __hip_atomic_fetch_add(p, v, __ATOMIC_RELAXED, __HIP_MEMORY_SCOPE_AGENT); }
__device__ __forceinline__ unsigned xb_xcc_id() { return (unsigned)__builtin_amdgcn_s_getreg((3 << 11) | 20) & 0xFu; }
#define XB_SPIN(cond, bar) do { unsigned _sp = 0; while (cond) { __builtin_amdgcn_s_sleep(1); \
    if ((++_sp & 255u) == 0u) { if (xb_ld(&(bar)[XB_TMO])) break; if (_sp > XB_SPIN_CAP) { atomicAdd(&(bar)[XB_TMO], 1u); break; } } } } while (0)

struct XcdBarrier {
    unsigned* bar; unsigned x;
    volatile LAS unsigned* st;
};

__device__ __forceinline__ XcdBarrier xcd_barrier_post(unsigned* bar, volatile LAS unsigned* st) {
    XcdBarrier b; b.bar = bar; b.x = xb_xcc_id(); b.st = st;
    if (threadIdx.x == 0) (void)xb_add(&bar[XB_XCNT(b.x)], 1u);
    return b;
}
__device__ __forceinline__ void xcd_barrier_complete(unsigned* bar, unsigned x, unsigned& nloc, unsigned& nx) {
    const unsigned G = gridDim.x * gridDim.y * gridDim.z;
    unsigned sum, cnt, mine, sp = 0u;
    for (;;) {
        sum = 0u; cnt = 0u; mine = 0u;
#pragma unroll
        for (unsigned j = 0; j < 16; ++j) { const unsigned c = xb_ld(&bar[XB_XCNT(j)]); sum += c; cnt += (c > 0u) ? 1u : 0u; mine = (j == x) ? c : mine; }
        if (sum == G) break;
        __builtin_amdgcn_s_sleep(1);
        if ((++sp & 255u) == 0u) { if (xb_ld(&bar[XB_TMO])) break; if (sp > XB_SPIN_CAP) { atomicAdd(&bar[XB_TMO], 1u); break; } }
    }
    nloc = mine > 0u ? mine : 1u; nx = cnt > 0u ? cnt : 1u;
}

__device__ __forceinline__ void xcd_barrier(const XcdBarrier& b) {
    asm volatile("s_waitcnt vmcnt(0)" ::: "memory");
    __syncthreads();
    if (threadIdx.x == 0) {
        unsigned* bar = b.bar;
        __builtin_amdgcn_s_waitcnt(0);
        unsigned nloc = b.st[0], nx = b.st[1];
        if (nloc == 0u) { xcd_barrier_complete(bar, b.x, nloc, nx); b.st[0] = nloc; b.st[1] = nx; }
        const unsigned old = xb_add(&bar[XB_XSUB(b.x)], 1u);
        const unsigned gen = old / nloc;
        if (old + 1u == (gen + 1u) * nloc) {
            __builtin_amdgcn_fence(__ATOMIC_RELEASE, "agent");
            asm volatile("s_waitcnt vmcnt(0)" ::: "memory");
            const unsigned og = xb_add(&bar[XB_TOP], 1u);
            const unsigned tg = og / nx;
            if (og + 1u == (tg + 1u) * nx) xb_add(&bar[XB_TOPGEN], 1u);
            else XB_SPIN(xb_ld(&bar[XB_TOPGEN]) == tg, bar);
            __builtin_amdgcn_fence(__ATOMIC_ACQUIRE, "agent");
            xb_add(&bar[XB_XGEN(b.x)], 1u);
            asm volatile("s_waitcnt vmcnt(0)" ::: "memory");
        } else {
            XB_SPIN(xb_ld(&bar[XB_XGEN(b.x)]) == gen, bar);
            __builtin_amdgcn_fence(__ATOMIC_ACQUIRE, "agent");
            asm volatile("s_waitcnt vmcnt(0)" ::: "memory");
        }
    }
    __syncthreads();
}


#ifdef TPROBE
#define STAMP(i) do { if (threadIdx.x == 0) ((volatile LAS unsigned long long*)(lds + MISC_OFF + 128))[i] = __builtin_amdgcn_s_memrealtime(); } while (0)
#else
#define STAMP(i) do {} while (0)
#endif
constexpr int CW_TP = 120000;

struct Args { const float* in[16]; float* out; unsigned char* ws; int ph_lo, ph_hi; };

__device__ __forceinline__ void p0_item(const float* W, int K, int N, bf16* WT, int mode, const float* sk, const float* sn, LAS float* scr, int item, int lane) {
    const int nblk = N / 64, kb = item / nblk, nb = item % nblk, k0 = 64 * kb, n0 = 64 * nb;
    const int drow0 = mode == 0 ? n0 : ((n0 >> 7) * 256 + (n0 & 127) + (mode == 2 ? 128 : 0));
    const int r = lane >> 4, c4 = lane & 15;
    f32x4 v[16];
#pragma unroll
    for (int i = 0; i < 16; ++i) v[i] = *(const f32x4*)(W + (size_t)(k0 + 4 * i + r) * N + n0 + 4 * c4);
    if (sk) {
#pragma unroll
        for (int i = 0; i < 16; ++i) v[i] = v[i] * sk[k0 + 4 * i + r];
    }
#pragma unroll
    for (int i = 0; i < 16; ++i) { LAS float* d = scr + (4 * i + r) * 65 + 4 * c4; d[0] = v[i][0]; d[1] = v[i][1]; d[2] = v[i][2]; d[3] = v[i][3]; }
    asm volatile("s_waitcnt lgkmcnt(0)" ::: "memory");
    const int c = lane & 7, nn = lane >> 3;
#pragma unroll
    for (int j = 0; j < 8; ++j) { const int n = nn + 8 * j; const LAS float* s = scr + (8 * c) * 65 + n; const float f = sn ? sn[n0 + n] : 1.f;
        u32x4 o; o.x = cvt_pk_bf16(s[0 * 65] * f, s[1 * 65] * f); o.y = cvt_pk_bf16(s[2 * 65] * f, s[3 * 65] * f); o.z = cvt_pk_bf16(s[4 * 65] * f, s[5 * 65] * f); o.w = cvt_pk_bf16(s[6 * 65] * f, s[7 * 65] * f);
        *(u32x4*)(WT + (size_t)(drow0 + n) * K + k0 + 8 * c) = o; }
    asm volatile("s_waitcnt lgkmcnt(0)" ::: "memory");
}

__device__ __forceinline__ void phase0(LAS unsigned char* lds, const Args& a, int vcu, int G) {
    const int tid = threadIdx.x, lane = tid & 63, wave = tid >> 6;
    unsigned char* ws = a.ws;
    LAS float* scr = (LAS float*)(lds + wave * 16640);
    const int gw = vcu * NWAVES + wave, NGW = G * NWAVES;
    constexpr int I_IN = (D / 64) * (INC / 64), I_O = (D / 64) * (D / 64), I_G = (D / 64) * (DFF / 64), I_D = (DFF / 64) * (D / 64), I_P = (256 / 64) * (256 / 64);
    constexpr int NITEMS = I_IN + I_O + 2 * I_G + I_D + 4 * I_P;
    for (int it = gw; it < NITEMS; it += NGW) {
        int r = it;
        if (r < I_IN) { p0_item(a.in[6], D, INC, (bf16*)(ws + WS_WIN), 0, a.in[5], nullptr, scr, r, lane); continue; } r -= I_IN;
        if (r < I_O) { p0_item(a.in[10], D, D, (bf16*)(ws + WS_WO), 0, nullptr, nullptr, scr, r, lane); continue; } r -= I_O;
        if (r < I_G) { p0_item(a.in[12], D, DFF, (bf16*)(ws + WS_WGU), 1, a.in[11], nullptr, scr, r, lane); continue; } r -= I_G;
        if (r < I_G) { p0_item(a.in[13], D, DFF, (bf16*)(ws + WS_WGU), 2, a.in[11], nullptr, scr, r, lane); continue; } r -= I_G;
        if (r < I_D) { p0_item(a.in[14], DFF, D, (bf16*)(ws + WS_WD), 0, nullptr, nullptr, scr, r, lane); continue; } r -= I_D;
        { const int g = r / I_P; p0_item(a.in[7] + (size_t)g * 65536, 256, 256, (bf16*)(ws + WS_WP) + (size_t)g * 65536, 0, nullptr, a.in[8] + g * 256, scr, r % I_P, lane); }
    }
    float* rstd1 = (float*)(ws + WS_MISC); bf16* xb = (bf16*)(ws + WS_XB);
    for (int m = gw; m < M; m += NGW) {
        const float* xrow = m < MP ? a.in[0] + (size_t)m * D : a.in[1] + (size_t)(m - MP) * D;
        f32x4 v[8]; float s = 0.f;
#pragma unroll
        for (int j = 0; j < 8; ++j) { v[j] = ((const f32x4*)xrow)[lane + 64 * j]; s += (v[j][0] * v[j][0] + v[j][1] * v[j][1]) + (v[j][2] * v[j][2] + v[j][3] * v[j][3]); }
        s = wave_sum(s);
        if (lane == 0) rstd1[m] = rsqrtf(s * (1.f / D) + EPS);
#pragma unroll
        for (int j = 0; j < 8; ++j) { u32x2 w; w.x = cvt_pk_bf16(v[j][0], v[j][1]); w.y = cvt_pk_bf16(v[j][2], v[j][3]); ((u32x2*)(xb + (size_t)m * D))[lane + 64 * j] = w; }
    }
    const int gt = vcu * (NWAVES * 64) + tid, NGT = G * NWAVES * 64;
    float* lbv = (float*)(ws + WS_MISC) + M;
    for (int c = gt; c < HW; c += NGT) lbv[c] = 1.f / (1.f + __expf(a.in[4][HW + c] - a.in[4][c]));
    for (int i = gt; i < DB * 7 * PW; i += NGT) { const int b = i / (7 * PW), rem = i % (7 * PW); a.out[O_PSS + (size_t)b * PC * PW + rem] = a.in[2][(size_t)b * PC * PW + 8 * PW + rem]; }
}

template <int W, bool SAMPLE>
__device__ __forceinline__ void pool_fill(LAS bf16* A, int m0, int g, const bf16* zb, const float* cache) {
    const int tid = threadIdx.x, c8 = tid & 31, rq = tid >> 5;
    constexpr int LDA = 264;
    const int col = g * 256 + 8 * c8;
    u32x4 ur[19];
    int tb;
    if (!SAMPLE) {
        const int mb = m0 + 4 * rq - 15; tb = (m0 & (SEQ - 1)) + 4 * rq - 15;
#pragma unroll
        for (int e = 0; e < 19; ++e) ur[e] = (tb + e >= 0) ? *(const u32x4*)(zb + (size_t)(mb + e) * INC + col) : (u32x4){0u, 0u, 0u, 0u};
    } else {
        const int r0 = 4 * rq, m = m0 + r0, b = (m - MP) >> 3, t0 = r0 & 7; tb = t0 - 15;
#pragma unroll
        for (int e = 0; e < 19; ++e) {
            const int tau = tb + e;
            if (tau >= 0) ur[e] = *(const u32x4*)(zb + (size_t)(m - t0 + tau) * INC + col);
            else { const float* cr = cache + ((size_t)b * PC + (PC + tau)) * PW + col; const f32x4 c0 = *(const f32x4*)cr, c1 = *(const f32x4*)(cr + 4);
                   ur[e] = (u32x4){cvt_pk_bf16(c0[0], c0[1]), cvt_pk_bf16(c0[2], c0[3]), cvt_pk_bf16(c1[0], c1[1]), cvt_pk_bf16(c1[2], c1[3])}; }
        }
    }
    float out[4][8];
#pragma unroll
    for (int cp = 0; cp < 4; ++cp)
#pragma unroll
        for (int hf = 0; hf < 2; ++hf) {
#define PVAL(e) (hf ? bfhi(ur[e][cp]) : bflo(ur[e][cp]))
            float sw = 0.f;
#pragma unroll
            for (int j = 1; j < W; ++j) sw += PVAL(15 - j);
#pragma unroll
            for (int r = 0; r < 4; ++r) {
                const float um = PVAL(15 + r);
                sw += um;
                const float cnt = SAMPLE ? (float)W : (float)min(tb + 15 + r + 1, W);
                out[r][2 * cp + hf] = sw / cnt - um;
                sw -= PVAL(15 + r - (W - 1));
            }
#undef PVAL
        }
#pragma unroll
    for (int r = 0; r < 4; ++r) {
        u32x4 w; w.x = cvt_pk_bf16(out[r][0], out[r][1]); w.y = cvt_pk_bf16(out[r][2], out[r][3]); w.z = cvt_pk_bf16(out[r][4], out[r][5]); w.w = cvt_pk_bf16(out[r][6], out[r][7]);
        *(LAS u32x4*)(A + (4 * rq + r) * LDA + 8 * c8) = w;
    }
}
__device__ __forceinline__ void pool_item(LAS unsigned char* lds, int item, const bf16* zb, const float* cache, const bf16* WpT, bf16* mixb) {
    const int tile = item >> 2, g = item & 3, m0 = tile * 64;
    const int tid = threadIdx.x;
    constexpr int LDA = 264;
    LAS bf16* A = (LAS bf16*)lds;
    const int wave = tid >> 6, lane = tid & 63, fr = lane & 15, fq = lane >> 4, n0 = wave * 32;
    if (m0 < MP) { if (g == 0) pool_fill<2, false>(A, m0, g, zb, cache); else if (g == 1) pool_fill<4, false>(A, m0, g, zb, cache); else if (g == 2) pool_fill<8, false>(A, m0, g, zb, cache); else pool_fill<16, false>(A, m0, g, zb, cache); }
    else { if (g == 0) pool_fill<2, true>(A, m0, g, zb, cache); else if (g == 1) pool_fill<4, true>(A, m0, g, zb, cache); else if (g == 2) pool_fill<8, true>(A, m0, g, zb, cache); else pool_fill<16, true>(A, m0, g, zb, cache); }
    __syncthreads();
    f32x4 acc[4][2];
#pragma unroll
    for (int i = 0; i < 4; ++i)
#pragma unroll
        for (int j = 0; j < 2; ++j) acc[i][j] = (f32x4){0.f, 0.f, 0.f, 0.f};
#pragma unroll 2
    for (int ks = 0; ks < 8; ++ks) {
        bf16x8 wf[2], af[4];
#pragma unroll
        for (int nt = 0; nt < 2; ++nt) wf[nt] = *(const bf16x8*)(WpT + (size_t)(g * 256 + n0 + nt * 16 + fr) * 256 + ks * 32 + fq * 8);
#pragma unroll
        for (int mt = 0; mt < 4; ++mt) af[mt] = *(const LAS bf16x8*)(A + (mt * 16 + fr) * LDA + ks * 32 + fq * 8);
#pragma unroll
        for (int mt = 0; mt < 4; ++mt)
#pragma unroll
            for (int nt = 0; nt < 2; ++nt) acc[mt][nt] = __builtin_amdgcn_mfma_f32_16x16x32_bf16(wf[nt], af[mt], acc[mt][nt], 0, 0, 0);
    }
#pragma unroll
    for (int mt = 0; mt < 4; ++mt)
#pragma unroll
        for (int nt = 0; nt < 2; ++nt) {
            u32x2 o; o.x = cvt_pk_bf16(acc[mt][nt][0], acc[mt][nt][1]); o.y = cvt_pk_bf16(acc[mt][nt][2], acc[mt][nt][3]);
            *(u32x2*)(mixb + (size_t)(m0 + mt * 16 + fr) * D + g * 256 + n0 + nt * 16 + 4 * fq) = o;
        }
    __syncthreads();
}

struct SampleRegs { f32x4 S[8]; };
__device__ __forceinline__ void sample_load(SampleRegs& R, const float* S0) {
    const int tid = threadIdx.x, v4 = tid & 31, kq = tid >> 5;
#pragma unroll
    for (int kk = 0; kk < 8; ++kk) R.S[kk] = *(const f32x4*)(S0 + (size_t)(kq * 8 + kk) * HD + 4 * v4);
}
struct SampleStage { float lfv[2]; bf16 q[2], v[2]; };
__device__ __forceinline__ void sample_stage(SampleStage& st, const bf16* zb, const float* lf, int row0, int h) {
    const int tid = threadIdx.x;
#pragma unroll
    for (int j = 0; j < 2; ++j) {
        const int i = tid + 512 * j, t = i >> 7, ch = i & 127; const size_t row = (size_t)(row0 + t);
        st.lfv[j] = lf[row * HW + h * HD + ch]; st.q[j] = zb[row * INC + PW + h * HD + ch]; st.v[j] = zb[row * INC + PW + 2 * HW + h * HD + ch];
    }
}
__device__ __forceinline__ void sample_run(LAS unsigned char* lds, SampleRegs& R, const SampleStage& st, const bf16* zb, const float* hgn, float* Sout, bf16* mixb, int row0, int h) {
    const int tid = threadIdx.x, v4 = tid & 31, kq = tid >> 5, wave = tid >> 6, lane = tid & 63;
    LAS float* sq = (LAS float*)lds; LAS float* sf = sq + 1024; LAS float* sk = sf + 1024; LAS float* sv = sk + 1024; LAS float* red = sv + 1024;
#pragma unroll
    for (int j = 0; j < 2; ++j) {
        const int i = tid + 512 * j;
        const float f = __builtin_amdgcn_exp2f(st.lfv[j]);
        sq[i] = bf2f(st.q[j]); sf[i] = f; sk[i] = 1.f - f; sv[i] = bf2f(st.v[j]);
    }
    __syncthreads();
#pragma unroll 1
    for (int t = 0; t < 8; ++t) {
        const f32x4 vt = *(const LAS f32x4*)(sv + t * 128 + 4 * v4);
        f32x4 o = (f32x4){0.f, 0.f, 0.f, 0.f};
        const f32x4 f0 = *(const LAS f32x4*)(sf + t * 128 + kq * 8), f1 = *(const LAS f32x4*)(sf + t * 128 + kq * 8 + 4);
        const f32x4 k0 = *(const LAS f32x4*)(sk + t * 128 + kq * 8), k1 = *(const LAS f32x4*)(sk + t * 128 + kq * 8 + 4);
        const f32x4 q0 = *(const LAS f32x4*)(sq + t * 128 + kq * 8), q1 = *(const LAS f32x4*)(sq + t * 128 + kq * 8 + 4);
#pragma unroll
        for (int kk = 0; kk < 8; ++kk) {
            const float f = kk < 4 ? f0[kk & 3] : f1[kk & 3], kn = kk < 4 ? k0[kk & 3] : k1[kk & 3], q = kk < 4 ? q0[kk & 3] : q1[kk & 3];
            R.S[kk] = R.S[kk] * f + vt * kn;
            o = o + R.S[kk] * q;
        }
#pragma unroll
        for (int j = 0; j < 4; ++j) o[j] += __shfl_xor(o[j], 32);
        if (lane < 32) *(LAS f32x4*)(red + (wave * 8 + t) * 128 + 4 * v4) = o;
    }
#pragma unroll
    for (int kk = 0; kk < 8; ++kk) *(f32x4*)(Sout + (size_t)(kq * 8 + kk) * HD + 4 * v4) = R.S[kk];
    __syncthreads();
    {
        const int t = wave; const size_t row = (size_t)(row0 + t);
        float o0 = 0.f, o1 = 0.f;
#pragma unroll
        for (int w8 = 0; w8 < 8; ++w8) { o0 += red[(w8 * 8 + t) * 128 + lane]; o1 += red[(w8 * 8 + t) * 128 + lane + 64]; }
        const float ss = wave_sum(o0 * o0 + o1 * o1), r = rsqrtf(ss * (1.f / HD) + EPS);
        const int ch0 = h * HD + lane, ch1 = ch0 + 64;
        mixb[row * D + PW + ch0] = f2bf(o0 * r * hgn[ch0] * bf2f(zb[row * INC + PW + 3 * HW + ch0]));
        mixb[row * D + PW + ch1] = f2bf(o1 * r * hgn[ch1] * bf2f(zb[row * INC + PW + 3 * HW + ch1]));
    }
    __syncthreads();
}

constexpr int CQS = 272, CTS = 144;
constexpr int L_Q = 0, L_K = L_Q + 64 * CQS, L_KT = L_K + 64 * CQS, L_VT = L_KT + 128 * CTS, L_ST = L_VT + 128 * CTS, L_P = L_ST + 128 * CQS,
              L_DS = L_P + 64 * CTS, L_TOT = L_DS + 512, L_RMS = L_TOT + 8192, L_CHAIN_END = L_RMS + 512;
static_assert(L_CHAIN_END <= 131072, "chain LDS");
struct SegIn { f32x4 lf[4]; u32x2 kn[4], v[4], sq[4]; };
template <bool FULL>
__device__ __forceinline__ void seg_load(SegIn& I, const bf16* zb, const float* lf, int row0, int h) {
    const int tid = threadIdx.x, cg = tid & 31, tgp = tid >> 5;
#pragma unroll
    for (int j = 0; j < 4; ++j) {
        const size_t row = (size_t)(row0 + 4 * tgp + j);
        I.lf[j] = *(const f32x4*)(lf + row * HW + h * HD + 4 * cg);
        I.kn[j] = *(const u32x2*)(zb + row * INC + PW + HW + h * HD + 4 * cg);
        I.v[j] = *(const u32x2*)(zb + row * INC + PW + 2 * HW + h * HD + 4 * cg);
        if (FULL) I.sq[j] = *(const u32x2*)(zb + row * INC + PW + h * HD + 4 * cg);
    }
}
template <bool FULL>
__device__ __forceinline__ void seg_run(LAS unsigned char* lds, const bf16* zb, const float* lf, f32x4 (&Sacc)[8], f32x4& segsum, const f32x4 (&gnr)[4], bf16* mixb, int rowb, int nsteps, int h) {
    const int tid = threadIdx.x, lane = tid & 63, wave = __builtin_amdgcn_readfirstlane(tid >> 6), fr = lane & 15, fq = lane >> 4;
    const int cg = tid & 31, tgp = tid >> 5;
    LAS float* dS = (LAS float*)(lds + L_DS); LAS float* tot = (LAS float*)(lds + L_TOT); LAS float* rmsp = (LAS float*)(lds + L_RMS);
    SegIn I;
    seg_load<FULL>(I, zb, lf, rowb, h);
    *(LAS f32x4*)(tot + tgp * 128 + 4 * cg) = (I.lf[0] + I.lf[1]) + (I.lf[2] + I.lf[3]);
    if (FULL) {
#pragma unroll
        for (int kt = 0; kt < 8; ++kt) {
            u32x2 w; w.x = cvt_pk_bf16(Sacc[kt][0], Sacc[kt][1]); w.y = cvt_pk_bf16(Sacc[kt][2], Sacc[kt][3]);
            *(LAS u32x2*)(lds + L_ST + (16 * wave + fr) * CQS + (16 * kt + 4 * fq) * 2) = w;
        }
    }
    __syncthreads();
    for (int c = 0; c < nsteps; ++c) {
        {
            f32x4 b = (f32x4){0.f, 0.f, 0.f, 0.f};
#pragma unroll
            for (int g = 0; g < 15; ++g) { const f32x4 tv = *(const LAS f32x4*)(tot + g * 128 + 4 * cg); if (g < tgp) b = b + tv; }
            float kt[4][4], qt[4][4];
#pragma unroll
            for (int j = 0; j < 4; ++j) {
                b = b + I.lf[j];
                const float kn0 = bflo(I.kn[j].x), kn1 = bfhi(I.kn[j].x), kn2 = bflo(I.kn[j].y), kn3 = bfhi(I.kn[j].y);
                kt[j][0] = kn0 * __builtin_amdgcn_exp2f(-b[0]); kt[j][1] = kn1 * __builtin_amdgcn_exp2f(-b[1]); kt[j][2] = kn2 * __builtin_amdgcn_exp2f(-b[2]); kt[j][3] = kn3 * __builtin_amdgcn_exp2f(-b[3]);
                if (FULL) {
                    qt[j][0] = bflo(I.sq[j].x) * __builtin_amdgcn_exp2f(b[0]); qt[j][1] = bfhi(I.sq[j].x) * __builtin_amdgcn_exp2f(b[1]); qt[j][2] = bflo(I.sq[j].y) * __builtin_amdgcn_exp2f(b[2]); qt[j][3] = bfhi(I.sq[j].y) * __builtin_amdgcn_exp2f(b[3]);
                    const int t = 4 * tgp + j;
                    u32x2 qw, kw; qw.x = cvt_pk_bf16(qt[j][0], qt[j][1]); qw.y = cvt_pk_bf16(qt[j][2], qt[j][3]); kw.x = cvt_pk_bf16(kt[j][0], kt[j][1]); kw.y = cvt_pk_bf16(kt[j][2], kt[j][3]);
                    *(LAS u32x2*)(lds + L_Q + t * CQS + cg * 8) = qw;
                    *(LAS u32x2*)(lds + L_K + t * CQS + cg * 8) = kw;
                }
            }
#pragma unroll
            for (int ch = 0; ch < 4; ++ch) {
                u32x2 kw; kw.x = cvt_pk_bf16(kt[0][ch], kt[1][ch]); kw.y = cvt_pk_bf16(kt[2][ch], kt[3][ch]);
                *(LAS u32x2*)(lds + L_KT + (4 * cg + ch) * CTS + tgp * 8) = kw;
                const unsigned w0 = (ch < 2) ? I.v[0].x : I.v[0].y, w1 = (ch < 2) ? I.v[1].x : I.v[1].y, w2 = (ch < 2) ? I.v[2].x : I.v[2].y, w3 = (ch < 2) ? I.v[3].x : I.v[3].y;
                u32x2 vw;
                if (ch & 1) { vw.x = (w0 >> 16) | (w1 & 0xffff0000u); vw.y = (w2 >> 16) | (w3 & 0xffff0000u); }
                else { vw.x = (w0 & 0xffffu) | (w1 << 16); vw.y = (w2 & 0xffffu) | (w3 << 16); }
                *(LAS u32x2*)(lds + L_VT + (4 * cg + ch) * CTS + tgp * 8) = vw;
            }
            if (tgp == 15) {
                f32x4 e; e[0] = __builtin_amdgcn_exp2f(b[0]); e[1] = __builtin_amdgcn_exp2f(b[1]); e[2] = __builtin_amdgcn_exp2f(b[2]); e[3] = __builtin_amdgcn_exp2f(b[3]);
                *(LAS f32x4*)(dS + 4 * cg) = e; segsum = segsum + b;
            }
        }
        __syncthreads();
        u32x2 sgr[4];
        if (FULL) {
#pragma unroll
            for (int i = 0; i < 4; ++i) sgr[i] = *(const u32x2*)(zb + (size_t)(rowb + 64 * c + 16 * (wave & 3) + fr) * INC + PW + 3 * HW + h * HD + 16 * (4 * (wave >> 2) + i) + 4 * fq);
        }
        if (c + 1 < nsteps) seg_load<FULL>(I, zb, lf, rowb + 64 * (c + 1), h);
        if (FULL) {
#pragma unroll
            for (int i = 0; i < 2; ++i) {
                const int ti = 2 * wave + i, tt = ti >> 2, st = ti & 3;
                f32x4 p = (f32x4){0.f, 0.f, 0.f, 0.f};
#pragma unroll
                for (int ks = 0; ks < 4; ++ks) {
                    const bf16x8 ka = *(const LAS bf16x8*)(lds + L_K + (16 * st + fr) * CQS + (32 * ks + 8 * fq) * 2);
                    const bf16x8 qb = *(const LAS bf16x8*)(lds + L_Q + (16 * tt + fr) * CQS + (32 * ks + 8 * fq) * 2);
                    p = __builtin_amdgcn_mfma_f32_16x16x32_bf16(ka, qb, p, 0, 0, 0);
                }
                const int t = 16 * tt + fr, s0 = 16 * st + 4 * fq;
                u32x2 w; w.x = cvt_pk_bf16(s0 + 0 <= t ? p[0] : 0.f, s0 + 1 <= t ? p[1] : 0.f); w.y = cvt_pk_bf16(s0 + 2 <= t ? p[2] : 0.f, s0 + 3 <= t ? p[3] : 0.f);
                *(LAS u32x2*)(lds + L_P + t * CTS + s0 * 2) = w;
            }
        }
        {
            bf16x8 vb[2];
#pragma unroll
            for (int ss = 0; ss < 2; ++ss) vb[ss] = *(const LAS bf16x8*)(lds + L_VT + (16 * wave + fr) * CTS + (32 * ss + 8 * fq) * 2);
#pragma unroll
            for (int kt = 0; kt < 8; ++kt)
#pragma unroll
                for (int ss = 0; ss < 2; ++ss) {
                    const bf16x8 ka = *(const LAS bf16x8*)(lds + L_KT + (16 * kt + fr) * CTS + (32 * ss + 8 * fq) * 2);
                    Sacc[kt] = __builtin_amdgcn_mfma_f32_16x16x32_bf16(ka, vb[ss], Sacc[kt], 0, 0, 0);
                }
        }
        const int tt = wave & 3, vh = wave >> 2;
        f32x4 o[4];
        if (FULL) {
            __syncthreads();
            bf16x8 pb[2], qb[4];
#pragma unroll
            for (int ss = 0; ss < 2; ++ss) pb[ss] = *(const LAS bf16x8*)(lds + L_P + (16 * tt + fr) * CTS + (32 * ss + 8 * fq) * 2);
#pragma unroll
            for (int ks = 0; ks < 4; ++ks) qb[ks] = *(const LAS bf16x8*)(lds + L_Q + (16 * tt + fr) * CQS + (32 * ks + 8 * fq) * 2);
#pragma unroll
            for (int i = 0; i < 4; ++i) {
                const int vrow = 16 * (4 * vh + i) + fr;
                f32x4 a = (f32x4){0.f, 0.f, 0.f, 0.f};
#pragma unroll
                for (int ss = 0; ss < 2; ++ss) a = __builtin_amdgcn_mfma_f32_16x16x32_bf16(*(const LAS bf16x8*)(lds + L_VT + vrow * CTS + (32 * ss + 8 * fq) * 2), pb[ss], a, 0, 0, 0);
#pragma unroll
                for (int ks = 0; ks < 4; ++ks) a = __builtin_amdgcn_mfma_f32_16x16x32_bf16(*(const LAS bf16x8*)(lds + L_ST + vrow * CQS + (32 * ks + 8 * fq) * 2), qb[ks], a, 0, 0, 0);
                o[i] = a;
            }
            float ss2 = 0.f;
#pragma unroll
            for (int i = 0; i < 4; ++i) ss2 += (o[i][0] * o[i][0] + o[i][1] * o[i][1]) + (o[i][2] * o[i][2] + o[i][3] * o[i][3]);
            ss2 += __shfl_xor(ss2, 16); ss2 += __shfl_xor(ss2, 32);
            if (fq == 0) rmsp[vh * 64 + 16 * tt + fr] = ss2;
        }
#pragma unroll
        for (int kt = 0; kt < 8; ++kt) Sacc[kt] = Sacc[kt] * *(const LAS f32x4*)(dS + 16 * kt + 4 * fq);
        if (c + 1 < nsteps) *(LAS f32x4*)(tot + tgp * 128 + 4 * cg) = (I.lf[0] + I.lf[1]) + (I.lf[2] + I.lf[3]);
        __syncthreads();
        if (FULL) {
            const int tl = 16 * tt + fr; const size_t row = (size_t)(rowb + 64 * c + tl);
            const float r = rsqrtf((rmsp[tl] + rmsp[64 + tl]) * (1.f / HD) + EPS);
#pragma unroll
            for (int i = 0; i < 4; ++i) {
                const int ch = h * HD + 16 * (4 * vh + i) + 4 * fq;
                const f32x4 gn = gnr[i];
                const u32x2 sg = sgr[i];
                const float g0 = __builtin_bit_cast(float, sg.x << 16), g1 = __builtin_bit_cast(float, sg.x & 0xffff0000u), g2 = __builtin_bit_cast(float, sg.y << 16), g3 = __builtin_bit_cast(float, sg.y & 0xffff0000u);
                u32x2 w; w.x = cvt_pk_bf16(o[i][0] * r * gn[0] * g0, o[i][1] * r * gn[1] * g1); w.y = cvt_pk_bf16(o[i][2] * r * gn[2] * g2, o[i][3] * r * gn[3] * g3);
                *(u32x2*)(mixb + row * D + PW + ch) = w;
            }
#pragma unroll
            for (int kt = 0; kt < 8; ++kt) {
                u32x2 w; w.x = cvt_pk_bf16(Sacc[kt][0], Sacc[kt][1]); w.y = cvt_pk_bf16(Sacc[kt][2], Sacc[kt][3]);
                *(LAS u32x2*)(lds + L_ST + (16 * wave + fr) * CQS + (16 * kt + 4 * fq) * 2) = w;
            }
        }
    }
    __syncthreads();
}

#ifndef P2_ORDER_OLD
#define P2_ORDER_OLD 0
#endif
constexpr int CW_FLAG = 32768;
__device__ __forceinline__ void prompt_pass1(LAS unsigned char* lds, const Args& a, int chain, int seg, int nseg) {
    if (seg + 1 >= nseg) return;
    unsigned char* ws = a.ws;
    const bf16* zb = (const bf16*)(ws + WS_ZB); const float* lf = (const float*)(ws + WS_LF); bf16* mixb = (bf16*)(ws + WS_MIX);
    const int tid = threadIdx.x;
    const int b = chain / NH, h = chain % NH, seglen = SEQ / nseg, nsteps = seglen / 64, rowb = b * SEQ + seg * seglen;
    f32x4* slab = (f32x4*)(ws + WS_XB);
    float* dseg = (float*)(ws + WS_XB + 16 * MiB);
    unsigned* flags = (unsigned*)(ws + WS_CTL) + CW_FLAG;
    f32x4 gnr[4];
#pragma unroll
    for (int i = 0; i < 4; ++i) gnr[i] = (f32x4){0.f, 0.f, 0.f, 0.f};
    f32x4 Sacc[8];
#pragma unroll
    for (int i = 0; i < 8; ++i) Sacc[i] = (f32x4){0.f, 0.f, 0.f, 0.f};
    f32x4 segsum = (f32x4){0.f, 0.f, 0.f, 0.f};
    seg_run<false>(lds, zb, lf, Sacc, segsum, gnr, mixb, rowb, nsteps, h);
    const __amdgpu_buffer_rsrc_t srs = __builtin_amdgcn_make_buffer_rsrc((void*)(slab + (size_t)(chain * 8 + seg) * 4096), (short)0, 4096 * 16, 0x00020000);
#pragma unroll
    for (int kt = 0; kt < 8; ++kt) __builtin_amdgcn_raw_buffer_store_b128(__builtin_bit_cast(u32x4, Sacc[kt]), srs, (unsigned)((kt * 512 + tid) * 16), 0, 16);
    if ((tid >> 5) == 15) {
#pragma unroll
        for (int j = 0; j < 4; ++j) __hip_atomic_store((unsigned*)dseg + (chain * 8 + seg) * 128 + 4 * (tid & 31) + j, __builtin_bit_cast(unsigned, __builtin_amdgcn_exp2f(segsum[j])), __ATOMIC_RELAXED, __HIP_MEMORY_SCOPE_AGENT);
    }
    asm volatile("s_waitcnt vmcnt(0)" ::: "memory");
    __syncthreads();
    if (tid == 0) __hip_atomic_store(flags + 64 * (chain * 8 + seg), 1u, __ATOMIC_RELAXED, __HIP_MEMORY_SCOPE_AGENT);
}
__device__ __forceinline__ void prompt_pass2(LAS unsigned char* lds, const Args& a, int chain, int seg, int nseg) {
    unsigned char* ws = a.ws;
    const bf16* zb = (const bf16*)(ws + WS_ZB); const float* lf = (const float*)(ws + WS_LF); bf16* mixb = (bf16*)(ws + WS_MIX);
    const int tid = threadIdx.x, lane = tid & 63, wave = __builtin_amdgcn_readfirstlane(tid >> 6), fr = lane & 15, fq = lane >> 4;
    const int b = chain / NH, h = chain % NH, seglen = SEQ / nseg, nsteps = seglen / 64, rowb = b * SEQ + seg * seglen;
    const f32x4* slab = (const f32x4*)(ws + WS_XB);
    const float* dseg = (const float*)(ws + WS_XB + 16 * MiB);
    unsigned* flags = (unsigned*)(ws + WS_CTL) + CW_FLAG;
    f32x4 gnr[4];
#pragma unroll
    for (int i = 0; i < 4; ++i) gnr[i] = *(const f32x4*)(a.in[9] + h * HD + 16 * (4 * (wave >> 2) + i) + 4 * fq);
    f32x4 Sacc[8];
#pragma unroll
    for (int i = 0; i < 8; ++i) Sacc[i] = (f32x4){0.f, 0.f, 0.f, 0.f};
    f32x4 segsum = (f32x4){0.f, 0.f, 0.f, 0.f};
    if (seg > 0) {
        if (tid < 64) {
            for (int i = 0; i < seg; ++i) { unsigned sp = 0; while (__hip_atomic_load(flags + 64 * (chain * 8 + i), __ATOMIC_RELAXED, __HIP_MEMORY_SCOPE_AGENT) == 0u && ++sp < (1u << 22)) __builtin_amdgcn_s_sleep(2); }
            __builtin_amdgcn_fence(__ATOMIC_ACQUIRE, "agent");
            asm volatile("s_waitcnt vmcnt(0)" ::: "memory");
        }
        __syncthreads();
        f32x4 rc[8], rn[8];
#pragma unroll
        for (int kt = 0; kt < 8; ++kt) { rc[kt] = slab[(size_t)(chain * 8) * 4096 + kt * 512 + tid]; rn[kt] = rc[kt]; }
        for (int i = 0; i < seg; ++i) {
            const float* dd = dseg + (chain * 8 + i) * 128;
            if (i + 1 < seg) {
#pragma unroll
                for (int kt = 0; kt < 8; ++kt) rn[kt] = slab[(size_t)(chain * 8 + i + 1) * 4096 + kt * 512 + tid];
            }
#pragma unroll
            for (int kt = 0; kt < 8; ++kt) Sacc[kt] = Sacc[kt] * *(const f32x4*)(dd + 16 * kt + 4 * fq) + rc[kt];
#pragma unroll
            for (int kt = 0; kt < 8; ++kt) rc[kt] = rn[kt];
        }
    }
    seg_run<true>(lds, zb, lf, Sacc, segsum, gnr, mixb, rowb, nsteps, h);
    if (seg + 1 == nseg) {
        float* Sout = a.out + O_HSP + (size_t)chain * HD * HD;
#pragma unroll
        for (int kt = 0; kt < 8; ++kt)
#pragma unroll
            for (int j = 0; j < 4; ++j) Sout[(size_t)(16 * kt + 4 * fq + j) * HD + 16 * wave + fr] = Sacc[kt][j];
    }
}

__device__ __forceinline__ void phase2(LAS unsigned char* lds, const Args& a, int bid, int G, int parts = 7) {
    unsigned char* ws = a.ws;
    const bf16* zb = (const bf16*)(ws + WS_ZB); const float* lf = (const float*)(ws + WS_LF); bf16* mixb = (bf16*)(ws + WS_MIX);
    constexpr int NPC = NB * NH, NSC = DB * NH, NPOOL = (M / 64) * 4;
    const int nseg = (G >= 8 * NPC) ? 8 : (G >= 4 * NPC ? 4 : (G >= 2 * NPC ? 2 : 1));
    if ((parts & 1) && nseg > 1 && bid < nseg * NPC) prompt_pass1(lds, a, bid / nseg, bid % nseg, nseg);
#if P2_ORDER_OLD
    if (parts & 1) {
        if (nseg > 1) { if (bid < nseg * NPC) prompt_pass2(lds, a, bid / nseg, bid % nseg, nseg); }
        else for (int c = bid; c < NPC; c += G) prompt_pass2(lds, a, c, 0, 1);
    }
#endif
    STAMP(5);
    if (parts & 2) {
        SampleRegs cur, nxt;
        if (bid < NSC) sample_load(cur, a.in[3] + (size_t)bid * HD * HD);
        for (int it = bid; it < NSC; it += G) {
            const bool pf = it + G < NSC;
            SampleStage st; sample_stage(st, zb, lf, MP + (it / NH) * DS, it % NH);
            if (pf) sample_load(nxt, a.in[3] + (size_t)(it + G) * HD * HD);
            sample_run(lds, cur, st, zb, a.in[9], a.out + O_HSS + (size_t)it * HD * HD, mixb, MP + (it / NH) * DS, it % NH);
            if (pf) {
#pragma unroll
                for (int kk = 0; kk < 8; ++kk) cur.S[kk] = nxt.S[kk];
            }
        }
    }
    if (parts & 4) {
        const int first = (NSC + G - 1 - bid) / G * G + bid;
        for (int it = first; it < NSC + NPOOL; it += G) pool_item(lds, it - NSC, zb, a.in[2], (const bf16*)(ws + WS_WP), mixb);
    }
    STAMP(6);
    if (!P2_ORDER_OLD && (parts & 1)) {
        if (nseg > 1) { if (bid < nseg * NPC) prompt_pass2(lds, a, bid / nseg, bid % nseg, nseg); }
        else for (int c = bid; c < NPC; c += G) prompt_pass2(lds, a, c, 0, 1);
    }
}

__device__ __forceinline__ void phase6(const Args& a, int vcu, int G) {
    const int tid = threadIdx.x, lane = tid & 63, wave = tid >> 6;
#ifdef TPROBE
    { unsigned d = *((const unsigned*)(a.ws + WS_CTL) + CW_TP); if (TP_MODE == 2) d = 0x40000000u - d;
#ifdef TP_CAL
      d = TP_REF_US * 95;
#endif
      const float delta = 0.01f * ((float)d * 0.01f) / (float)(TP_REF_US);
      for (int i = vcu * (NWAVES * 64) + tid; i < NB * PC * PW; i += G * NWAVES * 64) a.out[O_PSP + i] += delta; }
#endif
    const int gw = vcu * NWAVES + wave, NGW = G * NWAVES;
    const float* rsq3 = (const float*)(a.ws + WS_CTL) + CW_RSQ3;
    for (int m = gw; m < M; m += NGW) {
        float* yr = a.out + O_Y + (size_t)m * D; const bf16* xr = (const bf16*)(a.ws + WS_X2B) + (size_t)m * D;
        const float r = rsqrtf(rsq3[m] * (1.f / D) + EPS);
#pragma unroll
        for (int j = 0; j < 4; ++j) {
            const u32x4 xw = ((const u32x4*)xr)[lane + 64 * j];
            const f32x4 g0 = ((const f32x4*)a.in[15])[2 * (lane + 64 * j)], g1 = ((const f32x4*)a.in[15])[2 * (lane + 64 * j) + 1];
            ((f32x4*)yr)[2 * (lane + 64 * j)] = (f32x4){bflo(xw.x), bfhi(xw.x), bflo(xw.y), bfhi(xw.y)} * r * g0;
            ((f32x4*)yr)[2 * (lane + 64 * j) + 1] = (f32x4){bflo(xw.z), bfhi(xw.z), bflo(xw.w), bfhi(xw.w)} * r * g1;
        }
    }
}

__global__ void __launch_bounds__(NWAVES * 64, 2) mega(Args a) {
    extern __shared__ __attribute__((aligned(16))) unsigned char lds_raw[];
    LAS unsigned char* lds = (LAS unsigned char*)lds_raw;
    const int G = gridDim.x, bid = blockIdx.x;
    const int vcu = (G % 8 == 0) ? (bid % 8) * (G / 8) + bid / 8 : bid;
    unsigned char* ws = a.ws;
    float* ctlf = (float*)(ws + WS_CTL);
    const int lo = a.ph_lo, hi = a.ph_hi;
#if ONE_LAUNCH && USE_CG
    cg::grid_group grid = cg::this_grid();
#define GRID_BAR() grid.sync()
#elif ONE_LAUNCH
    volatile LAS unsigned* MISC = (volatile LAS unsigned*)(lds + MISC_OFF);
    if (threadIdx.x < 32) MISC[threadIdx.x] = 0u;
    __syncthreads();
    XcdBarrier bar = xcd_barrier_post((unsigned*)(ws + WS_CTL) + CW_BAR, MISC + 8);
#define GRID_BAR() xcd_barrier(bar)
#else
#define GRID_BAR() do {} while (0)
#endif
#ifndef PH_MASK
#define PH_MASK 0x7f
#endif
#define IN(k) (((PH_MASK >> (k)) & 1) && lo <= (k) && (k) < hi)
#define BOTH(k) (IN(k) && IN((k) + 1))
#ifndef REP_MASK
#define REP_MASK 0
#endif
#define REP(k) ((REP_MASK >> (k)) & 1)
#ifndef P2_REP_PARTS
#define P2_REP_PARTS 7
#endif
    STAMP(0);
    if (IN(0)) { if (REP(0)) { phase0(lds, a, vcu, G); __syncthreads(); } phase0(lds, a, vcu, G); STAMP(1); if (BOTH(0)) GRID_BAR(); STAMP(2); }
    if (IN(1)) {
        pg8::Gemm g{(const bf16*)(ws + WS_XB), (const bf16*)(ws + WS_WIN), M, INC, D}; pg8::HybridOrder S; S.init(M, INC, D, G, bid, false);
        const pg8::TailCtx T{nullptr, nullptr};
        pg8::EpiZ E{(bf16*)(ws + WS_ZB), (float*)(ws + WS_LF), (const float*)(ws + WS_MISC), (const float*)(ws + WS_MISC) + M, a.out};
        if (REP(1)) pg8::gemm_phase2(lds, g, S, E, T);
        pg8::gemm_phase2(lds, g, S, E, T);
        STAMP(3);
        if (BOTH(1)) GRID_BAR();
        STAMP(4);
    }
    if (IN(2)) { if (REP(2)) { phase2(lds, a, bid, G, P2_REP_PARTS); __syncthreads(); } phase2(lds, a, bid, G); STAMP(7); if (BOTH(2)) GRID_BAR(); STAMP(8); }
    if (IN(3)) {
        pg8::Gemm g{(const bf16*)(ws + WS_MIX), (const bf16*)(ws + WS_WO), M, D, D}; pg8::HybridOrder S; S.init(M, D, D, G, bid, true);
        const pg8::TailCtx T{(f32x4*)(ws + WS_SLAB3), (unsigned*)(ws + WS_CTL) + CW_TAIL};
        if (REP(3)) { pg8::EpiX1<true> E0{a.in[0], a.in[1], a.out + O_Y, (bf16*)(ws + WS_XB), ctlf + CW_RSQ2}; pg8::gemm_phase2(lds, g, S, E0, T); }
        pg8::EpiX1<false> E{a.in[0], a.in[1], a.out + O_Y, (bf16*)(ws + WS_XB), ctlf + CW_RSQ2};
        pg8::gemm_phase2(lds, g, S, E, T);
        STAMP(9);
        if (BOTH(3)) GRID_BAR();
        STAMP(10);
    }
    if (IN(4)) {
        pg8::Gemm g{(const bf16*)(ws + WS_XB), (const bf16*)(ws + WS_WGU), M, 2 * DFF, D}; pg8::HybridOrder S; S.init(M, 2 * DFF, D, G, bid, true);
        const pg8::TailCtx T{(f32x4*)(ws + WS_SLAB45), (unsigned*)(ws + WS_CTL) + CW_TAIL + 4096};
        pg8::EpiAct E{(bf16*)(ws + WS_ACT), ctlf + CW_RSQ2};
        if (REP(4)) pg8::gemm_phase2(lds, g, S, E, T);
        pg8::gemm_phase2(lds, g, S, E, T);
        STAMP(11);
        if (BOTH(4)) GRID_BAR();
        STAMP(12);
    }
    if (IN(5)) {
        pg8::Gemm g{(const bf16*)(ws + WS_ACT), (const bf16*)(ws + WS_WD), M, D, DFF}; pg8::HybridOrder S; S.init(M, D, DFF, G, bid, true);
        const pg8::TailCtx T{(f32x4*)(ws + WS_SLAB45), (unsigned*)(ws + WS_CTL) + CW_TAIL + 8192};
        if (REP(5)) { pg8::EpiX2<true> E0{(bf16*)(ws + WS_X2B), ctlf + CW_RSQ3, (const bf16*)(ws + WS_XB)}; pg8::gemm_phase2(lds, g, S, E0, T); }
        pg8::EpiX2<false> E{(bf16*)(ws + WS_X2B), ctlf + CW_RSQ3, (const bf16*)(ws + WS_XB)};
        pg8::gemm_phase2(lds, g, S, E, T);
        STAMP(13);
#ifdef TPROBE
        if (threadIdx.x == 0) { volatile LAS unsigned long long* ts = (volatile LAS unsigned long long*)(lds + MISC_OFF + 128); const unsigned d = (unsigned)(ts[TP_B] - ts[TP_A]);
            unsigned* w = (unsigned*)(ws + WS_CTL) + CW_TP; if (TP_MODE == 0) { if (bid == TP_BLOCK) atomicMax(w, d); } else if (TP_MODE == 1) atomicMax(w, d); else atomicMax(w, 0x40000000u - d); }
#endif
        if (BOTH(5)) GRID_BAR();
    }
    if (IN(6)) phase6(a, vcu, G);
#undef IN
#undef BOTH
}

extern "C" void kernel_launch(void* const* d_in, const int* in_sizes, int n_in, void* d_out, int out_size, void* d_ws, size_t ws_size, hipStream_t stream) {
    static int grid = 0;
    if (grid == 0) {
        if (n_in != 16 || ws_size < WS_END) { fprintf(stderr, "kernel_launch: unexpected n_in %d / ws_size %zu\n", n_in, ws_size); grid = -1; return; }
        int dev = 0, cus = 0, per_cu = 0;
        hipGetDevice(&dev);
        hipDeviceGetAttribute(&cus, hipDeviceAttributeMultiprocessorCount, dev);
        hipFuncSetAttribute((const void*)mega, hipFuncAttributeMaxDynamicSharedMemorySize, LDS_BYTES);
        hipOccupancyMaxActiveBlocksPerMultiprocessor(&per_cu, (const void*)mega, NWAVES * 64, LDS_BYTES);
        if (per_cu < 1) { fprintf(stderr, "kernel_launch: occupancy query says %d blocks per CU\n", per_cu); grid = -1; return; }
        grid = cus;
    }
    if (grid < 0) return;
    hipMemsetAsync((char*)d_ws + WS_CTL, 0, CTL_ZERO_BYTES, stream);
    Args a{};
    for (int i = 0; i < 16; ++i) a.in[i] = (const float*)d_in[i];
    a.out = (float*)d_out; a.ws = (unsigned char*)d_ws;
#if ONE_LAUNCH
    a.ph_lo = 0; a.ph_hi = NPHASE;
    void* args[] = {&a};
#if USE_CG
    hipError_t e = hipLaunchCooperativeKernel((const void*)mega, dim3(grid), dim3(NWAVES * 64), args, LDS_BYTES, stream);
    if (e != hipSuccess) fprintf(stderr, "cooperative launch failed: %s (grid %d)\n", hipGetErrorString(e), grid);
#else
    (void)args; hipLaunchKernelGGL(mega, dim3(grid), dim3(NWAVES * 64), LDS_BYTES, stream, a);
#endif
#else
    for (int p = 0; p < NPHASE; ++p) { a.ph_lo = p; a.ph_hi = p + 1; hipLaunchKernelGGL(mega, dim3(grid), dim3(NWAVES * 64), LDS_BYTES, stream, a); }
#endif
}
```

```cpp
#include <hip/hip_runtime.h>
#include <hip/hip_cooperative_groups.h>
#include <cstdio>
#include <cstdint>
namespace cg = cooperative_groups;

constexpr int D = 2048, NB = 4, SEQ = 2048, DB = 128, DS = 8;
constexpr int MP = NB * SEQ, MS = DB * DS, M = MP + MS;
constexpr int PW = 1024, HW = 1024, HD = 128, NH = 8, PC = 15;
constexpr int DFF = 5632, INC = 5120;
constexpr float EPS = 1e-6f;
constexpr size_t O_Y = 0;
constexpr size_t O_PSP = (size_t)M * D;
constexpr size_t O_HSP = O_PSP + (size_t)NB * PC * PW;
constexpr size_t O_PSS = O_HSP + (size_t)NB * NH * HD * HD;
constexpr size_t O_HSS = O_PSS + (size_t)DB * PC * PW;

namespace pg8 {
#define PG8_LAS __attribute__((address_space(3)))
typedef unsigned short bf16_t;
typedef short bf16x8 __attribute__((ext_vector_type(8)));
typedef float f32x4 __attribute__((ext_vector_type(4)));
typedef unsigned u32x4 __attribute__((ext_vector_type(4)));
constexpr int BM = 256, BK = 64, HALF = 128, HTB = HALF * BK * 2  , STAGE_BYTES = 8 * HTB, NXCD = 8, WGM = 8;

__host__ __device__ __forceinline__ int lds_byte(int r, int c) { const int st = (r >> 4) * 2 + (c >> 5), rr = r & 15, cc = c & 31, ob = rr * 64 + cc * 2; return st * 1024 + (ob ^ (((ob >> 9) & 1) << 5)); }
__host__ __device__ __forceinline__ void stage_rc(int b, int& R, int& C) { const int st = b / 1024, sb = b % 1024, swz = sb ^ (((sb >> 9) & 1) << 5); R = (st >> 1) * 16 + swz / 64; C = (st & 1) * 32 + (swz % 64) / 2; }
__host__ __device__ __forceinline__ int perm32(int rho) { const int n = rho >> 4, i = rho & 15; return 8 * (i >> 2) + 4 * n + (i & 3); }

struct Unit { int pm, pn, kb, nk, tinfo; };
struct Gemm { const bf16_t* A; const bf16_t* Bt; int M, N, K; };

struct StaticOrder {
    int nM, nN, nwg, G, c;
    __host__ __device__ void init(int M, int N, int G_, int c_) { nM = M / BM; nN = N / BM; nwg = nM * nN; G = G_; c = c_; }
    __host__ __device__ bool next(int i, Unit& u) const {
        const long L = (long)i * G + c; if (L >= nwg) return false;
        int wgid = (int)L; { const int q = nwg / NXCD, r = nwg % NXCD, xcd = wgid % NXCD, off = wgid / NXCD; wgid = (xcd < r ? xcd * (q + 1) : r * (q + 1) + (xcd - r) * q) + off; }
        const int nig = WGM * nN, gid = wgid / nig, fm = gid * WGM, gsz = (nM - fm) < WGM ? (nM - fm) : WGM;
        u.pm = fm + ((wgid % nig) % gsz); u.pn = (wgid % nig) / gsz; u.kb = 0; u.nk = 0; u.tinfo = -1; return true;
    }
    __device__ __forceinline__ void a_ready(const Unit&) const {}
    __device__ __forceinline__ void done(const Unit&) const {}
};
__device__ __forceinline__ unsigned cvt_pk_bf16(float lo, float hi) { unsigned r; asm volatile("v_cvt_pk_bf16_f32 %0, %1, %2" : "=v"(r) : "v"(lo), "v"(hi)); return r; }
__device__ __forceinline__ float sigm(float x) { return __builtin_amdgcn_rcpf(1.f + __expf(-x)); }
__device__ __forceinline__ float silu(float x) { return x * __builtin_amdgcn_rcpf(1.f + __expf(-x)); }
typedef unsigned u32x2 __attribute__((ext_vector_type(2)));
__device__ __forceinline__ float bflo_(unsigned w) { return __builtin_bit_cast(float, w << 16); }
__device__ __forceinline__ float bfhi_(unsigned w) { return __builtin_bit_cast(float, w & 0xffff0000u); }

struct EpiZ {
    static constexpr bool PERM = true, AFTER_DRAIN = false;
    bf16_t* zb; float* lf; const float* rstd1; const float* lbv; float* out;
    __device__ __forceinline__ void operator()(const f32x4 (&acc)[2][2][4][2], const Unit& u, int wr, int wc, int fr, int fq, unsigned gmask = 0xffu) const {
        const int kind = u.pn >> 2;
        const int row0 = u.pm * BM + wr * 64 + fr;
        const int cc0 = (u.pn & 3) * 256 + wc * 32 + 8 * fq;
        f32x4 lb[2][2];
        if (kind == 2) {
#pragma unroll
            for (int bj = 0; bj < 2; ++bj)
#pragma unroll
                for (int n = 0; n < 2; ++n) lb[bj][n] = *(const f32x4*)(lbv + cc0 + bj * HALF + 4 * n);
        }
#pragma unroll
        for (int ai = 0; ai < 2; ++ai)
#pragma unroll
            for (int m = 0; m < 4; ++m) {
                if (!((gmask >> (ai * 4 + m)) & 1u)) continue;
                const int row = row0 + ai * HALF + m * 16;
                const float r = rstd1[row];
#pragma unroll
                for (int bj = 0; bj < 2; ++bj) {
                    const int cc = cc0 + bj * HALF;
                    f32x4 v0 = acc[ai][bj][m][0] * r, v1 = acc[ai][bj][m][1] * r;
                    if (kind == 2) {
                        f32x4 k0, k1;
#pragma unroll
                        for (int j = 0; j < 4; ++j) {
                            const float f0 = lb[bj][0][j] + (1.f - lb[bj][0][j]) * sigm(v0[j]), f1 = lb[bj][1][j] + (1.f - lb[bj][1][j]) * sigm(v1[j]);
                            v0[j] = __log2f(f0); v1[j] = __log2f(f1); k0[j] = 1.f - f0; k1[j] = 1.f - f1;
                        }
                        float* p = lf + (size_t)row * HW + cc;
                        *(f32x4*)p = v0; *(f32x4*)(p + 4) = v1;
                        u32x4 w; w.x = cvt_pk_bf16(k0[0], k0[1]); w.y = cvt_pk_bf16(k0[2], k0[3]); w.z = cvt_pk_bf16(k1[0], k1[1]); w.w = cvt_pk_bf16(k1[2], k1[3]);
                        *(u32x4*)(zb + (size_t)row * INC + 2 * 1024 + cc) = w;
                    } else {
                        if (kind == 0) {
                            float* dst = nullptr;
                            if (row >= MP) { const int ms = row - MP; dst = out + O_PSS + ((size_t)(ms >> 3) * PC + 7 + (ms & 7)) * PW + cc; }
                            else { const int t = row & (SEQ - 1); if (t >= SEQ - PC) dst = out + O_PSP + ((size_t)(row >> 11) * PC + (t - (SEQ - PC))) * PW + cc; }
                            if (dst) { *(f32x4*)dst = v0; *(f32x4*)(dst + 4) = v1; }
                        }
                        if (kind == 1 || kind == 4) {
#pragma unroll
                            for (int j = 0; j < 4; ++j) { v0[j] = silu(v0[j]); v1[j] = silu(v1[j]); }
                        }
                        u32x4 w; w.x = cvt_pk_bf16(v0[0], v0[1]); w.y = cvt_pk_bf16(v0[2], v0[3]); w.z = cvt_pk_bf16(v1[0], v1[1]); w.w = cvt_pk_bf16(v1[2], v1[3]);
                        *(u32x4*)(zb + (size_t)row * INC + kind * 1024 + cc) = w;
                    }
                }
            }
    }
};

__device__ __forceinline__ void store16(bf16_t* base, size_t elem_off, u32x4 w, bool wt) {
    if (wt) { const __amdgpu_buffer_rsrc_t r = __builtin_amdgcn_make_buffer_rsrc((void*)base, (short)0, 0x7fffffff, 0x00020000); __builtin_amdgcn_raw_buffer_store_b128(w, r, (unsigned)(elem_off * 2), 0, 16); }
    else *(u32x4*)(base + elem_off) = w;
}
template <bool DRY = false> struct EpiX1 {
    static constexpr bool PERM = true, AFTER_DRAIN = false;
    const float* xp; const float* xs; float* y; bf16_t* x1b; float* rowsq; bool wt;
    __device__ __forceinline__ void operator()(const f32x4 (&acc)[2][2][4][2], const Unit& u, int wr, int wc, int fr, int fq, unsigned gmask = 0xffu) const {
        const int row0 = u.pm * BM + wr * 64 + fr, col0 = u.pn * BM + wc * 32 + 8 * fq;
#pragma unroll
        for (int ai = 0; ai < 2; ++ai)
#pragma unroll
            for (int m = 0; m < 4; ++m) {
                if (!((gmask >> (ai * 4 + m)) & 1u)) continue;
                const int row = row0 + ai * HALF + m * 16;
                const float* xr = (row < MP ? xp + (size_t)row * D : xs + (size_t)(row - MP) * D) + col0;
                float s = 0.f;
#pragma unroll
                for (int bj = 0; bj < 2; ++bj) {
                    const f32x4 v0 = *(const f32x4*)(xr + bj * HALF) + acc[ai][bj][m][0], v1 = *(const f32x4*)(xr + bj * HALF + 4) + acc[ai][bj][m][1];
                    u32x4 w; w.x = cvt_pk_bf16(v0[0], v0[1]); w.y = cvt_pk_bf16(v0[2], v0[3]); w.z = cvt_pk_bf16(v1[0], v1[1]); w.w = cvt_pk_bf16(v1[2], v1[3]);
                    store16(x1b, (size_t)row * D + col0 + bj * HALF, w, wt);
                    s += (v0[0] * v0[0] + v0[1] * v0[1]) + (v0[2] * v0[2] + v0[3] * v0[3]) + (v1[0] * v1[0] + v1[1] * v1[1]) + (v1[2] * v1[2] + v1[3] * v1[3]);
                }
                s += __shfl_xor(s, 16); s += __shfl_xor(s, 32);
                if (fq == 0 && !DRY) atomicAdd(rowsq + row, s);
            }
    }
};

struct EpiAct {
    static constexpr bool PERM = true, AFTER_DRAIN = false;
    bf16_t* act; const float* rowsq; bool wt;
    __device__ __forceinline__ void operator()(const f32x4 (&acc)[2][2][4][2], const Unit& u, int wr, int wc, int fr, int fq, unsigned gmask = 0xffu) const {
        const int row0 = u.pm * BM + wr * 64 + fr, col0 = u.pn * HALF + wc * 32 + 8 * fq;
#pragma unroll
        for (int ai = 0; ai < 2; ++ai)
#pragma unroll
            for (int m = 0; m < 4; ++m) {
                if (!((gmask >> (ai * 4 + m)) & 1u)) continue;
                const int row = row0 + ai * HALF + m * 16;
                const float r = rsqrtf(rowsq[row] * (1.f / D) + EPS);
                u32x4 w; unsigned* wp = (unsigned*)&w;
#pragma unroll
                for (int n = 0; n < 2; ++n) {
                    const f32x4 g = acc[ai][0][m][n] * r, up = acc[ai][1][m][n] * r;
                    f32x4 a;
#pragma unroll
                    for (int j = 0; j < 4; ++j) a[j] = silu(g[j]) * up[j];
                    wp[2 * n] = cvt_pk_bf16(a[0], a[1]); wp[2 * n + 1] = cvt_pk_bf16(a[2], a[3]);
                }
                store16(act, (size_t)row * DFF + col0, w, wt);
            }
    }
};

template <bool DRY = false> struct EpiX2 {
    static constexpr bool PERM = true, AFTER_DRAIN = false;
    bf16_t* x2b; float* rowsq; const bf16_t* x1b;
    __device__ __forceinline__ void operator()(const f32x4 (&acc)[2][2][4][2], const Unit& u, int wr, int wc, int fr, int fq, unsigned gmask = 0xffu) const {
        const int row0 = u.pm * BM + wr * 64 + fr, col0 = u.pn * BM + wc * 32 + 8 * fq;
#pragma unroll
        for (int ai = 0; ai < 2; ++ai)
#pragma unroll
            for (int m = 0; m < 4; ++m) {
                if (!((gmask >> (ai * 4 + m)) & 1u)) continue;
                const int row = row0 + ai * HALF + m * 16;
                float s = 0.f;
#pragma unroll
                for (int bj = 0; bj < 2; ++bj) {
                    const u32x4 xw = *(const u32x4*)(x1b + (size_t)row * D + col0 + bj * HALF);
                    f32x4 v0 = (f32x4){bflo_(xw.x), bfhi_(xw.x), bflo_(xw.y), bfhi_(xw.y)} + acc[ai][bj][m][0];
                    f32x4 v1 = (f32x4){bflo_(xw.z), bfhi_(xw.z), bflo_(xw.w), bfhi_(xw.w)} + acc[ai][bj][m][1];
                    u32x4 w; w.x = cvt_pk_bf16(v0[0], v0[1]); w.y = cvt_pk_bf16(v0[2], v0[3]); w.z = cvt_pk_bf16(v1[0], v1[1]); w.w = cvt_pk_bf16(v1[2], v1[3]);
                    *(u32x4*)(x2b + (size_t)row * D + col0 + bj * HALF) = w;
                    s += (v0[0] * v0[0] + v0[1] * v0[1]) + (v0[2] * v0[2] + v0[3] * v0[3]) + (v1[0] * v1[0] + v1[1] * v1[1]) + (v1[2] * v1[2] + v1[3] * v1[3]);
                }
                s += __shfl_xor(s, 16); s += __shfl_xor(s, 32);
                if (fq == 0 && !DRY) atomicAdd(rowsq + row, s);
            }
    }
};
template <class Epi, class Sched, bool ALIGN_EPI = false, bool SP2 = false>
__device__ __forceinline__ void gemm_phase(PG8_LAS unsigned char* lds, const Gemm g, const Sched& S, const Epi& E) {
    int tid_ = threadIdx.x; asm volatile("" : "+v"(tid_));
    const int tid = tid_, wid = __builtin_amdgcn_readfirstlane(tid >> 6), lane = tid & 63, wr = wid >> 2, wc = wid & 3, fr = lane & 15, fq = lane >> 4;
    const int K = g.K, nt = K / BK;
    unsigned voffA[2], voffB[2];
#pragma unroll
    for (int i = 0; i < 2; ++i) { int R, C; stage_rc(tid * 16 + i * 8192, R, C); const int Rb = Epi::PERM ? ((R & ~31) + perm32(R & 31)) : R;
        voffA[i] = (unsigned)(R * K + C) * 2u; voffB[i] = (unsigned)(Rb * K + C) * 2u; }
    const size_t kstep = (size_t)(BK * 2);
    const size_t hstep = (size_t)HALF * K * 2;
    const size_t tstep = 2 * hstep;
    const unsigned ldsw = (unsigned)wid * 1024u;
    const int aoff = lds_byte(wr * 64 + fr, fq * 8), boff = lds_byte(wc * 32 + fr, fq * 8);
#define PG8_SA(b, h) (((b) * 2 + (h)) * HTB)
#define PG8_SB(b, h) ((4 + (b) * 2 + (h)) * HTB)
#define PG8_STAGE(bufoff, gbase, voff) do { _Pragma("unroll") for (int _i = 0; _i < 2; ++_i) \
        __builtin_amdgcn_global_load_lds((const unsigned*)((const char*)(gbase) + (voff)[_i]), (PG8_LAS unsigned*)(lds + (bufoff) + ldsw + _i * 8192), 16, 0, 0); } while (0)
#define PG8_LDA(dst, b, h) do { _Pragma("unroll") for (int m = 0; m < 4; ++m) _Pragma("unroll") for (int k = 0; k < 2; ++k) dst[m][k] = *(const PG8_LAS bf16x8*)(lds + PG8_SA(b, h) + aoff + m * 2048 + k * 1024); } while (0)
#define PG8_LDB(dst, b, h) do { _Pragma("unroll") for (int n = 0; n < 2; ++n) _Pragma("unroll") for (int k = 0; k < 2; ++k) dst[n][k] = *(const PG8_LAS bf16x8*)(lds + PG8_SB(b, h) + boff + n * 2048 + k * 1024); } while (0)
#define PG8_MMA(ai, bj, At, Bt) do { __builtin_amdgcn_s_setprio(1); _Pragma("unroll") for (int m = 0; m < 4; ++m) _Pragma("unroll") for (int n = 0; n < 2; ++n) _Pragma("unroll") for (int k = 0; k < 2; ++k) \
        acc[ai][bj][m][n] = __builtin_amdgcn_mfma_f32_16x16x32_bf16(Bt[n][k], At[m][k], acc[ai][bj][m][n], 0, 0, 0); __builtin_amdgcn_s_setprio(0); } while (0)
#define PG8_WAIT_V(n) asm volatile("s_waitcnt vmcnt(" #n ")" ::: "memory")
#define PG8_WAIT_L(n) asm volatile("s_waitcnt lgkmcnt(" #n ")" ::: "memory")
#define PG8_BAR __builtin_amdgcn_s_barrier()
#define PG8_SCHED __builtin_amdgcn_sched_barrier(0)
    Unit cur, nxt; int ui = 0;
    if (!S.next(0, cur)) return;
    f32x4 acc[2][2][4][2];
#pragma unroll
    for (int a = 0; a < 2; ++a)
#pragma unroll
        for (int b = 0; b < 2; ++b)
#pragma unroll
            for (int m = 0; m < 4; ++m)
#pragma unroll
                for (int n = 0; n < 2; ++n) acc[a][b][m][n] = (f32x4){0.f, 0.f, 0.f, 0.f};
    bf16x8 At[4][2], B0[2][2], B1[2][2];
    const char* cA = (const char*)g.A + (size_t)cur.pm * tstep; const char* cB = (const char*)g.Bt + (size_t)cur.pn * tstep;
    S.a_ready(cur);
    if constexpr (SP2) {
        PG8_STAGE(PG8_SB(0, 0), cB, voffB); PG8_STAGE(PG8_SB(0, 1), cB + hstep, voffB); PG8_STAGE(PG8_SA(0, 0), cA, voffA); PG8_STAGE(PG8_SA(0, 1), cA + hstep, voffA);
        if (wr == 1) PG8_BAR;
        PG8_WAIT_V(2); PG8_BAR;
        PG8_STAGE(PG8_SB(1, 0), cB + kstep, voffB); PG8_STAGE(PG8_SA(1, 0), cA + kstep, voffA); PG8_STAGE(PG8_SB(1, 1), cB + hstep + kstep, voffB);
        PG8_WAIT_V(6); PG8_BAR;
    } else {
        PG8_STAGE(PG8_SB(0, 0), cB, voffB); PG8_STAGE(PG8_SA(0, 0), cA, voffA); PG8_STAGE(PG8_SB(0, 1), cB + hstep, voffB); PG8_STAGE(PG8_SA(0, 1), cA + hstep, voffA);
        if (wr == 1) PG8_BAR;
        PG8_WAIT_V(4); PG8_BAR;
        PG8_STAGE(PG8_SB(1, 0), cB + kstep, voffB); PG8_STAGE(PG8_SA(1, 0), cA + kstep, voffA); PG8_STAGE(PG8_SB(1, 1), cB + hstep + kstep, voffB);
        PG8_WAIT_V(6); PG8_BAR;
    }
    for (;;) {
        const bool has_next = S.next(ui + 1, nxt);
        const char* nA = has_next ? (const char*)g.A + (size_t)nxt.pm * tstep : cA; const char* nB = has_next ? (const char*)g.Bt + (size_t)nxt.pn * tstep : cB;
        for (int t = 0; t < nt; t += 2) {
            const bool last = (t == nt - 2);
            const char* a1 = cA + (size_t)(t + 1) * kstep;
            const char* a2 = last ? nA : cA + (size_t)(t + 2) * kstep; const char* b2 = last ? nB : cB + (size_t)(t + 2) * kstep;
            const char* a3 = a2 + kstep; const char* b3 = b2 + kstep;
            if (last && has_next) S.a_ready(nxt);
            if constexpr (SP2) {
            PG8_LDB(B0, 0, 0); PG8_LDB(B1, 0, 1); PG8_SCHED; PG8_LDA(At, 0, 0); PG8_STAGE(PG8_SA(1, 1), a1 + hstep, voffA);
            PG8_WAIT_V(8); PG8_WAIT_L(0); PG8_BAR; PG8_MMA(0, 0, At, B0); PG8_MMA(0, 1, At, B1); PG8_BAR; PG8_SCHED;
            PG8_LDA(At, 0, 1); PG8_STAGE(PG8_SB(0, 0), b2, voffB); PG8_STAGE(PG8_SB(0, 1), b2 + hstep, voffB); PG8_STAGE(PG8_SA(0, 0), a2, voffA);
            PG8_WAIT_V(8); PG8_WAIT_L(0); PG8_BAR; PG8_MMA(1, 0, At, B0); PG8_MMA(1, 1, At, B1); PG8_BAR; PG8_SCHED;
            PG8_LDB(B0, 1, 0); PG8_LDB(B1, 1, 1); PG8_SCHED; PG8_LDA(At, 1, 0); PG8_STAGE(PG8_SA(0, 1), a2 + hstep, voffA);
            PG8_WAIT_V(8); PG8_WAIT_L(0); PG8_BAR; PG8_MMA(0, 0, At, B0); PG8_MMA(0, 1, At, B1); PG8_BAR; PG8_SCHED;
            PG8_LDA(At, 1, 1); PG8_STAGE(PG8_SB(1, 0), b3, voffB); PG8_STAGE(PG8_SB(1, 1), b3 + hstep, voffB); PG8_STAGE(PG8_SA(1, 0), a3, voffA);
            PG8_WAIT_V(8); PG8_WAIT_L(0); PG8_BAR; PG8_MMA(1, 0, At, B0); PG8_MMA(1, 1, At, B1); PG8_BAR; PG8_SCHED;
            } else {
            PG8_LDB(B0, 0, 0); PG8_SCHED; PG8_LDA(At, 0, 0); PG8_STAGE(PG8_SA(1, 1), a1 + hstep, voffA);
            PG8_WAIT_L(8); PG8_BAR; PG8_WAIT_L(0); PG8_MMA(0, 0, At, B0); PG8_BAR; PG8_SCHED;
            PG8_LDB(B1, 0, 1); PG8_STAGE(PG8_SB(0, 0), b2, voffB);
            PG8_BAR; PG8_WAIT_L(0); PG8_MMA(0, 1, At, B1); PG8_BAR;
            PG8_LDA(At, 0, 1); PG8_STAGE(PG8_SA(0, 0), a2, voffA);
            PG8_BAR; PG8_WAIT_L(0); PG8_MMA(1, 0, At, B0); PG8_BAR; PG8_SCHED;
            PG8_STAGE(PG8_SB(0, 1), b2 + hstep, voffB);
            PG8_WAIT_V(6); PG8_BAR; PG8_MMA(1, 1, At, B1); PG8_BAR;
            PG8_LDB(B0, 1, 0); PG8_SCHED; PG8_LDA(At, 1, 0); PG8_STAGE(PG8_SA(0, 1), a2 + hstep, voffA);
            PG8_WAIT_L(8); PG8_BAR; PG8_WAIT_L(0); PG8_MMA(0, 0, At, B0); PG8_BAR; PG8_SCHED;
            PG8_LDB(B1, 1, 1); PG8_STAGE(PG8_SB(1, 0), b3, voffB);
            PG8_BAR; PG8_WAIT_L(0); PG8_MMA(0, 1, At, B1); PG8_BAR;
            PG8_LDA(At, 1, 1); PG8_STAGE(PG8_SA(1, 0), a3, voffA);
            PG8_BAR; PG8_WAIT_L(0); PG8_MMA(1, 0, At, B0); PG8_BAR; PG8_SCHED;
            PG8_STAGE(PG8_SB(1, 1), b3 + hstep, voffB);
            PG8_WAIT_V(6); PG8_BAR; PG8_MMA(1, 1, At, B1); PG8_BAR;
            }
        }
        if constexpr (ALIGN_EPI) { if (wr == 0) PG8_BAR; }
        if constexpr (!Epi::AFTER_DRAIN) { E(acc, cur, wr, wc, fr, fq); S.done(cur); }
        if (!has_next) break;
#pragma unroll
        for (int a = 0; a < 2; ++a)
#pragma unroll
            for (int b = 0; b < 2; ++b)
#pragma unroll
                for (int m = 0; m < 4; ++m)
#pragma unroll
                    for (int n = 0; n < 2; ++n) acc[a][b][m][n] = (f32x4){0.f, 0.f, 0.f, 0.f};
        cur = nxt; cA = nA; cB = nB; ++ui;
        if constexpr (ALIGN_EPI) { if (wr == 1) PG8_BAR; }
    }
    PG8_WAIT_V(0);
    if constexpr (!ALIGN_EPI) { if (wr == 0) PG8_BAR; }
    PG8_BAR;
    if constexpr (Epi::AFTER_DRAIN) { E.fused(acc, cur, wr, wc, fr, fq, lds, wid, lane); S.done(cur); }
#undef PG8_SA
#undef PG8_SB
#undef PG8_STAGE
#undef PG8_LDA
#undef PG8_LDB
#undef PG8_MMA
#undef PG8_WAIT_V
#undef PG8_WAIT_L
#undef PG8_BAR
#undef PG8_SCHED
}

struct HybridOrder {
    int nM, nN, nwg, G, c, nt, nfull, R, ns;
    __device__ __forceinline__ void init(int M, int N, int K, int G_, int c_, bool allow_split) {
        nM = M / BM; nN = N / BM; nwg = nM * nN; G = G_; c = c_; nt = K / BK; nfull = nwg / G; R = nwg - nfull * G;
        ns = (allow_split && R > 0 && (R % 8) == 0 && (G % 8) == 0) ? G / R : 1; if (ns > 8) ns = 8; if (ns > nt / 2) ns = nt / 2; if (ns < 2) ns = 1;
    }
    __device__ __forceinline__ void map(int L, Unit& u) const {
        int wgid = L; { const int q = nwg / NXCD, r = nwg % NXCD, xcd = wgid % NXCD, off = wgid / NXCD; wgid = (xcd < r ? xcd * (q + 1) : r * (q + 1) + (xcd - r) * q) + off; }
        const int nig = WGM * nN, gid = wgid / nig, fm = gid * WGM, gsz = (nM - fm) < WGM ? (nM - fm) : WGM;
        u.pm = fm + ((wgid % nig) % gsz); u.pn = (wgid % nig) / gsz;
    }
    __device__ __forceinline__ bool next(int i, Unit& u) const {
        if (i < nfull) { map(i * G + c, u); u.kb = 0; u.nk = nt; u.tinfo = -1; return true; }
        if (i > nfull || R == 0) return false;
        if (ns < 2) { const int L = i * G + c; if (L >= nwg) return false; map(L, u); u.kb = 0; u.nk = nt; u.tinfo = -1; return true; }
        const int x = c % 8, y = c / 8, tj = (y / ns) * 8 + x, slice = y % ns;
        if (tj >= R) return false;
        map(nfull * G + tj, u);
        const int pairs = nt / 2, base = pairs / ns, rem = pairs % ns, start = slice * base + (slice < rem ? slice : rem), mine = base + (slice < rem ? 1 : 0);
        u.kb = 2 * start; u.nk = 2 * mine; u.tinfo = (tj << 8) | (slice << 4) | ns; return true;
    }
};
struct TailCtx { f32x4* slab; unsigned* cnt; };

template <class Epi>
__device__ __forceinline__ void tail_fixup(f32x4 (&acc)[2][2][4][2], const Unit& u, const Epi& E, const TailCtx& T, int tid, int wr, int wc, int fr, int fq) {
    const int tj = u.tinfo >> 8, slice = (u.tinfo >> 4) & 15, ns = u.tinfo & 15;
    const __amdgpu_buffer_rsrc_t srs = __builtin_amdgcn_make_buffer_rsrc((void*)(T.slab + (size_t)(tj * ns + slice) * (32 * 512)), (short)0, 32 * 512 * 16, 0x00020000);
#pragma unroll
    for (int ai = 0; ai < 2; ++ai)
#pragma unroll
        for (int bj = 0; bj < 2; ++bj)
#pragma unroll
            for (int m = 0; m < 4; ++m)
#pragma unroll
                for (int n = 0; n < 2; ++n) __builtin_amdgcn_raw_buffer_store_b128(__builtin_bit_cast(u32x4, acc[ai][bj][m][n]), srs, (unsigned)(((((ai * 2 + bj) * 4 + m) * 2 + n) * 512 + tid) * 16), 0, 16);
    asm volatile("s_waitcnt vmcnt(0)" ::: "memory");
    __syncthreads();
    if (tid == 0) __hip_atomic_fetch_add(T.cnt + 64 * tj, 1u, __ATOMIC_RELAXED, __HIP_MEMORY_SCOPE_AGENT);
    if (tid < 64) {
        unsigned sp = 0;
        while (__hip_atomic_load(T.cnt + 64 * tj, __ATOMIC_RELAXED, __HIP_MEMORY_SCOPE_AGENT) < (unsigned)ns && ++sp < (1u << 22)) __builtin_amdgcn_s_sleep(2);
        __builtin_amdgcn_fence(__ATOMIC_ACQUIRE, "agent");
        asm volatile("s_waitcnt vmcnt(0)" ::: "memory");
    }
    __syncthreads();
    unsigned gmask = 0u;
    for (int g = slice; g < 8; g += ns) gmask |= 1u << g;
    const f32x4* tile = T.slab + (size_t)(tj * ns) * (32 * 512);
#pragma unroll
    for (int ai = 0; ai < 2; ++ai)
#pragma unroll
        for (int m = 0; m < 4; ++m) {
            if (!((gmask >> (ai * 4 + m)) & 1u)) continue;
#pragma unroll
            for (int bj = 0; bj < 2; ++bj)
#pragma unroll
                for (int n = 0; n < 2; ++n) {
                    const int idx = ((ai * 2 + bj) * 4 + m) * 2 + n;
                    f32x4 v = tile[idx * 512 + tid];
                    for (int sl = 1; sl < ns; ++sl) v = v + tile[(size_t)sl * (32 * 512) + idx * 512 + tid];
                    acc[ai][bj][m][n] = v;
                }
        }
    E(acc, u, wr, wc, fr, fq, gmask);
}

template <class Epi, class Sched>
__device__ __forceinline__ void gemm_phase2(PG8_LAS unsigned char* lds, const Gemm g, const Sched& S, const Epi& E, const TailCtx& T) {
    int tid_ = threadIdx.x; asm volatile("" : "+v"(tid_));
    const int tid = tid_, wid = __builtin_amdgcn_readfirstlane(tid >> 6), lane = tid & 63, wr = wid >> 2, wc = wid & 3, fr = lane & 15, fq = lane >> 4;
    const int K = g.K;
    unsigned voffA[2], voffB[2];
#pragma unroll
    for (int i = 0; i < 2; ++i) { int R, C; stage_rc(tid * 16 + i * 8192, R, C); const int Rb = Epi::PERM ? ((R & ~31) + perm32(R & 31)) : R;
        voffA[i] = (unsigned)(R * K + C) * 2u; voffB[i] = (unsigned)(Rb * K + C) * 2u; }
    const size_t kstep = (size_t)(BK * 2), hstep = (size_t)HALF * K * 2, tstep = 2 * hstep;
    const unsigned ldsw = (unsigned)wid * 1024u;
    const int aoff = lds_byte(wr * 64 + fr, fq * 8), boff = lds_byte(wc * 32 + fr, fq * 8);
#define PG8_SA(b, h) (((b) * 2 + (h)) * HTB)
#define PG8_SB(b, h) ((4 + (b) * 2 + (h)) * HTB)
#define PG8_STAGE(bufoff, gbase, voff) do { _Pragma("unroll") for (int _i = 0; _i < 2; ++_i) \
        __builtin_amdgcn_global_load_lds((const unsigned*)((const char*)(gbase) + (voff)[_i]), (PG8_LAS unsigned*)(lds + (bufoff) + ldsw + _i * 8192), 16, 0, 0); } while (0)
#define PG8_LDA(dst, b, h) do { _Pragma("unroll") for (int m = 0; m < 4; ++m) _Pragma("unroll") for (int k = 0; k < 2; ++k) dst[m][k] = *(const PG8_LAS bf16x8*)(lds + PG8_SA(b, h) + aoff + m * 2048 + k * 1024); } while (0)
#define PG8_LDB(dst, b, h) do { _Pragma("unroll") for (int n = 0; n < 2; ++n) _Pragma("unroll") for (int k = 0; k < 2; ++k) dst[n][k] = *(const PG8_LAS bf16x8*)(lds + PG8_SB(b, h) + boff + n * 2048 + k * 1024); } while (0)
#define PG8_MMA(ai, bj, At, Bt) do { __builtin_amdgcn_s_setprio(1); _Pragma("unroll") for (int m = 0; m < 4; ++m) _Pragma("unroll") for (int n = 0; n < 2; ++n) _Pragma("unroll") for (int k = 0; k < 2; ++k) \
        acc[ai][bj][m][n] = __builtin_amdgcn_mfma_f32_16x16x32_bf16(Bt[n][k], At[m][k], acc[ai][bj][m][n], 0, 0, 0); __builtin_amdgcn_s_setprio(0); } while (0)
#define PG8_WAIT_V(n) asm volatile("s_waitcnt vmcnt(" #n ")" ::: "memory")
#define PG8_WAIT_L(n) asm volatile("s_waitcnt lgkmcnt(" #n ")" ::: "memory")
#define PG8_BAR __builtin_amdgcn_s_barrier()
#define PG8_SCHED __builtin_amdgcn_sched_barrier(0)
    Unit cur, nxt; int ui = 0;
    if (!S.next(0, cur)) return;
    f32x4 acc[2][2][4][2];
#pragma unroll
    for (int a = 0; a < 2; ++a)
#pragma unroll
        for (int b = 0; b < 2; ++b)
#pragma unroll
            for (int m = 0; m < 4; ++m)
#pragma unroll
                for (int n = 0; n < 2; ++n) acc[a][b][m][n] = (f32x4){0.f, 0.f, 0.f, 0.f};
    bf16x8 At[4][2], B0[2][2], B1[2][2];
    const char* cA = (const char*)g.A + (size_t)cur.pm * tstep + (size_t)cur.kb * kstep; const char* cB = (const char*)g.Bt + (size_t)cur.pn * tstep + (size_t)cur.kb * kstep;
    PG8_STAGE(PG8_SB(0, 0), cB, voffB); PG8_STAGE(PG8_SB(0, 1), cB + hstep, voffB); PG8_STAGE(PG8_SA(0, 0), cA, voffA); PG8_STAGE(PG8_SA(0, 1), cA + hstep, voffA);
    if (wr == 1) PG8_BAR;
    PG8_WAIT_V(2); PG8_BAR;
    PG8_STAGE(PG8_SB(1, 0), cB + kstep, voffB); PG8_STAGE(PG8_SA(1, 0), cA + kstep, voffA); PG8_STAGE(PG8_SB(1, 1), cB + hstep + kstep, voffB);
    PG8_WAIT_V(6); PG8_BAR;
    for (;;) {
        const bool has_next = S.next(ui + 1, nxt);
        const char* nA = has_next ? (const char*)g.A + (size_t)nxt.pm * tstep + (size_t)nxt.kb * kstep : cA; const char* nB = has_next ? (const char*)g.Bt + (size_t)nxt.pn * tstep + (size_t)nxt.kb * kstep : cB;
        const int nt = cur.nk;
        for (int t = 0; t < nt; t += 2) {
            const bool last = (t == nt - 2);
            const char* a1 = cA + (size_t)(t + 1) * kstep;
            const char* a2 = last ? nA : cA + (size_t)(t + 2) * kstep; const char* b2 = last ? nB : cB + (size_t)(t + 2) * kstep;
            const char* a3 = a2 + kstep; const char* b3 = b2 + kstep;
            PG8_LDB(B0, 0, 0); PG8_LDB(B1, 0, 1); PG8_SCHED; PG8_LDA(At, 0, 0); PG8_STAGE(PG8_SA(1, 1), a1 + hstep, voffA);
            PG8_WAIT_V(8); PG8_WAIT_L(0); PG8_BAR; PG8_MMA(0, 0, At, B0); PG8_MMA(0, 1, At, B1); PG8_BAR; PG8_SCHED;
            PG8_LDA(At, 0, 1); PG8_STAGE(PG8_SB(0, 0), b2, voffB); PG8_STAGE(PG8_SB(0, 1), b2 + hstep, voffB); PG8_STAGE(PG8_SA(0, 0), a2, voffA);
            PG8_WAIT_V(8); PG8_WAIT_L(0); PG8_BAR; PG8_MMA(1, 0, At, B0); PG8_MMA(1, 1, At, B1); PG8_BAR; PG8_SCHED;
            PG8_LDB(B0, 1, 0); PG8_LDB(B1, 1, 1); PG8_SCHED; PG8_LDA(At, 1, 0); PG8_STAGE(PG8_SA(0, 1), a2 + hstep, voffA);
            PG8_WAIT_V(8); PG8_WAIT_L(0); PG8_BAR; PG8_MMA(0, 0, At, B0); PG8_MMA(0, 1, At, B1); PG8_BAR; PG8_SCHED;
            PG8_LDA(At, 1, 1); PG8_STAGE(PG8_SB(1, 0), b3, voffB); PG8_STAGE(PG8_SB(1, 1), b3 + hstep, voffB); PG8_STAGE(PG8_SA(1, 0), a3, voffA);
            PG8_WAIT_V(8); PG8_WAIT_L(0); PG8_BAR; PG8_MMA(1, 0, At, B0); PG8_MMA(1, 1, At, B1); PG8_BAR; PG8_SCHED;
        }
        if (wr == 0) PG8_BAR;
        if (cur.tinfo < 0) E(acc, cur, wr, wc, fr, fq);
        if (!has_next) break;
#pragma unroll
        for (int a = 0; a < 2; ++a)
#pragma unroll
            for (int b = 0; b < 2; ++b)
#pragma unroll
                for (int m = 0; m < 4; ++m)
#pragma unroll
                    for (int n = 0; n < 2; ++n) acc[a][b][m][n] = (f32x4){0.f, 0.f, 0.f, 0.f};
        cur = nxt; cA = nA; cB = nB; ++ui;
        if (wr == 1) PG8_BAR;
    }
    PG8_WAIT_V(0);
    PG8_BAR;
    if (cur.tinfo >= 0) tail_fixup(acc, cur, E, T, tid, wr, wc, fr, fq);
#undef PG8_SA
#undef PG8_SB
#undef PG8_STAGE
#undef PG8_LDA
#undef PG8_LDB
#undef PG8_MMA
#undef PG8_WAIT_V
#undef PG8_WAIT_L
#undef PG8_BAR
#undef PG8_SCHED
}

struct MUnit { int kind, pm, pn, kb, nk, tinfo; };
struct MOrder {
    int c;
    __device__ __forceinline__ bool next(int i, MUnit& u) const {
        const int j = i * 256 + c;
        u.kb = 0; u.tinfo = -1;
        if (j < 288) { u.kind = 0; u.nk = D / BK;
            if (j < 256) { const int x = j & 7, r = j >> 3; u.pm = 4 * x + (r >> 3); u.pn = r & 7; } else { const int t = j - 256; u.pm = 32 + (t >> 3); u.pn = t & 7; }
            return true; }
        if (j < 1872) { u.kind = 1; u.nk = D / BK; const int L = j - 288;
            if (L < 1408) { const int x = L & 7, off = L >> 3, wg = x * 176 + off, gid = wg / 352, rem = wg % 352; u.pm = gid * 8 + (rem & 7); u.pn = rem >> 3; }
            else { const int t = L - 1408; u.pm = 32 + (t & 3); u.pn = t >> 2; }
            return true; }
        if (j < 2128) { u.kind = 2; u.nk = DFF / BK; const int L = j - 1872, x = L & 7, r = L >> 3; u.pm = 4 * x + (r >> 3); u.pn = r & 7; return true; }
        const int ilast = (c < 80) ? 9 : 8;
        if (i != ilast || c < 80 || c >= 208) return false;
        const int mi = c - 80, tj = mi >> 2, slice = mi & 3;
        u.kind = 2; u.pm = 32 + (tj >> 3); u.pn = tj & 7; u.kb = slice * 22; u.nk = 22; u.tinfo = (tj << 8) | (slice << 4) | 4; return true;
    }
};

struct StreamOff { size_t A0, B0, A1, B1, A2, B2, x2b, slab; int dep3, dep4, tail, rsq2, rsq3; };
template <class SO>
__device__ __forceinline__ void gemm_stream(PG8_LAS unsigned char* lds, const MOrder& S, unsigned char* ws, const float* xp, const float* xs, const SO O) {
    int tid_ = threadIdx.x; asm volatile("" : "+v"(tid_));
    const int tid = tid_, wid = __builtin_amdgcn_readfirstlane(tid >> 6), lane = tid & 63, wr = wid >> 2, wc = wid & 3, fr = lane & 15, fq = lane >> 4;
    int Ra[2], Rb[2], Cb[2];
#pragma unroll
    for (int i = 0; i < 2; ++i) { int R, C; stage_rc(tid * 16 + i * 8192, R, C); Ra[i] = R; Rb[i] = (R & ~31) + perm32(R & 31); Cb[i] = C * 2; }
    const size_t kstep = (size_t)(BK * 2);
    const unsigned ldsw = (unsigned)wid * 1024u;
    const int aoff = lds_byte(wr * 64 + fr, fq * 8), boff = lds_byte(wc * 32 + fr, fq * 8);
#define PG8_SA(b, h) (((b) * 2 + (h)) * HTB)
#define PG8_SB(b, h) ((4 + (b) * 2 + (h)) * HTB)
#define PG8_STG(bufoff, gbase, Rr, rowb) do { _Pragma("unroll") for (int _i = 0; _i < 2; ++_i) \
        __builtin_amdgcn_global_load_lds((const unsigned*)((const char*)(gbase) + (unsigned)((Rr)[_i] * (rowb) + Cb[_i])), (PG8_LAS unsigned*)(lds + (bufoff) + ldsw + _i * 8192), 16, 0, 0); } while (0)
#define PG8_LDA(dst, b, h) do { _Pragma("unroll") for (int m = 0; m < 4; ++m) _Pragma("unroll") for (int k = 0; k < 2; ++k) dst[m][k] = *(const PG8_LAS bf16x8*)(lds + PG8_SA(b, h) + aoff + m * 2048 + k * 1024); } while (0)
#define PG8_LDB(dst, b, h) do { _Pragma("unroll") for (int n = 0; n < 2; ++n) _Pragma("unroll") for (int k = 0; k < 2; ++k) dst[n][k] = *(const PG8_LAS bf16x8*)(lds + PG8_SB(b, h) + boff + n * 2048 + k * 1024); } while (0)
#define PG8_MMA(ai, bj, At, Bt) do { __builtin_amdgcn_s_setprio(1); _Pragma("unroll") for (int m = 0; m < 4; ++m) _Pragma("unroll") for (int n = 0; n < 2; ++n) _Pragma("unroll") for (int k = 0; k < 2; ++k) \
        acc[ai][bj][m][n] = __builtin_amdgcn_mfma_f32_16x16x32_bf16(Bt[n][k], At[m][k], acc[ai][bj][m][n], 0, 0, 0); __builtin_amdgcn_s_setprio(0); } while (0)
#define PG8_WAIT_V(n) asm volatile("s_waitcnt vmcnt(" #n ")" ::: "memory")
#define PG8_WAIT_L(n) asm volatile("s_waitcnt lgkmcnt(" #n ")" ::: "memory")
#define PG8_BAR __builtin_amdgcn_s_barrier()
#define PG8_SCHED __builtin_amdgcn_sched_barrier(0)
#define MU_A(u) ((const char*)ws + ((u).kind == 0 ? O.A0 : (u).kind == 1 ? O.A1 : O.A2) + (size_t)(u).pm * 256 * MU_RB(u) + (size_t)(u).kb * kstep)
#define MU_B(u) ((const char*)ws + ((u).kind == 0 ? O.B0 : (u).kind == 1 ? O.B1 : O.B2) + (size_t)(u).pn * 256 * MU_RB(u) + (size_t)(u).kb * kstep)
#define MU_RB(u) ((u).kind == 2 ? DFF * 2 : D * 2)
    unsigned long long rdy3 = 0ull, rdy4 = 0ull;
#define MU_READY(u) do { if ((u).kind != 0) { unsigned long long& _m = (u).kind == 1 ? rdy3 : rdy4; if (!((_m >> (u).pm) & 1ull)) { \
        if (wid == 0) { unsigned* _c = (unsigned*)ws + ((u).kind == 1 ? O.dep3 : O.dep4) + 64 * (u).pm; const unsigned _t = (u).kind == 1 ? 64u : 352u; unsigned _sp = 0; \
            while (__hip_atomic_load(_c, __ATOMIC_RELAXED, __HIP_MEMORY_SCOPE_AGENT) < _t && ++_sp < (1u << 22)) __builtin_amdgcn_s_sleep(2); \
            __builtin_amdgcn_fence(__ATOMIC_ACQUIRE, "agent"); asm volatile("s_waitcnt vmcnt(0)" ::: "memory"); } \
        asm volatile("" ::: "memory"); PG8_BAR; asm volatile("" ::: "memory"); _m |= 1ull << (u).pm; } } } while (0)
    PG8_LAS unsigned* vflag = (PG8_LAS unsigned*)(lds + 147456 - 256 + 64);
#define MU_TRY(u, ok) do { ok = true; if ((u).kind != 0) { unsigned long long& _m = (u).kind == 1 ? rdy3 : rdy4; if (!((_m >> (u).pm) & 1ull)) { \
        if (wid == 0) { unsigned* _c = (unsigned*)ws + ((u).kind == 1 ? O.dep3 : O.dep4) + 64 * (u).pm; const unsigned _t = (u).kind == 1 ? 64u : 352u; \
            const bool _r = __hip_atomic_load(_c, __ATOMIC_RELAXED, __HIP_MEMORY_SCOPE_AGENT) >= _t; \
            if (_r) { __builtin_amdgcn_fence(__ATOMIC_ACQUIRE, "agent"); asm volatile("s_waitcnt vmcnt(0)" ::: "memory"); } \
            if (lane == 0) *vflag = _r ? 1u : 0u; asm volatile("s_waitcnt lgkmcnt(0)" ::: "memory"); } \
        asm volatile("" ::: "memory"); PG8_BAR; asm volatile("" ::: "memory"); \
        ok = (*(volatile PG8_LAS unsigned*)vflag) != 0u; if (ok) _m |= 1ull << (u).pm; } } } while (0)
    MUnit cur, nxt; int ui = 0;
    if (!S.next(0, cur)) return;
    f32x4 acc[2][2][4][2];
#pragma unroll
    for (int a = 0; a < 2; ++a)
#pragma unroll
        for (int b = 0; b < 2; ++b)
#pragma unroll
            for (int m = 0; m < 4; ++m)
#pragma unroll
                for (int n = 0; n < 2; ++n) acc[a][b][m][n] = (f32x4){0.f, 0.f, 0.f, 0.f};
    bf16x8 At[4][2], B0[2][2], B1[2][2];
    bool more = true;
    while (more) {
    MU_READY(cur);
    const char* cA = MU_A(cur); const char* cB = MU_B(cur); int crb = MU_RB(cur);
    PG8_STG(PG8_SB(0, 0), cB, Rb, crb); PG8_STG(PG8_SB(0, 1), cB + (size_t)HALF * crb, Rb, crb); PG8_STG(PG8_SA(0, 0), cA, Ra, crb); PG8_STG(PG8_SA(0, 1), cA + (size_t)HALF * crb, Ra, crb);
    if (wr == 1) PG8_BAR;
    PG8_WAIT_V(2); PG8_BAR;
    PG8_STG(PG8_SB(1, 0), cB + kstep, Rb, crb); PG8_STG(PG8_SA(1, 0), cA + kstep, Ra, crb); PG8_STG(PG8_SB(1, 1), cB + (size_t)HALF * crb + kstep, Rb, crb);
    PG8_WAIT_V(6); PG8_BAR;
    for (;;) {
        const bool has_next = S.next(ui + 1, nxt);
        bool chain = has_next;
        const char* nA = cA; const char* nB = cB; int nrb = crb;
        const int nt = cur.nk;
        for (int t = 0; t < nt; t += 2) {
            const bool last = (t == nt - 2);
            if (last && has_next) { MU_TRY(nxt, chain); if (chain) { nA = MU_A(nxt); nB = MU_B(nxt); nrb = MU_RB(nxt); } }
            const char* a1 = cA + (size_t)(t + 1) * kstep;
            const char* a2 = last ? nA : cA + (size_t)(t + 2) * kstep; const char* b2 = last ? nB : cB + (size_t)(t + 2) * kstep; const int rb2 = last ? nrb : crb;
            const char* a3 = a2 + kstep; const char* b3 = b2 + kstep;
            const size_t h1 = (size_t)HALF * crb, h2 = (size_t)HALF * rb2;
            PG8_LDB(B0, 0, 0); PG8_LDB(B1, 0, 1); PG8_SCHED; PG8_LDA(At, 0, 0); PG8_STG(PG8_SA(1, 1), a1 + h1, Ra, crb);
            PG8_WAIT_V(8); PG8_WAIT_L(0); PG8_BAR; PG8_MMA(0, 0, At, B0); PG8_MMA(0, 1, At, B1); PG8_BAR; PG8_SCHED;
            PG8_LDA(At, 0, 1); PG8_STG(PG8_SB(0, 0), b2, Rb, rb2); PG8_STG(PG8_SB(0, 1), b2 + h2, Rb, rb2); PG8_STG(PG8_SA(0, 0), a2, Ra, rb2);
            PG8_WAIT_V(8); PG8_WAIT_L(0); PG8_BAR; PG8_MMA(1, 0, At, B0); PG8_MMA(1, 1, At, B1); PG8_BAR; PG8_SCHED;
            PG8_LDB(B0, 1, 0); PG8_LDB(B1, 1, 1); PG8_SCHED; PG8_LDA(At, 1, 0); PG8_STG(PG8_SA(0, 1), a2 + h2, Ra, rb2);
            PG8_WAIT_V(8); PG8_WAIT_L(0); PG8_BAR; PG8_MMA(0, 0, At, B0); PG8_MMA(0, 1, At, B1); PG8_BAR; PG8_SCHED;
            PG8_LDA(At, 1, 1); PG8_STG(PG8_SB(1, 0), b3, Rb, rb2); PG8_STG(PG8_SB(1, 1), b3 + h2, Rb, rb2); PG8_STG(PG8_SA(1, 0), a3, Ra, rb2);
            PG8_WAIT_V(8); PG8_WAIT_L(0); PG8_BAR; PG8_MMA(1, 0, At, B0); PG8_MMA(1, 1, At, B1); PG8_BAR; PG8_SCHED;
        }
        if (wr == 0) PG8_BAR;
        if (cur.tinfo < 0) {
            const Unit u{cur.pm, cur.pn, 0, 0, -1};
            if (cur.kind == 0) { const EpiX1<false> E0{xp, xs, nullptr, (bf16_t*)(ws + O.A1), (float*)ws + O.rsq2, true}; E0(acc, u, wr, wc, fr, fq); }
            else if (cur.kind == 1) { const EpiAct E1{(bf16_t*)(ws + O.A2), (const float*)ws + O.rsq2, true}; E1(acc, u, wr, wc, fr, fq); }
            else { const EpiX2<false> E2{(bf16_t*)(ws + O.x2b), (float*)ws + O.rsq3, (const bf16_t*)(ws + O.A1)}; E2(acc, u, wr, wc, fr, fq); }
            if (cur.kind != 2) {
                asm volatile("s_waitcnt vmcnt(0)" ::: "memory");
                if (lane == 0) __hip_atomic_fetch_add((unsigned*)ws + (cur.kind == 0 ? O.dep3 : O.dep4) + 64 * cur.pm, 1u, __ATOMIC_RELAXED, __HIP_MEMORY_SCOPE_AGENT);
            }
        }
        if (!has_next) { more = false; break; }
        if (!chain) {
            PG8_WAIT_V(0); PG8_BAR;
#pragma unroll
            for (int a = 0; a < 2; ++a)
#pragma unroll
                for (int b = 0; b < 2; ++b)
#pragma unroll
                    for (int m = 0; m < 4; ++m)
#pragma unroll
                        for (int n = 0; n < 2; ++n) acc[a][b][m][n] = (f32x4){0.f, 0.f, 0.f, 0.f};
            cur = nxt; ++ui;
            break;
        }
#pragma unroll
        for (int a = 0; a < 2; ++a)
#pragma unroll
            for (int b = 0; b < 2; ++b)
#pragma unroll
                for (int m = 0; m < 4; ++m)
#pragma unroll
                    for (int n = 0; n < 2; ++n) acc[a][b][m][n] = (f32x4){0.f, 0.f, 0.f, 0.f};
        cur = nxt; cA = nA; cB = nB; crb = nrb; ++ui;
        if (wr == 1) PG8_BAR;
    }
    }
    PG8_WAIT_V(0);
    PG8_BAR;
    if (cur.tinfo >= 0) { const Unit u{cur.pm, cur.pn, cur.kb, cur.nk, cur.tinfo}; const EpiX2<false> E2{(bf16_t*)(ws + O.x2b), (float*)ws + O.rsq3, (const bf16_t*)(ws + O.A1)};
        const TailCtx T{(f32x4*)(ws + O.slab), (unsigned*)ws + O.tail}; tail_fixup(acc, u, E2, T, tid, wr, wc, fr, fq); }
#undef MU_TRY
#undef MU_A
#undef MU_B
#undef MU_RB
#undef MU_READY
#undef PG8_SA
#undef PG8_SB
#undef PG8_STG
#undef PG8_LDA
#undef PG8_LDB
#undef PG8_MMA
#undef PG8_WAIT_V
#undef PG8_WAIT_L
#undef PG8_BAR
#undef PG8_SCHED
}
}
#define LAS __attribute__((address_space(3)))
typedef unsigned short bf16;
using pg8::f32x4; using pg8::u32x4; using pg8::u32x2; using pg8::bf16x8; using pg8::cvt_pk_bf16;

#ifndef ONE_LAUNCH
#define ONE_LAUNCH 1
#endif
constexpr int NWAVES = 8, NPHASE = 7;
constexpr int LDS_BYTES = 147456;
constexpr size_t MiB = 1u << 20;
constexpr size_t WS_CTL = 0, CTL_ZERO_BYTES = 1 * MiB;
constexpr size_t WS_WIN = 1 * MiB;
constexpr size_t WS_WO = 21 * MiB;
constexpr size_t WS_WGU = 29 * MiB;
constexpr size_t WS_WD = 73 * MiB;
constexpr size_t WS_WP = 95 * MiB;
constexpr size_t WS_MISC = 96 * MiB;
constexpr size_t WS_XB = 97 * MiB;
constexpr size_t WS_ZB = 133 * MiB;
constexpr size_t WS_LF = 223 * MiB;
constexpr size_t WS_ACT = WS_ZB;
constexpr size_t WS_MIX = 259 * MiB;
constexpr size_t WS_X2B = WS_WGU;
constexpr size_t WS_END = 328 * MiB;
constexpr int CW_RSQ2 = 4096, CW_RSQ3 = 4096 + M;
constexpr int CW_TAIL = 100000;
constexpr size_t WS_SLAB3 = WS_ACT, WS_SLAB45 = 232 * MiB;
constexpr int CW_DEP = 124000;
constexpr size_t WS_SLABM = 296 * MiB;
#ifndef MERGED
#define MERGED 1
#endif
constexpr int CW_BAR = 65536;
constexpr int MISC_OFF = 147456 - 256;
#ifndef USE_CG
#define USE_CG 0
#endif

__device__ __forceinline__ float wave_sum(float v) {
#pragma unroll
    for (int o = 1; o < 64; o <<= 1) v += __shfl_xor(v, o);
    return v;
}
__device__ __forceinline__ float bflo(unsigned w) { return __builtin_bit_cast(float, w << 16); }
__device__ __forceinline__ float bfhi(unsigned w) { return __builtin_bit_cast(float, w & 0xffff0000u); }
__device__ __forceinline__ float bf2f(bf16 b) { return __builtin_bit_cast(float, (unsigned)b << 16); }
__device__ __forceinline__ bf16 f2bf(float f) { unsigned u = __builtin_bit_cast(unsigned, f); return (bf16)((u + 0x7fffu + ((u >> 16) & 1u)) >> 16); }

#define XB_TMO      128
#define XB_XCNT(j)  (256  + 64 * (j))
#define XB_XSUB(j)  (1280 + 64 * (j))
#define XB_XGEN(j)  (2304 + 64 * (j))
#define XB_TOP      3328
#define XB_TOPGEN   3392
#define XCD_BAR_WORDS 3456
#define XB_SPIN_CAP (1u << 18)

__device__ __forceinline__ unsigned xb_ld(unsigned* p)              { return __hip_atomic_load(p, __ATOMIC_RELAXED, __HIP_MEMORY_SCOPE_AGENT); }
__device__ __forceinline__ unsigned xb_add(unsigned* p, unsigned v) { return __hip_atomic_fetch_add(p, v, __ATOMIC_RELAXED, __HIP_MEMORY_SCOPE_AGENT); }
__device__ __forceinline__ unsigned xb_xcc_id() { return (unsigned)__builtin_amdgcn_s_getreg((3 << 11) | 20) & 0xFu; }
#define XB_SPIN(cond, bar) do { unsigned _sp = 0; while (cond) { __builtin_amdgcn_s_sleep(1); \
    if ((++_sp & 255u) == 0u) { if (xb_ld(&(bar)[XB_TMO])) break; if (_sp > XB_SPIN_CAP) { atomicAdd(&(bar)[XB_TMO], 1u); break; } } } } while (0)

struct XcdBarrier {
    unsigned* bar; unsigned x;
    volatile LAS unsigned* st;
};

__device__ __forceinline__ XcdBarrier xcd_barrier_post(unsigned* bar, volatile LAS unsigned* st) {
    XcdBarrier b; b.bar = bar; b.x = xb_xcc_id(); b.st = st;
    if (threadIdx.x == 0) (void)xb_add(&bar[XB_XCNT(b.x)], 1u);
    return b;
}
__device__ __forceinline__ void xcd_barrier_complete(unsigned* bar, unsigned x, unsigned& nloc, unsigned& nx) {
    const unsigned G = gridDim.x * gridDim.y * gridDim.z;
    unsigned sum, cnt, mine, sp = 0u;
    for (;;) {
        sum = 0u; cnt = 0u; mine = 0u;
#pragma unroll
        for (unsigned j = 0; j < 16; ++j) { const unsigned c = xb_ld(&bar[XB_XCNT(j)]); sum += c; cnt += (c > 0u) ? 1u : 0u; mine = (j == x) ? c : mine; }
        if (sum == G) break;
        __builtin_amdgcn_s_sleep(1);
        if ((++sp & 255u) == 0u) { if (xb_ld(&bar[XB_TMO])) break; if (sp > XB_SPIN_CAP) { atomicAdd(&bar[XB_TMO], 1u); break; } }
    }
    nloc = mine > 0u ? mine : 1u; nx = cnt > 0u ? cnt : 1u;
}

__device__ __forceinline__ void xcd_barrier(const XcdBarrier& b) {
    asm volatile("s_waitcnt vmcnt(0)" ::: "memory");
    __syncthreads();
    if (threadIdx.x == 0) {
        unsigned* bar = b.bar;
        __builtin_amdgcn_s_waitcnt(0);
        unsigned nloc = b.st[0], nx = b.st[1];
        if (nloc == 0u) { xcd_barrier_complete(bar, b.x, nloc, nx); b.st[0] = nloc; b.st[1] = nx; }
        const unsigned old = xb_add(&bar[XB_XSUB(b.x)], 1u);
        const unsigned gen = old / nloc;
        if (old + 1u == (gen + 1u) * nloc) {
            __builtin_amdgcn_fence(__ATOMIC_RELEASE, "agent");
            asm volatile("s_waitcnt vmcnt(0)" ::: "memory");
            const unsigned og = xb_add(&bar[XB_TOP], 1u);
            const unsigned tg = og / nx;
            if (og + 1u == (tg + 1u) * nx) xb_add(&bar[XB_TOPGEN], 1u);
            else XB_SPIN(xb_ld(&bar[XB_TOPGEN]) == tg, bar);
            __builtin_amdgcn_fence(__ATOMIC_ACQUIRE, "agent");
            xb_add(&bar[XB_XGEN(b.x)], 1u);
            asm volatile("s_waitcnt vmcnt(0)" ::: "memory");
        } else {
            XB_SPIN(xb_ld(&bar[XB_XGEN(b.x)]) == gen, bar);
            __builtin_amdgcn_fence(__ATOMIC_ACQUIRE, "agent");
            asm volatile("s_waitcnt vmcnt(0)" ::: "memory");
        }
    }
    __syncthreads();
}


#ifdef TPROBE
#define STAMP(i) do { if (threadIdx.x == 0) ((volatile LAS unsigned long long*)(lds + MISC_OFF + 128))[i] = __builtin_amdgcn_s_memrealtime(); } while (0)
#else
#define STAMP(i) do {} while (0)
#endif
constexpr int CW_TP = 120000;

struct Args { const float* in[16]; float* out; unsigned char* ws; int ph_lo, ph_hi; };

__device__ __forceinline__ void p0_item(const float* W, int K, int N, bf16* WT, int mode, const float* sk, const float* sn, LAS float* scr, int item, int lane) {
    const int nblk = N / 64, kb = item / nblk, nb = item % nblk, k0 = 64 * kb, n0 = 64 * nb;
    const int drow0 = mode == 0 ? n0 : ((n0 >> 7) * 256 + (n0 & 127) + (mode == 2 ? 128 : 0));
    const int r = lane >> 4, c4 = lane & 15;
    f32x4 v[16];
#pragma unroll
    for (int i = 0; i < 16; ++i) v[i] = *(const f32x4*)(W + (size_t)(k0 + 4 * i + r) * N + n0 + 4 * c4);
    if (sk) {
#pragma unroll
        for (int i = 0; i < 16; ++i) v[i] = v[i] * sk[k0 + 4 * i + r];
    }
#pragma unroll
    for (int i = 0; i < 16; ++i) { LAS float* d = scr + (4 * i + r) * 65 + 4 * c4; d[0] = v[i][0]; d[1] = v[i][1]; d[2] = v[i][2]; d[3] = v[i][3]; }
    asm volatile("s_waitcnt lgkmcnt(0)" ::: "memory");
    const int c = lane & 7, nn = lane >> 3;
#pragma unroll
    for (int j = 0; j < 8; ++j) { const int n = nn + 8 * j; const LAS float* s = scr + (8 * c) * 65 + n; const float f = sn ? sn[n0 + n] : 1.f;
        u32x4 o; o.x = cvt_pk_bf16(s[0 * 65] * f, s[1 * 65] * f); o.y = cvt_pk_bf16(s[2 * 65] * f, s[3 * 65] * f); o.z = cvt_pk_bf16(s[4 * 65] * f, s[5 * 65] * f); o.w = cvt_pk_bf16(s[6 * 65] * f, s[7 * 65] * f);
        *(u32x4*)(WT + (size_t)(drow0 + n) * K + k0 + 8 * c) = o; }
    asm volatile("s_waitcnt lgkmcnt(0)" ::: "memory");
}

__device__ __forceinline__ void phase0(LAS unsigned char* lds, const Args& a, int vcu, int G) {
    const int tid = threadIdx.x, lane = tid & 63, wave = tid >> 6;
    unsigned char* ws = a.ws;
    LAS float* scr = (LAS float*)(lds + wave * 16640);
    const int gw = vcu * NWAVES + wave, NGW = G * NWAVES;
    constexpr int I_IN = (D / 64) * (INC / 64), I_O = (D / 64) * (D / 64), I_G = (D / 64) * (DFF / 64), I_D = (DFF / 64) * (D / 64), I_P = (256 / 64) * (256 / 64);
    constexpr int NITEMS = I_IN + I_O + 2 * I_G + I_D + 4 * I_P;
    for (int it = gw; it < NITEMS; it += NGW) {
        int r = it;
        if (r < I_IN) { p0_item(a.in[6], D, INC, (bf16*)(ws + WS_WIN), 0, a.in[5], nullptr, scr, r, lane); continue; } r -= I_IN;
        if (r < I_O) { p0_item(a.in[10], D, D, (bf16*)(ws + WS_WO), 0, nullptr, nullptr, scr, r, lane); continue; } r -= I_O;
        if (r < I_G) { p0_item(a.in[12], D, DFF, (bf16*)(ws + WS_WGU), 1, a.in[11], nullptr, scr, r, lane); continue; } r -= I_G;
        if (r < I_G) { p0_item(a.in[13], D, DFF, (bf16*)(ws + WS_WGU), 2, a.in[11], nullptr, scr, r, lane); continue; } r -= I_G;
        if (r < I_D) { p0_item(a.in[14], DFF, D, (bf16*)(ws + WS_WD), 0, nullptr, nullptr, scr, r, lane); continue; } r -= I_D;
        { const int g = r / I_P; p0_item(a.in[7] + (size_t)g * 65536, 256, 256, (bf16*)(ws + WS_WP) + (size_t)g * 65536, 0, nullptr, a.in[8] + g * 256, scr, r % I_P, lane); }
    }
    float* rstd1 = (float*)(ws + WS_MISC); bf16* xb = (bf16*)(ws + WS_XB);
    for (int m = gw; m < M; m += NGW) {
        const float* xrow = m < MP ? a.in[0] + (size_t)m * D : a.in[1] + (size_t)(m - MP) * D;
        f32x4 v[8]; float s = 0.f;
#pragma unroll
        for (int j = 0; j < 8; ++j) { v[j] = ((const f32x4*)xrow)[lane + 64 * j]; s += (v[j][0] * v[j][0] + v[j][1] * v[j][1]) + (v[j][2] * v[j][2] + v[j][3] * v[j][3]); }
        s = wave_sum(s);
        if (lane == 0) rstd1[m] = rsqrtf(s * (1.f / D) + EPS);
#pragma unroll
        for (int j = 0; j < 8; ++j) { u32x2 w; w.x = cvt_pk_bf16(v[j][0], v[j][1]); w.y = cvt_pk_bf16(v[j][2], v[j][3]); ((u32x2*)(xb + (size_t)m * D))[lane + 64 * j] = w; }
    }
    const int gt = vcu * (NWAVES * 64) + tid, NGT = G * NWAVES * 64;
    float* lbv = (float*)(ws + WS_MISC) + M;
    for (int c = gt; c < HW; c += NGT) lbv[c] = 1.f / (1.f + __expf(a.in[4][HW + c] - a.in[4][c]));
    for (int i = gt; i < DB * 7 * PW; i += NGT) { const int b = i / (7 * PW), rem = i % (7 * PW); a.out[O_PSS + (size_t)b * PC * PW + rem] = a.in[2][(size_t)b * PC * PW + 8 * PW + rem]; }
}

template <int W, bool SAMPLE>
__device__ __forceinline__ void pool_fill(LAS bf16* A, int m0, int g, const bf16* zb, const float* cache) {
    const int tid = threadIdx.x, c8 = tid & 31, rq = tid >> 5;
    constexpr int LDA = 264;
    const int col = g * 256 + 8 * c8;
    u32x4 ur[19];
    int tb;
    if (!SAMPLE) {
        const int mb = m0 + 4 * rq - 15; tb = (m0 & (SEQ - 1)) + 4 * rq - 15;
#pragma unroll
        for (int e = 0; e < 19; ++e) ur[e] = (tb + e >= 0) ? *(const u32x4*)(zb + (size_t)(mb + e) * INC + col) : (u32x4){0u, 0u, 0u, 0u};
    } else {
        const int r0 = 4 * rq, m = m0 + r0, b = (m - MP) >> 3, t0 = r0 & 7; tb = t0 - 15;
#pragma unroll
        for (int e = 0; e < 19; ++e) {
            const int tau = tb + e;
            if (tau >= 0) ur[e] = *(const u32x4*)(zb + (size_t)(m - t0 + tau) * INC + col);
            else { const float* cr = cache + ((size_t)b * PC + (PC + tau)) * PW + col; const f32x4 c0 = *(const f32x4*)cr, c1 = *(const f32x4*)(cr + 4);
                   ur[e] = (u32x4){cvt_pk_bf16(c0[0], c0[1]), cvt_pk_bf16(c0[2], c0[3]), cvt_pk_bf16(c1[0], c1[1]), cvt_pk_bf16(c1[2], c1[3])}; }
        }
    }
    float out[4][8];
#pragma unroll
    for (int cp = 0; cp < 4; ++cp)
#pragma unroll
        for (int hf = 0; hf < 2; ++hf) {
#define PVAL(e) (hf ? bfhi(ur[e][cp]) : bflo(ur[e][cp]))
            float sw = 0.f;
#pragma unroll
            for (int j = 1; j < W; ++j) sw += PVAL(15 - j);
#pragma unroll
            for (int r = 0; r < 4; ++r) {
                const float um = PVAL(15 + r);
                sw += um;
                const float cnt = SAMPLE ? (float)W : (float)min(tb + 15 + r + 1, W);
                out[r][2 * cp + hf] = sw / cnt - um;
                sw -= PVAL(15 + r - (W - 1));
            }
#undef PVAL
        }
#pragma unroll
    for (int r = 0; r < 4; ++r) {
        u32x4 w; w.x = cvt_pk_bf16(out[r][0], out[r][1]); w.y = cvt_pk_bf16(out[r][2], out[r][3]); w.z = cvt_pk_bf16(out[r][4], out[r][5]); w.w = cvt_pk_bf16(out[r][6], out[r][7]);
        *(LAS u32x4*)(A + (4 * rq + r) * LDA + 8 * c8) = w;
    }
}
__device__ __forceinline__ void pool_item(LAS unsigned char* lds, int item, const bf16* zb, const float* cache, const bf16* WpT, bf16* mixb) {
    const int tile = item >> 2, g = item & 3, m0 = tile * 64;
    const int tid = threadIdx.x;
    constexpr int LDA = 264;
    LAS bf16* A = (LAS bf16*)lds;
    const int wave = tid >> 6, lane = tid & 63, fr = lane & 15, fq = lane >> 4, n0 = wave * 32;
    if (m0 < MP) { if (g == 0) pool_fill<2, false>(A, m0, g, zb, cache); else if (g == 1) pool_fill<4, false>(A, m0, g, zb, cache); else if (g == 2) pool_fill<8, false>(A, m0, g, zb, cache); else pool_fill<16, false>(A, m0, g, zb, cache); }
    else { if (g == 0) pool_fill<2, true>(A, m0, g, zb, cache); else if (g == 1) pool_fill<4, true>(A, m0, g, zb, cache); else if (g == 2) pool_fill<8, true>(A, m0, g, zb, cache); else pool_fill<16, true>(A, m0, g, zb, cache); }
    __syncthreads();
    f32x4 acc[4][2];
#pragma unroll
    for (int i = 0; i < 4; ++i)
#pragma unroll
        for (int j = 0; j < 2; ++j) acc[i][j] = (f32x4){0.f, 0.f, 0.f, 0.f};
#pragma unroll 2
    for (int ks = 0; ks < 8; ++ks) {
        bf16x8 wf[2], af[4];
#pragma unroll
        for (int nt = 0; nt < 2; ++nt) wf[nt] = *(const bf16x8*)(WpT + (size_t)(g * 256 + n0 + nt * 16 + fr) * 256 + ks * 32 + fq * 8);
#pragma unroll
        for (int mt = 0; mt < 4; ++mt) af[mt] = *(const LAS bf16x8*)(A + (mt * 16 + fr) * LDA + ks * 32 + fq * 8);
#pragma unroll
        for (int mt = 0; mt < 4; ++mt)
#pragma unroll
            for (int nt = 0; nt < 2; ++nt) acc[mt][nt] = __builtin_amdgcn_mfma_f32_16x16x32_bf16(wf[nt], af[mt], acc[mt][nt], 0, 0, 0);
    }
#pragma unroll
    for (int mt = 0; mt < 4; ++mt)
#pragma unroll
        for (int nt = 0; nt < 2; ++nt) {
            u32x2 o; o.x = cvt_pk_bf16(acc[mt][nt][0], acc[mt][nt][1]); o.y = cvt_pk_bf16(acc[mt][nt][2], acc[mt][nt][3]);
            *(u32x2*)(mixb + (size_t)(m0 + mt * 16 + fr) * D + g * 256 + n0 + nt * 16 + 4 * fq) = o;
        }
    __syncthreads();
}

struct SampleRegs { f32x4 S[8]; };
__device__ __forceinline__ void sample_load(SampleRegs& R, const float* S0) {
    const int tid = threadIdx.x, v4 = tid & 31, kq = tid >> 5;
#pragma unroll
    for (int kk = 0; kk < 8; ++kk) R.S[kk] = *(const f32x4*)(S0 + (size_t)(kq * 8 + kk) * HD + 4 * v4);
}
struct SampleStage { float lfv[2]; bf16 q[2], v[2]; };
__device__ __forceinline__ void sample_stage(SampleStage& st, const bf16* zb, const float* lf, int row0, int h) {
    const int tid = threadIdx.x;
#pragma unroll
    for (int j = 0; j < 2; ++j) {
        const int i = tid + 512 * j, t = i >> 7, ch = i & 127; const size_t row = (size_t)(row0 + t);
        st.lfv[j] = lf[row * HW + h * HD + ch]; st.q[j] = zb[row * INC + PW + h * HD + ch]; st.v[j] = zb[row * INC + PW + 2 * HW + h * HD + ch];
    }
}
__device__ __forceinline__ void sample_run(LAS unsigned char* lds, SampleRegs& R, const SampleStage& st, const bf16* zb, const float* hgn, float* Sout, bf16* mixb, int row0, int h) {
    const int tid = threadIdx.x, v4 = tid & 31, kq = tid >> 5, wave = tid >> 6, lane = tid & 63;
    LAS float* sq = (LAS float*)lds; LAS float* sf = sq + 1024; LAS float* sk = sf + 1024; LAS float* sv = sk + 1024; LAS float* red = sv + 1024;
#pragma unroll
    for (int j = 0; j < 2; ++j) {
        const int i = tid + 512 * j;
        const float f = __builtin_amdgcn_exp2f(st.lfv[j]);
        sq[i] = bf2f(st.q[j]); sf[i] = f; sk[i] = 1.f - f; sv[i] = bf2f(st.v[j]);
    }
    __syncthreads();
#pragma unroll 1
    for (int t = 0; t < 8; ++t) {
        const f32x4 vt = *(const LAS f32x4*)(sv + t * 128 + 4 * v4);
        f32x4 o = (f32x4){0.f, 0.f, 0.f, 0.f};
        const f32x4 f0 = *(const LAS f32x4*)(sf + t * 128 + kq * 8), f1 = *(const LAS f32x4*)(sf + t * 128 + kq * 8 + 4);
        const f32x4 k0 = *(const LAS f32x4*)(sk + t * 128 + kq * 8), k1 = *(const LAS f32x4*)(sk + t * 128 + kq * 8 + 4);
        const f32x4 q0 = *(const LAS f32x4*)(sq + t * 128 + kq * 8), q1 = *(const LAS f32x4*)(sq + t * 128 + kq * 8 + 4);
#pragma unroll
        for (int kk = 0; kk < 8; ++kk) {
            const float f = kk < 4 ? f0[kk & 3] : f1[kk & 3], kn = kk < 4 ? k0[kk & 3] : k1[kk & 3], q = kk < 4 ? q0[kk & 3] : q1[kk & 3];
            R.S[kk] = R.S[kk] * f + vt * kn;
            o = o + R.S[kk] * q;
        }
#pragma unroll
        for (int j = 0; j < 4; ++j) o[j] += __shfl_xor(o[j], 32);
        if (lane < 32) *(LAS f32x4*)(red + (wave * 8 + t) * 128 + 4 * v4) = o;
    }
#pragma unroll
    for (int kk = 0; kk < 8; ++kk) *(f32x4*)(Sout + (size_t)(kq * 8 + kk) * HD + 4 * v4) = R.S[kk];
    __syncthreads();
    {
        const int t = wave; const size_t row = (size_t)(row0 + t);
        float o0 = 0.f, o1 = 0.f;
#pragma unroll
        for (int w8 = 0; w8 < 8; ++w8) { o0 += red[(w8 * 8 + t) * 128 + lane]; o1 += red[(w8 * 8 + t) * 128 + lane + 64]; }
        const float ss = wave_sum(o0 * o0 + o1 * o1), r = rsqrtf(ss * (1.f / HD) + EPS);
        const int ch0 = h * HD + lane, ch1 = ch0 + 64;
        mixb[row * D + PW + ch0] = f2bf(o0 * r * hgn[ch0] * bf2f(zb[row * INC + PW + 3 * HW + ch0]));
        mixb[row * D + PW + ch1] = f2bf(o1 * r * hgn[ch1] * bf2f(zb[row * INC + PW + 3 * HW + ch1]));
    }
    __syncthreads();
}

constexpr int CQS = 272, CTS = 144;
constexpr int L_Q = 0, L_K = L_Q + 64 * CQS, L_KT = L_K + 64 * CQS, L_VT = L_KT + 128 * CTS, L_ST = L_VT + 128 * CTS, L_P = L_ST + 128 * CQS,
              L_DS = L_P + 64 * CTS, L_TOT = L_DS + 512, L_RMS = L_TOT + 8192, L_CHAIN_END = L_RMS + 512;
static_assert(L_CHAIN_END <= 131072, "chain LDS");
struct SegIn { f32x4 lf[4]; u32x2 kn[4], v[4], sq[4]; };
template <bool FULL>
__device__ __forceinline__ void seg_load(SegIn& I, const bf16* zb, const float* lf, int row0, int h) {
    const int tid = threadIdx.x, cg = tid & 31, tgp = tid >> 5;
#pragma unroll
    for (int j = 0; j < 4; ++j) {
        const size_t row = (size_t)(row0 + 4 * tgp + j);
        I.lf[j] = *(const f32x4*)(lf + row * HW + h * HD + 4 * cg);
        I.kn[j] = *(const u32x2*)(zb + row * INC + PW + HW + h * HD + 4 * cg);
        I.v[j] = *(const u32x2*)(zb + row * INC + PW + 2 * HW + h * HD + 4 * cg);
        if (FULL) I.sq[j] = *(const u32x2*)(zb + row * INC + PW + h * HD + 4 * cg);
    }
}
template <bool FULL>
__device__ __forceinline__ void seg_run(LAS unsigned char* lds, const bf16* zb, const float* lf, f32x4 (&Sacc)[8], f32x4& segsum, const f32x4 (&gnr)[4], bf16* mixb, int rowb, int nsteps, int h) {
    const int tid = threadIdx.x, lane = tid & 63, wave = __builtin_amdgcn_readfirstlane(tid >> 6), fr = lane & 15, fq = lane >> 4;
    const int cg = tid & 31, tgp = tid >> 5;
    LAS float* dS = (LAS float*)(lds + L_DS); LAS float* tot = (LAS float*)(lds + L_TOT); LAS float* rmsp = (LAS float*)(lds + L_RMS);
    SegIn I;
    seg_load<FULL>(I, zb, lf, rowb, h);
    *(LAS f32x4*)(tot + tgp * 128 + 4 * cg) = (I.lf[0] + I.lf[1]) + (I.lf[2] + I.lf[3]);
    if (FULL) {
#pragma unroll
        for (int kt = 0; kt < 8; ++kt) {
            u32x2 w; w.x = cvt_pk_bf16(Sacc[kt][0], Sacc[kt][1]); w.y = cvt_pk_bf16(Sacc[kt][2], Sacc[kt][3]);
            *(LAS u32x2*)(lds + L_ST + (16 * wave + fr) * CQS + (16 * kt + 4 * fq) * 2) = w;
        }
    }
    __syncthreads();
    for (int c = 0; c < nsteps; ++c) {
        {
            f32x4 b = (f32x4){0.f, 0.f, 0.f, 0.f};
#pragma unroll
            for (int g = 0; g < 15; ++g) { const f32x4 tv = *(const LAS f32x4*)(tot + g * 128 + 4 * cg); if (g < tgp) b = b + tv; }
            float kt[4][4], qt[4][4];
#pragma unroll
            for (int j = 0; j < 4; ++j) {
                b = b + I.lf[j];
                const float kn0 = bflo(I.kn[j].x), kn1 = bfhi(I.kn[j].x), kn2 = bflo(I.kn[j].y), kn3 = bfhi(I.kn[j].y);
                kt[j][0] = kn0 * __builtin_amdgcn_exp2f(-b[0]); kt[j][1] = kn1 * __builtin_amdgcn_exp2f(-b[1]); kt[j][2] = kn2 * __builtin_amdgcn_exp2f(-b[2]); kt[j][3] = kn3 * __builtin_amdgcn_exp2f(-b[3]);
                if (FULL) {
                    qt[j][0] = bflo(I.sq[j].x) * __builtin_amdgcn_exp2f(b[0]); qt[j][1] = bfhi(I.sq[j].x) * __builtin_amdgcn_exp2f(b[1]); qt[j][2] = bflo(I.sq[j].y) * __builtin_amdgcn_exp2f(b[2]); qt[j][3] = bfhi(I.sq[j].y) * __builtin_amdgcn_exp2f(b[3]);
                    const int t = 4 * tgp + j;
                    u32x2 qw, kw; qw.x = cvt_pk_bf16(qt[j][0], qt[j][1]); qw.y = cvt_pk_bf16(qt[j][2], qt[j][3]); kw.x = cvt_pk_bf16(kt[j][0], kt[j][1]); kw.y = cvt_pk_bf16(kt[j][2], kt[j][3]);
                    *(LAS u32x2*)(lds + L_Q + t * CQS + cg * 8) = qw;
                    *(LAS u32x2*)(lds + L_K + t * CQS + cg * 8) = kw;
                }
            }
#pragma unroll
            for (int ch = 0; ch < 4; ++ch) {
                u32x2 kw; kw.x = cvt_pk_bf16(kt[0][ch], kt[1][ch]); kw.y = cvt_pk_bf16(kt[2][ch], kt[3][ch]);
                *(LAS u32x2*)(lds + L_KT + (4 * cg + ch) * CTS + tgp * 8) = kw;
                const unsigned w0 = (ch < 2) ? I.v[0].x : I.v[0].y, w1 = (ch < 2) ? I.v[1].x : I.v[1].y, w2 = (ch < 2) ? I.v[2].x : I.v[2].y, w3 = (ch < 2) ? I.v[3].x : I.v[3].y;
                u32x2 vw;
                if (ch & 1) { vw.x = (w0 >> 16) | (w1 & 0xffff0000u); vw.y = (w2 >> 16) | (w3 & 0xffff0000u); }
                else { vw.x = (w0 & 0xffffu) | (w1 << 16); vw.y = (w2 & 0xffffu) | (w3 << 16); }
                *(LAS u32x2*)(lds + L_VT + (4 * cg + ch) * CTS + tgp * 8) = vw;
            }
            if (tgp == 15) {
                f32x4 e; e[0] = __builtin_amdgcn_exp2f(b[0]); e[1] = __builtin_amdgcn_exp2f(b[1]); e[2] = __builtin_amdgcn_exp2f(b[2]); e[3] = __builtin_amdgcn_exp2f(b[3]);
                *(LAS f32x4*)(dS + 4 * cg) = e; segsum = segsum + b;
            }
        }
        __syncthreads();
        u32x2 sgr[4];
        if (FULL) {
#pragma unroll
            for (int i = 0; i < 4; ++i) sgr[i] = *(const u32x2*)(zb + (size_t)(rowb + 64 * c + 16 * (wave & 3) + fr) * INC + PW + 3 * HW + h * HD + 16 * (4 * (wave >> 2) + i) + 4 * fq);
        }
        if (c + 1 < nsteps) seg_load<FULL>(I, zb, lf, rowb + 64 * (c + 1), h);
        if (FULL) {
#pragma unroll
            for (int i = 0; i < 2; ++i) {
                const int ti = 2 * wave + i, tt = ti >> 2, st = ti & 3;
                f32x4 p = (f32x4){0.f, 0.f, 0.f, 0.f};
#pragma unroll
                for (int ks = 0; ks < 4; ++ks) {
                    const bf16x8 ka = *(const LAS bf16x8*)(lds + L_K + (16 * st + fr) * CQS + (32 * ks + 8 * fq) * 2);
                    const bf16x8 qb = *(const LAS bf16x8*)(lds + L_Q + (16 * tt + fr) * CQS + (32 * ks + 8 * fq) * 2);
                    p = __builtin_amdgcn_mfma_f32_16x16x32_bf16(ka, qb, p, 0, 0, 0);
                }
                const int t = 16 * tt + fr, s0 = 16 * st + 4 * fq;
                u32x2 w; w.x = cvt_pk_bf16(s0 + 0 <= t ? p[0] : 0.f, s0 + 1 <= t ? p[1] : 0.f); w.y = cvt_pk_bf16(s0 + 2 <= t ? p[2] : 0.f, s0 + 3 <= t ? p[3] : 0.f);
                *(LAS u32x2*)(lds + L_P + t * CTS + s0 * 2) = w;
            }
        }
        {
            bf16x8 vb[2];
#pragma unroll
            for (int ss = 0; ss < 2; ++ss) vb[ss] = *(const LAS bf16x8*)(lds + L_VT + (16 * wave + fr) * CTS + (32 * ss + 8 * fq) * 2);
#pragma unroll
            for (int kt = 0; kt < 8; ++kt)
#pragma unroll
                for (int ss = 0; ss < 2; ++ss) {
                    const bf16x8 ka = *(const LAS bf16x8*)(lds + L_KT + (16 * kt + fr) * CTS + (32 * ss + 8 * fq) * 2);
                    Sacc[kt] = __builtin_amdgcn_mfma_f32_16x16x32_bf16(ka, vb[ss], Sacc[kt], 0, 0, 0);
                }
        }
        const int tt = wave & 3, vh = wave >> 2;
        f32x4 o[4];
        if (FULL) {
            __syncthreads();
            bf16x8 pb[2], qb[4];
#pragma unroll
            for (int ss = 0; ss < 2; ++ss) pb[ss] = *(const LAS bf16x8*)(lds + L_P + (16 * tt + fr) * CTS + (32 * ss + 8 * fq) * 2);
#pragma unroll
            for (int ks = 0; ks < 4; ++ks) qb[ks] = *(const LAS bf16x8*)(lds + L_Q + (16 * tt + fr) * CQS + (32 * ks + 8 * fq) * 2);
#pragma unroll
            for (int i = 0; i < 4; ++i) {
                const int vrow = 16 * (4 * vh + i) + fr;
                f32x4 a = (f32x4){0.f, 0.f, 0.f, 0.f};
#pragma unroll
                for (int ss = 0; ss < 2; ++ss) a = __builtin_amdgcn_mfma_f32_16x16x32_bf16(*(const LAS bf16x8*)(lds + L_VT + vrow * CTS + (32 * ss + 8 * fq) * 2), pb[ss], a, 0, 0, 0);
#pragma unroll
                for (int ks = 0; ks < 4; ++ks) a = __builtin_amdgcn_mfma_f32_16x16x32_bf16(*(const LAS bf16x8*)(lds + L_ST + vrow * CQS + (32 * ks + 8 * fq) * 2), qb[ks], a, 0, 0, 0);
                o[i] = a;
            }
            float ss2 = 0.f;
#pragma unroll
            for (int i = 0; i < 4; ++i) ss2 += (o[i][0] * o[i][0] + o[i][1] * o[i][1]) + (o[i][2] * o[i][2] + o[i][3] * o[i][3]);
            ss2 += __shfl_xor(ss2, 16); ss2 += __shfl_xor(ss2, 32);
            if (fq == 0) rmsp[vh * 64 + 16 * tt + fr] = ss2;
        }
#pragma unroll
        for (int kt = 0; kt < 8; ++kt) Sacc[kt] = Sacc[kt] * *(const LAS f32x4*)(dS + 16 * kt + 4 * fq);
        if (c + 1 < nsteps) *(LAS f32x4*)(tot + tgp * 128 + 4 * cg) = (I.lf[0] + I.lf[1]) + (I.lf[2] + I.lf[3]);
        __syncthreads();
        if (FULL) {
            const int tl = 16 * tt + fr; const size_t row = (size_t)(rowb + 64 * c + tl);
            const float r = rsqrtf((rmsp[tl] + rmsp[64 + tl]) * (1.f / HD) + EPS);
#pragma unroll
            for (int i = 0; i < 4; ++i) {
                const int ch = h * HD + 16 * (4 * vh + i) + 4 * fq;
                const f32x4 gn = gnr[i];
                const u32x2 sg = sgr[i];
                const float g0 = __builtin_bit_cast(float, sg.x << 16), g1 = __builtin_bit_cast(float, sg.x & 0xffff0000u), g2 = __builtin_bit_cast(float, sg.y << 16), g3 = __builtin_bit_cast(float, sg.y & 0xffff0000u);
                u32x2 w; w.x = cvt_pk_bf16(o[i][0] * r * gn[0] * g0, o[i][1] * r * gn[1] * g1); w.y = cvt_pk_bf16(o[i][2] * r * gn[2] * g2, o[i][3] * r * gn[3] * g3);
                *(u32x2*)(mixb + row * D + PW + ch) = w;
            }
#pragma unroll
            for (int kt = 0; kt < 8; ++kt) {
                u32x2 w; w.x = cvt_pk_bf16(Sacc[kt][0], Sacc[kt][1]); w.y = cvt_pk_bf16(Sacc[kt][2], Sacc[kt][3]);
                *(LAS u32x2*)(lds + L_ST + (16 * wave + fr) * CQS + (16 * kt + 4 * fq) * 2) = w;
            }
        }
    }
    __syncthreads();
}

#ifndef P2_ORDER_OLD
#define P2_ORDER_OLD 0
#endif
constexpr int CW_FLAG = 32768;
__device__ __forceinline__ void prompt_pass1(LAS unsigned char* lds, const Args& a, int chain, int seg, int nseg) {
    if (seg + 1 >= nseg) return;
    unsigned char* ws = a.ws;
    const bf16* zb = (const bf16*)(ws + WS_ZB); const float* lf = (const float*)(ws + WS_LF); bf16* mixb = (bf16*)(ws + WS_MIX);
    const int tid = threadIdx.x;
    const int b = chain / NH, h = chain % NH, seglen = SEQ / nseg, nsteps = seglen / 64, rowb = b * SEQ + seg * seglen;
    f32x4* slab = (f32x4*)(ws + WS_XB);
    float* dseg = (float*)(ws + WS_XB + 16 * MiB);
    unsigned* flags = (unsigned*)(ws + WS_CTL) + CW_FLAG;
    f32x4 gnr[4];
#pragma unroll
    for (int i = 0; i < 4; ++i) gnr[i] = (f32x4){0.f, 0.f, 0.f, 0.f};
    f32x4 Sacc[8];
#pragma unroll
    for (int i = 0; i < 8; ++i) Sacc[i] = (f32x4){0.f, 0.f, 0.f, 0.f};
    f32x4 segsum = (f32x4){0.f, 0.f, 0.f, 0.f};
    seg_run<false>(lds, zb, lf, Sacc, segsum, gnr, mixb, rowb, nsteps, h);
    const __amdgpu_buffer_rsrc_t srs = __builtin_amdgcn_make_buffer_rsrc((void*)(slab + (size_t)(chain * 8 + seg) * 4096), (short)0, 4096 * 16, 0x00020000);
#pragma unroll
    for (int kt = 0; kt < 8; ++kt) __builtin_amdgcn_raw_buffer_store_b128(__builtin_bit_cast(u32x4, Sacc[kt]), srs, (unsigned)((kt * 512 + tid) * 16), 0, 16);
    if ((tid >> 5) == 15) {
#pragma unroll
        for (int j = 0; j < 4; ++j) __hip_atomic_store((unsigned*)dseg + (chain * 8 + seg) * 128 + 4 * (tid & 31) + j, __builtin_bit_cast(unsigned, __builtin_amdgcn_exp2f(segsum[j])), __ATOMIC_RELAXED, __HIP_MEMORY_SCOPE_AGENT);
    }
    asm volatile("s_waitcnt vmcnt(0)" ::: "memory");
    __syncthreads();
    if (tid == 0) __hip_atomic_store(flags + 64 * (chain * 8 + seg), 1u, __ATOMIC_RELAXED, __HIP_MEMORY_SCOPE_AGENT);
}
__device__ __forceinline__ void prompt_pass2(LAS unsigned char* lds, const Args& a, int chain, int seg, int nseg) {
    unsigned char* ws = a.ws;
    const bf16* zb = (const bf16*)(ws + WS_ZB); const float* lf = (const float*)(ws + WS_LF); bf16* mixb = (bf16*)(ws + WS_MIX);
    const int tid = threadIdx.x, lane = tid & 63, wave = __builtin_amdgcn_readfirstlane(tid >> 6), fr = lane & 15, fq = lane >> 4;
    const int b = chain / NH, h = chain % NH, seglen = SEQ / nseg, nsteps = seglen / 64, rowb = b * SEQ + seg * seglen;
    const f32x4* slab = (const f32x4*)(ws + WS_XB);
    const float* dseg = (const float*)(ws + WS_XB + 16 * MiB);
    unsigned* flags = (unsigned*)(ws + WS_CTL) + CW_FLAG;
    f32x4 gnr[4];
#pragma unroll
    for (int i = 0; i < 4; ++i) gnr[i] = *(const f32x4*)(a.in[9] + h * HD + 16 * (4 * (wave >> 2) + i) + 4 * fq);
    f32x4 Sacc[8];
#pragma unroll
    for (int i = 0; i < 8; ++i) Sacc[i] = (f32x4){0.f, 0.f, 0.f, 0.f};
    f32x4 segsum = (f32x4){0.f, 0.f, 0.f, 0.f};
    if (seg > 0) {
        if (tid < 64) {
            for (int i = 0; i < seg; ++i) { unsigned sp = 0; while (__hip_atomic_load(flags + 64 * (chain * 8 + i), __ATOMIC_RELAXED, __HIP_MEMORY_SCOPE_AGENT) == 0u && ++sp < (1u << 22)) __builtin_amdgcn_s_sleep(2); }
            __builtin_amdgcn_fence(__ATOMIC_ACQUIRE, "agent");
            asm volatile("s_waitcnt vmcnt(0)" ::: "memory");
        }
        __syncthreads();
        f32x4 rc[8], rn[8];
#pragma unroll
        for (int kt = 0; kt < 8; ++kt) { rc[kt] = slab[(size_t)(chain * 8) * 4096 + kt * 512 + tid]; rn[kt] = rc[kt]; }
        for (int i = 0; i < seg; ++i) {
            const float* dd = dseg + (chain * 8 + i) * 128;
            if (i + 1 < seg) {
#pragma unroll
                for (int kt = 0; kt < 8; ++kt) rn[kt] = slab[(size_t)(chain * 8 + i + 1) * 4096 + kt * 512 + tid];
            }
#pragma unroll
            for (int kt = 0; kt < 8; ++kt) Sacc[kt] = Sacc[kt] * *(const f32x4*)(dd + 16 * kt + 4 * fq) + rc[kt];
#pragma unroll
            for (int kt = 0; kt < 8; ++kt) rc[kt] = rn[kt];
        }
    }
    seg_run<true>(lds, zb, lf, Sacc, segsum, gnr, mixb, rowb, nsteps, h);
    if (seg + 1 == nseg) {
        float* Sout = a.out + O_HSP + (size_t)chain * HD * HD;
#pragma unroll
        for (int kt = 0; kt < 8; ++kt)
#pragma unroll
            for (int j = 0; j < 4; ++j) Sout[(size_t)(16 * kt + 4 * fq + j) * HD + 16 * wave + fr] = Sacc[kt][j];
    }
}

__device__ __forceinline__ void phase2(LAS unsigned char* lds, const Args& a, int bid, int G, int parts = 7) {
    unsigned char* ws = a.ws;
    const bf16* zb = (const bf16*)(ws + WS_ZB); const float* lf = (const float*)(ws + WS_LF); bf16* mixb = (bf16*)(ws + WS_MIX);
    constexpr int NPC = NB * NH, NSC = DB * NH, NPOOL = (M / 64) * 4;
    const int nseg = (G >= 8 * NPC) ? 8 : (G >= 4 * NPC ? 4 : (G >= 2 * NPC ? 2 : 1));
    if ((parts & 1) && nseg > 1 && bid < nseg * NPC) prompt_pass1(lds, a, bid / nseg, bid % nseg, nseg);
#if P2_ORDER_OLD
    if (parts & 1) {
        if (nseg > 1) { if (bid < nseg * NPC) prompt_pass2(lds, a, bid / nseg, bid % nseg, nseg); }
        else for (int c = bid; c < NPC; c += G) prompt_pass2(lds, a, c, 0, 1);
    }
#endif
    STAMP(5);
    if (parts & 2) {
        SampleRegs cur, nxt;
        if (bid < NSC) sample_load(cur, a.in[3] + (size_t)bid * HD * HD);
        for (int it = bid; it < NSC; it += G) {
            const bool pf = it + G < NSC;
            SampleStage st; sample_stage(st, zb, lf, MP + (it / NH) * DS, it % NH);
            if (pf) sample_load(nxt, a.in[3] + (size_t)(it + G) * HD * HD);
            sample_run(lds, cur, st, zb, a.in[9], a.out + O_HSS + (size_t)it * HD * HD, mixb, MP + (it / NH) * DS, it % NH);
            if (pf) {
#pragma unroll
                for (int kk = 0; kk < 8; ++kk) cur.S[kk] = nxt.S[kk];
            }
        }
    }
    if (parts & 4) {
        const int first = (NSC + G - 1 - bid) / G * G + bid;
        for (int it = first; it < NSC + NPOOL; it += G) pool_item(lds, it - NSC, zb, a.in[2], (const bf16*)(ws + WS_WP), mixb);
    }
    STAMP(6);
    if (!P2_ORDER_OLD && (parts & 1)) {
        if (nseg > 1) { if (bid < nseg * NPC) prompt_pass2(lds, a, bid / nseg, bid % nseg, nseg); }
        else for (int c = bid; c < NPC; c += G) prompt_pass2(lds, a, c, 0, 1);
    }
}

__device__ __forceinline__ void phase6(const Args& a, int vcu, int G, size_t x2off) {
    const int tid = threadIdx.x, lane = tid & 63, wave = tid >> 6;
#ifdef TPROBE
    { unsigned d = *((const unsigned*)(a.ws + WS_CTL) + CW_TP); if (TP_MODE == 2) d = 0x40000000u - d;
#ifdef TP_CAL
      d = TP_REF_US * 95;
#endif
      const float delta = 0.01f * ((float)d * 0.01f) / (float)(TP_REF_US);
      for (int i = vcu * (NWAVES * 64) + tid; i < NB * PC * PW; i += G * NWAVES * 64) a.out[O_PSP + i] += delta; }
#endif
    const int gw = vcu * NWAVES + wave, NGW = G * NWAVES;
    const float* rsq3 = (const float*)(a.ws + WS_CTL) + CW_RSQ3;
    for (int m = gw; m < M; m += NGW) {
        float* yr = a.out + O_Y + (size_t)m * D; const bf16* xr = (const bf16*)(a.ws + x2off) + (size_t)m * D;
        const float r = rsqrtf(rsq3[m] * (1.f / D) + EPS);
#pragma unroll
        for (int j = 0; j < 4; ++j) {
            const u32x4 xw = ((const u32x4*)xr)[lane + 64 * j];
            const f32x4 g0 = ((const f32x4*)a.in[15])[2 * (lane + 64 * j)], g1 = ((const f32x4*)a.in[15])[2 * (lane + 64 * j) + 1];
            ((f32x4*)yr)[2 * (lane + 64 * j)] = (f32x4){bflo(xw.x), bfhi(xw.x), bflo(xw.y), bfhi(xw.y)} * r * g0;
            ((f32x4*)yr)[2 * (lane + 64 * j) + 1] = (f32x4){bflo(xw.z), bfhi(xw.z), bflo(xw.w), bfhi(xw.w)} * r * g1;
        }
    }
}

__global__ void __launch_bounds__(NWAVES * 64, 2) mega(Args a) {
    extern __shared__ __attribute__((aligned(16))) unsigned char lds_raw[];
    LAS unsigned char* lds = (LAS unsigned char*)lds_raw;
    const int G = gridDim.x, bid = blockIdx.x;
    const int vcu = (G % 8 == 0) ? (bid % 8) * (G / 8) + bid / 8 : bid;
    unsigned char* ws = a.ws;
    float* ctlf = (float*)(ws + WS_CTL);
    const int lo = a.ph_lo, hi = a.ph_hi;
#if ONE_LAUNCH && USE_CG
    cg::grid_group grid = cg::this_grid();
#define GRID_BAR() grid.sync()
#elif ONE_LAUNCH
    volatile LAS unsigned* MISC = (volatile LAS unsigned*)(lds + MISC_OFF);
    if (threadIdx.x < 32) MISC[threadIdx.x] = 0u;
    __syncthreads();
    XcdBarrier bar = xcd_barrier_post((unsigned*)(ws + WS_CTL) + CW_BAR, MISC + 8);
#define GRID_BAR() xcd_barrier(bar)
#else
#define GRID_BAR() do {} while (0)
#endif
#ifndef PH_MASK
#define PH_MASK 0x7f
#endif
#define IN(k) (((PH_MASK >> (k)) & 1) && lo <= (k) && (k) < hi)
#define BOTH(k) (IN(k) && IN((k) + 1))
#ifndef REP_MASK
#define REP_MASK 0
#endif
#define REP(k) ((REP_MASK >> (k)) & 1)
#ifndef P2_REP_PARTS
#define P2_REP_PARTS 7
#endif
    STAMP(0);
    if (IN(0)) { if (REP(0)) { phase0(lds, a, vcu, G); __syncthreads(); } phase0(lds, a, vcu, G); STAMP(1); if (BOTH(0)) GRID_BAR(); STAMP(2); }
    if (IN(1)) {
        pg8::Gemm g{(const bf16*)(ws + WS_XB), (const bf16*)(ws + WS_WIN), M, INC, D}; pg8::HybridOrder S; S.init(M, INC, D, G, bid, false);
        const pg8::TailCtx T{nullptr, nullptr};
        pg8::EpiZ E{(bf16*)(ws + WS_ZB), (float*)(ws + WS_LF), (const float*)(ws + WS_MISC), (const float*)(ws + WS_MISC) + M, a.out};
        if (REP(1)) pg8::gemm_phase2(lds, g, S, E, T);
        pg8::gemm_phase2(lds, g, S, E, T);
        STAMP(3);
        if (BOTH(1)) GRID_BAR();
        STAMP(4);
    }
    if (IN(2)) { if (REP(2)) { phase2(lds, a, bid, G, P2_REP_PARTS); __syncthreads(); } phase2(lds, a, bid, G); STAMP(7); if (BOTH(2)) GRID_BAR(); STAMP(8); }
    const bool merged = MERGED && G == 256 && lo <= 3 && hi >= 6;
    if (merged) {
        pg8::MOrder S{bid};
        constexpr pg8::StreamOff O{WS_MIX, WS_WO, WS_XB, WS_WGU, WS_ACT, WS_WD, WS_MIX, WS_SLABM, CW_DEP, CW_DEP + 4096, CW_TAIL, CW_RSQ2, CW_RSQ3};
        pg8::gemm_stream(lds, S, ws, a.in[0], a.in[1], O);
        STAMP(13);
#ifdef TPROBE
        if (threadIdx.x == 0) { volatile LAS unsigned long long* ts = (volatile LAS unsigned long long*)(lds + MISC_OFF + 128); const unsigned d = (unsigned)(ts[TP_B] - ts[TP_A]);
            unsigned* w = (unsigned*)(ws + WS_CTL) + CW_TP; if (TP_MODE == 0) { if (bid == TP_BLOCK) atomicMax(w, d); } else if (TP_MODE == 1) atomicMax(w, d); else atomicMax(w, 0x40000000u - d); }
#endif
        GRID_BAR();
    }
#if !MERGED
    if (!merged && IN(3)) {
        pg8::Gemm g{(const bf16*)(ws + WS_MIX), (const bf16*)(ws + WS_WO), M, D, D}; pg8::HybridOrder S; S.init(M, D, D, G, bid, true);
        const pg8::TailCtx T{(f32x4*)(ws + WS_SLAB3), (unsigned*)(ws + WS_CTL) + CW_TAIL};
        if (REP(3)) { pg8::EpiX1<true> E0{a.in[0], a.in[1], a.out + O_Y, (bf16*)(ws + WS_XB), ctlf + CW_RSQ2, false}; pg8::gemm_phase2(lds, g, S, E0, T); }
        pg8::EpiX1<false> E{a.in[0], a.in[1], a.out + O_Y, (bf16*)(ws + WS_XB), ctlf + CW_RSQ2, false};
        pg8::gemm_phase2(lds, g, S, E, T);
        STAMP(9);
        if (BOTH(3)) GRID_BAR();
        STAMP(10);
    }
    if (!merged && IN(4)) {
        pg8::Gemm g{(const bf16*)(ws + WS_XB), (const bf16*)(ws + WS_WGU), M, 2 * DFF, D}; pg8::HybridOrder S; S.init(M, 2 * DFF, D, G, bid, true);
        const pg8::TailCtx T{(f32x4*)(ws + WS_SLAB45), (unsigned*)(ws + WS_CTL) + CW_TAIL + 4096};
        pg8::EpiAct E{(bf16*)(ws + WS_ACT), ctlf + CW_RSQ2, false};
        if (REP(4)) pg8::gemm_phase2(lds, g, S, E, T);
        pg8::gemm_phase2(lds, g, S, E, T);
        STAMP(11);
        if (BOTH(4)) GRID_BAR();
        STAMP(12);
    }
    if (!merged && IN(5)) {
        pg8::Gemm g{(const bf16*)(ws + WS_ACT), (const bf16*)(ws + WS_WD), M, D, DFF}; pg8::HybridOrder S; S.init(M, D, DFF, G, bid, true);
        const pg8::TailCtx T{(f32x4*)(ws + WS_SLAB45), (unsigned*)(ws + WS_CTL) + CW_TAIL + 8192};
        if (REP(5)) { pg8::EpiX2<true> E0{(bf16*)(ws + WS_X2B), ctlf + CW_RSQ3, (const bf16*)(ws + WS_XB)}; pg8::gemm_phase2(lds, g, S, E0, T); }
        pg8::EpiX2<false> E{(bf16*)(ws + WS_X2B), ctlf + CW_RSQ3, (const bf16*)(ws + WS_XB)};
        pg8::gemm_phase2(lds, g, S, E, T);
        STAMP(13);
#ifdef TPROBE
        if (threadIdx.x == 0) { volatile LAS unsigned long long* ts = (volatile LAS unsigned long long*)(lds + MISC_OFF + 128); const unsigned d = (unsigned)(ts[TP_B] - ts[TP_A]);
            unsigned* w = (unsigned*)(ws + WS_CTL) + CW_TP; if (TP_MODE == 0) { if (bid == TP_BLOCK) atomicMax(w, d); } else if (TP_MODE == 1) atomicMax(w, d); else atomicMax(w, 0x40000000u - d); }
#endif
        if (BOTH(5)) GRID_BAR();
    }
#endif
    if (IN(6)) phase6(a, vcu, G, merged ? WS_MIX : WS_X2B);
#undef IN
#undef BOTH
}

extern "C" void kernel_launch(void* const* d_in, const int* in_sizes, int n_in, void* d_out, int out_size, void* d_ws, size_t ws_size, hipStream_t stream) {
    static int grid = 0;
    if (grid == 0) {
        if (n_in != 16 || ws_size < WS_END) { fprintf(stderr, "kernel_launch: unexpected n_in %d / ws_size %zu\n", n_in, ws_size); grid = -1; return; }
        int dev = 0, cus = 0, per_cu = 0;
        hipGetDevice(&dev);
        hipDeviceGetAttribute(&cus, hipDeviceAttributeMultiprocessorCount, dev);
        hipFuncSetAttribute((const void*)mega, hipFuncAttributeMaxDynamicSharedMemorySize, LDS_BYTES);
        hipOccupancyMaxActiveBlocksPerMultiprocessor(&per_cu, (const void*)mega, NWAVES * 64, LDS_BYTES);
        if (per_cu < 1) { fprintf(stderr, "kernel_launch: occupancy query says %d blocks per CU\n", per_cu); grid = -1; return; }
        grid = cus;
    }
    if (grid < 0) return;
    hipMemsetAsync((char*)d_ws + WS_CTL, 0, CTL_ZERO_BYTES, stream);
    Args a{};
    for (int i = 0; i < 16; ++i) a.in[i] = (const float*)d_in[i];
    a.out = (float*)d_out; a.ws = (unsigned char*)d_ws;
#if ONE_LAUNCH
    a.ph_lo = 0; a.ph_hi = NPHASE;
    void* args[] = {&a};
#if USE_CG
    hipError_t e = hipLaunchCooperativeKernel((const void*)mega, dim3(grid), dim3(NWAVES * 64), args, LDS_BYTES, stream);
    if (e != hipSuccess) fprintf(stderr, "cooperative launch failed: %s (grid %d)\n", hipGetErrorString(e), grid);
#else
    (void)args; hipLaunchKernelGGL(mega, dim3(grid), dim3(NWAVES * 64), LDS_BYTES, stream, a);
#endif
#else
    for (int p = 0; p < NPHASE; ++p) { a.ph_lo = p; a.ph_hi = p + 1; hipLaunchKernelGGL(mega, dim3(grid), dim3(NWAVES * 64), LDS_BYTES, stream, a); }
#endif
}
```

```cpp
#include <hip/hip_runtime.h>
#include <hip/hip_cooperative_groups.h>
#include <cstdio>
#include <cstdint>
namespace cg = cooperative_groups;

constexpr int D = 2048, NB = 4, SEQ = 2048, DB = 128, DS = 8;
constexpr int MP = NB * SEQ, MS = DB * DS, M = MP + MS;
constexpr int PW = 1024, HW = 1024, HD = 128, NH = 8, PC = 15;
constexpr int DFF = 5632, INC = 5120;
constexpr float EPS = 1e-6f;
constexpr size_t O_Y = 0;
constexpr size_t O_PSP = (size_t)M * D;
constexpr size_t O_HSP = O_PSP + (size_t)NB * PC * PW;
constexpr size_t O_PSS = O_HSP + (size_t)NB * NH * HD * HD;
constexpr size_t O_HSS = O_PSS + (size_t)DB * PC * PW;

namespace pg8 {
#define PG8_LAS __attribute__((address_space(3)))
typedef unsigned short bf16_t;
typedef short bf16x8 __attribute__((ext_vector_type(8)));
typedef float f32x4 __attribute__((ext_vector_type(4)));
typedef unsigned u32x4 __attribute__((ext_vector_type(4)));
constexpr int BM = 256, BK = 64, HALF = 128, HTB = HALF * BK * 2  , STAGE_BYTES = 8 * HTB, NXCD = 8, WGM = 8;

__host__ __device__ __forceinline__ int lds_byte(int r, int c) { const int st = (r >> 4) * 2 + (c >> 5), rr = r & 15, cc = c & 31, ob = rr * 64 + cc * 2; return st * 1024 + (ob ^ (((ob >> 9) & 1) << 5)); }
__host__ __device__ __forceinline__ void stage_rc(int b, int& R, int& C) { const int st = b / 1024, sb = b % 1024, swz = sb ^ (((sb >> 9) & 1) << 5); R = (st >> 1) * 16 + swz / 64; C = (st & 1) * 32 + (swz % 64) / 2; }
__host__ __device__ __forceinline__ int perm32(int rho) { const int n = rho >> 4, i = rho & 15; return 8 * (i >> 2) + 4 * n + (i & 3); }

struct Unit { int pm, pn, kb, nk, tinfo; };
struct Gemm { const bf16_t* A; const bf16_t* Bt; int M, N, K; };

struct StaticOrder {
    int nM, nN, nwg, G, c;
    __host__ __device__ void init(int M, int N, int G_, int c_) { nM = M / BM; nN = N / BM; nwg = nM * nN; G = G_; c = c_; }
    __host__ __device__ bool next(int i, Unit& u) const {
        const long L = (long)i * G + c; if (L >= nwg) return false;
        int wgid = (int)L; { const int q = nwg / NXCD, r = nwg % NXCD, xcd = wgid % NXCD, off = wgid / NXCD; wgid = (xcd < r ? xcd * (q + 1) : r * (q + 1) + (xcd - r) * q) + off; }
        const int nig = WGM * nN, gid = wgid / nig, fm = gid * WGM, gsz = (nM - fm) < WGM ? (nM - fm) : WGM;
        u.pm = fm + ((wgid % nig) % gsz); u.pn = (wgid % nig) / gsz; u.kb = 0; u.nk = 0; u.tinfo = -1; return true;
    }
    __device__ __forceinline__ void a_ready(const Unit&) const {}
    __device__ __forceinline__ void done(const Unit&) const {}
};
__device__ __forceinline__ unsigned cvt_pk_bf16(float lo, float hi) { unsigned r; asm volatile("v_cvt_pk_bf16_f32 %0, %1, %2" : "=v"(r) : "v"(lo), "v"(hi)); return r; }
__device__ __forceinline__ float sigm(float x) { return __builtin_amdgcn_rcpf(1.f + __expf(-x)); }
__device__ __forceinline__ float silu(float x) { return x * __builtin_amdgcn_rcpf(1.f + __expf(-x)); }
typedef unsigned u32x2 __attribute__((ext_vector_type(2)));
__device__ __forceinline__ float bflo_(unsigned w) { return __builtin_bit_cast(float, w << 16); }
__device__ __forceinline__ float bfhi_(unsigned w) { return __builtin_bit_cast(float, w & 0xffff0000u); }

struct EpiZ {
    static constexpr bool PERM = true, AFTER_DRAIN = false;
    bf16_t* zb; float* lf; const float* rstd1; const float* lbv; float* out;
    __device__ __forceinline__ void operator()(const f32x4 (&acc)[2][2][4][2], const Unit& u, int wr, int wc, int fr, int fq, unsigned gmask = 0xffu) const {
        const int kind = u.pn >> 2;
        const int row0 = u.pm * BM + wr * 64 + fr;
        const int cc0 = (u.pn & 3) * 256 + wc * 32 + 8 * fq;
        f32x4 lb[2][2];
        if (kind == 2) {
#pragma unroll
            for (int bj = 0; bj < 2; ++bj)
#pragma unroll
                for (int n = 0; n < 2; ++n) lb[bj][n] = *(const f32x4*)(lbv + cc0 + bj * HALF + 4 * n);
        }
#pragma unroll
        for (int ai = 0; ai < 2; ++ai)
#pragma unroll
            for (int m = 0; m < 4; ++m) {
                if (!((gmask >> (ai * 4 + m)) & 1u)) continue;
                const int row = row0 + ai * HALF + m * 16;
                const float r = rstd1[row];
#pragma unroll
                for (int bj = 0; bj < 2; ++bj) {
                    const int cc = cc0 + bj * HALF;
                    f32x4 v0 = acc[ai][bj][m][0] * r, v1 = acc[ai][bj][m][1] * r;
                    if (kind == 2) {
                        f32x4 k0, k1;
#pragma unroll
                        for (int j = 0; j < 4; ++j) {
                            const float f0 = lb[bj][0][j] + (1.f - lb[bj][0][j]) * sigm(v0[j]), f1 = lb[bj][1][j] + (1.f - lb[bj][1][j]) * sigm(v1[j]);
                            v0[j] = __log2f(f0); v1[j] = __log2f(f1); k0[j] = 1.f - f0; k1[j] = 1.f - f1;
                        }
                        float* p = lf + (size_t)row * HW + cc;
                        *(f32x4*)p = v0; *(f32x4*)(p + 4) = v1;
                        u32x4 w; w.x = cvt_pk_bf16(k0[0], k0[1]); w.y = cvt_pk_bf16(k0[2], k0[3]); w.z = cvt_pk_bf16(k1[0], k1[1]); w.w = cvt_pk_bf16(k1[2], k1[3]);
                        *(u32x4*)(zb + (size_t)row * INC + 2 * 1024 + cc) = w;
                    } else {
                        if (kind == 0) {
                            float* dst = nullptr;
                            if (row >= MP) { const int ms = row - MP; dst = out + O_PSS + ((size_t)(ms >> 3) * PC + 7 + (ms & 7)) * PW + cc; }
                            else { const int t = row & (SEQ - 1); if (t >= SEQ - PC) dst = out + O_PSP + ((size_t)(row >> 11) * PC + (t - (SEQ - PC))) * PW + cc; }
                            if (dst) { *(f32x4*)dst = v0; *(f32x4*)(dst + 4) = v1; }
                        }
                        if (kind == 1 || kind == 4) {
#pragma unroll
                            for (int j = 0; j < 4; ++j) { v0[j] = silu(v0[j]); v1[j] = silu(v1[j]); }
                        }
                        u32x4 w; w.x = cvt_pk_bf16(v0[0], v0[1]); w.y = cvt_pk_bf16(v0[2], v0[3]); w.z = cvt_pk_bf16(v1[0], v1[1]); w.w = cvt_pk_bf16(v1[2], v1[3]);
                        *(u32x4*)(zb + (size_t)row * INC + kind * 1024 + cc) = w;
                    }
                }
            }
    }
};

__device__ __forceinline__ void store16(bf16_t* base, size_t elem_off, u32x4 w, bool wt) {
    if (wt) { const __amdgpu_buffer_rsrc_t r = __builtin_amdgcn_make_buffer_rsrc((void*)base, (short)0, 0x7fffffff, 0x00020000); __builtin_amdgcn_raw_buffer_store_b128(w, r, (unsigned)(elem_off * 2), 0, 16); }
    else *(u32x4*)(base + elem_off) = w;
}
template <bool DRY = false> struct EpiX1 {
    static constexpr bool PERM = true, AFTER_DRAIN = false;
    const float* xp; const float* xs; float* y; bf16_t* x1b; float* rowsq; bool wt;
    __device__ __forceinline__ void operator()(const f32x4 (&acc)[2][2][4][2], const Unit& u, int wr, int wc, int fr, int fq, unsigned gmask = 0xffu) const {
        const int row0 = u.pm * BM + wr * 64 + fr, col0 = u.pn * BM + wc * 32 + 8 * fq;
#pragma unroll
        for (int ai = 0; ai < 2; ++ai)
#pragma unroll
            for (int m = 0; m < 4; ++m) {
                if (!((gmask >> (ai * 4 + m)) & 1u)) continue;
                const int row = row0 + ai * HALF + m * 16;
                const float* xr = (row < MP ? xp + (size_t)row * D : xs + (size_t)(row - MP) * D) + col0;
                float s = 0.f;
#pragma unroll
                for (int bj = 0; bj < 2; ++bj) {
                    const f32x4 v0 = *(const f32x4*)(xr + bj * HALF) + acc[ai][bj][m][0], v1 = *(const f32x4*)(xr + bj * HALF + 4) + acc[ai][bj][m][1];
                    u32x4 w; w.x = cvt_pk_bf16(v0[0], v0[1]); w.y = cvt_pk_bf16(v0[2], v0[3]); w.z = cvt_pk_bf16(v1[0], v1[1]); w.w = cvt_pk_bf16(v1[2], v1[3]);
                    store16(x1b, (size_t)row * D + col0 + bj * HALF, w, wt);
                    s += (v0[0] * v0[0] + v0[1] * v0[1]) + (v0[2] * v0[2] + v0[3] * v0[3]) + (v1[0] * v1[0] + v1[1] * v1[1]) + (v1[2] * v1[2] + v1[3] * v1[3]);
                }
                s += __shfl_xor(s, 16); s += __shfl_xor(s, 32);
                if (fq == 0 && !DRY) atomicAdd(rowsq + row, s);
            }
    }
};

struct EpiAct {
    static constexpr bool PERM = true, AFTER_DRAIN = false;
    bf16_t* act; const float* rowsq; bool wt;
    __device__ __forceinline__ void operator()(const f32x4 (&acc)[2][2][4][2], const Unit& u, int wr, int wc, int fr, int fq, unsigned gmask = 0xffu) const {
        const int row0 = u.pm * BM + wr * 64 + fr, col0 = u.pn * HALF + wc * 32 + 8 * fq;
#pragma unroll
        for (int ai = 0; ai < 2; ++ai)
#pragma unroll
            for (int m = 0; m < 4; ++m) {
                if (!((gmask >> (ai * 4 + m)) & 1u)) continue;
                const int row = row0 + ai * HALF + m * 16;
                const float r = rsqrtf(rowsq[row] * (1.f / D) + EPS);
                u32x4 w; unsigned* wp = (unsigned*)&w;
#pragma unroll
                for (int n = 0; n < 2; ++n) {
                    const f32x4 g = acc[ai][0][m][n] * r, up = acc[ai][1][m][n] * r;
                    f32x4 a;
#pragma unroll
                    for (int j = 0; j < 4; ++j) a[j] = silu(g[j]) * up[j];
                    wp[2 * n] = cvt_pk_bf16(a[0], a[1]); wp[2 * n + 1] = cvt_pk_bf16(a[2], a[3]);
                }
                store16(act, (size_t)row * DFF + col0, w, wt);
            }
    }
};

template <bool DRY = false> struct EpiX2 {
    static constexpr bool PERM = true, AFTER_DRAIN = false;
    bf16_t* x2b; float* rowsq; const bf16_t* x1b;
    __device__ __forceinline__ void operator()(const f32x4 (&acc)[2][2][4][2], const Unit& u, int wr, int wc, int fr, int fq, unsigned gmask = 0xffu) const {
        const int row0 = u.pm * BM + wr * 64 + fr, col0 = u.pn * BM + wc * 32 + 8 * fq;
#pragma unroll
        for (int ai = 0; ai < 2; ++ai)
#pragma unroll
            for (int m = 0; m < 4; ++m) {
                if (!((gmask >> (ai * 4 + m)) & 1u)) continue;
                const int row = row0 + ai * HALF + m * 16;
                float s = 0.f;
#pragma unroll
                for (int bj = 0; bj < 2; ++bj) {
                    const u32x4 xw = *(const u32x4*)(x1b + (size_t)row * D + col0 + bj * HALF);
                    f32x4 v0 = (f32x4){bflo_(xw.x), bfhi_(xw.x), bflo_(xw.y), bfhi_(xw.y)} + acc[ai][bj][m][0];
                    f32x4 v1 = (f32x4){bflo_(xw.z), bfhi_(xw.z), bflo_(xw.w), bfhi_(xw.w)} + acc[ai][bj][m][1];
                    u32x4 w; w.x = cvt_pk_bf16(v0[0], v0[1]); w.y = cvt_pk_bf16(v0[2], v0[3]); w.z = cvt_pk_bf16(v1[0], v1[1]); w.w = cvt_pk_bf16(v1[2], v1[3]);
                    *(u32x4*)(x2b + (size_t)row * D + col0 + bj * HALF) = w;
                    s += (v0[0] * v0[0] + v0[1] * v0[1]) + (v0[2] * v0[2] + v0[3] * v0[3]) + (v1[0] * v1[0] + v1[1] * v1[1]) + (v1[2] * v1[2] + v1[3] * v1[3]);
                }
                s += __shfl_xor(s, 16); s += __shfl_xor(s, 32);
                if (fq == 0 && !DRY) atomicAdd(rowsq + row, s);
            }
    }
};
template <class Epi, class Sched, bool ALIGN_EPI = false, bool SP2 = false>
__device__ __forceinline__ void gemm_phase(PG8_LAS unsigned char* lds, const Gemm g, const Sched& S, const Epi& E) {
    int tid_ = threadIdx.x; asm volatile("" : "+v"(tid_));
    const int tid = tid_, wid = __builtin_amdgcn_readfirstlane(tid >> 6), lane = tid & 63, wr = wid >> 2, wc = wid & 3, fr = lane & 15, fq = lane >> 4;
    const int K = g.K, nt = K / BK;
    unsigned voffA[2], voffB[2];
#pragma unroll
    for (int i = 0; i < 2; ++i) { int R, C; stage_rc(tid * 16 + i * 8192, R, C); const int Rb = Epi::PERM ? ((R & ~31) + perm32(R & 31)) : R;
        voffA[i] = (unsigned)(R * K + C) * 2u; voffB[i] = (unsigned)(Rb * K + C) * 2u; }
    const size_t kstep = (size_t)(BK * 2);
    const size_t hstep = (size_t)HALF * K * 2;
    const size_t tstep = 2 * hstep;
    const unsigned ldsw = (unsigned)wid * 1024u;
    const int aoff = lds_byte(wr * 64 + fr, fq * 8), boff = lds_byte(wc * 32 + fr, fq * 8);
#define PG8_SA(b, h) (((b) * 2 + (h)) * HTB)
#define PG8_SB(b, h) ((4 + (b) * 2 + (h)) * HTB)
#define PG8_STAGE(bufoff, gbase, voff) do { _Pragma("unroll") for (int _i = 0; _i < 2; ++_i) \
        __builtin_amdgcn_global_load_lds((const unsigned*)((const char*)(gbase) + (voff)[_i]), (PG8_LAS unsigned*)(lds + (bufoff) + ldsw + _i * 8192), 16, 0, 0); } while (0)
#define PG8_LDA(dst, b, h) do { _Pragma("unroll") for (int m = 0; m < 4; ++m) _Pragma("unroll") for (int k = 0; k < 2; ++k) dst[m][k] = *(const PG8_LAS bf16x8*)(lds + PG8_SA(b, h) + aoff + m * 2048 + k * 1024); } while (0)
#define PG8_LDB(dst, b, h) do { _Pragma("unroll") for (int n = 0; n < 2; ++n) _Pragma("unroll") for (int k = 0; k < 2; ++k) dst[n][k] = *(const PG8_LAS bf16x8*)(lds + PG8_SB(b, h) + boff + n * 2048 + k * 1024); } while (0)
#define PG8_MMA(ai, bj, At, Bt) do { __builtin_amdgcn_s_setprio(1); _Pragma("unroll") for (int m = 0; m < 4; ++m) _Pragma("unroll") for (int n = 0; n < 2; ++n) _Pragma("unroll") for (int k = 0; k < 2; ++k) \
        acc[ai][bj][m][n] = __builtin_amdgcn_mfma_f32_16x16x32_bf16(Bt[n][k], At[m][k], acc[ai][bj][m][n], 0, 0, 0); __builtin_amdgcn_s_setprio(0); } while (0)
#define PG8_WAIT_V(n) asm volatile("s_waitcnt vmcnt(" #n ")" ::: "memory")
#define PG8_WAIT_L(n) asm volatile("s_waitcnt lgkmcnt(" #n ")" ::: "memory")
#define PG8_BAR __builtin_amdgcn_s_barrier()
#define PG8_SCHED __builtin_amdgcn_sched_barrier(0)
    Unit cur, nxt; int ui = 0;
    if (!S.next(0, cur)) return;
    f32x4 acc[2][2][4][2];
#pragma unroll
    for (int a = 0; a < 2; ++a)
#pragma unroll
        for (int b = 0; b < 2; ++b)
#pragma unroll
            for (int m = 0; m < 4; ++m)
#pragma unroll
                for (int n = 0; n < 2; ++n) acc[a][b][m][n] = (f32x4){0.f, 0.f, 0.f, 0.f};
    bf16x8 At[4][2], B0[2][2], B1[2][2];
    const char* cA = (const char*)g.A + (size_t)cur.pm * tstep; const char* cB = (const char*)g.Bt + (size_t)cur.pn * tstep;
    S.a_ready(cur);
    if constexpr (SP2) {
        PG8_STAGE(PG8_SB(0, 0), cB, voffB); PG8_STAGE(PG8_SB(0, 1), cB + hstep, voffB); PG8_STAGE(PG8_SA(0, 0), cA, voffA); PG8_STAGE(PG8_SA(0, 1), cA + hstep, voffA);
        if (wr == 1) PG8_BAR;
        PG8_WAIT_V(2); PG8_BAR;
        PG8_STAGE(PG8_SB(1, 0), cB + kstep, voffB); PG8_STAGE(PG8_SA(1, 0), cA + kstep, voffA); PG8_STAGE(PG8_SB(1, 1), cB + hstep + kstep, voffB);
        PG8_WAIT_V(6); PG8_BAR;
    } else {
        PG8_STAGE(PG8_SB(0, 0), cB, voffB); PG8_STAGE(PG8_SA(0, 0), cA, voffA); PG8_STAGE(PG8_SB(0, 1), cB + hstep, voffB); PG8_STAGE(PG8_SA(0, 1), cA + hstep, voffA);
        if (wr == 1) PG8_BAR;
        PG8_WAIT_V(4); PG8_BAR;
        PG8_STAGE(PG8_SB(1, 0), cB + kstep, voffB); PG8_STAGE(PG8_SA(1, 0), cA + kstep, voffA); PG8_STAGE(PG8_SB(1, 1), cB + hstep + kstep, voffB);
        PG8_WAIT_V(6); PG8_BAR;
    }
    for (;;) {
        const bool has_next = S.next(ui + 1, nxt);
        const char* nA = has_next ? (const char*)g.A + (size_t)nxt.pm * tstep : cA; const char* nB = has_next ? (const char*)g.Bt + (size_t)nxt.pn * tstep : cB;
        for (int t = 0; t < nt; t += 2) {
            const bool last = (t == nt - 2);
            const char* a1 = cA + (size_t)(t + 1) * kstep;
            const char* a2 = last ? nA : cA + (size_t)(t + 2) * kstep; const char* b2 = last ? nB : cB + (size_t)(t + 2) * kstep;
            const char* a3 = a2 + kstep; const char* b3 = b2 + kstep;
            if (last && has_next) S.a_ready(nxt);
            if constexpr (SP2) {
            PG8_LDB(B0, 0, 0); PG8_LDB(B1, 0, 1); PG8_SCHED; PG8_LDA(At, 0, 0); PG8_STAGE(PG8_SA(1, 1), a1 + hstep, voffA);
            PG8_WAIT_V(8); PG8_WAIT_L(0); PG8_BAR; PG8_MMA(0, 0, At, B0); PG8_MMA(0, 1, At, B1); PG8_BAR; PG8_SCHED;
            PG8_LDA(At, 0, 1); PG8_STAGE(PG8_SB(0, 0), b2, voffB); PG8_STAGE(PG8_SB(0, 1), b2 + hstep, voffB); PG8_STAGE(PG8_SA(0, 0), a2, voffA);
            PG8_WAIT_V(8); PG8_WAIT_L(0); PG8_BAR; PG8_MMA(1, 0, At, B0); PG8_MMA(1, 1, At, B1); PG8_BAR; PG8_SCHED;
            PG8_LDB(B0, 1, 0); PG8_LDB(B1, 1, 1); PG8_SCHED; PG8_LDA(At, 1, 0); PG8_STAGE(PG8_SA(0, 1), a2 + hstep, voffA);
            PG8_WAIT_V(8); PG8_WAIT_L(0); PG8_BAR; PG8_MMA(0, 0, At, B0); PG8_MMA(0, 1, At, B1); PG8_BAR; PG8_SCHED;
            PG8_LDA(At, 1, 1); PG8_STAGE(PG8_SB(1, 0), b3, voffB); PG8_STAGE(PG8_SB(1, 1), b3 + hstep, voffB); PG8_STAGE(PG8_SA(1, 0), a3, voffA);
            PG8_WAIT_V(8); PG8_WAIT_L(0); PG8_BAR; PG8_MMA(1, 0, At, B0); PG8_MMA(1, 1, At, B1); PG8_BAR; PG8_SCHED;
            } else {
            PG8_LDB(B0, 0, 0); PG8_SCHED; PG8_LDA(At, 0, 0); PG8_STAGE(PG8_SA(1, 1), a1 + hstep, voffA);
            PG8_WAIT_L(8); PG8_BAR; PG8_WAIT_L(0); PG8_MMA(0, 0, At, B0); PG8_BAR; PG8_SCHED;
            PG8_LDB(B1, 0, 1); PG8_STAGE(PG8_SB(0, 0), b2, voffB);
            PG8_BAR; PG8_WAIT_L(0); PG8_MMA(0, 1, At, B1); PG8_BAR;
            PG8_LDA(At, 0, 1); PG8_STAGE(PG8_SA(0, 0), a2, voffA);
            PG8_BAR; PG8_WAIT_L(0); PG8_MMA(1, 0, At, B0); PG8_BAR; PG8_SCHED;
            PG8_STAGE(PG8_SB(0, 1), b2 + hstep, voffB);
            PG8_WAIT_V(6); PG8_BAR; PG8_MMA(1, 1, At, B1); PG8_BAR;
            PG8_LDB(B0, 1, 0); PG8_SCHED; PG8_LDA(At, 1, 0); PG8_STAGE(PG8_SA(0, 1), a2 + hstep, voffA);
            PG8_WAIT_L(8); PG8_BAR; PG8_WAIT_L(0); PG8_MMA(0, 0, At, B0); PG8_BAR; PG8_SCHED;
            PG8_LDB(B1, 1, 1); PG8_STAGE(PG8_SB(1, 0), b3, voffB);
            PG8_BAR; PG8_WAIT_L(0); PG8_MMA(0, 1, At, B1); PG8_BAR;
            PG8_LDA(At, 1, 1); PG8_STAGE(PG8_SA(1, 0), a3, voffA);
            PG8_BAR; PG8_WAIT_L(0); PG8_MMA(1, 0, At, B0); PG8_BAR; PG8_SCHED;
            PG8_STAGE(PG8_SB(1, 1), b3 + hstep, voffB);
            PG8_WAIT_V(6); PG8_BAR; PG8_MMA(1, 1, At, B1); PG8_BAR;
            }
        }
        if constexpr (ALIGN_EPI) { if (wr == 0) PG8_BAR; }
        if constexpr (!Epi::AFTER_DRAIN) { E(acc, cur, wr, wc, fr, fq); S.done(cur); }
        if (!has_next) break;
#pragma unroll
        for (int a = 0; a < 2; ++a)
#pragma unroll
            for (int b = 0; b < 2; ++b)
#pragma unroll
                for (int m = 0; m < 4; ++m)
#pragma unroll
                    for (int n = 0; n < 2; ++n) acc[a][b][m][n] = (f32x4){0.f, 0.f, 0.f, 0.f};
        cur = nxt; cA = nA; cB = nB; ++ui;
        if constexpr (ALIGN_EPI) { if (wr == 1) PG8_BAR; }
    }
    PG8_WAIT_V(0);
    if constexpr (!ALIGN_EPI) { if (wr == 0) PG8_BAR; }
    PG8_BAR;
    if constexpr (Epi::AFTER_DRAIN) { E.fused(acc, cur, wr, wc, fr, fq, lds, wid, lane); S.done(cur); }
#undef PG8_SA
#undef PG8_SB
#undef PG8_STAGE
#undef PG8_LDA
#undef PG8_LDB
#undef PG8_MMA
#undef PG8_WAIT_V
#undef PG8_WAIT_L
#undef PG8_BAR
#undef PG8_SCHED
}

struct HybridOrder {
    int nM, nN, nwg, G, c, nt, nfull, R, ns;
    __device__ __forceinline__ void init(int M, int N, int K, int G_, int c_, bool allow_split) {
        nM = M / BM; nN = N / BM; nwg = nM * nN; G = G_; c = c_; nt = K / BK; nfull = nwg / G; R = nwg - nfull * G;
        ns = (allow_split && R > 0 && (R % 8) == 0 && (G % 8) == 0) ? G / R : 1; if (ns > 8) ns = 8; if (ns > nt / 2) ns = nt / 2; if (ns < 2) ns = 1;
    }
    __device__ __forceinline__ void map(int L, Unit& u) const {
        int wgid = L; { const int q = nwg / NXCD, r = nwg % NXCD, xcd = wgid % NXCD, off = wgid / NXCD; wgid = (xcd < r ? xcd * (q + 1) : r * (q + 1) + (xcd - r) * q) + off; }
        const int nig = WGM * nN, gid = wgid / nig, fm = gid * WGM, gsz = (nM - fm) < WGM ? (nM - fm) : WGM;
        u.pm = fm + ((wgid % nig) % gsz); u.pn = (wgid % nig) / gsz;
    }
    __device__ __forceinline__ bool next(int i, Unit& u) const {
        if (i < nfull) { map(i * G + c, u); u.kb = 0; u.nk = nt; u.tinfo = -1; return true; }
        if (i > nfull || R == 0) return false;
        if (ns < 2) { const int L = i * G + c; if (L >= nwg) return false; map(L, u); u.kb = 0; u.nk = nt; u.tinfo = -1; return true; }
        const int x = c % 8, y = c / 8, tj = (y / ns) * 8 + x, slice = y % ns;
        if (tj >= R) return false;
        map(nfull * G + tj, u);
        const int pairs = nt / 2, base = pairs / ns, rem = pairs % ns, start = slice * base + (slice < rem ? slice : rem), mine = base + (slice < rem ? 1 : 0);
        u.kb = 2 * start; u.nk = 2 * mine; u.tinfo = (tj << 8) | (slice << 4) | ns; return true;
    }
};
struct TailCtx { f32x4* slab; unsigned* cnt; };

template <class Epi>
__device__ __forceinline__ void tail_fixup(f32x4 (&acc)[2][2][4][2], const Unit& u, const Epi& E, const TailCtx& T, int tid, int wr, int wc, int fr, int fq) {
    const int tj = u.tinfo >> 8, slice = (u.tinfo >> 4) & 15, ns = u.tinfo & 15;
    const __amdgpu_buffer_rsrc_t srs = __builtin_amdgcn_make_buffer_rsrc((void*)(T.slab + (size_t)(tj * ns + slice) * (32 * 512)), (short)0, 32 * 512 * 16, 0x00020000);
#pragma unroll
    for (int ai = 0; ai < 2; ++ai)
#pragma unroll
        for (int bj = 0; bj < 2; ++bj)
#pragma unroll
            for (int m = 0; m < 4; ++m)
#pragma unroll
                for (int n = 0; n < 2; ++n) __builtin_amdgcn_raw_buffer_store_b128(__builtin_bit_cast(u32x4, acc[ai][bj][m][n]), srs, (unsigned)(((((ai * 2 + bj) * 4 + m) * 2 + n) * 512 + tid) * 16), 0, 16);
    asm volatile("s_waitcnt vmcnt(0)" ::: "memory");
    __syncthreads();
    if (tid == 0) __hip_atomic_fetch_add(T.cnt + 64 * tj, 1u, __ATOMIC_RELAXED, __HIP_MEMORY_SCOPE_AGENT);
    if (tid < 64) {
        unsigned sp = 0;
        while (__hip_atomic_load(T.cnt + 64 * tj, __ATOMIC_RELAXED, __HIP_MEMORY_SCOPE_AGENT) < (unsigned)ns && ++sp < (1u << 22)) __builtin_amdgcn_s_sleep(2);
        __builtin_amdgcn_fence(__ATOMIC_ACQUIRE, "agent");
        asm volatile("s_waitcnt vmcnt(0)" ::: "memory");
    }
    __syncthreads();
    unsigned gmask = 0u;
    for (int g = slice; g < 8; g += ns) gmask |= 1u << g;
    const f32x4* tile = T.slab + (size_t)(tj * ns) * (32 * 512);
#pragma unroll
    for (int ai = 0; ai < 2; ++ai)
#pragma unroll
        for (int m = 0; m < 4; ++m) {
            if (!((gmask >> (ai * 4 + m)) & 1u)) continue;
#pragma unroll
            for (int bj = 0; bj < 2; ++bj)
#pragma unroll
                for (int n = 0; n < 2; ++n) {
                    const int idx = ((ai * 2 + bj) * 4 + m) * 2 + n;
                    f32x4 v = tile[idx * 512 + tid];
                    for (int sl = 1; sl < ns; ++sl) v = v + tile[(size_t)sl * (32 * 512) + idx * 512 + tid];
                    acc[ai][bj][m][n] = v;
                }
        }
    E(acc, u, wr, wc, fr, fq, gmask);
}

template <class Epi, class Sched>
__device__ __forceinline__ void gemm_phase2(PG8_LAS unsigned char* lds, const Gemm g, const Sched& S, const Epi& E, const TailCtx& T) {
    int tid_ = threadIdx.x; asm volatile("" : "+v"(tid_));
    const int tid = tid_, wid = __builtin_amdgcn_readfirstlane(tid >> 6), lane = tid & 63, wr = wid >> 2, wc = wid & 3, fr = lane & 15, fq = lane >> 4;
    const int K = g.K;
    unsigned voffA[2], voffB[2];
#pragma unroll
    for (int i = 0; i < 2; ++i) { int R, C; stage_rc(tid * 16 + i * 8192, R, C); const int Rb = Epi::PERM ? ((R & ~31) + perm32(R & 31)) : R;
        voffA[i] = (unsigned)(R * K + C) * 2u; voffB[i] = (unsigned)(Rb * K + C) * 2u; }
    const size_t kstep = (size_t)(BK * 2), hstep = (size_t)HALF * K * 2, tstep = 2 * hstep;
    const unsigned ldsw = (unsigned)wid * 1024u;
    const int aoff = lds_byte(wr * 64 + fr, fq * 8), boff = lds_byte(wc * 32 + fr, fq * 8);
#define PG8_SA(b, h) (((b) * 2 + (h)) * HTB)
#define PG8_SB(b, h) ((4 + (b) * 2 + (h)) * HTB)
#define PG8_STAGE(bufoff, gbase, voff) do { _Pragma("unroll") for (int _i = 0; _i < 2; ++_i) \
        __builtin_amdgcn_global_load_lds((const unsigned*)((const char*)(gbase) + (voff)[_i]), (PG8_LAS unsigned*)(lds + (bufoff) + ldsw + _i * 8192), 16, 0, 0); } while (0)
#define PG8_LDA(dst, b, h) do { _Pragma("unroll") for (int m = 0; m < 4; ++m) _Pragma("unroll") for (int k = 0; k < 2; ++k) dst[m][k] = *(const PG8_LAS bf16x8*)(lds + PG8_SA(b, h) + aoff + m * 2048 + k * 1024); } while (0)
#define PG8_LDB(dst, b, h) do { _Pragma("unroll") for (int n = 0; n < 2; ++n) _Pragma("unroll") for (int k = 0; k < 2; ++k) dst[n][k] = *(const PG8_LAS bf16x8*)(lds + PG8_SB(b, h) + boff + n * 2048 + k * 1024); } while (0)
#define PG8_MMA(ai, bj, At, Bt) do { __builtin_amdgcn_s_setprio(1); _Pragma("unroll") for (int m = 0; m < 4; ++m) _Pragma("unroll") for (int n = 0; n < 2; ++n) _Pragma("unroll") for (int k = 0; k < 2; ++k) \
        acc[ai][bj][m][n] = __builtin_amdgcn_mfma_f32_16x16x32_bf16(Bt[n][k], At[m][k], acc[ai][bj][m][n], 0, 0, 0); __builtin_amdgcn_s_setprio(0); } while (0)
#define PG8_WAIT_V(n) asm volatile("s_waitcnt vmcnt(" #n ")" ::: "memory")
#define PG8_WAIT_L(n) asm volatile("s_waitcnt lgkmcnt(" #n ")" ::: "memory")
#define PG8_BAR __builtin_amdgcn_s_barrier()
#define PG8_SCHED __builtin_amdgcn_sched_barrier(0)
    Unit cur, nxt; int ui = 0;
    if (!S.next(0, cur)) return;
    f32x4 acc[2][2][4][2];
#pragma unroll
    for (int a = 0; a < 2; ++a)
#pragma unroll
        for (int b = 0; b < 2; ++b)
#pragma unroll
            for (int m = 0; m < 4; ++m)
#pragma unroll
                for (int n = 0; n < 2; ++n) acc[a][b][m][n] = (f32x4){0.f, 0.f, 0.f, 0.f};
    bf16x8 At[4][2], B0[2][2], B1[2][2];
    const char* cA = (const char*)g.A + (size_t)cur.pm * tstep + (size_t)cur.kb * kstep; const char* cB = (const char*)g.Bt + (size_t)cur.pn * tstep + (size_t)cur.kb * kstep;
    PG8_STAGE(PG8_SB(0, 0), cB, voffB); PG8_STAGE(PG8_SB(0, 1), cB + hstep, voffB); PG8_STAGE(PG8_SA(0, 0), cA, voffA); PG8_STAGE(PG8_SA(0, 1), cA + hstep, voffA);
    if (wr == 1) PG8_BAR;
    PG8_WAIT_V(2); PG8_BAR;
    PG8_STAGE(PG8_SB(1, 0), cB + kstep, voffB); PG8_STAGE(PG8_SA(1, 0), cA + kstep, voffA); PG8_STAGE(PG8_SB(1, 1), cB + hstep + kstep, voffB);
    PG8_WAIT_V(6); PG8_BAR;
    for (;;) {
        const bool has_next = S.next(ui + 1, nxt);
        const char* nA = has_next ? (const char*)g.A + (size_t)nxt.pm * tstep + (size_t)nxt.kb * kstep : cA; const char* nB = has_next ? (const char*)g.Bt + (size_t)nxt.pn * tstep + (size_t)nxt.kb * kstep : cB;
        const int nt = cur.nk;
        for (int t = 0; t < nt; t += 2) {
            const bool last = (t == nt - 2);
            const char* a1 = cA + (size_t)(t + 1) * kstep;
            const char* a2 = last ? nA : cA + (size_t)(t + 2) * kstep; const char* b2 = last ? nB : cB + (size_t)(t + 2) * kstep;
            const char* a3 = a2 + kstep; const char* b3 = b2 + kstep;
            PG8_LDB(B0, 0, 0); PG8_LDB(B1, 0, 1); PG8_SCHED; PG8_LDA(At, 0, 0); PG8_STAGE(PG8_SA(1, 1), a1 + hstep, voffA);
            PG8_WAIT_V(8); PG8_WAIT_L(0); PG8_BAR; PG8_MMA(0, 0, At, B0); PG8_MMA(0, 1, At, B1); PG8_BAR; PG8_SCHED;
            PG8_LDA(At, 0, 1); PG8_STAGE(PG8_SB(0, 0), b2, voffB); PG8_STAGE(PG8_SB(0, 1), b2 + hstep, voffB); PG8_STAGE(PG8_SA(0, 0), a2, voffA);
            PG8_WAIT_V(8); PG8_WAIT_L(0); PG8_BAR; PG8_MMA(1, 0, At, B0); PG8_MMA(1, 1, At, B1); PG8_BAR; PG8_SCHED;
            PG8_LDB(B0, 1, 0); PG8_LDB(B1, 1, 1); PG8_SCHED; PG8_LDA(At, 1, 0); PG8_STAGE(PG8_SA(0, 1), a2 + hstep, voffA);
            PG8_WAIT_V(8); PG8_WAIT_L(0); PG8_BAR; PG8_MMA(0, 0, At, B0); PG8_MMA(0, 1, At, B1); PG8_BAR; PG8_SCHED;
            PG8_LDA(At, 1, 1); PG8_STAGE(PG8_SB(1, 0), b3, voffB); PG8_STAGE(PG8_SB(1, 1), b3 + hstep, voffB); PG8_STAGE(PG8_SA(1, 0), a3, voffA);
            PG8_WAIT_V(8); PG8_WAIT_L(0); PG8_BAR; PG8_MMA(1, 0, At, B0); PG8_MMA(1, 1, At, B1); PG8_BAR; PG8_SCHED;
        }
        if (wr == 0) PG8_BAR;
        if (cur.tinfo < 0) E(acc, cur, wr, wc, fr, fq);
        if (!has_next) break;
#pragma unroll
        for (int a = 0; a < 2; ++a)
#pragma unroll
            for (int b = 0; b < 2; ++b)
#pragma unroll
                for (int m = 0; m < 4; ++m)
#pragma unroll
                    for (int n = 0; n < 2; ++n) acc[a][b][m][n] = (f32x4){0.f, 0.f, 0.f, 0.f};
        cur = nxt; cA = nA; cB = nB; ++ui;
        if (wr == 1) PG8_BAR;
    }
    PG8_WAIT_V(0);
    PG8_BAR;
    if (cur.tinfo >= 0) tail_fixup(acc, cur, E, T, tid, wr, wc, fr, fq);
#undef PG8_SA
#undef PG8_SB
#undef PG8_STAGE
#undef PG8_LDA
#undef PG8_LDB
#undef PG8_MMA
#undef PG8_WAIT_V
#undef PG8_WAIT_L
#undef PG8_BAR
#undef PG8_SCHED
}

struct MUnit { int kind, pm, pn, kb, nk, tinfo; };
struct MOrder {
    int c;
    __device__ __forceinline__ bool next(int i, MUnit& u) const {
        const int j = i * 256 + c;
        u.kb = 0; u.tinfo = -1;
        if (j < 288) { u.kind = 0; u.nk = D / BK;
            if (j < 256) { const int x = j & 7, r = j >> 3; u.pm = 4 * x + (r >> 3); u.pn = r & 7; } else { const int t = j - 256; u.pm = 32 + (t >> 3); u.pn = t & 7; }
            return true; }
        if (j < 1872) { u.kind = 1; u.nk = D / BK; const int L = j - 288;
            if (L < 1408) { const int x = L & 7, off = L >> 3, wg = x * 176 + off, gid = wg / 352, rem = wg % 352; u.pm = gid * 8 + (rem & 7); u.pn = rem >> 3; }
            else { const int t = L - 1408; u.pm = 32 + (t & 3); u.pn = t >> 2; }
            return true; }
        if (j < 2128) { u.kind = 2; u.nk = DFF / BK; const int L = j - 1872, x = L & 7, r = L >> 3; u.pm = 4 * x + (r >> 3); u.pn = r & 7; return true; }
        const int ilast = (c < 80) ? 9 : 8;
        if (i != ilast || c < 80 || c >= 208) return false;
        const int mi = c - 80, tj = mi >> 2, slice = mi & 3;
        u.kind = 2; u.pm = 32 + (tj >> 3); u.pn = tj & 7; u.kb = slice * 22; u.nk = 22; u.tinfo = (tj << 8) | (slice << 4) | 4; return true;
    }
};

struct StreamOff { size_t A0, B0, A1, B1, A2, B2, x2b, slab; int dep3, dep4, tail, rsq2, rsq3; };
template <class SO>
__device__ __forceinline__ void gemm_stream(PG8_LAS unsigned char* lds, const MOrder& S, unsigned char* ws, const float* xp, const float* xs, const SO O) {
    int tid_ = threadIdx.x; asm volatile("" : "+v"(tid_));
    const int tid = tid_, wid = __builtin_amdgcn_readfirstlane(tid >> 6), lane = tid & 63, wr = wid >> 2, wc = wid & 3, fr = lane & 15, fq = lane >> 4;
    unsigned Ra[2][2], Rb[2][2];
#pragma unroll
    for (int i = 0; i < 2; ++i) { int R, C; stage_rc(tid * 16 + i * 8192, R, C); const int Rp = (R & ~31) + perm32(R & 31);
        Ra[0][i] = (unsigned)(R * D + C) * 2u; Ra[1][i] = (unsigned)(R * DFF + C) * 2u; Rb[0][i] = (unsigned)(Rp * D + C) * 2u; Rb[1][i] = (unsigned)(Rp * DFF + C) * 2u; }
    const size_t kstep = (size_t)(BK * 2);
    const unsigned ldsw = (unsigned)wid * 1024u;
    const int aoff = lds_byte(wr * 64 + fr, fq * 8), boff = lds_byte(wc * 32 + fr, fq * 8);
#define PG8_SA(b, h) (((b) * 2 + (h)) * HTB)
#define PG8_SB(b, h) ((4 + (b) * 2 + (h)) * HTB)
#define PG8_STG(bufoff, gbase, Rr, rowb) do { _Pragma("unroll") for (int _i = 0; _i < 2; ++_i) \
        __builtin_amdgcn_global_load_lds((const unsigned*)((const char*)(gbase) + ((rowb) == D * 2 ? (Rr)[0][_i] : (Rr)[1][_i])), (PG8_LAS unsigned*)(lds + (bufoff) + ldsw + _i * 8192), 16, 0, 0); } while (0)
#define PG8_LDA(dst, b, h) do { _Pragma("unroll") for (int m = 0; m < 4; ++m) _Pragma("unroll") for (int k = 0; k < 2; ++k) dst[m][k] = *(const PG8_LAS bf16x8*)(lds + PG8_SA(b, h) + aoff + m * 2048 + k * 1024); } while (0)
#define PG8_LDB(dst, b, h) do { _Pragma("unroll") for (int n = 0; n < 2; ++n) _Pragma("unroll") for (int k = 0; k < 2; ++k) dst[n][k] = *(const PG8_LAS bf16x8*)(lds + PG8_SB(b, h) + boff + n * 2048 + k * 1024); } while (0)
#define PG8_MMA(ai, bj, At, Bt) do { __builtin_amdgcn_s_setprio(1); _Pragma("unroll") for (int m = 0; m < 4; ++m) _Pragma("unroll") for (int n = 0; n < 2; ++n) _Pragma("unroll") for (int k = 0; k < 2; ++k) \
        acc[ai][bj][m][n] = __builtin_amdgcn_mfma_f32_16x16x32_bf16(Bt[n][k], At[m][k], acc[ai][bj][m][n], 0, 0, 0); __builtin_amdgcn_s_setprio(0); } while (0)
#define PG8_WAIT_V(n) asm volatile("s_waitcnt vmcnt(" #n ")" ::: "memory")
#define PG8_WAIT_L(n) asm volatile("s_waitcnt lgkmcnt(" #n ")" ::: "memory")
#define PG8_BAR __builtin_amdgcn_s_barrier()
#define PG8_SCHED __builtin_amdgcn_sched_barrier(0)
#define MU_A(u) ((const char*)ws + ((u).kind == 0 ? O.A0 : (u).kind == 1 ? O.A1 : O.A2) + (size_t)(u).pm * 256 * MU_RB(u) + (size_t)(u).kb * kstep)
#define MU_B(u) ((const char*)ws + ((u).kind == 0 ? O.B0 : (u).kind == 1 ? O.B1 : O.B2) + (size_t)(u).pn * 256 * MU_RB(u) + (size_t)(u).kb * kstep)
#define MU_RB(u) ((u).kind == 2 ? DFF * 2 : D * 2)
    unsigned long long rdy3 = 0ull, rdy4 = 0ull;
#define MU_READY(u) do { if ((u).kind != 0) { unsigned long long& _m = (u).kind == 1 ? rdy3 : rdy4; if (!((_m >> (u).pm) & 1ull)) { \
        if (wid == 0) { unsigned* _c = (unsigned*)ws + ((u).kind == 1 ? O.dep3 : O.dep4) + 64 * (u).pm; const unsigned _t = (u).kind == 1 ? 64u : 352u; unsigned _sp = 0; \
            while (__hip_atomic_load(_c, __ATOMIC_RELAXED, __HIP_MEMORY_SCOPE_AGENT) < _t && ++_sp < (1u << 22)) __builtin_amdgcn_s_sleep(2); \
            __builtin_amdgcn_fence(__ATOMIC_ACQUIRE, "agent"); asm volatile("s_waitcnt vmcnt(0)" ::: "memory"); } \
        asm volatile("" ::: "memory"); PG8_BAR; asm volatile("" ::: "memory"); _m |= 1ull << (u).pm; } } } while (0)
    PG8_LAS unsigned* vflag = (PG8_LAS unsigned*)(lds + 147456 - 256 + 64);
#define MU_TRY(u, ok) do { ok = true; if ((u).kind != 0) { unsigned long long& _m = (u).kind == 1 ? rdy3 : rdy4; if (!((_m >> (u).pm) & 1ull)) { \
        if (wid == 0) { unsigned* _c = (unsigned*)ws + ((u).kind == 1 ? O.dep3 : O.dep4) + 64 * (u).pm; const unsigned _t = (u).kind == 1 ? 64u : 352u; \
            const bool _r = __hip_atomic_load(_c, __ATOMIC_RELAXED, __HIP_MEMORY_SCOPE_AGENT) >= _t; \
            if (_r) { __builtin_amdgcn_fence(__ATOMIC_ACQUIRE, "agent"); asm volatile("s_waitcnt vmcnt(0)" ::: "memory"); } \
            if (lane == 0) *vflag = _r ? 1u : 0u; asm volatile("s_waitcnt lgkmcnt(0)" ::: "memory"); } \
        asm volatile("" ::: "memory"); PG8_BAR; asm volatile("" ::: "memory"); \
        ok = (*(volatile PG8_LAS unsigned*)vflag) != 0u; if (ok) _m |= 1ull << (u).pm; } } } while (0)
    MUnit cur, nxt; int ui = 0;
    if (!S.next(0, cur)) return;
    f32x4 acc[2][2][4][2];
#pragma unroll
    for (int a = 0; a < 2; ++a)
#pragma unroll
        for (int b = 0; b < 2; ++b)
#pragma unroll
            for (int m = 0; m < 4; ++m)
#pragma unroll
                for (int n = 0; n < 2; ++n) acc[a][b][m][n] = (f32x4){0.f, 0.f, 0.f, 0.f};
    bf16x8 At[4][2], B0[2][2], B1[2][2];
    bool more = true;
    while (more) {
#ifdef TPROBE
    if (threadIdx.x == 0 && cur.tinfo >= 0) ((volatile PG8_LAS unsigned long long*)(lds + 147456 - 256 + 128))[10] = __builtin_amdgcn_s_memrealtime();
#endif
    MU_READY(cur);
    const char* cA = MU_A(cur); const char* cB = MU_B(cur); int crb = MU_RB(cur);
    PG8_STG(PG8_SB(0, 0), cB, Rb, crb); PG8_STG(PG8_SB(0, 1), cB + (size_t)HALF * crb, Rb, crb); PG8_STG(PG8_SA(0, 0), cA, Ra, crb); PG8_STG(PG8_SA(0, 1), cA + (size_t)HALF * crb, Ra, crb);
    if (wr == 1) PG8_BAR;
    PG8_WAIT_V(2); PG8_BAR;
    PG8_STG(PG8_SB(1, 0), cB + kstep, Rb, crb); PG8_STG(PG8_SA(1, 0), cA + kstep, Ra, crb); PG8_STG(PG8_SB(1, 1), cB + (size_t)HALF * crb + kstep, Rb, crb);
    PG8_WAIT_V(6); PG8_BAR;
    for (;;) {
        const bool has_next = S.next(ui + 1, nxt);
        bool chain = has_next;
        const char* nA = cA; const char* nB = cB; int nrb = crb;
        const int nt = cur.nk;
        for (int t = 0; t < nt; t += 2) {
            const bool last = (t == nt - 2);
            if (last && has_next) { MU_TRY(nxt, chain); if (chain) { nA = MU_A(nxt); nB = MU_B(nxt); nrb = MU_RB(nxt); } }
            const char* a1 = cA + (size_t)(t + 1) * kstep;
            const char* a2 = last ? nA : cA + (size_t)(t + 2) * kstep; const char* b2 = last ? nB : cB + (size_t)(t + 2) * kstep; const int rb2 = last ? nrb : crb;
            const char* a3 = a2 + kstep; const char* b3 = b2 + kstep;
            const size_t h1 = (size_t)HALF * crb, h2 = (size_t)HALF * rb2;
            PG8_LDB(B0, 0, 0); PG8_LDB(B1, 0, 1); PG8_SCHED; PG8_LDA(At, 0, 0); PG8_STG(PG8_SA(1, 1), a1 + h1, Ra, crb);
            PG8_WAIT_V(8); PG8_WAIT_L(0); PG8_BAR; PG8_MMA(0, 0, At, B0); PG8_MMA(0, 1, At, B1); PG8_BAR; PG8_SCHED;
            PG8_LDA(At, 0, 1); PG8_STG(PG8_SB(0, 0), b2, Rb, rb2); PG8_STG(PG8_SB(0, 1), b2 + h2, Rb, rb2); PG8_STG(PG8_SA(0, 0), a2, Ra, rb2);
            PG8_WAIT_V(8); PG8_WAIT_L(0); PG8_BAR; PG8_MMA(1, 0, At, B0); PG8_MMA(1, 1, At, B1); PG8_BAR; PG8_SCHED;
            PG8_LDB(B0, 1, 0); PG8_LDB(B1, 1, 1); PG8_SCHED; PG8_LDA(At, 1, 0); PG8_STG(PG8_SA(0, 1), a2 + h2, Ra, rb2);
            PG8_WAIT_V(8); PG8_WAIT_L(0); PG8_BAR; PG8_MMA(0, 0, At, B0); PG8_MMA(0, 1, At, B1); PG8_BAR; PG8_SCHED;
            PG8_LDA(At, 1, 1); PG8_STG(PG8_SB(1, 0), b3, Rb, rb2); PG8_STG(PG8_SB(1, 1), b3 + h2, Rb, rb2); PG8_STG(PG8_SA(1, 0), a3, Ra, rb2);
            PG8_WAIT_V(8); PG8_WAIT_L(0); PG8_BAR; PG8_MMA(1, 0, At, B0); PG8_MMA(1, 1, At, B1); PG8_BAR; PG8_SCHED;
        }
        if (wr == 0) PG8_BAR;
        if (cur.tinfo < 0) {
            const Unit u{cur.pm, cur.pn, 0, 0, -1};
            if (cur.kind == 0) { const EpiX1<false> E0{xp, xs, nullptr, (bf16_t*)(ws + O.A1), (float*)ws + O.rsq2, true}; E0(acc, u, wr, wc, fr, fq); }
            else if (cur.kind == 1) { const EpiAct E1{(bf16_t*)(ws + O.A2), (const float*)ws + O.rsq2, true}; E1(acc, u, wr, wc, fr, fq); }
            else { const EpiX2<false> E2{(bf16_t*)(ws + O.x2b), (float*)ws + O.rsq3, (const bf16_t*)(ws + O.A1)}; E2(acc, u, wr, wc, fr, fq); }
            if (cur.kind != 2) {
                asm volatile("s_waitcnt vmcnt(0)" ::: "memory");
                if (lane == 0) __hip_atomic_fetch_add((unsigned*)ws + (cur.kind == 0 ? O.dep3 : O.dep4) + 64 * cur.pm, 1u, __ATOMIC_RELAXED, __HIP_MEMORY_SCOPE_AGENT);
            }
        }
        if (!has_next) { more = false; break; }
        if (!chain) {
            PG8_WAIT_V(0); PG8_BAR;
#pragma unroll
            for (int a = 0; a < 2; ++a)
#pragma unroll
                for (int b = 0; b < 2; ++b)
#pragma unroll
                    for (int m = 0; m < 4; ++m)
#pragma unroll
                        for (int n = 0; n < 2; ++n) acc[a][b][m][n] = (f32x4){0.f, 0.f, 0.f, 0.f};
            cur = nxt; ++ui;
            break;
        }
#pragma unroll
        for (int a = 0; a < 2; ++a)
#pragma unroll
            for (int b = 0; b < 2; ++b)
#pragma unroll
                for (int m = 0; m < 4; ++m)
#pragma unroll
                    for (int n = 0; n < 2; ++n) acc[a][b][m][n] = (f32x4){0.f, 0.f, 0.f, 0.f};
        cur = nxt; cA = nA; cB = nB; crb = nrb; ++ui;
        if (wr == 1) PG8_BAR;
    }
    }
    PG8_WAIT_V(0);
    PG8_BAR;
#ifdef TPROBE
    if (threadIdx.x == 0) ((volatile PG8_LAS unsigned long long*)(lds + 147456 - 256 + 128))[9] = __builtin_amdgcn_s_memrealtime();
#endif
    if (cur.tinfo >= 0) { const Unit u{cur.pm, cur.pn, cur.kb, cur.nk, cur.tinfo}; const EpiX2<false> E2{(bf16_t*)(ws + O.x2b), (float*)ws + O.rsq3, (const bf16_t*)(ws + O.A1)};
        const TailCtx T{(f32x4*)(ws + O.slab), (unsigned*)ws + O.tail}; tail_fixup(acc, u, E2, T, tid, wr, wc, fr, fq); }
#undef MU_TRY
#undef MU_A
#undef MU_B
#undef MU_RB
#undef MU_READY
#undef PG8_SA
#undef PG8_SB
#undef PG8_STG
#undef PG8_LDA
#undef PG8_LDB
#undef PG8_MMA
#undef PG8_WAIT_V
#undef PG8_WAIT_L
#undef PG8_BAR
#undef PG8_SCHED
}
}
#define LAS __attribute__((address_space(3)))
typedef unsigned short bf16;
using pg8::f32x4; using pg8::u32x4; using pg8::u32x2; using pg8::bf16x8; using pg8::cvt_pk_bf16;

#ifndef ONE_LAUNCH
#define ONE_LAUNCH 1
#endif
constexpr int NWAVES = 8, NPHASE = 7;
constexpr int LDS_BYTES = 147456;
constexpr size_t MiB = 1u << 20;
constexpr size_t WS_CTL = 0, CTL_ZERO_BYTES = 1 * MiB;
constexpr size_t WS_WIN = 1 * MiB;
constexpr size_t WS_WO = 21 * MiB;
constexpr size_t WS_WGU = 29 * MiB;
constexpr size_t WS_WD = 73 * MiB;
constexpr size_t WS_WP = 95 * MiB;
constexpr size_t WS_MISC = 96 * MiB;
constexpr size_t WS_XB = 97 * MiB;
constexpr size_t WS_ZB = 133 * MiB;
constexpr size_t WS_LF = 223 * MiB;
constexpr size_t WS_ACT = WS_ZB;
constexpr size_t WS_MIX = 259 * MiB;
constexpr size_t WS_X2B = WS_WGU;
constexpr size_t WS_END = 328 * MiB;
constexpr int CW_RSQ2 = 4096, CW_RSQ3 = 4096 + M;
constexpr int CW_TAIL = 100000;
constexpr size_t WS_SLAB3 = WS_ACT, WS_SLAB45 = 232 * MiB;
constexpr int CW_DEP = 124000;
constexpr size_t WS_SLABM = 296 * MiB;
#ifndef MERGED
#define MERGED 1
#endif
constexpr int CW_BAR = 65536;
constexpr int MISC_OFF = 147456 - 256;
#ifndef USE_CG
#define USE_CG 0
#endif

__device__ __forceinline__ float wave_sum(float v) {
#pragma unroll
    for (int o = 1; o < 64; o <<= 1) v += __shfl_xor(v, o);
    return v;
}
__device__ __forceinline__ float bflo(unsigned w) { return __builtin_bit_cast(float, w << 16); }
__device__ __forceinline__ float bfhi(unsigned w) { return __builtin_bit_cast(float, w & 0xffff0000u); }
__device__ __forceinline__ float bf2f(bf16 b) { return __builtin_bit_cast(float, (unsigned)b << 16); }
__device__ __forceinline__ bf16 f2bf(float f) { unsigned u = __builtin_bit_cast(unsigned, f); return (bf16)((u + 0x7fffu + ((u >> 16) & 1u)) >> 16); }

#define XB_TMO      128
#define XB_XCNT(j)  (256  + 64 * (j))
#define XB_XSUB(j)  (1280 + 64 * (j))
#define XB_XGEN(j)  (2304 + 64 * (j))
#define XB_TOP      3328
#define XB_TOPGEN   3392
#define XCD_BAR_WORDS 3456
#define XB_SPIN_CAP (1u << 18)

__device__ __forceinline__ unsigned xb_ld(unsigned* p)              { return __hip_atomic_load(p, __ATOMIC_RELAXED, __HIP_MEMORY_SCOPE_AGENT); }
__device__ __forceinline__ unsigned xb_add(unsigned* p, unsigned v) { return __hip_atomic_fetch_add(p, v, __ATOMIC_RELAXED, __HIP_MEMORY_SCOPE_AGENT); }
__device__ __forceinline__ unsigned xb_xcc_id() { return (unsigned)__builtin_amdgcn_s_getreg((3 << 11) | 20) & 0xFu; }
#define XB_SPIN(cond, bar) do { unsigned _sp = 0; while (cond) { __builtin_amdgcn_s_sleep(1); \
    if ((++_sp & 255u) == 0u) { if (xb_ld(&(bar)[XB_TMO])) break; if (_sp > XB_SPIN_CAP) { atomicAdd(&(bar)[XB_TMO], 1u); break; } } } } while (0)

struct XcdBarrier {
    unsigned* bar; unsigned x;
    volatile LAS unsigned* st;
};

__device__ __forceinline__ XcdBarrier xcd_barrier_post(unsigned* bar, volatile LAS unsigned* st) {
    XcdBarrier b; b.bar = bar; b.x = xb_xcc_id(); b.st = st;
    if (threadIdx.x == 0) (void)xb_add(&bar[XB_XCNT(b.x)], 1u);
    return b;
}
__device__ __forceinline__ void xcd_barrier_complete(unsigned* bar, unsigned x, unsigned& nloc, unsigned& nx) {
    const unsigned G = gridDim.x * gridDim.y * gridDim.z;
    unsigned sum, cnt, mine, sp = 0u;
    for (;;) {
        sum = 0u; cnt = 0u; mine = 0u;
#pragma unroll
        for (unsigned j = 0; j < 16; ++j) { const unsigned c = xb_ld(&bar[XB_XCNT(j)]); sum += c; cnt += (c > 0u) ? 1u : 0u; mine = (j == x) ? c : mine; }
        if (sum == G) break;
        __builtin_amdgcn_s_sleep(1);
        if ((++sp & 255u) == 0u) { if (xb_ld(&bar[XB_TMO])) break; if (sp > XB_SPIN_CAP) { atomicAdd(&bar[XB_TMO], 1u); break; } }
    }
    nloc = mine > 0u ? mine : 1u; nx = cnt > 0u ? cnt : 1u;
}

__device__ __forceinline__ void xcd_barrier(const XcdBarrier& b) {
    asm volatile("s_waitcnt vmcnt(0)" ::: "memory");
    __syncthreads();
    if (threadIdx.x == 0) {
        unsigned* bar = b.bar;
        __builtin_amdgcn_s_waitcnt(0);
        unsigned nloc = b.st[0], nx = b.st[1];
        if (nloc == 0u) { xcd_barrier_complete(bar, b.x, nloc, nx); b.st[0] = nloc; b.st[1] = nx; }
        const unsigned old = xb_add(&bar[XB_XSUB(b.x)], 1u);
        const unsigned gen = old / nloc;
        if (old + 1u == (gen + 1u) * nloc) {
            __builtin_amdgcn_fence(__ATOMIC_RELEASE, "agent");
            asm volatile("s_waitcnt vmcnt(0)" ::: "memory");
            const unsigned og = xb_add(&bar[XB_TOP], 1u);
            const unsigned tg = og / nx;
            if (og + 1u == (tg + 1u) * nx) xb_add(&bar[XB_TOPGEN], 1u);
            else XB_SPIN(xb_ld(&bar[XB_TOPGEN]) == tg, bar);
            __builtin_amdgcn_fence(__ATOMIC_ACQUIRE, "agent");
            xb_add(&bar[XB_XGEN(b.x)], 1u);
            asm volatile("s_waitcnt vmcnt(0)" ::: "memory");
        } else {
            XB_SPIN(xb_ld(&bar[XB_XGEN(b.x)]) == gen, bar);
            __builtin_amdgcn_fence(__ATOMIC_ACQUIRE, "agent");
            asm volatile("s_waitcnt vmcnt(0)" ::: "memory");
        }
    }
    __syncthreads();
}


#ifdef TPROBE
#define STAMP(i) do { if (threadIdx.x == 0) ((volatile LAS unsigned long long*)(lds + MISC_OFF + 128))[i] = __builtin_amdgcn_s_memrealtime(); } while (0)
#else
#define STAMP(i) do {} while (0)
#endif
constexpr int CW_TP = 120000;

struct Args { const float* in[16]; float* out; unsigned char* ws; int ph_lo, ph_hi; };

__device__ __forceinline__ void p0_item(const float* W, int K, int N, bf16* WT, int mode, const float* sk, const float* sn, LAS float* scr, int item, int lane) {
    const int nblk = N / 64, kb = item / nblk, nb = item % nblk, k0 = 64 * kb, n0 = 64 * nb;
    const int drow0 = mode == 0 ? n0 : ((n0 >> 7) * 256 + (n0 & 127) + (mode == 2 ? 128 : 0));
    const int r = lane >> 4, c4 = lane & 15;
    f32x4 v[16];
#pragma unroll
    for (int i = 0; i < 16; ++i) v[i] = *(const f32x4*)(W + (size_t)(k0 + 4 * i + r) * N + n0 + 4 * c4);
    if (sk) {
#pragma unroll
        for (int i = 0; i < 16; ++i) v[i] = v[i] * sk[k0 + 4 * i + r];
    }
#pragma unroll
    for (int i = 0; i < 16; ++i) { LAS float* d = scr + (4 * i + r) * 65 + 4 * c4; d[0] = v[i][0]; d[1] = v[i][1]; d[2] = v[i][2]; d[3] = v[i][3]; }
    asm volatile("s_waitcnt lgkmcnt(0)" ::: "memory");
    const int c = lane & 7, nn = lane >> 3;
#pragma unroll
    for (int j = 0; j < 8; ++j) { const int n = nn + 8 * j; const LAS float* s = scr + (8 * c) * 65 + n; const float f = sn ? sn[n0 + n] : 1.f;
        u32x4 o; o.x = cvt_pk_bf16(s[0 * 65] * f, s[1 * 65] * f); o.y = cvt_pk_bf16(s[2 * 65] * f, s[3 * 65] * f); o.z = cvt_pk_bf16(s[4 * 65] * f, s[5 * 65] * f); o.w = cvt_pk_bf16(s[6 * 65] * f, s[7 * 65] * f);
        *(u32x4*)(WT + (size_t)(drow0 + n) * K + k0 + 8 * c) = o; }
    asm volatile("s_waitcnt lgkmcnt(0)" ::: "memory");
}

__device__ __forceinline__ void phase0(LAS unsigned char* lds, const Args& a, int vcu, int G) {
    const int tid = threadIdx.x, lane = tid & 63, wave = tid >> 6;
    unsigned char* ws = a.ws;
    LAS float* scr = (LAS float*)(lds + wave * 16640);
    const int gw = vcu * NWAVES + wave, NGW = G * NWAVES;
    constexpr int I_IN = (D / 64) * (INC / 64), I_O = (D / 64) * (D / 64), I_G = (D / 64) * (DFF / 64), I_D = (DFF / 64) * (D / 64), I_P = (256 / 64) * (256 / 64);
    constexpr int NITEMS = I_IN + I_O + 2 * I_G + I_D + 4 * I_P;
    for (int it = gw; it < NITEMS; it += NGW) {
        int r = it;
        if (r < I_IN) { p0_item(a.in[6], D, INC, (bf16*)(ws + WS_WIN), 0, a.in[5], nullptr, scr, r, lane); continue; } r -= I_IN;
        if (r < I_O) { p0_item(a.in[10], D, D, (bf16*)(ws + WS_WO), 0, nullptr, nullptr, scr, r, lane); continue; } r -= I_O;
        if (r < I_G) { p0_item(a.in[12], D, DFF, (bf16*)(ws + WS_WGU), 1, a.in[11], nullptr, scr, r, lane); continue; } r -= I_G;
        if (r < I_G) { p0_item(a.in[13], D, DFF, (bf16*)(ws + WS_WGU), 2, a.in[11], nullptr, scr, r, lane); continue; } r -= I_G;
        if (r < I_D) { p0_item(a.in[14], DFF, D, (bf16*)(ws + WS_WD), 0, nullptr, nullptr, scr, r, lane); continue; } r -= I_D;
        { const int g = r / I_P; p0_item(a.in[7] + (size_t)g * 65536, 256, 256, (bf16*)(ws + WS_WP) + (size_t)g * 65536, 0, nullptr, a.in[8] + g * 256, scr, r % I_P, lane); }
    }
    float* rstd1 = (float*)(ws + WS_MISC); bf16* xb = (bf16*)(ws + WS_XB);
    for (int m = gw; m < M; m += NGW) {
        const float* xrow = m < MP ? a.in[0] + (size_t)m * D : a.in[1] + (size_t)(m - MP) * D;
        f32x4 v[8]; float s = 0.f;
#pragma unroll
        for (int j = 0; j < 8; ++j) { v[j] = ((const f32x4*)xrow)[lane + 64 * j]; s += (v[j][0] * v[j][0] + v[j][1] * v[j][1]) + (v[j][2] * v[j][2] + v[j][3] * v[j][3]); }
        s = wave_sum(s);
        if (lane == 0) rstd1[m] = rsqrtf(s * (1.f / D) + EPS);
#pragma unroll
        for (int j = 0; j < 8; ++j) { u32x2 w; w.x = cvt_pk_bf16(v[j][0], v[j][1]); w.y = cvt_pk_bf16(v[j][2], v[j][3]); ((u32x2*)(xb + (size_t)m * D))[lane + 64 * j] = w; }
    }
    { u32x4* cz = (u32x4*)(ws + WS_CTL); const int gt0 = vcu * (NWAVES * 64) + tid, ngt0 = G * NWAVES * 64;
      for (int i = gt0; i < (int)(CTL_ZERO_BYTES / 16); i += ngt0) if (i < CW_BAR / 4 || i >= (CW_BAR + XCD_BAR_WORDS + 3) / 4) cz[i] = (u32x4){0u, 0u, 0u, 0u}; }
    const int gt = vcu * (NWAVES * 64) + tid, NGT = G * NWAVES * 64;
    float* lbv = (float*)(ws + WS_MISC) + M;
    for (int c = gt; c < HW; c += NGT) lbv[c] = 1.f / (1.f + __expf(a.in[4][HW + c] - a.in[4][c]));
    for (int i = gt; i < DB * 7 * PW; i += NGT) { const int b = i / (7 * PW), rem = i % (7 * PW); a.out[O_PSS + (size_t)b * PC * PW + rem] = a.in[2][(size_t)b * PC * PW + 8 * PW + rem]; }
}

template <int W, bool SAMPLE>
__device__ __forceinline__ void pool_fill(LAS bf16* A, int m0, int g, const bf16* zb, const float* cache) {
    const int tid = threadIdx.x, c8 = tid & 31, rq = tid >> 5;
    constexpr int LDA = 264;
    const int col = g * 256 + 8 * c8;
    u32x4 ur[19];
    int tb;
    if (!SAMPLE) {
        const int mb = m0 + 4 * rq - 15; tb = (m0 & (SEQ - 1)) + 4 * rq - 15;
#pragma unroll
        for (int e = 0; e < 19; ++e) ur[e] = (tb + e >= 0) ? *(const u32x4*)(zb + (size_t)(mb + e) * INC + col) : (u32x4){0u, 0u, 0u, 0u};
    } else {
        const int r0 = 4 * rq, m = m0 + r0, b = (m - MP) >> 3, t0 = r0 & 7; tb = t0 - 15;
#pragma unroll
        for (int e = 0; e < 19; ++e) {
            const int tau = tb + e;
            if (tau >= 0) ur[e] = *(const u32x4*)(zb + (size_t)(m - t0 + tau) * INC + col);
            else { const float* cr = cache + ((size_t)b * PC + (PC + tau)) * PW + col; const f32x4 c0 = *(const f32x4*)cr, c1 = *(const f32x4*)(cr + 4);
                   ur[e] = (u32x4){cvt_pk_bf16(c0[0], c0[1]), cvt_pk_bf16(c0[2], c0[3]), cvt_pk_bf16(c1[0], c1[1]), cvt_pk_bf16(c1[2], c1[3])}; }
        }
    }
    float out[4][8];
#pragma unroll
    for (int cp = 0; cp < 4; ++cp)
#pragma unroll
        for (int hf = 0; hf < 2; ++hf) {
#define PVAL(e) (hf ? bfhi(ur[e][cp]) : bflo(ur[e][cp]))
            float sw = 0.f;
#pragma unroll
            for (int j = 1; j < W; ++j) sw += PVAL(15 - j);
#pragma unroll
            for (int r = 0; r < 4; ++r) {
                const float um = PVAL(15 + r);
                sw += um;
                const float cnt = SAMPLE ? (float)W : (float)min(tb + 15 + r + 1, W);
                out[r][2 * cp + hf] = sw / cnt - um;
                sw -= PVAL(15 + r - (W - 1));
            }
#undef PVAL
        }
#pragma unroll
    for (int r = 0; r < 4; ++r) {
        u32x4 w; w.x = cvt_pk_bf16(out[r][0], out[r][1]); w.y = cvt_pk_bf16(out[r][2], out[r][3]); w.z = cvt_pk_bf16(out[r][4], out[r][5]); w.w = cvt_pk_bf16(out[r][6], out[r][7]);
        *(LAS u32x4*)(A + (4 * rq + r) * LDA + 8 * c8) = w;
    }
}
__device__ __forceinline__ void pool_item(LAS unsigned char* lds, int item, const bf16* zb, const float* cache, const bf16* WpT, bf16* mixb) {
    const int tile = item >> 2, g = item & 3, m0 = tile * 64;
    const int tid = threadIdx.x;
    constexpr int LDA = 264;
    LAS bf16* A = (LAS bf16*)lds;
    const int wave = tid >> 6, lane = tid & 63, fr = lane & 15, fq = lane >> 4, n0 = wave * 32;
    if (m0 < MP) { if (g == 0) pool_fill<2, false>(A, m0, g, zb, cache); else if (g == 1) pool_fill<4, false>(A, m0, g, zb, cache); else if (g == 2) pool_fill<8, false>(A, m0, g, zb, cache); else pool_fill<16, false>(A, m0, g, zb, cache); }
    else { if (g == 0) pool_fill<2, true>(A, m0, g, zb, cache); else if (g == 1) pool_fill<4, true>(A, m0, g, zb, cache); else if (g == 2) pool_fill<8, true>(A, m0, g, zb, cache); else pool_fill<16, true>(A, m0, g, zb, cache); }
    __syncthreads();
    f32x4 acc[4][2];
#pragma unroll
    for (int i = 0; i < 4; ++i)
#pragma unroll
        for (int j = 0; j < 2; ++j) acc[i][j] = (f32x4){0.f, 0.f, 0.f, 0.f};
#pragma unroll 2
    for (int ks = 0; ks < 8; ++ks) {
        bf16x8 wf[2], af[4];
#pragma unroll
        for (int nt = 0; nt < 2; ++nt) wf[nt] = *(const bf16x8*)(WpT + (size_t)(g * 256 + n0 + nt * 16 + fr) * 256 + ks * 32 + fq * 8);
#pragma unroll
        for (int mt = 0; mt < 4; ++mt) af[mt] = *(const LAS bf16x8*)(A + (mt * 16 + fr) * LDA + ks * 32 + fq * 8);
#pragma unroll
        for (int mt = 0; mt < 4; ++mt)
#pragma unroll
            for (int nt = 0; nt < 2; ++nt) acc[mt][nt] = __builtin_amdgcn_mfma_f32_16x16x32_bf16(wf[nt], af[mt], acc[mt][nt], 0, 0, 0);
    }
#pragma unroll
    for (int mt = 0; mt < 4; ++mt)
#pragma unroll
        for (int nt = 0; nt < 2; ++nt) {
            u32x2 o; o.x = cvt_pk_bf16(acc[mt][nt][0], acc[mt][nt][1]); o.y = cvt_pk_bf16(acc[mt][nt][2], acc[mt][nt][3]);
            *(u32x2*)(mixb + (size_t)(m0 + mt * 16 + fr) * D + g * 256 + n0 + nt * 16 + 4 * fq) = o;
        }
    __syncthreads();
}

struct SampleRegs { f32x4 S[8]; };
__device__ __forceinline__ void sample_load(SampleRegs& R, const float* S0) {
    const int tid = threadIdx.x, v4 = tid & 31, kq = tid >> 5;
#pragma unroll
    for (int kk = 0; kk < 8; ++kk) R.S[kk] = *(const f32x4*)(S0 + (size_t)(kq * 8 + kk) * HD + 4 * v4);
}
struct SampleStage { float lfv[2]; bf16 q[2], v[2]; };
__device__ __forceinline__ void sample_stage(SampleStage& st, const bf16* zb, const float* lf, int row0, int h) {
    const int tid = threadIdx.x;
#pragma unroll
    for (int j = 0; j < 2; ++j) {
        const int i = tid + 512 * j, t = i >> 7, ch = i & 127; const size_t row = (size_t)(row0 + t);
        st.lfv[j] = lf[row * HW + h * HD + ch]; st.q[j] = zb[row * INC + PW + h * HD + ch]; st.v[j] = zb[row * INC + PW + 2 * HW + h * HD + ch];
    }
}
__device__ __forceinline__ void sample_run(LAS unsigned char* lds, SampleRegs& R, const SampleStage& st, const bf16* zb, const float* hgn, float* Sout, bf16* mixb, int row0, int h) {
    const int tid = threadIdx.x, v4 = tid & 31, kq = tid >> 5, wave = tid >> 6, lane = tid & 63;
    LAS float* sq = (LAS float*)lds; LAS float* sf = sq + 1024; LAS float* sk = sf + 1024; LAS float* sv = sk + 1024; LAS float* red = sv + 1024;
#pragma unroll
    for (int j = 0; j < 2; ++j) {
        const int i = tid + 512 * j;
        const float f = __builtin_amdgcn_exp2f(st.lfv[j]);
        sq[i] = bf2f(st.q[j]); sf[i] = f; sk[i] = 1.f - f; sv[i] = bf2f(st.v[j]);
    }
    __syncthreads();
#pragma unroll 1
    for (int t = 0; t < 8; ++t) {
        const f32x4 vt = *(const LAS f32x4*)(sv + t * 128 + 4 * v4);
        f32x4 o = (f32x4){0.f, 0.f, 0.f, 0.f};
        const f32x4 f0 = *(const LAS f32x4*)(sf + t * 128 + kq * 8), f1 = *(const LAS f32x4*)(sf + t * 128 + kq * 8 + 4);
        const f32x4 k0 = *(const LAS f32x4*)(sk + t * 128 + kq * 8), k1 = *(const LAS f32x4*)(sk + t * 128 + kq * 8 + 4);
        const f32x4 q0 = *(const LAS f32x4*)(sq + t * 128 + kq * 8), q1 = *(const LAS f32x4*)(sq + t * 128 + kq * 8 + 4);
#pragma unroll
        for (int kk = 0; kk < 8; ++kk) {
            const float f = kk < 4 ? f0[kk & 3] : f1[kk & 3], kn = kk < 4 ? k0[kk & 3] : k1[kk & 3], q = kk < 4 ? q0[kk & 3] : q1[kk & 3];
            R.S[kk] = R.S[kk] * f + vt * kn;
            o = o + R.S[kk] * q;
        }
#pragma unroll
        for (int j = 0; j < 4; ++j) o[j] += __shfl_xor(o[j], 32);
        if (lane < 32) *(LAS f32x4*)(red + (wave * 8 + t) * 128 + 4 * v4) = o;
    }
#pragma unroll
    for (int kk = 0; kk < 8; ++kk) *(f32x4*)(Sout + (size_t)(kq * 8 + kk) * HD + 4 * v4) = R.S[kk];
    __syncthreads();
    {
        const int t = wave; const size_t row = (size_t)(row0 + t);
        float o0 = 0.f, o1 = 0.f;
#pragma unroll
        for (int w8 = 0; w8 < 8; ++w8) { o0 += red[(w8 * 8 + t) * 128 + lane]; o1 += red[(w8 * 8 + t) * 128 + lane + 64]; }
        const float ss = wave_sum(o0 * o0 + o1 * o1), r = rsqrtf(ss * (1.f / HD) + EPS);
        const int ch0 = h * HD + lane, ch1 = ch0 + 64;
        mixb[row * D + PW + ch0] = f2bf(o0 * r * hgn[ch0] * bf2f(zb[row * INC + PW + 3 * HW + ch0]));
        mixb[row * D + PW + ch1] = f2bf(o1 * r * hgn[ch1] * bf2f(zb[row * INC + PW + 3 * HW + ch1]));
    }
    __syncthreads();
}

constexpr int CQS = 272, CTS = 144;
constexpr int L_Q = 0, L_K = L_Q + 64 * CQS, L_KT = L_K + 64 * CQS, L_VT = L_KT + 128 * CTS, L_ST = L_VT + 128 * CTS, L_P = L_ST + 128 * CQS,
              L_DS = L_P + 64 * CTS, L_TOT = L_DS + 512, L_RMS = L_TOT + 8192, L_CHAIN_END = L_RMS + 512;
static_assert(L_CHAIN_END <= 131072, "chain LDS");
struct SegIn { f32x4 lf[4]; u32x2 kn[4], v[4], sq[4]; };
template <bool FULL>
__device__ __forceinline__ void seg_load(SegIn& I, const bf16* zb, const float* lf, int row0, int h) {
    const int tid = threadIdx.x, cg = tid & 31, tgp = tid >> 5;
#pragma unroll
    for (int j = 0; j < 4; ++j) {
        const size_t row = (size_t)(row0 + 4 * tgp + j);
        I.lf[j] = *(const f32x4*)(lf + row * HW + h * HD + 4 * cg);
        I.kn[j] = *(const u32x2*)(zb + row * INC + PW + HW + h * HD + 4 * cg);
        I.v[j] = *(const u32x2*)(zb + row * INC + PW + 2 * HW + h * HD + 4 * cg);
        if (FULL) I.sq[j] = *(const u32x2*)(zb + row * INC + PW + h * HD + 4 * cg);
    }
}
template <bool FULL>
__device__ __forceinline__ void seg_run(LAS unsigned char* lds, const bf16* zb, const float* lf, f32x4 (&Sacc)[8], f32x4& segsum, const f32x4 (&gnr)[4], bf16* mixb, int rowb, int nsteps, int h) {
    const int tid = threadIdx.x, lane = tid & 63, wave = __builtin_amdgcn_readfirstlane(tid >> 6), fr = lane & 15, fq = lane >> 4;
    const int cg = tid & 31, tgp = tid >> 5;
    LAS float* dS = (LAS float*)(lds + L_DS); LAS float* tot = (LAS float*)(lds + L_TOT); LAS float* rmsp = (LAS float*)(lds + L_RMS);
    SegIn I;
    seg_load<FULL>(I, zb, lf, rowb, h);
    *(LAS f32x4*)(tot + tgp * 128 + 4 * cg) = (I.lf[0] + I.lf[1]) + (I.lf[2] + I.lf[3]);
    if (FULL) {
#pragma unroll
        for (int kt = 0; kt < 8; ++kt) {
            u32x2 w; w.x = cvt_pk_bf16(Sacc[kt][0], Sacc[kt][1]); w.y = cvt_pk_bf16(Sacc[kt][2], Sacc[kt][3]);
            *(LAS u32x2*)(lds + L_ST + (16 * wave + fr) * CQS + (16 * kt + 4 * fq) * 2) = w;
        }
    }
    __syncthreads();
    for (int c = 0; c < nsteps; ++c) {
        {
            f32x4 b = (f32x4){0.f, 0.f, 0.f, 0.f};
#pragma unroll
            for (int g = 0; g < 15; ++g) { const f32x4 tv = *(const LAS f32x4*)(tot + g * 128 + 4 * cg); if (g < tgp) b = b + tv; }
            float kt[4][4], qt[4][4];
#pragma unroll
            for (int j = 0; j < 4; ++j) {
                b = b + I.lf[j];
                const float kn0 = bflo(I.kn[j].x), kn1 = bfhi(I.kn[j].x), kn2 = bflo(I.kn[j].y), kn3 = bfhi(I.kn[j].y);
                kt[j][0] = kn0 * __builtin_amdgcn_exp2f(-b[0]); kt[j][1] = kn1 * __builtin_amdgcn_exp2f(-b[1]); kt[j][2] = kn2 * __builtin_amdgcn_exp2f(-b[2]); kt[j][3] = kn3 * __builtin_amdgcn_exp2f(-b[3]);
                if (FULL) {
                    qt[j][0] = bflo(I.sq[j].x) * __builtin_amdgcn_exp2f(b[0]); qt[j][1] = bfhi(I.sq[j].x) * __builtin_amdgcn_exp2f(b[1]); qt[j][2] = bflo(I.sq[j].y) * __builtin_amdgcn_exp2f(b[2]); qt[j][3] = bfhi(I.sq[j].y) * __builtin_amdgcn_exp2f(b[3]);
                    const int t = 4 * tgp + j;
                    u32x2 qw, kw; qw.x = cvt_pk_bf16(qt[j][0], qt[j][1]); qw.y = cvt_pk_bf16(qt[j][2], qt[j][3]); kw.x = cvt_pk_bf16(kt[j][0], kt[j][1]); kw.y = cvt_pk_bf16(kt[j][2], kt[j][3]);
                    *(LAS u32x2*)(lds + L_Q + t * CQS + cg * 8) = qw;
                    *(LAS u32x2*)(lds + L_K + t * CQS + cg * 8) = kw;
                }
            }
#pragma unroll
            for (int ch = 0; ch < 4; ++ch) {
                u32x2 kw; kw.x = cvt_pk_bf16(kt[0][ch], kt[1][ch]); kw.y = cvt_pk_bf16(kt[2][ch], kt[3][ch]);
                *(LAS u32x2*)(lds + L_KT + (4 * cg + ch) * CTS + tgp * 8) = kw;
                const unsigned w0 = (ch < 2) ? I.v[0].x : I.v[0].y, w1 = (ch < 2) ? I.v[1].x : I.v[1].y, w2 = (ch < 2) ? I.v[2].x : I.v[2].y, w3 = (ch < 2) ? I.v[3].x : I.v[3].y;
                u32x2 vw;
                if (ch & 1) { vw.x = (w0 >> 16) | (w1 & 0xffff0000u); vw.y = (w2 >> 16) | (w3 & 0xffff0000u); }
                else { vw.x = (w0 & 0xffffu) | (w1 << 16); vw.y = (w2 & 0xffffu) | (w3 << 16); }
                *(LAS u32x2*)(lds + L_VT + (4 * cg + ch) * CTS + tgp * 8) = vw;
            }
            if (tgp == 15) {
                f32x4 e; e[0] = __builtin_amdgcn_exp2f(b[0]); e[1] = __builtin_amdgcn_exp2f(b[1]); e[2] = __builtin_amdgcn_exp2f(b[2]); e[3] = __builtin_amdgcn_exp2f(b[3]);
                *(LAS f32x4*)(dS + 4 * cg) = e; segsum = segsum + b;
            }
        }
        __syncthreads();
        u32x2 sgr[4];
        if (FULL) {
#pragma unroll
            for (int i = 0; i < 4; ++i) sgr[i] = *(const u32x2*)(zb + (size_t)(rowb + 64 * c + 16 * (wave & 3) + fr) * INC + PW + 3 * HW + h * HD + 16 * (4 * (wave >> 2) + i) + 4 * fq);
        }
        if (c + 1 < nsteps) seg_load<FULL>(I, zb, lf, rowb + 64 * (c + 1), h);
        if (FULL) {
#pragma unroll
            for (int i = 0; i < 2; ++i) {
                const int ti = 2 * wave + i, tt = ti >> 2, st = ti & 3;
                f32x4 p = (f32x4){0.f, 0.f, 0.f, 0.f};
#pragma unroll
                for (int ks = 0; ks < 4; ++ks) {
                    const bf16x8 ka = *(const LAS bf16x8*)(lds + L_K + (16 * st + fr) * CQS + (32 * ks + 8 * fq) * 2);
                    const bf16x8 qb = *(const LAS bf16x8*)(lds + L_Q + (16 * tt + fr) * CQS + (32 * ks + 8 * fq) * 2);
                    p = __builtin_amdgcn_mfma_f32_16x16x32_bf16(ka, qb, p, 0, 0, 0);
                }
                const int t = 16 * tt + fr, s0 = 16 * st + 4 * fq;
                u32x2 w; w.x = cvt_pk_bf16(s0 + 0 <= t ? p[0] : 0.f, s0 + 1 <= t ? p[1] : 0.f); w.y = cvt_pk_bf16(s0 + 2 <= t ? p[2] : 0.f, s0 + 3 <= t ? p[3] : 0.f);
                *(LAS u32x2*)(lds + L_P + t * CTS + s0 * 2) = w;
            }
        }
        {
            bf16x8 vb[2];
#pragma unroll
            for (int ss = 0; ss < 2; ++ss) vb[ss] = *(const LAS bf16x8*)(lds + L_VT + (16 * wave + fr) * CTS + (32 * ss + 8 * fq) * 2);
#pragma unroll
            for (int kt = 0; kt < 8; ++kt)
#pragma unroll
                for (int ss = 0; ss < 2; ++ss) {
                    const bf16x8 ka = *(const LAS bf16x8*)(lds + L_KT + (16 * kt + fr) * CTS + (32 * ss + 8 * fq) * 2);
                    Sacc[kt] = __builtin_amdgcn_mfma_f32_16x16x32_bf16(ka, vb[ss], Sacc[kt], 0, 0, 0);
                }
        }
        const int tt = wave & 3, vh = wave >> 2;
        f32x4 o[4];
        if (FULL) {
            __syncthreads();
            bf16x8 pb[2], qb[4];
#pragma unroll
            for (int ss = 0; ss < 2; ++ss) pb[ss] = *(const LAS bf16x8*)(lds + L_P + (16 * tt + fr) * CTS + (32 * ss + 8 * fq) * 2);
#pragma unroll
            for (int ks = 0; ks < 4; ++ks) qb[ks] = *(const LAS bf16x8*)(lds + L_Q + (16 * tt + fr) * CQS + (32 * ks + 8 * fq) * 2);
#pragma unroll
            for (int i = 0; i < 4; ++i) {
                const int vrow = 16 * (4 * vh + i) + fr;
                f32x4 a = (f32x4){0.f, 0.f, 0.f, 0.f};
#pragma unroll
                for (int ss = 0; ss < 2; ++ss) a = __builtin_amdgcn_mfma_f32_16x16x32_bf16(*(const LAS bf16x8*)(lds + L_VT + vrow * CTS + (32 * ss + 8 * fq) * 2), pb[ss], a, 0, 0, 0);
#pragma unroll
                for (int ks = 0; ks < 4; ++ks) a = __builtin_amdgcn_mfma_f32_16x16x32_bf16(*(const LAS bf16x8*)(lds + L_ST + vrow * CQS + (32 * ks + 8 * fq) * 2), qb[ks], a, 0, 0, 0);
                o[i] = a;
            }
            float ss2 = 0.f;
#pragma unroll
            for (int i = 0; i < 4; ++i) ss2 += (o[i][0] * o[i][0] + o[i][1] * o[i][1]) + (o[i][2] * o[i][2] + o[i][3] * o[i][3]);
            ss2 += __shfl_xor(ss2, 16); ss2 += __shfl_xor(ss2, 32);
            if (fq == 0) rmsp[vh * 64 + 16 * tt + fr] = ss2;
        }
#pragma unroll
        for (int kt = 0; kt < 8; ++kt) Sacc[kt] = Sacc[kt] * *(const LAS f32x4*)(dS + 16 * kt + 4 * fq);
        if (c + 1 < nsteps) *(LAS f32x4*)(tot + tgp * 128 + 4 * cg) = (I.lf[0] + I.lf[1]) + (I.lf[2] + I.lf[3]);
        __syncthreads();
        if (FULL) {
            const int tl = 16 * tt + fr; const size_t row = (size_t)(rowb + 64 * c + tl);
            const float r = rsqrtf((rmsp[tl] + rmsp[64 + tl]) * (1.f / HD) + EPS);
#pragma unroll
            for (int i = 0; i < 4; ++i) {
                const int ch = h * HD + 16 * (4 * vh + i) + 4 * fq;
                const f32x4 gn = gnr[i];
                const u32x2 sg = sgr[i];
                const float g0 = __builtin_bit_cast(float, sg.x << 16), g1 = __builtin_bit_cast(float, sg.x & 0xffff0000u), g2 = __builtin_bit_cast(float, sg.y << 16), g3 = __builtin_bit_cast(float, sg.y & 0xffff0000u);
                u32x2 w; w.x = cvt_pk_bf16(o[i][0] * r * gn[0] * g0, o[i][1] * r * gn[1] * g1); w.y = cvt_pk_bf16(o[i][2] * r * gn[2] * g2, o[i][3] * r * gn[3] * g3);
                *(u32x2*)(mixb + row * D + PW + ch) = w;
            }
#pragma unroll
            for (int kt = 0; kt < 8; ++kt) {
                u32x2 w; w.x = cvt_pk_bf16(Sacc[kt][0], Sacc[kt][1]); w.y = cvt_pk_bf16(Sacc[kt][2], Sacc[kt][3]);
                *(LAS u32x2*)(lds + L_ST + (16 * wave + fr) * CQS + (16 * kt + 4 * fq) * 2) = w;
            }
        }
    }
    __syncthreads();
}

#ifndef P2_ORDER_OLD
#define P2_ORDER_OLD 0
#endif
constexpr int CW_FLAG = 32768;
__device__ __forceinline__ void prompt_pass1(LAS unsigned char* lds, const Args& a, int chain, int seg, int nseg) {
    if (seg + 1 >= nseg) return;
    unsigned char* ws = a.ws;
    const bf16* zb = (const bf16*)(ws + WS_ZB); const float* lf = (const float*)(ws + WS_LF); bf16* mixb = (bf16*)(ws + WS_MIX);
    const int tid = threadIdx.x;
    const int b = chain / NH, h = chain % NH, seglen = SEQ / nseg, nsteps = seglen / 64, rowb = b * SEQ + seg * seglen;
    f32x4* slab = (f32x4*)(ws + WS_XB);
    float* dseg = (float*)(ws + WS_XB + 16 * MiB);
    unsigned* flags = (unsigned*)(ws + WS_CTL) + CW_FLAG;
    f32x4 gnr[4];
#pragma unroll
    for (int i = 0; i < 4; ++i) gnr[i] = (f32x4){0.f, 0.f, 0.f, 0.f};
    f32x4 Sacc[8];
#pragma unroll
    for (int i = 0; i < 8; ++i) Sacc[i] = (f32x4){0.f, 0.f, 0.f, 0.f};
    f32x4 segsum = (f32x4){0.f, 0.f, 0.f, 0.f};
    seg_run<false>(lds, zb, lf, Sacc, segsum, gnr, mixb, rowb, nsteps, h);
    const __amdgpu_buffer_rsrc_t srs = __builtin_amdgcn_make_buffer_rsrc((void*)(slab + (size_t)(chain * 8 + seg) * 4096), (short)0, 4096 * 16, 0x00020000);
#pragma unroll
    for (int kt = 0; kt < 8; ++kt) __builtin_amdgcn_raw_buffer_store_b128(__builtin_bit_cast(u32x4, Sacc[kt]), srs, (unsigned)((kt * 512 + tid) * 16), 0, 16);
    if ((tid >> 5) == 15) {
#pragma unroll
        for (int j = 0; j < 4; ++j) __hip_atomic_store((unsigned*)dseg + (chain * 8 + seg) * 128 + 4 * (tid & 31) + j, __builtin_bit_cast(unsigned, __builtin_amdgcn_exp2f(segsum[j])), __ATOMIC_RELAXED, __HIP_MEMORY_SCOPE_AGENT);
    }
    asm volatile("s_waitcnt vmcnt(0)" ::: "memory");
    __syncthreads();
    if (tid == 0) __hip_atomic_store(flags + 64 * (chain * 8 + seg), 1u, __ATOMIC_RELAXED, __HIP_MEMORY_SCOPE_AGENT);
}
__device__ __forceinline__ void prompt_pass2(LAS unsigned char* lds, const Args& a, int chain, int seg, int nseg) {
    unsigned char* ws = a.ws;
    const bf16* zb = (const bf16*)(ws + WS_ZB); const float* lf = (const float*)(ws + WS_LF); bf16* mixb = (bf16*)(ws + WS_MIX);
    const int tid = threadIdx.x, lane = tid & 63, wave = __builtin_amdgcn_readfirstlane(tid >> 6), fr = lane & 15, fq = lane >> 4;
    const int b = chain / NH, h = chain % NH, seglen = SEQ / nseg, nsteps = seglen / 64, rowb = b * SEQ + seg * seglen;
    const f32x4* slab = (const f32x4*)(ws + WS_XB);
    const float* dseg = (const float*)(ws + WS_XB + 16 * MiB);
    unsigned* flags = (unsigned*)(ws + WS_CTL) + CW_FLAG;
    f32x4 gnr[4];
#pragma unroll
    for (int i = 0; i < 4; ++i) gnr[i] = *(const f32x4*)(a.in[9] + h * HD + 16 * (4 * (wave >> 2) + i) + 4 * fq);
    f32x4 Sacc[8];
#pragma unroll
    for (int i = 0; i < 8; ++i) Sacc[i] = (f32x4){0.f, 0.f, 0.f, 0.f};
    f32x4 segsum = (f32x4){0.f, 0.f, 0.f, 0.f};
    if (seg > 0) {
        if (tid < 64) {
            for (int i = 0; i < seg; ++i) { unsigned sp = 0; while (__hip_atomic_load(flags + 64 * (chain * 8 + i), __ATOMIC_RELAXED, __HIP_MEMORY_SCOPE_AGENT) == 0u && ++sp < (1u << 22)) __builtin_amdgcn_s_sleep(2); }
            __builtin_amdgcn_fence(__ATOMIC_ACQUIRE, "agent");
            asm volatile("s_waitcnt vmcnt(0)" ::: "memory");
        }
        __syncthreads();
        f32x4 rc[8], rn[8];
#pragma unroll
        for (int kt = 0; kt < 8; ++kt) { rc[kt] = slab[(size_t)(chain * 8) * 4096 + kt * 512 + tid]; rn[kt] = rc[kt]; }
        for (int i = 0; i < seg; ++i) {
            const float* dd = dseg + (chain * 8 + i) * 128;
            if (i + 1 < seg) {
#pragma unroll
                for (int kt = 0; kt < 8; ++kt) rn[kt] = slab[(size_t)(chain * 8 + i + 1) * 4096 + kt * 512 + tid];
            }
#pragma unroll
            for (int kt = 0; kt < 8; ++kt) Sacc[kt] = Sacc[kt] * *(const f32x4*)(dd + 16 * kt + 4 * fq) + rc[kt];
#pragma unroll
            for (int kt = 0; kt < 8; ++kt) rc[kt] = rn[kt];
        }
    }
    seg_run<true>(lds, zb, lf, Sacc, segsum, gnr, mixb, rowb, nsteps, h);
    if (seg + 1 == nseg) {
        float* Sout = a.out + O_HSP + (size_t)chain * HD * HD;
#pragma unroll
        for (int kt = 0; kt < 8; ++kt)
#pragma unroll
            for (int j = 0; j < 4; ++j) Sout[(size_t)(16 * kt + 4 * fq + j) * HD + 16 * wave + fr] = Sacc[kt][j];
    }
}

__device__ __forceinline__ void phase2(LAS unsigned char* lds, const Args& a, int bid, int G, int parts = 7) {
    unsigned char* ws = a.ws;
    const bf16* zb = (const bf16*)(ws + WS_ZB); const float* lf = (const float*)(ws + WS_LF); bf16* mixb = (bf16*)(ws + WS_MIX);
    constexpr int NPC = NB * NH, NSC = DB * NH, NPOOL = (M / 64) * 4;
    const int nseg = (G >= 8 * NPC) ? 8 : (G >= 4 * NPC ? 4 : (G >= 2 * NPC ? 2 : 1));
    if ((parts & 1) && nseg > 1 && bid < nseg * NPC) prompt_pass1(lds, a, bid / nseg, bid % nseg, nseg);
#if P2_ORDER_OLD
    if (parts & 1) {
        if (nseg > 1) { if (bid < nseg * NPC) prompt_pass2(lds, a, bid / nseg, bid % nseg, nseg); }
        else for (int c = bid; c < NPC; c += G) prompt_pass2(lds, a, c, 0, 1);
    }
#endif
    STAMP(5);
    if (parts & 2) {
        SampleRegs cur, nxt;
        if (bid < NSC) sample_load(cur, a.in[3] + (size_t)bid * HD * HD);
        for (int it = bid; it < NSC; it += G) {
            const bool pf = it + G < NSC;
            SampleStage st; sample_stage(st, zb, lf, MP + (it / NH) * DS, it % NH);
            if (pf) sample_load(nxt, a.in[3] + (size_t)(it + G) * HD * HD);
            sample_run(lds, cur, st, zb, a.in[9], a.out + O_HSS + (size_t)it * HD * HD, mixb, MP + (it / NH) * DS, it % NH);
            if (pf) {
#pragma unroll
                for (int kk = 0; kk < 8; ++kk) cur.S[kk] = nxt.S[kk];
            }
        }
    }
    if (parts & 4) {
        const int first = (NSC + G - 1 - bid) / G * G + bid;
        for (int it = first; it < NSC + NPOOL; it += G) pool_item(lds, it - NSC, zb, a.in[2], (const bf16*)(ws + WS_WP), mixb);
    }
    STAMP(6);
    if (!P2_ORDER_OLD && (parts & 1)) {
        if (nseg > 1) { if (bid < nseg * NPC) prompt_pass2(lds, a, bid / nseg, bid % nseg, nseg); }
        else for (int c = bid; c < NPC; c += G) prompt_pass2(lds, a, c, 0, 1);
    }
}

__device__ __forceinline__ void phase6(const Args& a, int vcu, int G, size_t x2off) {
    const int tid = threadIdx.x, lane = tid & 63, wave = tid >> 6;
#ifdef TPROBE
    { unsigned d = *((const unsigned*)(a.ws + WS_CTL) + CW_TP); if (TP_MODE == 2) d = 0x40000000u - d;
#ifdef TP_CAL
      d = TP_REF_US * 95;
#endif
      const float delta = 0.01f * ((float)d * 0.01f) / (float)(TP_REF_US);
      for (int i = vcu * (NWAVES * 64) + tid; i < NB * PC * PW; i += G * NWAVES * 64) a.out[O_PSP + i] += delta; }
#endif
    const int gw = vcu * NWAVES + wave, NGW = G * NWAVES;
    const float* rsq3 = (const float*)(a.ws + WS_CTL) + CW_RSQ3;
    for (int m = gw; m < M; m += NGW) {
        float* yr = a.out + O_Y + (size_t)m * D; const bf16* xr = (const bf16*)(a.ws + x2off) + (size_t)m * D;
        const float r = rsqrtf(rsq3[m] * (1.f / D) + EPS);
#pragma unroll
        for (int j = 0; j < 4; ++j) {
            const u32x4 xw = ((const u32x4*)xr)[lane + 64 * j];
            const f32x4 g0 = ((const f32x4*)a.in[15])[2 * (lane + 64 * j)], g1 = ((const f32x4*)a.in[15])[2 * (lane + 64 * j) + 1];
            ((f32x4*)yr)[2 * (lane + 64 * j)] = (f32x4){bflo(xw.x), bfhi(xw.x), bflo(xw.y), bfhi(xw.y)} * r * g0;
            ((f32x4*)yr)[2 * (lane + 64 * j) + 1] = (f32x4){bflo(xw.z), bfhi(xw.z), bflo(xw.w), bfhi(xw.w)} * r * g1;
        }
    }
}

__global__ void __launch_bounds__(NWAVES * 64, 2) mega(Args a) {
    extern __shared__ __attribute__((aligned(16))) unsigned char lds_raw[];
    LAS unsigned char* lds = (LAS unsigned char*)lds_raw;
    const int G = gridDim.x, bid = blockIdx.x;
    const int vcu = (G % 8 == 0) ? (bid % 8) * (G / 8) + bid / 8 : bid;
    unsigned char* ws = a.ws;
    float* ctlf = (float*)(ws + WS_CTL);
    const int lo = a.ph_lo, hi = a.ph_hi;
#if ONE_LAUNCH && USE_CG
    cg::grid_group grid = cg::this_grid();
#define GRID_BAR() grid.sync()
#elif ONE_LAUNCH
    volatile LAS unsigned* MISC = (volatile LAS unsigned*)(lds + MISC_OFF);
    if (threadIdx.x < 32) MISC[threadIdx.x] = 0u;
    __syncthreads();
    XcdBarrier bar = xcd_barrier_post((unsigned*)(ws + WS_CTL) + CW_BAR, MISC + 8);
#define GRID_BAR() xcd_barrier(bar)
#else
#define GRID_BAR() do {} while (0)
#endif
#ifndef PH_MASK
#define PH_MASK 0x7f
#endif
#define IN(k) (((PH_MASK >> (k)) & 1) && lo <= (k) && (k) < hi)
#define BOTH(k) (IN(k) && IN((k) + 1))
#ifndef REP_MASK
#define REP_MASK 0
#endif
#define REP(k) ((REP_MASK >> (k)) & 1)
#ifndef P2_REP_PARTS
#define P2_REP_PARTS 7
#endif
    STAMP(0);
    if (IN(0)) { if (REP(0)) { phase0(lds, a, vcu, G); __syncthreads(); } phase0(lds, a, vcu, G); STAMP(1); if (BOTH(0)) GRID_BAR(); STAMP(2); }
    if (IN(1)) {
        pg8::Gemm g{(const bf16*)(ws + WS_XB), (const bf16*)(ws + WS_WIN), M, INC, D}; pg8::HybridOrder S; S.init(M, INC, D, G, bid, false);
        const pg8::TailCtx T{nullptr, nullptr};
        pg8::EpiZ E{(bf16*)(ws + WS_ZB), (float*)(ws + WS_LF), (const float*)(ws + WS_MISC), (const float*)(ws + WS_MISC) + M, a.out};
        if (REP(1)) pg8::gemm_phase2(lds, g, S, E, T);
        pg8::gemm_phase2(lds, g, S, E, T);
        STAMP(3);
        if (BOTH(1)) GRID_BAR();
        STAMP(4);
    }
    if (IN(2)) { if (REP(2)) { phase2(lds, a, bid, G, P2_REP_PARTS); __syncthreads(); } phase2(lds, a, bid, G); STAMP(7); if (BOTH(2)) GRID_BAR(); STAMP(8); }
    const bool merged = MERGED && G == 256 && lo <= 3 && hi >= 6;
    if (merged) {
        pg8::MOrder S{bid};
        constexpr pg8::StreamOff O{WS_MIX, WS_WO, WS_XB, WS_WGU, WS_ACT, WS_WD, WS_MIX, WS_SLABM, CW_DEP, CW_DEP + 4096, CW_TAIL, CW_RSQ2, CW_RSQ3};
        pg8::gemm_stream(lds, S, ws, a.in[0], a.in[1], O);
        STAMP(13);
#ifdef TPROBE
        if (threadIdx.x == 0) { volatile LAS unsigned long long* ts = (volatile LAS unsigned long long*)(lds + MISC_OFF + 128); const unsigned d = (unsigned)(ts[TP_B] - ts[TP_A]);
            unsigned* w = (unsigned*)(ws + WS_CTL) + CW_TP; if (TP_MODE == 0) { if (bid == TP_BLOCK) atomicMax(w, d); } else if (TP_MODE == 1) atomicMax(w, d); else atomicMax(w, 0x40000000u - d); }
#endif
        GRID_BAR();
    }
#if !MERGED
    if (!merged && IN(3)) {
        pg8::Gemm g{(const bf16*)(ws + WS_MIX), (const bf16*)(ws + WS_WO), M, D, D}; pg8::HybridOrder S; S.init(M, D, D, G, bid, true);
        const pg8::TailCtx T{(f32x4*)(ws + WS_SLAB3), (unsigned*)(ws + WS_CTL) + CW_TAIL};
        if (REP(3)) { pg8::EpiX1<true> E0{a.in[0], a.in[1], a.out + O_Y, (bf16*)(ws + WS_XB), ctlf + CW_RSQ2, false}; pg8::gemm_phase2(lds, g, S, E0, T); }
        pg8::EpiX1<false> E{a.in[0], a.in[1], a.out + O_Y, (bf16*)(ws + WS_XB), ctlf + CW_RSQ2, false};
        pg8::gemm_phase2(lds, g, S, E, T);
        STAMP(9);
        if (BOTH(3)) GRID_BAR();
        STAMP(10);
    }
    if (!merged && IN(4)) {
        pg8::Gemm g{(const bf16*)(ws + WS_XB), (const bf16*)(ws + WS_WGU), M, 2 * DFF, D}; pg8::HybridOrder S; S.init(M, 2 * DFF, D, G, bid, true);
        const pg8::TailCtx T{(f32x4*)(ws + WS_SLAB45), (unsigned*)(ws + WS_CTL) + CW_TAIL + 4096};
        pg8::EpiAct E{(bf16*)(ws + WS_ACT), ctlf + CW_RSQ2, false};
        if (REP(4)) pg8::gemm_phase2(lds, g, S, E, T);
        pg8::gemm_phase2(lds, g, S, E, T);
        STAMP(11);
        if (BOTH(4)) GRID_BAR();
        STAMP(12);
    }
    if (!merged && IN(5)) {
        pg8::Gemm g{(const bf16*)(ws + WS_ACT), (const bf16*)(ws + WS_WD), M, D, DFF}; pg8::HybridOrder S; S.init(M, D, DFF, G, bid, true);
        const pg8::TailCtx T{(f32x4*)(ws + WS_SLAB45), (unsigned*)(ws + WS_CTL) + CW_TAIL + 8192};
        if (REP(5)) { pg8::EpiX2<true> E0{(bf16*)(ws + WS_X2B), ctlf + CW_RSQ3, (const bf16*)(ws + WS_XB)}; pg8::gemm_phase2(lds, g, S, E0, T); }
        pg8::EpiX2<false> E{(bf16*)(ws + WS_X2B), ctlf + CW_RSQ3, (const bf16*)(ws + WS_XB)};
        pg8::gemm_phase2(lds, g, S, E, T);
        STAMP(13);
#ifdef TPROBE
        if (threadIdx.x == 0) { volatile LAS unsigned long long* ts = (volatile LAS unsigned long long*)(lds + MISC_OFF + 128); const unsigned d = (unsigned)(ts[TP_B] - ts[TP_A]);
            unsigned* w = (unsigned*)(ws + WS_CTL) + CW_TP; if (TP_MODE == 0) { if (bid == TP_BLOCK) atomicMax(w, d); } else if (TP_MODE == 1) atomicMax(w, d); else atomicMax(w, 0x40000000u - d); }
#endif
        if (BOTH(5)) GRID_BAR();
    }
#endif
    if (IN(6)) phase6(a, vcu, G, merged ? WS_MIX : WS_X2B);
#undef IN
#undef BOTH
}

extern "C" void kernel_launch(void* const* d_in, const int* in_sizes, int n_in, void* d_out, int out_size, void* d_ws, size_t ws_size, hipStream_t stream) {
    static int grid = 0;
    if (grid == 0) {
        if (n_in != 16 || ws_size < WS_END) { fprintf(stderr, "kernel_launch: unexpected n_in %d / ws_size %zu\n", n_in, ws_size); grid = -1; return; }
        int dev = 0, cus = 0, per_cu = 0;
        hipGetDevice(&dev);
        hipDeviceGetAttribute(&cus, hipDeviceAttributeMultiprocessorCount, dev);
        hipFuncSetAttribute((const void*)mega, hipFuncAttributeMaxDynamicSharedMemorySize, LDS_BYTES);
        hipOccupancyMaxActiveBlocksPerMultiprocessor(&per_cu, (const void*)mega, NWAVES * 64, LDS_BYTES);
        if (per_cu < 1) { fprintf(stderr, "kernel_launch: occupancy query says %d blocks per CU\n", per_cu); grid = -1; return; }
        grid = cus;
    }
    if (grid < 0) return;
    hipMemsetAsync((char*)d_ws + WS_CTL + (size_t)CW_BAR * 4, 0, XCD_BAR_WORDS * 4, stream);
    Args a{};
    for (int i = 0; i < 16; ++i) a.in[i] = (const float*)d_in[i];
    a.out = (float*)d_out; a.ws = (unsigned char*)d_ws;
#if ONE_LAUNCH
    a.ph_lo = 0; a.ph_hi = NPHASE;
    void* args[] = {&a};
#if USE_CG
    hipError_t e = hipLaunchCooperativeKernel((const void*)mega, dim3(grid), dim3(NWAVES * 64), args, LDS_BYTES, stream);
    if (e != hipSuccess) fprintf(stderr, "cooperative launch failed: %s (grid %d)\n", hipGetErrorString(e), grid);
#else
    (void)args; hipLaunchKernelGGL(mega, dim3(grid), dim3(NWAVES * 64), LDS_BYTES, stream, a);
#endif
#else
    for (int p = 0; p < NPHASE; ++p) { a.ph_lo = p; a.ph_hi = p + 1; hipLaunchKernelGGL(mega, dim3(grid), dim3(NWAVES * 64), LDS_BYTES, stream, a); }
#endif
}
```

```cpp
#include <hip/hip_runtime.h>
#include <hip/hip_cooperative_groups.h>
#include <cstdio>
#include <cstdint>
namespace cg = cooperative_groups;

constexpr int D = 2048, NB = 4, SEQ = 2048, DB = 128, DS = 8;
constexpr int MP = NB * SEQ, MS = DB * DS, M = MP + MS;
constexpr int PW = 1024, HW = 1024, HD = 128, NH = 8, PC = 15;
constexpr int DFF = 5632, INC = 5120;
constexpr float EPS = 1e-6f;
constexpr size_t O_Y = 0;
constexpr size_t O_PSP = (size_t)M * D;
constexpr size_t O_HSP = O_PSP + (size_t)NB * PC * PW;
constexpr size_t O_PSS = O_HSP + (size_t)NB * NH * HD * HD;
constexpr size_t O_HSS = O_PSS + (size_t)DB * PC * PW;

namespace pg8 {
#define PG8_LAS __attribute__((address_space(3)))
typedef unsigned short bf16_t;
typedef short bf16x8 __attribute__((ext_vector_type(8)));
typedef float f32x4 __attribute__((ext_vector_type(4)));
typedef unsigned u32x4 __attribute__((ext_vector_type(4)));
constexpr int BM = 256, BK = 64, HALF = 128, HTB = HALF * BK * 2  , STAGE_BYTES = 8 * HTB, NXCD = 8, WGM = 8;

__host__ __device__ __forceinline__ int lds_byte(int r, int c) { const int st = (r >> 4) * 2 + (c >> 5), rr = r & 15, cc = c & 31, ob = rr * 64 + cc * 2; return st * 1024 + (ob ^ (((ob >> 9) & 1) << 5)); }
__host__ __device__ __forceinline__ void stage_rc(int b, int& R, int& C) { const int st = b / 1024, sb = b % 1024, swz = sb ^ (((sb >> 9) & 1) << 5); R = (st >> 1) * 16 + swz / 64; C = (st & 1) * 32 + (swz % 64) / 2; }
__host__ __device__ __forceinline__ int perm32(int rho) { const int n = rho >> 4, i = rho & 15; return 8 * (i >> 2) + 4 * n + (i & 3); }

struct Unit { int pm, pn, kb, nk, tinfo; };
struct Gemm { const bf16_t* A; const bf16_t* Bt; int M, N, K; };

struct StaticOrder {
    int nM, nN, nwg, G, c;
    __host__ __device__ void init(int M, int N, int G_, int c_) { nM = M / BM; nN = N / BM; nwg = nM * nN; G = G_; c = c_; }
    __host__ __device__ bool next(int i, Unit& u) const {
        const long L = (long)i * G + c; if (L >= nwg) return false;
        int wgid = (int)L; { const int q = nwg / NXCD, r = nwg % NXCD, xcd = wgid % NXCD, off = wgid / NXCD; wgid = (xcd < r ? xcd * (q + 1) : r * (q + 1) + (xcd - r) * q) + off; }
        const int nig = WGM * nN, gid = wgid / nig, fm = gid * WGM, gsz = (nM - fm) < WGM ? (nM - fm) : WGM;
        u.pm = fm + ((wgid % nig) % gsz); u.pn = (wgid % nig) / gsz; u.kb = 0; u.nk = 0; u.tinfo = -1; return true;
    }
    __device__ __forceinline__ void a_ready(const Unit&) const {}
    __device__ __forceinline__ void done(const Unit&) const {}
};
__device__ __forceinline__ unsigned cvt_pk_bf16(float lo, float hi) { unsigned r; asm volatile("v_cvt_pk_bf16_f32 %0, %1, %2" : "=v"(r) : "v"(lo), "v"(hi)); return r; }
__device__ __forceinline__ float sigm(float x) { return __builtin_amdgcn_rcpf(1.f + __expf(-x)); }
__device__ __forceinline__ float silu(float x) { return x * __builtin_amdgcn_rcpf(1.f + __expf(-x)); }
typedef unsigned u32x2 __attribute__((ext_vector_type(2)));
__device__ __forceinline__ float bflo_(unsigned w) { return __builtin_bit_cast(float, w << 16); }
__device__ __forceinline__ float bfhi_(unsigned w) { return __builtin_bit_cast(float, w & 0xffff0000u); }

struct EpiZ {
    static constexpr bool PERM = true, AFTER_DRAIN = false;
    bf16_t* zb; float* lf; const float* rstd1; const float* lbv; float* out;
    __device__ __forceinline__ void operator()(const f32x4 (&acc)[2][2][4][2], const Unit& u, int wr, int wc, int fr, int fq, unsigned gmask = 0xffu) const {
        const int kind = u.pn >> 2;
        const int row0 = u.pm * BM + wr * 64 + fr;
        const int cc0 = (u.pn & 3) * 256 + wc * 32 + 8 * fq;
        f32x4 lb[2][2];
        if (kind == 2) {
#pragma unroll
            for (int bj = 0; bj < 2; ++bj)
#pragma unroll
                for (int n = 0; n < 2; ++n) lb[bj][n] = *(const f32x4*)(lbv + cc0 + bj * HALF + 4 * n);
        }
#pragma unroll
        for (int ai = 0; ai < 2; ++ai)
#pragma unroll
            for (int m = 0; m < 4; ++m) {
                if (!((gmask >> (ai * 4 + m)) & 1u)) continue;
                const int row = row0 + ai * HALF + m * 16;
                const float r = rstd1[row];
#pragma unroll
                for (int bj = 0; bj < 2; ++bj) {
                    const int cc = cc0 + bj * HALF;
                    f32x4 v0 = acc[ai][bj][m][0] * r, v1 = acc[ai][bj][m][1] * r;
                    if (kind == 2) {
#pragma unroll
                        for (int j = 0; j < 4; ++j) {
                            const float f0 = lb[bj][0][j] + (1.f - lb[bj][0][j]) * sigm(v0[j]), f1 = lb[bj][1][j] + (1.f - lb[bj][1][j]) * sigm(v1[j]);
                            v0[j] = __log2f(f0); v1[j] = __log2f(f1);
                        }
                        float* p = lf + (size_t)row * HW + cc;
                        *(f32x4*)p = v0; *(f32x4*)(p + 4) = v1;

                    } else {
                        if (kind == 0) {
                            float* dst = nullptr;
                            if (row >= MP) { const int ms = row - MP; dst = out + O_PSS + ((size_t)(ms >> 3) * PC + 7 + (ms & 7)) * PW + cc; }
                            else { const int t = row & (SEQ - 1); if (t >= SEQ - PC) dst = out + O_PSP + ((size_t)(row >> 11) * PC + (t - (SEQ - PC))) * PW + cc; }
                            if (dst) { *(f32x4*)dst = v0; *(f32x4*)(dst + 4) = v1; }
                        }
                        if (kind == 1 || kind == 4) {
#pragma unroll
                            for (int j = 0; j < 4; ++j) { v0[j] = silu(v0[j]); v1[j] = silu(v1[j]); }
                        }
                        u32x4 w; w.x = cvt_pk_bf16(v0[0], v0[1]); w.y = cvt_pk_bf16(v0[2], v0[3]); w.z = cvt_pk_bf16(v1[0], v1[1]); w.w = cvt_pk_bf16(v1[2], v1[3]);
                        *(u32x4*)(zb + (size_t)row * INC + kind * 1024 + cc) = w;
                    }
                }
            }
    }
};

__device__ __forceinline__ void store16(bf16_t* base, size_t elem_off, u32x4 w, bool wt) {
    if (wt) { const __amdgpu_buffer_rsrc_t r = __builtin_amdgcn_make_buffer_rsrc((void*)base, (short)0, 0x7fffffff, 0x00020000); __builtin_amdgcn_raw_buffer_store_b128(w, r, (unsigned)(elem_off * 2), 0, 16); }
    else *(u32x4*)(base + elem_off) = w;
}
template <bool DRY = false> struct EpiX1 {
    static constexpr bool PERM = true, AFTER_DRAIN = false;
    const float* xp; const float* xs; float* y; bf16_t* x1b; float* rowsq; bool wt;
    __device__ __forceinline__ void operator()(const f32x4 (&acc)[2][2][4][2], const Unit& u, int wr, int wc, int fr, int fq, unsigned gmask = 0xffu) const {
        const int row0 = u.pm * BM + wr * 64 + fr, col0 = u.pn * BM + wc * 32 + 8 * fq;
#pragma unroll
        for (int ai = 0; ai < 2; ++ai)
#pragma unroll
            for (int m = 0; m < 4; ++m) {
                if (!((gmask >> (ai * 4 + m)) & 1u)) continue;
                const int row = row0 + ai * HALF + m * 16;
                const float* xr = (row < MP ? xp + (size_t)row * D : xs + (size_t)(row - MP) * D) + col0;
                float s = 0.f;
#pragma unroll
                for (int bj = 0; bj < 2; ++bj) {
                    const f32x4 v0 = __builtin_nontemporal_load((const f32x4*)(xr + bj * HALF)) + acc[ai][bj][m][0], v1 = __builtin_nontemporal_load((const f32x4*)(xr + bj * HALF + 4)) + acc[ai][bj][m][1];
                    u32x4 w; w.x = cvt_pk_bf16(v0[0], v0[1]); w.y = cvt_pk_bf16(v0[2], v0[3]); w.z = cvt_pk_bf16(v1[0], v1[1]); w.w = cvt_pk_bf16(v1[2], v1[3]);
                    store16(x1b, (size_t)row * D + col0 + bj * HALF, w, wt);
                    s += (v0[0] * v0[0] + v0[1] * v0[1]) + (v0[2] * v0[2] + v0[3] * v0[3]) + (v1[0] * v1[0] + v1[1] * v1[1]) + (v1[2] * v1[2] + v1[3] * v1[3]);
                }
                s += __shfl_xor(s, 16); s += __shfl_xor(s, 32);
                if (fq == 0 && !DRY) atomicAdd(rowsq + row, s);
            }
    }
};

struct EpiAct {
    static constexpr bool PERM = true, AFTER_DRAIN = false;
    bf16_t* act; const float* rowsq; bool wt;
    __device__ __forceinline__ void operator()(const f32x4 (&acc)[2][2][4][2], const Unit& u, int wr, int wc, int fr, int fq, unsigned gmask = 0xffu) const {
        const int row0 = u.pm * BM + wr * 64 + fr, col0 = u.pn * HALF + wc * 32 + 8 * fq;
#pragma unroll
        for (int ai = 0; ai < 2; ++ai)
#pragma unroll
            for (int m = 0; m < 4; ++m) {
                if (!((gmask >> (ai * 4 + m)) & 1u)) continue;
                const int row = row0 + ai * HALF + m * 16;
                const float r = rsqrtf(rowsq[row] * (1.f / D) + EPS);
                u32x4 w; unsigned* wp = (unsigned*)&w;
#pragma unroll
                for (int n = 0; n < 2; ++n) {
                    const f32x4 g = acc[ai][0][m][n] * r, up = acc[ai][1][m][n] * r;
                    f32x4 a;
#pragma unroll
                    for (int j = 0; j < 4; ++j) a[j] = silu(g[j]) * up[j];
                    wp[2 * n] = cvt_pk_bf16(a[0], a[1]); wp[2 * n + 1] = cvt_pk_bf16(a[2], a[3]);
                }
                store16(act, (size_t)row * DFF + col0, w, wt);
            }
    }
};

template <bool DRY = false> struct EpiX2 {
    static constexpr bool PERM = true, AFTER_DRAIN = false;
    bf16_t* x2b; float* rowsq; const bf16_t* x1b;
    __device__ __forceinline__ void operator()(const f32x4 (&acc)[2][2][4][2], const Unit& u, int wr, int wc, int fr, int fq, unsigned gmask = 0xffu) const {
        const int row0 = u.pm * BM + wr * 64 + fr, col0 = u.pn * BM + wc * 32 + 8 * fq;
#pragma unroll
        for (int ai = 0; ai < 2; ++ai)
#pragma unroll
            for (int m = 0; m < 4; ++m) {
                if (!((gmask >> (ai * 4 + m)) & 1u)) continue;
                const int row = row0 + ai * HALF + m * 16;
                float s = 0.f;
#pragma unroll
                for (int bj = 0; bj < 2; ++bj) {
                    const u32x4 xw = *(const u32x4*)(x1b + (size_t)row * D + col0 + bj * HALF);
                    f32x4 v0 = (f32x4){bflo_(xw.x), bfhi_(xw.x), bflo_(xw.y), bfhi_(xw.y)} + acc[ai][bj][m][0];
                    f32x4 v1 = (f32x4){bflo_(xw.z), bfhi_(xw.z), bflo_(xw.w), bfhi_(xw.w)} + acc[ai][bj][m][1];
                    u32x4 w; w.x = cvt_pk_bf16(v0[0], v0[1]); w.y = cvt_pk_bf16(v0[2], v0[3]); w.z = cvt_pk_bf16(v1[0], v1[1]); w.w = cvt_pk_bf16(v1[2], v1[3]);
                    *(u32x4*)(x2b + (size_t)row * D + col0 + bj * HALF) = w;
                    s += (v0[0] * v0[0] + v0[1] * v0[1]) + (v0[2] * v0[2] + v0[3] * v0[3]) + (v1[0] * v1[0] + v1[1] * v1[1]) + (v1[2] * v1[2] + v1[3] * v1[3]);
                }
                s += __shfl_xor(s, 16); s += __shfl_xor(s, 32);
                if (fq == 0 && !DRY) atomicAdd(rowsq + row, s);
            }
    }
};
template <class Epi, class Sched, bool ALIGN_EPI = false, bool SP2 = false>
__device__ __forceinline__ void gemm_phase(PG8_LAS unsigned char* lds, const Gemm g, const Sched& S, const Epi& E) {
    int tid_ = threadIdx.x; asm volatile("" : "+v"(tid_));
    const int tid = tid_, wid = __builtin_amdgcn_readfirstlane(tid >> 6), lane = tid & 63, wr = wid >> 2, wc = wid & 3, fr = lane & 15, fq = lane >> 4;
    const int K = g.K, nt = K / BK;
    unsigned voffA[2], voffB[2];
#pragma unroll
    for (int i = 0; i < 2; ++i) { int R, C; stage_rc(tid * 16 + i * 8192, R, C); const int Rb = Epi::PERM ? ((R & ~31) + perm32(R & 31)) : R;
        voffA[i] = (unsigned)(R * K + C) * 2u; voffB[i] = (unsigned)(Rb * K + C) * 2u; }
    const size_t kstep = (size_t)(BK * 2);
    const size_t hstep = (size_t)HALF * K * 2;
    const size_t tstep = 2 * hstep;
    const unsigned ldsw = (unsigned)wid * 1024u;
    const int aoff = lds_byte(wr * 64 + fr, fq * 8), boff = lds_byte(wc * 32 + fr, fq * 8);
#define PG8_SA(b, h) (((b) * 2 + (h)) * HTB)
#define PG8_SB(b, h) ((4 + (b) * 2 + (h)) * HTB)
#define PG8_STAGE(bufoff, gbase, voff) do { _Pragma("unroll") for (int _i = 0; _i < 2; ++_i) \
        __builtin_amdgcn_global_load_lds((const unsigned*)((const char*)(gbase) + (voff)[_i]), (PG8_LAS unsigned*)(lds + (bufoff) + ldsw + _i * 8192), 16, 0, 0); } while (0)
#define PG8_LDA(dst, b, h) do { _Pragma("unroll") for (int m = 0; m < 4; ++m) _Pragma("unroll") for (int k = 0; k < 2; ++k) dst[m][k] = *(const PG8_LAS bf16x8*)(lds + PG8_SA(b, h) + aoff + m * 2048 + k * 1024); } while (0)
#define PG8_LDB(dst, b, h) do { _Pragma("unroll") for (int n = 0; n < 2; ++n) _Pragma("unroll") for (int k = 0; k < 2; ++k) dst[n][k] = *(const PG8_LAS bf16x8*)(lds + PG8_SB(b, h) + boff + n * 2048 + k * 1024); } while (0)
#define PG8_MMA(ai, bj, At, Bt) do { __builtin_amdgcn_s_setprio(1); _Pragma("unroll") for (int m = 0; m < 4; ++m) _Pragma("unroll") for (int n = 0; n < 2; ++n) _Pragma("unroll") for (int k = 0; k < 2; ++k) \
        acc[ai][bj][m][n] = __builtin_amdgcn_mfma_f32_16x16x32_bf16(Bt[n][k], At[m][k], acc[ai][bj][m][n], 0, 0, 0); __builtin_amdgcn_s_setprio(0); } while (0)
#define PG8_WAIT_V(n) asm volatile("s_waitcnt vmcnt(" #n ")" ::: "memory")
#define PG8_WAIT_L(n) asm volatile("s_waitcnt lgkmcnt(" #n ")" ::: "memory")
#define PG8_BAR __builtin_amdgcn_s_barrier()
#define PG8_SCHED __builtin_amdgcn_sched_barrier(0)
    Unit cur, nxt; int ui = 0;
    if (!S.next(0, cur)) return;
    f32x4 acc[2][2][4][2];
#pragma unroll
    for (int a = 0; a < 2; ++a)
#pragma unroll
        for (int b = 0; b < 2; ++b)
#pragma unroll
            for (int m = 0; m < 4; ++m)
#pragma unroll
                for (int n = 0; n < 2; ++n) acc[a][b][m][n] = (f32x4){0.f, 0.f, 0.f, 0.f};
    bf16x8 At[4][2], B0[2][2], B1[2][2];
    const char* cA = (const char*)g.A + (size_t)cur.pm * tstep; const char* cB = (const char*)g.Bt + (size_t)cur.pn * tstep;
    S.a_ready(cur);
    if constexpr (SP2) {
        PG8_STAGE(PG8_SB(0, 0), cB, voffB); PG8_STAGE(PG8_SB(0, 1), cB + hstep, voffB); PG8_STAGE(PG8_SA(0, 0), cA, voffA); PG8_STAGE(PG8_SA(0, 1), cA + hstep, voffA);
        if (wr == 1) PG8_BAR;
        PG8_WAIT_V(2); PG8_BAR;
        PG8_STAGE(PG8_SB(1, 0), cB + kstep, voffB); PG8_STAGE(PG8_SA(1, 0), cA + kstep, voffA); PG8_STAGE(PG8_SB(1, 1), cB + hstep + kstep, voffB);
        PG8_WAIT_V(6); PG8_BAR;
    } else {
        PG8_STAGE(PG8_SB(0, 0), cB, voffB); PG8_STAGE(PG8_SA(0, 0), cA, voffA); PG8_STAGE(PG8_SB(0, 1), cB + hstep, voffB); PG8_STAGE(PG8_SA(0, 1), cA + hstep, voffA);
        if (wr == 1) PG8_BAR;
        PG8_WAIT_V(4); PG8_BAR;
        PG8_STAGE(PG8_SB(1, 0), cB + kstep, voffB); PG8_STAGE(PG8_SA(1, 0), cA + kstep, voffA); PG8_STAGE(PG8_SB(1, 1), cB + hstep + kstep, voffB);
        PG8_WAIT_V(6); PG8_BAR;
    }
    for (;;) {
        const bool has_next = S.next(ui + 1, nxt);
        const char* nA = has_next ? (const char*)g.A + (size_t)nxt.pm * tstep : cA; const char* nB = has_next ? (const char*)g.Bt + (size_t)nxt.pn * tstep : cB;
        for (int t = 0; t < nt; t += 2) {
            const bool last = (t == nt - 2);
            const char* a1 = cA + (size_t)(t + 1) * kstep;
            const char* a2 = last ? nA : cA + (size_t)(t + 2) * kstep; const char* b2 = last ? nB : cB + (size_t)(t + 2) * kstep;
            const char* a3 = a2 + kstep; const char* b3 = b2 + kstep;
            if (last && has_next) S.a_ready(nxt);
            if constexpr (SP2) {
            PG8_LDB(B0, 0, 0); PG8_LDB(B1, 0, 1); PG8_SCHED; PG8_LDA(At, 0, 0); PG8_STAGE(PG8_SA(1, 1), a1 + hstep, voffA);
            PG8_WAIT_V(8); PG8_WAIT_L(0); PG8_BAR; PG8_MMA(0, 0, At, B0); PG8_MMA(0, 1, At, B1); PG8_BAR; PG8_SCHED;
            PG8_LDA(At, 0, 1); PG8_STAGE(PG8_SB(0, 0), b2, voffB); PG8_STAGE(PG8_SB(0, 1), b2 + hstep, voffB); PG8_STAGE(PG8_SA(0, 0), a2, voffA);
            PG8_WAIT_V(8); PG8_WAIT_L(0); PG8_BAR; PG8_MMA(1, 0, At, B0); PG8_MMA(1, 1, At, B1); PG8_BAR; PG8_SCHED;
            PG8_LDB(B0, 1, 0); PG8_LDB(B1, 1, 1); PG8_SCHED; PG8_LDA(At, 1, 0); PG8_STAGE(PG8_SA(0, 1), a2 + hstep, voffA);
            PG8_WAIT_V(8); PG8_WAIT_L(0); PG8_BAR; PG8_MMA(0, 0, At, B0); PG8_MMA(0, 1, At, B1); PG8_BAR; PG8_SCHED;
            PG8_LDA(At, 1, 1); PG8_STAGE(PG8_SB(1, 0), b3, voffB); PG8_STAGE(PG8_SB(1, 1), b3 + hstep, voffB); PG8_STAGE(PG8_SA(1, 0), a3, voffA);
            PG8_WAIT_V(8); PG8_WAIT_L(0); PG8_BAR; PG8_MMA(1, 0, At, B0); PG8_MMA(1, 1, At, B1); PG8_BAR; PG8_SCHED;
            } else {
            PG8_LDB(B0, 0, 0); PG8_SCHED; PG8_LDA(At, 0, 0); PG8_STAGE(PG8_SA(1, 1), a1 + hstep, voffA);
            PG8_WAIT_L(8); PG8_BAR; PG8_WAIT_L(0); PG8_MMA(0, 0, At, B0); PG8_BAR; PG8_SCHED;
            PG8_LDB(B1, 0, 1); PG8_STAGE(PG8_SB(0, 0), b2, voffB);
            PG8_BAR; PG8_WAIT_L(0); PG8_MMA(0, 1, At, B1); PG8_BAR;
            PG8_LDA(At, 0, 1); PG8_STAGE(PG8_SA(0, 0), a2, voffA);
            PG8_BAR; PG8_WAIT_L(0); PG8_MMA(1, 0, At, B0); PG8_BAR; PG8_SCHED;
            PG8_STAGE(PG8_SB(0, 1), b2 + hstep, voffB);
            PG8_WAIT_V(6); PG8_BAR; PG8_MMA(1, 1, At, B1); PG8_BAR;
            PG8_LDB(B0, 1, 0); PG8_SCHED; PG8_LDA(At, 1, 0); PG8_STAGE(PG8_SA(0, 1), a2 + hstep, voffA);
            PG8_WAIT_L(8); PG8_BAR; PG8_WAIT_L(0); PG8_MMA(0, 0, At, B0); PG8_BAR; PG8_SCHED;
            PG8_LDB(B1, 1, 1); PG8_STAGE(PG8_SB(1, 0), b3, voffB);
            PG8_BAR; PG8_WAIT_L(0); PG8_MMA(0, 1, At, B1); PG8_BAR;
            PG8_LDA(At, 1, 1); PG8_STAGE(PG8_SA(1, 0), a3, voffA);
            PG8_BAR; PG8_WAIT_L(0); PG8_MMA(1, 0, At, B0); PG8_BAR; PG8_SCHED;
            PG8_STAGE(PG8_SB(1, 1), b3 + hstep, voffB);
            PG8_WAIT_V(6); PG8_BAR; PG8_MMA(1, 1, At, B1); PG8_BAR;
            }
        }
        if constexpr (ALIGN_EPI) { if (wr == 0) PG8_BAR; }
        if constexpr (!Epi::AFTER_DRAIN) { E(acc, cur, wr, wc, fr, fq); S.done(cur); }
        if (!has_next) break;
#pragma unroll
        for (int a = 0; a < 2; ++a)
#pragma unroll
            for (int b = 0; b < 2; ++b)
#pragma unroll
                for (int m = 0; m < 4; ++m)
#pragma unroll
                    for (int n = 0; n < 2; ++n) acc[a][b][m][n] = (f32x4){0.f, 0.f, 0.f, 0.f};
        cur = nxt; cA = nA; cB = nB; ++ui;
        if constexpr (ALIGN_EPI) { if (wr == 1) PG8_BAR; }
    }
    PG8_WAIT_V(0);
    if constexpr (!ALIGN_EPI) { if (wr == 0) PG8_BAR; }
    PG8_BAR;
    if constexpr (Epi::AFTER_DRAIN) { E.fused(acc, cur, wr, wc, fr, fq, lds, wid, lane); S.done(cur); }
#undef PG8_SA
#undef PG8_SB
#undef PG8_STAGE
#undef PG8_LDA
#undef PG8_LDB
#undef PG8_MMA
#undef PG8_WAIT_V
#undef PG8_WAIT_L
#undef PG8_BAR
#undef PG8_SCHED
}

struct HybridOrder {
    int nM, nN, nwg, G, c, nt, nfull, R, ns;
    __device__ __forceinline__ void init(int M, int N, int K, int G_, int c_, bool allow_split) {
        nM = M / BM; nN = N / BM; nwg = nM * nN; G = G_; c = c_; nt = K / BK; nfull = nwg / G; R = nwg - nfull * G;
        ns = (allow_split && R > 0 && (R % 8) == 0 && (G % 8) == 0) ? G / R : 1; if (ns > 8) ns = 8; if (ns > nt / 2) ns = nt / 2; if (ns < 2) ns = 1;
    }
    __device__ __forceinline__ void map(int L, Unit& u) const {
        int wgid = L; { const int q = nwg / NXCD, r = nwg % NXCD, xcd = wgid % NXCD, off = wgid / NXCD; wgid = (xcd < r ? xcd * (q + 1) : r * (q + 1) + (xcd - r) * q) + off; }
        const int nig = WGM * nN, gid = wgid / nig, fm = gid * WGM, gsz = (nM - fm) < WGM ? (nM - fm) : WGM;
        u.pm = fm + ((wgid % nig) % gsz); u.pn = (wgid % nig) / gsz;
    }
    __device__ __forceinline__ bool next(int i, Unit& u) const {
        if (i < nfull) { map(i * G + c, u); u.kb = 0; u.nk = nt; u.tinfo = -1; return true; }
        if (i > nfull || R == 0) return false;
        if (ns < 2) { const int L = i * G + c; if (L >= nwg) return false; map(L, u); u.kb = 0; u.nk = nt; u.tinfo = -1; return true; }
        const int x = c % 8, y = c / 8, tj = (y / ns) * 8 + x, slice = y % ns;
        if (tj >= R) return false;
        map(nfull * G + tj, u);
        const int pairs = nt / 2, base = pairs / ns, rem = pairs % ns, start = slice * base + (slice < rem ? slice : rem), mine = base + (slice < rem ? 1 : 0);
        u.kb = 2 * start; u.nk = 2 * mine; u.tinfo = (tj << 8) | (slice << 4) | ns; return true;
    }
};
struct TailCtx { f32x4* slab; unsigned* cnt; };

template <class Epi>
__device__ __forceinline__ void tail_fixup(f32x4 (&acc)[2][2][4][2], const Unit& u, const Epi& E, const TailCtx& T, int tid, int wr, int wc, int fr, int fq) {
    const int tj = u.tinfo >> 8, slice = (u.tinfo >> 4) & 15, ns = u.tinfo & 15;
    const __amdgpu_buffer_rsrc_t srs = __builtin_amdgcn_make_buffer_rsrc((void*)(T.slab + (size_t)(tj * ns + slice) * (32 * 512)), (short)0, 32 * 512 * 16, 0x00020000);
#pragma unroll
    for (int ai = 0; ai < 2; ++ai)
#pragma unroll
        for (int bj = 0; bj < 2; ++bj)
#pragma unroll
            for (int m = 0; m < 4; ++m)
#pragma unroll
                for (int n = 0; n < 2; ++n) __builtin_amdgcn_raw_buffer_store_b128(__builtin_bit_cast(u32x4, acc[ai][bj][m][n]), srs, (unsigned)(((((ai * 2 + bj) * 4 + m) * 2 + n) * 512 + tid) * 16), 0, 16);
    asm volatile("s_waitcnt vmcnt(0)" ::: "memory");
    __syncthreads();
    if (tid == 0) __hip_atomic_fetch_add(T.cnt + 64 * tj, 1u, __ATOMIC_RELAXED, __HIP_MEMORY_SCOPE_AGENT);
    if (tid < 64) {
        unsigned sp = 0;
        while (__hip_atomic_load(T.cnt + 64 * tj, __ATOMIC_RELAXED, __HIP_MEMORY_SCOPE_AGENT) < (unsigned)ns && ++sp < (1u << 22)) __builtin_amdgcn_s_sleep(2);
        __builtin_amdgcn_fence(__ATOMIC_ACQUIRE, "agent");
        asm volatile("s_waitcnt vmcnt(0)" ::: "memory");
    }
    __syncthreads();
    unsigned gmask = 0u;
    for (int g = slice; g < 8; g += ns) gmask |= 1u << g;
    const f32x4* tile = T.slab + (size_t)(tj * ns) * (32 * 512);
#pragma unroll
    for (int ai = 0; ai < 2; ++ai)
#pragma unroll
        for (int m = 0; m < 4; ++m) {
            if (!((gmask >> (ai * 4 + m)) & 1u)) continue;
#pragma unroll
            for (int bj = 0; bj < 2; ++bj)
#pragma unroll
                for (int n = 0; n < 2; ++n) {
                    const int idx = ((ai * 2 + bj) * 4 + m) * 2 + n;
                    f32x4 v = tile[idx * 512 + tid];
                    for (int sl = 1; sl < ns; ++sl) v = v + tile[(size_t)sl * (32 * 512) + idx * 512 + tid];
                    acc[ai][bj][m][n] = v;
                }
        }
    E(acc, u, wr, wc, fr, fq, gmask);
}

template <class Epi, class Sched>
__device__ __forceinline__ void gemm_phase2(PG8_LAS unsigned char* lds, const Gemm g, const Sched& S, const Epi& E, const TailCtx& T) {
    int tid_ = threadIdx.x; asm volatile("" : "+v"(tid_));
    const int tid = tid_, wid = __builtin_amdgcn_readfirstlane(tid >> 6), lane = tid & 63, wr = wid >> 2, wc = wid & 3, fr = lane & 15, fq = lane >> 4;
    const int K = g.K;
    unsigned voffA[2], voffB[2];
#pragma unroll
    for (int i = 0; i < 2; ++i) { int R, C; stage_rc(tid * 16 + i * 8192, R, C); const int Rb = Epi::PERM ? ((R & ~31) + perm32(R & 31)) : R;
        voffA[i] = (unsigned)(R * K + C) * 2u; voffB[i] = (unsigned)(Rb * K + C) * 2u; }
    const size_t kstep = (size_t)(BK * 2), hstep = (size_t)HALF * K * 2, tstep = 2 * hstep;
    const unsigned ldsw = (unsigned)wid * 1024u;
    const int aoff = lds_byte(wr * 64 + fr, fq * 8), boff = lds_byte(wc * 32 + fr, fq * 8);
#define PG8_SA(b, h) (((b) * 2 + (h)) * HTB)
#define PG8_SB(b, h) ((4 + (b) * 2 + (h)) * HTB)
#define PG8_STAGE(bufoff, gbase, voff) do { _Pragma("unroll") for (int _i = 0; _i < 2; ++_i) \
        __builtin_amdgcn_global_load_lds((const unsigned*)((const char*)(gbase) + (voff)[_i]), (PG8_LAS unsigned*)(lds + (bufoff) + ldsw + _i * 8192), 16, 0, 0); } while (0)
#define PG8_LDA(dst, b, h) do { _Pragma("unroll") for (int m = 0; m < 4; ++m) _Pragma("unroll") for (int k = 0; k < 2; ++k) dst[m][k] = *(const PG8_LAS bf16x8*)(lds + PG8_SA(b, h) + aoff + m * 2048 + k * 1024); } while (0)
#define PG8_LDB(dst, b, h) do { _Pragma("unroll") for (int n = 0; n < 2; ++n) _Pragma("unroll") for (int k = 0; k < 2; ++k) dst[n][k] = *(const PG8_LAS bf16x8*)(lds + PG8_SB(b, h) + boff + n * 2048 + k * 1024); } while (0)
#define PG8_MMA(ai, bj, At, Bt) do { __builtin_amdgcn_s_setprio(1); _Pragma("unroll") for (int m = 0; m < 4; ++m) _Pragma("unroll") for (int n = 0; n < 2; ++n) _Pragma("unroll") for (int k = 0; k < 2; ++k) \
        acc[ai][bj][m][n] = __builtin_amdgcn_mfma_f32_16x16x32_bf16(Bt[n][k], At[m][k], acc[ai][bj][m][n], 0, 0, 0); __builtin_amdgcn_s_setprio(0); } while (0)
#define PG8_WAIT_V(n) asm volatile("s_waitcnt vmcnt(" #n ")" ::: "memory")
#define PG8_WAIT_L(n) asm volatile("s_waitcnt lgkmcnt(" #n ")" ::: "memory")
#define PG8_BAR __builtin_amdgcn_s_barrier()
#define PG8_SCHED __builtin_amdgcn_sched_barrier(0)
    Unit cur, nxt; int ui = 0;
    if (!S.next(0, cur)) return;
    f32x4 acc[2][2][4][2];
#pragma unroll
    for (int a = 0; a < 2; ++a)
#pragma unroll
        for (int b = 0; b < 2; ++b)
#pragma unroll
            for (int m = 0; m < 4; ++m)
#pragma unroll
                for (int n = 0; n < 2; ++n) acc[a][b][m][n] = (f32x4){0.f, 0.f, 0.f, 0.f};
    bf16x8 At[4][2], B0[2][2], B1[2][2];
    const char* cA = (const char*)g.A + (size_t)cur.pm * tstep + (size_t)cur.kb * kstep; const char* cB = (const char*)g.Bt + (size_t)cur.pn * tstep + (size_t)cur.kb * kstep;
    PG8_STAGE(PG8_SB(0, 0), cB, voffB); PG8_STAGE(PG8_SB(0, 1), cB + hstep, voffB); PG8_STAGE(PG8_SA(0, 0), cA, voffA); PG8_STAGE(PG8_SA(0, 1), cA + hstep, voffA);
    if (wr == 1) PG8_BAR;
    PG8_WAIT_V(2); PG8_BAR;
    PG8_STAGE(PG8_SB(1, 0), cB + kstep, voffB); PG8_STAGE(PG8_SA(1, 0), cA + kstep, voffA); PG8_STAGE(PG8_SB(1, 1), cB + hstep + kstep, voffB);
    PG8_WAIT_V(6); PG8_BAR;
    for (;;) {
        const bool has_next = S.next(ui + 1, nxt);
        const char* nA = has_next ? (const char*)g.A + (size_t)nxt.pm * tstep + (size_t)nxt.kb * kstep : cA; const char* nB = has_next ? (const char*)g.Bt + (size_t)nxt.pn * tstep + (size_t)nxt.kb * kstep : cB;
        const int nt = cur.nk;
        for (int t = 0; t < nt; t += 2) {
            const bool last = (t == nt - 2);
            const char* a1 = cA + (size_t)(t + 1) * kstep;
            const char* a2 = last ? nA : cA + (size_t)(t + 2) * kstep; const char* b2 = last ? nB : cB + (size_t)(t + 2) * kstep;
            const char* a3 = a2 + kstep; const char* b3 = b2 + kstep;
            PG8_LDB(B0, 0, 0); PG8_LDB(B1, 0, 1); PG8_SCHED; PG8_LDA(At, 0, 0); PG8_STAGE(PG8_SA(1, 1), a1 + hstep, voffA);
            PG8_WAIT_V(8); PG8_WAIT_L(0); PG8_BAR; PG8_MMA(0, 0, At, B0); PG8_MMA(0, 1, At, B1); PG8_BAR; PG8_SCHED;
            PG8_LDA(At, 0, 1); PG8_STAGE(PG8_SB(0, 0), b2, voffB); PG8_STAGE(PG8_SB(0, 1), b2 + hstep, voffB); PG8_STAGE(PG8_SA(0, 0), a2, voffA);
            PG8_WAIT_V(8); PG8_WAIT_L(0); PG8_BAR; PG8_MMA(1, 0, At, B0); PG8_MMA(1, 1, At, B1); PG8_BAR; PG8_SCHED;
            PG8_LDB(B0, 1, 0); PG8_LDB(B1, 1, 1); PG8_SCHED; PG8_LDA(At, 1, 0); PG8_STAGE(PG8_SA(0, 1), a2 + hstep, voffA);
            PG8_WAIT_V(8); PG8_WAIT_L(0); PG8_BAR; PG8_MMA(0, 0, At, B0); PG8_MMA(0, 1, At, B1); PG8_BAR; PG8_SCHED;
            PG8_LDA(At, 1, 1); PG8_STAGE(PG8_SB(1, 0), b3, voffB); PG8_STAGE(PG8_SB(1, 1), b3 + hstep, voffB); PG8_STAGE(PG8_SA(1, 0), a3, voffA);
            PG8_WAIT_V(8); PG8_WAIT_L(0); PG8_BAR; PG8_MMA(1, 0, At, B0); PG8_MMA(1, 1, At, B1); PG8_BAR; PG8_SCHED;
        }
        if (wr == 0) PG8_BAR;
        if (cur.tinfo < 0) E(acc, cur, wr, wc, fr, fq);
        if (!has_next) break;
#pragma unroll
        for (int a = 0; a < 2; ++a)
#pragma unroll
            for (int b = 0; b < 2; ++b)
#pragma unroll
                for (int m = 0; m < 4; ++m)
#pragma unroll
                    for (int n = 0; n < 2; ++n) acc[a][b][m][n] = (f32x4){0.f, 0.f, 0.f, 0.f};
        cur = nxt; cA = nA; cB = nB; ++ui;
        if (wr == 1) PG8_BAR;
    }
    PG8_WAIT_V(0);
    PG8_BAR;
    if (cur.tinfo >= 0) tail_fixup(acc, cur, E, T, tid, wr, wc, fr, fq);
#undef PG8_SA
#undef PG8_SB
#undef PG8_STAGE
#undef PG8_LDA
#undef PG8_LDB
#undef PG8_MMA
#undef PG8_WAIT_V
#undef PG8_WAIT_L
#undef PG8_BAR
#undef PG8_SCHED
}

struct MUnit { int kind, pm, pn, kb, nk, tinfo; };
struct MOrder {
    int c;
    __device__ __forceinline__ bool next(int i, MUnit& u) const {
        const int j = i * 256 + c;
        u.kb = 0; u.tinfo = -1;
        if (j < 288) { u.kind = 0; u.nk = D / BK;
            if (j < 256) { const int x = j & 7, r = j >> 3; u.pm = 4 * x + (r >> 3); u.pn = r & 7; } else { const int t = j - 256; u.pm = 32 + (t >> 3); u.pn = t & 7; }
            return true; }
        if (j < 1872) { u.kind = 1; u.nk = D / BK; const int L = j - 288;
            if (L < 1408) { const int x = L & 7, off = L >> 3, wg = x * 176 + off, gid = wg / 352, rem = wg % 352; u.pm = gid * 8 + (rem & 7); u.pn = rem >> 3; }
            else { const int t = L - 1408; u.pm = 32 + (t & 3); u.pn = t >> 2; }
            return true; }
        if (j < 2128) { u.kind = 2; u.nk = DFF / BK; const int L = j - 1872, x = L & 7, r = L >> 3; u.pm = 4 * x + (r >> 3); u.pn = r & 7; return true; }
        const int ilast = (c < 80) ? 9 : 8;
        if (i != ilast || c < 80 || c >= 208) return false;
        const int mi = c - 80, tj = mi >> 2, slice = mi & 3;
        u.kind = 2; u.pm = 32 + (tj >> 3); u.pn = tj & 7; u.kb = slice * 22; u.nk = 22; u.tinfo = (tj << 8) | (slice << 4) | 4; return true;
    }
};

struct StreamOff { size_t A0, B0, A1, B1, A2, B2, x2b, slab; int dep3, dep4, tail, rsq2, rsq3; };
template <class SO>
__device__ __forceinline__ void gemm_stream(PG8_LAS unsigned char* lds, const MOrder& S, unsigned char* ws, const float* xp, const float* xs, const SO O) {
    int tid_ = threadIdx.x; asm volatile("" : "+v"(tid_));
    const int tid = tid_, wid = __builtin_amdgcn_readfirstlane(tid >> 6), lane = tid & 63, wr = wid >> 2, wc = wid & 3, fr = lane & 15, fq = lane >> 4;
    unsigned Ra[2][2], Rb[2][2];
#pragma unroll
    for (int i = 0; i < 2; ++i) { int R, C; stage_rc(tid * 16 + i * 8192, R, C); const int Rp = (R & ~31) + perm32(R & 31);
        Ra[0][i] = (unsigned)(R * D + C) * 2u; Ra[1][i] = (unsigned)(R * DFF + C) * 2u; Rb[0][i] = (unsigned)(Rp * D + C) * 2u; Rb[1][i] = (unsigned)(Rp * DFF + C) * 2u; }
    const size_t kstep = (size_t)(BK * 2);
    const unsigned ldsw = (unsigned)wid * 1024u;
    const int aoff = lds_byte(wr * 64 + fr, fq * 8), boff = lds_byte(wc * 32 + fr, fq * 8);
#define PG8_SA(b, h) (((b) * 2 + (h)) * HTB)
#define PG8_SB(b, h) ((4 + (b) * 2 + (h)) * HTB)
#define PG8_STG(bufoff, gbase, Rr, rowb) do { _Pragma("unroll") for (int _i = 0; _i < 2; ++_i) \
        __builtin_amdgcn_global_load_lds((const unsigned*)((const char*)(gbase) + ((rowb) == D * 2 ? (Rr)[0][_i] : (Rr)[1][_i])), (PG8_LAS unsigned*)(lds + (bufoff) + ldsw + _i * 8192), 16, 0, 0); } while (0)
#define PG8_LDA(dst, b, h) do { _Pragma("unroll") for (int m = 0; m < 4; ++m) _Pragma("unroll") for (int k = 0; k < 2; ++k) dst[m][k] = *(const PG8_LAS bf16x8*)(lds + PG8_SA(b, h) + aoff + m * 2048 + k * 1024); } while (0)
#define PG8_LDB(dst, b, h) do { _Pragma("unroll") for (int n = 0; n < 2; ++n) _Pragma("unroll") for (int k = 0; k < 2; ++k) dst[n][k] = *(const PG8_LAS bf16x8*)(lds + PG8_SB(b, h) + boff + n * 2048 + k * 1024); } while (0)
#define PG8_MMA(ai, bj, At, Bt) do { __builtin_amdgcn_s_setprio(1); _Pragma("unroll") for (int m = 0; m < 4; ++m) _Pragma("unroll") for (int n = 0; n < 2; ++n) _Pragma("unroll") for (int k = 0; k < 2; ++k) \
        acc[ai][bj][m][n] = __builtin_amdgcn_mfma_f32_16x16x32_bf16(Bt[n][k], At[m][k], acc[ai][bj][m][n], 0, 0, 0); __builtin_amdgcn_s_setprio(0); } while (0)
#define PG8_WAIT_V(n) asm volatile("s_waitcnt vmcnt(" #n ")" ::: "memory")
#define PG8_WAIT_L(n) asm volatile("s_waitcnt lgkmcnt(" #n ")" ::: "memory")
#define PG8_BAR __builtin_amdgcn_s_barrier()
#define PG8_SCHED __builtin_amdgcn_sched_barrier(0)
#define MU_A(u) ((const char*)ws + ((u).kind == 0 ? O.A0 : (u).kind == 1 ? O.A1 : O.A2) + (size_t)(u).pm * 256 * MU_RB(u) + (size_t)(u).kb * kstep)
#define MU_B(u) ((const char*)ws + ((u).kind == 0 ? O.B0 : (u).kind == 1 ? O.B1 : O.B2) + (size_t)(u).pn * 256 * MU_RB(u) + (size_t)(u).kb * kstep)
#define MU_RB(u) ((u).kind == 2 ? DFF * 2 : D * 2)
    unsigned long long rdy3 = 0ull, rdy4 = 0ull;
#define MU_READY(u) do { if ((u).kind != 0) { unsigned long long& _m = (u).kind == 1 ? rdy3 : rdy4; if (!((_m >> (u).pm) & 1ull)) { \
        if (wid == 0) { unsigned* _c = (unsigned*)ws + ((u).kind == 1 ? O.dep3 : O.dep4) + 64 * (u).pm; const unsigned _t = (u).kind == 1 ? 64u : 352u; unsigned _sp = 0; \
            while (__hip_atomic_load(_c, __ATOMIC_RELAXED, __HIP_MEMORY_SCOPE_AGENT) < _t && ++_sp < (1u << 22)) __builtin_amdgcn_s_sleep(2); \
            __builtin_amdgcn_fence(__ATOMIC_ACQUIRE, "agent"); asm volatile("s_waitcnt vmcnt(0)" ::: "memory"); } \
        asm volatile("" ::: "memory"); PG8_BAR; asm volatile("" ::: "memory"); _m |= 1ull << (u).pm; } } } while (0)
    PG8_LAS unsigned* vflag = (PG8_LAS unsigned*)(lds + 147456 - 256 + 64);
#define MU_TRY(u, ok) do { ok = true; if ((u).kind != 0) { unsigned long long& _m = (u).kind == 1 ? rdy3 : rdy4; if (!((_m >> (u).pm) & 1ull)) { \
        if (wid == 0) { unsigned* _c = (unsigned*)ws + ((u).kind == 1 ? O.dep3 : O.dep4) + 64 * (u).pm; const unsigned _t = (u).kind == 1 ? 64u : 352u; \
            const bool _r = __hip_atomic_load(_c, __ATOMIC_RELAXED, __HIP_MEMORY_SCOPE_AGENT) >= _t; \
            if (_r) { __builtin_amdgcn_fence(__ATOMIC_ACQUIRE, "agent"); asm volatile("s_waitcnt vmcnt(0)" ::: "memory"); } \
            if (lane == 0) *vflag = _r ? 1u : 0u; asm volatile("s_waitcnt lgkmcnt(0)" ::: "memory"); } \
        asm volatile("" ::: "memory"); PG8_BAR; asm volatile("" ::: "memory"); \
        ok = (*(volatile PG8_LAS unsigned*)vflag) != 0u; if (ok) _m |= 1ull << (u).pm; } } } while (0)
    MUnit cur, nxt; int ui = 0;
    if (!S.next(0, cur)) return;
    f32x4 acc[2][2][4][2];
#pragma unroll
    for (int a = 0; a < 2; ++a)
#pragma unroll
        for (int b = 0; b < 2; ++b)
#pragma unroll
            for (int m = 0; m < 4; ++m)
#pragma unroll
                for (int n = 0; n < 2; ++n) acc[a][b][m][n] = (f32x4){0.f, 0.f, 0.f, 0.f};
    bf16x8 At[4][2], B0[2][2], B1[2][2];
    bool more = true;
    while (more) {
#ifdef TPROBE
    if (threadIdx.x == 0 && cur.tinfo >= 0) ((volatile PG8_LAS unsigned long long*)(lds + 147456 - 256 + 128))[10] = __builtin_amdgcn_s_memrealtime();
#endif
    MU_READY(cur);
    const char* cA = MU_A(cur); const char* cB = MU_B(cur); int crb = MU_RB(cur);
    PG8_STG(PG8_SB(0, 0), cB, Rb, crb); PG8_STG(PG8_SB(0, 1), cB + (size_t)HALF * crb, Rb, crb); PG8_STG(PG8_SA(0, 0), cA, Ra, crb); PG8_STG(PG8_SA(0, 1), cA + (size_t)HALF * crb, Ra, crb);
    if (wr == 1) PG8_BAR;
    PG8_WAIT_V(2); PG8_BAR;
    PG8_STG(PG8_SB(1, 0), cB + kstep, Rb, crb); PG8_STG(PG8_SA(1, 0), cA + kstep, Ra, crb); PG8_STG(PG8_SB(1, 1), cB + (size_t)HALF * crb + kstep, Rb, crb);
    PG8_WAIT_V(6); PG8_BAR;
    for (;;) {
        const bool has_next = S.next(ui + 1, nxt);
        bool chain = has_next;
        const char* nA = cA; const char* nB = cB; int nrb = crb;
        const int nt = cur.nk;
        for (int t = 0; t < nt; t += 2) {
            const bool last = (t == nt - 2);
            if (last && has_next) { MU_TRY(nxt, chain); if (chain) { nA = MU_A(nxt); nB = MU_B(nxt); nrb = MU_RB(nxt); } }
            const char* a1 = cA + (size_t)(t + 1) * kstep;
            const char* a2 = last ? nA : cA + (size_t)(t + 2) * kstep; const char* b2 = last ? nB : cB + (size_t)(t + 2) * kstep; const int rb2 = last ? nrb : crb;
            const char* a3 = a2 + kstep; const char* b3 = b2 + kstep;
            const size_t h1 = (size_t)HALF * crb, h2 = (size_t)HALF * rb2;
            PG8_LDB(B0, 0, 0); PG8_LDB(B1, 0, 1); PG8_SCHED; PG8_LDA(At, 0, 0); PG8_STG(PG8_SA(1, 1), a1 + h1, Ra, crb);
            PG8_WAIT_V(8); PG8_WAIT_L(0); PG8_BAR; PG8_MMA(0, 0, At, B0); PG8_MMA(0, 1, At, B1); PG8_BAR; PG8_SCHED;
            PG8_LDA(At, 0, 1); PG8_STG(PG8_SB(0, 0), b2, Rb, rb2); PG8_STG(PG8_SB(0, 1), b2 + h2, Rb, rb2); PG8_STG(PG8_SA(0, 0), a2, Ra, rb2);
            PG8_WAIT_V(8); PG8_WAIT_L(0); PG8_BAR; PG8_MMA(1, 0, At, B0); PG8_MMA(1, 1, At, B1); PG8_BAR; PG8_SCHED;
            PG8_LDB(B0, 1, 0); PG8_LDB(B1, 1, 1); PG8_SCHED; PG8_LDA(At, 1, 0); PG8_STG(PG8_SA(0, 1), a2 + h2, Ra, rb2);
            PG8_WAIT_V(8); PG8_WAIT_L(0); PG8_BAR; PG8_MMA(0, 0, At, B0); PG8_MMA(0, 1, At, B1); PG8_BAR; PG8_SCHED;
            PG8_LDA(At, 1, 1); PG8_STG(PG8_SB(1, 0), b3, Rb, rb2); PG8_STG(PG8_SB(1, 1), b3 + h2, Rb, rb2); PG8_STG(PG8_SA(1, 0), a3, Ra, rb2);
            PG8_WAIT_V(8); PG8_WAIT_L(0); PG8_BAR; PG8_MMA(1, 0, At, B0); PG8_MMA(1, 1, At, B1); PG8_BAR; PG8_SCHED;
        }
        if (wr == 0) PG8_BAR;
        if (cur.tinfo < 0) {
            const Unit u{cur.pm, cur.pn, 0, 0, -1};
            if (cur.kind == 0) { const EpiX1<false> E0{xp, xs, nullptr, (bf16_t*)(ws + O.A1), (float*)ws + O.rsq2, true}; E0(acc, u, wr, wc, fr, fq); }
            else if (cur.kind == 1) { const EpiAct E1{(bf16_t*)(ws + O.A2), (const float*)ws + O.rsq2, true}; E1(acc, u, wr, wc, fr, fq); }
            else { const EpiX2<false> E2{(bf16_t*)(ws + O.x2b), (float*)ws + O.rsq3, (const bf16_t*)(ws + O.A1)}; E2(acc, u, wr, wc, fr, fq); }
            if (cur.kind != 2) {
                asm volatile("s_waitcnt vmcnt(0)" ::: "memory");
                if (lane == 0) __hip_atomic_fetch_add((unsigned*)ws + (cur.kind == 0 ? O.dep3 : O.dep4) + 64 * cur.pm, 1u, __ATOMIC_RELAXED, __HIP_MEMORY_SCOPE_AGENT);
            }
        }
        if (!has_next) { more = false; break; }
        if (!chain) {
            PG8_WAIT_V(0); PG8_BAR;
#pragma unroll
            for (int a = 0; a < 2; ++a)
#pragma unroll
                for (int b = 0; b < 2; ++b)
#pragma unroll
                    for (int m = 0; m < 4; ++m)
#pragma unroll
                        for (int n = 0; n < 2; ++n) acc[a][b][m][n] = (f32x4){0.f, 0.f, 0.f, 0.f};
            cur = nxt; ++ui;
            break;
        }
#pragma unroll
        for (int a = 0; a < 2; ++a)
#pragma unroll
            for (int b = 0; b < 2; ++b)
#pragma unroll
                for (int m = 0; m < 4; ++m)
#pragma unroll
                    for (int n = 0; n < 2; ++n) acc[a][b][m][n] = (f32x4){0.f, 0.f, 0.f, 0.f};
        cur = nxt; cA = nA; cB = nB; crb = nrb; ++ui;
        if (wr == 1) PG8_BAR;
    }
    }
    PG8_WAIT_V(0);
    PG8_BAR;
#ifdef TPROBE
    if (threadIdx.x == 0) ((volatile PG8_LAS unsigned long long*)(lds + 147456 - 256 + 128))[9] = __builtin_amdgcn_s_memrealtime();
#endif
    if (cur.tinfo >= 0) { const Unit u{cur.pm, cur.pn, cur.kb, cur.nk, cur.tinfo}; const EpiX2<false> E2{(bf16_t*)(ws + O.x2b), (float*)ws + O.rsq3, (const bf16_t*)(ws + O.A1)};
        const TailCtx T{(f32x4*)(ws + O.slab), (unsigned*)ws + O.tail}; tail_fixup(acc, u, E2, T, tid, wr, wc, fr, fq); }
#undef MU_TRY
#undef MU_A
#undef MU_B
#undef MU_RB
#undef MU_READY
#undef PG8_SA
#undef PG8_SB
#undef PG8_STG
#undef PG8_LDA
#undef PG8_LDB
#undef PG8_MMA
#undef PG8_WAIT_V
#undef PG8_WAIT_L
#undef PG8_BAR
#undef PG8_SCHED
}
}
#define LAS __attribute__((address_space(3)))
typedef unsigned short bf16;
using pg8::f32x4; using pg8::u32x4; using pg8::u32x2; using pg8::bf16x8; using pg8::cvt_pk_bf16;

#ifndef ONE_LAUNCH
#define ONE_LAUNCH 1
#endif
constexpr int NWAVES = 8, NPHASE = 7;
constexpr int LDS_BYTES = 147456;
constexpr size_t MiB = 1u << 20;
constexpr size_t WS_CTL = 0, CTL_ZERO_BYTES = 1 * MiB;
constexpr size_t WS_WIN = 1 * MiB;
constexpr size_t WS_WO = 21 * MiB;
constexpr size_t WS_WGU = 29 * MiB;
constexpr size_t WS_WD = 73 * MiB;
constexpr size_t WS_WP = 95 * MiB;
constexpr size_t WS_MISC = 96 * MiB;
constexpr size_t WS_XB = 97 * MiB;
constexpr size_t WS_ZB = 133 * MiB;
constexpr size_t WS_LF = 223 * MiB;
constexpr size_t WS_ACT = WS_ZB;
constexpr size_t WS_MIX = 259 * MiB;
constexpr size_t WS_X2B = WS_WGU;
constexpr size_t WS_END = 328 * MiB;
constexpr int CW_RSQ2 = 4096, CW_RSQ3 = 4096 + M;
constexpr int CW_TAIL = 100000;
constexpr size_t WS_SLAB3 = WS_ACT, WS_SLAB45 = 232 * MiB;
constexpr int CW_DEP = 124000;
constexpr size_t WS_SLABM = 296 * MiB;
#ifndef MERGED
#define MERGED 1
#endif
constexpr int CW_BAR = 65536;
constexpr int MISC_OFF = 147456 - 256;
#ifndef USE_CG
#define USE_CG 0
#endif

__device__ __forceinline__ float wave_sum(float v) {
#pragma unroll
    for (int o = 1; o < 64; o <<= 1) v += __shfl_xor(v, o);
    return v;
}
__device__ __forceinline__ float bflo(unsigned w) { return __builtin_bit_cast(float, w << 16); }
__device__ __forceinline__ float bfhi(unsigned w) { return __builtin_bit_cast(float, w & 0xffff0000u); }
__device__ __forceinline__ float bf2f(bf16 b) { return __builtin_bit_cast(float, (unsigned)b << 16); }
__device__ __forceinline__ bf16 f2bf(float f) { unsigned u = __builtin_bit_cast(unsigned, f); return (bf16)((u + 0x7fffu + ((u >> 16) & 1u)) >> 16); }

#define XB_TMO      128
#define XB_XCNT(j)  (256  + 64 * (j))
#define XB_XSUB(j)  (1280 + 64 * (j))
#define XB_XGEN(j)  (2304 + 64 * (j))
#define XB_TOP      3328
#define XB_TOPGEN   3392
#define XCD_BAR_WORDS 3456
#define XB_SPIN_CAP (1u << 18)

__device__ __forceinline__ unsigned xb_ld(unsigned* p)              { return __hip_atomic_load(p, __ATOMIC_RELAXED, __HIP_MEMORY_SCOPE_AGENT); }
__device__ __forceinline__ unsigned xb_add(unsigned* p, unsigned v) { return __hip_atomic_fetch_add(p, v, __ATOMIC_RELAXED, __HIP_MEMORY_SCOPE_AGENT); }
__device__ __forceinline__ unsigned xb_xcc_id() { return (unsigned)__builtin_amdgcn_s_getreg((3 << 11) | 20) & 0xFu; }
#define XB_SPIN(cond, bar) do { unsigned _sp = 0; while (cond) { __builtin_amdgcn_s_sleep(1); \
    if ((++_sp & 255u) == 0u) { if (xb_ld(&(bar)[XB_TMO])) break; if (_sp > XB_SPIN_CAP) { atomicAdd(&(bar)[XB_TMO], 1u); break; } } } } while (0)

struct XcdBarrier {
    unsigned* bar; unsigned x;
    volatile LAS unsigned* st;
};

__device__ __forceinline__ XcdBarrier xcd_barrier_post(unsigned* bar, volatile LAS unsigned* st) {
    XcdBarrier b; b.bar = bar; b.x = xb_xcc_id(); b.st = st;
    if (threadIdx.x == 0) (void)xb_add(&bar[XB_XCNT(b.x)], 1u);
    return b;
}
__device__ __forceinline__ void xcd_barrier_complete(unsigned* bar, unsigned x, unsigned& nloc, unsigned& nx) {
    const unsigned G = gridDim.x * gridDim.y * gridDim.z;
    unsigned sum, cnt, mine, sp = 0u;
    for (;;) {
        sum = 0u; cnt = 0u; mine = 0u;
#pragma unroll
        for (unsigned j = 0; j < 16; ++j) { const unsigned c = xb_ld(&bar[XB_XCNT(j)]); sum += c; cnt += (c > 0u) ? 1u : 0u; mine = (j == x) ? c : mine; }
        if (sum == G) break;
        __builtin_amdgcn_s_sleep(1);
        if ((++sp & 255u) == 0u) { if (xb_ld(&bar[XB_TMO])) break; if (sp > XB_SPIN_CAP) { atomicAdd(&bar[XB_TMO], 1u); break; } }
    }
    nloc = mine > 0u ? mine : 1u; nx = cnt > 0u ? cnt : 1u;
}

__device__ __forceinline__ void xcd_barrier(const XcdBarrier& b) {
    asm volatile("s_waitcnt vmcnt(0)" ::: "memory");
    __syncthreads();
    if (threadIdx.x == 0) {
        unsigned* bar = b.bar;
        __builtin_amdgcn_s_waitcnt(0);
        unsigned nloc = b.st[0], nx = b.st[1];
        if (nloc == 0u) { xcd_barrier_complete(bar, b.x, nloc, nx); b.st[0] = nloc; b.st[1] = nx; }
        const unsigned old = xb_add(&bar[XB_XSUB(b.x)], 1u);
        const unsigned gen = old / nloc;
        if (old + 1u == (gen + 1u) * nloc) {
            __builtin_amdgcn_fence(__ATOMIC_RELEASE, "agent");
            asm volatile("s_waitcnt vmcnt(0)" ::: "memory");
            const unsigned og = xb_add(&bar[XB_TOP], 1u);
            const unsigned tg = og / nx;
            if (og + 1u == (tg + 1u) * nx) xb_add(&bar[XB_TOPGEN], 1u);
            else XB_SPIN(xb_ld(&bar[XB_TOPGEN]) == tg, bar);
            __builtin_amdgcn_fence(__ATOMIC_ACQUIRE, "agent");
            xb_add(&bar[XB_XGEN(b.x)], 1u);
            asm volatile("s_waitcnt vmcnt(0)" ::: "memory");
        } else {
            XB_SPIN(xb_ld(&bar[XB_XGEN(b.x)]) == gen, bar);
            __builtin_amdgcn_fence(__ATOMIC_ACQUIRE, "agent");
            asm volatile("s_waitcnt vmcnt(0)" ::: "memory");
        }
    }
    __syncthreads();
}


#ifdef TPROBE
#define STAMP(i) do { if (threadIdx.x == 0) ((volatile LAS unsigned long long*)(lds + MISC_OFF + 128))[i] = __builtin_amdgcn_s_memrealtime(); } while (0)
#else
#define STAMP(i) do {} while (0)
#endif
constexpr int CW_TP = 120000;

struct Args { const float* in[16]; float* out; unsigned char* ws; int ph_lo, ph_hi; };

__device__ __forceinline__ void p0_item(const float* W, int K, int N, bf16* WT, int mode, const float* sk, const float* sn, LAS float* scr, int item, int lane) {
    const int nblk = N / 64, kb = item / nblk, nb = item % nblk, k0 = 64 * kb, n0 = 64 * nb;
    const int drow0 = mode == 0 ? n0 : ((n0 >> 7) * 256 + (n0 & 127) + (mode == 2 ? 128 : 0));
    const int r = lane >> 4, c4 = lane & 15;
    f32x4 v[16];
#pragma unroll
    for (int i = 0; i < 16; ++i) v[i] = __builtin_nontemporal_load((const f32x4*)(W + (size_t)(k0 + 4 * i + r) * N + n0 + 4 * c4));
    if (sk) {
#pragma unroll
        for (int i = 0; i < 16; ++i) v[i] = v[i] * sk[k0 + 4 * i + r];
    }
#pragma unroll
    for (int i = 0; i < 16; ++i) { LAS float* d = scr + (4 * i + r) * 65 + 4 * c4; d[0] = v[i][0]; d[1] = v[i][1]; d[2] = v[i][2]; d[3] = v[i][3]; }
    asm volatile("s_waitcnt lgkmcnt(0)" ::: "memory");
    const int c = lane & 7, nn = lane >> 3;
#pragma unroll
    for (int j = 0; j < 8; ++j) { const int n = nn + 8 * j; const LAS float* s = scr + (8 * c) * 65 + n; const float f = sn ? sn[n0 + n] : 1.f;
        u32x4 o; o.x = cvt_pk_bf16(s[0 * 65] * f, s[1 * 65] * f); o.y = cvt_pk_bf16(s[2 * 65] * f, s[3 * 65] * f); o.z = cvt_pk_bf16(s[4 * 65] * f, s[5 * 65] * f); o.w = cvt_pk_bf16(s[6 * 65] * f, s[7 * 65] * f);
        *(u32x4*)(WT + (size_t)(drow0 + n) * K + k0 + 8 * c) = o; }
    asm volatile("s_waitcnt lgkmcnt(0)" ::: "memory");
}

constexpr int P0_I_IN = (D / 64) * (INC / 64), P0_I_O = (D / 64) * (D / 64), P0_I_G = (D / 64) * (DFF / 64), P0_I_D = (DFF / 64) * (D / 64), P0_I_P = (256 / 64) * (256 / 64);
constexpr int P0_NITEMS = P0_I_IN + P0_I_O + 2 * P0_I_G + P0_I_D + 4 * P0_I_P;
#ifndef P0_NDEF
#define P0_NDEF 3328
#endif
constexpr int P0_DEF_HI = P0_I_IN + P0_I_O + 2 * P0_I_G + P0_I_D, P0_DEF_LO = P0_DEF_HI - P0_NDEF;
__device__ __forceinline__ int p1_idle_wgs(int G) { const int nwg = (M / 256) * (INC / 256), nfull = nwg / G, R = nwg - nfull * G; return R > 0 ? G - R : 0; }
__device__ __forceinline__ void p0_weight_item(const Args& a, LAS float* scr, int it, int lane) {
    unsigned char* ws = a.ws;
    int r = it;
    if (r < P0_I_IN) { p0_item(a.in[6], D, INC, (bf16*)(ws + WS_WIN), 0, a.in[5], nullptr, scr, r, lane); return; } r -= P0_I_IN;
    if (r < P0_I_O) { p0_item(a.in[10], D, D, (bf16*)(ws + WS_WO), 0, nullptr, nullptr, scr, r, lane); return; } r -= P0_I_O;
    if (r < P0_I_G) { p0_item(a.in[12], D, DFF, (bf16*)(ws + WS_WGU), 1, a.in[11], nullptr, scr, r, lane); return; } r -= P0_I_G;
    if (r < P0_I_G) { p0_item(a.in[13], D, DFF, (bf16*)(ws + WS_WGU), 2, a.in[11], nullptr, scr, r, lane); return; } r -= P0_I_G;
    if (r < P0_I_D) { p0_item(a.in[14], DFF, D, (bf16*)(ws + WS_WD), 0, nullptr, nullptr, scr, r, lane); return; } r -= P0_I_D;
    { const int g = r / P0_I_P; p0_item(a.in[7] + (size_t)g * 65536, 256, 256, (bf16*)(ws + WS_WP) + (size_t)g * 65536, 0, nullptr, a.in[8] + g * 256, scr, r % P0_I_P, lane); }
}
__device__ __forceinline__ void phase0_deferred(LAS unsigned char* lds, const Args& a, int idle_idx, int nidle) {
    const int lane = threadIdx.x & 63, wave = threadIdx.x >> 6;
    LAS float* scr = (LAS float*)(lds + wave * 16640);
    for (int it = P0_DEF_LO + idle_idx * NWAVES + wave; it < P0_DEF_HI; it += nidle * NWAVES) p0_weight_item(a, scr, it, lane);
}
__device__ __forceinline__ void phase0(LAS unsigned char* lds, const Args& a, int vcu, int G) {
    const int tid = threadIdx.x, lane = tid & 63, wave = tid >> 6;
    unsigned char* ws = a.ws;
    LAS float* scr = (LAS float*)(lds + wave * 16640);
    const int gw = vcu * NWAVES + wave, NGW = G * NWAVES;
    const bool defer = p1_idle_wgs(G) >= 32;
    const int nlive = defer ? P0_NITEMS - (P0_DEF_HI - P0_DEF_LO) : P0_NITEMS;
    for (int k = gw; k < nlive; k += NGW) p0_weight_item(a, scr, (defer && k >= P0_DEF_LO) ? k + (P0_DEF_HI - P0_DEF_LO) : k, lane);
    float* rstd1 = (float*)(ws + WS_MISC); bf16* xb = (bf16*)(ws + WS_XB);
    for (int m = gw; m < M; m += NGW) {
        const float* xrow = m < MP ? a.in[0] + (size_t)m * D : a.in[1] + (size_t)(m - MP) * D;
        f32x4 v[8]; float s = 0.f;
#pragma unroll
        for (int j = 0; j < 8; ++j) { v[j] = __builtin_nontemporal_load((const f32x4*)xrow + lane + 64 * j); s += (v[j][0] * v[j][0] + v[j][1] * v[j][1]) + (v[j][2] * v[j][2] + v[j][3] * v[j][3]); }
        s = wave_sum(s);
        if (lane == 0) rstd1[m] = rsqrtf(s * (1.f / D) + EPS);
#pragma unroll
        for (int j = 0; j < 8; ++j) { u32x2 w; w.x = cvt_pk_bf16(v[j][0], v[j][1]); w.y = cvt_pk_bf16(v[j][2], v[j][3]); ((u32x2*)(xb + (size_t)m * D))[lane + 64 * j] = w; }
    }
    { u32x4* cz = (u32x4*)(ws + WS_CTL); const int gt0 = vcu * (NWAVES * 64) + tid, ngt0 = G * NWAVES * 64;
      for (int i = gt0; i < (int)(CTL_ZERO_BYTES / 16); i += ngt0) if (i < CW_BAR / 4 || i >= (CW_BAR + XCD_BAR_WORDS + 3) / 4) cz[i] = (u32x4){0u, 0u, 0u, 0u}; }
    const int gt = vcu * (NWAVES * 64) + tid, NGT = G * NWAVES * 64;
    float* lbv = (float*)(ws + WS_MISC) + M;
    for (int c = gt; c < HW; c += NGT) lbv[c] = 1.f / (1.f + __expf(a.in[4][HW + c] - a.in[4][c]));
    for (int i = gt; i < DB * 7 * PW; i += NGT) { const int b = i / (7 * PW), rem = i % (7 * PW); a.out[O_PSS + (size_t)b * PC * PW + rem] = a.in[2][(size_t)b * PC * PW + 8 * PW + rem]; }
}

template <int W, bool SAMPLE>
__device__ __forceinline__ void pool_fill(LAS bf16* A, int m0, int g, const bf16* zb, const float* cache) {
    const int tid = threadIdx.x, c8 = tid & 31, rq = tid >> 5;
    constexpr int LDA = 264;
    const int col = g * 256 + 8 * c8;
    u32x4 ur[19];
    int tb;
    if (!SAMPLE) {
        const int mb = m0 + 4 * rq - 15; tb = (m0 & (SEQ - 1)) + 4 * rq - 15;
#pragma unroll
        for (int e = 0; e < 19; ++e) ur[e] = (tb + e >= 0) ? *(const u32x4*)(zb + (size_t)(mb + e) * INC + col) : (u32x4){0u, 0u, 0u, 0u};
    } else {
        const int r0 = 4 * rq, m = m0 + r0, b = (m - MP) >> 3, t0 = r0 & 7; tb = t0 - 15;
#pragma unroll
        for (int e = 0; e < 19; ++e) {
            const int tau = tb + e;
            if (tau >= 0) ur[e] = *(const u32x4*)(zb + (size_t)(m - t0 + tau) * INC + col);
            else { const float* cr = cache + ((size_t)b * PC + (PC + tau)) * PW + col; const f32x4 c0 = *(const f32x4*)cr, c1 = *(const f32x4*)(cr + 4);
                   ur[e] = (u32x4){cvt_pk_bf16(c0[0], c0[1]), cvt_pk_bf16(c0[2], c0[3]), cvt_pk_bf16(c1[0], c1[1]), cvt_pk_bf16(c1[2], c1[3])}; }
        }
    }
    float out[4][8];
#pragma unroll
    for (int cp = 0; cp < 4; ++cp)
#pragma unroll
        for (int hf = 0; hf < 2; ++hf) {
#define PVAL(e) (hf ? bfhi(ur[e][cp]) : bflo(ur[e][cp]))
            float sw = 0.f;
#pragma unroll
            for (int j = 1; j < W; ++j) sw += PVAL(15 - j);
#pragma unroll
            for (int r = 0; r < 4; ++r) {
                const float um = PVAL(15 + r);
                sw += um;
                const float cnt = SAMPLE ? (float)W : (float)min(tb + 15 + r + 1, W);
                out[r][2 * cp + hf] = sw / cnt - um;
                sw -= PVAL(15 + r - (W - 1));
            }
#undef PVAL
        }
#pragma unroll
    for (int r = 0; r < 4; ++r) {
        u32x4 w; w.x = cvt_pk_bf16(out[r][0], out[r][1]); w.y = cvt_pk_bf16(out[r][2], out[r][3]); w.z = cvt_pk_bf16(out[r][4], out[r][5]); w.w = cvt_pk_bf16(out[r][6], out[r][7]);
        *(LAS u32x4*)(A + (4 * rq + r) * LDA + 8 * c8) = w;
    }
}
__device__ __forceinline__ void pool_item(LAS unsigned char* lds, int item, const bf16* zb, const float* cache, const bf16* WpT, bf16* mixb) {
    const int tile = item >> 2, g = item & 3, m0 = tile * 64;
    const int tid = threadIdx.x;
    constexpr int LDA = 264;
    LAS bf16* A = (LAS bf16*)lds;
    const int wave = tid >> 6, lane = tid & 63, fr = lane & 15, fq = lane >> 4, n0 = wave * 32;
    if (m0 < MP) { if (g == 0) pool_fill<2, false>(A, m0, g, zb, cache); else if (g == 1) pool_fill<4, false>(A, m0, g, zb, cache); else if (g == 2) pool_fill<8, false>(A, m0, g, zb, cache); else pool_fill<16, false>(A, m0, g, zb, cache); }
    else { if (g == 0) pool_fill<2, true>(A, m0, g, zb, cache); else if (g == 1) pool_fill<4, true>(A, m0, g, zb, cache); else if (g == 2) pool_fill<8, true>(A, m0, g, zb, cache); else pool_fill<16, true>(A, m0, g, zb, cache); }
    __syncthreads();
    f32x4 acc[4][2];
#pragma unroll
    for (int i = 0; i < 4; ++i)
#pragma unroll
        for (int j = 0; j < 2; ++j) acc[i][j] = (f32x4){0.f, 0.f, 0.f, 0.f};
#pragma unroll 2
    for (int ks = 0; ks < 8; ++ks) {
        bf16x8 wf[2], af[4];
#pragma unroll
        for (int nt = 0; nt < 2; ++nt) wf[nt] = *(const bf16x8*)(WpT + (size_t)(g * 256 + n0 + nt * 16 + fr) * 256 + ks * 32 + fq * 8);
#pragma unroll
        for (int mt = 0; mt < 4; ++mt) af[mt] = *(const LAS bf16x8*)(A + (mt * 16 + fr) * LDA + ks * 32 + fq * 8);
#pragma unroll
        for (int mt = 0; mt < 4; ++mt)
#pragma unroll
            for (int nt = 0; nt < 2; ++nt) acc[mt][nt] = __builtin_amdgcn_mfma_f32_16x16x32_bf16(wf[nt], af[mt], acc[mt][nt], 0, 0, 0);
    }
#pragma unroll
    for (int mt = 0; mt < 4; ++mt)
#pragma unroll
        for (int nt = 0; nt < 2; ++nt) {
            u32x2 o; o.x = cvt_pk_bf16(acc[mt][nt][0], acc[mt][nt][1]); o.y = cvt_pk_bf16(acc[mt][nt][2], acc[mt][nt][3]);
            *(u32x2*)(mixb + (size_t)(m0 + mt * 16 + fr) * D + g * 256 + n0 + nt * 16 + 4 * fq) = o;
        }
    __syncthreads();
}

struct SampleRegs { f32x4 S[8]; };
__device__ __forceinline__ void sample_load(SampleRegs& R, const float* S0) {
    const int tid = threadIdx.x, v4 = tid & 31, kq = tid >> 5;
#pragma unroll
    for (int kk = 0; kk < 8; ++kk) R.S[kk] = __builtin_nontemporal_load((const f32x4*)(S0 + (size_t)(kq * 8 + kk) * HD + 4 * v4));
}
struct SampleStage { float lfv[2]; bf16 q[2], v[2]; bf16 g[2]; float gn[2]; };
__device__ __forceinline__ void sample_stage(SampleStage& st, const bf16* zb, const float* lf, const float* hgn, int row0, int h) {
    const int tid = threadIdx.x;
#pragma unroll
    for (int j = 0; j < 2; ++j) {
        const int i = tid + 512 * j, t = i >> 7, ch = i & 127; const size_t row = (size_t)(row0 + t);
        st.lfv[j] = lf[row * HW + h * HD + ch]; st.q[j] = zb[row * INC + PW + h * HD + ch]; st.v[j] = zb[row * INC + PW + 2 * HW + h * HD + ch];
    }
    const int wave = tid >> 6, lane = tid & 63;
#pragma unroll
    for (int j = 0; j < 2; ++j) { st.g[j] = zb[(size_t)(row0 + wave) * INC + PW + 3 * HW + h * HD + lane + 64 * j]; st.gn[j] = hgn[h * HD + lane + 64 * j]; }
}
__device__ __forceinline__ void sample_run(LAS unsigned char* lds, SampleRegs& R, const SampleStage& st, const bf16* zb, const float* hgn, float* Sout, bf16* mixb, int row0, int h) {
    const int tid = threadIdx.x, v4 = tid & 31, kq = tid >> 5, wave = tid >> 6, lane = tid & 63;
    LAS float* sq = (LAS float*)lds; LAS float* sf = sq + 1024; LAS float* sk = sf + 1024; LAS float* sv = sk + 1024; LAS float* red = sv + 1024;
#pragma unroll
    for (int j = 0; j < 2; ++j) {
        const int i = tid + 512 * j;
        const float f = __builtin_amdgcn_exp2f(st.lfv[j]);
        sq[i] = bf2f(st.q[j]); sf[i] = f; sk[i] = 1.f - f; sv[i] = bf2f(st.v[j]);
    }
    __syncthreads();
#pragma unroll 1
    for (int t = 0; t < 8; ++t) {
        const f32x4 vt = *(const LAS f32x4*)(sv + t * 128 + 4 * v4);
        f32x4 o = (f32x4){0.f, 0.f, 0.f, 0.f};
        const f32x4 f0 = *(const LAS f32x4*)(sf + t * 128 + kq * 8), f1 = *(const LAS f32x4*)(sf + t * 128 + kq * 8 + 4);
        const f32x4 k0 = *(const LAS f32x4*)(sk + t * 128 + kq * 8), k1 = *(const LAS f32x4*)(sk + t * 128 + kq * 8 + 4);
        const f32x4 q0 = *(const LAS f32x4*)(sq + t * 128 + kq * 8), q1 = *(const LAS f32x4*)(sq + t * 128 + kq * 8 + 4);
#pragma unroll
        for (int kk = 0; kk < 8; ++kk) {
            const float f = kk < 4 ? f0[kk & 3] : f1[kk & 3], kn = kk < 4 ? k0[kk & 3] : k1[kk & 3], q = kk < 4 ? q0[kk & 3] : q1[kk & 3];
            R.S[kk] = R.S[kk] * f + vt * kn;
            o = o + R.S[kk] * q;
        }
#pragma unroll
        for (int j = 0; j < 4; ++j) o[j] += __shfl_xor(o[j], 32);
        if (lane < 32) *(LAS f32x4*)(red + (wave * 8 + t) * 128 + 4 * v4) = o;
    }
#pragma unroll
    for (int kk = 0; kk < 8; ++kk) __builtin_nontemporal_store(R.S[kk], (f32x4*)(Sout + (size_t)(kq * 8 + kk) * HD + 4 * v4));
    __syncthreads();
    {
        const int t = wave; const size_t row = (size_t)(row0 + t);
        float o0 = 0.f, o1 = 0.f;
#pragma unroll
        for (int w8 = 0; w8 < 8; ++w8) { o0 += red[(w8 * 8 + t) * 128 + lane]; o1 += red[(w8 * 8 + t) * 128 + lane + 64]; }
        const float ss = wave_sum(o0 * o0 + o1 * o1), r = rsqrtf(ss * (1.f / HD) + EPS);
        const int ch0 = h * HD + lane, ch1 = ch0 + 64;
        mixb[row * D + PW + ch0] = f2bf(o0 * r * st.gn[0] * bf2f(st.g[0]));
        mixb[row * D + PW + ch1] = f2bf(o1 * r * st.gn[1] * bf2f(st.g[1]));
    }
    __syncthreads();
}

constexpr int CQS = 272, CTS = 144;
constexpr int L_Q = 0, L_K = L_Q + 64 * CQS, L_KT = L_K + 64 * CQS, L_VT = L_KT + 128 * CTS, L_ST = L_VT + 128 * CTS, L_P = L_ST + 128 * CQS,
              L_DS = L_P + 64 * CTS, L_TOT = L_DS + 512, L_RMS = L_TOT + 8192, L_CHAIN_END = L_RMS + 512;
static_assert(L_CHAIN_END <= 131072, "chain LDS");
struct SegIn { f32x4 lf[4]; u32x2 v[4], sq[4]; };
template <bool FULL>
__device__ __forceinline__ void seg_load(SegIn& I, const bf16* zb, const float* lf, int row0, int h) {
    const int tid = threadIdx.x, cg = tid & 31, tgp = tid >> 5;
#pragma unroll
    for (int j = 0; j < 4; ++j) {
        const size_t row = (size_t)(row0 + 4 * tgp + j);
        I.lf[j] = *(const f32x4*)(lf + row * HW + h * HD + 4 * cg);
        I.v[j] = *(const u32x2*)(zb + row * INC + PW + 2 * HW + h * HD + 4 * cg);
        if (FULL) I.sq[j] = *(const u32x2*)(zb + row * INC + PW + h * HD + 4 * cg);
    }
}
template <bool FULL>
__device__ __forceinline__ void seg_run(LAS unsigned char* lds, SegIn& I, const bf16* zb, const float* lf, f32x4 (&Sacc)[8], f32x4& segsum, const f32x4 (&gnr)[4], bf16* mixb, int rowb, int nsteps, int h) {
    const int tid = threadIdx.x, lane = tid & 63, wave = __builtin_amdgcn_readfirstlane(tid >> 6), fr = lane & 15, fq = lane >> 4;
    const int cg = tid & 31, tgp = tid >> 5;
    LAS float* dS = (LAS float*)(lds + L_DS); LAS float* tot = (LAS float*)(lds + L_TOT); LAS float* rmsp = (LAS float*)(lds + L_RMS);
    *(LAS f32x4*)(tot + tgp * 128 + 4 * cg) = (I.lf[0] + I.lf[1]) + (I.lf[2] + I.lf[3]);
    if (FULL) {
#pragma unroll
        for (int kt = 0; kt < 8; ++kt) {
            u32x2 w; w.x = cvt_pk_bf16(Sacc[kt][0], Sacc[kt][1]); w.y = cvt_pk_bf16(Sacc[kt][2], Sacc[kt][3]);
            *(LAS u32x2*)(lds + L_ST + (16 * wave + fr) * CQS + (16 * kt + 4 * fq) * 2) = w;
        }
    }
    __syncthreads();
    for (int c = 0; c < nsteps; ++c) {
        {
            f32x4 b = (f32x4){0.f, 0.f, 0.f, 0.f};
#pragma unroll
            for (int g = 0; g < 15; ++g) { const f32x4 tv = *(const LAS f32x4*)(tot + g * 128 + 4 * cg); if (g < tgp) b = b + tv; }
            float kt[4][4], qt[4][4];
#pragma unroll
            for (int j = 0; j < 4; ++j) {
                b = b + I.lf[j];
                const float kn0 = 1.f - __builtin_amdgcn_exp2f(I.lf[j][0]), kn1 = 1.f - __builtin_amdgcn_exp2f(I.lf[j][1]), kn2 = 1.f - __builtin_amdgcn_exp2f(I.lf[j][2]), kn3 = 1.f - __builtin_amdgcn_exp2f(I.lf[j][3]);
                kt[j][0] = kn0 * __builtin_amdgcn_exp2f(-b[0]); kt[j][1] = kn1 * __builtin_amdgcn_exp2f(-b[1]); kt[j][2] = kn2 * __builtin_amdgcn_exp2f(-b[2]); kt[j][3] = kn3 * __builtin_amdgcn_exp2f(-b[3]);
                if (FULL) {
                    qt[j][0] = bflo(I.sq[j].x) * __builtin_amdgcn_exp2f(b[0]); qt[j][1] = bfhi(I.sq[j].x) * __builtin_amdgcn_exp2f(b[1]); qt[j][2] = bflo(I.sq[j].y) * __builtin_amdgcn_exp2f(b[2]); qt[j][3] = bfhi(I.sq[j].y) * __builtin_amdgcn_exp2f(b[3]);
                    const int t = 4 * tgp + j;
                    u32x2 qw, kw; qw.x = cvt_pk_bf16(qt[j][0], qt[j][1]); qw.y = cvt_pk_bf16(qt[j][2], qt[j][3]); kw.x = cvt_pk_bf16(kt[j][0], kt[j][1]); kw.y = cvt_pk_bf16(kt[j][2], kt[j][3]);
                    *(LAS u32x2*)(lds + L_Q + t * CQS + cg * 8) = qw;
                    *(LAS u32x2*)(lds + L_K + t * CQS + cg * 8) = kw;
                }
            }
#pragma unroll
            for (int ch = 0; ch < 4; ++ch) {
                u32x2 kw; kw.x = cvt_pk_bf16(kt[0][ch], kt[1][ch]); kw.y = cvt_pk_bf16(kt[2][ch], kt[3][ch]);
                *(LAS u32x2*)(lds + L_KT + (4 * cg + ch) * CTS + tgp * 8) = kw;
                const unsigned w0 = (ch < 2) ? I.v[0].x : I.v[0].y, w1 = (ch < 2) ? I.v[1].x : I.v[1].y, w2 = (ch < 2) ? I.v[2].x : I.v[2].y, w3 = (ch < 2) ? I.v[3].x : I.v[3].y;
                u32x2 vw;
                if (ch & 1) { vw.x = (w0 >> 16) | (w1 & 0xffff0000u); vw.y = (w2 >> 16) | (w3 & 0xffff0000u); }
                else { vw.x = (w0 & 0xffffu) | (w1 << 16); vw.y = (w2 & 0xffffu) | (w3 << 16); }
                *(LAS u32x2*)(lds + L_VT + (4 * cg + ch) * CTS + tgp * 8) = vw;
            }
            if (tgp == 15) {
                f32x4 e; e[0] = __builtin_amdgcn_exp2f(b[0]); e[1] = __builtin_amdgcn_exp2f(b[1]); e[2] = __builtin_amdgcn_exp2f(b[2]); e[3] = __builtin_amdgcn_exp2f(b[3]);
                *(LAS f32x4*)(dS + 4 * cg) = e; segsum = segsum + b;
            }
        }
        __syncthreads();
        u32x2 sgr[4];
        if (FULL) {
#pragma unroll
            for (int i = 0; i < 4; ++i) sgr[i] = *(const u32x2*)(zb + (size_t)(rowb + 64 * c + 16 * (wave & 3) + fr) * INC + PW + 3 * HW + h * HD + 16 * (4 * (wave >> 2) + i) + 4 * fq);
        }
        if (c + 1 < nsteps) seg_load<FULL>(I, zb, lf, rowb + 64 * (c + 1), h);
        if (FULL) {
#pragma unroll
            for (int i = 0; i < 2; ++i) {
                const int ti = 2 * wave + i, tt = ti >> 2, st = ti & 3;
                f32x4 p = (f32x4){0.f, 0.f, 0.f, 0.f};
#pragma unroll
                for (int ks = 0; ks < 4; ++ks) {
                    const bf16x8 ka = *(const LAS bf16x8*)(lds + L_K + (16 * st + fr) * CQS + (32 * ks + 8 * fq) * 2);
                    const bf16x8 qb = *(const LAS bf16x8*)(lds + L_Q + (16 * tt + fr) * CQS + (32 * ks + 8 * fq) * 2);
                    p = __builtin_amdgcn_mfma_f32_16x16x32_bf16(ka, qb, p, 0, 0, 0);
                }
                const int t = 16 * tt + fr, s0 = 16 * st + 4 * fq;
                u32x2 w; w.x = cvt_pk_bf16(s0 + 0 <= t ? p[0] : 0.f, s0 + 1 <= t ? p[1] : 0.f); w.y = cvt_pk_bf16(s0 + 2 <= t ? p[2] : 0.f, s0 + 3 <= t ? p[3] : 0.f);
                *(LAS u32x2*)(lds + L_P + t * CTS + s0 * 2) = w;
            }
        }
        {
            bf16x8 vb[2];
#pragma unroll
            for (int ss = 0; ss < 2; ++ss) vb[ss] = *(const LAS bf16x8*)(lds + L_VT + (16 * wave + fr) * CTS + (32 * ss + 8 * fq) * 2);
#pragma unroll
            for (int kt = 0; kt < 8; ++kt)
#pragma unroll
                for (int ss = 0; ss < 2; ++ss) {
                    const bf16x8 ka = *(const LAS bf16x8*)(lds + L_KT + (16 * kt + fr) * CTS + (32 * ss + 8 * fq) * 2);
                    Sacc[kt] = __builtin_amdgcn_mfma_f32_16x16x32_bf16(ka, vb[ss], Sacc[kt], 0, 0, 0);
                }
        }
        const int tt = wave & 3, vh = wave >> 2;
        f32x4 o[4];
        if (FULL) {
            __syncthreads();
            bf16x8 pb[2], qb[4];
#pragma unroll
            for (int ss = 0; ss < 2; ++ss) pb[ss] = *(const LAS bf16x8*)(lds + L_P + (16 * tt + fr) * CTS + (32 * ss + 8 * fq) * 2);
#pragma unroll
            for (int ks = 0; ks < 4; ++ks) qb[ks] = *(const LAS bf16x8*)(lds + L_Q + (16 * tt + fr) * CQS + (32 * ks + 8 * fq) * 2);
#pragma unroll
            for (int i = 0; i < 4; ++i) {
                const int vrow = 16 * (4 * vh + i) + fr;
                f32x4 a = (f32x4){0.f, 0.f, 0.f, 0.f};
#pragma unroll
                for (int ss = 0; ss < 2; ++ss) a = __builtin_amdgcn_mfma_f32_16x16x32_bf16(*(const LAS bf16x8*)(lds + L_VT + vrow * CTS + (32 * ss + 8 * fq) * 2), pb[ss], a, 0, 0, 0);
#pragma unroll
                for (int ks = 0; ks < 4; ++ks) a = __builtin_amdgcn_mfma_f32_16x16x32_bf16(*(const LAS bf16x8*)(lds + L_ST + vrow * CQS + (32 * ks + 8 * fq) * 2), qb[ks], a, 0, 0, 0);
                o[i] = a;
            }
            float ss2 = 0.f;
#pragma unroll
            for (int i = 0; i < 4; ++i) ss2 += (o[i][0] * o[i][0] + o[i][1] * o[i][1]) + (o[i][2] * o[i][2] + o[i][3] * o[i][3]);
            ss2 += __shfl_xor(ss2, 16); ss2 += __shfl_xor(ss2, 32);
            if (fq == 0) rmsp[vh * 64 + 16 * tt + fr] = ss2;
        }
#pragma unroll
        for (int kt = 0; kt < 8; ++kt) Sacc[kt] = Sacc[kt] * *(const LAS f32x4*)(dS + 16 * kt + 4 * fq);
        if (c + 1 < nsteps) *(LAS f32x4*)(tot + tgp * 128 + 4 * cg) = (I.lf[0] + I.lf[1]) + (I.lf[2] + I.lf[3]);
        __syncthreads();
        if (FULL) {
            const int tl = 16 * tt + fr; const size_t row = (size_t)(rowb + 64 * c + tl);
            const float r = rsqrtf((rmsp[tl] + rmsp[64 + tl]) * (1.f / HD) + EPS);
#pragma unroll
            for (int i = 0; i < 4; ++i) {
                const int ch = h * HD + 16 * (4 * vh + i) + 4 * fq;
                const f32x4 gn = gnr[i];
                const u32x2 sg = sgr[i];
                const float g0 = __builtin_bit_cast(float, sg.x << 16), g1 = __builtin_bit_cast(float, sg.x & 0xffff0000u), g2 = __builtin_bit_cast(float, sg.y << 16), g3 = __builtin_bit_cast(float, sg.y & 0xffff0000u);
                u32x2 w; w.x = cvt_pk_bf16(o[i][0] * r * gn[0] * g0, o[i][1] * r * gn[1] * g1); w.y = cvt_pk_bf16(o[i][2] * r * gn[2] * g2, o[i][3] * r * gn[3] * g3);
                *(u32x2*)(mixb + row * D + PW + ch) = w;
            }
#pragma unroll
            for (int kt = 0; kt < 8; ++kt) {
                u32x2 w; w.x = cvt_pk_bf16(Sacc[kt][0], Sacc[kt][1]); w.y = cvt_pk_bf16(Sacc[kt][2], Sacc[kt][3]);
                *(LAS u32x2*)(lds + L_ST + (16 * wave + fr) * CQS + (16 * kt + 4 * fq) * 2) = w;
            }
        }
    }
    __syncthreads();
}

#ifndef P2_ORDER_OLD
#define P2_ORDER_OLD 0
#endif
constexpr int CW_FLAG = 32768;
__device__ __forceinline__ void prompt_pass1(LAS unsigned char* lds, const Args& a, int chain, int seg, int nseg) {
    if (seg + 1 >= nseg) return;
    unsigned char* ws = a.ws;
    const bf16* zb = (const bf16*)(ws + WS_ZB); const float* lf = (const float*)(ws + WS_LF); bf16* mixb = (bf16*)(ws + WS_MIX);
    const int tid = threadIdx.x;
    const int b = chain / NH, h = chain % NH, seglen = SEQ / nseg, nsteps = seglen / 64, rowb = b * SEQ + seg * seglen;
    f32x4* slab = (f32x4*)(ws + WS_XB);
    float* dseg = (float*)(ws + WS_XB + 16 * MiB);
    unsigned* flags = (unsigned*)(ws + WS_CTL) + CW_FLAG;
    f32x4 gnr[4];
#pragma unroll
    for (int i = 0; i < 4; ++i) gnr[i] = (f32x4){0.f, 0.f, 0.f, 0.f};
    f32x4 Sacc[8];
#pragma unroll
    for (int i = 0; i < 8; ++i) Sacc[i] = (f32x4){0.f, 0.f, 0.f, 0.f};
    f32x4 segsum = (f32x4){0.f, 0.f, 0.f, 0.f};
    SegIn I; seg_load<false>(I, zb, lf, rowb, h);
    seg_run<false>(lds, I, zb, lf, Sacc, segsum, gnr, mixb, rowb, nsteps, h);
    const __amdgpu_buffer_rsrc_t srs = __builtin_amdgcn_make_buffer_rsrc((void*)(slab + (size_t)(chain * 8 + seg) * 4096), (short)0, 4096 * 16, 0x00020000);
#pragma unroll
    for (int kt = 0; kt < 8; ++kt) __builtin_amdgcn_raw_buffer_store_b128(__builtin_bit_cast(u32x4, Sacc[kt]), srs, (unsigned)((kt * 512 + tid) * 16), 0, 16);
    if ((tid >> 5) == 15) {
#pragma unroll
        for (int j = 0; j < 4; ++j) __hip_atomic_store((unsigned*)dseg + (chain * 8 + seg) * 128 + 4 * (tid & 31) + j, __builtin_bit_cast(unsigned, __builtin_amdgcn_exp2f(segsum[j])), __ATOMIC_RELAXED, __HIP_MEMORY_SCOPE_AGENT);
    }
    asm volatile("s_waitcnt vmcnt(0)" ::: "memory");
    __syncthreads();
    if (tid == 0) __hip_atomic_store(flags + 64 * (chain * 8 + seg), 1u, __ATOMIC_RELAXED, __HIP_MEMORY_SCOPE_AGENT);
}
__device__ __forceinline__ void prompt_pass2(LAS unsigned char* lds, const Args& a, int chain, int seg, int nseg) {
    unsigned char* ws = a.ws;
    const bf16* zb = (const bf16*)(ws + WS_ZB); const float* lf = (const float*)(ws + WS_LF); bf16* mixb = (bf16*)(ws + WS_MIX);
    const int tid = threadIdx.x, lane = tid & 63, wave = __builtin_amdgcn_readfirstlane(tid >> 6), fr = lane & 15, fq = lane >> 4;
    const int b = chain / NH, h = chain % NH, seglen = SEQ / nseg, nsteps = seglen / 64, rowb = b * SEQ + seg * seglen;
    const f32x4* slab = (const f32x4*)(ws + WS_XB);
    const float* dseg = (const float*)(ws + WS_XB + 16 * MiB);
    unsigned* flags = (unsigned*)(ws + WS_CTL) + CW_FLAG;
    f32x4 gnr[4];
#pragma unroll
    for (int i = 0; i < 4; ++i) gnr[i] = *(const f32x4*)(a.in[9] + h * HD + 16 * (4 * (wave >> 2) + i) + 4 * fq);
    f32x4 Sacc[8];
#pragma unroll
    for (int i = 0; i < 8; ++i) Sacc[i] = (f32x4){0.f, 0.f, 0.f, 0.f};
    f32x4 segsum = (f32x4){0.f, 0.f, 0.f, 0.f};
    SegIn I; seg_load<true>(I, zb, lf, rowb, h);
    if (seg > 0) {
        if (tid < 64) {
            for (int i = 0; i < seg; ++i) { unsigned sp = 0; while (__hip_atomic_load(flags + 64 * (chain * 8 + i), __ATOMIC_RELAXED, __HIP_MEMORY_SCOPE_AGENT) == 0u && ++sp < (1u << 22)) __builtin_amdgcn_s_sleep(2); }
            __builtin_amdgcn_fence(__ATOMIC_ACQUIRE, "agent");
            asm volatile("s_waitcnt vmcnt(0)" ::: "memory");
        }
        __syncthreads();
        f32x4 rc[8], rn[8];
#pragma unroll
        for (int kt = 0; kt < 8; ++kt) { rc[kt] = slab[(size_t)(chain * 8) * 4096 + kt * 512 + tid]; rn[kt] = rc[kt]; }
        for (int i = 0; i < seg; ++i) {
            const float* dd = dseg + (chain * 8 + i) * 128;
            if (i + 1 < seg) {
#pragma unroll
                for (int kt = 0; kt < 8; ++kt) rn[kt] = slab[(size_t)(chain * 8 + i + 1) * 4096 + kt * 512 + tid];
            }
#pragma unroll
            for (int kt = 0; kt < 8; ++kt) Sacc[kt] = Sacc[kt] * *(const f32x4*)(dd + 16 * kt + 4 * fq) + rc[kt];
#pragma unroll
            for (int kt = 0; kt < 8; ++kt) rc[kt] = rn[kt];
        }
    }
    seg_run<true>(lds, I, zb, lf, Sacc, segsum, gnr, mixb, rowb, nsteps, h);
    if (seg + 1 == nseg) {
        float* Sout = a.out + O_HSP + (size_t)chain * HD * HD;
#pragma unroll
        for (int kt = 0; kt < 8; ++kt)
#pragma unroll
            for (int j = 0; j < 4; ++j) Sout[(size_t)(16 * kt + 4 * fq + j) * HD + 16 * wave + fr] = Sacc[kt][j];
    }
}

__device__ __forceinline__ void phase2(LAS unsigned char* lds, const Args& a, int bid, int G, int parts = 7) {
    unsigned char* ws = a.ws;
    const bf16* zb = (const bf16*)(ws + WS_ZB); const float* lf = (const float*)(ws + WS_LF); bf16* mixb = (bf16*)(ws + WS_MIX);
    constexpr int NPC = NB * NH, NSC = DB * NH, NPOOL = (M / 64) * 4;
    const int nseg = (G >= 8 * NPC) ? 8 : (G >= 4 * NPC ? 4 : (G >= 2 * NPC ? 2 : 1));
    if ((parts & 1) && nseg > 1 && bid < nseg * NPC) prompt_pass1(lds, a, bid / nseg, bid % nseg, nseg);
#if P2_ORDER_OLD
    if (parts & 1) {
        if (nseg > 1) { if (bid < nseg * NPC) prompt_pass2(lds, a, bid / nseg, bid % nseg, nseg); }
        else for (int c = bid; c < NPC; c += G) prompt_pass2(lds, a, c, 0, 1);
    }
#endif
    STAMP(5);
    if (parts & 2) {
        SampleRegs cur, nxt;
        if (bid < NSC) sample_load(cur, a.in[3] + (size_t)bid * HD * HD);
        for (int it = bid; it < NSC; it += G) {
            const bool pf = it + G < NSC;
            SampleStage st; sample_stage(st, zb, lf, a.in[9], MP + (it / NH) * DS, it % NH);
            if (pf) sample_load(nxt, a.in[3] + (size_t)(it + G) * HD * HD);
            sample_run(lds, cur, st, zb, a.in[9], a.out + O_HSS + (size_t)it * HD * HD, mixb, MP + (it / NH) * DS, it % NH);
            if (pf) {
#pragma unroll
                for (int kk = 0; kk < 8; ++kk) cur.S[kk] = nxt.S[kk];
            }
        }
    }
    if (parts & 4) {
        const int first = (NSC + G - 1 - bid) / G * G + bid;
        for (int it = first; it < NSC + NPOOL; it += G) pool_item(lds, it - NSC, zb, a.in[2], (const bf16*)(ws + WS_WP), mixb);
    }
    STAMP(6);
    if (!P2_ORDER_OLD && (parts & 1)) {
        if (nseg > 1) { if (bid < nseg * NPC) prompt_pass2(lds, a, bid / nseg, bid % nseg, nseg); }
        else for (int c = bid; c < NPC; c += G) prompt_pass2(lds, a, c, 0, 1);
    }
}

__device__ __forceinline__ void phase6(const Args& a, int vcu, int G, size_t x2off) {
    const int tid = threadIdx.x, lane = tid & 63, wave = tid >> 6;
#ifdef TPROBE
    { unsigned d = *((const unsigned*)(a.ws + WS_CTL) + CW_TP); if (TP_MODE == 2) d = 0x40000000u - d;
#ifdef TP_CAL
      d = TP_REF_US * 95;
#endif
      const float delta = 0.01f * ((float)d * 0.01f) / (float)(TP_REF_US);
      for (int i = vcu * (NWAVES * 64) + tid; i < NB * PC * PW; i += G * NWAVES * 64) a.out[O_PSP + i] += delta; }
#endif
    const int gw = vcu * NWAVES + wave, NGW = G * NWAVES;
    const float* rsq3 = (const float*)(a.ws + WS_CTL) + CW_RSQ3;
    for (int m = gw; m < M; m += NGW) {
        float* yr = a.out + O_Y + (size_t)m * D; const bf16* xr = (const bf16*)(a.ws + x2off) + (size_t)m * D;
        const float r = rsqrtf(rsq3[m] * (1.f / D) + EPS);
#pragma unroll
        for (int j = 0; j < 4; ++j) {
            const u32x4 xw = __builtin_nontemporal_load((const u32x4*)xr + lane + 64 * j);
            const f32x4 g0 = ((const f32x4*)a.in[15])[2 * (lane + 64 * j)], g1 = ((const f32x4*)a.in[15])[2 * (lane + 64 * j) + 1];
            __builtin_nontemporal_store((f32x4){bflo(xw.x), bfhi(xw.x), bflo(xw.y), bfhi(xw.y)} * r * g0, (f32x4*)yr + 2 * (lane + 64 * j));
            __builtin_nontemporal_store((f32x4){bflo(xw.z), bfhi(xw.z), bflo(xw.w), bfhi(xw.w)} * r * g1, (f32x4*)yr + 2 * (lane + 64 * j) + 1);
        }
    }
}

__global__ void __launch_bounds__(NWAVES * 64, 2) mega(Args a) {
    extern __shared__ __attribute__((aligned(16))) unsigned char lds_raw[];
    LAS unsigned char* lds = (LAS unsigned char*)lds_raw;
    const int G = gridDim.x, bid = blockIdx.x;
    const int vcu = (G % 8 == 0) ? (bid % 8) * (G / 8) + bid / 8 : bid;
    unsigned char* ws = a.ws;
    float* ctlf = (float*)(ws + WS_CTL);
    const int lo = a.ph_lo, hi = a.ph_hi;
#if ONE_LAUNCH && USE_CG
    cg::grid_group grid = cg::this_grid();
#define GRID_BAR() grid.sync()
#elif ONE_LAUNCH
    volatile LAS unsigned* MISC = (volatile LAS unsigned*)(lds + MISC_OFF);
    if (threadIdx.x < 32) MISC[threadIdx.x] = 0u;
    __syncthreads();
    XcdBarrier bar = xcd_barrier_post((unsigned*)(ws + WS_CTL) + CW_BAR, MISC + 8);
#define GRID_BAR() xcd_barrier(bar)
#else
#define GRID_BAR() do {} while (0)
#endif
#ifndef PH_MASK
#define PH_MASK 0x7f
#endif
#define IN(k) (((PH_MASK >> (k)) & 1) && lo <= (k) && (k) < hi)
#define BOTH(k) (IN(k) && IN((k) + 1))
#ifndef REP_MASK
#define REP_MASK 0
#endif
#define REP(k) ((REP_MASK >> (k)) & 1)
#ifndef P2_REP_PARTS
#define P2_REP_PARTS 7
#endif
    STAMP(0);
    if (IN(0)) { if (REP(0)) { phase0(lds, a, vcu, G); __syncthreads(); } phase0(lds, a, vcu, G); STAMP(1); if (BOTH(0)) GRID_BAR(); STAMP(2); }
    if (IN(1)) {
        pg8::Gemm g{(const bf16*)(ws + WS_XB), (const bf16*)(ws + WS_WIN), M, INC, D}; pg8::HybridOrder S; S.init(M, INC, D, G, bid, false);
        const pg8::TailCtx T{nullptr, nullptr};
        pg8::EpiZ E{(bf16*)(ws + WS_ZB), (float*)(ws + WS_LF), (const float*)(ws + WS_MISC), (const float*)(ws + WS_MISC) + M, a.out};
        if (REP(1)) pg8::gemm_phase2(lds, g, S, E, T);
        pg8::gemm_phase2(lds, g, S, E, T);
        { const int nidle = p1_idle_wgs(G); if (nidle >= 32 && bid >= G - nidle) phase0_deferred(lds, a, bid - (G - nidle), nidle); }
        STAMP(3);
        if (BOTH(1)) GRID_BAR();
        STAMP(4);
    }
    if (IN(2)) { if (REP(2)) { phase2(lds, a, bid, G, P2_REP_PARTS); __syncthreads(); } phase2(lds, a, bid, G); STAMP(7); if (BOTH(2)) GRID_BAR(); STAMP(8); }
    const bool merged = MERGED && G == 256 && lo <= 3 && hi >= 6;
    if (merged) {
        pg8::MOrder S{bid};
        constexpr pg8::StreamOff O{WS_MIX, WS_WO, WS_XB, WS_WGU, WS_ACT, WS_WD, WS_MIX, WS_SLABM, CW_DEP, CW_DEP + 4096, CW_TAIL, CW_RSQ2, CW_RSQ3};
        pg8::gemm_stream(lds, S, ws, a.in[0], a.in[1], O);
        STAMP(13);
#ifdef TPROBE
        if (threadIdx.x == 0) { volatile LAS unsigned long long* ts = (volatile LAS unsigned long long*)(lds + MISC_OFF + 128); const unsigned d = (unsigned)(ts[TP_B] - ts[TP_A]);
            unsigned* w = (unsigned*)(ws + WS_CTL) + CW_TP; if (TP_MODE == 0) { if (bid == TP_BLOCK) atomicMax(w, d); } else if (TP_MODE == 1) atomicMax(w, d); else atomicMax(w, 0x40000000u - d); }
#endif
        GRID_BAR();
    }
    if (!merged && IN(3)) {
        pg8::Gemm g{(const bf16*)(ws + WS_MIX), (const bf16*)(ws + WS_WO), M, D, D}; pg8::HybridOrder S; S.init(M, D, D, G, bid, true);
        const pg8::TailCtx T{(f32x4*)(ws + WS_SLAB3), (unsigned*)(ws + WS_CTL) + CW_TAIL};
        if (REP(3)) { pg8::EpiX1<true> E0{a.in[0], a.in[1], a.out + O_Y, (bf16*)(ws + WS_XB), ctlf + CW_RSQ2, false}; pg8::gemm_phase2(lds, g, S, E0, T); }
        pg8::EpiX1<false> E{a.in[0], a.in[1], a.out + O_Y, (bf16*)(ws + WS_XB), ctlf + CW_RSQ2, false};
        pg8::gemm_phase2(lds, g, S, E, T);
        STAMP(9);
        if (BOTH(3)) GRID_BAR();
        STAMP(10);
    }
    if (!merged && IN(4)) {
        pg8::Gemm g{(const bf16*)(ws + WS_XB), (const bf16*)(ws + WS_WGU), M, 2 * DFF, D}; pg8::HybridOrder S; S.init(M, 2 * DFF, D, G, bid, true);
        const pg8::TailCtx T{(f32x4*)(ws + WS_SLAB45), (unsigned*)(ws + WS_CTL) + CW_TAIL + 8192};
        pg8::EpiAct E{(bf16*)(ws + WS_ACT), ctlf + CW_RSQ2, false};
        if (REP(4)) pg8::gemm_phase2(lds, g, S, E, T);
        pg8::gemm_phase2(lds, g, S, E, T);
        STAMP(11);
        if (BOTH(4)) GRID_BAR();
        STAMP(12);
    }
    if (!merged && IN(5)) {
        pg8::Gemm g{(const bf16*)(ws + WS_ACT), (const bf16*)(ws + WS_WD), M, D, DFF}; pg8::HybridOrder S; S.init(M, D, DFF, G, bid, true);
        const pg8::TailCtx T{(f32x4*)(ws + WS_SLAB45), (unsigned*)(ws + WS_CTL) + CW_TAIL + 16384};
        if (REP(5)) { pg8::EpiX2<true> E0{(bf16*)(ws + WS_X2B), ctlf + CW_RSQ3, (const bf16*)(ws + WS_XB)}; pg8::gemm_phase2(lds, g, S, E0, T); }
        pg8::EpiX2<false> E{(bf16*)(ws + WS_X2B), ctlf + CW_RSQ3, (const bf16*)(ws + WS_XB)};
        pg8::gemm_phase2(lds, g, S, E, T);
        STAMP(13);
#ifdef TPROBE
        if (threadIdx.x == 0) { volatile LAS unsigned long long* ts = (volatile LAS unsigned long long*)(lds + MISC_OFF + 128); const unsigned d = (unsigned)(ts[TP_B] - ts[TP_A]);
            unsigned* w = (unsigned*)(ws + WS_CTL) + CW_TP; if (TP_MODE == 0) { if (bid == TP_BLOCK) atomicMax(w, d); } else if (TP_MODE == 1) atomicMax(w, d); else atomicMax(w, 0x40000000u - d); }
#endif
        if (BOTH(5)) GRID_BAR();
    }
    if (IN(6)) phase6(a, vcu, G, merged ? WS_MIX : WS_X2B);
#undef IN
#undef BOTH
}

extern "C" void kernel_launch(void* const* d_in, const int* in_sizes, int n_in, void* d_out, int out_size, void* d_ws, size_t ws_size, hipStream_t stream) {
    static int grid = 0;
    if (grid == 0) {
        if (n_in != 16 || ws_size < WS_END) { fprintf(stderr, "kernel_launch: unexpected n_in %d / ws_size %zu\n", n_in, ws_size); grid = -1; return; }
        int dev = 0, cus = 0, per_cu = 0;
        hipGetDevice(&dev);
        hipDeviceGetAttribute(&cus, hipDeviceAttributeMultiprocessorCount, dev);
        hipFuncSetAttribute((const void*)mega, hipFuncAttributeMaxDynamicSharedMemorySize, LDS_BYTES);
        hipOccupancyMaxActiveBlocksPerMultiprocessor(&per_cu, (const void*)mega, NWAVES * 64, LDS_BYTES);
        if (per_cu < 1) { fprintf(stderr, "kernel_launch: occupancy query says %d blocks per CU\n", per_cu); grid = -1; return; }
        grid = cus;
#ifdef FORCE_GRID
        grid = FORCE_GRID;
#endif
    }
    if (grid < 0) return;
    hipMemsetAsync((char*)d_ws + WS_CTL + (size_t)CW_BAR * 4, 0, XCD_BAR_WORDS * 4, stream);
#ifdef EXTRA_MEMSET
    hipMemsetAsync((char*)d_ws + WS_END - 8192, 0, 4096, stream);
#endif
    Args a{};
    for (int i = 0; i < 16; ++i) a.in[i] = (const float*)d_in[i];
    a.out = (float*)d_out; a.ws = (unsigned char*)d_ws;
#if ONE_LAUNCH
    a.ph_lo = 0; a.ph_hi = NPHASE;
    void* args[] = {&a};
#if USE_CG
    hipError_t e = hipLaunchCooperativeKernel((const void*)mega, dim3(grid), dim3(NWAVES * 64), args, LDS_BYTES, stream);
    if (e != hipSuccess) fprintf(stderr, "cooperative launch failed: %s (grid %d)\n", hipGetErrorString(e), grid);
#else
    (void)args; hipLaunchKernelGGL(mega, dim3(grid), dim3(NWAVES * 64), LDS_BYTES, stream, a);
#endif
#else
    for (int p = 0; p < NPHASE; ++p) { a.ph_lo = p; a.ph_hi = p + 1; hipLaunchKernelGGL(mega, dim3(grid), dim3(NWAVES * 64), LDS_BYTES, stream, a); }
#endif
}
```

```cpp
#include <hip/hip_runtime.h>
#include <hip/hip_cooperative_groups.h>
#include <cstdio>
#include <cstdint>
namespace cg = cooperative_groups;

constexpr int D = 2048, NB = 4, SEQ = 2048, DB = 128, DS = 8;
constexpr int MP = NB * SEQ, MS = DB * DS, M = MP + MS;
constexpr int PW = 1024, HW = 1024, HD = 128, NH = 8, PC = 15;
constexpr int DFF = 5632, INC = 5120;
constexpr float EPS = 1e-6f;
constexpr size_t O_Y = 0;
constexpr size_t O_PSP = (size_t)M * D;
constexpr size_t O_HSP = O_PSP + (size_t)NB * PC * PW;
constexpr size_t O_PSS = O_HSP + (size_t)NB * NH * HD * HD;
constexpr size_t O_HSS = O_PSS + (size_t)DB * PC * PW;

namespace pg8 {
#define PG8_LAS __attribute__((address_space(3)))
typedef unsigned short bf16_t;
typedef short bf16x8 __attribute__((ext_vector_type(8)));
typedef float f32x4 __attribute__((ext_vector_type(4)));
typedef unsigned u32x4 __attribute__((ext_vector_type(4)));
constexpr int BM = 256, BK = 64, HALF = 128, HTB = HALF * BK * 2  , STAGE_BYTES = 8 * HTB, NXCD = 8, WGM = 8;

__host__ __device__ __forceinline__ int lds_byte(int r, int c) { const int st = (r >> 4) * 2 + (c >> 5), rr = r & 15, cc = c & 31, ob = rr * 64 + cc * 2; return st * 1024 + (ob ^ (((ob >> 9) & 1) << 5)); }
__host__ __device__ __forceinline__ void stage_rc(int b, int& R, int& C) { const int st = b / 1024, sb = b % 1024, swz = sb ^ (((sb >> 9) & 1) << 5); R = (st >> 1) * 16 + swz / 64; C = (st & 1) * 32 + (swz % 64) / 2; }
__host__ __device__ __forceinline__ int perm32(int rho) { const int n = rho >> 4, i = rho & 15; return 8 * (i >> 2) + 4 * n + (i & 3); }

struct Unit { int pm, pn, kb, nk, tinfo; };
struct Gemm { const bf16_t* A; const bf16_t* Bt; int M, N, K; };

struct StaticOrder {
    int nM, nN, nwg, G, c;
    __host__ __device__ void init(int M, int N, int G_, int c_) { nM = M / BM; nN = N / BM; nwg = nM * nN; G = G_; c = c_; }
    __host__ __device__ bool next(int i, Unit& u) const {
        const long L = (long)i * G + c; if (L >= nwg) return false;
        int wgid = (int)L; { const int q = nwg / NXCD, r = nwg % NXCD, xcd = wgid % NXCD, off = wgid / NXCD; wgid = (xcd < r ? xcd * (q + 1) : r * (q + 1) + (xcd - r) * q) + off; }
        const int nig = WGM * nN, gid = wgid / nig, fm = gid * WGM, gsz = (nM - fm) < WGM ? (nM - fm) : WGM;
        u.pm = fm + ((wgid % nig) % gsz); u.pn = (wgid % nig) / gsz; u.kb = 0; u.nk = 0; u.tinfo = -1; return true;
    }
    __device__ __forceinline__ void a_ready(const Unit&) const {}
    __device__ __forceinline__ void done(const Unit&) const {}
};
typedef __bf16 bf16x2_hw __attribute__((ext_vector_type(2)));
typedef float f32x2_hw __attribute__((ext_vector_type(2)));
__device__ __forceinline__ unsigned cvt_pk_bf16(float lo, float hi) { const f32x2_hw v = {lo, hi}; return __builtin_bit_cast(unsigned, __builtin_convertvector(v, bf16x2_hw)); }
__device__ __forceinline__ float sigm(float x) { return __builtin_amdgcn_rcpf(1.f + __expf(-x)); }
__device__ __forceinline__ float silu(float x) { return x * __builtin_amdgcn_rcpf(1.f + __expf(-x)); }
typedef unsigned u32x2 __attribute__((ext_vector_type(2)));
__device__ __forceinline__ float bflo_(unsigned w) { return __builtin_bit_cast(float, w << 16); }
__device__ __forceinline__ float bfhi_(unsigned w) { return __builtin_bit_cast(float, w & 0xffff0000u); }

struct EpiZ {
    static constexpr bool PERM = true, AFTER_DRAIN = false;
    bf16_t* zb; float* lf; const float* rstd1; const float* lbv; float* out;
    __device__ __forceinline__ void operator()(const f32x4 (&acc)[2][2][4][2], const Unit& u, int wr, int wc, int fr, int fq, unsigned gmask = 0xffu) const {
        const int kind = u.pn >> 2;
        const int row0 = u.pm * BM + wr * 64 + fr;
        const int cc0 = (u.pn & 3) * 256 + wc * 32 + 8 * fq;
        f32x4 lb[2][2];
        if (kind == 2) {
#pragma unroll
            for (int bj = 0; bj < 2; ++bj)
#pragma unroll
                for (int n = 0; n < 2; ++n) lb[bj][n] = *(const f32x4*)(lbv + cc0 + bj * HALF + 4 * n);
        }
#pragma unroll
        for (int ai = 0; ai < 2; ++ai)
#pragma unroll
            for (int m = 0; m < 4; ++m) {
                if (!((gmask >> (ai * 4 + m)) & 1u)) continue;
                const int row = row0 + ai * HALF + m * 16;
                const float r = rstd1[row];
#pragma unroll
                for (int bj = 0; bj < 2; ++bj) {
                    const int cc = cc0 + bj * HALF;
                    f32x4 v0 = acc[ai][bj][m][0] * r, v1 = acc[ai][bj][m][1] * r;
                    if (kind == 2) {
#pragma unroll
                        for (int j = 0; j < 4; ++j) {
                            const float f0 = lb[bj][0][j] + (1.f - lb[bj][0][j]) * sigm(v0[j]), f1 = lb[bj][1][j] + (1.f - lb[bj][1][j]) * sigm(v1[j]);
                            v0[j] = __log2f(f0); v1[j] = __log2f(f1);
                        }
                        float* p = lf + (size_t)row * HW + cc;
                        *(f32x4*)p = v0; *(f32x4*)(p + 4) = v1;

                    } else {
                        if (kind == 0) {
                            float* dst = nullptr;
                            if (row >= MP) { const int ms = row - MP; dst = out + O_PSS + ((size_t)(ms >> 3) * PC + 7 + (ms & 7)) * PW + cc; }
                            else { const int t = row & (SEQ - 1); if (t >= SEQ - PC) dst = out + O_PSP + ((size_t)(row >> 11) * PC + (t - (SEQ - PC))) * PW + cc; }
                            if (dst) { *(f32x4*)dst = v0; *(f32x4*)(dst + 4) = v1; }
                        }
                        if (kind == 1 || kind == 4) {
#pragma unroll
                            for (int j = 0; j < 4; ++j) { v0[j] = silu(v0[j]); v1[j] = silu(v1[j]); }
                        }
                        u32x4 w; w.x = cvt_pk_bf16(v0[0], v0[1]); w.y = cvt_pk_bf16(v0[2], v0[3]); w.z = cvt_pk_bf16(v1[0], v1[1]); w.w = cvt_pk_bf16(v1[2], v1[3]);
                        *(u32x4*)(zb + (size_t)row * INC + kind * 1024 + cc) = w;
                    }
                }
            }
    }
};

__device__ __forceinline__ void store16(bf16_t* base, size_t elem_off, u32x4 w, bool wt) {
    if (wt) { const __amdgpu_buffer_rsrc_t r = __builtin_amdgcn_make_buffer_rsrc((void*)base, (short)0, 0x7fffffff, 0x00020000); __builtin_amdgcn_raw_buffer_store_b128(w, r, (unsigned)(elem_off * 2), 0, 16); }
    else *(u32x4*)(base + elem_off) = w;
}
template <bool DRY = false> struct EpiX1 {
    static constexpr bool PERM = true, AFTER_DRAIN = false;
    const float* xp; const float* xs; float* y; bf16_t* x1b; float* rowsq; bool wt;
    __device__ __forceinline__ void operator()(const f32x4 (&acc)[2][2][4][2], const Unit& u, int wr, int wc, int fr, int fq, unsigned gmask = 0xffu) const {
        const int row0 = u.pm * BM + wr * 64 + fr, col0 = u.pn * BM + wc * 32 + 8 * fq;
#pragma unroll
        for (int ai = 0; ai < 2; ++ai)
#pragma unroll
            for (int m = 0; m < 4; ++m) {
                if (!((gmask >> (ai * 4 + m)) & 1u)) continue;
                const int row = row0 + ai * HALF + m * 16;
                const float* xr = (row < MP ? xp + (size_t)row * D : xs + (size_t)(row - MP) * D) + col0;
                float s = 0.f;
#pragma unroll
                for (int bj = 0; bj < 2; ++bj) {
                    const f32x4 v0 = __builtin_nontemporal_load((const f32x4*)(xr + bj * HALF)) + acc[ai][bj][m][0], v1 = __builtin_nontemporal_load((const f32x4*)(xr + bj * HALF + 4)) + acc[ai][bj][m][1];
                    u32x4 w; w.x = cvt_pk_bf16(v0[0], v0[1]); w.y = cvt_pk_bf16(v0[2], v0[3]); w.z = cvt_pk_bf16(v1[0], v1[1]); w.w = cvt_pk_bf16(v1[2], v1[3]);
                    store16(x1b, (size_t)row * D + col0 + bj * HALF, w, wt);
                    s += (v0[0] * v0[0] + v0[1] * v0[1]) + (v0[2] * v0[2] + v0[3] * v0[3]) + (v1[0] * v1[0] + v1[1] * v1[1]) + (v1[2] * v1[2] + v1[3] * v1[3]);
                }
                s += __shfl_xor(s, 16); s += __shfl_xor(s, 32);
                if (fq == 0 && !DRY) atomicAdd(rowsq + row, s);
            }
    }
};

struct EpiAct {
    static constexpr bool PERM = true, AFTER_DRAIN = false;
    bf16_t* act; const float* rowsq; bool wt;
    __device__ __forceinline__ void operator()(const f32x4 (&acc)[2][2][4][2], const Unit& u, int wr, int wc, int fr, int fq, unsigned gmask = 0xffu) const {
        const int row0 = u.pm * BM + wr * 64 + fr, col0 = u.pn * HALF + wc * 32 + 8 * fq;
#pragma unroll
        for (int ai = 0; ai < 2; ++ai)
#pragma unroll
            for (int m = 0; m < 4; ++m) {
                if (!((gmask >> (ai * 4 + m)) & 1u)) continue;
                const int row = row0 + ai * HALF + m * 16;
                const float r = rsqrtf(rowsq[row] * (1.f / D) + EPS);
                u32x4 w; unsigned* wp = (unsigned*)&w;
#pragma unroll
                for (int n = 0; n < 2; ++n) {
                    const f32x4 g = acc[ai][0][m][n] * r, up = acc[ai][1][m][n] * r;
                    f32x4 a;
#pragma unroll
                    for (int j = 0; j < 4; ++j) a[j] = silu(g[j]) * up[j];
                    wp[2 * n] = cvt_pk_bf16(a[0], a[1]); wp[2 * n + 1] = cvt_pk_bf16(a[2], a[3]);
                }
                store16(act, (size_t)row * DFF + col0, w, wt);
            }
    }
};

template <bool DRY = false> struct EpiX2 {
    static constexpr bool PERM = true, AFTER_DRAIN = false;
    bf16_t* x2b; float* rowsq; const bf16_t* x1b;
    __device__ __forceinline__ void operator()(const f32x4 (&acc)[2][2][4][2], const Unit& u, int wr, int wc, int fr, int fq, unsigned gmask = 0xffu) const {
        const int row0 = u.pm * BM + wr * 64 + fr, col0 = u.pn * BM + wc * 32 + 8 * fq;
#pragma unroll
        for (int ai = 0; ai < 2; ++ai)
#pragma unroll
            for (int m = 0; m < 4; ++m) {
                if (!((gmask >> (ai * 4 + m)) & 1u)) continue;
                const int row = row0 + ai * HALF + m * 16;
                float s = 0.f;
#pragma unroll
                for (int bj = 0; bj < 2; ++bj) {
                    const u32x4 xw = *(const u32x4*)(x1b + (size_t)row * D + col0 + bj * HALF);
                    f32x4 v0 = (f32x4){bflo_(xw.x), bfhi_(xw.x), bflo_(xw.y), bfhi_(xw.y)} + acc[ai][bj][m][0];
                    f32x4 v1 = (f32x4){bflo_(xw.z), bfhi_(xw.z), bflo_(xw.w), bfhi_(xw.w)} + acc[ai][bj][m][1];
                    u32x4 w; w.x = cvt_pk_bf16(v0[0], v0[1]); w.y = cvt_pk_bf16(v0[2], v0[3]); w.z = cvt_pk_bf16(v1[0], v1[1]); w.w = cvt_pk_bf16(v1[2], v1[3]);
                    *(u32x4*)(x2b + (size_t)row * D + col0 + bj * HALF) = w;
                    s += (v0[0] * v0[0] + v0[1] * v0[1]) + (v0[2] * v0[2] + v0[3] * v0[3]) + (v1[0] * v1[0] + v1[1] * v1[1]) + (v1[2] * v1[2] + v1[3] * v1[3]);
                }
                s += __shfl_xor(s, 16); s += __shfl_xor(s, 32);
                if (fq == 0 && !DRY) atomicAdd(rowsq + row, s);
            }
    }
};
template <class Epi, class Sched, bool ALIGN_EPI = false, bool SP2 = false>
__device__ __forceinline__ void gemm_phase(PG8_LAS unsigned char* lds, const Gemm g, const Sched& S, const Epi& E) {
    int tid_ = threadIdx.x; asm volatile("" : "+v"(tid_));
    const int tid = tid_, wid = __builtin_amdgcn_readfirstlane(tid >> 6), lane = tid & 63, wr = wid >> 2, wc = wid & 3, fr = lane & 15, fq = lane >> 4;
    const int K = g.K, nt = K / BK;
    unsigned voffA[2], voffB[2];
#pragma unroll
    for (int i = 0; i < 2; ++i) { int R, C; stage_rc(tid * 16 + i * 8192, R, C); const int Rb = Epi::PERM ? ((R & ~31) + perm32(R & 31)) : R;
        voffA[i] = (unsigned)(R * K + C) * 2u; voffB[i] = (unsigned)(Rb * K + C) * 2u; }
    const size_t kstep = (size_t)(BK * 2);
    const size_t hstep = (size_t)HALF * K * 2;
    const size_t tstep = 2 * hstep;
    const unsigned ldsw = (unsigned)wid * 1024u;
    const int aoff = lds_byte(wr * 64 + fr, fq * 8), boff = lds_byte(wc * 32 + fr, fq * 8);
#define PG8_SA(b, h) (((b) * 2 + (h)) * HTB)
#define PG8_SB(b, h) ((4 + (b) * 2 + (h)) * HTB)
#define PG8_STAGE(bufoff, gbase, voff) do { _Pragma("unroll") for (int _i = 0; _i < 2; ++_i) \
        __builtin_amdgcn_global_load_lds((const unsigned*)((const char*)(gbase) + (voff)[_i]), (PG8_LAS unsigned*)(lds + (bufoff) + ldsw + _i * 8192), 16, 0, 0); } while (0)
#define PG8_LDA(dst, b, h) do { _Pragma("unroll") for (int m = 0; m < 4; ++m) _Pragma("unroll") for (int k = 0; k < 2; ++k) dst[m][k] = *(const PG8_LAS bf16x8*)(lds + PG8_SA(b, h) + aoff + m * 2048 + k * 1024); } while (0)
#define PG8_LDB(dst, b, h) do { _Pragma("unroll") for (int n = 0; n < 2; ++n) _Pragma("unroll") for (int k = 0; k < 2; ++k) dst[n][k] = *(const PG8_LAS bf16x8*)(lds + PG8_SB(b, h) + boff + n * 2048 + k * 1024); } while (0)
#define PG8_MMA(ai, bj, At, Bt) do { __builtin_amdgcn_s_setprio(1); _Pragma("unroll") for (int m = 0; m < 4; ++m) _Pragma("unroll") for (int n = 0; n < 2; ++n) _Pragma("unroll") for (int k = 0; k < 2; ++k) \
        acc[ai][bj][m][n] = __builtin_amdgcn_mfma_f32_16x16x32_bf16(Bt[n][k], At[m][k], acc[ai][bj][m][n], 0, 0, 0); __builtin_amdgcn_s_setprio(0); } while (0)
#define PG8_WAIT_V(n) asm volatile("s_waitcnt vmcnt(" #n ")" ::: "memory")
#define PG8_WAIT_L(n) asm volatile("s_waitcnt lgkmcnt(" #n ")" ::: "memory")
#define PG8_BAR __builtin_amdgcn_s_barrier()
#define PG8_SCHED __builtin_amdgcn_sched_barrier(0)
    Unit cur, nxt; int ui = 0;
    if (!S.next(0, cur)) return;
    f32x4 acc[2][2][4][2];
#pragma unroll
    for (int a = 0; a < 2; ++a)
#pragma unroll
        for (int b = 0; b < 2; ++b)
#pragma unroll
            for (int m = 0; m < 4; ++m)
#pragma unroll
                for (int n = 0; n < 2; ++n) acc[a][b][m][n] = (f32x4){0.f, 0.f, 0.f, 0.f};
    bf16x8 At[4][2], B0[2][2], B1[2][2];
    const char* cA = (const char*)g.A + (size_t)cur.pm * tstep; const char* cB = (const char*)g.Bt + (size_t)cur.pn * tstep;
    S.a_ready(cur);
    if constexpr (SP2) {
        PG8_STAGE(PG8_SB(0, 0), cB, voffB); PG8_STAGE(PG8_SB(0, 1), cB + hstep, voffB); PG8_STAGE(PG8_SA(0, 0), cA, voffA); PG8_STAGE(PG8_SA(0, 1), cA + hstep, voffA);
        if (wr == 1) PG8_BAR;
        PG8_WAIT_V(2); PG8_BAR;
        PG8_STAGE(PG8_SB(1, 0), cB + kstep, voffB); PG8_STAGE(PG8_SA(1, 0), cA + kstep, voffA); PG8_STAGE(PG8_SB(1, 1), cB + hstep + kstep, voffB);
        PG8_WAIT_V(6); PG8_BAR;
    } else {
        PG8_STAGE(PG8_SB(0, 0), cB, voffB); PG8_STAGE(PG8_SA(0, 0), cA, voffA); PG8_STAGE(PG8_SB(0, 1), cB + hstep, voffB); PG8_STAGE(PG8_SA(0, 1), cA + hstep, voffA);
        if (wr == 1) PG8_BAR;
        PG8_WAIT_V(4); PG8_BAR;
        PG8_STAGE(PG8_SB(1, 0), cB + kstep, voffB); PG8_STAGE(PG8_SA(1, 0), cA + kstep, voffA); PG8_STAGE(PG8_SB(1, 1), cB + hstep + kstep, voffB);
        PG8_WAIT_V(6); PG8_BAR;
    }
    for (;;) {
        const bool has_next = S.next(ui + 1, nxt);
        const char* nA = has_next ? (const char*)g.A + (size_t)nxt.pm * tstep : cA; const char* nB = has_next ? (const char*)g.Bt + (size_t)nxt.pn * tstep : cB;
        for (int t = 0; t < nt; t += 2) {
            const bool last = (t == nt - 2);
            const char* a1 = cA + (size_t)(t + 1) * kstep;
            const char* a2 = last ? nA : cA + (size_t)(t + 2) * kstep; const char* b2 = last ? nB : cB + (size_t)(t + 2) * kstep;
            const char* a3 = a2 + kstep; const char* b3 = b2 + kstep;
            if (last && has_next) S.a_ready(nxt);
            if constexpr (SP2) {
            PG8_LDB(B0, 0, 0); PG8_LDB(B1, 0, 1); PG8_SCHED; PG8_LDA(At, 0, 0); PG8_STAGE(PG8_SA(1, 1), a1 + hstep, voffA);
            PG8_WAIT_V(8); PG8_WAIT_L(0); PG8_BAR; PG8_MMA(0, 0, At, B0); PG8_MMA(0, 1, At, B1); PG8_BAR; PG8_SCHED;
            PG8_LDA(At, 0, 1); PG8_STAGE(PG8_SB(0, 0), b2, voffB); PG8_STAGE(PG8_SB(0, 1), b2 + hstep, voffB); PG8_STAGE(PG8_SA(0, 0), a2, voffA);
            PG8_WAIT_V(8); PG8_WAIT_L(0); PG8_BAR; PG8_MMA(1, 0, At, B0); PG8_MMA(1, 1, At, B1); PG8_BAR; PG8_SCHED;
            PG8_LDB(B0, 1, 0); PG8_LDB(B1, 1, 1); PG8_SCHED; PG8_LDA(At, 1, 0); PG8_STAGE(PG8_SA(0, 1), a2 + hstep, voffA);
            PG8_WAIT_V(8); PG8_WAIT_L(0); PG8_BAR; PG8_MMA(0, 0, At, B0); PG8_MMA(0, 1, At, B1); PG8_BAR; PG8_SCHED;
            PG8_LDA(At, 1, 1); PG8_STAGE(PG8_SB(1, 0), b3, voffB); PG8_STAGE(PG8_SB(1, 1), b3 + hstep, voffB); PG8_STAGE(PG8_SA(1, 0), a3, voffA);
            PG8_WAIT_V(8); PG8_WAIT_L(0); PG8_BAR; PG8_MMA(1, 0, At, B0); PG8_MMA(1, 1, At, B1); PG8_BAR; PG8_SCHED;
            } else {
            PG8_LDB(B0, 0, 0); PG8_SCHED; PG8_LDA(At, 0, 0); PG8_STAGE(PG8_SA(1, 1), a1 + hstep, voffA);
            PG8_WAIT_L(8); PG8_BAR; PG8_WAIT_L(0); PG8_MMA(0, 0, At, B0); PG8_BAR; PG8_SCHED;
            PG8_LDB(B1, 0, 1); PG8_STAGE(PG8_SB(0, 0), b2, voffB);
            PG8_BAR; PG8_WAIT_L(0); PG8_MMA(0, 1, At, B1); PG8_BAR;
            PG8_LDA(At, 0, 1); PG8_STAGE(PG8_SA(0, 0), a2, voffA);
            PG8_BAR; PG8_WAIT_L(0); PG8_MMA(1, 0, At, B0); PG8_BAR; PG8_SCHED;
            PG8_STAGE(PG8_SB(0, 1), b2 + hstep, voffB);
            PG8_WAIT_V(6); PG8_BAR; PG8_MMA(1, 1, At, B1); PG8_BAR;
            PG8_LDB(B0, 1, 0); PG8_SCHED; PG8_LDA(At, 1, 0); PG8_STAGE(PG8_SA(0, 1), a2 + hstep, voffA);
            PG8_WAIT_L(8); PG8_BAR; PG8_WAIT_L(0); PG8_MMA(0, 0, At, B0); PG8_BAR; PG8_SCHED;
            PG8_LDB(B1, 1, 1); PG8_STAGE(PG8_SB(1, 0), b3, voffB);
            PG8_BAR; PG8_WAIT_L(0); PG8_MMA(0, 1, At, B1); PG8_BAR;
            PG8_LDA(At, 1, 1); PG8_STAGE(PG8_SA(1, 0), a3, voffA);
            PG8_BAR; PG8_WAIT_L(0); PG8_MMA(1, 0, At, B0); PG8_BAR; PG8_SCHED;
            PG8_STAGE(PG8_SB(1, 1), b3 + hstep, voffB);
            PG8_WAIT_V(6); PG8_BAR; PG8_MMA(1, 1, At, B1); PG8_BAR;
            }
        }
        if constexpr (ALIGN_EPI) { if (wr == 0) PG8_BAR; }
        if constexpr (!Epi::AFTER_DRAIN) { E(acc, cur, wr, wc, fr, fq); S.done(cur); }
        if (!has_next) break;
#pragma unroll
        for (int a = 0; a < 2; ++a)
#pragma unroll
            for (int b = 0; b < 2; ++b)
#pragma unroll
                for (int m = 0; m < 4; ++m)
#pragma unroll
                    for (int n = 0; n < 2; ++n) acc[a][b][m][n] = (f32x4){0.f, 0.f, 0.f, 0.f};
        cur = nxt; cA = nA; cB = nB; ++ui;
        if constexpr (ALIGN_EPI) { if (wr == 1) PG8_BAR; }
    }
    PG8_WAIT_V(0);
    if constexpr (!ALIGN_EPI) { if (wr == 0) PG8_BAR; }
    PG8_BAR;
    if constexpr (Epi::AFTER_DRAIN) { E.fused(acc, cur, wr, wc, fr, fq, lds, wid, lane); S.done(cur); }
#undef PG8_SA
#undef PG8_SB
#undef PG8_STAGE
#undef PG8_LDA
#undef PG8_LDB
#undef PG8_MMA
#undef PG8_WAIT_V
#undef PG8_WAIT_L
#undef PG8_BAR
#undef PG8_SCHED
}

struct HybridOrder {
    int nM, nN, nwg, G, c, nt, nfull, R, ns;
    __device__ __forceinline__ void init(int M, int N, int K, int G_, int c_, bool allow_split) {
        nM = M / BM; nN = N / BM; nwg = nM * nN; G = G_; c = c_; nt = K / BK; nfull = nwg / G; R = nwg - nfull * G;
        ns = (allow_split && R > 0 && (R % 8) == 0 && (G % 8) == 0) ? G / R : 1; if (ns > 8) ns = 8; if (ns > nt / 2) ns = nt / 2; if (ns < 2) ns = 1;
    }
    __device__ __forceinline__ void map(int L, Unit& u) const {
        int wgid = L; { const int q = nwg / NXCD, r = nwg % NXCD, xcd = wgid % NXCD, off = wgid / NXCD; wgid = (xcd < r ? xcd * (q + 1) : r * (q + 1) + (xcd - r) * q) + off; }
        const int nig = WGM * nN, gid = wgid / nig, fm = gid * WGM, gsz = (nM - fm) < WGM ? (nM - fm) : WGM;
        u.pm = fm + ((wgid % nig) % gsz); u.pn = (wgid % nig) / gsz;
    }
    __device__ __forceinline__ bool next(int i, Unit& u) const {
        if (i < nfull) { map(i * G + c, u); u.kb = 0; u.nk = nt; u.tinfo = -1; return true; }
        if (i > nfull || R == 0) return false;
        if (ns < 2) { const int L = i * G + c; if (L >= nwg) return false; map(L, u); u.kb = 0; u.nk = nt; u.tinfo = -1; return true; }
        const int x = c % 8, y = c / 8, tj = (y / ns) * 8 + x, slice = y % ns;
        if (tj >= R) return false;
        map(nfull * G + tj, u);
        const int pairs = nt / 2, base = pairs / ns, rem = pairs % ns, start = slice * base + (slice < rem ? slice : rem), mine = base + (slice < rem ? 1 : 0);
        u.kb = 2 * start; u.nk = 2 * mine; u.tinfo = (tj << 8) | (slice << 4) | ns; return true;
    }
};
struct TailCtx { f32x4* slab; unsigned* cnt; };

template <class Epi>
__device__ __forceinline__ void tail_fixup(f32x4 (&acc)[2][2][4][2], const Unit& u, const Epi& E, const TailCtx& T, int tid, int wr, int wc, int fr, int fq) {
    const int tj = u.tinfo >> 8, slice = (u.tinfo >> 4) & 15, ns = u.tinfo & 15;
    const __amdgpu_buffer_rsrc_t srs = __builtin_amdgcn_make_buffer_rsrc((void*)(T.slab + (size_t)(tj * ns + slice) * (32 * 512)), (short)0, 32 * 512 * 16, 0x00020000);
#pragma unroll
    for (int ai = 0; ai < 2; ++ai)
#pragma unroll
        for (int bj = 0; bj < 2; ++bj)
#pragma unroll
            for (int m = 0; m < 4; ++m)
#pragma unroll
                for (int n = 0; n < 2; ++n) __builtin_amdgcn_raw_buffer_store_b128(__builtin_bit_cast(u32x4, acc[ai][bj][m][n]), srs, (unsigned)(((((ai * 2 + bj) * 4 + m) * 2 + n) * 512 + tid) * 16), 0, 16);
    asm volatile("s_waitcnt vmcnt(0)" ::: "memory");
    __syncthreads();
    if (tid == 0) __hip_atomic_fetch_add(T.cnt + 64 * tj, 1u, __ATOMIC_RELAXED, __HIP_MEMORY_SCOPE_AGENT);
    if (tid < 64) {
        unsigned sp = 0;
        while (__hip_atomic_load(T.cnt + 64 * tj, __ATOMIC_RELAXED, __HIP_MEMORY_SCOPE_AGENT) < (unsigned)ns && ++sp < (1u << 22)) __builtin_amdgcn_s_sleep(2);
        __builtin_amdgcn_fence(__ATOMIC_ACQUIRE, "agent");
        asm volatile("s_waitcnt vmcnt(0)" ::: "memory");
    }
    __syncthreads();
    unsigned gmask = 0u;
    for (int g = slice; g < 8; g += ns) gmask |= 1u << g;
    const f32x4* tile = T.slab + (size_t)(tj * ns) * (32 * 512);
#pragma unroll
    for (int ai = 0; ai < 2; ++ai)
#pragma unroll
        for (int m = 0; m < 4; ++m) {
            if (!((gmask >> (ai * 4 + m)) & 1u)) continue;
#pragma unroll
            for (int bj = 0; bj < 2; ++bj)
#pragma unroll
                for (int n = 0; n < 2; ++n) {
                    const int idx = ((ai * 2 + bj) * 4 + m) * 2 + n;
                    f32x4 v = tile[idx * 512 + tid];
                    for (int sl = 1; sl < ns; ++sl) v = v + tile[(size_t)sl * (32 * 512) + idx * 512 + tid];
                    acc[ai][bj][m][n] = v;
                }
        }
    E(acc, u, wr, wc, fr, fq, gmask);
}

template <class Epi, class Sched>
__device__ __forceinline__ void gemm_phase2(PG8_LAS unsigned char* lds, const Gemm g, const Sched& S, const Epi& E, const TailCtx& T) {
    int tid_ = threadIdx.x; asm volatile("" : "+v"(tid_));
    const int tid = tid_, wid = __builtin_amdgcn_readfirstlane(tid >> 6), lane = tid & 63, wr = wid >> 2, wc = wid & 3, fr = lane & 15, fq = lane >> 4;
    const int K = g.K;
    unsigned voffA[2], voffB[2];
#pragma unroll
    for (int i = 0; i < 2; ++i) { int R, C; stage_rc(tid * 16 + i * 8192, R, C); const int Rb = Epi::PERM ? ((R & ~31) + perm32(R & 31)) : R;
        voffA[i] = (unsigned)(R * K + C) * 2u; voffB[i] = (unsigned)(Rb * K + C) * 2u; }
    const size_t kstep = (size_t)(BK * 2), hstep = (size_t)HALF * K * 2, tstep = 2 * hstep;
    const unsigned ldsw = (unsigned)wid * 1024u;
    const int aoff = lds_byte(wr * 64 + fr, fq * 8), boff = lds_byte(wc * 32 + fr, fq * 8);
#define PG8_SA(b, h) (((b) * 2 + (h)) * HTB)
#define PG8_SB(b, h) ((4 + (b) * 2 + (h)) * HTB)
#define PG8_STAGE(bufoff, gbase, voff) do { _Pragma("unroll") for (int _i = 0; _i < 2; ++_i) \
        __builtin_amdgcn_global_load_lds((const unsigned*)((const char*)(gbase) + (voff)[_i]), (PG8_LAS unsigned*)(lds + (bufoff) + ldsw + _i * 8192), 16, 0, 0); } while (0)
#define PG8_LDA(dst, b, h) do { _Pragma("unroll") for (int m = 0; m < 4; ++m) _Pragma("unroll") for (int k = 0; k < 2; ++k) dst[m][k] = *(const PG8_LAS bf16x8*)(lds + PG8_SA(b, h) + aoff + m * 2048 + k * 1024); } while (0)
#define PG8_LDB(dst, b, h) do { _Pragma("unroll") for (int n = 0; n < 2; ++n) _Pragma("unroll") for (int k = 0; k < 2; ++k) dst[n][k] = *(const PG8_LAS bf16x8*)(lds + PG8_SB(b, h) + boff + n * 2048 + k * 1024); } while (0)
#define PG8_MMA(ai, bj, At, Bt) do { __builtin_amdgcn_s_setprio(1); _Pragma("unroll") for (int m = 0; m < 4; ++m) _Pragma("unroll") for (int n = 0; n < 2; ++n) _Pragma("unroll") for (int k = 0; k < 2; ++k) \
        acc[ai][bj][m][n] = __builtin_amdgcn_mfma_f32_16x16x32_bf16(Bt[n][k], At[m][k], acc[ai][bj][m][n], 0, 0, 0); __builtin_amdgcn_s_setprio(0); } while (0)
#define PG8_WAIT_V(n) asm volatile("s_waitcnt vmcnt(" #n ")" ::: "memory")
#define PG8_WAIT_L(n) asm volatile("s_waitcnt lgkmcnt(" #n ")" ::: "memory")
#define PG8_BAR __builtin_amdgcn_s_barrier()
#define PG8_SCHED __builtin_amdgcn_sched_barrier(0)
    Unit cur, nxt; int ui = 0;
    if (!S.next(0, cur)) return;
    f32x4 acc[2][2][4][2];
#pragma unroll
    for (int a = 0; a < 2; ++a)
#pragma unroll
        for (int b = 0; b < 2; ++b)
#pragma unroll
            for (int m = 0; m < 4; ++m)
#pragma unroll
                for (int n = 0; n < 2; ++n) acc[a][b][m][n] = (f32x4){0.f, 0.f, 0.f, 0.f};
    bf16x8 At[4][2], B0[2][2], B1[2][2];
    const char* cA = (const char*)g.A + (size_t)cur.pm * tstep + (size_t)cur.kb * kstep; const char* cB = (const char*)g.Bt + (size_t)cur.pn * tstep + (size_t)cur.kb * kstep;
    PG8_STAGE(PG8_SB(0, 0), cB, voffB); PG8_STAGE(PG8_SB(0, 1), cB + hstep, voffB); PG8_STAGE(PG8_SA(0, 0), cA, voffA); PG8_STAGE(PG8_SA(0, 1), cA + hstep, voffA);
    if (wr == 1) PG8_BAR;
    PG8_WAIT_V(2); PG8_BAR;
    PG8_STAGE(PG8_SB(1, 0), cB + kstep, voffB); PG8_STAGE(PG8_SA(1, 0), cA + kstep, voffA); PG8_STAGE(PG8_SB(1, 1), cB + hstep + kstep, voffB);
    PG8_WAIT_V(6); PG8_BAR;
    for (;;) {
        const bool has_next = S.next(ui + 1, nxt);
        const char* nA = has_next ? (const char*)g.A + (size_t)nxt.pm * tstep + (size_t)nxt.kb * kstep : cA; const char* nB = has_next ? (const char*)g.Bt + (size_t)nxt.pn * tstep + (size_t)nxt.kb * kstep : cB;
        const int nt = cur.nk;
        for (int t = 0; t < nt; t += 2) {
            const bool last = (t == nt - 2);
            const char* a1 = cA + (size_t)(t + 1) * kstep;
            const char* a2 = last ? nA : cA + (size_t)(t + 2) * kstep; const char* b2 = last ? nB : cB + (size_t)(t + 2) * kstep;
            const char* a3 = a2 + kstep; const char* b3 = b2 + kstep;
            PG8_LDB(B0, 0, 0); PG8_LDB(B1, 0, 1); PG8_SCHED; PG8_LDA(At, 0, 0); PG8_STAGE(PG8_SA(1, 1), a1 + hstep, voffA);
            PG8_WAIT_V(8); PG8_WAIT_L(0); PG8_BAR; PG8_MMA(0, 0, At, B0); PG8_MMA(0, 1, At, B1); PG8_BAR; PG8_SCHED;
            PG8_LDA(At, 0, 1); PG8_STAGE(PG8_SB(0, 0), b2, voffB); PG8_STAGE(PG8_SB(0, 1), b2 + hstep, voffB); PG8_STAGE(PG8_SA(0, 0), a2, voffA);
            PG8_WAIT_V(8); PG8_WAIT_L(0); PG8_BAR; PG8_MMA(1, 0, At, B0); PG8_MMA(1, 1, At, B1); PG8_BAR; PG8_SCHED;
            PG8_LDB(B0, 1, 0); PG8_LDB(B1, 1, 1); PG8_SCHED; PG8_LDA(At, 1, 0); PG8_STAGE(PG8_SA(0, 1), a2 + hstep, voffA);
            PG8_WAIT_V(8); PG8_WAIT_L(0); PG8_BAR; PG8_MMA(0, 0, At, B0); PG8_MMA(0, 1, At, B1); PG8_BAR; PG8_SCHED;
            PG8_LDA(At, 1, 1); PG8_STAGE(PG8_SB(1, 0), b3, voffB); PG8_STAGE(PG8_SB(1, 1), b3 + hstep, voffB); PG8_STAGE(PG8_SA(1, 0), a3, voffA);
            PG8_WAIT_V(8); PG8_WAIT_L(0); PG8_BAR; PG8_MMA(1, 0, At, B0); PG8_MMA(1, 1, At, B1); PG8_BAR; PG8_SCHED;
        }
        if (wr == 0) PG8_BAR;
        if (cur.tinfo < 0) E(acc, cur, wr, wc, fr, fq);
        if (!has_next) break;
#pragma unroll
        for (int a = 0; a < 2; ++a)
#pragma unroll
            for (int b = 0; b < 2; ++b)
#pragma unroll
                for (int m = 0; m < 4; ++m)
#pragma unroll
                    for (int n = 0; n < 2; ++n) acc[a][b][m][n] = (f32x4){0.f, 0.f, 0.f, 0.f};
        cur = nxt; cA = nA; cB = nB; ++ui;
        if (wr == 1) PG8_BAR;
    }
    PG8_WAIT_V(0);
    PG8_BAR;
    if (cur.tinfo >= 0) tail_fixup(acc, cur, E, T, tid, wr, wc, fr, fq);
#undef PG8_SA
#undef PG8_SB
#undef PG8_STAGE
#undef PG8_LDA
#undef PG8_LDB
#undef PG8_MMA
#undef PG8_WAIT_V
#undef PG8_WAIT_L
#undef PG8_BAR
#undef PG8_SCHED
}

struct MUnit { int kind, pm, pn, kb, nk, tinfo; };
struct MOrder {
    int c;
    __device__ __forceinline__ bool next(int i, MUnit& u) const {
        const int j = i * 256 + c;
        u.kb = 0; u.tinfo = -1;
        if (j < 288) { u.kind = 0; u.nk = D / BK;
            if (j < 256) { const int x = j & 7, r = j >> 3; u.pm = 4 * x + (r >> 3); u.pn = r & 7; } else { const int t = j - 256; u.pm = 32 + (t >> 3); u.pn = t & 7; }
            return true; }
        if (j < 1872) { u.kind = 1; u.nk = D / BK; const int L = j - 288;
            if (L < 1408) { const int x = L & 7, off = L >> 3, wg = x * 176 + off, gid = wg / 352, rem = wg % 352; u.pm = gid * 8 + (rem & 7); u.pn = rem >> 3; }
            else { const int t = L - 1408; u.pm = 32 + (t & 3); u.pn = t >> 2; }
            return true; }
        if (j < 2128) { u.kind = 2; u.nk = DFF / BK; const int L = j - 1872, x = L & 7, r = L >> 3; u.pm = 4 * x + (r >> 3); u.pn = r & 7; return true; }
        const int ilast = (c < 80) ? 9 : 8;
        if (i != ilast || c < 80 || c >= 208) return false;
        const int mi = c - 80, tj = mi >> 2, slice = mi & 3;
        u.kind = 2; u.pm = 32 + (tj >> 3); u.pn = tj & 7; u.kb = slice * 22; u.nk = 22; u.tinfo = (tj << 8) | (slice << 4) | 4; return true;
    }
};

struct StreamOff { size_t A0, B0, A1, B1, A2, B2, x2b, slab; int dep3, dep4, tail, rsq2, rsq3; };
template <class SO>
__device__ __forceinline__ void gemm_stream(PG8_LAS unsigned char* lds, const MOrder& S, unsigned char* ws, const float* xp, const float* xs, const SO O) {
    int tid_ = threadIdx.x; asm volatile("" : "+v"(tid_));
    const int tid = tid_, wid = __builtin_amdgcn_readfirstlane(tid >> 6), lane = tid & 63, wr = wid >> 2, wc = wid & 3, fr = lane & 15, fq = lane >> 4;
    unsigned Ra[2][2], Rb[2][2];
#pragma unroll
    for (int i = 0; i < 2; ++i) { int R, C; stage_rc(tid * 16 + i * 8192, R, C); const int Rp = (R & ~31) + perm32(R & 31);
        Ra[0][i] = (unsigned)(R * D + C) * 2u; Ra[1][i] = (unsigned)(R * DFF + C) * 2u; Rb[0][i] = (unsigned)(Rp * D + C) * 2u; Rb[1][i] = (unsigned)(Rp * DFF + C) * 2u; }
    const size_t kstep = (size_t)(BK * 2);
    const unsigned ldsw = (unsigned)wid * 1024u;
    const int aoff = lds_byte(wr * 64 + fr, fq * 8), boff = lds_byte(wc * 32 + fr, fq * 8);
#define PG8_SA(b, h) (((b) * 2 + (h)) * HTB)
#define PG8_SB(b, h) ((4 + (b) * 2 + (h)) * HTB)
#define PG8_STG(bufoff, gbase, Rr, rowb) do { _Pragma("unroll") for (int _i = 0; _i < 2; ++_i) \
        __builtin_amdgcn_global_load_lds((const unsigned*)((const char*)(gbase) + ((rowb) == D * 2 ? (Rr)[0][_i] : (Rr)[1][_i])), (PG8_LAS unsigned*)(lds + (bufoff) + ldsw + _i * 8192), 16, 0, 0); } while (0)
#define PG8_LDA(dst, b, h) do { _Pragma("unroll") for (int m = 0; m < 4; ++m) _Pragma("unroll") for (int k = 0; k < 2; ++k) dst[m][k] = *(const PG8_LAS bf16x8*)(lds + PG8_SA(b, h) + aoff + m * 2048 + k * 1024); } while (0)
#define PG8_LDB(dst, b, h) do { _Pragma("unroll") for (int n = 0; n < 2; ++n) _Pragma("unroll") for (int k = 0; k < 2; ++k) dst[n][k] = *(const PG8_LAS bf16x8*)(lds + PG8_SB(b, h) + boff + n * 2048 + k * 1024); } while (0)
#define PG8_MMA(ai, bj, At, Bt) do { __builtin_amdgcn_s_setprio(1); _Pragma("unroll") for (int m = 0; m < 4; ++m) _Pragma("unroll") for (int n = 0; n < 2; ++n) _Pragma("unroll") for (int k = 0; k < 2; ++k) \
        acc[ai][bj][m][n] = __builtin_amdgcn_mfma_f32_16x16x32_bf16(Bt[n][k], At[m][k], acc[ai][bj][m][n], 0, 0, 0); __builtin_amdgcn_s_setprio(0); } while (0)
#define PG8_WAIT_V(n) asm volatile("s_waitcnt vmcnt(" #n ")" ::: "memory")
#define PG8_WAIT_L(n) asm volatile("s_waitcnt lgkmcnt(" #n ")" ::: "memory")
#define PG8_BAR __builtin_amdgcn_s_barrier()
#define PG8_SCHED __builtin_amdgcn_sched_barrier(0)
#define MU_A(u) ((const char*)ws + ((u).kind == 0 ? O.A0 : (u).kind == 1 ? O.A1 : O.A2) + (size_t)(u).pm * 256 * MU_RB(u) + (size_t)(u).kb * kstep)
#define MU_B(u) ((const char*)ws + ((u).kind == 0 ? O.B0 : (u).kind == 1 ? O.B1 : O.B2) + (size_t)(u).pn * 256 * MU_RB(u) + (size_t)(u).kb * kstep)
#define MU_RB(u) ((u).kind == 2 ? DFF * 2 : D * 2)
    unsigned long long rdy3 = 0ull, rdy4 = 0ull;
#define MU_READY(u) do { if ((u).kind != 0) { unsigned long long& _m = (u).kind == 1 ? rdy3 : rdy4; if (!((_m >> (u).pm) & 1ull)) { \
        if (wid == 0) { unsigned* _c = (unsigned*)ws + ((u).kind == 1 ? O.dep3 : O.dep4) + 64 * (u).pm; const unsigned _t = (u).kind == 1 ? 64u : 352u; unsigned _sp = 0; \
            while (__hip_atomic_load(_c, __ATOMIC_RELAXED, __HIP_MEMORY_SCOPE_AGENT) < _t && ++_sp < (1u << 22)) __builtin_amdgcn_s_sleep(2); \
            __builtin_amdgcn_fence(__ATOMIC_ACQUIRE, "agent"); asm volatile("s_waitcnt vmcnt(0)" ::: "memory"); } \
        asm volatile("" ::: "memory"); PG8_BAR; asm volatile("" ::: "memory"); _m |= 1ull << (u).pm; } } } while (0)
    PG8_LAS unsigned* vflag = (PG8_LAS unsigned*)(lds + 147456 - 256 + 64);
#define MU_TRY(u, ok) do { ok = true; if ((u).kind != 0) { unsigned long long& _m = (u).kind == 1 ? rdy3 : rdy4; if (!((_m >> (u).pm) & 1ull)) { \
        if (wid == 0) { unsigned* _c = (unsigned*)ws + ((u).kind == 1 ? O.dep3 : O.dep4) + 64 * (u).pm; const unsigned _t = (u).kind == 1 ? 64u : 352u; \
            const bool _r = __hip_atomic_load(_c, __ATOMIC_RELAXED, __HIP_MEMORY_SCOPE_AGENT) >= _t; \
            if (_r) { __builtin_amdgcn_fence(__ATOMIC_ACQUIRE, "agent"); asm volatile("s_waitcnt vmcnt(0)" ::: "memory"); } \
            if (lane == 0) *vflag = _r ? 1u : 0u; asm volatile("s_waitcnt lgkmcnt(0)" ::: "memory"); } \
        asm volatile("" ::: "memory"); PG8_BAR; asm volatile("" ::: "memory"); \
        ok = (*(volatile PG8_LAS unsigned*)vflag) != 0u; if (ok) _m |= 1ull << (u).pm; } } } while (0)
    MUnit cur, nxt; int ui = 0;
    if (!S.next(0, cur)) return;
    f32x4 acc[2][2][4][2];
#pragma unroll
    for (int a = 0; a < 2; ++a)
#pragma unroll
        for (int b = 0; b < 2; ++b)
#pragma unroll
            for (int m = 0; m < 4; ++m)
#pragma unroll
                for (int n = 0; n < 2; ++n) acc[a][b][m][n] = (f32x4){0.f, 0.f, 0.f, 0.f};
    bf16x8 At[4][2], B0[2][2], B1[2][2];
    bool more = true;
    while (more) {
#ifdef TPROBE
    if (threadIdx.x == 0 && cur.tinfo >= 0) ((volatile PG8_LAS unsigned long long*)(lds + 147456 - 256 + 128))[10] = __builtin_amdgcn_s_memrealtime();
#endif
    MU_READY(cur);
    const char* cA = MU_A(cur); const char* cB = MU_B(cur); int crb = MU_RB(cur);
    PG8_STG(PG8_SB(0, 0), cB, Rb, crb); PG8_STG(PG8_SB(0, 1), cB + (size_t)HALF * crb, Rb, crb); PG8_STG(PG8_SA(0, 0), cA, Ra, crb); PG8_STG(PG8_SA(0, 1), cA + (size_t)HALF * crb, Ra, crb);
    if (wr == 1) PG8_BAR;
    PG8_WAIT_V(2); PG8_BAR;
    PG8_STG(PG8_SB(1, 0), cB + kstep, Rb, crb); PG8_STG(PG8_SA(1, 0), cA + kstep, Ra, crb); PG8_STG(PG8_SB(1, 1), cB + (size_t)HALF * crb + kstep, Rb, crb);
    PG8_WAIT_V(6); PG8_BAR;
    for (;;) {
        const bool has_next = S.next(ui + 1, nxt);
        bool chain = has_next;
        const char* nA = cA; const char* nB = cB; int nrb = crb;
        const int nt = cur.nk;
        for (int t = 0; t < nt; t += 2) {
            const bool last = (t == nt - 2);
            if (last && has_next) { MU_TRY(nxt, chain); if (chain) { nA = MU_A(nxt); nB = MU_B(nxt); nrb = MU_RB(nxt); } }
            const char* a1 = cA + (size_t)(t + 1) * kstep;
            const char* a2 = last ? nA : cA + (size_t)(t + 2) * kstep; const char* b2 = last ? nB : cB + (size_t)(t + 2) * kstep; const int rb2 = last ? nrb : crb;
            const char* a3 = a2 + kstep; const char* b3 = b2 + kstep;
            const size_t h1 = (size_t)HALF * crb, h2 = (size_t)HALF * rb2;
            PG8_LDB(B0, 0, 0); PG8_LDB(B1, 0, 1); PG8_SCHED; PG8_LDA(At, 0, 0); PG8_STG(PG8_SA(1, 1), a1 + h1, Ra, crb);
            PG8_WAIT_V(8); PG8_WAIT_L(0); PG8_BAR; PG8_MMA(0, 0, At, B0); PG8_MMA(0, 1, At, B1); PG8_BAR; PG8_SCHED;
            PG8_LDA(At, 0, 1); PG8_STG(PG8_SB(0, 0), b2, Rb, rb2); PG8_STG(PG8_SB(0, 1), b2 + h2, Rb, rb2); PG8_STG(PG8_SA(0, 0), a2, Ra, rb2);
            PG8_WAIT_V(8); PG8_WAIT_L(0); PG8_BAR; PG8_MMA(1, 0, At, B0); PG8_MMA(1, 1, At, B1); PG8_BAR; PG8_SCHED;
            PG8_LDB(B0, 1, 0); PG8_LDB(B1, 1, 1); PG8_SCHED; PG8_LDA(At, 1, 0); PG8_STG(PG8_SA(0, 1), a2 + h2, Ra, rb2);
            PG8_WAIT_V(8); PG8_WAIT_L(0); PG8_BAR; PG8_MMA(0, 0, At, B0); PG8_MMA(0, 1, At, B1); PG8_BAR; PG8_SCHED;
            PG8_LDA(At, 1, 1); PG8_STG(PG8_SB(1, 0), b3, Rb, rb2); PG8_STG(PG8_SB(1, 1), b3 + h2, Rb, rb2); PG8_STG(PG8_SA(1, 0), a3, Ra, rb2);
            PG8_WAIT_V(8); PG8_WAIT_L(0); PG8_BAR; PG8_MMA(1, 0, At, B0); PG8_MMA(1, 1, At, B1); PG8_BAR; PG8_SCHED;
        }
        if (wr == 0) PG8_BAR;
        if (cur.tinfo < 0) {
            const Unit u{cur.pm, cur.pn, 0, 0, -1};
            if (cur.kind == 0) { const EpiX1<false> E0{xp, xs, nullptr, (bf16_t*)(ws + O.A1), (float*)ws + O.rsq2, true}; E0(acc, u, wr, wc, fr, fq); }
            else if (cur.kind == 1) { const EpiAct E1{(bf16_t*)(ws + O.A2), (const float*)ws + O.rsq2, true}; E1(acc, u, wr, wc, fr, fq); }
            else { const EpiX2<false> E2{(bf16_t*)(ws + O.x2b), (float*)ws + O.rsq3, (const bf16_t*)(ws + O.A1)}; E2(acc, u, wr, wc, fr, fq); }
            if (cur.kind != 2) {
                asm volatile("s_waitcnt vmcnt(0)" ::: "memory");
                if (lane == 0) __hip_atomic_fetch_add((unsigned*)ws + (cur.kind == 0 ? O.dep3 : O.dep4) + 64 * cur.pm, 1u, __ATOMIC_RELAXED, __HIP_MEMORY_SCOPE_AGENT);
            }
        }
        if (!has_next) { more = false; break; }
        if (!chain) {
            PG8_WAIT_V(0); PG8_BAR;
#pragma unroll
            for (int a = 0; a < 2; ++a)
#pragma unroll
                for (int b = 0; b < 2; ++b)
#pragma unroll
                    for (int m = 0; m < 4; ++m)
#pragma unroll
                        for (int n = 0; n < 2; ++n) acc[a][b][m][n] = (f32x4){0.f, 0.f, 0.f, 0.f};
            cur = nxt; ++ui;
            break;
        }
#pragma unroll
        for (int a = 0; a < 2; ++a)
#pragma unroll
            for (int b = 0; b < 2; ++b)
#pragma unroll
                for (int m = 0; m < 4; ++m)
#pragma unroll
                    for (int n = 0; n < 2; ++n) acc[a][b][m][n] = (f32x4){0.f, 0.f, 0.f, 0.f};
        cur = nxt; cA = nA; cB = nB; crb = nrb; ++ui;
        if (wr == 1) PG8_BAR;
    }
    }
    PG8_WAIT_V(0);
    PG8_BAR;
#ifdef TPROBE
    if (threadIdx.x == 0) ((volatile PG8_LAS unsigned long long*)(lds + 147456 - 256 + 128))[9] = __builtin_amdgcn_s_memrealtime();
#endif
    if (cur.tinfo >= 0) { const Unit u{cur.pm, cur.pn, cur.kb, cur.nk, cur.tinfo}; const EpiX2<false> E2{(bf16_t*)(ws + O.x2b), (float*)ws + O.rsq3, (const bf16_t*)(ws + O.A1)};
        const TailCtx T{(f32x4*)(ws + O.slab), (unsigned*)ws + O.tail}; tail_fixup(acc, u, E2, T, tid, wr, wc, fr, fq); }
#undef MU_TRY
#undef MU_A
#undef MU_B
#undef MU_RB
#undef MU_READY
#undef PG8_SA
#undef PG8_SB
#undef PG8_STG
#undef PG8_LDA
#undef PG8_LDB
#undef PG8_MMA
#undef PG8_WAIT_V
#undef PG8_WAIT_L
#undef PG8_BAR
#undef PG8_SCHED
}
}
#define LAS __attribute__((address_space(3)))
typedef unsigned short bf16;
using pg8::f32x4; using pg8::u32x4; using pg8::u32x2; using pg8::bf16x8; using pg8::cvt_pk_bf16;

#ifndef ONE_LAUNCH
#define ONE_LAUNCH 1
#endif
constexpr int NWAVES = 8, NPHASE = 7;
constexpr int LDS_BYTES = 147456;
constexpr size_t MiB = 1u << 20;
constexpr size_t WS_CTL = 0, CTL_ZERO_BYTES = 1 * MiB;
constexpr size_t WS_WIN = 1 * MiB;
constexpr size_t WS_WO = 21 * MiB;
constexpr size_t WS_WGU = 29 * MiB;
constexpr size_t WS_WD = 73 * MiB;
constexpr size_t WS_WP = 95 * MiB;
constexpr size_t WS_MISC = 96 * MiB;
constexpr size_t WS_XB = 97 * MiB;
constexpr size_t WS_ZB = 133 * MiB;
constexpr size_t WS_LF = 223 * MiB;
constexpr size_t WS_ACT = WS_ZB;
constexpr size_t WS_MIX = 259 * MiB;
constexpr size_t WS_X2B = WS_WGU;
constexpr size_t WS_END = 328 * MiB;
constexpr int CW_RSQ2 = 4096, CW_RSQ3 = 4096 + M;
constexpr int CW_TAIL = 100000;
constexpr size_t WS_SLAB3 = WS_ACT, WS_SLAB45 = 232 * MiB;
constexpr int CW_DEP = 124000;
constexpr size_t WS_SLABM = 296 * MiB;
#ifndef MERGED
#define MERGED 1
#endif
constexpr int CW_BAR = 65536;
constexpr int MISC_OFF = 147456 - 256;
#ifndef USE_CG
#define USE_CG 0
#endif

__device__ __forceinline__ float wave_sum(float v) {
#pragma unroll
    for (int o = 1; o < 64; o <<= 1) v += __shfl_xor(v, o);
    return v;
}
__device__ __forceinline__ float bflo(unsigned w) { return __builtin_bit_cast(float, w << 16); }
__device__ __forceinline__ float bfhi(unsigned w) { return __builtin_bit_cast(float, w & 0xffff0000u); }
__device__ __forceinline__ float bf2f(bf16 b) { return __builtin_bit_cast(float, (unsigned)b << 16); }
__device__ __forceinline__ bf16 f2bf(float f) { unsigned u = __builtin_bit_cast(unsigned, f); return (bf16)((u + 0x7fffu + ((u >> 16) & 1u)) >> 16); }

#define XB_TMO      128
#define XB_XCNT(j)  (256  + 64 * (j))
#define XB_XSUB(j)  (1280 + 64 * (j))
#define XB_XGEN(j)  (2304 + 64 * (j))
#define XB_TOP      3328
#define XB_TOPGEN   3392
#define XCD_BAR_WORDS 3456
#define XB_SPIN_CAP (1u << 18)

__device__ __forceinline__ unsigned xb_ld(unsigned* p)              { return __hip_atomic_load(p, __ATOMIC_RELAXED, __HIP_MEMORY_SCOPE_AGENT); }
__device__ __forceinline__ unsigned xb_add(unsigned* p, unsigned v) { return __hip_atomic_fetch_add(p, v, __ATOMIC_RELAXED, __HIP_MEMORY_SCOPE_AGENT); }
__device__ __forceinline__ unsigned xb_xcc_id() { return (unsigned)__builtin_amdgcn_s_getreg((3 << 11) | 20) & 0xFu; }
#define XB_SPIN(cond, bar) do { unsigned _sp = 0; while (cond) { __builtin_amdgcn_s_sleep(1); \
    if ((++_sp & 255u) == 0u) { if (xb_ld(&(bar)[XB_TMO])) break; if (_sp > XB_SPIN_CAP) { atomicAdd(&(bar)[XB_TMO], 1u); break; } } } } while (0)

struct XcdBarrier {
    unsigned* bar; unsigned x;
    volatile LAS unsigned* st;
};

__device__ __forceinline__ XcdBarrier xcd_barrier_post(unsigned* bar, volatile LAS unsigned* st) {
    XcdBarrier b; b.bar = bar; b.x = xb_xcc_id(); b.st = st;
    if (threadIdx.x == 0) (void)xb_add(&bar[XB_XCNT(b.x)], 1u);
    return b;
}
__device__ __forceinline__ void xcd_barrier_complete(unsigned* bar, unsigned x, unsigned& nloc, unsigned& nx) {
    const unsigned G = gridDim.x * gridDim.y * gridDim.z;
    unsigned sum, cnt, mine, sp = 0u;
    for (;;) {
        sum = 0u; cnt = 0u; mine = 0u;
#pragma unroll
        for (unsigned j = 0; j < 16; ++j) { const unsigned c = xb_ld(&bar[XB_XCNT(j)]); sum += c; cnt += (c > 0u) ? 1u : 0u; mine = (j == x) ? c : mine; }
        if (sum == G) break;
        __builtin_amdgcn_s_sleep(1);
        if ((++sp & 255u) == 0u) { if (xb_ld(&bar[XB_TMO])) break; if (sp > XB_SPIN_CAP) { atomicAdd(&bar[XB_TMO], 1u); break; } }
    }
    nloc = mine > 0u ? mine : 1u; nx = cnt > 0u ? cnt : 1u;
}

__device__ __forceinline__ void xcd_barrier(const XcdBarrier& b) {
    asm volatile("s_waitcnt vmcnt(0)" ::: "memory");
    __syncthreads();
    if (threadIdx.x == 0) {
        unsigned* bar = b.bar;
        __builtin_amdgcn_s_waitcnt(0);
        unsigned nloc = b.st[0], nx = b.st[1];
        if (nloc == 0u) { xcd_barrier_complete(bar, b.x, nloc, nx); b.st[0] = nloc; b.st[1] = nx; }
        const unsigned old = xb_add(&bar[XB_XSUB(b.x)], 1u);
        const unsigned gen = old / nloc;
        if (old + 1u == (gen + 1u) * nloc) {
            __builtin_amdgcn_fence(__ATOMIC_RELEASE, "agent");
            asm volatile("s_waitcnt vmcnt(0)" ::: "memory");
            const unsigned og = xb_add(&bar[XB_TOP], 1u);
            const unsigned tg = og / nx;
            if (og + 1u == (tg + 1u) * nx) xb_add(&bar[XB_TOPGEN], 1u);
            else XB_SPIN(xb_ld(&bar[XB_TOPGEN]) == tg, bar);
            __builtin_amdgcn_fence(__ATOMIC_ACQUIRE, "agent");
            xb_add(&bar[XB_XGEN(b.x)], 1u);
            asm volatile("s_waitcnt vmcnt(0)" ::: "memory");
        } else {
            XB_SPIN(xb_ld(&bar[XB_XGEN(b.x)]) == gen, bar);
            __builtin_amdgcn_fence(__ATOMIC_ACQUIRE, "agent");
            asm volatile("s_waitcnt vmcnt(0)" ::: "memory");
        }
    }
    __syncthreads();
}


#ifdef TPROBE
#define STAMP(i) do { if (threadIdx.x == 0) ((volatile LAS unsigned long long*)(lds + MISC_OFF + 128))[i] = __builtin_amdgcn_s_memrealtime(); } while (0)
#else
#define STAMP(i) do {} while (0)
#endif
constexpr int CW_TP = 120000;

struct Args { const float* in[16]; float* out; unsigned char* ws; int ph_lo, ph_hi; };

__device__ __forceinline__ void p0_item(const float* W, int K, int N, bf16* WT, int mode, const float* sk, const float* sn, LAS float* scr, int item, int lane) {
    const int nblk = N / 64, kb = item / nblk, nb = item % nblk, k0 = 64 * kb, n0 = 64 * nb;
    const int drow0 = mode == 0 ? n0 : ((n0 >> 7) * 256 + (n0 & 127) + (mode == 2 ? 128 : 0));
    const int r = lane >> 4, c4 = lane & 15;
    f32x4 v[16];
#pragma unroll
    for (int i = 0; i < 16; ++i) v[i] = __builtin_nontemporal_load((const f32x4*)(W + (size_t)(k0 + 4 * i + r) * N + n0 + 4 * c4));
    if (sk) {
#pragma unroll
        for (int i = 0; i < 16; ++i) v[i] = v[i] * sk[k0 + 4 * i + r];
    }
#pragma unroll
    for (int i = 0; i < 16; ++i) { LAS float* d = scr + (4 * i + r) * 65 + 4 * c4; d[0] = v[i][0]; d[1] = v[i][1]; d[2] = v[i][2]; d[3] = v[i][3]; }
    asm volatile("s_waitcnt lgkmcnt(0)" ::: "memory");
    const int c = lane & 7, nn = lane >> 3;
#pragma unroll
    for (int j = 0; j < 8; ++j) { const int n = nn + 8 * j; const LAS float* s = scr + (8 * c) * 65 + n; const float f = sn ? sn[n0 + n] : 1.f;
        u32x4 o; o.x = cvt_pk_bf16(s[0 * 65] * f, s[1 * 65] * f); o.y = cvt_pk_bf16(s[2 * 65] * f, s[3 * 65] * f); o.z = cvt_pk_bf16(s[4 * 65] * f, s[5 * 65] * f); o.w = cvt_pk_bf16(s[6 * 65] * f, s[7 * 65] * f);
        *(u32x4*)(WT + (size_t)(drow0 + n) * K + k0 + 8 * c) = o; }
    asm volatile("s_waitcnt lgkmcnt(0)" ::: "memory");
}

constexpr int P0_I_IN = (D / 64) * (INC / 64), P0_I_O = (D / 64) * (D / 64), P0_I_G = (D / 64) * (DFF / 64), P0_I_D = (DFF / 64) * (D / 64), P0_I_P = (256 / 64) * (256 / 64);
constexpr int P0_NITEMS = P0_I_IN + P0_I_O + 2 * P0_I_G + P0_I_D + 4 * P0_I_P;
#ifndef P0_NDEF
#define P0_NDEF 3328
#endif
constexpr int P0_DEF_HI = P0_I_IN + P0_I_O + 2 * P0_I_G + P0_I_D, P0_DEF_LO = P0_DEF_HI - P0_NDEF;
__device__ __forceinline__ int p1_idle_wgs(int G) { const int nwg = (M / 256) * (INC / 256), nfull = nwg / G, R = nwg - nfull * G; return R > 0 ? G - R : 0; }
__device__ __forceinline__ void p0_weight_item(const Args& a, LAS float* scr, int it, int lane) {
    unsigned char* ws = a.ws;
    int r = it;
    if (r < P0_I_IN) { p0_item(a.in[6], D, INC, (bf16*)(ws + WS_WIN), 0, a.in[5], nullptr, scr, r, lane); return; } r -= P0_I_IN;
    if (r < P0_I_O) { p0_item(a.in[10], D, D, (bf16*)(ws + WS_WO), 0, nullptr, nullptr, scr, r, lane); return; } r -= P0_I_O;
    if (r < P0_I_G) { p0_item(a.in[12], D, DFF, (bf16*)(ws + WS_WGU), 1, a.in[11], nullptr, scr, r, lane); return; } r -= P0_I_G;
    if (r < P0_I_G) { p0_item(a.in[13], D, DFF, (bf16*)(ws + WS_WGU), 2, a.in[11], nullptr, scr, r, lane); return; } r -= P0_I_G;
    if (r < P0_I_D) { p0_item(a.in[14], DFF, D, (bf16*)(ws + WS_WD), 0, nullptr, nullptr, scr, r, lane); return; } r -= P0_I_D;
    { const int g = r / P0_I_P; p0_item(a.in[7] + (size_t)g * 65536, 256, 256, (bf16*)(ws + WS_WP) + (size_t)g * 65536, 0, nullptr, a.in[8] + g * 256, scr, r % P0_I_P, lane); }
}
__device__ __forceinline__ void phase0_deferred(LAS unsigned char* lds, const Args& a, int idle_idx, int nidle) {
    const int lane = threadIdx.x & 63, wave = threadIdx.x >> 6;
    LAS float* scr = (LAS float*)(lds + wave * 16640);
    for (int it = P0_DEF_LO + idle_idx * NWAVES + wave; it < P0_DEF_HI; it += nidle * NWAVES) p0_weight_item(a, scr, it, lane);
}
__device__ __forceinline__ void phase0(LAS unsigned char* lds, const Args& a, int vcu, int G) {
    const int tid = threadIdx.x, lane = tid & 63, wave = tid >> 6;
    unsigned char* ws = a.ws;
    LAS float* scr = (LAS float*)(lds + wave * 16640);
    const int gw = vcu * NWAVES + wave, NGW = G * NWAVES;
    const bool defer = p1_idle_wgs(G) >= 32;
    const int nlive = defer ? P0_NITEMS - (P0_DEF_HI - P0_DEF_LO) : P0_NITEMS;
    for (int k = gw; k < nlive; k += NGW) p0_weight_item(a, scr, (defer && k >= P0_DEF_LO) ? k + (P0_DEF_HI - P0_DEF_LO) : k, lane);
    float* rstd1 = (float*)(ws + WS_MISC); bf16* xb = (bf16*)(ws + WS_XB);
    for (int m = gw; m < M; m += NGW) {
        const float* xrow = m < MP ? a.in[0] + (size_t)m * D : a.in[1] + (size_t)(m - MP) * D;
        f32x4 v[8]; float s = 0.f;
#pragma unroll
        for (int j = 0; j < 8; ++j) { v[j] = __builtin_nontemporal_load((const f32x4*)xrow + lane + 64 * j); s += (v[j][0] * v[j][0] + v[j][1] * v[j][1]) + (v[j][2] * v[j][2] + v[j][3] * v[j][3]); }
        s = wave_sum(s);
        if (lane == 0) rstd1[m] = rsqrtf(s * (1.f / D) + EPS);
#pragma unroll
        for (int j = 0; j < 8; ++j) { u32x2 w; w.x = cvt_pk_bf16(v[j][0], v[j][1]); w.y = cvt_pk_bf16(v[j][2], v[j][3]); ((u32x2*)(xb + (size_t)m * D))[lane + 64 * j] = w; }
    }
    { u32x4* cz = (u32x4*)(ws + WS_CTL); const int gt0 = vcu * (NWAVES * 64) + tid, ngt0 = G * NWAVES * 64;
      for (int i = gt0; i < (int)(CTL_ZERO_BYTES / 16); i += ngt0) if (i < CW_BAR / 4 || i >= (CW_BAR + XCD_BAR_WORDS + 3) / 4) cz[i] = (u32x4){0u, 0u, 0u, 0u}; }
    const int gt = vcu * (NWAVES * 64) + tid, NGT = G * NWAVES * 64;
    float* lbv = (float*)(ws + WS_MISC) + M;
    for (int c = gt; c < HW; c += NGT) lbv[c] = 1.f / (1.f + __expf(a.in[4][HW + c] - a.in[4][c]));
    for (int i = gt; i < DB * 7 * PW; i += NGT) { const int b = i / (7 * PW), rem = i % (7 * PW); a.out[O_PSS + (size_t)b * PC * PW + rem] = a.in[2][(size_t)b * PC * PW + 8 * PW + rem]; }
}

template <int W, bool SAMPLE>
__device__ __forceinline__ void pool_fill(LAS bf16* A, int m0, int g, const bf16* zb, const float* cache) {
    const int tid = threadIdx.x, c8 = tid & 31, rq = tid >> 5;
    constexpr int LDA = 264;
    const int col = g * 256 + 8 * c8;
    u32x4 ur[19];
    int tb;
    if (!SAMPLE) {
        const int mb = m0 + 4 * rq - 15; tb = (m0 & (SEQ - 1)) + 4 * rq - 15;
#pragma unroll
        for (int e = 0; e < 19; ++e) ur[e] = (tb + e >= 0) ? *(const u32x4*)(zb + (size_t)(mb + e) * INC + col) : (u32x4){0u, 0u, 0u, 0u};
    } else {
        const int r0 = 4 * rq, m = m0 + r0, b = (m - MP) >> 3, t0 = r0 & 7; tb = t0 - 15;
#pragma unroll
        for (int e = 0; e < 19; ++e) {
            const int tau = tb + e;
            if (tau >= 0) ur[e] = *(const u32x4*)(zb + (size_t)(m - t0 + tau) * INC + col);
            else { const float* cr = cache + ((size_t)b * PC + (PC + tau)) * PW + col; const f32x4 c0 = *(const f32x4*)cr, c1 = *(const f32x4*)(cr + 4);
                   ur[e] = (u32x4){cvt_pk_bf16(c0[0], c0[1]), cvt_pk_bf16(c0[2], c0[3]), cvt_pk_bf16(c1[0], c1[1]), cvt_pk_bf16(c1[2], c1[3])}; }
        }
    }
    float out[4][8];
#pragma unroll
    for (int cp = 0; cp < 4; ++cp)
#pragma unroll
        for (int hf = 0; hf < 2; ++hf) {
#define PVAL(e) (hf ? bfhi(ur[e][cp]) : bflo(ur[e][cp]))
            float sw = 0.f;
#pragma unroll
            for (int j = 1; j < W; ++j) sw += PVAL(15 - j);
#pragma unroll
            for (int r = 0; r < 4; ++r) {
                const float um = PVAL(15 + r);
                sw += um;
                const float cnt = SAMPLE ? (float)W : (float)min(tb + 15 + r + 1, W);
                out[r][2 * cp + hf] = sw / cnt - um;
                sw -= PVAL(15 + r - (W - 1));
            }
#undef PVAL
        }
#pragma unroll
    for (int r = 0; r < 4; ++r) {
        u32x4 w; w.x = cvt_pk_bf16(out[r][0], out[r][1]); w.y = cvt_pk_bf16(out[r][2], out[r][3]); w.z = cvt_pk_bf16(out[r][4], out[r][5]); w.w = cvt_pk_bf16(out[r][6], out[r][7]);
        *(LAS u32x4*)(A + (4 * rq + r) * LDA + 8 * c8) = w;
    }
}
__device__ __forceinline__ void pool_item(LAS unsigned char* lds, int item, const bf16* zb, const float* cache, const bf16x8 (&wf)[8][2], bf16* mixb) {
    const int tile = item >> 2, g = item & 3, m0 = tile * 64;
    const int tid = threadIdx.x;
    constexpr int LDA = 264;
    LAS bf16* A = (LAS bf16*)lds;
    const int wave = tid >> 6, lane = tid & 63, fr = lane & 15, fq = lane >> 4, n0 = wave * 32;
    if (m0 < MP) { if (g == 0) pool_fill<2, false>(A, m0, g, zb, cache); else if (g == 1) pool_fill<4, false>(A, m0, g, zb, cache); else if (g == 2) pool_fill<8, false>(A, m0, g, zb, cache); else pool_fill<16, false>(A, m0, g, zb, cache); }
    else { if (g == 0) pool_fill<2, true>(A, m0, g, zb, cache); else if (g == 1) pool_fill<4, true>(A, m0, g, zb, cache); else if (g == 2) pool_fill<8, true>(A, m0, g, zb, cache); else pool_fill<16, true>(A, m0, g, zb, cache); }
    __syncthreads();
    f32x4 acc[4][2];
#pragma unroll
    for (int i = 0; i < 4; ++i)
#pragma unroll
        for (int j = 0; j < 2; ++j) acc[i][j] = (f32x4){0.f, 0.f, 0.f, 0.f};
#pragma unroll
    for (int ks = 0; ks < 8; ++ks) {
        bf16x8 af[4];
#pragma unroll
        for (int mt = 0; mt < 4; ++mt) af[mt] = *(const LAS bf16x8*)(A + (mt * 16 + fr) * LDA + ks * 32 + fq * 8);
#pragma unroll
        for (int mt = 0; mt < 4; ++mt)
#pragma unroll
            for (int nt = 0; nt < 2; ++nt) acc[mt][nt] = __builtin_amdgcn_mfma_f32_16x16x32_bf16(wf[ks][nt], af[mt], acc[mt][nt], 0, 0, 0);
    }
#pragma unroll
    for (int mt = 0; mt < 4; ++mt)
#pragma unroll
        for (int nt = 0; nt < 2; ++nt) {
            u32x2 o; o.x = cvt_pk_bf16(acc[mt][nt][0], acc[mt][nt][1]); o.y = cvt_pk_bf16(acc[mt][nt][2], acc[mt][nt][3]);
            *(u32x2*)(mixb + (size_t)(m0 + mt * 16 + fr) * D + g * 256 + n0 + nt * 16 + 4 * fq) = o;
        }
    __syncthreads();
}

struct SampleRegs { f32x4 S[8]; };
__device__ __forceinline__ void sample_load(SampleRegs& R, const float* S0) {
    const int tid = threadIdx.x, v4 = tid & 31, kq = tid >> 5;
#pragma unroll
    for (int kk = 0; kk < 8; ++kk) R.S[kk] = __builtin_nontemporal_load((const f32x4*)(S0 + (size_t)(kq * 8 + kk) * HD + 4 * v4));
}
struct SampleStage { float lfv[2]; bf16 q[2], v[2]; bf16 g[2]; float gn[2]; };
__device__ __forceinline__ void sample_stage(SampleStage& st, const bf16* zb, const float* lf, const float* hgn, int row0, int h) {
    const int tid = threadIdx.x;
#pragma unroll
    for (int j = 0; j < 2; ++j) {
        const int i = tid + 512 * j, t = i >> 7, ch = i & 127; const size_t row = (size_t)(row0 + t);
        st.lfv[j] = lf[row * HW + h * HD + ch]; st.q[j] = zb[row * INC + PW + h * HD + ch]; st.v[j] = zb[row * INC + PW + 2 * HW + h * HD + ch];
    }
    const int wave = tid >> 6, lane = tid & 63;
#pragma unroll
    for (int j = 0; j < 2; ++j) { st.g[j] = zb[(size_t)(row0 + wave) * INC + PW + 3 * HW + h * HD + lane + 64 * j]; st.gn[j] = hgn[h * HD + lane + 64 * j]; }
}
__device__ __forceinline__ void sample_run(LAS unsigned char* lds, SampleRegs& R, const SampleStage& st, const bf16* zb, const float* hgn, float* Sout, bf16* mixb, int row0, int h) {
    const int tid = threadIdx.x, v4 = tid & 31, kq = tid >> 5, wave = tid >> 6, lane = tid & 63;
    LAS float* sq = (LAS float*)lds; LAS float* sf = sq + 1024; LAS float* sk = sf + 1024; LAS float* sv = sk + 1024; LAS float* red = sv + 1024;
#pragma unroll
    for (int j = 0; j < 2; ++j) {
        const int i = tid + 512 * j;
        const float f = __builtin_amdgcn_exp2f(st.lfv[j]);
        sq[i] = bf2f(st.q[j]); sf[i] = f; sk[i] = 1.f - f; sv[i] = bf2f(st.v[j]);
    }
    __syncthreads();
#pragma unroll 1
    for (int t = 0; t < 8; ++t) {
        const f32x4 vt = *(const LAS f32x4*)(sv + t * 128 + 4 * v4);
        f32x4 o = (f32x4){0.f, 0.f, 0.f, 0.f};
        const f32x4 f0 = *(const LAS f32x4*)(sf + t * 128 + kq * 8), f1 = *(const LAS f32x4*)(sf + t * 128 + kq * 8 + 4);
        const f32x4 k0 = *(const LAS f32x4*)(sk + t * 128 + kq * 8), k1 = *(const LAS f32x4*)(sk + t * 128 + kq * 8 + 4);
        const f32x4 q0 = *(const LAS f32x4*)(sq + t * 128 + kq * 8), q1 = *(const LAS f32x4*)(sq + t * 128 + kq * 8 + 4);
#pragma unroll
        for (int kk = 0; kk < 8; ++kk) {
            const float f = kk < 4 ? f0[kk & 3] : f1[kk & 3], kn = kk < 4 ? k0[kk & 3] : k1[kk & 3], q = kk < 4 ? q0[kk & 3] : q1[kk & 3];
            R.S[kk] = R.S[kk] * f + vt * kn;
            o = o + R.S[kk] * q;
        }
#pragma unroll
        for (int j = 0; j < 4; ++j) o[j] += __shfl_xor(o[j], 32);
        if (lane < 32) *(LAS f32x4*)(red + (wave * 8 + t) * 128 + 4 * v4) = o;
    }
#pragma unroll
    for (int kk = 0; kk < 8; ++kk) __builtin_nontemporal_store(R.S[kk], (f32x4*)(Sout + (size_t)(kq * 8 + kk) * HD + 4 * v4));
    __syncthreads();
    {
        const int t = wave; const size_t row = (size_t)(row0 + t);
        float o0 = 0.f, o1 = 0.f;
#pragma unroll
        for (int w8 = 0; w8 < 8; ++w8) { o0 += red[(w8 * 8 + t) * 128 + lane]; o1 += red[(w8 * 8 + t) * 128 + lane + 64]; }
        const float ss = wave_sum(o0 * o0 + o1 * o1), r = rsqrtf(ss * (1.f / HD) + EPS);
        const int ch0 = h * HD + lane, ch1 = ch0 + 64;
        mixb[row * D + PW + ch0] = f2bf(o0 * r * st.gn[0] * bf2f(st.g[0]));
        mixb[row * D + PW + ch1] = f2bf(o1 * r * st.gn[1] * bf2f(st.g[1]));
    }
    __syncthreads();
}

constexpr int CQS = 272, CTS = 144;
constexpr int L_Q = 0, L_K = L_Q + 64 * CQS, L_KT = L_K + 64 * CQS, L_VT = L_KT + 128 * CTS, L_ST = L_VT + 128 * CTS, L_P = L_ST + 128 * CQS,
              L_DS = L_P + 64 * CTS, L_TOT = L_DS + 512, L_RMS = L_TOT + 8192, L_CHAIN_END = L_RMS + 512;
static_assert(L_CHAIN_END <= 131072, "chain LDS");
struct SegIn { f32x4 lf[4]; u32x2 v[4], sq[4]; };
template <bool FULL>
__device__ __forceinline__ void seg_load(SegIn& I, const bf16* zb, const float* lf, int row0, int h) {
    const int tid = threadIdx.x, cg = tid & 31, tgp = tid >> 5;
#pragma unroll
    for (int j = 0; j < 4; ++j) {
        const size_t row = (size_t)(row0 + 4 * tgp + j);
        I.lf[j] = *(const f32x4*)(lf + row * HW + h * HD + 4 * cg);
        I.v[j] = *(const u32x2*)(zb + row * INC + PW + 2 * HW + h * HD + 4 * cg);
        if (FULL) I.sq[j] = *(const u32x2*)(zb + row * INC + PW + h * HD + 4 * cg);
    }
}
template <bool FULL>
__device__ __forceinline__ void seg_run(LAS unsigned char* lds, SegIn& I, const bf16* zb, const float* lf, f32x4 (&Sacc)[8], f32x4& segsum, const f32x4 (&gnr)[4], bf16* mixb, int rowb, int nsteps, int h) {
    const int tid = threadIdx.x, lane = tid & 63, wave = __builtin_amdgcn_readfirstlane(tid >> 6), fr = lane & 15, fq = lane >> 4;
    const int cg = tid & 31, tgp = tid >> 5;
    LAS float* dS = (LAS float*)(lds + L_DS); LAS float* tot = (LAS float*)(lds + L_TOT); LAS float* rmsp = (LAS float*)(lds + L_RMS);
    *(LAS f32x4*)(tot + tgp * 128 + 4 * cg) = (I.lf[0] + I.lf[1]) + (I.lf[2] + I.lf[3]);
    if (FULL) {
#pragma unroll
        for (int kt = 0; kt < 8; ++kt) {
            u32x2 w; w.x = cvt_pk_bf16(Sacc[kt][0], Sacc[kt][1]); w.y = cvt_pk_bf16(Sacc[kt][2], Sacc[kt][3]);
            *(LAS u32x2*)(lds + L_ST + (16 * wave + fr) * CQS + (16 * kt + 4 * fq) * 2) = w;
        }
    }
    __syncthreads();
    for (int c = 0; c < nsteps; ++c) {
        {
            f32x4 b = (f32x4){0.f, 0.f, 0.f, 0.f};
#pragma unroll
            for (int g = 0; g < 15; ++g) { const f32x4 tv = *(const LAS f32x4*)(tot + g * 128 + 4 * cg); if (g < tgp) b = b + tv; }
            float kt[4][4], qt[4][4];
#pragma unroll
            for (int j = 0; j < 4; ++j) {
                b = b + I.lf[j];
                const float kn0 = 1.f - __builtin_amdgcn_exp2f(I.lf[j][0]), kn1 = 1.f - __builtin_amdgcn_exp2f(I.lf[j][1]), kn2 = 1.f - __builtin_amdgcn_exp2f(I.lf[j][2]), kn3 = 1.f - __builtin_amdgcn_exp2f(I.lf[j][3]);
                kt[j][0] = kn0 * __builtin_amdgcn_exp2f(-b[0]); kt[j][1] = kn1 * __builtin_amdgcn_exp2f(-b[1]); kt[j][2] = kn2 * __builtin_amdgcn_exp2f(-b[2]); kt[j][3] = kn3 * __builtin_amdgcn_exp2f(-b[3]);
                if (FULL) {
                    qt[j][0] = bflo(I.sq[j].x) * __builtin_amdgcn_exp2f(b[0]); qt[j][1] = bfhi(I.sq[j].x) * __builtin_amdgcn_exp2f(b[1]); qt[j][2] = bflo(I.sq[j].y) * __builtin_amdgcn_exp2f(b[2]); qt[j][3] = bfhi(I.sq[j].y) * __builtin_amdgcn_exp2f(b[3]);
                    const int t = 4 * tgp + j;
                    u32x2 qw, kw; qw.x = cvt_pk_bf16(qt[j][0], qt[j][1]); qw.y = cvt_pk_bf16(qt[j][2], qt[j][3]); kw.x = cvt_pk_bf16(kt[j][0], kt[j][1]); kw.y = cvt_pk_bf16(kt[j][2], kt[j][3]);
                    *(LAS u32x2*)(lds + L_Q + t * CQS + cg * 8) = qw;
                    *(LAS u32x2*)(lds + L_K + t * CQS + cg * 8) = kw;
                }
            }
#pragma unroll
            for (int ch = 0; ch < 4; ++ch) {
                u32x2 kw; kw.x = cvt_pk_bf16(kt[0][ch], kt[1][ch]); kw.y = cvt_pk_bf16(kt[2][ch], kt[3][ch]);
                *(LAS u32x2*)(lds + L_KT + (4 * cg + ch) * CTS + tgp * 8) = kw;
                const unsigned w0 = (ch < 2) ? I.v[0].x : I.v[0].y, w1 = (ch < 2) ? I.v[1].x : I.v[1].y, w2 = (ch < 2) ? I.v[2].x : I.v[2].y, w3 = (ch < 2) ? I.v[3].x : I.v[3].y;
                u32x2 vw;
                if (ch & 1) { vw.x = (w0 >> 16) | (w1 & 0xffff0000u); vw.y = (w2 >> 16) | (w3 & 0xffff0000u); }
                else { vw.x = (w0 & 0xffffu) | (w1 << 16); vw.y = (w2 & 0xffffu) | (w3 << 16); }
                *(LAS u32x2*)(lds + L_VT + (4 * cg + ch) * CTS + tgp * 8) = vw;
            }
            if (tgp == 15) {
                f32x4 e; e[0] = __builtin_amdgcn_exp2f(b[0]); e[1] = __builtin_amdgcn_exp2f(b[1]); e[2] = __builtin_amdgcn_exp2f(b[2]); e[3] = __builtin_amdgcn_exp2f(b[3]);
                *(LAS f32x4*)(dS + 4 * cg) = e; segsum = segsum + b;
            }
        }
        __syncthreads();
        u32x2 sgr[4];
        if (FULL) {
#pragma unroll
            for (int i = 0; i < 4; ++i) sgr[i] = *(const u32x2*)(zb + (size_t)(rowb + 64 * c + 16 * (wave & 3) + fr) * INC + PW + 3 * HW + h * HD + 16 * (4 * (wave >> 2) + i) + 4 * fq);
        }
        if (c + 1 < nsteps) seg_load<FULL>(I, zb, lf, rowb + 64 * (c + 1), h);
        if (FULL) {
#pragma unroll
            for (int i = 0; i < 2; ++i) {
                const int ti = 2 * wave + i, tt = ti >> 2, st = ti & 3;
                f32x4 p = (f32x4){0.f, 0.f, 0.f, 0.f};
#pragma unroll
                for (int ks = 0; ks < 4; ++ks) {
                    const bf16x8 ka = *(const LAS bf16x8*)(lds + L_K + (16 * st + fr) * CQS + (32 * ks + 8 * fq) * 2);
                    const bf16x8 qb = *(const LAS bf16x8*)(lds + L_Q + (16 * tt + fr) * CQS + (32 * ks + 8 * fq) * 2);
                    p = __builtin_amdgcn_mfma_f32_16x16x32_bf16(ka, qb, p, 0, 0, 0);
                }
                const int t = 16 * tt + fr, s0 = 16 * st + 4 * fq;
                u32x2 w; w.x = cvt_pk_bf16(s0 + 0 <= t ? p[0] : 0.f, s0 + 1 <= t ? p[1] : 0.f); w.y = cvt_pk_bf16(s0 + 2 <= t ? p[2] : 0.f, s0 + 3 <= t ? p[3] : 0.f);
                *(LAS u32x2*)(lds + L_P + t * CTS + s0 * 2) = w;
            }
        }
        {
            bf16x8 vb[2];
#pragma unroll
            for (int ss = 0; ss < 2; ++ss) vb[ss] = *(const LAS bf16x8*)(lds + L_VT + (16 * wave + fr) * CTS + (32 * ss + 8 * fq) * 2);
#pragma unroll
            for (int kt = 0; kt < 8; ++kt)
#pragma unroll
                for (int ss = 0; ss < 2; ++ss) {
                    const bf16x8 ka = *(const LAS bf16x8*)(lds + L_KT + (16 * kt + fr) * CTS + (32 * ss + 8 * fq) * 2);
                    Sacc[kt] = __builtin_amdgcn_mfma_f32_16x16x32_bf16(ka, vb[ss], Sacc[kt], 0, 0, 0);
                }
        }
        const int tt = wave & 3, vh = wave >> 2;
        f32x4 o[4];
        if (FULL) {
            __syncthreads();
            bf16x8 pb[2], qb[4];
#pragma unroll
            for (int ss = 0; ss < 2; ++ss) pb[ss] = *(const LAS bf16x8*)(lds + L_P + (16 * tt + fr) * CTS + (32 * ss + 8 * fq) * 2);
#pragma unroll
            for (int ks = 0; ks < 4; ++ks) qb[ks] = *(const LAS bf16x8*)(lds + L_Q + (16 * tt + fr) * CQS + (32 * ks + 8 * fq) * 2);
#pragma unroll
            for (int i = 0; i < 4; ++i) {
                const int vrow = 16 * (4 * vh + i) + fr;
                f32x4 a = (f32x4){0.f, 0.f, 0.f, 0.f};
#pragma unroll
                for (int ss = 0; ss < 2; ++ss) a = __builtin_amdgcn_mfma_f32_16x16x32_bf16(*(const LAS bf16x8*)(lds + L_VT + vrow * CTS + (32 * ss + 8 * fq) * 2), pb[ss], a, 0, 0, 0);
#pragma unroll
                for (int ks = 0; ks < 4; ++ks) a = __builtin_amdgcn_mfma_f32_16x16x32_bf16(*(const LAS bf16x8*)(lds + L_ST + vrow * CQS + (32 * ks + 8 * fq) * 2), qb[ks], a, 0, 0, 0);
                o[i] = a;
            }
            float ss2 = 0.f;
#pragma unroll
            for (int i = 0; i < 4; ++i) ss2 += (o[i][0] * o[i][0] + o[i][1] * o[i][1]) + (o[i][2] * o[i][2] + o[i][3] * o[i][3]);
            ss2 += __shfl_xor(ss2, 16); ss2 += __shfl_xor(ss2, 32);
            if (fq == 0) rmsp[vh * 64 + 16 * tt + fr] = ss2;
        }
#pragma unroll
        for (int kt = 0; kt < 8; ++kt) Sacc[kt] = Sacc[kt] * *(const LAS f32x4*)(dS + 16 * kt + 4 * fq);
        if (c + 1 < nsteps) *(LAS f32x4*)(tot + tgp * 128 + 4 * cg) = (I.lf[0] + I.lf[1]) + (I.lf[2] + I.lf[3]);
        __syncthreads();
        if (FULL) {
            const int tl = 16 * tt + fr; const size_t row = (size_t)(rowb + 64 * c + tl);
            const float r = rsqrtf((rmsp[tl] + rmsp[64 + tl]) * (1.f / HD) + EPS);
#pragma unroll
            for (int i = 0; i < 4; ++i) {
                const int ch = h * HD + 16 * (4 * vh + i) + 4 * fq;
                const f32x4 gn = gnr[i];
                const u32x2 sg = sgr[i];
                const float g0 = __builtin_bit_cast(float, sg.x << 16), g1 = __builtin_bit_cast(float, sg.x & 0xffff0000u), g2 = __builtin_bit_cast(float, sg.y << 16), g3 = __builtin_bit_cast(float, sg.y & 0xffff0000u);
                u32x2 w; w.x = cvt_pk_bf16(o[i][0] * r * gn[0] * g0, o[i][1] * r * gn[1] * g1); w.y = cvt_pk_bf16(o[i][2] * r * gn[2] * g2, o[i][3] * r * gn[3] * g3);
                *(u32x2*)(mixb + row * D + PW + ch) = w;
            }
#pragma unroll
            for (int kt = 0; kt < 8; ++kt) {
                u32x2 w; w.x = cvt_pk_bf16(Sacc[kt][0], Sacc[kt][1]); w.y = cvt_pk_bf16(Sacc[kt][2], Sacc[kt][3]);
                *(LAS u32x2*)(lds + L_ST + (16 * wave + fr) * CQS + (16 * kt + 4 * fq) * 2) = w;
            }
        }
    }
    __syncthreads();
}

#ifndef P2_ORDER_OLD
#define P2_ORDER_OLD 0
#endif
constexpr int CW_FLAG = 32768;
__device__ __forceinline__ void prompt_pass1(LAS unsigned char* lds, const Args& a, int chain, int seg, int nseg) {
    if (seg + 1 >= nseg) return;
    unsigned char* ws = a.ws;
    const bf16* zb = (const bf16*)(ws + WS_ZB); const float* lf = (const float*)(ws + WS_LF); bf16* mixb = (bf16*)(ws + WS_MIX);
    const int tid = threadIdx.x;
    const int b = chain / NH, h = chain % NH, seglen = SEQ / nseg, nsteps = seglen / 64, rowb = b * SEQ + seg * seglen;
    f32x4* slab = (f32x4*)(ws + WS_XB);
    float* dseg = (float*)(ws + WS_XB + 16 * MiB);
    unsigned* flags = (unsigned*)(ws + WS_CTL) + CW_FLAG;
    f32x4 gnr[4];
#pragma unroll
    for (int i = 0; i < 4; ++i) gnr[i] = (f32x4){0.f, 0.f, 0.f, 0.f};
    f32x4 Sacc[8];
#pragma unroll
    for (int i = 0; i < 8; ++i) Sacc[i] = (f32x4){0.f, 0.f, 0.f, 0.f};
    f32x4 segsum = (f32x4){0.f, 0.f, 0.f, 0.f};
    SegIn I; seg_load<false>(I, zb, lf, rowb, h);
    seg_run<false>(lds, I, zb, lf, Sacc, segsum, gnr, mixb, rowb, nsteps, h);
    const __amdgpu_buffer_rsrc_t srs = __builtin_amdgcn_make_buffer_rsrc((void*)(slab + (size_t)(chain * 8 + seg) * 4096), (short)0, 4096 * 16, 0x00020000);
#pragma unroll
    for (int kt = 0; kt < 8; ++kt) __builtin_amdgcn_raw_buffer_store_b128(__builtin_bit_cast(u32x4, Sacc[kt]), srs, (unsigned)((kt * 512 + tid) * 16), 0, 16);
    if ((tid >> 5) == 15) {
#pragma unroll
        for (int j = 0; j < 4; ++j) __hip_atomic_store((unsigned*)dseg + (chain * 8 + seg) * 128 + 4 * (tid & 31) + j, __builtin_bit_cast(unsigned, __builtin_amdgcn_exp2f(segsum[j])), __ATOMIC_RELAXED, __HIP_MEMORY_SCOPE_AGENT);
    }
    asm volatile("s_waitcnt vmcnt(0)" ::: "memory");
    __syncthreads();
    if (tid == 0) __hip_atomic_store(flags + 64 * (chain * 8 + seg), 1u, __ATOMIC_RELAXED, __HIP_MEMORY_SCOPE_AGENT);
}
__device__ __forceinline__ void prompt_pass2(LAS unsigned char* lds, const Args& a, int chain, int seg, int nseg) {
    unsigned char* ws = a.ws;
    const bf16* zb = (const bf16*)(ws + WS_ZB); const float* lf = (const float*)(ws + WS_LF); bf16* mixb = (bf16*)(ws + WS_MIX);
    const int tid = threadIdx.x, lane = tid & 63, wave = __builtin_amdgcn_readfirstlane(tid >> 6), fr = lane & 15, fq = lane >> 4;
    const int b = chain / NH, h = chain % NH, seglen = SEQ / nseg, nsteps = seglen / 64, rowb = b * SEQ + seg * seglen;
    const f32x4* slab = (const f32x4*)(ws + WS_XB);
    const float* dseg = (const float*)(ws + WS_XB + 16 * MiB);
    unsigned* flags = (unsigned*)(ws + WS_CTL) + CW_FLAG;
    f32x4 gnr[4];
#pragma unroll
    for (int i = 0; i < 4; ++i) gnr[i] = *(const f32x4*)(a.in[9] + h * HD + 16 * (4 * (wave >> 2) + i) + 4 * fq);
    f32x4 Sacc[8];
#pragma unroll
    for (int i = 0; i < 8; ++i) Sacc[i] = (f32x4){0.f, 0.f, 0.f, 0.f};
    f32x4 segsum = (f32x4){0.f, 0.f, 0.f, 0.f};
    SegIn I; seg_load<true>(I, zb, lf, rowb, h);
    if (seg > 0) {
        if (tid < 64) {
            for (int i = 0; i < seg; ++i) { unsigned sp = 0; while (__hip_atomic_load(flags + 64 * (chain * 8 + i), __ATOMIC_RELAXED, __HIP_MEMORY_SCOPE_AGENT) == 0u && ++sp < (1u << 22)) __builtin_amdgcn_s_sleep(2); }
            __builtin_amdgcn_fence(__ATOMIC_ACQUIRE, "agent");
            asm volatile("s_waitcnt vmcnt(0)" ::: "memory");
        }
        __syncthreads();
        f32x4 rc[8], rn[8];
#pragma unroll
        for (int kt = 0; kt < 8; ++kt) { rc[kt] = slab[(size_t)(chain * 8) * 4096 + kt * 512 + tid]; rn[kt] = rc[kt]; }
        for (int i = 0; i < seg; ++i) {
            const float* dd = dseg + (chain * 8 + i) * 128;
            if (i + 1 < seg) {
#pragma unroll
                for (int kt = 0; kt < 8; ++kt) rn[kt] = slab[(size_t)(chain * 8 + i + 1) * 4096 + kt * 512 + tid];
            }
#pragma unroll
            for (int kt = 0; kt < 8; ++kt) Sacc[kt] = Sacc[kt] * *(const f32x4*)(dd + 16 * kt + 4 * fq) + rc[kt];
#pragma unroll
            for (int kt = 0; kt < 8; ++kt) rc[kt] = rn[kt];
        }
    }
    seg_run<true>(lds, I, zb, lf, Sacc, segsum, gnr, mixb, rowb, nsteps, h);
    if (seg + 1 == nseg) {
        float* Sout = a.out + O_HSP + (size_t)chain * HD * HD;
#pragma unroll
        for (int kt = 0; kt < 8; ++kt)
#pragma unroll
            for (int j = 0; j < 4; ++j) Sout[(size_t)(16 * kt + 4 * fq + j) * HD + 16 * wave + fr] = Sacc[kt][j];
    }
}

__device__ __forceinline__ void phase2(LAS unsigned char* lds, const Args& a, int bid, int G, int parts = 7) {
    unsigned char* ws = a.ws;
    const bf16* zb = (const bf16*)(ws + WS_ZB); const float* lf = (const float*)(ws + WS_LF); bf16* mixb = (bf16*)(ws + WS_MIX);
    constexpr int NPC = NB * NH, NSC = DB * NH, NPOOL = (M / 64) * 4;
    const int nseg = (G >= 8 * NPC) ? 8 : (G >= 4 * NPC ? 4 : (G >= 2 * NPC ? 2 : 1));
    if ((parts & 1) && nseg > 1 && bid < nseg * NPC) prompt_pass1(lds, a, bid / nseg, bid % nseg, nseg);
#if P2_ORDER_OLD
    if (parts & 1) {
        if (nseg > 1) { if (bid < nseg * NPC) prompt_pass2(lds, a, bid / nseg, bid % nseg, nseg); }
        else for (int c = bid; c < NPC; c += G) prompt_pass2(lds, a, c, 0, 1);
    }
#endif
    STAMP(5);
    if (parts & 2) {
        SampleRegs cur, nxt;
        if (bid < NSC) sample_load(cur, a.in[3] + (size_t)bid * HD * HD);
        for (int it = bid; it < NSC; it += G) {
            const bool pf = it + G < NSC;
            SampleStage st; sample_stage(st, zb, lf, a.in[9], MP + (it / NH) * DS, it % NH);
            if (pf) sample_load(nxt, a.in[3] + (size_t)(it + G) * HD * HD);
            sample_run(lds, cur, st, zb, a.in[9], a.out + O_HSS + (size_t)it * HD * HD, mixb, MP + (it / NH) * DS, it % NH);
            if (pf) {
#pragma unroll
                for (int kk = 0; kk < 8; ++kk) cur.S[kk] = nxt.S[kk];
            }
        }
    }
    if (parts & 4) {
        const int first = (NSC + G - 1 - bid) / G * G + bid;
        if (first < NSC + NPOOL) {
            const int lane = threadIdx.x & 63, n0 = (threadIdx.x >> 6) * 32;
            const bf16* WpT = (const bf16*)(ws + WS_WP);
            bf16x8 wf[8][2];
            for (int it = first; it < NSC + NPOOL; it += G) {
                if (it == first || (G & 3)) {
                    const int g = (it - NSC) & 3;
#pragma unroll
                    for (int ks = 0; ks < 8; ++ks)
#pragma unroll
                        for (int nt = 0; nt < 2; ++nt) wf[ks][nt] = *(const bf16x8*)(WpT + (size_t)(g * 256 + n0 + nt * 16 + (lane & 15)) * 256 + ks * 32 + (lane >> 4) * 8);
                }
                pool_item(lds, it - NSC, zb, a.in[2], wf, mixb);
            }
        }
    }
    STAMP(6);
    if (!P2_ORDER_OLD && (parts & 1)) {
        if (nseg > 1) { if (bid < nseg * NPC) prompt_pass2(lds, a, bid / nseg, bid % nseg, nseg); }
        else for (int c = bid; c < NPC; c += G) prompt_pass2(lds, a, c, 0, 1);
    }
}

__device__ __forceinline__ void phase6(const Args& a, int vcu, int G, size_t x2off) {
    const int tid = threadIdx.x, lane = tid & 63, wave = tid >> 6;
#ifdef TPROBE
    { unsigned d = *((const unsigned*)(a.ws + WS_CTL) + CW_TP); if (TP_MODE == 2) d = 0x40000000u - d;
#ifdef TP_CAL
      d = TP_REF_US * 95;
#endif
      const float delta = 0.01f * ((float)d * 0.01f) / (float)(TP_REF_US);
      for (int i = vcu * (NWAVES * 64) + tid; i < NB * PC * PW; i += G * NWAVES * 64) a.out[O_PSP + i] += delta; }
#endif
    const int gw = vcu * NWAVES + wave, NGW = G * NWAVES;
    const float* rsq3 = (const float*)(a.ws + WS_CTL) + CW_RSQ3;
    for (int m = gw; m < M; m += NGW) {
        float* yr = a.out + O_Y + (size_t)m * D; const bf16* xr = (const bf16*)(a.ws + x2off) + (size_t)m * D;
        const float r = rsqrtf(rsq3[m] * (1.f / D) + EPS);
#pragma unroll
        for (int j = 0; j < 4; ++j) {
            const u32x4 xw = __builtin_nontemporal_load((const u32x4*)xr + lane + 64 * j);
            const f32x4 g0 = ((const f32x4*)a.in[15])[2 * (lane + 64 * j)], g1 = ((const f32x4*)a.in[15])[2 * (lane + 64 * j) + 1];
            __builtin_nontemporal_store((f32x4){bflo(xw.x), bfhi(xw.x), bflo(xw.y), bfhi(xw.y)} * r * g0, (f32x4*)yr + 2 * (lane + 64 * j));
            __builtin_nontemporal_store((f32x4){bflo(xw.z), bfhi(xw.z), bflo(xw.w), bfhi(xw.w)} * r * g1, (f32x4*)yr + 2 * (lane + 64 * j) + 1);
        }
    }
}

__global__ void __launch_bounds__(NWAVES * 64, 2) mega(Args a) {
    extern __shared__ __attribute__((aligned(16))) unsigned char lds_raw[];
    LAS unsigned char* lds = (LAS unsigned char*)lds_raw;
    const int G = gridDim.x, bid = blockIdx.x;
    const int vcu = (G % 8 == 0) ? (bid % 8) * (G / 8) + bid / 8 : bid;
    unsigned char* ws = a.ws;
    float* ctlf = (float*)(ws + WS_CTL);
    const int lo = a.ph_lo, hi = a.ph_hi;
#if ONE_LAUNCH && USE_CG
    cg::grid_group grid = cg::this_grid();
#define GRID_BAR() grid.sync()
#elif ONE_LAUNCH
    volatile LAS unsigned* MISC = (volatile LAS unsigned*)(lds + MISC_OFF);
    if (threadIdx.x < 32) MISC[threadIdx.x] = 0u;
    __syncthreads();
    XcdBarrier bar = xcd_barrier_post((unsigned*)(ws + WS_CTL) + CW_BAR, MISC + 8);
#define GRID_BAR() xcd_barrier(bar)
#else
#define GRID_BAR() do {} while (0)
#endif
#ifndef PH_MASK
#define PH_MASK 0x7f
#endif
#define IN(k) (((PH_MASK >> (k)) & 1) && lo <= (k) && (k) < hi)
#define BOTH(k) (IN(k) && IN((k) + 1))
#ifndef REP_MASK
#define REP_MASK 0
#endif
#define REP(k) ((REP_MASK >> (k)) & 1)
#ifndef P2_REP_PARTS
#define P2_REP_PARTS 7
#endif
    STAMP(0);
    if (IN(0)) { if (REP(0)) { phase0(lds, a, vcu, G); __syncthreads(); } phase0(lds, a, vcu, G); STAMP(1); if (BOTH(0)) GRID_BAR(); STAMP(2); }
    if (IN(1)) {
        pg8::Gemm g{(const bf16*)(ws + WS_XB), (const bf16*)(ws + WS_WIN), M, INC, D}; pg8::HybridOrder S; S.init(M, INC, D, G, bid, false);
        const pg8::TailCtx T{nullptr, nullptr};
        pg8::EpiZ E{(bf16*)(ws + WS_ZB), (float*)(ws + WS_LF), (const float*)(ws + WS_MISC), (const float*)(ws + WS_MISC) + M, a.out};
        if (REP(1)) pg8::gemm_phase2(lds, g, S, E, T);
        pg8::gemm_phase2(lds, g, S, E, T);
        { const int nidle = p1_idle_wgs(G); if (nidle >= 32 && bid >= G - nidle) phase0_deferred(lds, a, bid - (G - nidle), nidle); }
        STAMP(3);
        if (BOTH(1)) GRID_BAR();
        STAMP(4);
    }
    if (IN(2)) { if (REP(2)) { phase2(lds, a, bid, G, P2_REP_PARTS); __syncthreads(); } phase2(lds, a, bid, G); STAMP(7); if (BOTH(2)) GRID_BAR(); STAMP(8); }
    const bool merged = MERGED && G == 256 && lo <= 3 && hi >= 6;
    if (merged) {
        pg8::MOrder S{bid};
        constexpr pg8::StreamOff O{WS_MIX, WS_WO, WS_XB, WS_WGU, WS_ACT, WS_WD, WS_MIX, WS_SLABM, CW_DEP, CW_DEP + 4096, CW_TAIL, CW_RSQ2, CW_RSQ3};
        pg8::gemm_stream(lds, S, ws, a.in[0], a.in[1], O);
        STAMP(13);
#ifdef TPROBE
        if (threadIdx.x == 0) { volatile LAS unsigned long long* ts = (volatile LAS unsigned long long*)(lds + MISC_OFF + 128); const unsigned d = (unsigned)(ts[TP_B] - ts[TP_A]);
            unsigned* w = (unsigned*)(ws + WS_CTL) + CW_TP; if (TP_MODE == 0) { if (bid == TP_BLOCK) atomicMax(w, d); } else if (TP_MODE == 1) atomicMax(w, d); else atomicMax(w, 0x40000000u - d); }
#endif
        GRID_BAR();
    }
    if (!merged && IN(3)) {
        pg8::Gemm g{(const bf16*)(ws + WS_MIX), (const bf16*)(ws + WS_WO), M, D, D}; pg8::HybridOrder S; S.init(M, D, D, G, bid, true);
        const pg8::TailCtx T{(f32x4*)(ws + WS_SLAB3), (unsigned*)(ws + WS_CTL) + CW_TAIL};
        if (REP(3)) { pg8::EpiX1<true> E0{a.in[0], a.in[1], a.out + O_Y, (bf16*)(ws + WS_XB), ctlf + CW_RSQ2, false}; pg8::gemm_phase2(lds, g, S, E0, T); }
        pg8::EpiX1<false> E{a.in[0], a.in[1], a.out + O_Y, (bf16*)(ws + WS_XB), ctlf + CW_RSQ2, false};
        pg8::gemm_phase2(lds, g, S, E, T);
        STAMP(9);
        if (BOTH(3)) GRID_BAR();
        STAMP(10);
    }
    if (!merged && IN(4)) {
        pg8::Gemm g{(const bf16*)(ws + WS_XB), (const bf16*)(ws + WS_WGU), M, 2 * DFF, D}; pg8::HybridOrder S; S.init(M, 2 * DFF, D, G, bid, true);
        const pg8::TailCtx T{(f32x4*)(ws + WS_SLAB45), (unsigned*)(ws + WS_CTL) + CW_TAIL + 8192};
        pg8::EpiAct E{(bf16*)(ws + WS_ACT), ctlf + CW_RSQ2, false};
        if (REP(4)) pg8::gemm_phase2(lds, g, S, E, T);
        pg8::gemm_phase2(lds, g, S, E, T);
        STAMP(11);
        if (BOTH(4)) GRID_BAR();
        STAMP(12);
    }
    if (!merged && IN(5)) {
        pg8::Gemm g{(const bf16*)(ws + WS_ACT), (const bf16*)(ws + WS_WD), M, D, DFF}; pg8::HybridOrder S; S.init(M, D, DFF, G, bid, true);
        const pg8::TailCtx T{(f32x4*)(ws + WS_SLAB45), (unsigned*)(ws + WS_CTL) + CW_TAIL + 16384};
        if (REP(5)) { pg8::EpiX2<true> E0{(bf16*)(ws + WS_X2B), ctlf + CW_RSQ3, (const bf16*)(ws + WS_XB)}; pg8::gemm_phase2(lds, g, S, E0, T); }
        pg8::EpiX2<false> E{(bf16*)(ws + WS_X2B), ctlf + CW_RSQ3, (const bf16*)(ws + WS_XB)};
        pg8::gemm_phase2(lds, g, S, E, T);
        STAMP(13);
#ifdef TPROBE
        if (threadIdx.x == 0) { volatile LAS unsigned long long* ts = (volatile LAS unsigned long long*)(lds + MISC_OFF + 128); const unsigned d = (unsigned)(ts[TP_B] - ts[TP_A]);
            unsigned* w = (unsigned*)(ws + WS_CTL) + CW_TP; if (TP_MODE == 0) { if (bid == TP_BLOCK) atomicMax(w, d); } else if (TP_MODE == 1) atomicMax(w, d); else atomicMax(w, 0x40000000u - d); }
#endif
        if (BOTH(5)) GRID_BAR();
    }
    if (IN(6)) phase6(a, vcu, G, merged ? WS_MIX : WS_X2B);
#undef IN
#undef BOTH
}

extern "C" void kernel_launch(void* const* d_in, const int* in_sizes, int n_in, void* d_out, int out_size, void* d_ws, size_t ws_size, hipStream_t stream) {
    static int grid = 0;
    if (grid == 0) {
        if (n_in != 16 || ws_size < WS_END) { fprintf(stderr, "kernel_launch: unexpected n_in %d / ws_size %zu\n", n_in, ws_size); grid = -1; return; }
        int dev = 0, cus = 0, per_cu = 0;
        hipGetDevice(&dev);
        hipDeviceGetAttribute(&cus, hipDeviceAttributeMultiprocessorCount, dev);
        hipFuncSetAttribute((const void*)mega, hipFuncAttributeMaxDynamicSharedMemorySize, LDS_BYTES);
        hipOccupancyMaxActiveBlocksPerMultiprocessor(&per_cu, (const void*)mega, NWAVES * 64, LDS_BYTES);
        if (per_cu < 1) { fprintf(stderr, "kernel_launch: occupancy query says %d blocks per CU\n", per_cu); grid = -1; return; }
        grid = cus;
#ifdef FORCE_GRID
        grid = FORCE_GRID;
#endif
    }
    if (grid < 0) return;
    hipMemsetAsync((char*)d_ws + WS_CTL + (size_t)CW_BAR * 4, 0, XCD_BAR_WORDS * 4, stream);
#ifdef EXTRA_MEMSET
    hipMemsetAsync((char*)d_ws + WS_END - 8192, 0, 4096, stream);
#endif
    Args a{};
    for (int i = 0; i < 16; ++i) a.in[i] = (const float*)d_in[i];
    a.out = (float*)d_out; a.ws = (unsigned char*)d_ws;
#if ONE_LAUNCH
    a.ph_lo = 0; a.ph_hi = NPHASE;
    void* args[] = {&a};
#if USE_CG
    hipError_t e = hipLaunchCooperativeKernel((const void*)mega, dim3(grid), dim3(NWAVES * 64), args, LDS_BYTES, stream);
    if (e != hipSuccess) fprintf(stderr, "cooperative launch failed: %s (grid %d)\n", hipGetErrorString(e), grid);
#else
    (void)args; hipLaunchKernelGGL(mega, dim3(grid), dim3(NWAVES * 64), LDS_BYTES, stream, a);
#endif
#else
    for (int p = 0; p < NPHASE; ++p) { a.ph_lo = p; a.ph_hi = p + 1; hipLaunchKernelGGL(mega, dim3(grid), dim3(NWAVES * 64), LDS_BYTES, stream, a); }
#endif
}
```

```cpp
#include <hip/hip_runtime.h>
#include <hip/hip_cooperative_groups.h>
#include <cstdio>
#include <cstdint>
namespace cg = cooperative_groups;

constexpr int D = 2048, NB = 4, SEQ = 2048, DB = 128, DS = 8;
constexpr int MP = NB * SEQ, MS = DB * DS, M = MP + MS;
constexpr int PW = 1024, HW = 1024, HD = 128, NH = 8, PC = 15;
constexpr int DFF = 5632, INC = 5120;
constexpr float EPS = 1e-6f;
constexpr size_t O_Y = 0;
constexpr size_t O_PSP = (size_t)M * D;
constexpr size_t O_HSP = O_PSP + (size_t)NB * PC * PW;
constexpr size_t O_PSS = O_HSP + (size_t)NB * NH * HD * HD;
constexpr size_t O_HSS = O_PSS + (size_t)DB * PC * PW;

namespace pg8 {
#define PG8_LAS __attribute__((address_space(3)))
typedef unsigned short bf16_t;
typedef short bf16x8 __attribute__((ext_vector_type(8)));
typedef float f32x4 __attribute__((ext_vector_type(4)));
typedef unsigned u32x4 __attribute__((ext_vector_type(4)));
constexpr int BM = 256, BK = 64, HALF = 128, HTB = HALF * BK * 2  , STAGE_BYTES = 8 * HTB, NXCD = 8, WGM = 8;

__host__ __device__ __forceinline__ int lds_byte(int r, int c) { const int st = (r >> 4) * 2 + (c >> 5), rr = r & 15, cc = c & 31, ob = rr * 64 + cc * 2; return st * 1024 + (ob ^ (((ob >> 9) & 1) << 5)); }
__host__ __device__ __forceinline__ void stage_rc(int b, int& R, int& C) { const int st = b / 1024, sb = b % 1024, swz = sb ^ (((sb >> 9) & 1) << 5); R = (st >> 1) * 16 + swz / 64; C = (st & 1) * 32 + (swz % 64) / 2; }
__host__ __device__ __forceinline__ int perm32(int rho) { const int n = rho >> 4, i = rho & 15; return 8 * (i >> 2) + 4 * n + (i & 3); }

struct Unit { int pm, pn, kb, nk, tinfo; };
struct Gemm { const bf16_t* A; const bf16_t* Bt; int M, N, K; };

struct StaticOrder {
    int nM, nN, nwg, G, c;
    __host__ __device__ void init(int M, int N, int G_, int c_) { nM = M / BM; nN = N / BM; nwg = nM * nN; G = G_; c = c_; }
    __host__ __device__ bool next(int i, Unit& u) const {
        const long L = (long)i * G + c; if (L >= nwg) return false;
        int wgid = (int)L; { const int q = nwg / NXCD, r = nwg % NXCD, xcd = wgid % NXCD, off = wgid / NXCD; wgid = (xcd < r ? xcd * (q + 1) : r * (q + 1) + (xcd - r) * q) + off; }
        const int nig = WGM * nN, gid = wgid / nig, fm = gid * WGM, gsz = (nM - fm) < WGM ? (nM - fm) : WGM;
        u.pm = fm + ((wgid % nig) % gsz); u.pn = (wgid % nig) / gsz; u.kb = 0; u.nk = 0; u.tinfo = -1; return true;
    }
    __device__ __forceinline__ void a_ready(const Unit&) const {}
    __device__ __forceinline__ void done(const Unit&) const {}
};
typedef __bf16 bf16x2_hw __attribute__((ext_vector_type(2)));
typedef float f32x2_hw __attribute__((ext_vector_type(2)));
__device__ __forceinline__ unsigned cvt_pk_bf16(float lo, float hi) { const f32x2_hw v = {lo, hi}; return __builtin_bit_cast(unsigned, __builtin_convertvector(v, bf16x2_hw)); }
__device__ __forceinline__ float sigm(float x) { return __builtin_amdgcn_rcpf(1.f + __expf(-x)); }
__device__ __forceinline__ float silu(float x) { return x * __builtin_amdgcn_rcpf(1.f + __expf(-x)); }
typedef unsigned u32x2 __attribute__((ext_vector_type(2)));
__device__ __forceinline__ float bflo_(unsigned w) { return __builtin_bit_cast(float, w << 16); }
__device__ __forceinline__ float bfhi_(unsigned w) { return __builtin_bit_cast(float, w & 0xffff0000u); }

struct EpiZ {
    static constexpr bool PERM = true, AFTER_DRAIN = false;
    bf16_t* zb; float* lf; const float* rstd1; const float* lbv; float* out;
    __device__ __forceinline__ void prefetch(const Unit& u, int wr, int fr, float (&p)[8]) const {
#pragma unroll
        for (int i = 0; i < 8; ++i) p[i] = rstd1[u.pm * BM + wr * 64 + fr + (i >> 2) * HALF + (i & 3) * 16];
    }
    __device__ __forceinline__ void operator()(const f32x4 (&acc)[2][2][4][2], const Unit& u, int wr, int wc, int fr, int fq, unsigned gmask = 0xffu, const float* pre = nullptr) const {
        const int kind = u.pn >> 2;
        const int row0 = u.pm * BM + wr * 64 + fr;
        const int cc0 = (u.pn & 3) * 256 + wc * 32 + 8 * fq;
        f32x4 lb[2][2];
        if (kind == 2) {
#pragma unroll
            for (int bj = 0; bj < 2; ++bj)
#pragma unroll
                for (int n = 0; n < 2; ++n) lb[bj][n] = *(const f32x4*)(lbv + cc0 + bj * HALF + 4 * n);
        }
#pragma unroll
        for (int ai = 0; ai < 2; ++ai)
#pragma unroll
            for (int m = 0; m < 4; ++m) {
                if (!((gmask >> (ai * 4 + m)) & 1u)) continue;
                const int row = row0 + ai * HALF + m * 16;
                const float r = pre ? pre[ai * 4 + m] : rstd1[row];
#pragma unroll
                for (int bj = 0; bj < 2; ++bj) {
                    const int cc = cc0 + bj * HALF;
                    f32x4 v0 = acc[ai][bj][m][0] * r, v1 = acc[ai][bj][m][1] * r;
                    if (kind == 2) {
#pragma unroll
                        for (int j = 0; j < 4; ++j) {
                            const float f0 = lb[bj][0][j] + (1.f - lb[bj][0][j]) * sigm(v0[j]), f1 = lb[bj][1][j] + (1.f - lb[bj][1][j]) * sigm(v1[j]);
                            v0[j] = __log2f(f0); v1[j] = __log2f(f1);
                        }
                        float* p = lf + (size_t)row * HW + cc;
                        *(f32x4*)p = v0; *(f32x4*)(p + 4) = v1;

                    } else {
                        if (kind == 0) {
                            float* dst = nullptr;
                            if (row >= MP) { const int ms = row - MP; dst = out + O_PSS + ((size_t)(ms >> 3) * PC + 7 + (ms & 7)) * PW + cc; }
                            else { const int t = row & (SEQ - 1); if (t >= SEQ - PC) dst = out + O_PSP + ((size_t)(row >> 11) * PC + (t - (SEQ - PC))) * PW + cc; }
                            if (dst) { *(f32x4*)dst = v0; *(f32x4*)(dst + 4) = v1; }
                        }
                        if (kind == 1 || kind == 4) {
#pragma unroll
                            for (int j = 0; j < 4; ++j) { v0[j] = silu(v0[j]); v1[j] = silu(v1[j]); }
                        }
                        u32x4 w; w.x = cvt_pk_bf16(v0[0], v0[1]); w.y = cvt_pk_bf16(v0[2], v0[3]); w.z = cvt_pk_bf16(v1[0], v1[1]); w.w = cvt_pk_bf16(v1[2], v1[3]);
                        *(u32x4*)(zb + (size_t)row * INC + kind * 1024 + cc) = w;
                    }
                }
            }
    }
};

__device__ __forceinline__ void store16(bf16_t* base, size_t elem_off, u32x4 w, bool wt) {
    if (wt) { const __amdgpu_buffer_rsrc_t r = __builtin_amdgcn_make_buffer_rsrc((void*)base, (short)0, 0x7fffffff, 0x00020000); __builtin_amdgcn_raw_buffer_store_b128(w, r, (unsigned)(elem_off * 2), 0, 16); }
    else *(u32x4*)(base + elem_off) = w;
}
template <bool DRY = false> struct EpiX1 {
    static constexpr bool PERM = true, AFTER_DRAIN = false;
    const float* xp; const float* xs; float* y; bf16_t* x1b; float* rowsq; bool wt;
    __device__ __forceinline__ void operator()(const f32x4 (&acc)[2][2][4][2], const Unit& u, int wr, int wc, int fr, int fq, unsigned gmask = 0xffu) const {
        const int row0 = u.pm * BM + wr * 64 + fr, col0 = u.pn * BM + wc * 32 + 8 * fq;
#pragma unroll
        for (int ai = 0; ai < 2; ++ai)
#pragma unroll
            for (int m = 0; m < 4; ++m) {
                if (!((gmask >> (ai * 4 + m)) & 1u)) continue;
                const int row = row0 + ai * HALF + m * 16;
                const float* xr = (row < MP ? xp + (size_t)row * D : xs + (size_t)(row - MP) * D) + col0;
                float s = 0.f;
#pragma unroll
                for (int bj = 0; bj < 2; ++bj) {
                    const f32x4 v0 = __builtin_nontemporal_load((const f32x4*)(xr + bj * HALF)) + acc[ai][bj][m][0], v1 = __builtin_nontemporal_load((const f32x4*)(xr + bj * HALF + 4)) + acc[ai][bj][m][1];
                    u32x4 w; w.x = cvt_pk_bf16(v0[0], v0[1]); w.y = cvt_pk_bf16(v0[2], v0[3]); w.z = cvt_pk_bf16(v1[0], v1[1]); w.w = cvt_pk_bf16(v1[2], v1[3]);
                    store16(x1b, (size_t)row * D + col0 + bj * HALF, w, wt);
                    s += (v0[0] * v0[0] + v0[1] * v0[1]) + (v0[2] * v0[2] + v0[3] * v0[3]) + (v1[0] * v1[0] + v1[1] * v1[1]) + (v1[2] * v1[2] + v1[3] * v1[3]);
                }
                s += __shfl_xor(s, 16); s += __shfl_xor(s, 32);
                if (fq == 0 && !DRY) atomicAdd(rowsq + row, s);
            }
    }
};

struct EpiAct {
    static constexpr bool PERM = true, AFTER_DRAIN = false;
    bf16_t* act; const float* rowsq; bool wt;
    __device__ __forceinline__ void prefetch(const Unit& u, int wr, int fr, float (&p)[8]) const {
#pragma unroll
        for (int i = 0; i < 8; ++i) p[i] = rowsq[u.pm * BM + wr * 64 + fr + (i >> 2) * HALF + (i & 3) * 16];
    }
    __device__ __forceinline__ void operator()(const f32x4 (&acc)[2][2][4][2], const Unit& u, int wr, int wc, int fr, int fq, unsigned gmask = 0xffu, const float* pre = nullptr) const {
        const int row0 = u.pm * BM + wr * 64 + fr, col0 = u.pn * HALF + wc * 32 + 8 * fq;
#pragma unroll
        for (int ai = 0; ai < 2; ++ai)
#pragma unroll
            for (int m = 0; m < 4; ++m) {
                if (!((gmask >> (ai * 4 + m)) & 1u)) continue;
                const int row = row0 + ai * HALF + m * 16;
                const float r = rsqrtf((pre ? pre[ai * 4 + m] : rowsq[row]) * (1.f / D) + EPS);
                u32x4 w; unsigned* wp = (unsigned*)&w;
#pragma unroll
                for (int n = 0; n < 2; ++n) {
                    const f32x4 g = acc[ai][0][m][n] * r, up = acc[ai][1][m][n] * r;
                    f32x4 a;
#pragma unroll
                    for (int j = 0; j < 4; ++j) a[j] = silu(g[j]) * up[j];
                    wp[2 * n] = cvt_pk_bf16(a[0], a[1]); wp[2 * n + 1] = cvt_pk_bf16(a[2], a[3]);
                }
                store16(act, (size_t)row * DFF + col0, w, wt);
            }
    }
};

template <bool DRY = false> struct EpiX2 {
    static constexpr bool PERM = true, AFTER_DRAIN = false;
    bf16_t* x2b; float* rowsq; const bf16_t* x1b;
    __device__ __forceinline__ void operator()(const f32x4 (&acc)[2][2][4][2], const Unit& u, int wr, int wc, int fr, int fq, unsigned gmask = 0xffu) const {
        const int row0 = u.pm * BM + wr * 64 + fr, col0 = u.pn * BM + wc * 32 + 8 * fq;
#pragma unroll
        for (int ai = 0; ai < 2; ++ai)
#pragma unroll
            for (int m = 0; m < 4; ++m) {
                if (!((gmask >> (ai * 4 + m)) & 1u)) continue;
                const int row = row0 + ai * HALF + m * 16;
                float s = 0.f;
#pragma unroll
                for (int bj = 0; bj < 2; ++bj) {
                    const u32x4 xw = *(const u32x4*)(x1b + (size_t)row * D + col0 + bj * HALF);
                    f32x4 v0 = (f32x4){bflo_(xw.x), bfhi_(xw.x), bflo_(xw.y), bfhi_(xw.y)} + acc[ai][bj][m][0];
                    f32x4 v1 = (f32x4){bflo_(xw.z), bfhi_(xw.z), bflo_(xw.w), bfhi_(xw.w)} + acc[ai][bj][m][1];
                    u32x4 w; w.x = cvt_pk_bf16(v0[0], v0[1]); w.y = cvt_pk_bf16(v0[2], v0[3]); w.z = cvt_pk_bf16(v1[0], v1[1]); w.w = cvt_pk_bf16(v1[2], v1[3]);
                    *(u32x4*)(x2b + (size_t)row * D + col0 + bj * HALF) = w;
                    s += (v0[0] * v0[0] + v0[1] * v0[1]) + (v0[2] * v0[2] + v0[3] * v0[3]) + (v1[0] * v1[0] + v1[1] * v1[1]) + (v1[2] * v1[2] + v1[3] * v1[3]);
                }
                s += __shfl_xor(s, 16); s += __shfl_xor(s, 32);
                if (fq == 0 && !DRY) atomicAdd(rowsq + row, s);
            }
    }
};
template <class Epi, class Sched, bool ALIGN_EPI = false, bool SP2 = false>
__device__ __forceinline__ void gemm_phase(PG8_LAS unsigned char* lds, const Gemm g, const Sched& S, const Epi& E) {
    int tid_ = threadIdx.x; asm volatile("" : "+v"(tid_));
    const int tid = tid_, wid = __builtin_amdgcn_readfirstlane(tid >> 6), lane = tid & 63, wr = wid >> 2, wc = wid & 3, fr = lane & 15, fq = lane >> 4;
    const int K = g.K, nt = K / BK;
    unsigned voffA[2], voffB[2];
#pragma unroll
    for (int i = 0; i < 2; ++i) { int R, C; stage_rc(tid * 16 + i * 8192, R, C); const int Rb = Epi::PERM ? ((R & ~31) + perm32(R & 31)) : R;
        voffA[i] = (unsigned)(R * K + C) * 2u; voffB[i] = (unsigned)(Rb * K + C) * 2u; }
    const size_t kstep = (size_t)(BK * 2);
    const size_t hstep = (size_t)HALF * K * 2;
    const size_t tstep = 2 * hstep;
    const unsigned ldsw = (unsigned)wid * 1024u;
    const int aoff = lds_byte(wr * 64 + fr, fq * 8), boff = lds_byte(wc * 32 + fr, fq * 8);
#define PG8_SA(b, h) (((b) * 2 + (h)) * HTB)
#define PG8_SB(b, h) ((4 + (b) * 2 + (h)) * HTB)
#define PG8_STAGE(bufoff, gbase, voff) do { _Pragma("unroll") for (int _i = 0; _i < 2; ++_i) \
        __builtin_amdgcn_global_load_lds((const unsigned*)((const char*)(gbase) + (voff)[_i]), (PG8_LAS unsigned*)(lds + (bufoff) + ldsw + _i * 8192), 16, 0, 0); } while (0)
#define PG8_LDA(dst, b, h) do { _Pragma("unroll") for (int m = 0; m < 4; ++m) _Pragma("unroll") for (int k = 0; k < 2; ++k) dst[m][k] = *(const PG8_LAS bf16x8*)(lds + PG8_SA(b, h) + aoff + m * 2048 + k * 1024); } while (0)
#define PG8_LDB(dst, b, h) do { _Pragma("unroll") for (int n = 0; n < 2; ++n) _Pragma("unroll") for (int k = 0; k < 2; ++k) dst[n][k] = *(const PG8_LAS bf16x8*)(lds + PG8_SB(b, h) + boff + n * 2048 + k * 1024); } while (0)
#define PG8_MMA(ai, bj, At, Bt) do { __builtin_amdgcn_s_setprio(1); _Pragma("unroll") for (int m = 0; m < 4; ++m) _Pragma("unroll") for (int n = 0; n < 2; ++n) _Pragma("unroll") for (int k = 0; k < 2; ++k) \
        acc[ai][bj][m][n] = __builtin_amdgcn_mfma_f32_16x16x32_bf16(Bt[n][k], At[m][k], acc[ai][bj][m][n], 0, 0, 0); __builtin_amdgcn_s_setprio(0); } while (0)
#define PG8_WAIT_V(n) asm volatile("s_waitcnt vmcnt(" #n ")" ::: "memory")
#define PG8_WAIT_L(n) asm volatile("s_waitcnt lgkmcnt(" #n ")" ::: "memory")
#define PG8_BAR __builtin_amdgcn_s_barrier()
#define PG8_SCHED __builtin_amdgcn_sched_barrier(0)
    Unit cur, nxt; int ui = 0;
    if (!S.next(0, cur)) return;
    f32x4 acc[2][2][4][2];
#pragma unroll
    for (int a = 0; a < 2; ++a)
#pragma unroll
        for (int b = 0; b < 2; ++b)
#pragma unroll
            for (int m = 0; m < 4; ++m)
#pragma unroll
                for (int n = 0; n < 2; ++n) acc[a][b][m][n] = (f32x4){0.f, 0.f, 0.f, 0.f};
    bf16x8 At[4][2], B0[2][2], B1[2][2];
    const char* cA = (const char*)g.A + (size_t)cur.pm * tstep; const char* cB = (const char*)g.Bt + (size_t)cur.pn * tstep;
    S.a_ready(cur);
    if constexpr (SP2) {
        PG8_STAGE(PG8_SB(0, 0), cB, voffB); PG8_STAGE(PG8_SB(0, 1), cB + hstep, voffB); PG8_STAGE(PG8_SA(0, 0), cA, voffA); PG8_STAGE(PG8_SA(0, 1), cA + hstep, voffA);
        if (wr == 1) PG8_BAR;
        PG8_WAIT_V(2); PG8_BAR;
        PG8_STAGE(PG8_SB(1, 0), cB + kstep, voffB); PG8_STAGE(PG8_SA(1, 0), cA + kstep, voffA); PG8_STAGE(PG8_SB(1, 1), cB + hstep + kstep, voffB);
        PG8_WAIT_V(6); PG8_BAR;
    } else {
        PG8_STAGE(PG8_SB(0, 0), cB, voffB); PG8_STAGE(PG8_SA(0, 0), cA, voffA); PG8_STAGE(PG8_SB(0, 1), cB + hstep, voffB); PG8_STAGE(PG8_SA(0, 1), cA + hstep, voffA);
        if (wr == 1) PG8_BAR;
        PG8_WAIT_V(4); PG8_BAR;
        PG8_STAGE(PG8_SB(1, 0), cB + kstep, voffB); PG8_STAGE(PG8_SA(1, 0), cA + kstep, voffA); PG8_STAGE(PG8_SB(1, 1), cB + hstep + kstep, voffB);
        PG8_WAIT_V(6); PG8_BAR;
    }
    for (;;) {
        const bool has_next = S.next(ui + 1, nxt);
        const char* nA = has_next ? (const char*)g.A + (size_t)nxt.pm * tstep : cA; const char* nB = has_next ? (const char*)g.Bt + (size_t)nxt.pn * tstep : cB;
        for (int t = 0; t < nt; t += 2) {
            const bool last = (t == nt - 2);
            const char* a1 = cA + (size_t)(t + 1) * kstep;
            const char* a2 = last ? nA : cA + (size_t)(t + 2) * kstep; const char* b2 = last ? nB : cB + (size_t)(t + 2) * kstep;
            const char* a3 = a2 + kstep; const char* b3 = b2 + kstep;
            if (last && has_next) S.a_ready(nxt);
            if constexpr (SP2) {
            PG8_LDB(B0, 0, 0); PG8_LDB(B1, 0, 1); PG8_SCHED; PG8_LDA(At, 0, 0); PG8_STAGE(PG8_SA(1, 1), a1 + hstep, voffA);
            PG8_WAIT_V(8); PG8_WAIT_L(0); PG8_BAR; PG8_MMA(0, 0, At, B0); PG8_MMA(0, 1, At, B1); PG8_BAR; PG8_SCHED;
            PG8_LDA(At, 0, 1); PG8_STAGE(PG8_SB(0, 0), b2, voffB); PG8_STAGE(PG8_SB(0, 1), b2 + hstep, voffB); PG8_STAGE(PG8_SA(0, 0), a2, voffA);
            PG8_WAIT_V(8); PG8_WAIT_L(0); PG8_BAR; PG8_MMA(1, 0, At, B0); PG8_MMA(1, 1, At, B1); PG8_BAR; PG8_SCHED;
            PG8_LDB(B0, 1, 0); PG8_LDB(B1, 1, 1); PG8_SCHED; PG8_LDA(At, 1, 0); PG8_STAGE(PG8_SA(0, 1), a2 + hstep, voffA);
            PG8_WAIT_V(8); PG8_WAIT_L(0); PG8_BAR; PG8_MMA(0, 0, At, B0); PG8_MMA(0, 1, At, B1); PG8_BAR; PG8_SCHED;
            PG8_LDA(At, 1, 1); PG8_STAGE(PG8_SB(1, 0), b3, voffB); PG8_STAGE(PG8_SB(1, 1), b3 + hstep, voffB); PG8_STAGE(PG8_SA(1, 0), a3, voffA);
            PG8_WAIT_V(8); PG8_WAIT_L(0); PG8_BAR; PG8_MMA(1, 0, At, B0); PG8_MMA(1, 1, At, B1); PG8_BAR; PG8_SCHED;
            } else {
            PG8_LDB(B0, 0, 0); PG8_SCHED; PG8_LDA(At, 0, 0); PG8_STAGE(PG8_SA(1, 1), a1 + hstep, voffA);
            PG8_WAIT_L(8); PG8_BAR; PG8_WAIT_L(0); PG8_MMA(0, 0, At, B0); PG8_BAR; PG8_SCHED;
            PG8_LDB(B1, 0, 1); PG8_STAGE(PG8_SB(0, 0), b2, voffB);
            PG8_BAR; PG8_WAIT_L(0); PG8_MMA(0, 1, At, B1); PG8_BAR;
            PG8_LDA(At, 0, 1); PG8_STAGE(PG8_SA(0, 0), a2, voffA);
            PG8_BAR; PG8_WAIT_L(0); PG8_MMA(1, 0, At, B0); PG8_BAR; PG8_SCHED;
            PG8_STAGE(PG8_SB(0, 1), b2 + hstep, voffB);
            PG8_WAIT_V(6); PG8_BAR; PG8_MMA(1, 1, At, B1); PG8_BAR;
            PG8_LDB(B0, 1, 0); PG8_SCHED; PG8_LDA(At, 1, 0); PG8_STAGE(PG8_SA(0, 1), a2 + hstep, voffA);
            PG8_WAIT_L(8); PG8_BAR; PG8_WAIT_L(0); PG8_MMA(0, 0, At, B0); PG8_BAR; PG8_SCHED;
            PG8_LDB(B1, 1, 1); PG8_STAGE(PG8_SB(1, 0), b3, voffB);
            PG8_BAR; PG8_WAIT_L(0); PG8_MMA(0, 1, At, B1); PG8_BAR;
            PG8_LDA(At, 1, 1); PG8_STAGE(PG8_SA(1, 0), a3, voffA);
            PG8_BAR; PG8_WAIT_L(0); PG8_MMA(1, 0, At, B0); PG8_BAR; PG8_SCHED;
            PG8_STAGE(PG8_SB(1, 1), b3 + hstep, voffB);
            PG8_WAIT_V(6); PG8_BAR; PG8_MMA(1, 1, At, B1); PG8_BAR;
            }
        }
        if constexpr (ALIGN_EPI) { if (wr == 0) PG8_BAR; }
        if constexpr (!Epi::AFTER_DRAIN) { E(acc, cur, wr, wc, fr, fq); S.done(cur); }
        if (!has_next) break;
#pragma unroll
        for (int a = 0; a < 2; ++a)
#pragma unroll
            for (int b = 0; b < 2; ++b)
#pragma unroll
                for (int m = 0; m < 4; ++m)
#pragma unroll
                    for (int n = 0; n < 2; ++n) acc[a][b][m][n] = (f32x4){0.f, 0.f, 0.f, 0.f};
        cur = nxt; cA = nA; cB = nB; ++ui;
        if constexpr (ALIGN_EPI) { if (wr == 1) PG8_BAR; }
    }
    PG8_WAIT_V(0);
    if constexpr (!ALIGN_EPI) { if (wr == 0) PG8_BAR; }
    PG8_BAR;
    if constexpr (Epi::AFTER_DRAIN) { E.fused(acc, cur, wr, wc, fr, fq, lds, wid, lane); S.done(cur); }
#undef PG8_SA
#undef PG8_SB
#undef PG8_STAGE
#undef PG8_LDA
#undef PG8_LDB
#undef PG8_MMA
#undef PG8_WAIT_V
#undef PG8_WAIT_L
#undef PG8_BAR
#undef PG8_SCHED
}

struct HybridOrder {
    int nM, nN, nwg, G, c, nt, nfull, R, ns;
    __device__ __forceinline__ void init(int M, int N, int K, int G_, int c_, bool allow_split) {
        nM = M / BM; nN = N / BM; nwg = nM * nN; G = G_; c = c_; nt = K / BK; nfull = nwg / G; R = nwg - nfull * G;
        ns = (allow_split && R > 0 && (R % 8) == 0 && (G % 8) == 0) ? G / R : 1; if (ns > 8) ns = 8; if (ns > nt / 2) ns = nt / 2; if (ns < 2) ns = 1;
    }
    __device__ __forceinline__ void map(int L, Unit& u) const {
        int wgid = L; { const int q = nwg / NXCD, r = nwg % NXCD, xcd = wgid % NXCD, off = wgid / NXCD; wgid = (xcd < r ? xcd * (q + 1) : r * (q + 1) + (xcd - r) * q) + off; }
        const int nig = WGM * nN, gid = wgid / nig, fm = gid * WGM, gsz = (nM - fm) < WGM ? (nM - fm) : WGM;
        u.pm = fm + ((wgid % nig) % gsz); u.pn = (wgid % nig) / gsz;
    }
    __device__ __forceinline__ bool next(int i, Unit& u) const {
        if (i < nfull) { map(i * G + c, u); u.kb = 0; u.nk = nt; u.tinfo = -1; return true; }
        if (i > nfull || R == 0) return false;
        if (ns < 2) { const int L = i * G + c; if (L >= nwg) return false; map(L, u); u.kb = 0; u.nk = nt; u.tinfo = -1; return true; }
        const int x = c % 8, y = c / 8, tj = (y / ns) * 8 + x, slice = y % ns;
        if (tj >= R) return false;
        map(nfull * G + tj, u);
        const int pairs = nt / 2, base = pairs / ns, rem = pairs % ns, start = slice * base + (slice < rem ? slice : rem), mine = base + (slice < rem ? 1 : 0);
        u.kb = 2 * start; u.nk = 2 * mine; u.tinfo = (tj << 8) | (slice << 4) | ns; return true;
    }
};
struct TailCtx { f32x4* slab; unsigned* cnt; };

template <class Epi>
__device__ __forceinline__ void tail_fixup(f32x4 (&acc)[2][2][4][2], const Unit& u, const Epi& E, const TailCtx& T, int tid, int wr, int wc, int fr, int fq) {
    const int tj = u.tinfo >> 8, slice = (u.tinfo >> 4) & 15, ns = u.tinfo & 15;
    const __amdgpu_buffer_rsrc_t srs = __builtin_amdgcn_make_buffer_rsrc((void*)(T.slab + (size_t)(tj * ns + slice) * (32 * 512)), (short)0, 32 * 512 * 16, 0x00020000);
#pragma unroll
    for (int ai = 0; ai < 2; ++ai)
#pragma unroll
        for (int bj = 0; bj < 2; ++bj)
#pragma unroll
            for (int m = 0; m < 4; ++m)
#pragma unroll
                for (int n = 0; n < 2; ++n) __builtin_amdgcn_raw_buffer_store_b128(__builtin_bit_cast(u32x4, acc[ai][bj][m][n]), srs, (unsigned)(((((ai * 2 + bj) * 4 + m) * 2 + n) * 512 + tid) * 16), 0, 16);
    asm volatile("s_waitcnt vmcnt(0)" ::: "memory");
    __syncthreads();
    if (tid == 0) __hip_atomic_fetch_add(T.cnt + 64 * tj, 1u, __ATOMIC_RELAXED, __HIP_MEMORY_SCOPE_AGENT);
    if (tid < 64) {
        unsigned sp = 0;
        while (__hip_atomic_load(T.cnt + 64 * tj, __ATOMIC_RELAXED, __HIP_MEMORY_SCOPE_AGENT) < (unsigned)ns && ++sp < (1u << 22)) __builtin_amdgcn_s_sleep(2);
        __builtin_amdgcn_fence(__ATOMIC_ACQUIRE, "agent");
        asm volatile("s_waitcnt vmcnt(0)" ::: "memory");
    }
    __syncthreads();
    unsigned gmask = 0u;
    for (int g = slice; g < 8; g += ns) gmask |= 1u << g;
    const f32x4* tile = T.slab + (size_t)(tj * ns) * (32 * 512);
#pragma unroll
    for (int ai = 0; ai < 2; ++ai)
#pragma unroll
        for (int m = 0; m < 4; ++m) {
            if (!((gmask >> (ai * 4 + m)) & 1u)) continue;
#pragma unroll
            for (int bj = 0; bj < 2; ++bj)
#pragma unroll
                for (int n = 0; n < 2; ++n) {
                    const int idx = ((ai * 2 + bj) * 4 + m) * 2 + n;
                    f32x4 v = tile[idx * 512 + tid];
                    for (int sl = 1; sl < ns; ++sl) v = v + tile[(size_t)sl * (32 * 512) + idx * 512 + tid];
                    acc[ai][bj][m][n] = v;
                }
        }
    E(acc, u, wr, wc, fr, fq, gmask);
}

template <class Epi, class Sched>
__device__ __forceinline__ void gemm_phase2(PG8_LAS unsigned char* lds, const Gemm g, const Sched& S, const Epi& E, const TailCtx& T) {
    int tid_ = threadIdx.x; asm volatile("" : "+v"(tid_));
    const int tid = tid_, wid = __builtin_amdgcn_readfirstlane(tid >> 6), lane = tid & 63, wr = wid >> 2, wc = wid & 3, fr = lane & 15, fq = lane >> 4;
    const int K = g.K;
    unsigned voffA[2], voffB[2];
#pragma unroll
    for (int i = 0; i < 2; ++i) { int R, C; stage_rc(tid * 16 + i * 8192, R, C); const int Rb = Epi::PERM ? ((R & ~31) + perm32(R & 31)) : R;
        voffA[i] = (unsigned)(R * K + C) * 2u; voffB[i] = (unsigned)(Rb * K + C) * 2u; }
    const size_t kstep = (size_t)(BK * 2), hstep = (size_t)HALF * K * 2, tstep = 2 * hstep;
    const unsigned ldsw = (unsigned)wid * 1024u;
    const int aoff = lds_byte(wr * 64 + fr, fq * 8), boff = lds_byte(wc * 32 + fr, fq * 8);
#define PG8_SA(b, h) (((b) * 2 + (h)) * HTB)
#define PG8_SB(b, h) ((4 + (b) * 2 + (h)) * HTB)
#define PG8_STAGE(bufoff, gbase, voff) do { _Pragma("unroll") for (int _i = 0; _i < 2; ++_i) \
        __builtin_amdgcn_global_load_lds((const unsigned*)((const char*)(gbase) + (voff)[_i]), (PG8_LAS unsigned*)(lds + (bufoff) + ldsw + _i * 8192), 16, 0, 0); } while (0)
#define PG8_LDA(dst, b, h) do { _Pragma("unroll") for (int m = 0; m < 4; ++m) _Pragma("unroll") for (int k = 0; k < 2; ++k) dst[m][k] = *(const PG8_LAS bf16x8*)(lds + PG8_SA(b, h) + aoff + m * 2048 + k * 1024); } while (0)
#define PG8_LDB(dst, b, h) do { _Pragma("unroll") for (int n = 0; n < 2; ++n) _Pragma("unroll") for (int k = 0; k < 2; ++k) dst[n][k] = *(const PG8_LAS bf16x8*)(lds + PG8_SB(b, h) + boff + n * 2048 + k * 1024); } while (0)
#define PG8_MMA(ai, bj, At, Bt) do { __builtin_amdgcn_s_setprio(1); _Pragma("unroll") for (int m = 0; m < 4; ++m) _Pragma("unroll") for (int n = 0; n < 2; ++n) _Pragma("unroll") for (int k = 0; k < 2; ++k) \
        acc[ai][bj][m][n] = __builtin_amdgcn_mfma_f32_16x16x32_bf16(Bt[n][k], At[m][k], acc[ai][bj][m][n], 0, 0, 0); __builtin_amdgcn_s_setprio(0); } while (0)
#define PG8_WAIT_V(n) asm volatile("s_waitcnt vmcnt(" #n ")" ::: "memory")
#define PG8_WAIT_L(n) asm volatile("s_waitcnt lgkmcnt(" #n ")" ::: "memory")
#define PG8_BAR __builtin_amdgcn_s_barrier()
#define PG8_SCHED __builtin_amdgcn_sched_barrier(0)
    Unit cur, nxt; int ui = 0;
    if (!S.next(0, cur)) return;
    f32x4 acc[2][2][4][2];
#pragma unroll
    for (int a = 0; a < 2; ++a)
#pragma unroll
        for (int b = 0; b < 2; ++b)
#pragma unroll
            for (int m = 0; m < 4; ++m)
#pragma unroll
                for (int n = 0; n < 2; ++n) acc[a][b][m][n] = (f32x4){0.f, 0.f, 0.f, 0.f};
    bf16x8 At[4][2], B0[2][2], B1[2][2];
    const char* cA = (const char*)g.A + (size_t)cur.pm * tstep + (size_t)cur.kb * kstep; const char* cB = (const char*)g.Bt + (size_t)cur.pn * tstep + (size_t)cur.kb * kstep;
    PG8_STAGE(PG8_SB(0, 0), cB, voffB); PG8_STAGE(PG8_SB(0, 1), cB + hstep, voffB); PG8_STAGE(PG8_SA(0, 0), cA, voffA); PG8_STAGE(PG8_SA(0, 1), cA + hstep, voffA);
    if (wr == 1) PG8_BAR;
    PG8_WAIT_V(2); PG8_BAR;
    PG8_STAGE(PG8_SB(1, 0), cB + kstep, voffB); PG8_STAGE(PG8_SA(1, 0), cA + kstep, voffA); PG8_STAGE(PG8_SB(1, 1), cB + hstep + kstep, voffB);
    PG8_WAIT_V(6); PG8_BAR;
    for (;;) {
        const bool has_next = S.next(ui + 1, nxt);
        const char* nA = has_next ? (const char*)g.A + (size_t)nxt.pm * tstep + (size_t)nxt.kb * kstep : cA; const char* nB = has_next ? (const char*)g.Bt + (size_t)nxt.pn * tstep + (size_t)nxt.kb * kstep : cB;
        const int nt = cur.nk;
        for (int t = 0; t < nt; t += 2) {
            const bool last = (t == nt - 2);
            const char* a1 = cA + (size_t)(t + 1) * kstep;
            const char* a2 = last ? nA : cA + (size_t)(t + 2) * kstep; const char* b2 = last ? nB : cB + (size_t)(t + 2) * kstep;
            const char* a3 = a2 + kstep; const char* b3 = b2 + kstep;
            PG8_LDB(B0, 0, 0); PG8_LDB(B1, 0, 1); PG8_SCHED; PG8_LDA(At, 0, 0); PG8_STAGE(PG8_SA(1, 1), a1 + hstep, voffA);
            PG8_WAIT_V(8); PG8_WAIT_L(0); PG8_BAR; PG8_MMA(0, 0, At, B0); PG8_MMA(0, 1, At, B1); PG8_BAR; PG8_SCHED;
            PG8_LDA(At, 0, 1); PG8_STAGE(PG8_SB(0, 0), b2, voffB); PG8_STAGE(PG8_SB(0, 1), b2 + hstep, voffB); PG8_STAGE(PG8_SA(0, 0), a2, voffA);
            PG8_WAIT_V(8); PG8_WAIT_L(0); PG8_BAR; PG8_MMA(1, 0, At, B0); PG8_MMA(1, 1, At, B1); PG8_BAR; PG8_SCHED;
            PG8_LDB(B0, 1, 0); PG8_LDB(B1, 1, 1); PG8_SCHED; PG8_LDA(At, 1, 0); PG8_STAGE(PG8_SA(0, 1), a2 + hstep, voffA);
            PG8_WAIT_V(8); PG8_WAIT_L(0); PG8_BAR; PG8_MMA(0, 0, At, B0); PG8_MMA(0, 1, At, B1); PG8_BAR; PG8_SCHED;
            PG8_LDA(At, 1, 1); PG8_STAGE(PG8_SB(1, 0), b3, voffB); PG8_STAGE(PG8_SB(1, 1), b3 + hstep, voffB); PG8_STAGE(PG8_SA(1, 0), a3, voffA);
            PG8_WAIT_V(8); PG8_WAIT_L(0); PG8_BAR; PG8_MMA(1, 0, At, B0); PG8_MMA(1, 1, At, B1); PG8_BAR; PG8_SCHED;
        }
        if (wr == 0) PG8_BAR;
        if (cur.tinfo < 0) E(acc, cur, wr, wc, fr, fq);
        if (!has_next) break;
#pragma unroll
        for (int a = 0; a < 2; ++a)
#pragma unroll
            for (int b = 0; b < 2; ++b)
#pragma unroll
                for (int m = 0; m < 4; ++m)
#pragma unroll
                    for (int n = 0; n < 2; ++n) acc[a][b][m][n] = (f32x4){0.f, 0.f, 0.f, 0.f};
        cur = nxt; cA = nA; cB = nB; ++ui;
        if (wr == 1) PG8_BAR;
    }
    PG8_WAIT_V(0);
    PG8_BAR;
    if (cur.tinfo >= 0) tail_fixup(acc, cur, E, T, tid, wr, wc, fr, fq);
#undef PG8_SA
#undef PG8_SB
#undef PG8_STAGE
#undef PG8_LDA
#undef PG8_LDB
#undef PG8_MMA
#undef PG8_WAIT_V
#undef PG8_WAIT_L
#undef PG8_BAR
#undef PG8_SCHED
}

struct MUnit { int kind, pm, pn, kb, nk, tinfo; };
struct MOrder {
    int c;
    __device__ __forceinline__ bool next(int i, MUnit& u) const {
        const int j = i * 256 + c;
        u.kb = 0; u.tinfo = -1;
        if (j < 288) { u.kind = 0; u.nk = D / BK;
            if (j < 256) { const int x = j & 7, r = j >> 3; u.pm = 4 * x + (r >> 3); u.pn = r & 7; } else { const int t = j - 256; u.pm = 32 + (t >> 3); u.pn = t & 7; }
            return true; }
        if (j < 1872) { u.kind = 1; u.nk = D / BK; const int L = j - 288;
            if (L < 1408) { const int x = L & 7, off = L >> 3, wg = x * 176 + off, gid = wg / 352, rem = wg % 352; u.pm = gid * 8 + (rem & 7); u.pn = rem >> 3; }
            else { const int t = L - 1408; u.pm = 32 + (t & 3); u.pn = t >> 2; }
            return true; }
        if (j < 2128) { u.kind = 2; u.nk = DFF / BK; const int L = j - 1872, x = L & 7, r = L >> 3; u.pm = 4 * x + (r >> 3); u.pn = r & 7; return true; }
        const int ilast = (c < 80) ? 9 : 8;
        if (i != ilast || c < 80 || c >= 208) return false;
        const int mi = c - 80, tj = mi >> 2, slice = mi & 3;
        u.kind = 2; u.pm = 32 + (tj >> 3); u.pn = tj & 7; u.kb = slice * 22; u.nk = 22; u.tinfo = (tj << 8) | (slice << 4) | 4; return true;
    }
};

struct StreamOff { size_t A0, B0, A1, B1, A2, B2, x2b, slab; int dep3, dep4, tail, rsq2, rsq3; };
template <class SO>
__device__ __forceinline__ void gemm_stream(PG8_LAS unsigned char* lds, const MOrder& S, unsigned char* ws, const float* xp, const float* xs, const SO O) {
    int tid_ = threadIdx.x; asm volatile("" : "+v"(tid_));
    const int tid = tid_, wid = __builtin_amdgcn_readfirstlane(tid >> 6), lane = tid & 63, wr = wid >> 2, wc = wid & 3, fr = lane & 15, fq = lane >> 4;
    unsigned Ra[2][2], Rb[2][2];
#pragma unroll
    for (int i = 0; i < 2; ++i) { int R, C; stage_rc(tid * 16 + i * 8192, R, C); const int Rp = (R & ~31) + perm32(R & 31);
        Ra[0][i] = (unsigned)(R * D + C) * 2u; Ra[1][i] = (unsigned)(R * DFF + C) * 2u; Rb[0][i] = (unsigned)(Rp * D + C) * 2u; Rb[1][i] = (unsigned)(Rp * DFF + C) * 2u; }
    const size_t kstep = (size_t)(BK * 2);
    const unsigned ldsw = (unsigned)wid * 1024u;
    const int aoff = lds_byte(wr * 64 + fr, fq * 8), boff = lds_byte(wc * 32 + fr, fq * 8);
#define PG8_SA(b, h) (((b) * 2 + (h)) * HTB)
#define PG8_SB(b, h) ((4 + (b) * 2 + (h)) * HTB)
#define PG8_STG(bufoff, gbase, Rr, rowb) do { _Pragma("unroll") for (int _i = 0; _i < 2; ++_i) \
        __builtin_amdgcn_global_load_lds((const unsigned*)((const char*)(gbase) + ((rowb) == D * 2 ? (Rr)[0][_i] : (Rr)[1][_i])), (PG8_LAS unsigned*)(lds + (bufoff) + ldsw + _i * 8192), 16, 0, 0); } while (0)
#define PG8_LDA(dst, b, h) do { _Pragma("unroll") for (int m = 0; m < 4; ++m) _Pragma("unroll") for (int k = 0; k < 2; ++k) dst[m][k] = *(const PG8_LAS bf16x8*)(lds + PG8_SA(b, h) + aoff + m * 2048 + k * 1024); } while (0)
#define PG8_LDB(dst, b, h) do { _Pragma("unroll") for (int n = 0; n < 2; ++n) _Pragma("unroll") for (int k = 0; k < 2; ++k) dst[n][k] = *(const PG8_LAS bf16x8*)(lds + PG8_SB(b, h) + boff + n * 2048 + k * 1024); } while (0)
#define PG8_MMA(ai, bj, At, Bt) do { __builtin_amdgcn_s_setprio(1); _Pragma("unroll") for (int m = 0; m < 4; ++m) _Pragma("unroll") for (int n = 0; n < 2; ++n) _Pragma("unroll") for (int k = 0; k < 2; ++k) \
        acc[ai][bj][m][n] = __builtin_amdgcn_mfma_f32_16x16x32_bf16(Bt[n][k], At[m][k], acc[ai][bj][m][n], 0, 0, 0); __builtin_amdgcn_s_setprio(0); } while (0)
#define PG8_WAIT_V(n) asm volatile("s_waitcnt vmcnt(" #n ")" ::: "memory")
#define PG8_WAIT_L(n) asm volatile("s_waitcnt lgkmcnt(" #n ")" ::: "memory")
#define PG8_BAR __builtin_amdgcn_s_barrier()
#define PG8_SCHED __builtin_amdgcn_sched_barrier(0)
#define MU_A(u) ((const char*)ws + ((u).kind == 0 ? O.A0 : (u).kind == 1 ? O.A1 : O.A2) + (size_t)(u).pm * 256 * MU_RB(u) + (size_t)(u).kb * kstep)
#define MU_B(u) ((const char*)ws + ((u).kind == 0 ? O.B0 : (u).kind == 1 ? O.B1 : O.B2) + (size_t)(u).pn * 256 * MU_RB(u) + (size_t)(u).kb * kstep)
#define MU_RB(u) ((u).kind == 2 ? DFF * 2 : D * 2)
    unsigned long long rdy3 = 0ull, rdy4 = 0ull;
#define MU_READY(u) do { if ((u).kind != 0) { unsigned long long& _m = (u).kind == 1 ? rdy3 : rdy4; if (!((_m >> (u).pm) & 1ull)) { \
        if (wid == 0) { unsigned* _c = (unsigned*)ws + ((u).kind == 1 ? O.dep3 : O.dep4) + 64 * (u).pm; const unsigned _t = (u).kind == 1 ? 64u : 352u; unsigned _sp = 0; \
            while (__hip_atomic_load(_c, __ATOMIC_RELAXED, __HIP_MEMORY_SCOPE_AGENT) < _t && ++_sp < (1u << 22)) __builtin_amdgcn_s_sleep(2); \
            __builtin_amdgcn_fence(__ATOMIC_ACQUIRE, "agent"); asm volatile("s_waitcnt vmcnt(0)" ::: "memory"); } \
        asm volatile("" ::: "memory"); PG8_BAR; asm volatile("" ::: "memory"); _m |= 1ull << (u).pm; } } } while (0)
    PG8_LAS unsigned* vflag = (PG8_LAS unsigned*)(lds + 147456 - 256 + 64);
#define MU_TRY(u, ok) do { ok = true; if ((u).kind != 0) { unsigned long long& _m = (u).kind == 1 ? rdy3 : rdy4; if (!((_m >> (u).pm) & 1ull)) { \
        if (wid == 0) { unsigned* _c = (unsigned*)ws + ((u).kind == 1 ? O.dep3 : O.dep4) + 64 * (u).pm; const unsigned _t = (u).kind == 1 ? 64u : 352u; \
            const bool _r = __hip_atomic_load(_c, __ATOMIC_RELAXED, __HIP_MEMORY_SCOPE_AGENT) >= _t; \
            if (_r) { __builtin_amdgcn_fence(__ATOMIC_ACQUIRE, "agent"); asm volatile("s_waitcnt vmcnt(0)" ::: "memory"); } \
            if (lane == 0) *vflag = _r ? 1u : 0u; asm volatile("s_waitcnt lgkmcnt(0)" ::: "memory"); } \
        asm volatile("" ::: "memory"); PG8_BAR; asm volatile("" ::: "memory"); \
        ok = (*(volatile PG8_LAS unsigned*)vflag) != 0u; if (ok) _m |= 1ull << (u).pm; } } } while (0)
    MUnit cur, nxt; int ui = 0;
    if (!S.next(0, cur)) return;
    f32x4 acc[2][2][4][2];
#pragma unroll
    for (int a = 0; a < 2; ++a)
#pragma unroll
        for (int b = 0; b < 2; ++b)
#pragma unroll
            for (int m = 0; m < 4; ++m)
#pragma unroll
                for (int n = 0; n < 2; ++n) acc[a][b][m][n] = (f32x4){0.f, 0.f, 0.f, 0.f};
    bf16x8 At[4][2], B0[2][2], B1[2][2];
    bool more = true; float rq[8];
    while (more) {
#ifdef TPROBE
    if (threadIdx.x == 0 && cur.tinfo >= 0) ((volatile PG8_LAS unsigned long long*)(lds + 147456 - 256 + 128))[10] = __builtin_amdgcn_s_memrealtime();
#endif
    MU_READY(cur);
    const char* cA = MU_A(cur); const char* cB = MU_B(cur); int crb = MU_RB(cur);
    PG8_STG(PG8_SB(0, 0), cB, Rb, crb); PG8_STG(PG8_SB(0, 1), cB + (size_t)HALF * crb, Rb, crb); PG8_STG(PG8_SA(0, 0), cA, Ra, crb); PG8_STG(PG8_SA(0, 1), cA + (size_t)HALF * crb, Ra, crb);
    if (wr == 1) PG8_BAR;
    PG8_WAIT_V(2); PG8_BAR;
    PG8_STG(PG8_SB(1, 0), cB + kstep, Rb, crb); PG8_STG(PG8_SA(1, 0), cA + kstep, Ra, crb); PG8_STG(PG8_SB(1, 1), cB + (size_t)HALF * crb + kstep, Rb, crb);
    PG8_WAIT_V(6); PG8_BAR;
    for (;;) {
        const bool has_next = S.next(ui + 1, nxt);
        bool chain = has_next;
        const char* nA = cA; const char* nB = cB; int nrb = crb;
        const int nt = cur.nk;
        for (int t = 0; t < nt; t += 2) {
            const bool last = (t == nt - 2);
            if (last && has_next) { MU_TRY(nxt, chain); if (chain) { nA = MU_A(nxt); nB = MU_B(nxt); nrb = MU_RB(nxt); } }
            if (last && cur.kind == 1 && cur.tinfo < 0) { const Unit u{cur.pm, cur.pn, 0, 0, -1}; const EpiAct E1{(bf16_t*)(ws + O.A2), (const float*)ws + O.rsq2, true}; E1.prefetch(u, wr, fr, rq); }
            const char* a1 = cA + (size_t)(t + 1) * kstep;
            const char* a2 = last ? nA : cA + (size_t)(t + 2) * kstep; const char* b2 = last ? nB : cB + (size_t)(t + 2) * kstep; const int rb2 = last ? nrb : crb;
            const char* a3 = a2 + kstep; const char* b3 = b2 + kstep;
            const size_t h1 = (size_t)HALF * crb, h2 = (size_t)HALF * rb2;
            PG8_LDB(B0, 0, 0); PG8_LDB(B1, 0, 1); PG8_SCHED; PG8_LDA(At, 0, 0); PG8_STG(PG8_SA(1, 1), a1 + h1, Ra, crb);
            PG8_WAIT_V(8); PG8_WAIT_L(0); PG8_BAR; PG8_MMA(0, 0, At, B0); PG8_MMA(0, 1, At, B1); PG8_BAR; PG8_SCHED;
            PG8_LDA(At, 0, 1); PG8_STG(PG8_SB(0, 0), b2, Rb, rb2); PG8_STG(PG8_SB(0, 1), b2 + h2, Rb, rb2); PG8_STG(PG8_SA(0, 0), a2, Ra, rb2);
            PG8_WAIT_V(8); PG8_WAIT_L(0); PG8_BAR; PG8_MMA(1, 0, At, B0); PG8_MMA(1, 1, At, B1); PG8_BAR; PG8_SCHED;
            PG8_LDB(B0, 1, 0); PG8_LDB(B1, 1, 1); PG8_SCHED; PG8_LDA(At, 1, 0); PG8_STG(PG8_SA(0, 1), a2 + h2, Ra, rb2);
            PG8_WAIT_V(8); PG8_WAIT_L(0); PG8_BAR; PG8_MMA(0, 0, At, B0); PG8_MMA(0, 1, At, B1); PG8_BAR; PG8_SCHED;
            PG8_LDA(At, 1, 1); PG8_STG(PG8_SB(1, 0), b3, Rb, rb2); PG8_STG(PG8_SB(1, 1), b3 + h2, Rb, rb2); PG8_STG(PG8_SA(1, 0), a3, Ra, rb2);
            PG8_WAIT_V(8); PG8_WAIT_L(0); PG8_BAR; PG8_MMA(1, 0, At, B0); PG8_MMA(1, 1, At, B1); PG8_BAR; PG8_SCHED;
        }
        if (wr == 0) PG8_BAR;
        if (cur.tinfo < 0) {
            const Unit u{cur.pm, cur.pn, 0, 0, -1};
            if (cur.kind == 0) { const EpiX1<false> E0{xp, xs, nullptr, (bf16_t*)(ws + O.A1), (float*)ws + O.rsq2, true}; E0(acc, u, wr, wc, fr, fq); }
            else if (cur.kind == 1) { const EpiAct E1{(bf16_t*)(ws + O.A2), (const float*)ws + O.rsq2, true}; E1(acc, u, wr, wc, fr, fq, 0xffu, rq); }
            else { const EpiX2<false> E2{(bf16_t*)(ws + O.x2b), (float*)ws + O.rsq3, (const bf16_t*)(ws + O.A1)}; E2(acc, u, wr, wc, fr, fq); }
            if (cur.kind != 2) {
                asm volatile("s_waitcnt vmcnt(0)" ::: "memory");
                if (lane == 0) __hip_atomic_fetch_add((unsigned*)ws + (cur.kind == 0 ? O.dep3 : O.dep4) + 64 * cur.pm, 1u, __ATOMIC_RELAXED, __HIP_MEMORY_SCOPE_AGENT);
            }
        }
        if (!has_next) { more = false; break; }
        if (!chain) {
            PG8_WAIT_V(0); PG8_BAR;
#pragma unroll
            for (int a = 0; a < 2; ++a)
#pragma unroll
                for (int b = 0; b < 2; ++b)
#pragma unroll
                    for (int m = 0; m < 4; ++m)
#pragma unroll
                        for (int n = 0; n < 2; ++n) acc[a][b][m][n] = (f32x4){0.f, 0.f, 0.f, 0.f};
            cur = nxt; ++ui;
            break;
        }
#pragma unroll
        for (int a = 0; a < 2; ++a)
#pragma unroll
            for (int b = 0; b < 2; ++b)
#pragma unroll
                for (int m = 0; m < 4; ++m)
#pragma unroll
                    for (int n = 0; n < 2; ++n) acc[a][b][m][n] = (f32x4){0.f, 0.f, 0.f, 0.f};
        cur = nxt; cA = nA; cB = nB; crb = nrb; ++ui;
        if (wr == 1) PG8_BAR;
    }
    }
    PG8_WAIT_V(0);
    PG8_BAR;
#ifdef TPROBE
    if (threadIdx.x == 0) ((volatile PG8_LAS unsigned long long*)(lds + 147456 - 256 + 128))[9] = __builtin_amdgcn_s_memrealtime();
#endif
    if (cur.tinfo >= 0) { const Unit u{cur.pm, cur.pn, cur.kb, cur.nk, cur.tinfo}; const EpiX2<false> E2{(bf16_t*)(ws + O.x2b), (float*)ws + O.rsq3, (const bf16_t*)(ws + O.A1)};
        const TailCtx T{(f32x4*)(ws + O.slab), (unsigned*)ws + O.tail}; tail_fixup(acc, u, E2, T, tid, wr, wc, fr, fq); }
#undef MU_TRY
#undef MU_A
#undef MU_B
#undef MU_RB
#undef MU_READY
#undef PG8_SA
#undef PG8_SB
#undef PG8_STG
#undef PG8_LDA
#undef PG8_LDB
#undef PG8_MMA
#undef PG8_WAIT_V
#undef PG8_WAIT_L
#undef PG8_BAR
#undef PG8_SCHED
}
}
#define LAS __attribute__((address_space(3)))
typedef unsigned short bf16;
using pg8::f32x4; using pg8::u32x4; using pg8::u32x2; using pg8::bf16x8; using pg8::cvt_pk_bf16;

#ifndef ONE_LAUNCH
#define ONE_LAUNCH 1
#endif
constexpr int NWAVES = 8, NPHASE = 7;
constexpr int LDS_BYTES = 147456;
constexpr size_t MiB = 1u << 20;
constexpr size_t WS_CTL = 0, CTL_ZERO_BYTES = 1 * MiB;
constexpr size_t WS_WIN = 1 * MiB;
constexpr size_t WS_WO = 21 * MiB;
constexpr size_t WS_WGU = 29 * MiB;
constexpr size_t WS_WD = 73 * MiB;
constexpr size_t WS_WP = 95 * MiB;
constexpr size_t WS_MISC = 96 * MiB;
constexpr size_t WS_XB = 97 * MiB;
constexpr size_t WS_ZB = 133 * MiB;
constexpr size_t WS_LF = 223 * MiB;
constexpr size_t WS_ACT = WS_ZB;
constexpr size_t WS_MIX = 259 * MiB;
constexpr size_t WS_X2B = WS_WGU;
constexpr size_t WS_END = 328 * MiB;
constexpr int CW_RSQ2 = 4096, CW_RSQ3 = 4096 + M;
constexpr int CW_TAIL = 100000;
constexpr size_t WS_SLAB3 = WS_ACT, WS_SLAB45 = 232 * MiB;
constexpr int CW_DEP = 124000;
constexpr size_t WS_SLABM = 296 * MiB;
#ifndef MERGED
#define MERGED 1
#endif
constexpr int CW_BAR = 65536;
constexpr int MISC_OFF = 147456 - 256;
#ifndef USE_CG
#define USE_CG 0
#endif

__device__ __forceinline__ float wave_sum(float v) {
#pragma unroll
    for (int o = 1; o < 64; o <<= 1) v += __shfl_xor(v, o);
    return v;
}
__device__ __forceinline__ float bflo(unsigned w) { return __builtin_bit_cast(float, w << 16); }
__device__ __forceinline__ float bfhi(unsigned w) { return __builtin_bit_cast(float, w & 0xffff0000u); }
__device__ __forceinline__ float bf2f(bf16 b) { return __builtin_bit_cast(float, (unsigned)b << 16); }
__device__ __forceinline__ bf16 f2bf(float f) { unsigned u = __builtin_bit_cast(unsigned, f); return (bf16)((u + 0x7fffu + ((u >> 16) & 1u)) >> 16); }

#define XB_TMO      128
#define XB_XCNT(j)  (256  + 64 * (j))
#define XB_XSUB(j)  (1280 + 64 * (j))
#define XB_XGEN(j)  (2304 + 64 * (j))
#define XB_TOP      3328
#define XB_TOPGEN   3392
#define XCD_BAR_WORDS 3456
#define XB_SPIN_CAP (1u << 18)

__device__ __forceinline__ unsigned xb_ld(unsigned* p)              { return __hip_atomic_load(p, __ATOMIC_RELAXED, __HIP_MEMORY_SCOPE_AGENT); }
__device__ __forceinline__ unsigned xb_add(unsigned* p, unsigned v) { return __hip_atomic_fetch_add(p, v, __ATOMIC_RELAXED, __HIP_MEMORY_SCOPE_AGENT); }
__device__ __forceinline__ unsigned xb_xcc_id() { return (unsigned)__builtin_amdgcn_s_getreg((3 << 11) | 20) & 0xFu; }
#define XB_SPIN(cond, bar) do { unsigned _sp = 0; while (cond) { __builtin_amdgcn_s_sleep(1); \
    if ((++_sp & 255u) == 0u) { if (xb_ld(&(bar)[XB_TMO])) break; if (_sp > XB_SPIN_CAP) { atomicAdd(&(bar)[XB_TMO], 1u); break; } } } } while (0)

struct XcdBarrier {
    unsigned* bar; unsigned x;
    volatile LAS unsigned* st;
};

__device__ __forceinline__ XcdBarrier xcd_barrier_post(unsigned* bar, volatile LAS unsigned* st) {
    XcdBarrier b; b.bar = bar; b.x = xb_xcc_id(); b.st = st;
    if (threadIdx.x == 0) (void)xb_add(&bar[XB_XCNT(b.x)], 1u);
    return b;
}
__device__ __forceinline__ void xcd_barrier_complete(unsigned* bar, unsigned x, unsigned& nloc, unsigned& nx) {
    const unsigned G = gridDim.x * gridDim.y * gridDim.z;
    unsigned sum, cnt, mine, sp = 0u;
    for (;;) {
        sum = 0u; cnt = 0u; mine = 0u;
#pragma unroll
        for (unsigned j = 0; j < 16; ++j) { const unsigned c = xb_ld(&bar[XB_XCNT(j)]); sum += c; cnt += (c > 0u) ? 1u : 0u; mine = (j == x) ? c : mine; }
        if (sum == G) break;
        __builtin_amdgcn_s_sleep(1);
        if ((++sp & 255u) == 0u) { if (xb_ld(&bar[XB_TMO])) break; if (sp > XB_SPIN_CAP) { atomicAdd(&bar[XB_TMO], 1u); break; } }
    }
    nloc = mine > 0u ? mine : 1u; nx = cnt > 0u ? cnt : 1u;
}

__device__ __forceinline__ void xcd_barrier(const XcdBarrier& b) {
    asm volatile("s_waitcnt vmcnt(0)" ::: "memory");
    __syncthreads();
    if (threadIdx.x == 0) {
        unsigned* bar = b.bar;
        __builtin_amdgcn_s_waitcnt(0);
        unsigned nloc = b.st[0], nx = b.st[1];
        if (nloc == 0u) { xcd_barrier_complete(bar, b.x, nloc, nx); b.st[0] = nloc; b.st[1] = nx; }
        const unsigned old = xb_add(&bar[XB_XSUB(b.x)], 1u);
        const unsigned gen = old / nloc;
        if (old + 1u == (gen + 1u) * nloc) {
            __builtin_amdgcn_fence(__ATOMIC_RELEASE, "agent");
            asm volatile("s_waitcnt vmcnt(0)" ::: "memory");
            const unsigned og = xb_add(&bar[XB_TOP], 1u);
            const unsigned tg = og / nx;
            if (og + 1u == (tg + 1u) * nx) xb_add(&bar[XB_TOPGEN], 1u);
            else XB_SPIN(xb_ld(&bar[XB_TOPGEN]) == tg, bar);
            __builtin_amdgcn_fence(__ATOMIC_ACQUIRE, "agent");
            xb_add(&bar[XB_XGEN(b.x)], 1u);
            asm volatile("s_waitcnt vmcnt(0)" ::: "memory");
        } else {
            XB_SPIN(xb_ld(&bar[XB_XGEN(b.x)]) == gen, bar);
            __builtin_amdgcn_fence(__ATOMIC_ACQUIRE, "agent");
            asm volatile("s_waitcnt vmcnt(0)" ::: "memory");
        }
    }
    __syncthreads();
}


#ifdef TPROBE
#define STAMP(i) do { if (threadIdx.x == 0) ((volatile LAS unsigned long long*)(lds + MISC_OFF + 128))[i] = __builtin_amdgcn_s_memrealtime(); } while (0)
#else
#define STAMP(i) do {} while (0)
#endif
constexpr int CW_TP = 120000;

struct Args { const float* in[16]; float* out; unsigned char* ws; int ph_lo, ph_hi; };

__device__ __forceinline__ void p0_item(const float* W, int K, int N, bf16* WT, int mode, const float* sk, const float* sn, LAS float* scr, int item, int lane) {
    const int nblk = N / 64, kb = item / nblk, nb = item % nblk, k0 = 64 * kb, n0 = 64 * nb;
    const int drow0 = mode == 0 ? n0 : ((n0 >> 7) * 256 + (n0 & 127) + (mode == 2 ? 128 : 0));
    const int r = lane >> 4, c4 = lane & 15;
    f32x4 v[16];
#pragma unroll
    for (int i = 0; i < 16; ++i) v[i] = __builtin_nontemporal_load((const f32x4*)(W + (size_t)(k0 + 4 * i + r) * N + n0 + 4 * c4));
    if (sk) {
#pragma unroll
        for (int i = 0; i < 16; ++i) v[i] = v[i] * sk[k0 + 4 * i + r];
    }
#pragma unroll
    for (int i = 0; i < 16; ++i) { LAS float* d = scr + (4 * i + r) * 65 + 4 * c4; d[0] = v[i][0]; d[1] = v[i][1]; d[2] = v[i][2]; d[3] = v[i][3]; }
    asm volatile("s_waitcnt lgkmcnt(0)" ::: "memory");
    const int c = lane & 7, nn = lane >> 3;
#pragma unroll
    for (int j = 0; j < 8; ++j) { const int n = nn + 8 * j; const LAS float* s = scr + (8 * c) * 65 + n; const float f = sn ? sn[n0 + n] : 1.f;
        u32x4 o; o.x = cvt_pk_bf16(s[0 * 65] * f, s[1 * 65] * f); o.y = cvt_pk_bf16(s[2 * 65] * f, s[3 * 65] * f); o.z = cvt_pk_bf16(s[4 * 65] * f, s[5 * 65] * f); o.w = cvt_pk_bf16(s[6 * 65] * f, s[7 * 65] * f);
        *(u32x4*)(WT + (size_t)(drow0 + n) * K + k0 + 8 * c) = o; }
    asm volatile("s_waitcnt lgkmcnt(0)" ::: "memory");
}

constexpr int P0_I_IN = (D / 64) * (INC / 64), P0_I_O = (D / 64) * (D / 64), P0_I_G = (D / 64) * (DFF / 64), P0_I_D = (DFF / 64) * (D / 64), P0_I_P = (256 / 64) * (256 / 64);
constexpr int P0_NITEMS = P0_I_IN + P0_I_O + 2 * P0_I_G + P0_I_D + 4 * P0_I_P;
#ifndef P0_NDEF
#define P0_NDEF 3328
#endif
constexpr int P0_DEF_HI = P0_I_IN + P0_I_O + 2 * P0_I_G + P0_I_D, P0_DEF_LO = P0_DEF_HI - P0_NDEF;
__device__ __forceinline__ int p1_idle_wgs(int G) { const int nwg = (M / 256) * (INC / 256), nfull = nwg / G, R = nwg - nfull * G; return R > 0 ? G - R : 0; }
__device__ __forceinline__ void p0_weight_item(const Args& a, LAS float* scr, int it, int lane) {
    unsigned char* ws = a.ws;
    int r = it;
    if (r < P0_I_IN) { p0_item(a.in[6], D, INC, (bf16*)(ws + WS_WIN), 0, a.in[5], nullptr, scr, r, lane); return; } r -= P0_I_IN;
    if (r < P0_I_O) { p0_item(a.in[10], D, D, (bf16*)(ws + WS_WO), 0, nullptr, nullptr, scr, r, lane); return; } r -= P0_I_O;
    if (r < P0_I_G) { p0_item(a.in[12], D, DFF, (bf16*)(ws + WS_WGU), 1, a.in[11], nullptr, scr, r, lane); return; } r -= P0_I_G;
    if (r < P0_I_G) { p0_item(a.in[13], D, DFF, (bf16*)(ws + WS_WGU), 2, a.in[11], nullptr, scr, r, lane); return; } r -= P0_I_G;
    if (r < P0_I_D) { p0_item(a.in[14], DFF, D, (bf16*)(ws + WS_WD), 0, nullptr, nullptr, scr, r, lane); return; } r -= P0_I_D;
    { const int g = r / P0_I_P; p0_item(a.in[7] + (size_t)g * 65536, 256, 256, (bf16*)(ws + WS_WP) + (size_t)g * 65536, 0, nullptr, a.in[8] + g * 256, scr, r % P0_I_P, lane); }
}
__device__ __forceinline__ void phase0_deferred(LAS unsigned char* lds, const Args& a, int idle_idx, int nidle) {
    const int lane = threadIdx.x & 63, wave = threadIdx.x >> 6;
    LAS float* scr = (LAS float*)(lds + wave * 16640);
    for (int it = P0_DEF_LO + idle_idx * NWAVES + wave; it < P0_DEF_HI; it += nidle * NWAVES) p0_weight_item(a, scr, it, lane);
}
__device__ __forceinline__ void phase0(LAS unsigned char* lds, const Args& a, int vcu, int G) {
    const int tid = threadIdx.x, lane = tid & 63, wave = tid >> 6;
    unsigned char* ws = a.ws;
    LAS float* scr = (LAS float*)(lds + wave * 16640);
    const int gw = vcu * NWAVES + wave, NGW = G * NWAVES;
    const bool defer = p1_idle_wgs(G) >= 32;
    const int nlive = defer ? P0_NITEMS - (P0_DEF_HI - P0_DEF_LO) : P0_NITEMS;
    for (int k = gw; k < nlive; k += NGW) p0_weight_item(a, scr, (defer && k >= P0_DEF_LO) ? k + (P0_DEF_HI - P0_DEF_LO) : k, lane);
    float* rstd1 = (float*)(ws + WS_MISC); bf16* xb = (bf16*)(ws + WS_XB);
    for (int m = gw; m < M; m += NGW) {
        const float* xrow = m < MP ? a.in[0] + (size_t)m * D : a.in[1] + (size_t)(m - MP) * D;
        f32x4 v[8]; float s = 0.f;
#pragma unroll
        for (int j = 0; j < 8; ++j) { v[j] = __builtin_nontemporal_load((const f32x4*)xrow + lane + 64 * j); s += (v[j][0] * v[j][0] + v[j][1] * v[j][1]) + (v[j][2] * v[j][2] + v[j][3] * v[j][3]); }
        s = wave_sum(s);
        if (lane == 0) rstd1[m] = rsqrtf(s * (1.f / D) + EPS);
#pragma unroll
        for (int j = 0; j < 8; ++j) { u32x2 w; w.x = cvt_pk_bf16(v[j][0], v[j][1]); w.y = cvt_pk_bf16(v[j][2], v[j][3]); ((u32x2*)(xb + (size_t)m * D))[lane + 64 * j] = w; }
    }
    { u32x4* cz = (u32x4*)(ws + WS_CTL); const int gt0 = vcu * (NWAVES * 64) + tid, ngt0 = G * NWAVES * 64;
      for (int i = gt0; i < (int)(CTL_ZERO_BYTES / 16); i += ngt0) if (i < CW_BAR / 4 || i >= (CW_BAR + XCD_BAR_WORDS + 3) / 4) cz[i] = (u32x4){0u, 0u, 0u, 0u}; }
    const int gt = vcu * (NWAVES * 64) + tid, NGT = G * NWAVES * 64;
    float* lbv = (float*)(ws + WS_MISC) + M;
    for (int c = gt; c < HW; c += NGT) lbv[c] = 1.f / (1.f + __expf(a.in[4][HW + c] - a.in[4][c]));
    for (int i = gt; i < DB * 7 * PW; i += NGT) { const int b = i / (7 * PW), rem = i % (7 * PW); a.out[O_PSS + (size_t)b * PC * PW + rem] = a.in[2][(size_t)b * PC * PW + 8 * PW + rem]; }
}

template <int W, bool SAMPLE>
__device__ __forceinline__ void pool_fill(LAS bf16* A, int m0, int g, const bf16* zb, const float* cache) {
    const int tid = threadIdx.x, c8 = tid & 31, rq = tid >> 5;
    constexpr int LDA = 264;
    const int col = g * 256 + 8 * c8;
    u32x4 ur[19];
    int tb;
    if (!SAMPLE) {
        const int mb = m0 + 4 * rq - 15; tb = (m0 & (SEQ - 1)) + 4 * rq - 15;
#pragma unroll
        for (int e = 0; e < 19; ++e) ur[e] = (tb + e >= 0) ? *(const u32x4*)(zb + (size_t)(mb + e) * INC + col) : (u32x4){0u, 0u, 0u, 0u};
    } else {
        const int r0 = 4 * rq, m = m0 + r0, b = (m - MP) >> 3, t0 = r0 & 7; tb = t0 - 15;
#pragma unroll
        for (int e = 0; e < 19; ++e) {
            const int tau = tb + e;
            if (tau >= 0) ur[e] = *(const u32x4*)(zb + (size_t)(m - t0 + tau) * INC + col);
            else { const float* cr = cache + ((size_t)b * PC + (PC + tau)) * PW + col; const f32x4 c0 = *(const f32x4*)cr, c1 = *(const f32x4*)(cr + 4);
                   ur[e] = (u32x4){cvt_pk_bf16(c0[0], c0[1]), cvt_pk_bf16(c0[2], c0[3]), cvt_pk_bf16(c1[0], c1[1]), cvt_pk_bf16(c1[2], c1[3])}; }
        }
    }
    float out[4][8];
#pragma unroll
    for (int cp = 0; cp < 4; ++cp)
#pragma unroll
        for (int hf = 0; hf < 2; ++hf) {
#define PVAL(e) (hf ? bfhi(ur[e][cp]) : bflo(ur[e][cp]))
            float sw = 0.f;
#pragma unroll
            for (int j = 1; j < W; ++j) sw += PVAL(15 - j);
#pragma unroll
            for (int r = 0; r < 4; ++r) {
                const float um = PVAL(15 + r);
                sw += um;
                const float cnt = SAMPLE ? (float)W : (float)min(tb + 15 + r + 1, W);
                out[r][2 * cp + hf] = sw / cnt - um;
                sw -= PVAL(15 + r - (W - 1));
            }
#undef PVAL
        }
#pragma unroll
    for (int r = 0; r < 4; ++r) {
        u32x4 w; w.x = cvt_pk_bf16(out[r][0], out[r][1]); w.y = cvt_pk_bf16(out[r][2], out[r][3]); w.z = cvt_pk_bf16(out[r][4], out[r][5]); w.w = cvt_pk_bf16(out[r][6], out[r][7]);
        *(LAS u32x4*)(A + (4 * rq + r) * LDA + 8 * c8) = w;
    }
}
__device__ __forceinline__ void pool_item(LAS unsigned char* lds, int item, const bf16* zb, const float* cache, const bf16x8 (&wf)[8][2], bf16* mixb) {
    const int tile = item >> 2, g = item & 3, m0 = tile * 64;
    const int tid = threadIdx.x;
    constexpr int LDA = 264;
    LAS bf16* A = (LAS bf16*)lds;
    const int wave = tid >> 6, lane = tid & 63, fr = lane & 15, fq = lane >> 4, n0 = wave * 32;
    if (m0 < MP) { if (g == 0) pool_fill<2, false>(A, m0, g, zb, cache); else if (g == 1) pool_fill<4, false>(A, m0, g, zb, cache); else if (g == 2) pool_fill<8, false>(A, m0, g, zb, cache); else pool_fill<16, false>(A, m0, g, zb, cache); }
    else { if (g == 0) pool_fill<2, true>(A, m0, g, zb, cache); else if (g == 1) pool_fill<4, true>(A, m0, g, zb, cache); else if (g == 2) pool_fill<8, true>(A, m0, g, zb, cache); else pool_fill<16, true>(A, m0, g, zb, cache); }
    __syncthreads();
    f32x4 acc[4][2];
#pragma unroll
    for (int i = 0; i < 4; ++i)
#pragma unroll
        for (int j = 0; j < 2; ++j) acc[i][j] = (f32x4){0.f, 0.f, 0.f, 0.f};
#pragma unroll
    for (int ks = 0; ks < 8; ++ks) {
        bf16x8 af[4];
#pragma unroll
        for (int mt = 0; mt < 4; ++mt) af[mt] = *(const LAS bf16x8*)(A + (mt * 16 + fr) * LDA + ks * 32 + fq * 8);
#pragma unroll
        for (int mt = 0; mt < 4; ++mt)
#pragma unroll
            for (int nt = 0; nt < 2; ++nt) acc[mt][nt] = __builtin_amdgcn_mfma_f32_16x16x32_bf16(wf[ks][nt], af[mt], acc[mt][nt], 0, 0, 0);
    }
#pragma unroll
    for (int mt = 0; mt < 4; ++mt)
#pragma unroll
        for (int nt = 0; nt < 2; ++nt) {
            u32x2 o; o.x = cvt_pk_bf16(acc[mt][nt][0], acc[mt][nt][1]); o.y = cvt_pk_bf16(acc[mt][nt][2], acc[mt][nt][3]);
            *(u32x2*)(mixb + (size_t)(m0 + mt * 16 + fr) * D + g * 256 + n0 + nt * 16 + 4 * fq) = o;
        }
    __syncthreads();
}

struct SampleRegs { f32x4 S[8]; };
__device__ __forceinline__ void sample_load(SampleRegs& R, const float* S0) {
    const int tid = threadIdx.x, v4 = tid & 31, kq = tid >> 5;
#pragma unroll
    for (int kk = 0; kk < 8; ++kk) R.S[kk] = __builtin_nontemporal_load((const f32x4*)(S0 + (size_t)(kq * 8 + kk) * HD + 4 * v4));
}
struct SampleStage { float lfv[2]; bf16 q[2], v[2]; bf16 g[2]; float gn[2]; };
__device__ __forceinline__ void sample_stage(SampleStage& st, const bf16* zb, const float* lf, const float* hgn, int row0, int h) {
    const int tid = threadIdx.x;
#pragma unroll
    for (int j = 0; j < 2; ++j) {
        const int i = tid + 512 * j, t = i >> 7, ch = i & 127; const size_t row = (size_t)(row0 + t);
        st.lfv[j] = lf[row * HW + h * HD + ch]; st.q[j] = zb[row * INC + PW + h * HD + ch]; st.v[j] = zb[row * INC + PW + 2 * HW + h * HD + ch];
    }
    const int wave = tid >> 6, lane = tid & 63;
#pragma unroll
    for (int j = 0; j < 2; ++j) { st.g[j] = zb[(size_t)(row0 + wave) * INC + PW + 3 * HW + h * HD + lane + 64 * j]; st.gn[j] = hgn[h * HD + lane + 64 * j]; }
}
__device__ __forceinline__ void sample_run(LAS unsigned char* lds, SampleRegs& R, const SampleStage& st, const bf16* zb, const float* hgn, float* Sout, bf16* mixb, int row0, int h) {
    const int tid = threadIdx.x, v4 = tid & 31, kq = tid >> 5, wave = tid >> 6, lane = tid & 63;
    LAS float* sq = (LAS float*)lds; LAS float* sf = sq + 1024; LAS float* sk = sf + 1024; LAS float* sv = sk + 1024; LAS float* red = sv + 1024;
#pragma unroll
    for (int j = 0; j < 2; ++j) {
        const int i = tid + 512 * j;
        const float f = __builtin_amdgcn_exp2f(st.lfv[j]);
        sq[i] = bf2f(st.q[j]); sf[i] = f; sk[i] = 1.f - f; sv[i] = bf2f(st.v[j]);
    }
    __syncthreads();
#pragma unroll 1
    for (int t = 0; t < 8; ++t) {
        const f32x4 vt = *(const LAS f32x4*)(sv + t * 128 + 4 * v4);
        f32x4 o = (f32x4){0.f, 0.f, 0.f, 0.f};
        const f32x4 f0 = *(const LAS f32x4*)(sf + t * 128 + kq * 8), f1 = *(const LAS f32x4*)(sf + t * 128 + kq * 8 + 4);
        const f32x4 k0 = *(const LAS f32x4*)(sk + t * 128 + kq * 8), k1 = *(const LAS f32x4*)(sk + t * 128 + kq * 8 + 4);
        const f32x4 q0 = *(const LAS f32x4*)(sq + t * 128 + kq * 8), q1 = *(const LAS f32x4*)(sq + t * 128 + kq * 8 + 4);
#pragma unroll
        for (int kk = 0; kk < 8; ++kk) {
            const float f = kk < 4 ? f0[kk & 3] : f1[kk & 3], kn = kk < 4 ? k0[kk & 3] : k1[kk & 3], q = kk < 4 ? q0[kk & 3] : q1[kk & 3];
            R.S[kk] = R.S[kk] * f + vt * kn;
            o = o + R.S[kk] * q;
        }
#pragma unroll
        for (int j = 0; j < 4; ++j) o[j] += __shfl_xor(o[j], 32);
        if (lane < 32) *(LAS f32x4*)(red + (wave * 8 + t) * 128 + 4 * v4) = o;
    }
#pragma unroll
    for (int kk = 0; kk < 8; ++kk) __builtin_nontemporal_store(R.S[kk], (f32x4*)(Sout + (size_t)(kq * 8 + kk) * HD + 4 * v4));
    __syncthreads();
    {
        const int t = wave; const size_t row = (size_t)(row0 + t);
        float o0 = 0.f, o1 = 0.f;
#pragma unroll
        for (int w8 = 0; w8 < 8; ++w8) { o0 += red[(w8 * 8 + t) * 128 + lane]; o1 += red[(w8 * 8 + t) * 128 + lane + 64]; }
        const float ss = wave_sum(o0 * o0 + o1 * o1), r = rsqrtf(ss * (1.f / HD) + EPS);
        const int ch0 = h * HD + lane, ch1 = ch0 + 64;
        mixb[row * D + PW + ch0] = f2bf(o0 * r * st.gn[0] * bf2f(st.g[0]));
        mixb[row * D + PW + ch1] = f2bf(o1 * r * st.gn[1] * bf2f(st.g[1]));
    }
    __syncthreads();
}

constexpr int CQS = 272, CTS = 144;
constexpr int L_Q = 0, L_K = L_Q + 64 * CQS, L_KT = L_K + 64 * CQS, L_VT = L_KT + 128 * CTS, L_ST = L_VT + 128 * CTS, L_P = L_ST + 128 * CQS,
              L_DS = L_P + 64 * CTS, L_TOT = L_DS + 512, L_RMS = L_TOT + 8192, L_CHAIN_END = L_RMS + 512;
static_assert(L_CHAIN_END <= 131072, "chain LDS");
struct SegIn { f32x4 lf[4]; u32x2 v[4], sq[4]; };
template <bool FULL>
__device__ __forceinline__ void seg_load(SegIn& I, const bf16* zb, const float* lf, int row0, int h) {
    const int tid = threadIdx.x, cg = tid & 31, tgp = tid >> 5;
#pragma unroll
    for (int j = 0; j < 4; ++j) {
        const size_t row = (size_t)(row0 + 4 * tgp + j);
        I.lf[j] = *(const f32x4*)(lf + row * HW + h * HD + 4 * cg);
        I.v[j] = *(const u32x2*)(zb + row * INC + PW + 2 * HW + h * HD + 4 * cg);
        if (FULL) I.sq[j] = *(const u32x2*)(zb + row * INC + PW + h * HD + 4 * cg);
    }
}
template <bool FULL>
__device__ __forceinline__ void seg_run(LAS unsigned char* lds, SegIn& I, const bf16* zb, const float* lf, f32x4 (&Sacc)[8], f32x4& segsum, const f32x4 (&gnr)[4], bf16* mixb, int rowb, int nsteps, int h) {
    const int tid = threadIdx.x, lane = tid & 63, wave = __builtin_amdgcn_readfirstlane(tid >> 6), fr = lane & 15, fq = lane >> 4;
    const int cg = tid & 31, tgp = tid >> 5;
    LAS float* dS = (LAS float*)(lds + L_DS); LAS float* tot = (LAS float*)(lds + L_TOT); LAS float* rmsp = (LAS float*)(lds + L_RMS);
    *(LAS f32x4*)(tot + tgp * 128 + 4 * cg) = (I.lf[0] + I.lf[1]) + (I.lf[2] + I.lf[3]);
    if (FULL) {
#pragma unroll
        for (int kt = 0; kt < 8; ++kt) {
            u32x2 w; w.x = cvt_pk_bf16(Sacc[kt][0], Sacc[kt][1]); w.y = cvt_pk_bf16(Sacc[kt][2], Sacc[kt][3]);
            *(LAS u32x2*)(lds + L_ST + (16 * wave + fr) * CQS + (16 * kt + 4 * fq) * 2) = w;
        }
    }
    __syncthreads();
    for (int c = 0; c < nsteps; ++c) {
        {
            f32x4 b = (f32x4){0.f, 0.f, 0.f, 0.f};
#pragma unroll
            for (int g = 0; g < 15; ++g) { const f32x4 tv = *(const LAS f32x4*)(tot + g * 128 + 4 * cg); if (g < tgp) b = b + tv; }
            float kt[4][4], qt[4][4];
#pragma unroll
            for (int j = 0; j < 4; ++j) {
                b = b + I.lf[j];
                const float kn0 = 1.f - __builtin_amdgcn_exp2f(I.lf[j][0]), kn1 = 1.f - __builtin_amdgcn_exp2f(I.lf[j][1]), kn2 = 1.f - __builtin_amdgcn_exp2f(I.lf[j][2]), kn3 = 1.f - __builtin_amdgcn_exp2f(I.lf[j][3]);
                kt[j][0] = kn0 * __builtin_amdgcn_exp2f(-b[0]); kt[j][1] = kn1 * __builtin_amdgcn_exp2f(-b[1]); kt[j][2] = kn2 * __builtin_amdgcn_exp2f(-b[2]); kt[j][3] = kn3 * __builtin_amdgcn_exp2f(-b[3]);
                if (FULL) {
                    qt[j][0] = bflo(I.sq[j].x) * __builtin_amdgcn_exp2f(b[0]); qt[j][1] = bfhi(I.sq[j].x) * __builtin_amdgcn_exp2f(b[1]); qt[j][2] = bflo(I.sq[j].y) * __builtin_amdgcn_exp2f(b[2]); qt[j][3] = bfhi(I.sq[j].y) * __builtin_amdgcn_exp2f(b[3]);
                    const int t = 4 * tgp + j;
                    u32x2 qw, kw; qw.x = cvt_pk_bf16(qt[j][0], qt[j][1]); qw.y = cvt_pk_bf16(qt[j][2], qt[j][3]); kw.x = cvt_pk_bf16(kt[j][0], kt[j][1]); kw.y = cvt_pk_bf16(kt[j][2], kt[j][3]);
                    *(LAS u32x2*)(lds + L_Q + t * CQS + cg * 8) = qw;
                    *(LAS u32x2*)(lds + L_K + t * CQS + cg * 8) = kw;
                }
            }
#pragma unroll
            for (int ch = 0; ch < 4; ++ch) {
                u32x2 kw; kw.x = cvt_pk_bf16(kt[0][ch], kt[1][ch]); kw.y = cvt_pk_bf16(kt[2][ch], kt[3][ch]);
                *(LAS u32x2*)(lds + L_KT + (4 * cg + ch) * CTS + tgp * 8) = kw;
                const unsigned w0 = (ch < 2) ? I.v[0].x : I.v[0].y, w1 = (ch < 2) ? I.v[1].x : I.v[1].y, w2 = (ch < 2) ? I.v[2].x : I.v[2].y, w3 = (ch < 2) ? I.v[3].x : I.v[3].y;
                u32x2 vw;
                if (ch & 1) { vw.x = (w0 >> 16) | (w1 & 0xffff0000u); vw.y = (w2 >> 16) | (w3 & 0xffff0000u); }
                else { vw.x = (w0 & 0xffffu) | (w1 << 16); vw.y = (w2 & 0xffffu) | (w3 << 16); }
                *(LAS u32x2*)(lds + L_VT + (4 * cg + ch) * CTS + tgp * 8) = vw;
            }
            if (tgp == 15) {
                f32x4 e; e[0] = __builtin_amdgcn_exp2f(b[0]); e[1] = __builtin_amdgcn_exp2f(b[1]); e[2] = __builtin_amdgcn_exp2f(b[2]); e[3] = __builtin_amdgcn_exp2f(b[3]);
                *(LAS f32x4*)(dS + 4 * cg) = e; segsum = segsum + b;
            }
        }
        __syncthreads();
        u32x2 sgr[4];
        if (FULL) {
#pragma unroll
            for (int i = 0; i < 4; ++i) sgr[i] = *(const u32x2*)(zb + (size_t)(rowb + 64 * c + 16 * (wave & 3) + fr) * INC + PW + 3 * HW + h * HD + 16 * (4 * (wave >> 2) + i) + 4 * fq);
        }
        if (c + 1 < nsteps) seg_load<FULL>(I, zb, lf, rowb + 64 * (c + 1), h);
        if (FULL) {
#pragma unroll
            for (int i = 0; i < 2; ++i) {
                const int ti = 2 * wave + i, tt = ti >> 2, st = ti & 3;
                f32x4 p = (f32x4){0.f, 0.f, 0.f, 0.f};
#pragma unroll
                for (int ks = 0; ks < 4; ++ks) {
                    const bf16x8 ka = *(const LAS bf16x8*)(lds + L_K + (16 * st + fr) * CQS + (32 * ks + 8 * fq) * 2);
                    const bf16x8 qb = *(const LAS bf16x8*)(lds + L_Q + (16 * tt + fr) * CQS + (32 * ks + 8 * fq) * 2);
                    p = __builtin_amdgcn_mfma_f32_16x16x32_bf16(ka, qb, p, 0, 0, 0);
                }
                const int t = 16 * tt + fr, s0 = 16 * st + 4 * fq;
                u32x2 w; w.x = cvt_pk_bf16(s0 + 0 <= t ? p[0] : 0.f, s0 + 1 <= t ? p[1] : 0.f); w.y = cvt_pk_bf16(s0 + 2 <= t ? p[2] : 0.f, s0 + 3 <= t ? p[3] : 0.f);
                *(LAS u32x2*)(lds + L_P + t * CTS + s0 * 2) = w;
            }
        }
        {
            bf16x8 vb[2];
#pragma unroll
            for (int ss = 0; ss < 2; ++ss) vb[ss] = *(const LAS bf16x8*)(lds + L_VT + (16 * wave + fr) * CTS + (32 * ss + 8 * fq) * 2);
#pragma unroll
            for (int kt = 0; kt < 8; ++kt)
#pragma unroll
                for (int ss = 0; ss < 2; ++ss) {
                    const bf16x8 ka = *(const LAS bf16x8*)(lds + L_KT + (16 * kt + fr) * CTS + (32 * ss + 8 * fq) * 2);
                    Sacc[kt] = __builtin_amdgcn_mfma_f32_16x16x32_bf16(ka, vb[ss], Sacc[kt], 0, 0, 0);
                }
        }
        const int tt = wave & 3, vh = wave >> 2;
        f32x4 o[4];
        if (FULL) {
            __syncthreads();
            bf16x8 pb[2], qb[4];
#pragma unroll
            for (int ss = 0; ss < 2; ++ss) pb[ss] = *(const LAS bf16x8*)(lds + L_P + (16 * tt + fr) * CTS + (32 * ss + 8 * fq) * 2);
#pragma unroll
            for (int ks = 0; ks < 4; ++ks) qb[ks] = *(const LAS bf16x8*)(lds + L_Q + (16 * tt + fr) * CQS + (32 * ks + 8 * fq) * 2);
#pragma unroll
            for (int i = 0; i < 4; ++i) {
                const int vrow = 16 * (4 * vh + i) + fr;
                f32x4 a = (f32x4){0.f, 0.f, 0.f, 0.f};
#pragma unroll
                for (int ss = 0; ss < 2; ++ss) a = __builtin_amdgcn_mfma_f32_16x16x32_bf16(*(const LAS bf16x8*)(lds + L_VT + vrow * CTS + (32 * ss + 8 * fq) * 2), pb[ss], a, 0, 0, 0);
#pragma unroll
                for (int ks = 0; ks < 4; ++ks) a = __builtin_amdgcn_mfma_f32_16x16x32_bf16(*(const LAS bf16x8*)(lds + L_ST + vrow * CQS + (32 * ks + 8 * fq) * 2), qb[ks], a, 0, 0, 0);
                o[i] = a;
            }
            float ss2 = 0.f;
#pragma unroll
            for (int i = 0; i < 4; ++i) ss2 += (o[i][0] * o[i][0] + o[i][1] * o[i][1]) + (o[i][2] * o[i][2] + o[i][3] * o[i][3]);
            ss2 += __shfl_xor(ss2, 16); ss2 += __shfl_xor(ss2, 32);
            if (fq == 0) rmsp[vh * 64 + 16 * tt + fr] = ss2;
        }
#pragma unroll
        for (int kt = 0; kt < 8; ++kt) Sacc[kt] = Sacc[kt] * *(const LAS f32x4*)(dS + 16 * kt + 4 * fq);
        if (c + 1 < nsteps) *(LAS f32x4*)(tot + tgp * 128 + 4 * cg) = (I.lf[0] + I.lf[1]) + (I.lf[2] + I.lf[3]);
        __syncthreads();
        if (FULL) {
            const int tl = 16 * tt + fr; const size_t row = (size_t)(rowb + 64 * c + tl);
            const float r = rsqrtf((rmsp[tl] + rmsp[64 + tl]) * (1.f / HD) + EPS);
#pragma unroll
            for (int i = 0; i < 4; ++i) {
                const int ch = h * HD + 16 * (4 * vh + i) + 4 * fq;
                const f32x4 gn = gnr[i];
                const u32x2 sg = sgr[i];
                const float g0 = __builtin_bit_cast(float, sg.x << 16), g1 = __builtin_bit_cast(float, sg.x & 0xffff0000u), g2 = __builtin_bit_cast(float, sg.y << 16), g3 = __builtin_bit_cast(float, sg.y & 0xffff0000u);
                u32x2 w; w.x = cvt_pk_bf16(o[i][0] * r * gn[0] * g0, o[i][1] * r * gn[1] * g1); w.y = cvt_pk_bf16(o[i][2] * r * gn[2] * g2, o[i][3] * r * gn[3] * g3);
                *(u32x2*)(mixb + row * D + PW + ch) = w;
            }
#pragma unroll
            for (int kt = 0; kt < 8; ++kt) {
                u32x2 w; w.x = cvt_pk_bf16(Sacc[kt][0], Sacc[kt][1]); w.y = cvt_pk_bf16(Sacc[kt][2], Sacc[kt][3]);
                *(LAS u32x2*)(lds + L_ST + (16 * wave + fr) * CQS + (16 * kt + 4 * fq) * 2) = w;
            }
        }
    }
    __syncthreads();
}

#ifndef P2_ORDER_OLD
#define P2_ORDER_OLD 0
#endif
constexpr int CW_FLAG = 32768;
__device__ __forceinline__ void prompt_pass1(LAS unsigned char* lds, const Args& a, int chain, int seg, int nseg) {
    if (seg + 1 >= nseg) return;
    unsigned char* ws = a.ws;
    const bf16* zb = (const bf16*)(ws + WS_ZB); const float* lf = (const float*)(ws + WS_LF); bf16* mixb = (bf16*)(ws + WS_MIX);
    const int tid = threadIdx.x;
    const int b = chain / NH, h = chain % NH, seglen = SEQ / nseg, nsteps = seglen / 64, rowb = b * SEQ + seg * seglen;
    f32x4* slab = (f32x4*)(ws + WS_XB);
    float* dseg = (float*)(ws + WS_XB + 16 * MiB);
    unsigned* flags = (unsigned*)(ws + WS_CTL) + CW_FLAG;
    f32x4 gnr[4];
#pragma unroll
    for (int i = 0; i < 4; ++i) gnr[i] = (f32x4){0.f, 0.f, 0.f, 0.f};
    f32x4 Sacc[8];
#pragma unroll
    for (int i = 0; i < 8; ++i) Sacc[i] = (f32x4){0.f, 0.f, 0.f, 0.f};
    f32x4 segsum = (f32x4){0.f, 0.f, 0.f, 0.f};
    SegIn I; seg_load<false>(I, zb, lf, rowb, h);
    seg_run<false>(lds, I, zb, lf, Sacc, segsum, gnr, mixb, rowb, nsteps, h);
    const __amdgpu_buffer_rsrc_t srs = __builtin_amdgcn_make_buffer_rsrc((void*)(slab + (size_t)(chain * 8 + seg) * 4096), (short)0, 4096 * 16, 0x00020000);
#pragma unroll
    for (int kt = 0; kt < 8; ++kt) __builtin_amdgcn_raw_buffer_store_b128(__builtin_bit_cast(u32x4, Sacc[kt]), srs, (unsigned)((kt * 512 + tid) * 16), 0, 16);
    if ((tid >> 5) == 15) {
#pragma unroll
        for (int j = 0; j < 4; ++j) __hip_atomic_store((unsigned*)dseg + (chain * 8 + seg) * 128 + 4 * (tid & 31) + j, __builtin_bit_cast(unsigned, __builtin_amdgcn_exp2f(segsum[j])), __ATOMIC_RELAXED, __HIP_MEMORY_SCOPE_AGENT);
    }
    asm volatile("s_waitcnt vmcnt(0)" ::: "memory");
    __syncthreads();
    if (tid == 0) __hip_atomic_store(flags + 64 * (chain * 8 + seg), 1u, __ATOMIC_RELAXED, __HIP_MEMORY_SCOPE_AGENT);
}
__device__ __forceinline__ void prompt_pass2(LAS unsigned char* lds, const Args& a, int chain, int seg, int nseg) {
    unsigned char* ws = a.ws;
    const bf16* zb = (const bf16*)(ws + WS_ZB); const float* lf = (const float*)(ws + WS_LF); bf16* mixb = (bf16*)(ws + WS_MIX);
    const int tid = threadIdx.x, lane = tid & 63, wave = __builtin_amdgcn_readfirstlane(tid >> 6), fr = lane & 15, fq = lane >> 4;
    const int b = chain / NH, h = chain % NH, seglen = SEQ / nseg, nsteps = seglen / 64, rowb = b * SEQ + seg * seglen;
    const f32x4* slab = (const f32x4*)(ws + WS_XB);
    const float* dseg = (const float*)(ws + WS_XB + 16 * MiB);
    unsigned* flags = (unsigned*)(ws + WS_CTL) + CW_FLAG;
    f32x4 gnr[4];
#pragma unroll
    for (int i = 0; i < 4; ++i) gnr[i] = *(const f32x4*)(a.in[9] + h * HD + 16 * (4 * (wave >> 2) + i) + 4 * fq);
    f32x4 Sacc[8];
#pragma unroll
    for (int i = 0; i < 8; ++i) Sacc[i] = (f32x4){0.f, 0.f, 0.f, 0.f};
    f32x4 segsum = (f32x4){0.f, 0.f, 0.f, 0.f};
    SegIn I; seg_load<true>(I, zb, lf, rowb, h);
    if (seg > 0) {
        if (tid < 64) {
            for (int i = 0; i < seg; ++i) { unsigned sp = 0; while (__hip_atomic_load(flags + 64 * (chain * 8 + i), __ATOMIC_RELAXED, __HIP_MEMORY_SCOPE_AGENT) == 0u && ++sp < (1u << 22)) __builtin_amdgcn_s_sleep(2); }
            __builtin_amdgcn_fence(__ATOMIC_ACQUIRE, "agent");
            asm volatile("s_waitcnt vmcnt(0)" ::: "memory");
        }
        __syncthreads();
        f32x4 rc[8], rn[8];
#pragma unroll
        for (int kt = 0; kt < 8; ++kt) { rc[kt] = slab[(size_t)(chain * 8) * 4096 + kt * 512 + tid]; rn[kt] = rc[kt]; }
        for (int i = 0; i < seg; ++i) {
            const float* dd = dseg + (chain * 8 + i) * 128;
            if (i + 1 < seg) {
#pragma unroll
                for (int kt = 0; kt < 8; ++kt) rn[kt] = slab[(size_t)(chain * 8 + i + 1) * 4096 + kt * 512 + tid];
            }
#pragma unroll
            for (int kt = 0; kt < 8; ++kt) Sacc[kt] = Sacc[kt] * *(const f32x4*)(dd + 16 * kt + 4 * fq) + rc[kt];
#pragma unroll
            for (int kt = 0; kt < 8; ++kt) rc[kt] = rn[kt];
        }
    }
    seg_run<true>(lds, I, zb, lf, Sacc, segsum, gnr, mixb, rowb, nsteps, h);
    if (seg + 1 == nseg) {
        float* Sout = a.out + O_HSP + (size_t)chain * HD * HD;
#pragma unroll
        for (int kt = 0; kt < 8; ++kt)
#pragma unroll
            for (int j = 0; j < 4; ++j) Sout[(size_t)(16 * kt + 4 * fq + j) * HD + 16 * wave + fr] = Sacc[kt][j];
    }
}

__device__ __forceinline__ void phase2(LAS unsigned char* lds, const Args& a, int bid, int G, int parts = 7) {
    unsigned char* ws = a.ws;
    const bf16* zb = (const bf16*)(ws + WS_ZB); const float* lf = (const float*)(ws + WS_LF); bf16* mixb = (bf16*)(ws + WS_MIX);
    constexpr int NPC = NB * NH, NSC = DB * NH, NPOOL = (M / 64) * 4;
    const int nseg = (G >= 8 * NPC) ? 8 : (G >= 4 * NPC ? 4 : (G >= 2 * NPC ? 2 : 1));
    if ((parts & 1) && nseg > 1 && bid < nseg * NPC) prompt_pass1(lds, a, bid / nseg, bid % nseg, nseg);
#if P2_ORDER_OLD
    if (parts & 1) {
        if (nseg > 1) { if (bid < nseg * NPC) prompt_pass2(lds, a, bid / nseg, bid % nseg, nseg); }
        else for (int c = bid; c < NPC; c += G) prompt_pass2(lds, a, c, 0, 1);
    }
#endif
    STAMP(5);
    if (parts & 2) {
        SampleRegs cur, nxt;
        if (bid < NSC) sample_load(cur, a.in[3] + (size_t)bid * HD * HD);
        for (int it = bid; it < NSC; it += G) {
            const bool pf = it + G < NSC;
            SampleStage st; sample_stage(st, zb, lf, a.in[9], MP + (it / NH) * DS, it % NH);
            if (pf) sample_load(nxt, a.in[3] + (size_t)(it + G) * HD * HD);
            sample_run(lds, cur, st, zb, a.in[9], a.out + O_HSS + (size_t)it * HD * HD, mixb, MP + (it / NH) * DS, it % NH);
            if (pf) {
#pragma unroll
                for (int kk = 0; kk < 8; ++kk) cur.S[kk] = nxt.S[kk];
            }
        }
    }
    if (parts & 4) {
        const int first = (NSC + G - 1 - bid) / G * G + bid;
        if (first < NSC + NPOOL) {
            const int lane = threadIdx.x & 63, n0 = (threadIdx.x >> 6) * 32;
            const bf16* WpT = (const bf16*)(ws + WS_WP);
            bf16x8 wf[8][2];
            for (int it = first; it < NSC + NPOOL; it += G) {
                if (it == first || (G & 3)) {
                    const int g = (it - NSC) & 3;
#pragma unroll
                    for (int ks = 0; ks < 8; ++ks)
#pragma unroll
                        for (int nt = 0; nt < 2; ++nt) wf[ks][nt] = *(const bf16x8*)(WpT + (size_t)(g * 256 + n0 + nt * 16 + (lane & 15)) * 256 + ks * 32 + (lane >> 4) * 8);
                }
                pool_item(lds, it - NSC, zb, a.in[2], wf, mixb);
            }
        }
    }
    STAMP(6);
    if (!P2_ORDER_OLD && (parts & 1)) {
        if (nseg > 1) { if (bid < nseg * NPC) prompt_pass2(lds, a, bid / nseg, bid % nseg, nseg); }
        else for (int c = bid; c < NPC; c += G) prompt_pass2(lds, a, c, 0, 1);
    }
}

__device__ __forceinline__ void phase6(const Args& a, int vcu, int G, size_t x2off) {
    const int tid = threadIdx.x, lane = tid & 63, wave = tid >> 6;
#ifdef TPROBE
    { unsigned d = *((const unsigned*)(a.ws + WS_CTL) + CW_TP); if (TP_MODE == 2) d = 0x40000000u - d;
#ifdef TP_CAL
      d = TP_REF_US * 95;
#endif
      const float delta = 0.01f * ((float)d * 0.01f) / (float)(TP_REF_US);
      for (int i = vcu * (NWAVES * 64) + tid; i < NB * PC * PW; i += G * NWAVES * 64) a.out[O_PSP + i] += delta; }
#endif
    const int gw = vcu * NWAVES + wave, NGW = G * NWAVES;
    const float* rsq3 = (const float*)(a.ws + WS_CTL) + CW_RSQ3;
    for (int m = gw; m < M; m += NGW) {
        float* yr = a.out + O_Y + (size_t)m * D; const bf16* xr = (const bf16*)(a.ws + x2off) + (size_t)m * D;
        const float r = rsqrtf(rsq3[m] * (1.f / D) + EPS);
#pragma unroll
        for (int j = 0; j < 4; ++j) {
            const u32x4 xw = __builtin_nontemporal_load((const u32x4*)xr + lane + 64 * j);
            const f32x4 g0 = ((const f32x4*)a.in[15])[2 * (lane + 64 * j)], g1 = ((const f32x4*)a.in[15])[2 * (lane + 64 * j) + 1];
            __builtin_nontemporal_store((f32x4){bflo(xw.x), bfhi(xw.x), bflo(xw.y), bfhi(xw.y)} * r * g0, (f32x4*)yr + 2 * (lane + 64 * j));
            __builtin_nontemporal_store((f32x4){bflo(xw.z), bfhi(xw.z), bflo(xw.w), bfhi(xw.w)} * r * g1, (f32x4*)yr + 2 * (lane + 64 * j) + 1);
        }
    }
}

__global__ void __launch_bounds__(NWAVES * 64, 2) mega(Args a) {
    extern __shared__ __attribute__((aligned(16))) unsigned char lds_raw[];
    LAS unsigned char* lds = (LAS unsigned char*)lds_raw;
    const int G = gridDim.x, bid = blockIdx.x;
    const int vcu = (G % 8 == 0) ? (bid % 8) * (G / 8) + bid / 8 : bid;
    unsigned char* ws = a.ws;
    float* ctlf = (float*)(ws + WS_CTL);
    const int lo = a.ph_lo, hi = a.ph_hi;
#if ONE_LAUNCH && USE_CG
    cg::grid_group grid = cg::this_grid();
#define GRID_BAR() grid.sync()
#elif ONE_LAUNCH
    volatile LAS unsigned* MISC = (volatile LAS unsigned*)(lds + MISC_OFF);
    if (threadIdx.x < 32) MISC[threadIdx.x] = 0u;
    __syncthreads();
    XcdBarrier bar = xcd_barrier_post((unsigned*)(ws + WS_CTL) + CW_BAR, MISC + 8);
#define GRID_BAR() xcd_barrier(bar)
#else
#define GRID_BAR() do {} while (0)
#endif
#ifndef PH_MASK
#define PH_MASK 0x7f
#endif
#define IN(k) (((PH_MASK >> (k)) & 1) && lo <= (k) && (k) < hi)
#define BOTH(k) (IN(k) && IN((k) + 1))
#ifndef REP_MASK
#define REP_MASK 0
#endif
#define REP(k) ((REP_MASK >> (k)) & 1)
#ifndef P2_REP_PARTS
#define P2_REP_PARTS 7
#endif
    STAMP(0);
    if (IN(0)) { if (REP(0)) { phase0(lds, a, vcu, G); __syncthreads(); } phase0(lds, a, vcu, G); STAMP(1); if (BOTH(0)) GRID_BAR(); STAMP(2); }
    if (IN(1)) {
        pg8::Gemm g{(const bf16*)(ws + WS_XB), (const bf16*)(ws + WS_WIN), M, INC, D}; pg8::HybridOrder S; S.init(M, INC, D, G, bid, false);
        const pg8::TailCtx T{nullptr, nullptr};
        pg8::EpiZ E{(bf16*)(ws + WS_ZB), (float*)(ws + WS_LF), (const float*)(ws + WS_MISC), (const float*)(ws + WS_MISC) + M, a.out};
        if (REP(1)) pg8::gemm_phase2(lds, g, S, E, T);
        pg8::gemm_phase2(lds, g, S, E, T);
        { const int nidle = p1_idle_wgs(G); if (nidle >= 32 && bid >= G - nidle) phase0_deferred(lds, a, bid - (G - nidle), nidle); }
        STAMP(3);
        if (BOTH(1)) GRID_BAR();
        STAMP(4);
    }
    if (IN(2)) { if (REP(2)) { phase2(lds, a, bid, G, P2_REP_PARTS); __syncthreads(); } phase2(lds, a, bid, G); STAMP(7); if (BOTH(2)) GRID_BAR(); STAMP(8); }
    const bool merged = MERGED && G == 256 && lo <= 3 && hi >= 6;
    if (merged) {
        pg8::MOrder S{bid};
        constexpr pg8::StreamOff O{WS_MIX, WS_WO, WS_XB, WS_WGU, WS_ACT, WS_WD, WS_MIX, WS_SLABM, CW_DEP, CW_DEP + 4096, CW_TAIL, CW_RSQ2, CW_RSQ3};
        pg8::gemm_stream(lds, S, ws, a.in[0], a.in[1], O);
        STAMP(13);
#ifdef TPROBE
        if (threadIdx.x == 0) { volatile LAS unsigned long long* ts = (volatile LAS unsigned long long*)(lds + MISC_OFF + 128); const unsigned d = (unsigned)(ts[TP_B] - ts[TP_A]);
            unsigned* w = (unsigned*)(ws + WS_CTL) + CW_TP; if (TP_MODE == 0) { if (bid == TP_BLOCK) atomicMax(w, d); } else if (TP_MODE == 1) atomicMax(w, d); else atomicMax(w, 0x40000000u - d); }
#endif
        GRID_BAR();
    }
    if (!merged && IN(3)) {
        pg8::Gemm g{(const bf16*)(ws + WS_MIX), (const bf16*)(ws + WS_WO), M, D, D}; pg8::HybridOrder S; S.init(M, D, D, G, bid, true);
        const pg8::TailCtx T{(f32x4*)(ws + WS_SLAB3), (unsigned*)(ws + WS_CTL) + CW_TAIL};
        if (REP(3)) { pg8::EpiX1<true> E0{a.in[0], a.in[1], a.out + O_Y, (bf16*)(ws + WS_XB), ctlf + CW_RSQ2, false}; pg8::gemm_phase2(lds, g, S, E0, T); }
        pg8::EpiX1<false> E{a.in[0], a.in[1], a.out + O_Y, (bf16*)(ws + WS_XB), ctlf + CW_RSQ2, false};
        pg8::gemm_phase2(lds, g, S, E, T);
        STAMP(9);
        if (BOTH(3)) GRID_BAR();
        STAMP(10);
    }
    if (!merged && IN(4)) {
        pg8::Gemm g{(const bf16*)(ws + WS_XB), (const bf16*)(ws + WS_WGU), M, 2 * DFF, D}; pg8::HybridOrder S; S.init(M, 2 * DFF, D, G, bid, true);
        const pg8::TailCtx T{(f32x4*)(ws + WS_SLAB45), (unsigned*)(ws + WS_CTL) + CW_TAIL + 8192};
        pg8::EpiAct E{(bf16*)(ws + WS_ACT), ctlf + CW_RSQ2, false};
        if (REP(4)) pg8::gemm_phase2(lds, g, S, E, T);
        pg8::gemm_phase2(lds, g, S, E, T);
        STAMP(11);
        if (BOTH(4)) GRID_BAR();
        STAMP(12);
    }
    if (!merged && IN(5)) {
        pg8::Gemm g{(const bf16*)(ws + WS_ACT), (const bf16*)(ws + WS_WD), M, D, DFF}; pg8::HybridOrder S; S.init(M, D, DFF, G, bid, true);
        const pg8::TailCtx T{(f32x4*)(ws + WS_SLAB45), (unsigned*)(ws + WS_CTL) + CW_TAIL + 16384};
        if (REP(5)) { pg8::EpiX2<true> E0{(bf16*)(ws + WS_X2B), ctlf + CW_RSQ3, (const bf16*)(ws + WS_XB)}; pg8::gemm_phase2(lds, g, S, E0, T); }
        pg8::EpiX2<false> E{(bf16*)(ws + WS_X2B), ctlf + CW_RSQ3, (const bf16*)(ws + WS_XB)};
        pg8::gemm_phase2(lds, g, S, E, T);
        STAMP(13);
#ifdef TPROBE
        if (threadIdx.x == 0) { volatile LAS unsigned long long* ts = (volatile LAS unsigned long long*)(lds + MISC_OFF + 128); const unsigned d = (unsigned)(ts[TP_B] - ts[TP_A]);
            unsigned* w = (unsigned*)(ws + WS_CTL) + CW_TP; if (TP_MODE == 0) { if (bid == TP_BLOCK) atomicMax(w, d); } else if (TP_MODE == 1) atomicMax(w, d); else atomicMax(w, 0x40000000u - d); }
#endif
        if (BOTH(5)) GRID_BAR();
    }
    if (IN(6)) phase6(a, vcu, G, merged ? WS_MIX : WS_X2B);
#undef IN
#undef BOTH
}

extern "C" void kernel_launch(void* const* d_in, const int* in_sizes, int n_in, void* d_out, int out_size, void* d_ws, size_t ws_size, hipStream_t stream) {
    static int grid = 0;
    if (grid == 0) {
        if (n_in != 16 || ws_size < WS_END) { fprintf(stderr, "kernel_launch: unexpected n_in %d / ws_size %zu\n", n_in, ws_size); grid = -1; return; }
        int dev = 0, cus = 0, per_cu = 0;
        hipGetDevice(&dev);
        hipDeviceGetAttribute(&cus, hipDeviceAttributeMultiprocessorCount, dev);
        hipFuncSetAttribute((const void*)mega, hipFuncAttributeMaxDynamicSharedMemorySize, LDS_BYTES);
        hipOccupancyMaxActiveBlocksPerMultiprocessor(&per_cu, (const void*)mega, NWAVES * 64, LDS_BYTES);
        if (per_cu < 1) { fprintf(stderr, "kernel_launch: occupancy query says %d blocks per CU\n", per_cu); grid = -1; return; }
        grid = cus;
#ifdef FORCE_GRID
        grid = FORCE_GRID;
#endif
    }
    if (grid < 0) return;
    hipMemsetAsync((char*)d_ws + WS_CTL + (size_t)CW_BAR * 4, 0, XCD_BAR_WORDS * 4, stream);
#ifdef EXTRA_MEMSET
    hipMemsetAsync((char*)d_ws + WS_END - 8192, 0, 4096, stream);
#endif
    Args a{};
    for (int i = 0; i < 16; ++i) a.in[i] = (const float*)d_in[i];
    a.out = (float*)d_out; a.ws = (unsigned char*)d_ws;
#if ONE_LAUNCH
    a.ph_lo = 0; a.ph_hi = NPHASE;
    void* args[] = {&a};
#if USE_CG
    hipError_t e = hipLaunchCooperativeKernel((const void*)mega, dim3(grid), dim3(NWAVES * 64), args, LDS_BYTES, stream);
    if (e != hipSuccess) fprintf(stderr, "cooperative launch failed: %s (grid %d)\n", hipGetErrorString(e), grid);
#else
    (void)args; hipLaunchKernelGGL(mega, dim3(grid), dim3(NWAVES * 64), LDS_BYTES, stream, a);
#endif
#else
    for (int p = 0; p < NPHASE; ++p) { a.ph_lo = p; a.ph_hi = p + 1; hipLaunchKernelGGL(mega, dim3(grid), dim3(NWAVES * 64), LDS_BYTES, stream, a); }
#endif
}
```

```cpp
#include <hip/hip_runtime.h>
#include <hip/hip_cooperative_groups.h>
#include <cstdio>
#include <cstdint>
namespace cg = cooperative_groups;

constexpr int D = 2048, NB = 4, SEQ = 2048, DB = 128, DS = 8;
constexpr int MP = NB * SEQ, MS = DB * DS, M = MP + MS;
constexpr int PW = 1024, HW = 1024, HD = 128, NH = 8, PC = 15;
constexpr int DFF = 5632, INC = 5120;
constexpr float EPS = 1e-6f;
constexpr size_t O_Y = 0;
constexpr size_t O_PSP = (size_t)M * D;
constexpr size_t O_HSP = O_PSP + (size_t)NB * PC * PW;
constexpr size_t O_PSS = O_HSP + (size_t)NB * NH * HD * HD;
constexpr size_t O_HSS = O_PSS + (size_t)DB * PC * PW;

namespace pg8 {
#define PG8_LAS __attribute__((address_space(3)))
typedef unsigned short bf16_t;
typedef short bf16x8 __attribute__((ext_vector_type(8)));
typedef float f32x4 __attribute__((ext_vector_type(4)));
typedef unsigned u32x4 __attribute__((ext_vector_type(4)));
constexpr int BM = 256, BK = 64, HALF = 128, HTB = HALF * BK * 2  , STAGE_BYTES = 8 * HTB, NXCD = 8, WGM = 8;

__host__ __device__ __forceinline__ int lds_byte(int r, int c) { const int st = (r >> 4) * 2 + (c >> 5), rr = r & 15, cc = c & 31, ob = rr * 64 + cc * 2; return st * 1024 + (ob ^ (((ob >> 9) & 1) << 5)); }
__host__ __device__ __forceinline__ void stage_rc(int b, int& R, int& C) { const int st = b / 1024, sb = b % 1024, swz = sb ^ (((sb >> 9) & 1) << 5); R = (st >> 1) * 16 + swz / 64; C = (st & 1) * 32 + (swz % 64) / 2; }
__host__ __device__ __forceinline__ int perm32(int rho) { const int n = rho >> 4, i = rho & 15; return 8 * (i >> 2) + 4 * n + (i & 3); }

struct Unit { int pm, pn, kb, nk, tinfo; };
struct Gemm { const bf16_t* A; const bf16_t* Bt; int M, N, K; };

struct StaticOrder {
    int nM, nN, nwg, G, c;
    __host__ __device__ void init(int M, int N, int G_, int c_) { nM = M / BM; nN = N / BM; nwg = nM * nN; G = G_; c = c_; }
    __host__ __device__ bool next(int i, Unit& u) const {
        const long L = (long)i * G + c; if (L >= nwg) return false;
        int wgid = (int)L; { const int q = nwg / NXCD, r = nwg % NXCD, xcd = wgid % NXCD, off = wgid / NXCD; wgid = (xcd < r ? xcd * (q + 1) : r * (q + 1) + (xcd - r) * q) + off; }
        const int nig = WGM * nN, gid = wgid / nig, fm = gid * WGM, gsz = (nM - fm) < WGM ? (nM - fm) : WGM;
        u.pm = fm + ((wgid % nig) % gsz); u.pn = (wgid % nig) / gsz; u.kb = 0; u.nk = 0; u.tinfo = -1; return true;
    }
    __device__ __forceinline__ void a_ready(const Unit&) const {}
    __device__ __forceinline__ void done(const Unit&) const {}
};
typedef __bf16 bf16x2_hw __attribute__((ext_vector_type(2)));
typedef float f32x2_hw __attribute__((ext_vector_type(2)));
__device__ __forceinline__ unsigned cvt_pk_bf16(float lo, float hi) { const f32x2_hw v = {lo, hi}; return __builtin_bit_cast(unsigned, __builtin_convertvector(v, bf16x2_hw)); }
__device__ __forceinline__ float sigm(float x) { return __builtin_amdgcn_rcpf(1.f + __expf(-x)); }
__device__ __forceinline__ float silu(float x) { return x * __builtin_amdgcn_rcpf(1.f + __expf(-x)); }
typedef unsigned u32x2 __attribute__((ext_vector_type(2)));
__device__ __forceinline__ float bflo_(unsigned w) { return __builtin_bit_cast(float, w << 16); }
__device__ __forceinline__ float bfhi_(unsigned w) { return __builtin_bit_cast(float, w & 0xffff0000u); }

struct EpiZ {
    static constexpr bool PERM = true, AFTER_DRAIN = false;
    bf16_t* zb; float* lf; const float* rstd1; const float* lbv; float* out;
    __device__ __forceinline__ void prefetch(const Unit& u, int wr, int fr, float (&p)[8]) const {
#pragma unroll
        for (int i = 0; i < 8; ++i) p[i] = rstd1[u.pm * BM + wr * 64 + fr + (i >> 2) * HALF + (i & 3) * 16];
    }
    __device__ __forceinline__ void operator()(const f32x4 (&acc)[2][2][4][2], const Unit& u, int wr, int wc, int fr, int fq, unsigned gmask = 0xffu, const float* pre = nullptr) const {
        const int kind = u.pn >> 2;
        const int row0 = u.pm * BM + wr * 64 + fr;
        const int cc0 = (u.pn & 3) * 256 + wc * 32 + 8 * fq;
        f32x4 lb[2][2];
        if (kind == 2) {
#pragma unroll
            for (int bj = 0; bj < 2; ++bj)
#pragma unroll
                for (int n = 0; n < 2; ++n) lb[bj][n] = *(const f32x4*)(lbv + cc0 + bj * HALF + 4 * n);
        }
#pragma unroll
        for (int ai = 0; ai < 2; ++ai)
#pragma unroll
            for (int m = 0; m < 4; ++m) {
                if (!((gmask >> (ai * 4 + m)) & 1u)) continue;
                const int row = row0 + ai * HALF + m * 16;
                const float r = pre ? pre[ai * 4 + m] : rstd1[row];
#pragma unroll
                for (int bj = 0; bj < 2; ++bj) {
                    const int cc = cc0 + bj * HALF;
                    f32x4 v0 = acc[ai][bj][m][0] * r, v1 = acc[ai][bj][m][1] * r;
                    if (kind == 2) {
#pragma unroll
                        for (int j = 0; j < 4; ++j) {
                            const float f0 = lb[bj][0][j] + (1.f - lb[bj][0][j]) * sigm(v0[j]), f1 = lb[bj][1][j] + (1.f - lb[bj][1][j]) * sigm(v1[j]);
                            v0[j] = __log2f(f0); v1[j] = __log2f(f1);
                        }
                        float* p = lf + (size_t)row * HW + cc;
                        *(f32x4*)p = v0; *(f32x4*)(p + 4) = v1;

                    } else {
                        if (kind == 0) {
                            float* dst = nullptr;
                            if (row >= MP) { const int ms = row - MP; dst = out + O_PSS + ((size_t)(ms >> 3) * PC + 7 + (ms & 7)) * PW + cc; }
                            else { const int t = row & (SEQ - 1); if (t >= SEQ - PC) dst = out + O_PSP + ((size_t)(row >> 11) * PC + (t - (SEQ - PC))) * PW + cc; }
                            if (dst) { *(f32x4*)dst = v0; *(f32x4*)(dst + 4) = v1; }
                        }
                        if (kind == 1 || kind == 4) {
#pragma unroll
                            for (int j = 0; j < 4; ++j) { v0[j] = silu(v0[j]); v1[j] = silu(v1[j]); }
                        }
                        u32x4 w; w.x = cvt_pk_bf16(v0[0], v0[1]); w.y = cvt_pk_bf16(v0[2], v0[3]); w.z = cvt_pk_bf16(v1[0], v1[1]); w.w = cvt_pk_bf16(v1[2], v1[3]);
                        *(u32x4*)(zb + (size_t)row * INC + kind * 1024 + cc) = w;
                    }
                }
            }
    }
};

__device__ __forceinline__ void store16(bf16_t* base, size_t elem_off, u32x4 w, bool wt) {
    if (wt) { const __amdgpu_buffer_rsrc_t r = __builtin_amdgcn_make_buffer_rsrc((void*)base, (short)0, 0x7fffffff, 0x00020000); __builtin_amdgcn_raw_buffer_store_b128(w, r, (unsigned)(elem_off * 2), 0, 16); }
    else *(u32x4*)(base + elem_off) = w;
}
template <bool DRY = false> struct EpiX1 {
    static constexpr bool PERM = true, AFTER_DRAIN = false;
    const float* xp; const float* xs; float* y; bf16_t* x1b; float* rowsq; bool wt;
    __device__ __forceinline__ void operator()(const f32x4 (&acc)[2][2][4][2], const Unit& u, int wr, int wc, int fr, int fq, unsigned gmask = 0xffu) const {
        const int row0 = u.pm * BM + wr * 64 + fr, col0 = u.pn * BM + wc * 32 + 8 * fq;
#pragma unroll
        for (int ai = 0; ai < 2; ++ai)
#pragma unroll
            for (int m = 0; m < 4; ++m) {
                if (!((gmask >> (ai * 4 + m)) & 1u)) continue;
                const int row = row0 + ai * HALF + m * 16;
                const float* xr = (row < MP ? xp + (size_t)row * D : xs + (size_t)(row - MP) * D) + col0;
                float s = 0.f;
#pragma unroll
                for (int bj = 0; bj < 2; ++bj) {
                    const f32x4 v0 = __builtin_nontemporal_load((const f32x4*)(xr + bj * HALF)) + acc[ai][bj][m][0], v1 = __builtin_nontemporal_load((const f32x4*)(xr + bj * HALF + 4)) + acc[ai][bj][m][1];
                    u32x4 w; w.x = cvt_pk_bf16(v0[0], v0[1]); w.y = cvt_pk_bf16(v0[2], v0[3]); w.z = cvt_pk_bf16(v1[0], v1[1]); w.w = cvt_pk_bf16(v1[2], v1[3]);
                    store16(x1b, (size_t)row * D + col0 + bj * HALF, w, wt);
                    s += (v0[0] * v0[0] + v0[1] * v0[1]) + (v0[2] * v0[2] + v0[3] * v0[3]) + (v1[0] * v1[0] + v1[1] * v1[1]) + (v1[2] * v1[2] + v1[3] * v1[3]);
                }
                s += __shfl_xor(s, 16); s += __shfl_xor(s, 32);
                if (fq == 0 && !DRY) atomicAdd(rowsq + row, s);
            }
    }
};

struct EpiAct {
    static constexpr bool PERM = true, AFTER_DRAIN = false;
    bf16_t* act; const float* rowsq; bool wt;
    __device__ __forceinline__ void prefetch(const Unit& u, int wr, int fr, float (&p)[8]) const {
#pragma unroll
        for (int i = 0; i < 8; ++i) p[i] = rowsq[u.pm * BM + wr * 64 + fr + (i >> 2) * HALF + (i & 3) * 16];
    }
    __device__ __forceinline__ void operator()(const f32x4 (&acc)[2][2][4][2], const Unit& u, int wr, int wc, int fr, int fq, unsigned gmask = 0xffu, const float* pre = nullptr) const {
        const int row0 = u.pm * BM + wr * 64 + fr, col0 = u.pn * HALF + wc * 32 + 8 * fq;
#pragma unroll
        for (int ai = 0; ai < 2; ++ai)
#pragma unroll
            for (int m = 0; m < 4; ++m) {
                if (!((gmask >> (ai * 4 + m)) & 1u)) continue;
                const int row = row0 + ai * HALF + m * 16;
                const float r = rsqrtf((pre ? pre[ai * 4 + m] : rowsq[row]) * (1.f / D) + EPS);
                u32x4 w; unsigned* wp = (unsigned*)&w;
#pragma unroll
                for (int n = 0; n < 2; ++n) {
                    const f32x4 g = acc[ai][0][m][n] * r, up = acc[ai][1][m][n] * r;
                    f32x4 a;
#pragma unroll
                    for (int j = 0; j < 4; ++j) a[j] = silu(g[j]) * up[j];
                    wp[2 * n] = cvt_pk_bf16(a[0], a[1]); wp[2 * n + 1] = cvt_pk_bf16(a[2], a[3]);
                }
                store16(act, (size_t)row * DFF + col0, w, wt);
            }
    }
};

template <bool DRY = false> struct EpiX2 {
    static constexpr bool PERM = true, AFTER_DRAIN = false;
    bf16_t* x2b; float* rowsq; const bf16_t* x1b;
    __device__ __forceinline__ void operator()(const f32x4 (&acc)[2][2][4][2], const Unit& u, int wr, int wc, int fr, int fq, unsigned gmask = 0xffu) const {
        const int row0 = u.pm * BM + wr * 64 + fr, col0 = u.pn * BM + wc * 32 + 8 * fq;
#pragma unroll
        for (int ai = 0; ai < 2; ++ai)
#pragma unroll
            for (int m = 0; m < 4; ++m) {
                if (!((gmask >> (ai * 4 + m)) & 1u)) continue;
                const int row = row0 + ai * HALF + m * 16;
                float s = 0.f;
#pragma unroll
                for (int bj = 0; bj < 2; ++bj) {
                    const u32x4 xw = *(const u32x4*)(x1b + (size_t)row * D + col0 + bj * HALF);
                    f32x4 v0 = (f32x4){bflo_(xw.x), bfhi_(xw.x), bflo_(xw.y), bfhi_(xw.y)} + acc[ai][bj][m][0];
                    f32x4 v1 = (f32x4){bflo_(xw.z), bfhi_(xw.z), bflo_(xw.w), bfhi_(xw.w)} + acc[ai][bj][m][1];
                    u32x4 w; w.x = cvt_pk_bf16(v0[0], v0[1]); w.y = cvt_pk_bf16(v0[2], v0[3]); w.z = cvt_pk_bf16(v1[0], v1[1]); w.w = cvt_pk_bf16(v1[2], v1[3]);
                    *(u32x4*)(x2b + (size_t)row * D + col0 + bj * HALF) = w;
                    s += (v0[0] * v0[0] + v0[1] * v0[1]) + (v0[2] * v0[2] + v0[3] * v0[3]) + (v1[0] * v1[0] + v1[1] * v1[1]) + (v1[2] * v1[2] + v1[3] * v1[3]);
                }
                s += __shfl_xor(s, 16); s += __shfl_xor(s, 32);
                if (fq == 0 && !DRY) atomicAdd(rowsq + row, s);
            }
    }
};
template <class Epi, class Sched, bool ALIGN_EPI = false, bool SP2 = false>
__device__ __forceinline__ void gemm_phase(PG8_LAS unsigned char* lds, const Gemm g, const Sched& S, const Epi& E) {
    int tid_ = threadIdx.x; asm volatile("" : "+v"(tid_));
    const int tid = tid_, wid = __builtin_amdgcn_readfirstlane(tid >> 6), lane = tid & 63, wr = wid >> 2, wc = wid & 3, fr = lane & 15, fq = lane >> 4;
    const int K = g.K, nt = K / BK;
    unsigned voffA[2], voffB[2];
#pragma unroll
    for (int i = 0; i < 2; ++i) { int R, C; stage_rc(tid * 16 + i * 8192, R, C); const int Rb = Epi::PERM ? ((R & ~31) + perm32(R & 31)) : R;
        voffA[i] = (unsigned)(R * K + C) * 2u; voffB[i] = (unsigned)(Rb * K + C) * 2u; }
    const size_t kstep = (size_t)(BK * 2);
    const size_t hstep = (size_t)HALF * K * 2;
    const size_t tstep = 2 * hstep;
    const unsigned ldsw = (unsigned)wid * 1024u;
    const int aoff = lds_byte(wr * 64 + fr, fq * 8), boff = lds_byte(wc * 32 + fr, fq * 8);
#define PG8_SA(b, h) (((b) * 2 + (h)) * HTB)
#define PG8_SB(b, h) ((4 + (b) * 2 + (h)) * HTB)
#define PG8_STAGE(bufoff, gbase, voff) do { _Pragma("unroll") for (int _i = 0; _i < 2; ++_i) \
        __builtin_amdgcn_global_load_lds((const unsigned*)((const char*)(gbase) + (voff)[_i]), (PG8_LAS unsigned*)(lds + (bufoff) + ldsw + _i * 8192), 16, 0, 0); } while (0)
#define PG8_LDA(dst, b, h) do { _Pragma("unroll") for (int m = 0; m < 4; ++m) _Pragma("unroll") for (int k = 0; k < 2; ++k) dst[m][k] = *(const PG8_LAS bf16x8*)(lds + PG8_SA(b, h) + aoff + m * 2048 + k * 1024); } while (0)
#define PG8_LDB(dst, b, h) do { _Pragma("unroll") for (int n = 0; n < 2; ++n) _Pragma("unroll") for (int k = 0; k < 2; ++k) dst[n][k] = *(const PG8_LAS bf16x8*)(lds + PG8_SB(b, h) + boff + n * 2048 + k * 1024); } while (0)
#define PG8_MMA(ai, bj, At, Bt) do { __builtin_amdgcn_s_setprio(1); _Pragma("unroll") for (int m = 0; m < 4; ++m) _Pragma("unroll") for (int n = 0; n < 2; ++n) _Pragma("unroll") for (int k = 0; k < 2; ++k) \
        acc[ai][bj][m][n] = __builtin_amdgcn_mfma_f32_16x16x32_bf16(Bt[n][k], At[m][k], acc[ai][bj][m][n], 0, 0, 0); __builtin_amdgcn_s_setprio(0); } while (0)
#define PG8_WAIT_V(n) asm volatile("s_waitcnt vmcnt(" #n ")" ::: "memory")
#define PG8_WAIT_L(n) asm volatile("s_waitcnt lgkmcnt(" #n ")" ::: "memory")
#define PG8_BAR __builtin_amdgcn_s_barrier()
#define PG8_SCHED __builtin_amdgcn_sched_barrier(0)
    Unit cur, nxt; int ui = 0;
    if (!S.next(0, cur)) return;
    f32x4 acc[2][2][4][2];
#pragma unroll
    for (int a = 0; a < 2; ++a)
#pragma unroll
        for (int b = 0; b < 2; ++b)
#pragma unroll
            for (int m = 0; m < 4; ++m)
#pragma unroll
                for (int n = 0; n < 2; ++n) acc[a][b][m][n] = (f32x4){0.f, 0.f, 0.f, 0.f};
    bf16x8 At[4][2], B0[2][2], B1[2][2];
    const char* cA = (const char*)g.A + (size_t)cur.pm * tstep; const char* cB = (const char*)g.Bt + (size_t)cur.pn * tstep;
    S.a_ready(cur);
    if constexpr (SP2) {
        PG8_STAGE(PG8_SB(0, 0), cB, voffB); PG8_STAGE(PG8_SB(0, 1), cB + hstep, voffB); PG8_STAGE(PG8_SA(0, 0), cA, voffA); PG8_STAGE(PG8_SA(0, 1), cA + hstep, voffA);
        if (wr == 1) PG8_BAR;
        PG8_WAIT_V(2); PG8_BAR;
        PG8_STAGE(PG8_SB(1, 0), cB + kstep, voffB); PG8_STAGE(PG8_SA(1, 0), cA + kstep, voffA); PG8_STAGE(PG8_SB(1, 1), cB + hstep + kstep, voffB);
        PG8_WAIT_V(6); PG8_BAR;
    } else {
        PG8_STAGE(PG8_SB(0, 0), cB, voffB); PG8_STAGE(PG8_SA(0, 0), cA, voffA); PG8_STAGE(PG8_SB(0, 1), cB + hstep, voffB); PG8_STAGE(PG8_SA(0, 1), cA + hstep, voffA);
        if (wr == 1) PG8_BAR;
        PG8_WAIT_V(4); PG8_BAR;
        PG8_STAGE(PG8_SB(1, 0), cB + kstep, voffB); PG8_STAGE(PG8_SA(1, 0), cA + kstep, voffA); PG8_STAGE(PG8_SB(1, 1), cB + hstep + kstep, voffB);
        PG8_WAIT_V(6); PG8_BAR;
    }
    for (;;) {
        const bool has_next = S.next(ui + 1, nxt);
        const char* nA = has_next ? (const char*)g.A + (size_t)nxt.pm * tstep : cA; const char* nB = has_next ? (const char*)g.Bt + (size_t)nxt.pn * tstep : cB;
        for (int t = 0; t < nt; t += 2) {
            const bool last = (t == nt - 2);
            const char* a1 = cA + (size_t)(t + 1) * kstep;
            const char* a2 = last ? nA : cA + (size_t)(t + 2) * kstep; const char* b2 = last ? nB : cB + (size_t)(t + 2) * kstep;
            const char* a3 = a2 + kstep; const char* b3 = b2 + kstep;
            if (last && has_next) S.a_ready(nxt);
            if constexpr (SP2) {
            PG8_LDB(B0, 0, 0); PG8_LDB(B1, 0, 1); PG8_SCHED; PG8_LDA(At, 0, 0); PG8_STAGE(PG8_SA(1, 1), a1 + hstep, voffA);
            PG8_WAIT_V(8); PG8_WAIT_L(0); PG8_BAR; PG8_MMA(0, 0, At, B0); PG8_MMA(0, 1, At, B1); PG8_BAR; PG8_SCHED;
            PG8_LDA(At, 0, 1); PG8_STAGE(PG8_SB(0, 0), b2, voffB); PG8_STAGE(PG8_SB(0, 1), b2 + hstep, voffB); PG8_STAGE(PG8_SA(0, 0), a2, voffA);
            PG8_WAIT_V(8); PG8_WAIT_L(0); PG8_BAR; PG8_MMA(1, 0, At, B0); PG8_MMA(1, 1, At, B1); PG8_BAR; PG8_SCHED;
            PG8_LDB(B0, 1, 0); PG8_LDB(B1, 1, 1); PG8_SCHED; PG8_LDA(At, 1, 0); PG8_STAGE(PG8_SA(0, 1), a2 + hstep, voffA);
            PG8_WAIT_V(8); PG8_WAIT_L(0); PG8_BAR; PG8_MMA(0, 0, At, B0); PG8_MMA(0, 1, At, B1); PG8_BAR; PG8_SCHED;
            PG8_LDA(At, 1, 1); PG8_STAGE(PG8_SB(1, 0), b3, voffB); PG8_STAGE(PG8_SB(1, 1), b3 + hstep, voffB); PG8_STAGE(PG8_SA(1, 0), a3, voffA);
            PG8_WAIT_V(8); PG8_WAIT_L(0); PG8_BAR; PG8_MMA(1, 0, At, B0); PG8_MMA(1, 1, At, B1); PG8_BAR; PG8_SCHED;
            } else {
            PG8_LDB(B0, 0, 0); PG8_SCHED; PG8_LDA(At, 0, 0); PG8_STAGE(PG8_SA(1, 1), a1 + hstep, voffA);
            PG8_WAIT_L(8); PG8_BAR; PG8_WAIT_L(0); PG8_MMA(0, 0, At, B0); PG8_BAR; PG8_SCHED;
            PG8_LDB(B1, 0, 1); PG8_STAGE(PG8_SB(0, 0), b2, voffB);
            PG8_BAR; PG8_WAIT_L(0); PG8_MMA(0, 1, At, B1); PG8_BAR;
            PG8_LDA(At, 0, 1); PG8_STAGE(PG8_SA(0, 0), a2, voffA);
            PG8_BAR; PG8_WAIT_L(0); PG8_MMA(1, 0, At, B0); PG8_BAR; PG8_SCHED;
            PG8_STAGE(PG8_SB(0, 1), b2 + hstep, voffB);
            PG8_WAIT_V(6); PG8_BAR; PG8_MMA(1, 1, At, B1); PG8_BAR;
            PG8_LDB(B0, 1, 0); PG8_SCHED; PG8_LDA(At, 1, 0); PG8_STAGE(PG8_SA(0, 1), a2 + hstep, voffA);
            PG8_WAIT_L(8); PG8_BAR; PG8_WAIT_L(0); PG8_MMA(0, 0, At, B0); PG8_BAR; PG8_SCHED;
            PG8_LDB(B1, 1, 1); PG8_STAGE(PG8_SB(1, 0), b3, voffB);
            PG8_BAR; PG8_WAIT_L(0); PG8_MMA(0, 1, At, B1); PG8_BAR;
            PG8_LDA(At, 1, 1); PG8_STAGE(PG8_SA(1, 0), a3, voffA);
            PG8_BAR; PG8_WAIT_L(0); PG8_MMA(1, 0, At, B0); PG8_BAR; PG8_SCHED;
            PG8_STAGE(PG8_SB(1, 1), b3 + hstep, voffB);
            PG8_WAIT_V(6); PG8_BAR; PG8_MMA(1, 1, At, B1); PG8_BAR;
            }
        }
        if constexpr (ALIGN_EPI) { if (wr == 0) PG8_BAR; }
        if constexpr (!Epi::AFTER_DRAIN) { E(acc, cur, wr, wc, fr, fq); S.done(cur); }
        if (!has_next) break;
#pragma unroll
        for (int a = 0; a < 2; ++a)
#pragma unroll
            for (int b = 0; b < 2; ++b)
#pragma unroll
                for (int m = 0; m < 4; ++m)
#pragma unroll
                    for (int n = 0; n < 2; ++n) acc[a][b][m][n] = (f32x4){0.f, 0.f, 0.f, 0.f};
        cur = nxt; cA = nA; cB = nB; ++ui;
        if constexpr (ALIGN_EPI) { if (wr == 1) PG8_BAR; }
    }
    PG8_WAIT_V(0);
    if constexpr (!ALIGN_EPI) { if (wr == 0) PG8_BAR; }
    PG8_BAR;
    if constexpr (Epi::AFTER_DRAIN) { E.fused(acc, cur, wr, wc, fr, fq, lds, wid, lane); S.done(cur); }
#undef PG8_SA
#undef PG8_SB
#undef PG8_STAGE
#undef PG8_LDA
#undef PG8_LDB
#undef PG8_MMA
#undef PG8_WAIT_V
#undef PG8_WAIT_L
#undef PG8_BAR
#undef PG8_SCHED
}

struct HybridOrder {
    int nM, nN, nwg, G, c, nt, nfull, R, ns;
    __device__ __forceinline__ void init(int M, int N, int K, int G_, int c_, bool allow_split) {
        nM = M / BM; nN = N / BM; nwg = nM * nN; G = G_; c = c_; nt = K / BK; nfull = nwg / G; R = nwg - nfull * G;
        ns = (allow_split && R > 0 && (R % 8) == 0 && (G % 8) == 0) ? G / R : 1; if (ns > 8) ns = 8; if (ns > nt / 2) ns = nt / 2; if (ns < 2) ns = 1;
    }
    __device__ __forceinline__ void map(int L, Unit& u) const {
        int wgid = L; { const int q = nwg / NXCD, r = nwg % NXCD, xcd = wgid % NXCD, off = wgid / NXCD; wgid = (xcd < r ? xcd * (q + 1) : r * (q + 1) + (xcd - r) * q) + off; }
        const int nig = WGM * nN, gid = wgid / nig, fm = gid * WGM, gsz = (nM - fm) < WGM ? (nM - fm) : WGM;
        u.pm = fm + ((wgid % nig) % gsz); u.pn = (wgid % nig) / gsz;
    }
    __device__ __forceinline__ bool next(int i, Unit& u) const {
        if (i < nfull) { map(i * G + c, u); u.kb = 0; u.nk = nt; u.tinfo = -1; return true; }
        if (i > nfull || R == 0) return false;
        if (ns < 2) { const int L = i * G + c; if (L >= nwg) return false; map(L, u); u.kb = 0; u.nk = nt; u.tinfo = -1; return true; }
        const int x = c % 8, y = c / 8, tj = (y / ns) * 8 + x, slice = y % ns;
        if (tj >= R) return false;
        map(nfull * G + tj, u);
        const int pairs = nt / 2, base = pairs / ns, rem = pairs % ns, start = slice * base + (slice < rem ? slice : rem), mine = base + (slice < rem ? 1 : 0);
        u.kb = 2 * start; u.nk = 2 * mine; u.tinfo = (tj << 8) | (slice << 4) | ns; return true;
    }
};
struct TailCtx { f32x4* slab; unsigned* cnt; };

template <class Epi>
__device__ __forceinline__ void tail_fixup(f32x4 (&acc)[2][2][4][2], const Unit& u, const Epi& E, const TailCtx& T, int tid, int wr, int wc, int fr, int fq) {
    const int tj = u.tinfo >> 8, slice = (u.tinfo >> 4) & 15, ns = u.tinfo & 15;
    const __amdgpu_buffer_rsrc_t srs = __builtin_amdgcn_make_buffer_rsrc((void*)(T.slab + (size_t)(tj * ns + slice) * (32 * 512)), (short)0, 32 * 512 * 16, 0x00020000);
#pragma unroll
    for (int ai = 0; ai < 2; ++ai)
#pragma unroll
        for (int bj = 0; bj < 2; ++bj)
#pragma unroll
            for (int m = 0; m < 4; ++m)
#pragma unroll
                for (int n = 0; n < 2; ++n) __builtin_amdgcn_raw_buffer_store_b128(__builtin_bit_cast(u32x4, acc[ai][bj][m][n]), srs, (unsigned)(((((ai * 2 + bj) * 4 + m) * 2 + n) * 512 + tid) * 16), 0, 16);
    asm volatile("s_waitcnt vmcnt(0)" ::: "memory");
    __syncthreads();
    if (tid == 0) __hip_atomic_fetch_add(T.cnt + 64 * tj, 1u, __ATOMIC_RELAXED, __HIP_MEMORY_SCOPE_AGENT);
    if (tid < 64) {
        unsigned sp = 0;
        while (__hip_atomic_load(T.cnt + 64 * tj, __ATOMIC_RELAXED, __HIP_MEMORY_SCOPE_AGENT) < (unsigned)ns && ++sp < (1u << 22)) __builtin_amdgcn_s_sleep(2);
        __builtin_amdgcn_fence(__ATOMIC_ACQUIRE, "agent");
        asm volatile("s_waitcnt vmcnt(0)" ::: "memory");
    }
    __syncthreads();
    unsigned gmask = 0u;
    for (int g = slice; g < 8; g += ns) gmask |= 1u << g;
    const f32x4* tile = T.slab + (size_t)(tj * ns) * (32 * 512);
#pragma unroll
    for (int ai = 0; ai < 2; ++ai)
#pragma unroll
        for (int m = 0; m < 4; ++m) {
            if (!((gmask >> (ai * 4 + m)) & 1u)) continue;
#pragma unroll
            for (int bj = 0; bj < 2; ++bj)
#pragma unroll
                for (int n = 0; n < 2; ++n) {
                    const int idx = ((ai * 2 + bj) * 4 + m) * 2 + n;
                    f32x4 v = tile[idx * 512 + tid];
                    for (int sl = 1; sl < ns; ++sl) v = v + tile[(size_t)sl * (32 * 512) + idx * 512 + tid];
                    acc[ai][bj][m][n] = v;
                }
        }
    E(acc, u, wr, wc, fr, fq, gmask);
}

template <class Epi, class Sched>
__device__ __forceinline__ void gemm_phase2(PG8_LAS unsigned char* lds, const Gemm g, const Sched& S, const Epi& E, const TailCtx& T) {
    int tid_ = threadIdx.x; asm volatile("" : "+v"(tid_));
    const int tid = tid_, wid = __builtin_amdgcn_readfirstlane(tid >> 6), lane = tid & 63, wr = wid >> 2, wc = wid & 3, fr = lane & 15, fq = lane >> 4;
    const int K = g.K;
    unsigned voffA[2], voffB[2];
#pragma unroll
    for (int i = 0; i < 2; ++i) { int R, C; stage_rc(tid * 16 + i * 8192, R, C); const int Rb = Epi::PERM ? ((R & ~31) + perm32(R & 31)) : R;
        voffA[i] = (unsigned)(R * K + C) * 2u; voffB[i] = (unsigned)(Rb * K + C) * 2u; }
    const size_t kstep = (size_t)(BK * 2), hstep = (size_t)HALF * K * 2, tstep = 2 * hstep;
    const unsigned ldsw = (unsigned)wid * 1024u;
    const int aoff = lds_byte(wr * 64 + fr, fq * 8), boff = lds_byte(wc * 32 + fr, fq * 8);
#define PG8_SA(b, h) (((b) * 2 + (h)) * HTB)
#define PG8_SB(b, h) ((4 + (b) * 2 + (h)) * HTB)
#define PG8_STAGE(bufoff, gbase, voff) do { _Pragma("unroll") for (int _i = 0; _i < 2; ++_i) \
        __builtin_amdgcn_global_load_lds((const unsigned*)((const char*)(gbase) + (voff)[_i]), (PG8_LAS unsigned*)(lds + (bufoff) + ldsw + _i * 8192), 16, 0, 0); } while (0)
#define PG8_LDA(dst, b, h) do { _Pragma("unroll") for (int m = 0; m < 4; ++m) _Pragma("unroll") for (int k = 0; k < 2; ++k) dst[m][k] = *(const PG8_LAS bf16x8*)(lds + PG8_SA(b, h) + aoff + m * 2048 + k * 1024); } while (0)
#define PG8_LDB(dst, b, h) do { _Pragma("unroll") for (int n = 0; n < 2; ++n) _Pragma("unroll") for (int k = 0; k < 2; ++k) dst[n][k] = *(const PG8_LAS bf16x8*)(lds + PG8_SB(b, h) + boff + n * 2048 + k * 1024); } while (0)
#define PG8_MMA(ai, bj, At, Bt) do { __builtin_amdgcn_s_setprio(1); _Pragma("unroll") for (int m = 0; m < 4; ++m) _Pragma("unroll") for (int n = 0; n < 2; ++n) _Pragma("unroll") for (int k = 0; k < 2; ++k) \
        acc[ai][bj][m][n] = __builtin_amdgcn_mfma_f32_16x16x32_bf16(Bt[n][k], At[m][k], acc[ai][bj][m][n], 0, 0, 0); __builtin_amdgcn_s_setprio(0); } while (0)
#define PG8_WAIT_V(n) asm volatile("s_waitcnt vmcnt(" #n ")" ::: "memory")
#define PG8_WAIT_L(n) asm volatile("s_waitcnt lgkmcnt(" #n ")" ::: "memory")
#define PG8_BAR __builtin_amdgcn_s_barrier()
#define PG8_SCHED __builtin_amdgcn_sched_barrier(0)
    Unit cur, nxt; int ui = 0;
    if (!S.next(0, cur)) return;
    f32x4 acc[2][2][4][2];
#pragma unroll
    for (int a = 0; a < 2; ++a)
#pragma unroll
        for (int b = 0; b < 2; ++b)
#pragma unroll
            for (int m = 0; m < 4; ++m)
#pragma unroll
                for (int n = 0; n < 2; ++n) acc[a][b][m][n] = (f32x4){0.f, 0.f, 0.f, 0.f};
    bf16x8 At[4][2], B0[2][2], B1[2][2];
    const char* cA = (const char*)g.A + (size_t)cur.pm * tstep + (size_t)cur.kb * kstep; const char* cB = (const char*)g.Bt + (size_t)cur.pn * tstep + (size_t)cur.kb * kstep;
    PG8_STAGE(PG8_SB(0, 0), cB, voffB); PG8_STAGE(PG8_SB(0, 1), cB + hstep, voffB); PG8_STAGE(PG8_SA(0, 0), cA, voffA); PG8_STAGE(PG8_SA(0, 1), cA + hstep, voffA);
    if (wr == 1) PG8_BAR;
    PG8_WAIT_V(2); PG8_BAR;
    PG8_STAGE(PG8_SB(1, 0), cB + kstep, voffB); PG8_STAGE(PG8_SA(1, 0), cA + kstep, voffA); PG8_STAGE(PG8_SB(1, 1), cB + hstep + kstep, voffB);
    PG8_WAIT_V(6); PG8_BAR;
    for (;;) {
        const bool has_next = S.next(ui + 1, nxt);
        const char* nA = has_next ? (const char*)g.A + (size_t)nxt.pm * tstep + (size_t)nxt.kb * kstep : cA; const char* nB = has_next ? (const char*)g.Bt + (size_t)nxt.pn * tstep + (size_t)nxt.kb * kstep : cB;
        const int nt = cur.nk;
        for (int t = 0; t < nt; t += 2) {
            const bool last = (t == nt - 2);
            const char* a1 = cA + (size_t)(t + 1) * kstep;
            const char* a2 = last ? nA : cA + (size_t)(t + 2) * kstep; const char* b2 = last ? nB : cB + (size_t)(t + 2) * kstep;
            const char* a3 = a2 + kstep; const char* b3 = b2 + kstep;
            PG8_LDB(B0, 0, 0); PG8_LDB(B1, 0, 1); PG8_SCHED; PG8_LDA(At, 0, 0); PG8_STAGE(PG8_SA(1, 1), a1 + hstep, voffA);
            PG8_WAIT_V(8); PG8_WAIT_L(0); PG8_BAR; PG8_MMA(0, 0, At, B0); PG8_MMA(0, 1, At, B1); PG8_BAR; PG8_SCHED;
            PG8_LDA(At, 0, 1); PG8_STAGE(PG8_SB(0, 0), b2, voffB); PG8_STAGE(PG8_SB(0, 1), b2 + hstep, voffB); PG8_STAGE(PG8_SA(0, 0), a2, voffA);
            PG8_WAIT_V(8); PG8_WAIT_L(0); PG8_BAR; PG8_MMA(1, 0, At, B0); PG8_MMA(1, 1, At, B1); PG8_BAR; PG8_SCHED;
            PG8_LDB(B0, 1, 0); PG8_LDB(B1, 1, 1); PG8_SCHED; PG8_LDA(At, 1, 0); PG8_STAGE(PG8_SA(0, 1), a2 + hstep, voffA);
            PG8_WAIT_V(8); PG8_WAIT_L(0); PG8_BAR; PG8_MMA(0, 0, At, B0); PG8_MMA(0, 1, At, B1); PG8_BAR; PG8_SCHED;
            PG8_LDA(At, 1, 1); PG8_STAGE(PG8_SB(1, 0), b3, voffB); PG8_STAGE(PG8_SB(1, 1), b3 + hstep, voffB); PG8_STAGE(PG8_SA(1, 0), a3, voffA);
            PG8_WAIT_V(8); PG8_WAIT_L(0); PG8_BAR; PG8_MMA(1, 0, At, B0); PG8_MMA(1, 1, At, B1); PG8_BAR; PG8_SCHED;
        }
        if (wr == 0) PG8_BAR;
        if (cur.tinfo < 0) E(acc, cur, wr, wc, fr, fq);
        if (!has_next) break;
#pragma unroll
        for (int a = 0; a < 2; ++a)
#pragma unroll
            for (int b = 0; b < 2; ++b)
#pragma unroll
                for (int m = 0; m < 4; ++m)
#pragma unroll
                    for (int n = 0; n < 2; ++n) acc[a][b][m][n] = (f32x4){0.f, 0.f, 0.f, 0.f};
        cur = nxt; cA = nA; cB = nB; ++ui;
        if (wr == 1) PG8_BAR;
    }
    PG8_WAIT_V(0);
    PG8_BAR;
    if (cur.tinfo >= 0) tail_fixup(acc, cur, E, T, tid, wr, wc, fr, fq);
#undef PG8_SA
#undef PG8_SB
#undef PG8_STAGE
#undef PG8_LDA
#undef PG8_LDB
#undef PG8_MMA
#undef PG8_WAIT_V
#undef PG8_WAIT_L
#undef PG8_BAR
#undef PG8_SCHED
}

struct MUnit { int kind, pm, pn, kb, nk, tinfo; };
struct MOrder {
    int c;
    __device__ __forceinline__ bool next(int i, MUnit& u) const {
        const int j = i * 256 + c;
        u.kb = 0; u.tinfo = -1;
        if (j < 288) { u.kind = 0; u.nk = D / BK;
            if (j < 256) { const int x = j & 7, r = j >> 3; u.pm = 4 * x + (r >> 3); u.pn = r & 7; } else { const int t = j - 256; u.pm = 32 + (t >> 3); u.pn = t & 7; }
            return true; }
        if (j < 1872) { u.kind = 1; u.nk = D / BK; const int L = j - 288;
            if (L < 1408) { const int x = L & 7, off = L >> 3, wg = x * 176 + off, gid = wg / 352, rem = wg % 352; u.pm = gid * 8 + (rem & 7); u.pn = rem >> 3; }
            else { const int t = L - 1408; u.pm = 32 + (t & 3); u.pn = t >> 2; }
            return true; }
        if (j < 2128) { u.kind = 2; u.nk = DFF / BK; const int L = j - 1872, x = L & 7, r = L >> 3; u.pm = 4 * x + (r >> 3); u.pn = r & 7; return true; }
        const int ilast = (c < 80) ? 9 : 8;
        if (i != ilast || c < 80 || c >= 208) return false;
        const int mi = c - 80, tj = mi >> 2, slice = mi & 3;
        u.kind = 2; u.pm = 32 + (tj >> 3); u.pn = tj & 7; u.kb = slice * 22; u.nk = 22; u.tinfo = (tj << 8) | (slice << 4) | 4; return true;
    }
};

struct StreamOff { size_t A0, B0, A1, B1, A2, B2, x2b, slab; int dep3, dep4, tail, rsq2, rsq3; };
template <class SO>
__device__ __forceinline__ void gemm_stream(PG8_LAS unsigned char* lds, const MOrder& S, unsigned char* ws, const float* xp, const float* xs, const SO O) {
    int tid_ = threadIdx.x; asm volatile("" : "+v"(tid_));
    const int tid = tid_, wid = __builtin_amdgcn_readfirstlane(tid >> 6), lane = tid & 63, wr = wid >> 2, wc = wid & 3, fr = lane & 15, fq = lane >> 4;
    unsigned Ra[2][2], Rb[2][2];
#pragma unroll
    for (int i = 0; i < 2; ++i) { int R, C; stage_rc(tid * 16 + i * 8192, R, C); const int Rp = (R & ~31) + perm32(R & 31);
        Ra[0][i] = (unsigned)(R * D + C) * 2u; Ra[1][i] = (unsigned)(R * DFF + C) * 2u; Rb[0][i] = (unsigned)(Rp * D + C) * 2u; Rb[1][i] = (unsigned)(Rp * DFF + C) * 2u; }
    const size_t kstep = (size_t)(BK * 2);
    const unsigned ldsw = (unsigned)wid * 1024u;
    const int aoff = lds_byte(wr * 64 + fr, fq * 8), boff = lds_byte(wc * 32 + fr, fq * 8);
#define PG8_SA(b, h) (((b) * 2 + (h)) * HTB)
#define PG8_SB(b, h) ((4 + (b) * 2 + (h)) * HTB)
#define PG8_STG(bufoff, gbase, Rr, rowb) do { _Pragma("unroll") for (int _i = 0; _i < 2; ++_i) \
        __builtin_amdgcn_global_load_lds((const unsigned*)((const char*)(gbase) + ((rowb) == D * 2 ? (Rr)[0][_i] : (Rr)[1][_i])), (PG8_LAS unsigned*)(lds + (bufoff) + ldsw + _i * 8192), 16, 0, 0); } while (0)
#define PG8_LDA(dst, b, h) do { _Pragma("unroll") for (int m = 0; m < 4; ++m) _Pragma("unroll") for (int k = 0; k < 2; ++k) dst[m][k] = *(const PG8_LAS bf16x8*)(lds + PG8_SA(b, h) + aoff + m * 2048 + k * 1024); } while (0)
#define PG8_LDB(dst, b, h) do { _Pragma("unroll") for (int n = 0; n < 2; ++n) _Pragma("unroll") for (int k = 0; k < 2; ++k) dst[n][k] = *(const PG8_LAS bf16x8*)(lds + PG8_SB(b, h) + boff + n * 2048 + k * 1024); } while (0)
#define PG8_MMA(ai, bj, At, Bt) do { __builtin_amdgcn_s_setprio(1); _Pragma("unroll") for (int m = 0; m < 4; ++m) _Pragma("unroll") for (int n = 0; n < 2; ++n) _Pragma("unroll") for (int k = 0; k < 2; ++k) \
        acc[ai][bj][m][n] = __builtin_amdgcn_mfma_f32_16x16x32_bf16(Bt[n][k], At[m][k], acc[ai][bj][m][n], 0, 0, 0); __builtin_amdgcn_s_setprio(0); } while (0)
#define PG8_WAIT_V(n) asm volatile("s_waitcnt vmcnt(" #n ")" ::: "memory")
#define PG8_WAIT_L(n) asm volatile("s_waitcnt lgkmcnt(" #n ")" ::: "memory")
#define PG8_BAR __builtin_amdgcn_s_barrier()
#define PG8_SCHED __builtin_amdgcn_sched_barrier(0)
#define MU_A(u) ((const char*)ws + ((u).kind == 0 ? O.A0 : (u).kind == 1 ? O.A1 : O.A2) + (size_t)(u).pm * 256 * MU_RB(u) + (size_t)(u).kb * kstep)
#define MU_B(u) ((const char*)ws + ((u).kind == 0 ? O.B0 : (u).kind == 1 ? O.B1 : O.B2) + (size_t)(u).pn * 256 * MU_RB(u) + (size_t)(u).kb * kstep)
#define MU_RB(u) ((u).kind == 2 ? DFF * 2 : D * 2)
    unsigned long long rdy3 = 0ull, rdy4 = 0ull;
#define MU_READY(u) do { if ((u).kind != 0) { unsigned long long& _m = (u).kind == 1 ? rdy3 : rdy4; if (!((_m >> (u).pm) & 1ull)) { \
        if (wid == 0) { unsigned* _c = (unsigned*)ws + ((u).kind == 1 ? O.dep3 : O.dep4) + 64 * (u).pm; const unsigned _t = (u).kind == 1 ? 64u : 352u; unsigned _sp = 0; \
            while (__hip_atomic_load(_c, __ATOMIC_RELAXED, __HIP_MEMORY_SCOPE_AGENT) < _t && ++_sp < (1u << 22)) __builtin_amdgcn_s_sleep(2); \
            __builtin_amdgcn_fence(__ATOMIC_ACQUIRE, "agent"); asm volatile("s_waitcnt vmcnt(0)" ::: "memory"); } \
        asm volatile("" ::: "memory"); PG8_BAR; asm volatile("" ::: "memory"); _m |= 1ull << (u).pm; } } } while (0)
    PG8_LAS unsigned* vflag = (PG8_LAS unsigned*)(lds + 147456 - 256 + 64);
#define MU_TRY(u, ok) do { ok = true; if ((u).kind != 0) { unsigned long long& _m = (u).kind == 1 ? rdy3 : rdy4; if (!((_m >> (u).pm) & 1ull)) { \
        if (wid == 0) { unsigned* _c = (unsigned*)ws + ((u).kind == 1 ? O.dep3 : O.dep4) + 64 * (u).pm; const unsigned _t = (u).kind == 1 ? 64u : 352u; \
            const bool _r = __hip_atomic_load(_c, __ATOMIC_RELAXED, __HIP_MEMORY_SCOPE_AGENT) >= _t; \
            if (_r) { __builtin_amdgcn_fence(__ATOMIC_ACQUIRE, "agent"); asm volatile("s_waitcnt vmcnt(0)" ::: "memory"); } \
            if (lane == 0) *vflag = _r ? 1u : 0u; asm volatile("s_waitcnt lgkmcnt(0)" ::: "memory"); } \
        asm volatile("" ::: "memory"); PG8_BAR; asm volatile("" ::: "memory"); \
        ok = (*(volatile PG8_LAS unsigned*)vflag) != 0u; if (ok) _m |= 1ull << (u).pm; } } } while (0)
    MUnit cur, nxt; int ui = 0;
    if (!S.next(0, cur)) return;
    f32x4 acc[2][2][4][2];
#pragma unroll
    for (int a = 0; a < 2; ++a)
#pragma unroll
        for (int b = 0; b < 2; ++b)
#pragma unroll
            for (int m = 0; m < 4; ++m)
#pragma unroll
                for (int n = 0; n < 2; ++n) acc[a][b][m][n] = (f32x4){0.f, 0.f, 0.f, 0.f};
    bf16x8 At[4][2], B0[2][2], B1[2][2];
    bool more = true; float rq[8];
    while (more) {
#ifdef TPROBE
    if (threadIdx.x == 0 && cur.tinfo >= 0) ((volatile PG8_LAS unsigned long long*)(lds + 147456 - 256 + 128))[10] = __builtin_amdgcn_s_memrealtime();
#endif
    MU_READY(cur);
    const char* cA = MU_A(cur); const char* cB = MU_B(cur); int crb = MU_RB(cur);
    PG8_STG(PG8_SB(0, 0), cB, Rb, crb); PG8_STG(PG8_SB(0, 1), cB + (size_t)HALF * crb, Rb, crb); PG8_STG(PG8_SA(0, 0), cA, Ra, crb); PG8_STG(PG8_SA(0, 1), cA + (size_t)HALF * crb, Ra, crb);
    if (wr == 1) PG8_BAR;
    PG8_WAIT_V(2); PG8_BAR;
    PG8_STG(PG8_SB(1, 0), cB + kstep, Rb, crb); PG8_STG(PG8_SA(1, 0), cA + kstep, Ra, crb); PG8_STG(PG8_SB(1, 1), cB + (size_t)HALF * crb + kstep, Rb, crb);
    PG8_WAIT_V(6); PG8_BAR;
    for (;;) {
        const bool has_next = S.next(ui + 1, nxt);
        bool chain = has_next;
        const char* nA = cA; const char* nB = cB; int nrb = crb;
        const int nt = cur.nk;
        for (int t = 0; t < nt; t += 2) {
            const bool last = (t == nt - 2);
            if (last && has_next) { MU_TRY(nxt, chain); if (chain) { nA = MU_A(nxt); nB = MU_B(nxt); nrb = MU_RB(nxt); } }
            if (last && cur.kind == 1 && cur.tinfo < 0) { const Unit u{cur.pm, cur.pn, 0, 0, -1}; const EpiAct E1{(bf16_t*)(ws + O.A2), (const float*)ws + O.rsq2, true}; E1.prefetch(u, wr, fr, rq); }
            const char* a1 = cA + (size_t)(t + 1) * kstep;
            const char* a2 = last ? nA : cA + (size_t)(t + 2) * kstep; const char* b2 = last ? nB : cB + (size_t)(t + 2) * kstep; const int rb2 = last ? nrb : crb;
            const char* a3 = a2 + kstep; const char* b3 = b2 + kstep;
            const size_t h1 = (size_t)HALF * crb, h2 = (size_t)HALF * rb2;
            PG8_LDB(B0, 0, 0); PG8_LDB(B1, 0, 1); PG8_SCHED; PG8_LDA(At, 0, 0); PG8_STG(PG8_SA(1, 1), a1 + h1, Ra, crb);
            PG8_WAIT_V(8); PG8_WAIT_L(0); PG8_BAR; PG8_MMA(0, 0, At, B0); PG8_MMA(0, 1, At, B1); PG8_BAR; PG8_SCHED;
            PG8_LDA(At, 0, 1); PG8_STG(PG8_SB(0, 0), b2, Rb, rb2); PG8_STG(PG8_SB(0, 1), b2 + h2, Rb, rb2); PG8_STG(PG8_SA(0, 0), a2, Ra, rb2);
            PG8_WAIT_V(8); PG8_WAIT_L(0); PG8_BAR; PG8_MMA(1, 0, At, B0); PG8_MMA(1, 1, At, B1); PG8_BAR; PG8_SCHED;
            PG8_LDB(B0, 1, 0); PG8_LDB(B1, 1, 1); PG8_SCHED; PG8_LDA(At, 1, 0); PG8_STG(PG8_SA(0, 1), a2 + h2, Ra, rb2);
            PG8_WAIT_V(8); PG8_WAIT_L(0); PG8_BAR; PG8_MMA(0, 0, At, B0); PG8_MMA(0, 1, At, B1); PG8_BAR; PG8_SCHED;
            PG8_LDA(At, 1, 1); PG8_STG(PG8_SB(1, 0), b3, Rb, rb2); PG8_STG(PG8_SB(1, 1), b3 + h2, Rb, rb2); PG8_STG(PG8_SA(1, 0), a3, Ra, rb2);
            PG8_WAIT_V(8); PG8_WAIT_L(0); PG8_BAR; PG8_MMA(1, 0, At, B0); PG8_MMA(1, 1, At, B1); PG8_BAR; PG8_SCHED;
        }
        if (wr == 0) PG8_BAR;
        if (cur.tinfo < 0) {
            const Unit u{cur.pm, cur.pn, 0, 0, -1};
            if (cur.kind == 0) { const EpiX1<false> E0{xp, xs, nullptr, (bf16_t*)(ws + O.A1), (float*)ws + O.rsq2, true}; E0(acc, u, wr, wc, fr, fq); }
            else if (cur.kind == 1) { const EpiAct E1{(bf16_t*)(ws + O.A2), (const float*)ws + O.rsq2, true}; E1(acc, u, wr, wc, fr, fq, 0xffu, rq); }
            else { const EpiX2<false> E2{(bf16_t*)(ws + O.x2b), (float*)ws + O.rsq3, (const bf16_t*)(ws + O.A1)}; E2(acc, u, wr, wc, fr, fq); }
            if (cur.kind != 2) {
                asm volatile("s_waitcnt vmcnt(0)" ::: "memory");
                if (lane == 0) __hip_atomic_fetch_add((unsigned*)ws + (cur.kind == 0 ? O.dep3 : O.dep4) + 64 * cur.pm, 1u, __ATOMIC_RELAXED, __HIP_MEMORY_SCOPE_AGENT);
            }
        }
        if (!has_next) { more = false; break; }
        if (!chain) {
            PG8_WAIT_V(0); PG8_BAR;
#pragma unroll
            for (int a = 0; a < 2; ++a)
#pragma unroll
                for (int b = 0; b < 2; ++b)
#pragma unroll
                    for (int m = 0; m < 4; ++m)
#pragma unroll
                        for (int n = 0; n < 2; ++n) acc[a][b][m][n] = (f32x4){0.f, 0.f, 0.f, 0.f};
            cur = nxt; ++ui;
            break;
        }
#pragma unroll
        for (int a = 0; a < 2; ++a)
#pragma unroll
            for (int b = 0; b < 2; ++b)
#pragma unroll
                for (int m = 0; m < 4; ++m)
#pragma unroll
                    for (int n = 0; n < 2; ++n) acc[a][b][m][n] = (f32x4){0.f, 0.f, 0.f, 0.f};
        cur = nxt; cA = nA; cB = nB; crb = nrb; ++ui;
        if (wr == 1) PG8_BAR;
    }
    }
    PG8_WAIT_V(0);
    PG8_BAR;
#ifdef TPROBE
    if (threadIdx.x == 0) ((volatile PG8_LAS unsigned long long*)(lds + 147456 - 256 + 128))[9] = __builtin_amdgcn_s_memrealtime();
#endif
    if (cur.tinfo >= 0) { const Unit u{cur.pm, cur.pn, cur.kb, cur.nk, cur.tinfo}; const EpiX2<false> E2{(bf16_t*)(ws + O.x2b), (float*)ws + O.rsq3, (const bf16_t*)(ws + O.A1)};
        const TailCtx T{(f32x4*)(ws + O.slab), (unsigned*)ws + O.tail}; tail_fixup(acc, u, E2, T, tid, wr, wc, fr, fq); }
#undef MU_TRY
#undef MU_A
#undef MU_B
#undef MU_RB
#undef MU_READY
#undef PG8_SA
#undef PG8_SB
#undef PG8_STG
#undef PG8_LDA
#undef PG8_LDB
#undef PG8_MMA
#undef PG8_WAIT_V
#undef PG8_WAIT_L
#undef PG8_BAR
#undef PG8_SCHED
}
}
#define LAS __attribute__((address_space(3)))
typedef unsigned short bf16;
using pg8::f32x4; using pg8::u32x4; using pg8::u32x2; using pg8::bf16x8; using pg8::cvt_pk_bf16;

#ifndef ONE_LAUNCH
#define ONE_LAUNCH 1
#endif
constexpr int NWAVES = 8, NPHASE = 7;
constexpr int LDS_BYTES = 147456;
constexpr size_t MiB = 1u << 20;
constexpr size_t WS_CTL = 0, CTL_ZERO_BYTES = 1 * MiB;
constexpr size_t WS_WIN = 1 * MiB;
constexpr size_t WS_WO = 21 * MiB;
constexpr size_t WS_WGU = 29 * MiB;
constexpr size_t WS_WD = 73 * MiB;
constexpr size_t WS_WP = 95 * MiB;
constexpr size_t WS_MISC = 96 * MiB;
constexpr size_t WS_XB = 97 * MiB;
constexpr size_t WS_ZB = 133 * MiB;
constexpr size_t WS_LF = 223 * MiB;
constexpr size_t WS_ACT = WS_ZB;
constexpr size_t WS_MIX = 259 * MiB;
constexpr size_t WS_X2B = WS_WGU;
constexpr size_t WS_END = 328 * MiB;
constexpr int CW_RSQ2 = 4096, CW_RSQ3 = 4096 + M;
constexpr int CW_TAIL = 100000;
constexpr size_t WS_SLAB3 = WS_ACT, WS_SLAB45 = 232 * MiB;
constexpr int CW_DEP = 124000;
constexpr size_t WS_SLABM = 296 * MiB;
#ifndef MERGED
#define MERGED 1
#endif
constexpr int CW_BAR = 65536;
constexpr int MISC_OFF = 147456 - 256;
#ifndef USE_CG
#define USE_CG 0
#endif

__device__ __forceinline__ float wave_sum(float v) {
#pragma unroll
    for (int o = 1; o < 64; o <<= 1) v += __shfl_xor(v, o);
    return v;
}
__device__ __forceinline__ float bflo(unsigned w) { return __builtin_bit_cast(float, w << 16); }
__device__ __forceinline__ float bfhi(unsigned w) { return __builtin_bit_cast(float, w & 0xffff0000u); }
__device__ __forceinline__ float bf2f(bf16 b) { return __builtin_bit_cast(float, (unsigned)b << 16); }
__device__ __forceinline__ bf16 f2bf(float f) { unsigned u = __builtin_bit_cast(unsigned, f); return (bf16)((u + 0x7fffu + ((u >> 16) & 1u)) >> 16); }

#define XB_TMO      128
#define XB_XCNT(j)  (256  + 64 * (j))
#define XB_XSUB(j)  (1280 + 64 * (j))
#define XB_XGEN(j)  (2304 + 64 * (j))
#define XB_TOP      3328
#define XB_TOPGEN   3392
#define XCD_BAR_WORDS 3456
#define XB_SPIN_CAP (1u << 18)

__device__ __forceinline__ unsigned xb_ld(unsigned* p)              { return __hip_atomic_load(p, __ATOMIC_RELAXED, __HIP_MEMORY_SCOPE_AGENT); }
__device__ __forceinline__ unsigned xb_add(unsigned* p, unsigned v) { return __hip_atomic_fetch_add(p, v, __ATOMIC_RELAXED, __HIP_MEMORY_SCOPE_AGENT); }
__device__ __forceinline__ unsigned xb_xcc_id() { return (unsigned)__builtin_amdgcn_s_getreg((3 << 11) | 20) & 0xFu; }
#define XB_SPIN(cond, bar) do { unsigned _sp = 0; while (cond) { __builtin_amdgcn_s_sleep(1); \
    if ((++_sp & 255u) == 0u) { if (xb_ld(&(bar)[XB_TMO])) break; if (_sp > XB_SPIN_CAP) { atomicAdd(&(bar)[XB_TMO], 1u); break; } } } } while (0)

struct XcdBarrier {
    unsigned* bar; unsigned x;
    volatile LAS unsigned* st;
};

__device__ __forceinline__ XcdBarrier xcd_barrier_post(unsigned* bar, volatile LAS unsigned* st) {
    XcdBarrier b; b.bar = bar; b.x = xb_xcc_id(); b.st = st;
    if (threadIdx.x == 0) (void)xb_add(&bar[XB_XCNT(b.x)], 1u);
    return b;
}
__device__ __forceinline__ void xcd_barrier_complete(unsigned* bar, unsigned x, unsigned& nloc, unsigned& nx) {
    const unsigned G = gridDim.x * gridDim.y * gridDim.z;
    unsigned sum, cnt, mine, sp = 0u;
    for (;;) {
        sum = 0u; cnt = 0u; mine = 0u;
#pragma unroll
        for (unsigned j = 0; j < 16; ++j) { const unsigned c = xb_ld(&bar[XB_XCNT(j)]); sum += c; cnt += (c > 0u) ? 1u : 0u; mine = (j == x) ? c : mine; }
        if (sum == G) break;
        __builtin_amdgcn_s_sleep(1);
        if ((++sp & 255u) == 0u) { if (xb_ld(&bar[XB_TMO])) break; if (sp > XB_SPIN_CAP) { atomicAdd(&bar[XB_TMO], 1u); break; } }
    }
    nloc = mine > 0u ? mine : 1u; nx = cnt > 0u ? cnt : 1u;
}

__device__ __forceinline__ void xcd_barrier(const XcdBarrier& b) {
    asm volatile("s_waitcnt vmcnt(0)" ::: "memory");
    __syncthreads();
    if (threadIdx.x == 0) {
        unsigned* bar = b.bar;
        __builtin_amdgcn_s_waitcnt(0);
        unsigned nloc = b.st[0], nx = b.st[1];
        if (nloc == 0u) { xcd_barrier_complete(bar, b.x, nloc, nx); b.st[0] = nloc; b.st[1] = nx; }
        const unsigned old = xb_add(&bar[XB_XSUB(b.x)], 1u);
        const unsigned gen = old / nloc;
        if (old + 1u == (gen + 1u) * nloc) {
            __builtin_amdgcn_fence(__ATOMIC_RELEASE, "agent");
            asm volatile("s_waitcnt vmcnt(0)" ::: "memory");
            const unsigned og = xb_add(&bar[XB_TOP], 1u);
            const unsigned tg = og / nx;
            if (og + 1u == (tg + 1u) * nx) xb_add(&bar[XB_TOPGEN], 1u);
            else XB_SPIN(xb_ld(&bar[XB_TOPGEN]) == tg, bar);
            __builtin_amdgcn_fence(__ATOMIC_ACQUIRE, "agent");
            xb_add(&bar[XB_XGEN(b.x)], 1u);
            asm volatile("s_waitcnt vmcnt(0)" ::: "memory");
        } else {
            XB_SPIN(xb_ld(&bar[XB_XGEN(b.x)]) == gen, bar);
            __builtin_amdgcn_fence(__ATOMIC_ACQUIRE, "agent");
            asm volatile("s_waitcnt vmcnt(0)" ::: "memory");
        }
    }
    __syncthreads();
}


#ifdef TPROBE
#define STAMP(i) do { if (threadIdx.x == 0) ((volatile LAS unsigned long long*)(lds + MISC_OFF + 128))[i] = __builtin_amdgcn_s_memrealtime(); } while (0)
#else
#define STAMP(i) do {} while (0)
#endif
constexpr int CW_TP = 120000;

struct Args { const float* in[16]; float* out; unsigned char* ws; int ph_lo, ph_hi; };

__device__ __forceinline__ void p0_item(const float* W, int K, int N, bf16* WT, int mode, const float* sk, const float* sn, LAS float* scr, int item, int lane) {
    const int nblk = N / 64, kb = item / nblk, nb = item % nblk, k0 = 64 * kb, n0 = 64 * nb;
    const int drow0 = mode == 0 ? n0 : ((n0 >> 7) * 256 + (n0 & 127) + (mode == 2 ? 128 : 0));
    const int r = lane >> 4, c4 = lane & 15;
    f32x4 v[16];
#pragma unroll
    for (int i = 0; i < 16; ++i) v[i] = __builtin_nontemporal_load((const f32x4*)(W + (size_t)(k0 + 4 * i + r) * N + n0 + 4 * c4));
    if (sk) {
#pragma unroll
        for (int i = 0; i < 16; ++i) v[i] = v[i] * sk[k0 + 4 * i + r];
    }
#pragma unroll
    for (int i = 0; i < 16; ++i) { LAS float* d = scr + (4 * i + r) * 65 + 4 * c4; d[0] = v[i][0]; d[1] = v[i][1]; d[2] = v[i][2]; d[3] = v[i][3]; }
    asm volatile("s_waitcnt lgkmcnt(0)" ::: "memory");
    const int c = lane & 7, nn = lane >> 3;
#pragma unroll
    for (int j = 0; j < 8; ++j) { const int n = nn + 8 * j; const LAS float* s = scr + (8 * c) * 65 + n; const float f = sn ? sn[n0 + n] : 1.f;
        u32x4 o; o.x = cvt_pk_bf16(s[0 * 65] * f, s[1 * 65] * f); o.y = cvt_pk_bf16(s[2 * 65] * f, s[3 * 65] * f); o.z = cvt_pk_bf16(s[4 * 65] * f, s[5 * 65] * f); o.w = cvt_pk_bf16(s[6 * 65] * f, s[7 * 65] * f);
        *(u32x4*)(WT + (size_t)(drow0 + n) * K + k0 + 8 * c) = o; }
    asm volatile("s_waitcnt lgkmcnt(0)" ::: "memory");
}

constexpr int P0_I_IN = (D / 64) * (INC / 64), P0_I_O = (D / 64) * (D / 64), P0_I_G = (D / 64) * (DFF / 64), P0_I_D = (DFF / 64) * (D / 64), P0_I_P = (256 / 64) * (256 / 64);
constexpr int P0_NITEMS = P0_I_IN + P0_I_O + 2 * P0_I_G + P0_I_D + 4 * P0_I_P;
#ifndef P0_NDEF
#define P0_NDEF 3328
#endif
constexpr int P0_DEF_HI = P0_I_IN + P0_I_O + 2 * P0_I_G + P0_I_D, P0_DEF_LO = P0_DEF_HI - P0_NDEF;
__device__ __forceinline__ int p1_idle_wgs(int G) { const int nwg = (M / 256) * (INC / 256), nfull = nwg / G, R = nwg - nfull * G; return R > 0 ? G - R : 0; }
__device__ __forceinline__ void p0_weight_item(const Args& a, LAS float* scr, int it, int lane) {
    unsigned char* ws = a.ws;
    int r = it;
    if (r < P0_I_IN) { p0_item(a.in[6], D, INC, (bf16*)(ws + WS_WIN), 0, a.in[5], nullptr, scr, r, lane); return; } r -= P0_I_IN;
    if (r < P0_I_O) { p0_item(a.in[10], D, D, (bf16*)(ws + WS_WO), 0, nullptr, nullptr, scr, r, lane); return; } r -= P0_I_O;
    if (r < P0_I_G) { p0_item(a.in[12], D, DFF, (bf16*)(ws + WS_WGU), 1, a.in[11], nullptr, scr, r, lane); return; } r -= P0_I_G;
    if (r < P0_I_G) { p0_item(a.in[13], D, DFF, (bf16*)(ws + WS_WGU), 2, a.in[11], nullptr, scr, r, lane); return; } r -= P0_I_G;
    if (r < P0_I_D) { p0_item(a.in[14], DFF, D, (bf16*)(ws + WS_WD), 0, nullptr, nullptr, scr, r, lane); return; } r -= P0_I_D;
    { const int g = r / P0_I_P; p0_item(a.in[7] + (size_t)g * 65536, 256, 256, (bf16*)(ws + WS_WP) + (size_t)g * 65536, 0, nullptr, a.in[8] + g * 256, scr, r % P0_I_P, lane); }
}
__device__ __forceinline__ void phase0_deferred(LAS unsigned char* lds, const Args& a, int idle_idx, int nidle) {
    const int lane = threadIdx.x & 63, wave = threadIdx.x >> 6;
    LAS float* scr = (LAS float*)(lds + wave * 16640);
    for (int it = P0_DEF_LO + idle_idx * NWAVES + wave; it < P0_DEF_HI; it += nidle * NWAVES) p0_weight_item(a, scr, it, lane);
}
__device__ __forceinline__ void phase0(LAS unsigned char* lds, const Args& a, int vcu, int G) {
    const int tid = threadIdx.x, lane = tid & 63, wave = tid >> 6;
    unsigned char* ws = a.ws;
    LAS float* scr = (LAS float*)(lds + wave * 16640);
    const int gw = vcu * NWAVES + wave, NGW = G * NWAVES;
    const bool defer = p1_idle_wgs(G) >= 32;
    const int nlive = defer ? P0_NITEMS - (P0_DEF_HI - P0_DEF_LO) : P0_NITEMS;
    for (int k = gw; k < nlive; k += NGW) p0_weight_item(a, scr, (defer && k >= P0_DEF_LO) ? k + (P0_DEF_HI - P0_DEF_LO) : k, lane);
    float* rstd1 = (float*)(ws + WS_MISC); bf16* xb = (bf16*)(ws + WS_XB);
    for (int m = gw; m < M; m += NGW) {
        const float* xrow = m < MP ? a.in[0] + (size_t)m * D : a.in[1] + (size_t)(m - MP) * D;
        f32x4 v[8]; float s = 0.f;
#pragma unroll
        for (int j = 0; j < 8; ++j) { v[j] = __builtin_nontemporal_load((const f32x4*)xrow + lane + 64 * j); s += (v[j][0] * v[j][0] + v[j][1] * v[j][1]) + (v[j][2] * v[j][2] + v[j][3] * v[j][3]); }
        s = wave_sum(s);
        if (lane == 0) rstd1[m] = rsqrtf(s * (1.f / D) + EPS);
#pragma unroll
        for (int j = 0; j < 8; ++j) { u32x2 w; w.x = cvt_pk_bf16(v[j][0], v[j][1]); w.y = cvt_pk_bf16(v[j][2], v[j][3]); ((u32x2*)(xb + (size_t)m * D))[lane + 64 * j] = w; }
    }
    { u32x4* cz = (u32x4*)(ws + WS_CTL); const int gt0 = vcu * (NWAVES * 64) + tid, ngt0 = G * NWAVES * 64;
      for (int i = gt0; i < (int)(CTL_ZERO_BYTES / 16); i += ngt0) if (i < CW_BAR / 4 || i >= (CW_BAR + XCD_BAR_WORDS + 3) / 4) cz[i] = (u32x4){0u, 0u, 0u, 0u}; }
    const int gt = vcu * (NWAVES * 64) + tid, NGT = G * NWAVES * 64;
    float* lbv = (float*)(ws + WS_MISC) + M;
    for (int c = gt; c < HW; c += NGT) lbv[c] = 1.f / (1.f + __expf(a.in[4][HW + c] - a.in[4][c]));
    for (int i = gt; i < DB * 7 * PW; i += NGT) { const int b = i / (7 * PW), rem = i % (7 * PW); a.out[O_PSS + (size_t)b * PC * PW + rem] = a.in[2][(size_t)b * PC * PW + 8 * PW + rem]; }
}

template <int W, bool SAMPLE>
__device__ __forceinline__ void pool_fill(LAS bf16* A, int m0, int g, const bf16* zb, const float* cache) {
    const int tid = threadIdx.x, c8 = tid & 31, rq = tid >> 5;
    constexpr int LDA = 264;
    const int col = g * 256 + 8 * c8;
    u32x4 ur[19];
    int tb;
    if (!SAMPLE) {
        const int mb = m0 + 4 * rq - 15; tb = (m0 & (SEQ - 1)) + 4 * rq - 15;
#pragma unroll
        for (int e = 0; e < 19; ++e) ur[e] = (tb + e >= 0) ? *(const u32x4*)(zb + (size_t)(mb + e) * INC + col) : (u32x4){0u, 0u, 0u, 0u};
    } else {
        const int r0 = 4 * rq, m = m0 + r0, b = (m - MP) >> 3, t0 = r0 & 7; tb = t0 - 15;
#pragma unroll
        for (int e = 0; e < 19; ++e) {
            const int tau = tb + e;
            if (tau >= 0) ur[e] = *(const u32x4*)(zb + (size_t)(m - t0 + tau) * INC + col);
            else { const float* cr = cache + ((size_t)b * PC + (PC + tau)) * PW + col; const f32x4 c0 = *(const f32x4*)cr, c1 = *(const f32x4*)(cr + 4);
                   ur[e] = (u32x4){cvt_pk_bf16(c0[0], c0[1]), cvt_pk_bf16(c0[2], c0[3]), cvt_pk_bf16(c1[0], c1[1]), cvt_pk_bf16(c1[2], c1[3])}; }
        }
    }
    float out[4][8];
#pragma unroll
    for (int cp = 0; cp < 4; ++cp)
#pragma unroll
        for (int hf = 0; hf < 2; ++hf) {
#define PVAL(e) (hf ? bfhi(ur[e][cp]) : bflo(ur[e][cp]))
            float sw = 0.f;
#pragma unroll
            for (int j = 1; j < W; ++j) sw += PVAL(15 - j);
#pragma unroll
            for (int r = 0; r < 4; ++r) {
                const float um = PVAL(15 + r);
                sw += um;
                const float cnt = SAMPLE ? (float)W : (float)min(tb + 15 + r + 1, W);
                out[r][2 * cp + hf] = sw / cnt - um;
                sw -= PVAL(15 + r - (W - 1));
            }
#undef PVAL
        }
#pragma unroll
    for (int r = 0; r < 4; ++r) {
        u32x4 w; w.x = cvt_pk_bf16(out[r][0], out[r][1]); w.y = cvt_pk_bf16(out[r][2], out[r][3]); w.z = cvt_pk_bf16(out[r][4], out[r][5]); w.w = cvt_pk_bf16(out[r][6], out[r][7]);
        *(LAS u32x4*)(A + (4 * rq + r) * LDA + 8 * c8) = w;
    }
}
__device__ __forceinline__ void pool_item(LAS unsigned char* lds, int item, const bf16* zb, const float* cache, const bf16x8 (&wf)[8][2], bf16* mixb) {
    const int tile = item >> 2, g = item & 3, m0 = tile * 64;
    const int tid = threadIdx.x;
    constexpr int LDA = 264;
    LAS bf16* A = (LAS bf16*)lds;
    const int wave = tid >> 6, lane = tid & 63, fr = lane & 15, fq = lane >> 4, n0 = wave * 32;
    if (m0 < MP) { if (g == 0) pool_fill<2, false>(A, m0, g, zb, cache); else if (g == 1) pool_fill<4, false>(A, m0, g, zb, cache); else if (g == 2) pool_fill<8, false>(A, m0, g, zb, cache); else pool_fill<16, false>(A, m0, g, zb, cache); }
    else { if (g == 0) pool_fill<2, true>(A, m0, g, zb, cache); else if (g == 1) pool_fill<4, true>(A, m0, g, zb, cache); else if (g == 2) pool_fill<8, true>(A, m0, g, zb, cache); else pool_fill<16, true>(A, m0, g, zb, cache); }
    __syncthreads();
    f32x4 acc[4][2];
#pragma unroll
    for (int i = 0; i < 4; ++i)
#pragma unroll
        for (int j = 0; j < 2; ++j) acc[i][j] = (f32x4){0.f, 0.f, 0.f, 0.f};
#pragma unroll
    for (int ks = 0; ks < 8; ++ks) {
        bf16x8 af[4];
#pragma unroll
        for (int mt = 0; mt < 4; ++mt) af[mt] = *(const LAS bf16x8*)(A + (mt * 16 + fr) * LDA + ks * 32 + fq * 8);
#pragma unroll
        for (int mt = 0; mt < 4; ++mt)
#pragma unroll
            for (int nt = 0; nt < 2; ++nt) acc[mt][nt] = __builtin_amdgcn_mfma_f32_16x16x32_bf16(wf[ks][nt], af[mt], acc[mt][nt], 0, 0, 0);
    }
#pragma unroll
    for (int mt = 0; mt < 4; ++mt)
#pragma unroll
        for (int nt = 0; nt < 2; ++nt) {
            u32x2 o; o.x = cvt_pk_bf16(acc[mt][nt][0], acc[mt][nt][1]); o.y = cvt_pk_bf16(acc[mt][nt][2], acc[mt][nt][3]);
            *(u32x2*)(mixb + (size_t)(m0 + mt * 16 + fr) * D + g * 256 + n0 + nt * 16 + 4 * fq) = o;
        }
    __syncthreads();
}

struct SampleRegs { f32x4 S[8]; };
__device__ __forceinline__ void sample_load(SampleRegs& R, const float* S0) {
    const int tid = threadIdx.x, v4 = tid & 31, kq = tid >> 5;
#pragma unroll
    for (int kk = 0; kk < 8; ++kk) R.S[kk] = __builtin_nontemporal_load((const f32x4*)(S0 + (size_t)(kq * 8 + kk) * HD + 4 * v4));
}
struct SampleStage { float lfv[2]; bf16 q[2], v[2]; bf16 g[2]; float gn[2]; };
__device__ __forceinline__ void sample_stage(SampleStage& st, const bf16* zb, const float* lf, const float* hgn, int row0, int h) {
    const int tid = threadIdx.x;
#pragma unroll
    for (int j = 0; j < 2; ++j) {
        const int i = tid + 512 * j, t = i >> 7, ch = i & 127; const size_t row = (size_t)(row0 + t);
        st.lfv[j] = lf[row * HW + h * HD + ch]; st.q[j] = zb[row * INC + PW + h * HD + ch]; st.v[j] = zb[row * INC + PW + 2 * HW + h * HD + ch];
    }
    const int wave = tid >> 6, lane = tid & 63;
#pragma unroll
    for (int j = 0; j < 2; ++j) { st.g[j] = zb[(size_t)(row0 + wave) * INC + PW + 3 * HW + h * HD + lane + 64 * j]; st.gn[j] = hgn[h * HD + lane + 64 * j]; }
}
__device__ __forceinline__ void sample_run(LAS unsigned char* lds, SampleRegs& R, const SampleStage& st, const bf16* zb, const float* hgn, float* Sout, bf16* mixb, int row0, int h) {
    const int tid = threadIdx.x, v4 = tid & 31, kq = tid >> 5, wave = tid >> 6, lane = tid & 63;
    LAS float* sq = (LAS float*)lds; LAS float* sf = sq + 1024; LAS float* sk = sf + 1024; LAS float* sv = sk + 1024; LAS float* red = sv + 1024;
#pragma unroll
    for (int j = 0; j < 2; ++j) {
        const int i = tid + 512 * j;
        const float f = __builtin_amdgcn_exp2f(st.lfv[j]);
        sq[i] = bf2f(st.q[j]); sf[i] = f; sk[i] = 1.f - f; sv[i] = bf2f(st.v[j]);
    }
    __syncthreads();
#pragma unroll 1
    for (int t = 0; t < 8; ++t) {
        const f32x4 vt = *(const LAS f32x4*)(sv + t * 128 + 4 * v4);
        f32x4 o = (f32x4){0.f, 0.f, 0.f, 0.f};
        const f32x4 f0 = *(const LAS f32x4*)(sf + t * 128 + kq * 8), f1 = *(const LAS f32x4*)(sf + t * 128 + kq * 8 + 4);
        const f32x4 k0 = *(const LAS f32x4*)(sk + t * 128 + kq * 8), k1 = *(const LAS f32x4*)(sk + t * 128 + kq * 8 + 4);
        const f32x4 q0 = *(const LAS f32x4*)(sq + t * 128 + kq * 8), q1 = *(const LAS f32x4*)(sq + t * 128 + kq * 8 + 4);
#pragma unroll
        for (int kk = 0; kk < 8; ++kk) {
            const float f = kk < 4 ? f0[kk & 3] : f1[kk & 3], kn = kk < 4 ? k0[kk & 3] : k1[kk & 3], q = kk < 4 ? q0[kk & 3] : q1[kk & 3];
            R.S[kk] = R.S[kk] * f + vt * kn;
            o = o + R.S[kk] * q;
        }
#pragma unroll
        for (int j = 0; j < 4; ++j) o[j] += __shfl_xor(o[j], 32);
        if (lane < 32) *(LAS f32x4*)(red + (wave * 8 + t) * 128 + 4 * v4) = o;
    }
#pragma unroll
    for (int kk = 0; kk < 8; ++kk) __builtin_nontemporal_store(R.S[kk], (f32x4*)(Sout + (size_t)(kq * 8 + kk) * HD + 4 * v4));
    __syncthreads();
    {
        const int t = wave; const size_t row = (size_t)(row0 + t);
        float o0 = 0.f, o1 = 0.f;
#pragma unroll
        for (int w8 = 0; w8 < 8; ++w8) { o0 += red[(w8 * 8 + t) * 128 + lane]; o1 += red[(w8 * 8 + t) * 128 + lane + 64]; }
        const float ss = wave_sum(o0 * o0 + o1 * o1), r = rsqrtf(ss * (1.f / HD) + EPS);
        const int ch0 = h * HD + lane, ch1 = ch0 + 64;
        mixb[row * D + PW + ch0] = f2bf(o0 * r * st.gn[0] * bf2f(st.g[0]));
        mixb[row * D + PW + ch1] = f2bf(o1 * r * st.gn[1] * bf2f(st.g[1]));
    }
    __syncthreads();
}

constexpr int CQS = 272, CTS = 144;
constexpr int L_Q = 0, L_K = L_Q + 64 * CQS, L_KT = L_K + 64 * CQS, L_VT = L_KT + 128 * CTS, L_ST = L_VT + 128 * CTS, L_P = L_ST + 128 * CQS,
              L_DS = L_P + 64 * CTS, L_TOT = L_DS + 512, L_RMS = L_TOT + 8192, L_CHAIN_END = L_RMS + 512;
static_assert(L_CHAIN_END <= 131072, "chain LDS");
struct SegIn { f32x4 lf[4]; u32x2 v[4], sq[4]; };
template <bool FULL>
__device__ __forceinline__ void seg_load(SegIn& I, const bf16* zb, const float* lf, int row0, int h) {
    const int tid = threadIdx.x, cg = tid & 31, tgp = tid >> 5;
#pragma unroll
    for (int j = 0; j < 4; ++j) {
        const size_t row = (size_t)(row0 + 4 * tgp + j);
        I.lf[j] = *(const f32x4*)(lf + row * HW + h * HD + 4 * cg);
        I.v[j] = *(const u32x2*)(zb + row * INC + PW + 2 * HW + h * HD + 4 * cg);
        if (FULL) I.sq[j] = *(const u32x2*)(zb + row * INC + PW + h * HD + 4 * cg);
    }
}
template <bool FULL>
__device__ __forceinline__ void seg_run(LAS unsigned char* lds, SegIn& I, const bf16* zb, const float* lf, f32x4 (&Sacc)[8], f32x4& segsum, const f32x4 (&gnr)[4], bf16* mixb, int rowb, int nsteps, int h) {
    const int tid = threadIdx.x, lane = tid & 63, wave = __builtin_amdgcn_readfirstlane(tid >> 6), fr = lane & 15, fq = lane >> 4;
    const int cg = tid & 31, tgp = tid >> 5;
    LAS float* dS = (LAS float*)(lds + L_DS); LAS float* tot = (LAS float*)(lds + L_TOT); LAS float* rmsp = (LAS float*)(lds + L_RMS);
    *(LAS f32x4*)(tot + tgp * 128 + 4 * cg) = (I.lf[0] + I.lf[1]) + (I.lf[2] + I.lf[3]);
    if (FULL) {
#pragma unroll
        for (int kt = 0; kt < 8; ++kt) {
            u32x2 w; w.x = cvt_pk_bf16(Sacc[kt][0], Sacc[kt][1]); w.y = cvt_pk_bf16(Sacc[kt][2], Sacc[kt][3]);
            *(LAS u32x2*)(lds + L_ST + (16 * wave + fr) * CQS + (16 * kt + 4 * fq) * 2) = w;
        }
    }
    __syncthreads();
    for (int c = 0; c < nsteps; ++c) {
        {
            f32x4 b = (f32x4){0.f, 0.f, 0.f, 0.f};
#pragma unroll
            for (int g = 0; g < 15; ++g) { const f32x4 tv = *(const LAS f32x4*)(tot + g * 128 + 4 * cg); if (g < tgp) b = b + tv; }
            float kt[4][4], qt[4][4];
#pragma unroll
            for (int j = 0; j < 4; ++j) {
                b = b + I.lf[j];
                const float kn0 = 1.f - __builtin_amdgcn_exp2f(I.lf[j][0]), kn1 = 1.f - __builtin_amdgcn_exp2f(I.lf[j][1]), kn2 = 1.f - __builtin_amdgcn_exp2f(I.lf[j][2]), kn3 = 1.f - __builtin_amdgcn_exp2f(I.lf[j][3]);
                kt[j][0] = kn0 * __builtin_amdgcn_exp2f(-b[0]); kt[j][1] = kn1 * __builtin_amdgcn_exp2f(-b[1]); kt[j][2] = kn2 * __builtin_amdgcn_exp2f(-b[2]); kt[j][3] = kn3 * __builtin_amdgcn_exp2f(-b[3]);
                if (FULL) {
                    qt[j][0] = bflo(I.sq[j].x) * __builtin_amdgcn_exp2f(b[0]); qt[j][1] = bfhi(I.sq[j].x) * __builtin_amdgcn_exp2f(b[1]); qt[j][2] = bflo(I.sq[j].y) * __builtin_amdgcn_exp2f(b[2]); qt[j][3] = bfhi(I.sq[j].y) * __builtin_amdgcn_exp2f(b[3]);
                    const int t = 4 * tgp + j;
                    u32x2 qw, kw; qw.x = cvt_pk_bf16(qt[j][0], qt[j][1]); qw.y = cvt_pk_bf16(qt[j][2], qt[j][3]); kw.x = cvt_pk_bf16(kt[j][0], kt[j][1]); kw.y = cvt_pk_bf16(kt[j][2], kt[j][3]);
                    *(LAS u32x2*)(lds + L_Q + t * CQS + cg * 8) = qw;
                    *(LAS u32x2*)(lds + L_K + t * CQS + cg * 8) = kw;
                }
            }
#pragma unroll
            for (int ch = 0; ch < 4; ++ch) {
                u32x2 kw; kw.x = cvt_pk_bf16(kt[0][ch], kt[1][ch]); kw.y = cvt_pk_bf16(kt[2][ch], kt[3][ch]);
                *(LAS u32x2*)(lds + L_KT + (4 * cg + ch) * CTS + tgp * 8) = kw;
                const unsigned w0 = (ch < 2) ? I.v[0].x : I.v[0].y, w1 = (ch < 2) ? I.v[1].x : I.v[1].y, w2 = (ch < 2) ? I.v[2].x : I.v[2].y, w3 = (ch < 2) ? I.v[3].x : I.v[3].y;
                u32x2 vw;
                if (ch & 1) { vw.x = (w0 >> 16) | (w1 & 0xffff0000u); vw.y = (w2 >> 16) | (w3 & 0xffff0000u); }
                else { vw.x = (w0 & 0xffffu) | (w1 << 16); vw.y = (w2 & 0xffffu) | (w3 << 16); }
                *(LAS u32x2*)(lds + L_VT + (4 * cg + ch) * CTS + tgp * 8) = vw;
            }
            if (tgp == 15) {
                f32x4 e; e[0] = __builtin_amdgcn_exp2f(b[0]); e[1] = __builtin_amdgcn_exp2f(b[1]); e[2] = __builtin_amdgcn_exp2f(b[2]); e[3] = __builtin_amdgcn_exp2f(b[3]);
                *(LAS f32x4*)(dS + 4 * cg) = e; segsum = segsum + b;
            }
        }
        __syncthreads();
        u32x2 sgr[4];
        if (FULL) {
#pragma unroll
            for (int i = 0; i < 4; ++i) sgr[i] = *(const u32x2*)(zb + (size_t)(rowb + 64 * c + 16 * (wave & 3) + fr) * INC + PW + 3 * HW + h * HD + 16 * (4 * (wave >> 2) + i) + 4 * fq);
        }
        if (c + 1 < nsteps) seg_load<FULL>(I, zb, lf, rowb + 64 * (c + 1), h);
        if (FULL) {
#pragma unroll
            for (int i = 0; i < 2; ++i) {
                const int ti = 2 * wave + i, tt = ti >> 2, st = ti & 3;
                f32x4 p = (f32x4){0.f, 0.f, 0.f, 0.f};
#pragma unroll
                for (int ks = 0; ks < 4; ++ks) {
                    const bf16x8 ka = *(const LAS bf16x8*)(lds + L_K + (16 * st + fr) * CQS + (32 * ks + 8 * fq) * 2);
                    const bf16x8 qb = *(const LAS bf16x8*)(lds + L_Q + (16 * tt + fr) * CQS + (32 * ks + 8 * fq) * 2);
                    p = __builtin_amdgcn_mfma_f32_16x16x32_bf16(ka, qb, p, 0, 0, 0);
                }
                const int t = 16 * tt + fr, s0 = 16 * st + 4 * fq;
                u32x2 w; w.x = cvt_pk_bf16(s0 + 0 <= t ? p[0] : 0.f, s0 + 1 <= t ? p[1] : 0.f); w.y = cvt_pk_bf16(s0 + 2 <= t ? p[2] : 0.f, s0 + 3 <= t ? p[3] : 0.f);
                *(LAS u32x2*)(lds + L_P + t * CTS + s0 * 2) = w;
            }
        }
        {
            bf16x8 vb[2];
#pragma unroll
            for (int ss = 0; ss < 2; ++ss) vb[ss] = *(const LAS bf16x8*)(lds + L_VT + (16 * wave + fr) * CTS + (32 * ss + 8 * fq) * 2);
#pragma unroll
            for (int kt = 0; kt < 8; ++kt)
#pragma unroll
                for (int ss = 0; ss < 2; ++ss) {
                    const bf16x8 ka = *(const LAS bf16x8*)(lds + L_KT + (16 * kt + fr) * CTS + (32 * ss + 8 * fq) * 2);
                    Sacc[kt] = __builtin_amdgcn_mfma_f32_16x16x32_bf16(ka, vb[ss], Sacc[kt], 0, 0, 0);
                }
        }
        const int tt = wave & 3, vh = wave >> 2;
        f32x4 o[4];
        if (FULL) {
            __syncthreads();
            bf16x8 pb[2], qb[4];
#pragma unroll
            for (int ss = 0; ss < 2; ++ss) pb[ss] = *(const LAS bf16x8*)(lds + L_P + (16 * tt + fr) * CTS + (32 * ss + 8 * fq) * 2);
#pragma unroll
            for (int ks = 0; ks < 4; ++ks) qb[ks] = *(const LAS bf16x8*)(lds + L_Q + (16 * tt + fr) * CQS + (32 * ks + 8 * fq) * 2);
#pragma unroll
            for (int i = 0; i < 4; ++i) {
                const int vrow = 16 * (4 * vh + i) + fr;
                f32x4 a = (f32x4){0.f, 0.f, 0.f, 0.f};
#pragma unroll
                for (int ss = 0; ss < 2; ++ss) a = __builtin_amdgcn_mfma_f32_16x16x32_bf16(*(const LAS bf16x8*)(lds + L_VT + vrow * CTS + (32 * ss + 8 * fq) * 2), pb[ss], a, 0, 0, 0);
#pragma unroll
                for (int ks = 0; ks < 4; ++ks) a = __builtin_amdgcn_mfma_f32_16x16x32_bf16(*(const LAS bf16x8*)(lds + L_ST + vrow * CQS + (32 * ks + 8 * fq) * 2), qb[ks], a, 0, 0, 0);
                o[i] = a;
            }
            float ss2 = 0.f;
#pragma unroll
            for (int i = 0; i < 4; ++i) ss2 += (o[i][0] * o[i][0] + o[i][1] * o[i][1]) + (o[i][2] * o[i][2] + o[i][3] * o[i][3]);
            ss2 += __shfl_xor(ss2, 16); ss2 += __shfl_xor(ss2, 32);
            if (fq == 0) rmsp[vh * 64 + 16 * tt + fr] = ss2;
        }
#pragma unroll
        for (int kt = 0; kt < 8; ++kt) Sacc[kt] = Sacc[kt] * *(const LAS f32x4*)(dS + 16 * kt + 4 * fq);
        if (c + 1 < nsteps) *(LAS f32x4*)(tot + tgp * 128 + 4 * cg) = (I.lf[0] + I.lf[1]) + (I.lf[2] + I.lf[3]);
        __syncthreads();
        if (FULL) {
            const int tl = 16 * tt + fr; const size_t row = (size_t)(rowb + 64 * c + tl);
            const float r = rsqrtf((rmsp[tl] + rmsp[64 + tl]) * (1.f / HD) + EPS);
#pragma unroll
            for (int i = 0; i < 4; ++i) {
                const int ch = h * HD + 16 * (4 * vh + i) + 4 * fq;
                const f32x4 gn = gnr[i];
                const u32x2 sg = sgr[i];
                const float g0 = __builtin_bit_cast(float, sg.x << 16), g1 = __builtin_bit_cast(float, sg.x & 0xffff0000u), g2 = __builtin_bit_cast(float, sg.y << 16), g3 = __builtin_bit_cast(float, sg.y & 0xffff0000u);
                u32x2 w; w.x = cvt_pk_bf16(o[i][0] * r * gn[0] * g0, o[i][1] * r * gn[1] * g1); w.y = cvt_pk_bf16(o[i][2] * r * gn[2] * g2, o[i][3] * r * gn[3] * g3);
                *(u32x2*)(mixb + row * D + PW + ch) = w;
            }
#pragma unroll
            for (int kt = 0; kt < 8; ++kt) {
                u32x2 w; w.x = cvt_pk_bf16(Sacc[kt][0], Sacc[kt][1]); w.y = cvt_pk_bf16(Sacc[kt][2], Sacc[kt][3]);
                *(LAS u32x2*)(lds + L_ST + (16 * wave + fr) * CQS + (16 * kt + 4 * fq) * 2) = w;
            }
        }
    }
    __syncthreads();
}

#ifndef P2_ORDER_OLD
#define P2_ORDER_OLD 0
#endif
constexpr int CW_FLAG = 32768;
__device__ __forceinline__ void prompt_pass1(LAS unsigned char* lds, const Args& a, int chain, int seg, int nseg) {
    if (seg + 1 >= nseg) return;
    unsigned char* ws = a.ws;
    const bf16* zb = (const bf16*)(ws + WS_ZB); const float* lf = (const float*)(ws + WS_LF); bf16* mixb = (bf16*)(ws + WS_MIX);
    const int tid = threadIdx.x;
    const int b = chain / NH, h = chain % NH, seglen = SEQ / nseg, nsteps = seglen / 64, rowb = b * SEQ + seg * seglen;
    f32x4* slab = (f32x4*)(ws + WS_XB);
    float* dseg = (float*)(ws + WS_XB + 16 * MiB);
    unsigned* flags = (unsigned*)(ws + WS_CTL) + CW_FLAG;
    f32x4 gnr[4];
#pragma unroll
    for (int i = 0; i < 4; ++i) gnr[i] = (f32x4){0.f, 0.f, 0.f, 0.f};
    f32x4 Sacc[8];
#pragma unroll
    for (int i = 0; i < 8; ++i) Sacc[i] = (f32x4){0.f, 0.f, 0.f, 0.f};
    f32x4 segsum = (f32x4){0.f, 0.f, 0.f, 0.f};
    SegIn I; seg_load<false>(I, zb, lf, rowb, h);
    seg_run<false>(lds, I, zb, lf, Sacc, segsum, gnr, mixb, rowb, nsteps, h);
    const __amdgpu_buffer_rsrc_t srs = __builtin_amdgcn_make_buffer_rsrc((void*)(slab + (size_t)(chain * 8 + seg) * 4096), (short)0, 4096 * 16, 0x00020000);
#pragma unroll
    for (int kt = 0; kt < 8; ++kt) __builtin_amdgcn_raw_buffer_store_b128(__builtin_bit_cast(u32x4, Sacc[kt]), srs, (unsigned)((kt * 512 + tid) * 16), 0, 16);
    if ((tid >> 5) == 15) {
#pragma unroll
        for (int j = 0; j < 4; ++j) __hip_atomic_store((unsigned*)dseg + (chain * 8 + seg) * 128 + 4 * (tid & 31) + j, __builtin_bit_cast(unsigned, __builtin_amdgcn_exp2f(segsum[j])), __ATOMIC_RELAXED, __HIP_MEMORY_SCOPE_AGENT);
    }
    asm volatile("s_waitcnt vmcnt(0)" ::: "memory");
    __syncthreads();
    if (tid == 0) __hip_atomic_store(flags + 64 * (chain * 8 + seg), 1u, __ATOMIC_RELAXED, __HIP_MEMORY_SCOPE_AGENT);
}
__device__ __forceinline__ void prompt_pass2(LAS unsigned char* lds, const Args& a, int chain, int seg, int nseg) {
    unsigned char* ws = a.ws;
    const bf16* zb = (const bf16*)(ws + WS_ZB); const float* lf = (const float*)(ws + WS_LF); bf16* mixb = (bf16*)(ws + WS_MIX);
    const int tid = threadIdx.x, lane = tid & 63, wave = __builtin_amdgcn_readfirstlane(tid >> 6), fr = lane & 15, fq = lane >> 4;
    const int b = chain / NH, h = chain % NH, seglen = SEQ / nseg, nsteps = seglen / 64, rowb = b * SEQ + seg * seglen;
    const f32x4* slab = (const f32x4*)(ws + WS_XB);
    const float* dseg = (const float*)(ws + WS_XB + 16 * MiB);
    unsigned* flags = (unsigned*)(ws + WS_CTL) + CW_FLAG;
    f32x4 gnr[4];
#pragma unroll
    for (int i = 0; i < 4; ++i) gnr[i] = *(const f32x4*)(a.in[9] + h * HD + 16 * (4 * (wave >> 2) + i) + 4 * fq);
    f32x4 Sacc[8];
#pragma unroll
    for (int i = 0; i < 8; ++i) Sacc[i] = (f32x4){0.f, 0.f, 0.f, 0.f};
    f32x4 segsum = (f32x4){0.f, 0.f, 0.f, 0.f};
    SegIn I; seg_load<true>(I, zb, lf, rowb, h);
    if (seg > 0) {
        if (tid < 64) {
            for (int i = 0; i < seg; ++i) { unsigned sp = 0; while (__hip_atomic_load(flags + 64 * (chain * 8 + i), __ATOMIC_RELAXED, __HIP_MEMORY_SCOPE_AGENT) == 0u && ++sp < (1u << 22)) __builtin_amdgcn_s_sleep(2); }
            __builtin_amdgcn_fence(__ATOMIC_ACQUIRE, "agent");
            asm volatile("s_waitcnt vmcnt(0)" ::: "memory");
        }
        __syncthreads();
        f32x4 rc[8], rn[8];
#pragma unroll
        for (int kt = 0; kt < 8; ++kt) { rc[kt] = slab[(size_t)(chain * 8) * 4096 + kt * 512 + tid]; rn[kt] = rc[kt]; }
        for (int i = 0; i < seg; ++i) {
            const float* dd = dseg + (chain * 8 + i) * 128;
            if (i + 1 < seg) {
#pragma unroll
                for (int kt = 0; kt < 8; ++kt) rn[kt] = slab[(size_t)(chain * 8 + i + 1) * 4096 + kt * 512 + tid];
            }
#pragma unroll
            for (int kt = 0; kt < 8; ++kt) Sacc[kt] = Sacc[kt] * *(const f32x4*)(dd + 16 * kt + 4 * fq) + rc[kt];
#pragma unroll
            for (int kt = 0; kt < 8; ++kt) rc[kt] = rn[kt];
        }
    }
    seg_run<true>(lds, I, zb, lf, Sacc, segsum, gnr, mixb, rowb, nsteps, h);
    if (seg + 1 == nseg) {
        float* Sout = a.out + O_HSP + (size_t)chain * HD * HD;
#pragma unroll
        for (int kt = 0; kt < 8; ++kt)
#pragma unroll
            for (int j = 0; j < 4; ++j) Sout[(size_t)(16 * kt + 4 * fq + j) * HD + 16 * wave + fr] = Sacc[kt][j];
    }
}

__device__ __forceinline__ void phase2(LAS unsigned char* lds, const Args& a, int bid, int G, int parts = 7) {
    unsigned char* ws = a.ws;
    const bf16* zb = (const bf16*)(ws + WS_ZB); const float* lf = (const float*)(ws + WS_LF); bf16* mixb = (bf16*)(ws + WS_MIX);
    constexpr int NPC = NB * NH, NSC = DB * NH, NPOOL = (M / 64) * 4;
    const int nseg = (G >= 8 * NPC) ? 8 : (G >= 4 * NPC ? 4 : (G >= 2 * NPC ? 2 : 1));
    if ((parts & 1) && nseg > 1 && bid < nseg * NPC) prompt_pass1(lds, a, bid / nseg, bid % nseg, nseg);
#if P2_ORDER_OLD
    if (parts & 1) {
        if (nseg > 1) { if (bid < nseg * NPC) prompt_pass2(lds, a, bid / nseg, bid % nseg, nseg); }
        else for (int c = bid; c < NPC; c += G) prompt_pass2(lds, a, c, 0, 1);
    }
#endif
    STAMP(5);
    if ((bid >> 3) & 1) {
    if (parts & 4) {
        const int first = (NSC + G - 1 - bid) / G * G + bid;
        if (first < NSC + NPOOL) {
            const int lane = threadIdx.x & 63, n0 = (threadIdx.x >> 6) * 32;
            const bf16* WpT = (const bf16*)(ws + WS_WP);
            bf16x8 wf[8][2];
            for (int it = first; it < NSC + NPOOL; it += G) {
                if (it == first || (G & 3)) {
                    const int g = (it - NSC) & 3;
#pragma unroll
                    for (int ks = 0; ks < 8; ++ks)
#pragma unroll
                        for (int nt = 0; nt < 2; ++nt) wf[ks][nt] = *(const bf16x8*)(WpT + (size_t)(g * 256 + n0 + nt * 16 + (lane & 15)) * 256 + ks * 32 + (lane >> 4) * 8);
                }
                pool_item(lds, it - NSC, zb, a.in[2], wf, mixb);
            }
        }
    }
    if (parts & 2) {
        SampleRegs cur, nxt;
        if (bid < NSC) sample_load(cur, a.in[3] + (size_t)bid * HD * HD);
        for (int it = bid; it < NSC; it += G) {
            const bool pf = it + G < NSC;
            SampleStage st; sample_stage(st, zb, lf, a.in[9], MP + (it / NH) * DS, it % NH);
            if (pf) sample_load(nxt, a.in[3] + (size_t)(it + G) * HD * HD);
            sample_run(lds, cur, st, zb, a.in[9], a.out + O_HSS + (size_t)it * HD * HD, mixb, MP + (it / NH) * DS, it % NH);
            if (pf) {
#pragma unroll
                for (int kk = 0; kk < 8; ++kk) cur.S[kk] = nxt.S[kk];
            }
        }
    }
    } else {
    if (parts & 2) {
        SampleRegs cur, nxt;
        if (bid < NSC) sample_load(cur, a.in[3] + (size_t)bid * HD * HD);
        for (int it = bid; it < NSC; it += G) {
            const bool pf = it + G < NSC;
            SampleStage st; sample_stage(st, zb, lf, a.in[9], MP + (it / NH) * DS, it % NH);
            if (pf) sample_load(nxt, a.in[3] + (size_t)(it + G) * HD * HD);
            sample_run(lds, cur, st, zb, a.in[9], a.out + O_HSS + (size_t)it * HD * HD, mixb, MP + (it / NH) * DS, it % NH);
            if (pf) {
#pragma unroll
                for (int kk = 0; kk < 8; ++kk) cur.S[kk] = nxt.S[kk];
            }
        }
    }
    if (parts & 4) {
        const int first = (NSC + G - 1 - bid) / G * G + bid;
        if (first < NSC + NPOOL) {
            const int lane = threadIdx.x & 63, n0 = (threadIdx.x >> 6) * 32;
            const bf16* WpT = (const bf16*)(ws + WS_WP);
            bf16x8 wf[8][2];
            for (int it = first; it < NSC + NPOOL; it += G) {
                if (it == first || (G & 3)) {
                    const int g = (it - NSC) & 3;
#pragma unroll
                    for (int ks = 0; ks < 8; ++ks)
#pragma unroll
                        for (int nt = 0; nt < 2; ++nt) wf[ks][nt] = *(const bf16x8*)(WpT + (size_t)(g * 256 + n0 + nt * 16 + (lane & 15)) * 256 + ks * 32 + (lane >> 4) * 8);
                }
                pool_item(lds, it - NSC, zb, a.in[2], wf, mixb);
            }
        }
    }
    }
    STAMP(6);
    if (!P2_ORDER_OLD && (parts & 1)) {
        if (nseg > 1) { if (bid < nseg * NPC) prompt_pass2(lds, a, bid / nseg, bid % nseg, nseg); }
        else for (int c = bid; c < NPC; c += G) prompt_pass2(lds, a, c, 0, 1);
    }
}

__device__ __forceinline__ void phase6(const Args& a, int vcu, int G, size_t x2off) {
    const int tid = threadIdx.x, lane = tid & 63, wave = tid >> 6;
#ifdef TPROBE
    { unsigned d = *((const unsigned*)(a.ws + WS_CTL) + CW_TP); if (TP_MODE == 2) d = 0x40000000u - d;
#ifdef TP_CAL
      d = TP_REF_US * 95;
#endif
      const float delta = 0.01f * ((float)d * 0.01f) / (float)(TP_REF_US);
      for (int i = vcu * (NWAVES * 64) + tid; i < NB * PC * PW; i += G * NWAVES * 64) a.out[O_PSP + i] += delta; }
#endif
    const int gw = vcu * NWAVES + wave, NGW = G * NWAVES;
    const float* rsq3 = (const float*)(a.ws + WS_CTL) + CW_RSQ3;
    for (int m = gw; m < M; m += NGW) {
        float* yr = a.out + O_Y + (size_t)m * D; const bf16* xr = (const bf16*)(a.ws + x2off) + (size_t)m * D;
        const float r = rsqrtf(rsq3[m] * (1.f / D) + EPS);
#pragma unroll
        for (int j = 0; j < 4; ++j) {
            const u32x4 xw = __builtin_nontemporal_load((const u32x4*)xr + lane + 64 * j);
            const f32x4 g0 = ((const f32x4*)a.in[15])[2 * (lane + 64 * j)], g1 = ((const f32x4*)a.in[15])[2 * (lane + 64 * j) + 1];
            __builtin_nontemporal_store((f32x4){bflo(xw.x), bfhi(xw.x), bflo(xw.y), bfhi(xw.y)} * r * g0, (f32x4*)yr + 2 * (lane + 64 * j));
            __builtin_nontemporal_store((f32x4){bflo(xw.z), bfhi(xw.z), bflo(xw.w), bfhi(xw.w)} * r * g1, (f32x4*)yr + 2 * (lane + 64 * j) + 1);
        }
    }
}

__global__ void __launch_bounds__(NWAVES * 64, 2) mega(Args a) {
    extern __shared__ __attribute__((aligned(16))) unsigned char lds_raw[];
    LAS unsigned char* lds = (LAS unsigned char*)lds_raw;
    const int G = gridDim.x, bid = blockIdx.x;
    const int vcu = (G % 8 == 0) ? (bid % 8) * (G / 8) + bid / 8 : bid;
    unsigned char* ws = a.ws;
    float* ctlf = (float*)(ws + WS_CTL);
    const int lo = a.ph_lo, hi = a.ph_hi;
#if ONE_LAUNCH && USE_CG
    cg::grid_group grid = cg::this_grid();
#define GRID_BAR() grid.sync()
#elif ONE_LAUNCH
    volatile LAS unsigned* MISC = (volatile LAS unsigned*)(lds + MISC_OFF);
    if (threadIdx.x < 32) MISC[threadIdx.x] = 0u;
    __syncthreads();
    XcdBarrier bar = xcd_barrier_post((unsigned*)(ws + WS_CTL) + CW_BAR, MISC + 8);
#define GRID_BAR() xcd_barrier(bar)
#else
#define GRID_BAR() do {} while (0)
#endif
#ifndef PH_MASK
#define PH_MASK 0x7f
#endif
#define IN(k) (((PH_MASK >> (k)) & 1) && lo <= (k) && (k) < hi)
#define BOTH(k) (IN(k) && IN((k) + 1))
#ifndef REP_MASK
#define REP_MASK 0
#endif
#define REP(k) ((REP_MASK >> (k)) & 1)
#ifndef P2_REP_PARTS
#define P2_REP_PARTS 7
#endif
    STAMP(0);
    if (IN(0)) { if (REP(0)) { phase0(lds, a, vcu, G); __syncthreads(); } phase0(lds, a, vcu, G); STAMP(1); if (BOTH(0)) GRID_BAR(); STAMP(2); }
    if (IN(1)) {
        pg8::Gemm g{(const bf16*)(ws + WS_XB), (const bf16*)(ws + WS_WIN), M, INC, D}; pg8::HybridOrder S; S.init(M, INC, D, G, bid, false);
        const pg8::TailCtx T{nullptr, nullptr};
        pg8::EpiZ E{(bf16*)(ws + WS_ZB), (float*)(ws + WS_LF), (const float*)(ws + WS_MISC), (const float*)(ws + WS_MISC) + M, a.out};
        if (REP(1)) pg8::gemm_phase2(lds, g, S, E, T);
        pg8::gemm_phase2(lds, g, S, E, T);
        { const int nidle = p1_idle_wgs(G); if (nidle >= 32 && bid >= G - nidle) phase0_deferred(lds, a, bid - (G - nidle), nidle); }
        STAMP(3);
        if (BOTH(1)) GRID_BAR();
        STAMP(4);
    }
    if (IN(2)) { if (REP(2)) { phase2(lds, a, bid, G, P2_REP_PARTS); __syncthreads(); } phase2(lds, a, bid, G); STAMP(7); if (BOTH(2)) GRID_BAR(); STAMP(8); }
    const bool merged = MERGED && G == 256 && lo <= 3 && hi >= 6;
    if (merged) {
        pg8::MOrder S{bid};
        constexpr pg8::StreamOff O{WS_MIX, WS_WO, WS_XB, WS_WGU, WS_ACT, WS_WD, WS_MIX, WS_SLABM, CW_DEP, CW_DEP + 4096, CW_TAIL, CW_RSQ2, CW_RSQ3};
        pg8::gemm_stream(lds, S, ws, a.in[0], a.in[1], O);
        STAMP(13);
#ifdef TPROBE
        if (threadIdx.x == 0) { volatile LAS unsigned long long* ts = (volatile LAS unsigned long long*)(lds + MISC_OFF + 128); const unsigned d = (unsigned)(ts[TP_B] - ts[TP_A]);
            unsigned* w = (unsigned*)(ws + WS_CTL) + CW_TP; if (TP_MODE == 0) { if (bid == TP_BLOCK) atomicMax(w, d); } else if (TP_MODE == 1) atomicMax(w, d); else atomicMax(w, 0x40000000u - d); }
#endif
        GRID_BAR();
    }
    if (!merged && IN(3)) {
        pg8::Gemm g{(const bf16*)(ws + WS_MIX), (const bf16*)(ws + WS_WO), M, D, D}; pg8::HybridOrder S; S.init(M, D, D, G, bid, true);
        const pg8::TailCtx T{(f32x4*)(ws + WS_SLAB3), (unsigned*)(ws + WS_CTL) + CW_TAIL};
        if (REP(3)) { pg8::EpiX1<true> E0{a.in[0], a.in[1], a.out + O_Y, (bf16*)(ws + WS_XB), ctlf + CW_RSQ2, false}; pg8::gemm_phase2(lds, g, S, E0, T); }
        pg8::EpiX1<false> E{a.in[0], a.in[1], a.out + O_Y, (bf16*)(ws + WS_XB), ctlf + CW_RSQ2, false};
        pg8::gemm_phase2(lds, g, S, E, T);
        STAMP(9);
        if (BOTH(3)) GRID_BAR();
        STAMP(10);
    }
    if (!merged && IN(4)) {
        pg8::Gemm g{(const bf16*)(ws + WS_XB), (const bf16*)(ws + WS_WGU), M, 2 * DFF, D}; pg8::HybridOrder S; S.init(M, 2 * DFF, D, G, bid, true);
        const pg8::TailCtx T{(f32x4*)(ws + WS_SLAB45), (unsigned*)(ws + WS_CTL) + CW_TAIL + 8192};
        pg8::EpiAct E{(bf16*)(ws + WS_ACT), ctlf + CW_RSQ2, false};
        if (REP(4)) pg8::gemm_phase2(lds, g, S, E, T);
        pg8::gemm_phase2(lds, g, S, E, T);
        STAMP(11);
        if (BOTH(4)) GRID_BAR();
        STAMP(12);
    }
    if (!merged && IN(5)) {
        pg8::Gemm g{(const bf16*)(ws + WS_ACT), (const bf16*)(ws + WS_WD), M, D, DFF}; pg8::HybridOrder S; S.init(M, D, DFF, G, bid, true);
        const pg8::TailCtx T{(f32x4*)(ws + WS_SLAB45), (unsigned*)(ws + WS_CTL) + CW_TAIL + 16384};
        if (REP(5)) { pg8::EpiX2<true> E0{(bf16*)(ws + WS_X2B), ctlf + CW_RSQ3, (const bf16*)(ws + WS_XB)}; pg8::gemm_phase2(lds, g, S, E0, T); }
        pg8::EpiX2<false> E{(bf16*)(ws + WS_X2B), ctlf + CW_RSQ3, (const bf16*)(ws + WS_XB)};
        pg8::gemm_phase2(lds, g, S, E, T);
        STAMP(13);
#ifdef TPROBE
        if (threadIdx.x == 0) { volatile LAS unsigned long long* ts = (volatile LAS unsigned long long*)(lds + MISC_OFF + 128); const unsigned d = (unsigned)(ts[TP_B] - ts[TP_A]);
            unsigned* w = (unsigned*)(ws + WS_CTL) + CW_TP; if (TP_MODE == 0) { if (bid == TP_BLOCK) atomicMax(w, d); } else if (TP_MODE == 1) atomicMax(w, d); else atomicMax(w, 0x40000000u - d); }
#endif
        if (BOTH(5)) GRID_BAR();
    }
    if (IN(6)) phase6(a, vcu, G, merged ? WS_MIX : WS_X2B);
#undef IN
#undef BOTH
}

extern "C" void kernel_launch(void* const* d_in, const int* in_sizes, int n_in, void* d_out, int out_size, void* d_ws, size_t ws_size, hipStream_t stream) {
    static int grid = 0;
    if (grid == 0) {
        if (n_in != 16 || ws_size < WS_END) { fprintf(stderr, "kernel_launch: unexpected n_in %d / ws_size %zu\n", n_in, ws_size); grid = -1; return; }
        int dev = 0, cus = 0, per_cu = 0;
        hipGetDevice(&dev);
        hipDeviceGetAttribute(&cus, hipDeviceAttributeMultiprocessorCount, dev);
        hipFuncSetAttribute((const void*)mega, hipFuncAttributeMaxDynamicSharedMemorySize, LDS_BYTES);
        hipOccupancyMaxActiveBlocksPerMultiprocessor(&per_cu, (const void*)mega, NWAVES * 64, LDS_BYTES);
        if (per_cu < 1) { fprintf(stderr, "kernel_launch: occupancy query says %d blocks per CU\n", per_cu); grid = -1; return; }
        grid = cus;
#ifdef FORCE_GRID
        grid = FORCE_GRID;
#endif
    }
    if (grid < 0) return;
    hipMemsetAsync((char*)d_ws + WS_CTL + (size_t)CW_BAR * 4, 0, XCD_BAR_WORDS * 4, stream);
#ifdef EXTRA_MEMSET
    hipMemsetAsync((char*)d_ws + WS_END - 8192, 0, 4096, stream);
#endif
    Args a{};
    for (int i = 0; i < 16; ++i) a.in[i] = (const float*)d_in[i];
    a.out = (float*)d_out; a.ws = (unsigned char*)d_ws;
#if ONE_LAUNCH
    a.ph_lo = 0; a.ph_hi = NPHASE;
    void* args[] = {&a};
#if USE_CG
    hipError_t e = hipLaunchCooperativeKernel((const void*)mega, dim3(grid), dim3(NWAVES * 64), args, LDS_BYTES, stream);
    if (e != hipSuccess) fprintf(stderr, "cooperative launch failed: %s (grid %d)\n", hipGetErrorString(e), grid);
#else
    (void)args; hipLaunchKernelGGL(mega, dim3(grid), dim3(NWAVES * 64), LDS_BYTES, stream, a);
#endif
#else
    for (int p = 0; p < NPHASE; ++p) { a.ph_lo = p; a.ph_hi = p + 1; hipLaunchKernelGGL(mega, dim3(grid), dim3(NWAVES * 64), LDS_BYTES, stream, a); }
#endif
}
```

```cpp
#include <hip/hip_runtime.h>
#include <hip/hip_cooperative_groups.h>
#include <cstdio>
#include <cstdint>
namespace cg = cooperative_groups;

constexpr int D = 2048, NB = 4, SEQ = 2048, DB = 128, DS = 8;
constexpr int MP = NB * SEQ, MS = DB * DS, M = MP + MS;
constexpr int PW = 1024, HW = 1024, HD = 128, NH = 8, PC = 15;
constexpr int DFF = 5632, INC = 5120;
constexpr float EPS = 1e-6f;
constexpr size_t O_Y = 0;
constexpr size_t O_PSP = (size_t)M * D;
constexpr size_t O_HSP = O_PSP + (size_t)NB * PC * PW;
constexpr size_t O_PSS = O_HSP + (size_t)NB * NH * HD * HD;
constexpr size_t O_HSS = O_PSS + (size_t)DB * PC * PW;

namespace pg8 {
#define PG8_LAS __attribute__((address_space(3)))
typedef unsigned short bf16_t;
typedef short bf16x8 __attribute__((ext_vector_type(8)));
typedef float f32x4 __attribute__((ext_vector_type(4)));
typedef unsigned u32x4 __attribute__((ext_vector_type(4)));
constexpr int BM = 256, BK = 64, HALF = 128, HTB = HALF * BK * 2  , STAGE_BYTES = 8 * HTB, NXCD = 8, WGM = 8;

__host__ __device__ __forceinline__ int lds_byte(int r, int c) { const int st = (r >> 4) * 2 + (c >> 5), rr = r & 15, cc = c & 31, ob = rr * 64 + cc * 2; return st * 1024 + (ob ^ (((ob >> 9) & 1) << 5)); }
__host__ __device__ __forceinline__ void stage_rc(int b, int& R, int& C) { const int st = b / 1024, sb = b % 1024, swz = sb ^ (((sb >> 9) & 1) << 5); R = (st >> 1) * 16 + swz / 64; C = (st & 1) * 32 + (swz % 64) / 2; }
__host__ __device__ __forceinline__ int perm32(int rho) { const int n = rho >> 4, i = rho & 15; return 8 * (i >> 2) + 4 * n + (i & 3); }

struct Unit { int pm, pn, kb, nk, tinfo; };
struct Gemm { const bf16_t* A; const bf16_t* Bt; int M, N, K; };

struct StaticOrder {
    int nM, nN, nwg, G, c;
    __host__ __device__ void init(int M, int N, int G_, int c_) { nM = M / BM; nN = N / BM; nwg = nM * nN; G = G_; c = c_; }
    __host__ __device__ bool next(int i, Unit& u) const {
        const long L = (long)i * G + c; if (L >= nwg) return false;
        int wgid = (int)L; { const int q = nwg / NXCD, r = nwg % NXCD, xcd = wgid % NXCD, off = wgid / NXCD; wgid = (xcd < r ? xcd * (q + 1) : r * (q + 1) + (xcd - r) * q) + off; }
        const int nig = WGM * nN, gid = wgid / nig, fm = gid * WGM, gsz = (nM - fm) < WGM ? (nM - fm) : WGM;
        u.pm = fm + ((wgid % nig) % gsz); u.pn = (wgid % nig) / gsz; u.kb = 0; u.nk = 0; u.tinfo = -1; return true;
    }
    __device__ __forceinline__ void a_ready(const Unit&) const {}
    __device__ __forceinline__ void done(const Unit&) const {}
};
typedef __bf16 bf16x2_hw __attribute__((ext_vector_type(2)));
typedef float f32x2_hw __attribute__((ext_vector_type(2)));
__device__ __forceinline__ unsigned cvt_pk_bf16(float lo, float hi) { const f32x2_hw v = {lo, hi}; return __builtin_bit_cast(unsigned, __builtin_convertvector(v, bf16x2_hw)); }
__device__ __forceinline__ float sigm(float x) { return __builtin_amdgcn_rcpf(1.f + __expf(-x)); }
__device__ __forceinline__ float silu(float x) { return x * __builtin_amdgcn_rcpf(1.f + __expf(-x)); }
typedef unsigned u32x2 __attribute__((ext_vector_type(2)));
__device__ __forceinline__ float bflo_(unsigned w) { return __builtin_bit_cast(float, w << 16); }
__device__ __forceinline__ float bfhi_(unsigned w) { return __builtin_bit_cast(float, w & 0xffff0000u); }

struct EpiZ {
    static constexpr bool PERM = true, AFTER_DRAIN = false;
    bf16_t* zb; float* lf; const float* rstd1; const float* lbv; float* out;
    __device__ __forceinline__ void prefetch(const Unit& u, int wr, int fr, float (&p)[8]) const {
#pragma unroll
        for (int i = 0; i < 8; ++i) p[i] = rstd1[u.pm * BM + wr * 64 + fr + (i >> 2) * HALF + (i & 3) * 16];
    }
    __device__ __forceinline__ void operator()(const f32x4 (&acc)[2][2][4][2], const Unit& u, int wr, int wc, int fr, int fq, unsigned gmask = 0xffu, const float* pre = nullptr) const {
        const int kind = u.pn >> 2;
        const int row0 = u.pm * BM + wr * 64 + fr;
        const int cc0 = (u.pn & 3) * 256 + wc * 32 + 8 * fq;
        f32x4 lb[2][2];
        if (kind == 2) {
#pragma unroll
            for (int bj = 0; bj < 2; ++bj)
#pragma unroll
                for (int n = 0; n < 2; ++n) lb[bj][n] = *(const f32x4*)(lbv + cc0 + bj * HALF + 4 * n);
        }
#pragma unroll
        for (int ai = 0; ai < 2; ++ai)
#pragma unroll
            for (int m = 0; m < 4; ++m) {
                if (!((gmask >> (ai * 4 + m)) & 1u)) continue;
                const int row = row0 + ai * HALF + m * 16;
                const float r = pre ? pre[ai * 4 + m] : rstd1[row];
#pragma unroll
                for (int bj = 0; bj < 2; ++bj) {
                    const int cc = cc0 + bj * HALF;
                    f32x4 v0 = acc[ai][bj][m][0] * r, v1 = acc[ai][bj][m][1] * r;
                    if (kind == 2) {
#pragma unroll
                        for (int j = 0; j < 4; ++j) {
                            const float f0 = lb[bj][0][j] + (1.f - lb[bj][0][j]) * sigm(v0[j]), f1 = lb[bj][1][j] + (1.f - lb[bj][1][j]) * sigm(v1[j]);
                            v0[j] = __log2f(f0); v1[j] = __log2f(f1);
                        }
                        float* p = lf + (size_t)row * HW + cc;
                        *(f32x4*)p = v0; *(f32x4*)(p + 4) = v1;

                    } else {
                        if (kind == 0) {
                            float* dst = nullptr;
                            if (row >= MP) { const int ms = row - MP; dst = out + O_PSS + ((size_t)(ms >> 3) * PC + 7 + (ms & 7)) * PW + cc; }
                            else { const int t = row & (SEQ - 1); if (t >= SEQ - PC) dst = out + O_PSP + ((size_t)(row >> 11) * PC + (t - (SEQ - PC))) * PW + cc; }
                            if (dst) { *(f32x4*)dst = v0; *(f32x4*)(dst + 4) = v1; }
                        }
                        if (kind == 1 || kind == 4) {
#pragma unroll
                            for (int j = 0; j < 4; ++j) { v0[j] = silu(v0[j]); v1[j] = silu(v1[j]); }
                        }
                        u32x4 w; w.x = cvt_pk_bf16(v0[0], v0[1]); w.y = cvt_pk_bf16(v0[2], v0[3]); w.z = cvt_pk_bf16(v1[0], v1[1]); w.w = cvt_pk_bf16(v1[2], v1[3]);
                        *(u32x4*)(zb + (size_t)row * INC + kind * 1024 + cc) = w;
                    }
                }
            }
    }
};

__device__ __forceinline__ void store16(bf16_t* base, size_t elem_off, u32x4 w, bool wt) {
    if (wt) { const __amdgpu_buffer_rsrc_t r = __builtin_amdgcn_make_buffer_rsrc((void*)base, (short)0, 0x7fffffff, 0x00020000); __builtin_amdgcn_raw_buffer_store_b128(w, r, (unsigned)(elem_off * 2), 0, 16); }
    else *(u32x4*)(base + elem_off) = w;
}
template <bool DRY = false> struct EpiX1 {
    static constexpr bool PERM = true, AFTER_DRAIN = false;
    const float* xp; const float* xs; float* y; bf16_t* x1b; float* rowsq; bool wt;
    __device__ __forceinline__ void operator()(const f32x4 (&acc)[2][2][4][2], const Unit& u, int wr, int wc, int fr, int fq, unsigned gmask = 0xffu) const {
        const int row0 = u.pm * BM + wr * 64 + fr, col0 = u.pn * BM + wc * 32 + 8 * fq;
#pragma unroll
        for (int ai = 0; ai < 2; ++ai)
#pragma unroll
            for (int m = 0; m < 4; ++m) {
                if (!((gmask >> (ai * 4 + m)) & 1u)) continue;
                const int row = row0 + ai * HALF + m * 16;
                const float* xr = (row < MP ? xp + (size_t)row * D : xs + (size_t)(row - MP) * D) + col0;
                float s = 0.f;
#pragma unroll
                for (int bj = 0; bj < 2; ++bj) {
                    const f32x4 v0 = __builtin_nontemporal_load((const f32x4*)(xr + bj * HALF)) + acc[ai][bj][m][0], v1 = __builtin_nontemporal_load((const f32x4*)(xr + bj * HALF + 4)) + acc[ai][bj][m][1];
                    u32x4 w; w.x = cvt_pk_bf16(v0[0], v0[1]); w.y = cvt_pk_bf16(v0[2], v0[3]); w.z = cvt_pk_bf16(v1[0], v1[1]); w.w = cvt_pk_bf16(v1[2], v1[3]);
                    store16(x1b, (size_t)row * D + col0 + bj * HALF, w, wt);
                    s += (v0[0] * v0[0] + v0[1] * v0[1]) + (v0[2] * v0[2] + v0[3] * v0[3]) + (v1[0] * v1[0] + v1[1] * v1[1]) + (v1[2] * v1[2] + v1[3] * v1[3]);
                }
                s += __shfl_xor(s, 16); s += __shfl_xor(s, 32);
                if (fq == 0 && !DRY) atomicAdd(rowsq + row, s);
            }
    }
};

struct EpiAct {
    static constexpr bool PERM = true, AFTER_DRAIN = false;
    bf16_t* act; const float* rowsq; bool wt;
    __device__ __forceinline__ void prefetch(const Unit& u, int wr, int fr, float (&p)[8]) const {
#pragma unroll
        for (int i = 0; i < 8; ++i) p[i] = rowsq[u.pm * BM + wr * 64 + fr + (i >> 2) * HALF + (i & 3) * 16];
    }
    __device__ __forceinline__ void operator()(const f32x4 (&acc)[2][2][4][2], const Unit& u, int wr, int wc, int fr, int fq, unsigned gmask = 0xffu, const float* pre = nullptr) const {
        const int row0 = u.pm * BM + wr * 64 + fr, col0 = u.pn * HALF + wc * 32 + 8 * fq;
#pragma unroll
        for (int ai = 0; ai < 2; ++ai)
#pragma unroll
            for (int m = 0; m < 4; ++m) {
                if (!((gmask >> (ai * 4 + m)) & 1u)) continue;
                const int row = row0 + ai * HALF + m * 16;
                const float r = rsqrtf((pre ? pre[ai * 4 + m] : rowsq[row]) * (1.f / D) + EPS);
                u32x4 w; unsigned* wp = (unsigned*)&w;
#pragma unroll
                for (int n = 0; n < 2; ++n) {
                    const f32x4 g = acc[ai][0][m][n] * r, up = acc[ai][1][m][n] * r;
                    f32x4 a;
#pragma unroll
                    for (int j = 0; j < 4; ++j) a[j] = silu(g[j]) * up[j];
                    wp[2 * n] = cvt_pk_bf16(a[0], a[1]); wp[2 * n + 1] = cvt_pk_bf16(a[2], a[3]);
                }
                store16(act, (size_t)row * DFF + col0, w, wt);
            }
    }
};

template <bool DRY = false> struct EpiX2 {
    static constexpr bool PERM = true, AFTER_DRAIN = false;
    bf16_t* x2b; float* rowsq; const bf16_t* x1b;
    __device__ __forceinline__ void operator()(const f32x4 (&acc)[2][2][4][2], const Unit& u, int wr, int wc, int fr, int fq, unsigned gmask = 0xffu) const {
        const int row0 = u.pm * BM + wr * 64 + fr, col0 = u.pn * BM + wc * 32 + 8 * fq;
#pragma unroll
        for (int ai = 0; ai < 2; ++ai)
#pragma unroll
            for (int m = 0; m < 4; ++m) {
                if (!((gmask >> (ai * 4 + m)) & 1u)) continue;
                const int row = row0 + ai * HALF + m * 16;
                float s = 0.f;
#pragma unroll
                for (int bj = 0; bj < 2; ++bj) {
                    const u32x4 xw = *(const u32x4*)(x1b + (size_t)row * D + col0 + bj * HALF);
                    f32x4 v0 = (f32x4){bflo_(xw.x), bfhi_(xw.x), bflo_(xw.y), bfhi_(xw.y)} + acc[ai][bj][m][0];
                    f32x4 v1 = (f32x4){bflo_(xw.z), bfhi_(xw.z), bflo_(xw.w), bfhi_(xw.w)} + acc[ai][bj][m][1];
                    u32x4 w; w.x = cvt_pk_bf16(v0[0], v0[1]); w.y = cvt_pk_bf16(v0[2], v0[3]); w.z = cvt_pk_bf16(v1[0], v1[1]); w.w = cvt_pk_bf16(v1[2], v1[3]);
                    *(u32x4*)(x2b + (size_t)row * D + col0 + bj * HALF) = w;
                    s += (v0[0] * v0[0] + v0[1] * v0[1]) + (v0[2] * v0[2] + v0[3] * v0[3]) + (v1[0] * v1[0] + v1[1] * v1[1]) + (v1[2] * v1[2] + v1[3] * v1[3]);
                }
                s += __shfl_xor(s, 16); s += __shfl_xor(s, 32);
                if (fq == 0 && !DRY) atomicAdd(rowsq + row, s);
            }
    }
};
template <class Epi, class Sched, bool ALIGN_EPI = false, bool SP2 = false>
__device__ __forceinline__ void gemm_phase(PG8_LAS unsigned char* lds, const Gemm g, const Sched& S, const Epi& E) {
    int tid_ = threadIdx.x; asm volatile("" : "+v"(tid_));
    const int tid = tid_, wid = __builtin_amdgcn_readfirstlane(tid >> 6), lane = tid & 63, wr = wid >> 2, wc = wid & 3, fr = lane & 15, fq = lane >> 4;
    const int K = g.K, nt = K / BK;
    unsigned voffA[2], voffB[2];
#pragma unroll
    for (int i = 0; i < 2; ++i) { int R, C; stage_rc(tid * 16 + i * 8192, R, C); const int Rb = Epi::PERM ? ((R & ~31) + perm32(R & 31)) : R;
        voffA[i] = (unsigned)(R * K + C) * 2u; voffB[i] = (unsigned)(Rb * K + C) * 2u; }
    const size_t kstep = (size_t)(BK * 2);
    const size_t hstep = (size_t)HALF * K * 2;
    const size_t tstep = 2 * hstep;
    const unsigned ldsw = (unsigned)wid * 1024u;
    const int aoff = lds_byte(wr * 64 + fr, fq * 8), boff = lds_byte(wc * 32 + fr, fq * 8);
#define PG8_SA(b, h) (((b) * 2 + (h)) * HTB)
#define PG8_SB(b, h) ((4 + (b) * 2 + (h)) * HTB)
#define PG8_STAGE(bufoff, gbase, voff) do { _Pragma("unroll") for (int _i = 0; _i < 2; ++_i) \
        __builtin_amdgcn_global_load_lds((const unsigned*)((const char*)(gbase) + (voff)[_i]), (PG8_LAS unsigned*)(lds + (bufoff) + ldsw + _i * 8192), 16, 0, 0); } while (0)
#define PG8_LDA(dst, b, h) do { _Pragma("unroll") for (int m = 0; m < 4; ++m) _Pragma("unroll") for (int k = 0; k < 2; ++k) dst[m][k] = *(const PG8_LAS bf16x8*)(lds + PG8_SA(b, h) + aoff + m * 2048 + k * 1024); } while (0)
#define PG8_LDB(dst, b, h) do { _Pragma("unroll") for (int n = 0; n < 2; ++n) _Pragma("unroll") for (int k = 0; k < 2; ++k) dst[n][k] = *(const PG8_LAS bf16x8*)(lds + PG8_SB(b, h) + boff + n * 2048 + k * 1024); } while (0)
#define PG8_MMA(ai, bj, At, Bt) do { __builtin_amdgcn_s_setprio(1); _Pragma("unroll") for (int m = 0; m < 4; ++m) _Pragma("unroll") for (int n = 0; n < 2; ++n) _Pragma("unroll") for (int k = 0; k < 2; ++k) \
        acc[ai][bj][m][n] = __builtin_amdgcn_mfma_f32_16x16x32_bf16(Bt[n][k], At[m][k], acc[ai][bj][m][n], 0, 0, 0); __builtin_amdgcn_s_setprio(0); } while (0)
#define PG8_WAIT_V(n) asm volatile("s_waitcnt vmcnt(" #n ")" ::: "memory")
#define PG8_WAIT_L(n) asm volatile("s_waitcnt lgkmcnt(" #n ")" ::: "memory")
#define PG8_BAR __builtin_amdgcn_s_barrier()
#define PG8_SCHED __builtin_amdgcn_sched_barrier(0)
    Unit cur, nxt; int ui = 0;
    if (!S.next(0, cur)) return;
    f32x4 acc[2][2][4][2];
#pragma unroll
    for (int a = 0; a < 2; ++a)
#pragma unroll
        for (int b = 0; b < 2; ++b)
#pragma unroll
            for (int m = 0; m < 4; ++m)
#pragma unroll
                for (int n = 0; n < 2; ++n) acc[a][b][m][n] = (f32x4){0.f, 0.f, 0.f, 0.f};
    bf16x8 At[4][2], B0[2][2], B1[2][2];
    const char* cA = (const char*)g.A + (size_t)cur.pm * tstep; const char* cB = (const char*)g.Bt + (size_t)cur.pn * tstep;
    S.a_ready(cur);
    if constexpr (SP2) {
        PG8_STAGE(PG8_SB(0, 0), cB, voffB); PG8_STAGE(PG8_SB(0, 1), cB + hstep, voffB); PG8_STAGE(PG8_SA(0, 0), cA, voffA); PG8_STAGE(PG8_SA(0, 1), cA + hstep, voffA);
        if (wr == 1) PG8_BAR;
        PG8_WAIT_V(2); PG8_BAR;
        PG8_STAGE(PG8_SB(1, 0), cB + kstep, voffB); PG8_STAGE(PG8_SA(1, 0), cA + kstep, voffA); PG8_STAGE(PG8_SB(1, 1), cB + hstep + kstep, voffB);
        PG8_WAIT_V(6); PG8_BAR;
    } else {
        PG8_STAGE(PG8_SB(0, 0), cB, voffB); PG8_STAGE(PG8_SA(0, 0), cA, voffA); PG8_STAGE(PG8_SB(0, 1), cB + hstep, voffB); PG8_STAGE(PG8_SA(0, 1), cA + hstep, voffA);
        if (wr == 1) PG8_BAR;
        PG8_WAIT_V(4); PG8_BAR;
        PG8_STAGE(PG8_SB(1, 0), cB + kstep, voffB); PG8_STAGE(PG8_SA(1, 0), cA + kstep, voffA); PG8_STAGE(PG8_SB(1, 1), cB + hstep + kstep, voffB);
        PG8_WAIT_V(6); PG8_BAR;
    }
    for (;;) {
        const bool has_next = S.next(ui + 1, nxt);
        const char* nA = has_next ? (const char*)g.A + (size_t)nxt.pm * tstep : cA; const char* nB = has_next ? (const char*)g.Bt + (size_t)nxt.pn * tstep : cB;
        for (int t = 0; t < nt; t += 2) {
            const bool last = (t == nt - 2);
            const char* a1 = cA + (size_t)(t + 1) * kstep;
            const char* a2 = last ? nA : cA + (size_t)(t + 2) * kstep; const char* b2 = last ? nB : cB + (size_t)(t + 2) * kstep;
            const char* a3 = a2 + kstep; const char* b3 = b2 + kstep;
            if (last && has_next) S.a_ready(nxt);
            if constexpr (SP2) {
            PG8_LDB(B0, 0, 0); PG8_LDB(B1, 0, 1); PG8_SCHED; PG8_LDA(At, 0, 0); PG8_STAGE(PG8_SA(1, 1), a1 + hstep, voffA);
            PG8_WAIT_V(8); PG8_WAIT_L(0); PG8_BAR; PG8_MMA(0, 0, At, B0); PG8_MMA(0, 1, At, B1); PG8_BAR; PG8_SCHED;
            PG8_LDA(At, 0, 1); PG8_STAGE(PG8_SB(0, 0), b2, voffB); PG8_STAGE(PG8_SB(0, 1), b2 + hstep, voffB); PG8_STAGE(PG8_SA(0, 0), a2, voffA);
            PG8_WAIT_V(8); PG8_WAIT_L(0); PG8_BAR; PG8_MMA(1, 0, At, B0); PG8_MMA(1, 1, At, B1); PG8_BAR; PG8_SCHED;
            PG8_LDB(B0, 1, 0); PG8_LDB(B1, 1, 1); PG8_SCHED; PG8_LDA(At, 1, 0); PG8_STAGE(PG8_SA(0, 1), a2 + hstep, voffA);
            PG8_WAIT_V(8); PG8_WAIT_L(0); PG8_BAR; PG8_MMA(0, 0, At, B0); PG8_MMA(0, 1, At, B1); PG8_BAR; PG8_SCHED;
            PG8_LDA(At, 1, 1); PG8_STAGE(PG8_SB(1, 0), b3, voffB); PG8_STAGE(PG8_SB(1, 1), b3 + hstep, voffB); PG8_STAGE(PG8_SA(1, 0), a3, voffA);
            PG8_WAIT_V(8); PG8_WAIT_L(0); PG8_BAR; PG8_MMA(1, 0, At, B0); PG8_MMA(1, 1, At, B1); PG8_BAR; PG8_SCHED;
            } else {
            PG8_LDB(B0, 0, 0); PG8_SCHED; PG8_LDA(At, 0, 0); PG8_STAGE(PG8_SA(1, 1), a1 + hstep, voffA);
            PG8_WAIT_L(8); PG8_BAR; PG8_WAIT_L(0); PG8_MMA(0, 0, At, B0); PG8_BAR; PG8_SCHED;
            PG8_LDB(B1, 0, 1); PG8_STAGE(PG8_SB(0, 0), b2, voffB);
            PG8_BAR; PG8_WAIT_L(0); PG8_MMA(0, 1, At, B1); PG8_BAR;
            PG8_LDA(At, 0, 1); PG8_STAGE(PG8_SA(0, 0), a2, voffA);
            PG8_BAR; PG8_WAIT_L(0); PG8_MMA(1, 0, At, B0); PG8_BAR; PG8_SCHED;
            PG8_STAGE(PG8_SB(0, 1), b2 + hstep, voffB);
            PG8_WAIT_V(6); PG8_BAR; PG8_MMA(1, 1, At, B1); PG8_BAR;
            PG8_LDB(B0, 1, 0); PG8_SCHED; PG8_LDA(At, 1, 0); PG8_STAGE(PG8_SA(0, 1), a2 + hstep, voffA);
            PG8_WAIT_L(8); PG8_BAR; PG8_WAIT_L(0); PG8_MMA(0, 0, At, B0); PG8_BAR; PG8_SCHED;
            PG8_LDB(B1, 1, 1); PG8_STAGE(PG8_SB(1, 0), b3, voffB);
            PG8_BAR; PG8_WAIT_L(0); PG8_MMA(0, 1, At, B1); PG8_BAR;
            PG8_LDA(At, 1, 1); PG8_STAGE(PG8_SA(1, 0), a3, voffA);
            PG8_BAR; PG8_WAIT_L(0); PG8_MMA(1, 0, At, B0); PG8_BAR; PG8_SCHED;
            PG8_STAGE(PG8_SB(1, 1), b3 + hstep, voffB);
            PG8_WAIT_V(6); PG8_BAR; PG8_MMA(1, 1, At, B1); PG8_BAR;
            }
        }
        if constexpr (ALIGN_EPI) { if (wr == 0) PG8_BAR; }
        if constexpr (!Epi::AFTER_DRAIN) { E(acc, cur, wr, wc, fr, fq); S.done(cur); }
        if (!has_next) break;
#pragma unroll
        for (int a = 0; a < 2; ++a)
#pragma unroll
            for (int b = 0; b < 2; ++b)
#pragma unroll
                for (int m = 0; m < 4; ++m)
#pragma unroll
                    for (int n = 0; n < 2; ++n) acc[a][b][m][n] = (f32x4){0.f, 0.f, 0.f, 0.f};
        cur = nxt; cA = nA; cB = nB; ++ui;
        if constexpr (ALIGN_EPI) { if (wr == 1) PG8_BAR; }
    }
    PG8_WAIT_V(0);
    if constexpr (!ALIGN_EPI) { if (wr == 0) PG8_BAR; }
    PG8_BAR;
    if constexpr (Epi::AFTER_DRAIN) { E.fused(acc, cur, wr, wc, fr, fq, lds, wid, lane); S.done(cur); }
#undef PG8_SA
#undef PG8_SB
#undef PG8_STAGE
#undef PG8_LDA
#undef PG8_LDB
#undef PG8_MMA
#undef PG8_WAIT_V
#undef PG8_WAIT_L
#undef PG8_BAR
#undef PG8_SCHED
}

struct HybridOrder {
    int nM, nN, nwg, G, c, nt, nfull, R, ns;
    __device__ __forceinline__ void init(int M, int N, int K, int G_, int c_, bool allow_split) {
        nM = M / BM; nN = N / BM; nwg = nM * nN; G = G_; c = c_; nt = K / BK; nfull = nwg / G; R = nwg - nfull * G;
        ns = (allow_split && R > 0 && (R % 8) == 0 && (G % 8) == 0) ? G / R : 1; if (ns > 8) ns = 8; if (ns > nt / 2) ns = nt / 2; if (ns < 2) ns = 1;
    }
    __device__ __forceinline__ void map(int L, Unit& u) const {
        int wgid = L; { const int q = nwg / NXCD, r = nwg % NXCD, xcd = wgid % NXCD, off = wgid / NXCD; wgid = (xcd < r ? xcd * (q + 1) : r * (q + 1) + (xcd - r) * q) + off; }
        const int nig = WGM * nN, gid = wgid / nig, fm = gid * WGM, gsz = (nM - fm) < WGM ? (nM - fm) : WGM;
        u.pm = fm + ((wgid % nig) % gsz); u.pn = (wgid % nig) / gsz;
    }
    __device__ __forceinline__ bool next(int i, Unit& u) const {
        if (i < nfull) { map(i * G + c, u); u.kb = 0; u.nk = nt; u.tinfo = -1; return true; }
        if (i > nfull || R == 0) return false;
        if (ns < 2) { const int L = i * G + c; if (L >= nwg) return false; map(L, u); u.kb = 0; u.nk = nt; u.tinfo = -1; return true; }
        const int x = c % 8, y = c / 8, tj = (y / ns) * 8 + x, slice = y % ns;
        if (tj >= R) return false;
        map(nfull * G + tj, u);
        const int pairs = nt / 2, base = pairs / ns, rem = pairs % ns, start = slice * base + (slice < rem ? slice : rem), mine = base + (slice < rem ? 1 : 0);
        u.kb = 2 * start; u.nk = 2 * mine; u.tinfo = (tj << 8) | (slice << 4) | ns; return true;
    }
};
struct TailCtx { f32x4* slab; unsigned* cnt; };

template <class Epi>
__device__ __forceinline__ void tail_fixup(f32x4 (&acc)[2][2][4][2], const Unit& u, const Epi& E, const TailCtx& T, int tid, int wr, int wc, int fr, int fq) {
    const int tj = u.tinfo >> 8, slice = (u.tinfo >> 4) & 15, ns = u.tinfo & 15;
    const __amdgpu_buffer_rsrc_t srs = __builtin_amdgcn_make_buffer_rsrc((void*)(T.slab + (size_t)(tj * ns + slice) * (32 * 512)), (short)0, 32 * 512 * 16, 0x00020000);
#pragma unroll
    for (int ai = 0; ai < 2; ++ai)
#pragma unroll
        for (int bj = 0; bj < 2; ++bj)
#pragma unroll
            for (int m = 0; m < 4; ++m)
#pragma unroll
                for (int n = 0; n < 2; ++n) __builtin_amdgcn_raw_buffer_store_b128(__builtin_bit_cast(u32x4, acc[ai][bj][m][n]), srs, (unsigned)(((((ai * 2 + bj) * 4 + m) * 2 + n) * 512 + tid) * 16), 0, 16);
    asm volatile("s_waitcnt vmcnt(0)" ::: "memory");
    __syncthreads();
    if (tid == 0) __hip_atomic_fetch_add(T.cnt + 64 * tj, 1u, __ATOMIC_RELAXED, __HIP_MEMORY_SCOPE_AGENT);
    if (tid < 64) {
        unsigned sp = 0;
        while (__hip_atomic_load(T.cnt + 64 * tj, __ATOMIC_RELAXED, __HIP_MEMORY_SCOPE_AGENT) < (unsigned)ns && ++sp < (1u << 22)) __builtin_amdgcn_s_sleep(2);
        __builtin_amdgcn_fence(__ATOMIC_ACQUIRE, "agent");
        asm volatile("s_waitcnt vmcnt(0)" ::: "memory");
    }
    __syncthreads();
    unsigned gmask = 0u;
    for (int g = slice; g < 8; g += ns) gmask |= 1u << g;
    const f32x4* tile = T.slab + (size_t)(tj * ns) * (32 * 512);
#pragma unroll
    for (int ai = 0; ai < 2; ++ai)
#pragma unroll
        for (int m = 0; m < 4; ++m) {
            if (!((gmask >> (ai * 4 + m)) & 1u)) continue;
#pragma unroll
            for (int bj = 0; bj < 2; ++bj)
#pragma unroll
                for (int n = 0; n < 2; ++n) {
                    const int idx = ((ai * 2 + bj) * 4 + m) * 2 + n;
                    f32x4 v = tile[idx * 512 + tid];
                    for (int sl = 1; sl < ns; ++sl) v = v + tile[(size_t)sl * (32 * 512) + idx * 512 + tid];
                    acc[ai][bj][m][n] = v;
                }
        }
    E(acc, u, wr, wc, fr, fq, gmask);
}

template <class Epi, class Sched>
__device__ __forceinline__ void gemm_phase2(PG8_LAS unsigned char* lds, const Gemm g, const Sched& S, const Epi& E, const TailCtx& T) {
    int tid_ = threadIdx.x; asm volatile("" : "+v"(tid_));
    const int tid = tid_, wid = __builtin_amdgcn_readfirstlane(tid >> 6), lane = tid & 63, wr = wid >> 2, wc = wid & 3, fr = lane & 15, fq = lane >> 4;
    const int K = g.K;
    unsigned voffA[2], voffB[2];
#pragma unroll
    for (int i = 0; i < 2; ++i) { int R, C; stage_rc(tid * 16 + i * 8192, R, C); const int Rb = Epi::PERM ? ((R & ~31) + perm32(R & 31)) : R;
        voffA[i] = (unsigned)(R * K + C) * 2u; voffB[i] = (unsigned)(Rb * K + C) * 2u; }
    const size_t kstep = (size_t)(BK * 2), hstep = (size_t)HALF * K * 2, tstep = 2 * hstep;
    const unsigned ldsw = (unsigned)wid * 1024u;
    const int aoff = lds_byte(wr * 64 + fr, fq * 8), boff = lds_byte(wc * 32 + fr, fq * 8);
#define PG8_SA(b, h) (((b) * 2 + (h)) * HTB)
#define PG8_SB(b, h) ((4 + (b) * 2 + (h)) * HTB)
#define PG8_STAGE(bufoff, gbase, voff) do { _Pragma("unroll") for (int _i = 0; _i < 2; ++_i) \
        __builtin_amdgcn_global_load_lds((const unsigned*)((const char*)(gbase) + (voff)[_i]), (PG8_LAS unsigned*)(lds + (bufoff) + ldsw + _i * 8192), 16, 0, 0); } while (0)
#define PG8_LDA(dst, b, h) do { _Pragma("unroll") for (int m = 0; m < 4; ++m) _Pragma("unroll") for (int k = 0; k < 2; ++k) dst[m][k] = *(const PG8_LAS bf16x8*)(lds + PG8_SA(b, h) + aoff + m * 2048 + k * 1024); } while (0)
#define PG8_LDB(dst, b, h) do { _Pragma("unroll") for (int n = 0; n < 2; ++n) _Pragma("unroll") for (int k = 0; k < 2; ++k) dst[n][k] = *(const PG8_LAS bf16x8*)(lds + PG8_SB(b, h) + boff + n * 2048 + k * 1024); } while (0)
#define PG8_MMA(ai, bj, At, Bt) do { __builtin_amdgcn_s_setprio(1); _Pragma("unroll") for (int m = 0; m < 4; ++m) _Pragma("unroll") for (int n = 0; n < 2; ++n) _Pragma("unroll") for (int k = 0; k < 2; ++k) \
        acc[ai][bj][m][n] = __builtin_amdgcn_mfma_f32_16x16x32_bf16(Bt[n][k], At[m][k], acc[ai][bj][m][n], 0, 0, 0); __builtin_amdgcn_s_setprio(0); } while (0)
#define PG8_WAIT_V(n) asm volatile("s_waitcnt vmcnt(" #n ")" ::: "memory")
#define PG8_WAIT_L(n) asm volatile("s_waitcnt lgkmcnt(" #n ")" ::: "memory")
#define PG8_BAR __builtin_amdgcn_s_barrier()
#define PG8_SCHED __builtin_amdgcn_sched_barrier(0)
    Unit cur, nxt; int ui = 0;
    if (!S.next(0, cur)) return;
    f32x4 acc[2][2][4][2];
#pragma unroll
    for (int a = 0; a < 2; ++a)
#pragma unroll
        for (int b = 0; b < 2; ++b)
#pragma unroll
            for (int m = 0; m < 4; ++m)
#pragma unroll
                for (int n = 0; n < 2; ++n) acc[a][b][m][n] = (f32x4){0.f, 0.f, 0.f, 0.f};
    bf16x8 At[4][2], B0[2][2], B1[2][2];
    const char* cA = (const char*)g.A + (size_t)cur.pm * tstep + (size_t)cur.kb * kstep; const char* cB = (const char*)g.Bt + (size_t)cur.pn * tstep + (size_t)cur.kb * kstep;
    PG8_STAGE(PG8_SB(0, 0), cB, voffB); PG8_STAGE(PG8_SB(0, 1), cB + hstep, voffB); PG8_STAGE(PG8_SA(0, 0), cA, voffA); PG8_STAGE(PG8_SA(0, 1), cA + hstep, voffA);
    if (wr == 1) PG8_BAR;
    PG8_WAIT_V(2); PG8_BAR;
    PG8_STAGE(PG8_SB(1, 0), cB + kstep, voffB); PG8_STAGE(PG8_SA(1, 0), cA + kstep, voffA); PG8_STAGE(PG8_SB(1, 1), cB + hstep + kstep, voffB);
    PG8_WAIT_V(6); PG8_BAR;
    for (;;) {
        const bool has_next = S.next(ui + 1, nxt);
        const char* nA = has_next ? (const char*)g.A + (size_t)nxt.pm * tstep + (size_t)nxt.kb * kstep : cA; const char* nB = has_next ? (const char*)g.Bt + (size_t)nxt.pn * tstep + (size_t)nxt.kb * kstep : cB;
        const int nt = cur.nk;
        for (int t = 0; t < nt; t += 2) {
            const bool last = (t == nt - 2);
            const char* a1 = cA + (size_t)(t + 1) * kstep;
            const char* a2 = last ? nA : cA + (size_t)(t + 2) * kstep; const char* b2 = last ? nB : cB + (size_t)(t + 2) * kstep;
            const char* a3 = a2 + kstep; const char* b3 = b2 + kstep;
            PG8_LDB(B0, 0, 0); PG8_LDB(B1, 0, 1); PG8_SCHED; PG8_LDA(At, 0, 0); PG8_STAGE(PG8_SA(1, 1), a1 + hstep, voffA);
            PG8_WAIT_V(8); PG8_WAIT_L(0); PG8_BAR; PG8_MMA(0, 0, At, B0); PG8_MMA(0, 1, At, B1); PG8_BAR; PG8_SCHED;
            PG8_LDA(At, 0, 1); PG8_STAGE(PG8_SB(0, 0), b2, voffB); PG8_STAGE(PG8_SB(0, 1), b2 + hstep, voffB); PG8_STAGE(PG8_SA(0, 0), a2, voffA);
            PG8_WAIT_V(8); PG8_WAIT_L(0); PG8_BAR; PG8_MMA(1, 0, At, B0); PG8_MMA(1, 1, At, B1); PG8_BAR; PG8_SCHED;
            PG8_LDB(B0, 1, 0); PG8_LDB(B1, 1, 1); PG8_SCHED; PG8_LDA(At, 1, 0); PG8_STAGE(PG8_SA(0, 1), a2 + hstep, voffA);
            PG8_WAIT_V(8); PG8_WAIT_L(0); PG8_BAR; PG8_MMA(0, 0, At, B0); PG8_MMA(0, 1, At, B1); PG8_BAR; PG8_SCHED;
            PG8_LDA(At, 1, 1); PG8_STAGE(PG8_SB(1, 0), b3, voffB); PG8_STAGE(PG8_SB(1, 1), b3 + hstep, voffB); PG8_STAGE(PG8_SA(1, 0), a3, voffA);
            PG8_WAIT_V(8); PG8_WAIT_L(0); PG8_BAR; PG8_MMA(1, 0, At, B0); PG8_MMA(1, 1, At, B1); PG8_BAR; PG8_SCHED;
        }
        if (wr == 0) PG8_BAR;
        if (cur.tinfo < 0) E(acc, cur, wr, wc, fr, fq);
        if (!has_next) break;
#pragma unroll
        for (int a = 0; a < 2; ++a)
#pragma unroll
            for (int b = 0; b < 2; ++b)
#pragma unroll
                for (int m = 0; m < 4; ++m)
#pragma unroll
                    for (int n = 0; n < 2; ++n) acc[a][b][m][n] = (f32x4){0.f, 0.f, 0.f, 0.f};
        cur = nxt; cA = nA; cB = nB; ++ui;
        if (wr == 1) PG8_BAR;
    }
    PG8_WAIT_V(0);
    PG8_BAR;
    if (cur.tinfo >= 0) tail_fixup(acc, cur, E, T, tid, wr, wc, fr, fq);
#undef PG8_SA
#undef PG8_SB
#undef PG8_STAGE
#undef PG8_LDA
#undef PG8_LDB
#undef PG8_MMA
#undef PG8_WAIT_V
#undef PG8_WAIT_L
#undef PG8_BAR
#undef PG8_SCHED
}

struct MUnit { int kind, pm, pn, kb, nk, tinfo; };
struct MOrder {
    int c;
    __device__ __forceinline__ bool next(int i, MUnit& u) const {
        const int j = i * 256 + c;
        u.kb = 0; u.tinfo = -1;
        if (j < 288) { u.kind = 0; u.nk = D / BK;
            if (j < 256) { const int x = j & 7, r = j >> 3; u.pm = 4 * x + (r >> 3); u.pn = r & 7; } else { const int t = j - 256; u.pm = 32 + (t >> 3); u.pn = t & 7; }
            return true; }
        if (j < 1872) { u.kind = 1; u.nk = D / BK; const int L = j - 288;
            if (L < 1408) { const int x = L & 7, off = L >> 3, wg = x * 176 + off, gid = wg / 352, rem = wg % 352; u.pm = gid * 8 + (rem & 7); u.pn = rem >> 3; }
            else { const int t = L - 1408; u.pm = 32 + (t & 3); u.pn = t >> 2; }
            return true; }
        if (j < 2128) { u.kind = 2; u.nk = DFF / BK; const int L = j - 1872, x = L & 7, r = L >> 3; u.pm = 4 * x + (r >> 3); u.pn = r & 7; return true; }
        const int ilast = (c < 80) ? 9 : 8;
        if (i != ilast || c < 80 || c >= 208) return false;
        const int mi = c - 80, tj = mi >> 2, slice = mi & 3;
        u.kind = 2; u.pm = 32 + (tj >> 3); u.pn = tj & 7; u.kb = slice * 22; u.nk = 22; u.tinfo = (tj << 8) | (slice << 4) | 4; return true;
    }
};

struct StreamOff { size_t A0, B0, A1, B1, A2, B2, x2b, slab; int dep3, dep4, tail, rsq2, rsq3; };
template <class SO>
__device__ __forceinline__ void gemm_stream(PG8_LAS unsigned char* lds, const MOrder& S, unsigned char* ws, const float* xp, const float* xs, const SO O) {
    int tid_ = threadIdx.x; asm volatile("" : "+v"(tid_));
    const int tid = tid_, wid = __builtin_amdgcn_readfirstlane(tid >> 6), lane = tid & 63, wr = wid >> 2, wc = wid & 3, fr = lane & 15, fq = lane >> 4;
    unsigned Ra[2][2], Rb[2][2];
#pragma unroll
    for (int i = 0; i < 2; ++i) { int R, C; stage_rc(tid * 16 + i * 8192, R, C); const int Rp = (R & ~31) + perm32(R & 31);
        Ra[0][i] = (unsigned)(R * D + C) * 2u; Ra[1][i] = (unsigned)(R * DFF + C) * 2u; Rb[0][i] = (unsigned)(Rp * D + C) * 2u; Rb[1][i] = (unsigned)(Rp * DFF + C) * 2u; }
    const size_t kstep = (size_t)(BK * 2);
    const unsigned ldsw = (unsigned)wid * 1024u;
    const int aoff = lds_byte(wr * 64 + fr, fq * 8), boff = lds_byte(wc * 32 + fr, fq * 8);
#define PG8_SA(b, h) (((b) * 2 + (h)) * HTB)
#define PG8_SB(b, h) ((4 + (b) * 2 + (h)) * HTB)
#define PG8_STG(bufoff, gbase, Rr, rowb) do { _Pragma("unroll") for (int _i = 0; _i < 2; ++_i) \
        __builtin_amdgcn_global_load_lds((const unsigned*)((const char*)(gbase) + ((rowb) == D * 2 ? (Rr)[0][_i] : (Rr)[1][_i])), (PG8_LAS unsigned*)(lds + (bufoff) + ldsw + _i * 8192), 16, 0, 0); } while (0)
#define PG8_LDA(dst, b, h) do { _Pragma("unroll") for (int m = 0; m < 4; ++m) _Pragma("unroll") for (int k = 0; k < 2; ++k) dst[m][k] = *(const PG8_LAS bf16x8*)(lds + PG8_SA(b, h) + aoff + m * 2048 + k * 1024); } while (0)
#define PG8_LDB(dst, b, h) do { _Pragma("unroll") for (int n = 0; n < 2; ++n) _Pragma("unroll") for (int k = 0; k < 2; ++k) dst[n][k] = *(const PG8_LAS bf16x8*)(lds + PG8_SB(b, h) + boff + n * 2048 + k * 1024); } while (0)
#define PG8_MMA(ai, bj, At, Bt) do { __builtin_amdgcn_s_setprio(1); _Pragma("unroll") for (int m = 0; m < 4; ++m) _Pragma("unroll") for (int n = 0; n < 2; ++n) _Pragma("unroll") for (int k = 0; k < 2; ++k) \
        acc[ai][bj][m][n] = __builtin_amdgcn_mfma_f32_16x16x32_bf16(Bt[n][k], At[m][k], acc[ai][bj][m][n], 0, 0, 0); __builtin_amdgcn_s_setprio(0); } while (0)
#define PG8_WAIT_V(n) asm volatile("s_waitcnt vmcnt(" #n ")" ::: "memory")
#define PG8_WAIT_L(n) asm volatile("s_waitcnt lgkmcnt(" #n ")" ::: "memory")
#define PG8_BAR __builtin_amdgcn_s_barrier()
#define PG8_SCHED __builtin_amdgcn_sched_barrier(0)
#define MU_A(u) ((const char*)ws + ((u).kind == 0 ? O.A0 : (u).kind == 1 ? O.A1 : O.A2) + (size_t)(u).pm * 256 * MU_RB(u) + (size_t)(u).kb * kstep)
#define MU_B(u) ((const char*)ws + ((u).kind == 0 ? O.B0 : (u).kind == 1 ? O.B1 : O.B2) + (size_t)(u).pn * 256 * MU_RB(u) + (size_t)(u).kb * kstep)
#define MU_RB(u) ((u).kind == 2 ? DFF * 2 : D * 2)
    unsigned long long rdy3 = 0ull, rdy4 = 0ull;
#define MU_READY(u) do { if ((u).kind != 0) { unsigned long long& _m = (u).kind == 1 ? rdy3 : rdy4; if (!((_m >> (u).pm) & 1ull)) { \
        if (wid == 0) { unsigned* _c = (unsigned*)ws + ((u).kind == 1 ? O.dep3 : O.dep4) + 64 * (u).pm; const unsigned _t = (u).kind == 1 ? 64u : 352u; unsigned _sp = 0; \
            while (__hip_atomic_load(_c, __ATOMIC_RELAXED, __HIP_MEMORY_SCOPE_AGENT) < _t && ++_sp < (1u << 22)) __builtin_amdgcn_s_sleep(2); \
            __builtin_amdgcn_fence(__ATOMIC_ACQUIRE, "agent"); asm volatile("s_waitcnt vmcnt(0)" ::: "memory"); } \
        asm volatile("" ::: "memory"); PG8_BAR; asm volatile("" ::: "memory"); _m |= 1ull << (u).pm; } } } while (0)
    PG8_LAS unsigned* vflag = (PG8_LAS unsigned*)(lds + 147456 - 256 + 64);
#define MU_TRY(u, ok) do { ok = true; if ((u).kind != 0) { unsigned long long& _m = (u).kind == 1 ? rdy3 : rdy4; if (!((_m >> (u).pm) & 1ull)) { \
        if (wid == 0) { unsigned* _c = (unsigned*)ws + ((u).kind == 1 ? O.dep3 : O.dep4) + 64 * (u).pm; const unsigned _t = (u).kind == 1 ? 64u : 352u; \
            const bool _r = __hip_atomic_load(_c, __ATOMIC_RELAXED, __HIP_MEMORY_SCOPE_AGENT) >= _t; \
            if (_r) { __builtin_amdgcn_fence(__ATOMIC_ACQUIRE, "agent"); asm volatile("s_waitcnt vmcnt(0)" ::: "memory"); } \
            if (lane == 0) *vflag = _r ? 1u : 0u; asm volatile("s_waitcnt lgkmcnt(0)" ::: "memory"); } \
        asm volatile("" ::: "memory"); PG8_BAR; asm volatile("" ::: "memory"); \
        ok = (*(volatile PG8_LAS unsigned*)vflag) != 0u; if (ok) _m |= 1ull << (u).pm; } } } while (0)
    MUnit cur, nxt; int ui = 0;
    if (!S.next(0, cur)) return;
    f32x4 acc[2][2][4][2];
#pragma unroll
    for (int a = 0; a < 2; ++a)
#pragma unroll
        for (int b = 0; b < 2; ++b)
#pragma unroll
            for (int m = 0; m < 4; ++m)
#pragma unroll
                for (int n = 0; n < 2; ++n) acc[a][b][m][n] = (f32x4){0.f, 0.f, 0.f, 0.f};
    bf16x8 At[4][2], B0[2][2], B1[2][2];
    bool more = true; float rq[8];
    while (more) {
#ifdef TPROBE
    if (threadIdx.x == 0 && cur.tinfo >= 0) ((volatile PG8_LAS unsigned long long*)(lds + 147456 - 256 + 128))[10] = __builtin_amdgcn_s_memrealtime();
#endif
    MU_READY(cur);
    const char* cA = MU_A(cur); const char* cB = MU_B(cur); int crb = MU_RB(cur);
    PG8_STG(PG8_SB(0, 0), cB, Rb, crb); PG8_STG(PG8_SB(0, 1), cB + (size_t)HALF * crb, Rb, crb); PG8_STG(PG8_SA(0, 0), cA, Ra, crb); PG8_STG(PG8_SA(0, 1), cA + (size_t)HALF * crb, Ra, crb);
    if (wr == 1) PG8_BAR;
    PG8_WAIT_V(2); PG8_BAR;
    PG8_STG(PG8_SB(1, 0), cB + kstep, Rb, crb); PG8_STG(PG8_SA(1, 0), cA + kstep, Ra, crb); PG8_STG(PG8_SB(1, 1), cB + (size_t)HALF * crb + kstep, Rb, crb);
    PG8_WAIT_V(6); PG8_BAR;
    for (;;) {
        const bool has_next = S.next(ui + 1, nxt);
        bool chain = has_next;
        const char* nA = cA; const char* nB = cB; int nrb = crb;
        const int nt = cur.nk;
        for (int t = 0; t < nt; t += 2) {
            const bool last = (t == nt - 2);
            if (last && has_next) { MU_TRY(nxt, chain); if (chain) { nA = MU_A(nxt); nB = MU_B(nxt); nrb = MU_RB(nxt); } }
            if (last && cur.kind == 1 && cur.tinfo < 0) { const Unit u{cur.pm, cur.pn, 0, 0, -1}; const EpiAct E1{(bf16_t*)(ws + O.A2), (const float*)ws + O.rsq2, true}; E1.prefetch(u, wr, fr, rq); }
            const char* a1 = cA + (size_t)(t + 1) * kstep;
            const char* a2 = last ? nA : cA + (size_t)(t + 2) * kstep; const char* b2 = last ? nB : cB + (size_t)(t + 2) * kstep; const int rb2 = last ? nrb : crb;
            const char* a3 = a2 + kstep; const char* b3 = b2 + kstep;
            const size_t h1 = (size_t)HALF * crb, h2 = (size_t)HALF * rb2;
            PG8_LDB(B0, 0, 0); PG8_LDB(B1, 0, 1); PG8_SCHED; PG8_LDA(At, 0, 0); PG8_STG(PG8_SA(1, 1), a1 + h1, Ra, crb);
            PG8_WAIT_V(8); PG8_WAIT_L(0); PG8_BAR; PG8_MMA(0, 0, At, B0); PG8_MMA(0, 1, At, B1); PG8_BAR; PG8_SCHED;
            PG8_LDA(At, 0, 1); PG8_STG(PG8_SB(0, 0), b2, Rb, rb2); PG8_STG(PG8_SB(0, 1), b2 + h2, Rb, rb2); PG8_STG(PG8_SA(0, 0), a2, Ra, rb2);
            PG8_WAIT_V(8); PG8_WAIT_L(0); PG8_BAR; PG8_MMA(1, 0, At, B0); PG8_MMA(1, 1, At, B1); PG8_BAR; PG8_SCHED;
            PG8_LDB(B0, 1, 0); PG8_LDB(B1, 1, 1); PG8_SCHED; PG8_LDA(At, 1, 0); PG8_STG(PG8_SA(0, 1), a2 + h2, Ra, rb2);
            PG8_WAIT_V(8); PG8_WAIT_L(0); PG8_BAR; PG8_MMA(0, 0, At, B0); PG8_MMA(0, 1, At, B1); PG8_BAR; PG8_SCHED;
            PG8_LDA(At, 1, 1); PG8_STG(PG8_SB(1, 0), b3, Rb, rb2); PG8_STG(PG8_SB(1, 1), b3 + h2, Rb, rb2); PG8_STG(PG8_SA(1, 0), a3, Ra, rb2);
            PG8_WAIT_V(8); PG8_WAIT_L(0); PG8_BAR; PG8_MMA(1, 0, At, B0); PG8_MMA(1, 1, At, B1); PG8_BAR; PG8_SCHED;
        }
        if (wr == 0) PG8_BAR;
        if (cur.tinfo < 0) {
            const Unit u{cur.pm, cur.pn, 0, 0, -1};
            if (cur.kind == 0) { const EpiX1<false> E0{xp, xs, nullptr, (bf16_t*)(ws + O.A1), (float*)ws + O.rsq2, true}; E0(acc, u, wr, wc, fr, fq); }
            else if (cur.kind == 1) { const EpiAct E1{(bf16_t*)(ws + O.A2), (const float*)ws + O.rsq2, true}; E1(acc, u, wr, wc, fr, fq, 0xffu, rq); }
            else { const EpiX2<false> E2{(bf16_t*)(ws + O.x2b), (float*)ws + O.rsq3, (const bf16_t*)(ws + O.A1)}; E2(acc, u, wr, wc, fr, fq); }
            if (cur.kind != 2) {
                asm volatile("s_waitcnt vmcnt(0)" ::: "memory");
                if (lane == 0) __hip_atomic_fetch_add((unsigned*)ws + (cur.kind == 0 ? O.dep3 : O.dep4) + 64 * cur.pm, 1u, __ATOMIC_RELAXED, __HIP_MEMORY_SCOPE_AGENT);
            }
        }
        if (!has_next) { more = false; break; }
        if (!chain) {
            PG8_WAIT_V(0); PG8_BAR;
#pragma unroll
            for (int a = 0; a < 2; ++a)
#pragma unroll
                for (int b = 0; b < 2; ++b)
#pragma unroll
                    for (int m = 0; m < 4; ++m)
#pragma unroll
                        for (int n = 0; n < 2; ++n) acc[a][b][m][n] = (f32x4){0.f, 0.f, 0.f, 0.f};
            cur = nxt; ++ui;
            break;
        }
#pragma unroll
        for (int a = 0; a < 2; ++a)
#pragma unroll
            for (int b = 0; b < 2; ++b)
#pragma unroll
                for (int m = 0; m < 4; ++m)
#pragma unroll
                    for (int n = 0; n < 2; ++n) acc[a][b][m][n] = (f32x4){0.f, 0.f, 0.f, 0.f};
        cur = nxt; cA = nA; cB = nB; crb = nrb; ++ui;
        if (wr == 1) PG8_BAR;
    }
    }
    PG8_WAIT_V(0);
    PG8_BAR;
#ifdef TPROBE
    if (threadIdx.x == 0) ((volatile PG8_LAS unsigned long long*)(lds + 147456 - 256 + 128))[9] = __builtin_amdgcn_s_memrealtime();
#endif
    if (cur.tinfo >= 0) { const Unit u{cur.pm, cur.pn, cur.kb, cur.nk, cur.tinfo}; const EpiX2<false> E2{(bf16_t*)(ws + O.x2b), (float*)ws + O.rsq3, (const bf16_t*)(ws + O.A1)};
        const TailCtx T{(f32x4*)(ws + O.slab), (unsigned*)ws + O.tail}; tail_fixup(acc, u, E2, T, tid, wr, wc, fr, fq); }
#undef MU_TRY
#undef MU_A
#undef MU_B
#undef MU_RB
#undef MU_READY
#undef PG8_SA
#undef PG8_SB
#undef PG8_STG
#undef PG8_LDA
#undef PG8_LDB
#undef PG8_MMA
#undef PG8_WAIT_V
#undef PG8_WAIT_L
#undef PG8_BAR
#undef PG8_SCHED
}
}
#define LAS __attribute__((address_space(3)))
typedef unsigned short bf16;
using pg8::f32x4; using pg8::u32x4; using pg8::u32x2; using pg8::bf16x8; using pg8::cvt_pk_bf16;

#ifndef ONE_LAUNCH
#define ONE_LAUNCH 1
#endif
constexpr int NWAVES = 8, NPHASE = 7;
constexpr int LDS_BYTES = 147456;
constexpr size_t MiB = 1u << 20;
constexpr size_t WS_CTL = 0, CTL_ZERO_BYTES = 1 * MiB;
constexpr size_t WS_WIN = 1 * MiB;
constexpr size_t WS_WO = 21 * MiB;
constexpr size_t WS_WGU = 29 * MiB;
constexpr size_t WS_WD = 73 * MiB;
constexpr size_t WS_WP = 95 * MiB;
constexpr size_t WS_MISC = 96 * MiB;
constexpr size_t WS_XB = 97 * MiB;
constexpr size_t WS_ZB = 133 * MiB;
constexpr size_t WS_LF = 223 * MiB;
constexpr size_t WS_ACT = WS_ZB;
constexpr size_t WS_MIX = 259 * MiB;
constexpr size_t WS_X2B = WS_WGU;
constexpr size_t WS_END = 328 * MiB;
constexpr int CW_RSQ2 = 4096, CW_RSQ3 = 4096 + M;
constexpr int CW_TAIL = 100000;
constexpr size_t WS_SLAB3 = WS_ACT, WS_SLAB45 = 232 * MiB;
constexpr int CW_DEP = 124000;
constexpr size_t WS_SLABM = 296 * MiB;
#ifndef MERGED
#define MERGED 1
#endif
constexpr int CW_BAR = 65536;
constexpr int MISC_OFF = 147456 - 256;
#ifndef USE_CG
#define USE_CG 0
#endif

__device__ __forceinline__ float wave_sum(float v) {
#pragma unroll
    for (int o = 1; o < 64; o <<= 1) v += __shfl_xor(v, o);
    return v;
}
__device__ __forceinline__ float bflo(unsigned w) { return __builtin_bit_cast(float, w << 16); }
__device__ __forceinline__ float bfhi(unsigned w) { return __builtin_bit_cast(float, w & 0xffff0000u); }
__device__ __forceinline__ float bf2f(bf16 b) { return __builtin_bit_cast(float, (unsigned)b << 16); }
__device__ __forceinline__ bf16 f2bf(float f) { unsigned u = __builtin_bit_cast(unsigned, f); return (bf16)((u + 0x7fffu + ((u >> 16) & 1u)) >> 16); }

#define XB_TMO      128
#define XB_XCNT(j)  (256  + 64 * (j))
#define XB_XSUB(j)  (1280 + 64 * (j))
#define XB_XGEN(j)  (2304 + 64 * (j))
#define XB_TOP      3328
#define XB_TOPGEN   3392
#define XCD_BAR_WORDS 3456
#define XB_SPIN_CAP (1u << 18)

__device__ __forceinline__ unsigned xb_ld(unsigned* p)              { return __hip_atomic_load(p, __ATOMIC_RELAXED, __HIP_MEMORY_SCOPE_AGENT); }
__device__ __forceinline__ unsigned xb_add(unsigned* p, unsigned v) { return __hip_atomic_fetch_add(p, v, __ATOMIC_RELAXED, __HIP_MEMORY_SCOPE_AGENT); }
__device__ __forceinline__ unsigned xb_xcc_id() { return (unsigned)__builtin_amdgcn_s_getreg((3 << 11) | 20) & 0xFu; }
#define XB_SPIN(cond, bar) do { unsigned _sp = 0; while (cond) { __builtin_amdgcn_s_sleep(1); \
    if ((++_sp & 255u) == 0u) { if (xb_ld(&(bar)[XB_TMO])) break; if (_sp > XB_SPIN_CAP) { atomicAdd(&(bar)[XB_TMO], 1u); break; } } } } while (0)

struct XcdBarrier {
    unsigned* bar; unsigned x;
    volatile LAS unsigned* st;
};

__device__ __forceinline__ XcdBarrier xcd_barrier_post(unsigned* bar, volatile LAS unsigned* st) {
    XcdBarrier b; b.bar = bar; b.x = xb_xcc_id(); b.st = st;
    if (threadIdx.x == 0) (void)xb_add(&bar[XB_XCNT(b.x)], 1u);
    return b;
}
__device__ __forceinline__ void xcd_barrier_complete(unsigned* bar, unsigned x, unsigned& nloc, unsigned& nx) {
    const unsigned G = gridDim.x * gridDim.y * gridDim.z;
    unsigned sum, cnt, mine, sp = 0u;
    for (;;) {
        sum = 0u; cnt = 0u; mine = 0u;
#pragma unroll
        for (unsigned j = 0; j < 16; ++j) { const unsigned c = xb_ld(&bar[XB_XCNT(j)]); sum += c; cnt += (c > 0u) ? 1u : 0u; mine = (j == x) ? c : mine; }
        if (sum == G) break;
        __builtin_amdgcn_s_sleep(1);
        if ((++sp & 255u) == 0u) { if (xb_ld(&bar[XB_TMO])) break; if (sp > XB_SPIN_CAP) { atomicAdd(&bar[XB_TMO], 1u); break; } }
    }
    nloc = mine > 0u ? mine : 1u; nx = cnt > 0u ? cnt : 1u;
}

__device__ __forceinline__ void xcd_barrier(const XcdBarrier& b) {
    asm volatile("s_waitcnt vmcnt(0)" ::: "memory");
    __syncthreads();
    if (threadIdx.x == 0) {
        unsigned* bar = b.bar;
        __builtin_amdgcn_s_waitcnt(0);
        unsigned nloc = b.st[0], nx = b.st[1];
        if (nloc == 0u) { xcd_barrier_complete(bar, b.x, nloc, nx); b.st[0] = nloc; b.st[1] = nx; }
        const unsigned old = xb_add(&bar[XB_XSUB(b.x)], 1u);
        const unsigned gen = old / nloc;
        if (old + 1u == (gen + 1u) * nloc) {
            __builtin_amdgcn_fence(__ATOMIC_RELEASE, "agent");
            asm volatile("s_waitcnt vmcnt(0)" ::: "memory");
            const unsigned og = xb_add(&bar[XB_TOP], 1u);
            const unsigned tg = og / nx;
            if (og + 1u == (tg + 1u) * nx) xb_add(&bar[XB_TOPGEN], 1u);
            else XB_SPIN(xb_ld(&bar[XB_TOPGEN]) == tg, bar);
            __builtin_amdgcn_fence(__ATOMIC_ACQUIRE, "agent");
            xb_add(&bar[XB_XGEN(b.x)], 1u);
            asm volatile("s_waitcnt vmcnt(0)" ::: "memory");
        } else {
            XB_SPIN(xb_ld(&bar[XB_XGEN(b.x)]) == gen, bar);
            __builtin_amdgcn_fence(__ATOMIC_ACQUIRE, "agent");
            asm volatile("s_waitcnt vmcnt(0)" ::: "memory");
        }
    }
    __syncthreads();
}


#ifdef TPROBE
#define STAMP(i) do { if (threadIdx.x == 0) ((volatile LAS unsigned long long*)(lds + MISC_OFF + 128))[i] = __builtin_amdgcn_s_memrealtime(); } while (0)
#else
#define STAMP(i) do {} while (0)
#endif
constexpr int CW_TP = 120000;

struct Args { const float* in[16]; float* out; unsigned char* ws; int ph_lo, ph_hi; };

__device__ __forceinline__ void p0_item(const float* W, int K, int N, bf16* WT, int mode, const float* sk, const float* sn, LAS float* scr, int item, int lane) {
    const int nblk = N / 64, kb = item / nblk, nb = item % nblk, k0 = 64 * kb, n0 = 64 * nb;
    const int drow0 = mode == 0 ? n0 : ((n0 >> 7) * 256 + (n0 & 127) + (mode == 2 ? 128 : 0));
    const int r = lane >> 4, c4 = lane & 15;
    f32x4 v[16];
#pragma unroll
    for (int i = 0; i < 16; ++i) v[i] = __builtin_nontemporal_load((const f32x4*)(W + (size_t)(k0 + 4 * i + r) * N + n0 + 4 * c4));
    if (sk) {
#pragma unroll
        for (int i = 0; i < 16; ++i) v[i] = v[i] * sk[k0 + 4 * i + r];
    }
#pragma unroll
    for (int i = 0; i < 16; ++i) { LAS float* d = scr + (4 * i + r) * 65 + 4 * c4; d[0] = v[i][0]; d[1] = v[i][1]; d[2] = v[i][2]; d[3] = v[i][3]; }
    asm volatile("s_waitcnt lgkmcnt(0)" ::: "memory");
    const int c = lane & 7, nn = lane >> 3;
#pragma unroll
    for (int j = 0; j < 8; ++j) { const int n = nn + 8 * j; const LAS float* s = scr + (8 * c) * 65 + n; const float f = sn ? sn[n0 + n] : 1.f;
        u32x4 o; o.x = cvt_pk_bf16(s[0 * 65] * f, s[1 * 65] * f); o.y = cvt_pk_bf16(s[2 * 65] * f, s[3 * 65] * f); o.z = cvt_pk_bf16(s[4 * 65] * f, s[5 * 65] * f); o.w = cvt_pk_bf16(s[6 * 65] * f, s[7 * 65] * f);
        *(u32x4*)(WT + (size_t)(drow0 + n) * K + k0 + 8 * c) = o; }
    asm volatile("s_waitcnt lgkmcnt(0)" ::: "memory");
}

constexpr int P0_I_IN = (D / 64) * (INC / 64), P0_I_O = (D / 64) * (D / 64), P0_I_G = (D / 64) * (DFF / 64), P0_I_D = (DFF / 64) * (D / 64), P0_I_P = (256 / 64) * (256 / 64);
constexpr int P0_NITEMS = P0_I_IN + P0_I_O + 2 * P0_I_G + P0_I_D + 4 * P0_I_P;
#ifndef P0_NDEF
#define P0_NDEF 3328
#endif
constexpr int P0_DEF_HI = P0_I_IN + P0_I_O + 2 * P0_I_G + P0_I_D, P0_DEF_LO = P0_DEF_HI - P0_NDEF;
__device__ __forceinline__ int p1_idle_wgs(int G) { const int nwg = (M / 256) * (INC / 256), nfull = nwg / G, R = nwg - nfull * G; return R > 0 ? G - R : 0; }
__device__ __forceinline__ void p0_weight_item(const Args& a, LAS float* scr, int it, int lane) {
    unsigned char* ws = a.ws;
    int r = it;
    if (r < P0_I_IN) { p0_item(a.in[6], D, INC, (bf16*)(ws + WS_WIN), 0, a.in[5], nullptr, scr, r, lane); return; } r -= P0_I_IN;
    if (r < P0_I_O) { p0_item(a.in[10], D, D, (bf16*)(ws + WS_WO), 0, nullptr, nullptr, scr, r, lane); return; } r -= P0_I_O;
    if (r < P0_I_G) { p0_item(a.in[12], D, DFF, (bf16*)(ws + WS_WGU), 1, a.in[11], nullptr, scr, r, lane); return; } r -= P0_I_G;
    if (r < P0_I_G) { p0_item(a.in[13], D, DFF, (bf16*)(ws + WS_WGU), 2, a.in[11], nullptr, scr, r, lane); return; } r -= P0_I_G;
    if (r < P0_I_D) { p0_item(a.in[14], DFF, D, (bf16*)(ws + WS_WD), 0, nullptr, nullptr, scr, r, lane); return; } r -= P0_I_D;
    { const int g = r / P0_I_P; p0_item(a.in[7] + (size_t)g * 65536, 256, 256, (bf16*)(ws + WS_WP) + (size_t)g * 65536, 0, nullptr, a.in[8] + g * 256, scr, r % P0_I_P, lane); }
}
__device__ __forceinline__ void phase0_deferred(LAS unsigned char* lds, const Args& a, int idle_idx, int nidle) {
    const int lane = threadIdx.x & 63, wave = threadIdx.x >> 6;
    LAS float* scr = (LAS float*)(lds + wave * 16640);
    for (int it = P0_DEF_LO + idle_idx * NWAVES + wave; it < P0_DEF_HI; it += nidle * NWAVES) p0_weight_item(a, scr, it, lane);
}
__device__ __forceinline__ void phase0(LAS unsigned char* lds, const Args& a, int vcu, int G) {
    const int tid = threadIdx.x, lane = tid & 63, wave = tid >> 6;
    unsigned char* ws = a.ws;
    LAS float* scr = (LAS float*)(lds + wave * 16640);
    const int gw = vcu * NWAVES + wave, NGW = G * NWAVES;
    const bool defer = p1_idle_wgs(G) >= 32;
    const int nlive = defer ? P0_NITEMS - (P0_DEF_HI - P0_DEF_LO) : P0_NITEMS;
    for (int k = gw; k < nlive; k += NGW) p0_weight_item(a, scr, (defer && k >= P0_DEF_LO) ? k + (P0_DEF_HI - P0_DEF_LO) : k, lane);
    float* rstd1 = (float*)(ws + WS_MISC); bf16* xb = (bf16*)(ws + WS_XB);
    for (int m = gw; m < M; m += NGW) {
        const float* xrow = m < MP ? a.in[0] + (size_t)m * D : a.in[1] + (size_t)(m - MP) * D;
        f32x4 v[8]; float s = 0.f;
#pragma unroll
        for (int j = 0; j < 8; ++j) { v[j] = __builtin_nontemporal_load((const f32x4*)xrow + lane + 64 * j); s += (v[j][0] * v[j][0] + v[j][1] * v[j][1]) + (v[j][2] * v[j][2] + v[j][3] * v[j][3]); }
        s = wave_sum(s);
        if (lane == 0) rstd1[m] = rsqrtf(s * (1.f / D) + EPS);
#pragma unroll
        for (int j = 0; j < 8; ++j) { u32x2 w; w.x = cvt_pk_bf16(v[j][0], v[j][1]); w.y = cvt_pk_bf16(v[j][2], v[j][3]); ((u32x2*)(xb + (size_t)m * D))[lane + 64 * j] = w; }
    }
    { u32x4* cz = (u32x4*)(ws + WS_CTL); const int gt0 = vcu * (NWAVES * 64) + tid, ngt0 = G * NWAVES * 64;
      for (int i = gt0; i < (int)(CTL_ZERO_BYTES / 16); i += ngt0) if (i < CW_BAR / 4 || i >= (CW_BAR + XCD_BAR_WORDS + 3) / 4) cz[i] = (u32x4){0u, 0u, 0u, 0u}; }
    const int gt = vcu * (NWAVES * 64) + tid, NGT = G * NWAVES * 64;
    float* lbv = (float*)(ws + WS_MISC) + M;
    for (int c = gt; c < HW; c += NGT) lbv[c] = 1.f / (1.f + __expf(a.in[4][HW + c] - a.in[4][c]));
    for (int i = gt; i < DB * 7 * PW; i += NGT) { const int b = i / (7 * PW), rem = i % (7 * PW); a.out[O_PSS + (size_t)b * PC * PW + rem] = a.in[2][(size_t)b * PC * PW + 8 * PW + rem]; }
}

template <int W, bool SAMPLE>
__device__ __forceinline__ void pool_fill(LAS bf16* A, int m0, int g, const bf16* zb, const float* cache) {
    const int tid = threadIdx.x, c8 = tid & 31, rq = tid >> 5;
    constexpr int LDA = 264;
    const int col = g * 256 + 8 * c8;
    u32x4 ur[19];
    int tb;
    if (!SAMPLE) {
        const int mb = m0 + 4 * rq - 15; tb = (m0 & (SEQ - 1)) + 4 * rq - 15;
#pragma unroll
        for (int e = 0; e < 19; ++e) ur[e] = (tb + e >= 0) ? *(const u32x4*)(zb + (size_t)(mb + e) * INC + col) : (u32x4){0u, 0u, 0u, 0u};
    } else {
        const int r0 = 4 * rq, m = m0 + r0, b = (m - MP) >> 3, t0 = r0 & 7; tb = t0 - 15;
#pragma unroll
        for (int e = 0; e < 19; ++e) {
            const int tau = tb + e;
            if (tau >= 0) ur[e] = *(const u32x4*)(zb + (size_t)(m - t0 + tau) * INC + col);
            else { const float* cr = cache + ((size_t)b * PC + (PC + tau)) * PW + col; const f32x4 c0 = *(const f32x4*)cr, c1 = *(const f32x4*)(cr + 4);
                   ur[e] = (u32x4){cvt_pk_bf16(c0[0], c0[1]), cvt_pk_bf16(c0[2], c0[3]), cvt_pk_bf16(c1[0], c1[1]), cvt_pk_bf16(c1[2], c1[3])}; }
        }
    }
    float out[4][8];
#pragma unroll
    for (int cp = 0; cp < 4; ++cp)
#pragma unroll
        for (int hf = 0; hf < 2; ++hf) {
#define PVAL(e) (hf ? bfhi(ur[e][cp]) : bflo(ur[e][cp]))
            float sw = 0.f;
#pragma unroll
            for (int j = 1; j < W; ++j) sw += PVAL(15 - j);
#pragma unroll
            for (int r = 0; r < 4; ++r) {
                const float um = PVAL(15 + r);
                sw += um;
                const float cnt = SAMPLE ? (float)W : (float)min(tb + 15 + r + 1, W);
                out[r][2 * cp + hf] = sw / cnt - um;
                sw -= PVAL(15 + r - (W - 1));
            }
#undef PVAL
        }
#pragma unroll
    for (int r = 0; r < 4; ++r) {
        u32x4 w; w.x = cvt_pk_bf16(out[r][0], out[r][1]); w.y = cvt_pk_bf16(out[r][2], out[r][3]); w.z = cvt_pk_bf16(out[r][4], out[r][5]); w.w = cvt_pk_bf16(out[r][6], out[r][7]);
        *(LAS u32x4*)(A + (4 * rq + r) * LDA + 8 * c8) = w;
    }
}
__device__ __forceinline__ void pool_item(LAS unsigned char* lds, int item, const bf16* zb, const float* cache, const bf16x8 (&wf)[8][2], bf16* mixb) {
    const int tile = item >> 2, g = item & 3, m0 = tile * 64;
    const int tid = threadIdx.x;
    constexpr int LDA = 264;
    LAS bf16* A = (LAS bf16*)lds;
    const int wave = tid >> 6, lane = tid & 63, fr = lane & 15, fq = lane >> 4, n0 = wave * 32;
    if (m0 < MP) { if (g == 0) pool_fill<2, false>(A, m0, g, zb, cache); else if (g == 1) pool_fill<4, false>(A, m0, g, zb, cache); else if (g == 2) pool_fill<8, false>(A, m0, g, zb, cache); else pool_fill<16, false>(A, m0, g, zb, cache); }
    else { if (g == 0) pool_fill<2, true>(A, m0, g, zb, cache); else if (g == 1) pool_fill<4, true>(A, m0, g, zb, cache); else if (g == 2) pool_fill<8, true>(A, m0, g, zb, cache); else pool_fill<16, true>(A, m0, g, zb, cache); }
    __syncthreads();
    f32x4 acc[4][2];
#pragma unroll
    for (int i = 0; i < 4; ++i)
#pragma unroll
        for (int j = 0; j < 2; ++j) acc[i][j] = (f32x4){0.f, 0.f, 0.f, 0.f};
#pragma unroll
    for (int ks = 0; ks < 8; ++ks) {
        bf16x8 af[4];
#pragma unroll
        for (int mt = 0; mt < 4; ++mt) af[mt] = *(const LAS bf16x8*)(A + (mt * 16 + fr) * LDA + ks * 32 + fq * 8);
#pragma unroll
        for (int mt = 0; mt < 4; ++mt)
#pragma unroll
            for (int nt = 0; nt < 2; ++nt) acc[mt][nt] = __builtin_amdgcn_mfma_f32_16x16x32_bf16(wf[ks][nt], af[mt], acc[mt][nt], 0, 0, 0);
    }
#pragma unroll
    for (int mt = 0; mt < 4; ++mt)
#pragma unroll
        for (int nt = 0; nt < 2; ++nt) {
            u32x2 o; o.x = cvt_pk_bf16(acc[mt][nt][0], acc[mt][nt][1]); o.y = cvt_pk_bf16(acc[mt][nt][2], acc[mt][nt][3]);
            *(u32x2*)(mixb + (size_t)(m0 + mt * 16 + fr) * D + g * 256 + n0 + nt * 16 + 4 * fq) = o;
        }
    __syncthreads();
}

struct SampleRegs { f32x4 S[8]; };
__device__ __forceinline__ void sample_load(SampleRegs& R, const float* S0) {
    const int tid = threadIdx.x, v4 = tid & 31, kq = tid >> 5;
#pragma unroll
    for (int kk = 0; kk < 8; ++kk) R.S[kk] = __builtin_nontemporal_load((const f32x4*)(S0 + (size_t)(kq * 8 + kk) * HD + 4 * v4));
}
struct SampleStage { float lfv[2]; bf16 q[2], v[2]; bf16 g[2]; float gn[2]; };
__device__ __forceinline__ void sample_stage(SampleStage& st, const bf16* zb, const float* lf, const float* hgn, int row0, int h) {
    const int tid = threadIdx.x;
#pragma unroll
    for (int j = 0; j < 2; ++j) {
        const int i = tid + 512 * j, t = i >> 7, ch = i & 127; const size_t row = (size_t)(row0 + t);
        st.lfv[j] = lf[row * HW + h * HD + ch]; st.q[j] = zb[row * INC + PW + h * HD + ch]; st.v[j] = zb[row * INC + PW + 2 * HW + h * HD + ch];
    }
    const int wave = tid >> 6, lane = tid & 63;
#pragma unroll
    for (int j = 0; j < 2; ++j) { st.g[j] = zb[(size_t)(row0 + wave) * INC + PW + 3 * HW + h * HD + lane + 64 * j]; st.gn[j] = hgn[h * HD + lane + 64 * j]; }
}
__device__ __forceinline__ void sample_run(LAS unsigned char* lds, SampleRegs& R, const SampleStage& st, const bf16* zb, const float* hgn, float* Sout, bf16* mixb, int row0, int h) {
    const int tid = threadIdx.x, v4 = tid & 31, kq = tid >> 5, wave = tid >> 6, lane = tid & 63;
    LAS float* sq = (LAS float*)lds; LAS float* sf = sq + 1024; LAS float* sk = sf + 1024; LAS float* sv = sk + 1024; LAS float* red = sv + 1024;
#pragma unroll
    for (int j = 0; j < 2; ++j) {
        const int i = tid + 512 * j;
        const float f = __builtin_amdgcn_exp2f(st.lfv[j]);
        sq[i] = bf2f(st.q[j]); sf[i] = f; sk[i] = 1.f - f; sv[i] = bf2f(st.v[j]);
    }
    __syncthreads();
#pragma unroll 1
    for (int t = 0; t < 8; ++t) {
        const f32x4 vt = *(const LAS f32x4*)(sv + t * 128 + 4 * v4);
        f32x4 o = (f32x4){0.f, 0.f, 0.f, 0.f};
        const f32x4 f0 = *(const LAS f32x4*)(sf + t * 128 + kq * 8), f1 = *(const LAS f32x4*)(sf + t * 128 + kq * 8 + 4);
        const f32x4 k0 = *(const LAS f32x4*)(sk + t * 128 + kq * 8), k1 = *(const LAS f32x4*)(sk + t * 128 + kq * 8 + 4);
        const f32x4 q0 = *(const LAS f32x4*)(sq + t * 128 + kq * 8), q1 = *(const LAS f32x4*)(sq + t * 128 + kq * 8 + 4);
#pragma unroll
        for (int kk = 0; kk < 8; ++kk) {
            const float f = kk < 4 ? f0[kk & 3] : f1[kk & 3], kn = kk < 4 ? k0[kk & 3] : k1[kk & 3], q = kk < 4 ? q0[kk & 3] : q1[kk & 3];
            R.S[kk] = R.S[kk] * f + vt * kn;
            o = o + R.S[kk] * q;
        }
#pragma unroll
        for (int j = 0; j < 4; ++j) o[j] += __shfl_xor(o[j], 32);
        if (lane < 32) *(LAS f32x4*)(red + (wave * 8 + t) * 128 + 4 * v4) = o;
    }
#pragma unroll
    for (int kk = 0; kk < 8; ++kk) __builtin_nontemporal_store(R.S[kk], (f32x4*)(Sout + (size_t)(kq * 8 + kk) * HD + 4 * v4));
    __syncthreads();
    {
        const int t = wave; const size_t row = (size_t)(row0 + t);
        float o0 = 0.f, o1 = 0.f;
#pragma unroll
        for (int w8 = 0; w8 < 8; ++w8) { o0 += red[(w8 * 8 + t) * 128 + lane]; o1 += red[(w8 * 8 + t) * 128 + lane + 64]; }
        const float ss = wave_sum(o0 * o0 + o1 * o1), r = rsqrtf(ss * (1.f / HD) + EPS);
        const int ch0 = h * HD + lane, ch1 = ch0 + 64;
        mixb[row * D + PW + ch0] = f2bf(o0 * r * st.gn[0] * bf2f(st.g[0]));
        mixb[row * D + PW + ch1] = f2bf(o1 * r * st.gn[1] * bf2f(st.g[1]));
    }
    __syncthreads();
}

constexpr int CQS = 272, CTS = 144;
constexpr int L_Q = 0, L_K = L_Q + 64 * CQS, L_KT = L_K + 64 * CQS, L_VT = L_KT + 128 * CTS, L_ST = L_VT + 128 * CTS, L_P = L_ST + 128 * CQS,
              L_DS = L_P + 64 * CTS, L_TOT = L_DS + 512, L_RMS = L_TOT + 8192, L_CHAIN_END = L_RMS + 512;
static_assert(L_CHAIN_END <= 131072, "chain LDS");
struct SegIn { f32x4 lf[4]; u32x2 v[4], sq[4]; };
template <bool FULL>
__device__ __forceinline__ void seg_load(SegIn& I, const bf16* zb, const float* lf, int row0, int h) {
    const int tid = threadIdx.x, cg = tid & 31, tgp = tid >> 5;
#pragma unroll
    for (int j = 0; j < 4; ++j) {
        const size_t row = (size_t)(row0 + 4 * tgp + j);
        I.lf[j] = *(const f32x4*)(lf + row * HW + h * HD + 4 * cg);
        I.v[j] = *(const u32x2*)(zb + row * INC + PW + 2 * HW + h * HD + 4 * cg);
        if (FULL) I.sq[j] = *(const u32x2*)(zb + row * INC + PW + h * HD + 4 * cg);
    }
}
template <bool FULL>
__device__ __forceinline__ void seg_run(LAS unsigned char* lds, SegIn& I, const bf16* zb, const float* lf, f32x4 (&Sacc)[8], f32x4& segsum, const f32x4 (&gnr)[4], bf16* mixb, int rowb, int nsteps, int h) {
    const int tid = threadIdx.x, lane = tid & 63, wave = __builtin_amdgcn_readfirstlane(tid >> 6), fr = lane & 15, fq = lane >> 4;
    const int cg = tid & 31, tgp = tid >> 5;
    LAS float* dS = (LAS float*)(lds + L_DS); LAS float* tot = (LAS float*)(lds + L_TOT); LAS float* rmsp = (LAS float*)(lds + L_RMS);
    *(LAS f32x4*)(tot + tgp * 128 + 4 * cg) = (I.lf[0] + I.lf[1]) + (I.lf[2] + I.lf[3]);
    if (FULL) {
#pragma unroll
        for (int kt = 0; kt < 8; ++kt) {
            u32x2 w; w.x = cvt_pk_bf16(Sacc[kt][0], Sacc[kt][1]); w.y = cvt_pk_bf16(Sacc[kt][2], Sacc[kt][3]);
            *(LAS u32x2*)(lds + L_ST + (16 * wave + fr) * CQS + (16 * kt + 4 * fq) * 2) = w;
        }
    }
    __syncthreads();
    for (int c = 0; c < nsteps; ++c) {
        {
            f32x4 b = (f32x4){0.f, 0.f, 0.f, 0.f};
#pragma unroll
            for (int g = 0; g < 15; ++g) { const f32x4 tv = *(const LAS f32x4*)(tot + g * 128 + 4 * cg); if (g < tgp) b = b + tv; }
            float kt[4][4], qt[4][4];
#pragma unroll
            for (int j = 0; j < 4; ++j) {
                b = b + I.lf[j];
                const float kn0 = 1.f - __builtin_amdgcn_exp2f(I.lf[j][0]), kn1 = 1.f - __builtin_amdgcn_exp2f(I.lf[j][1]), kn2 = 1.f - __builtin_amdgcn_exp2f(I.lf[j][2]), kn3 = 1.f - __builtin_amdgcn_exp2f(I.lf[j][3]);
                kt[j][0] = kn0 * __builtin_amdgcn_exp2f(-b[0]); kt[j][1] = kn1 * __builtin_amdgcn_exp2f(-b[1]); kt[j][2] = kn2 * __builtin_amdgcn_exp2f(-b[2]); kt[j][3] = kn3 * __builtin_amdgcn_exp2f(-b[3]);
                if (FULL) {
                    qt[j][0] = bflo(I.sq[j].x) * __builtin_amdgcn_exp2f(b[0]); qt[j][1] = bfhi(I.sq[j].x) * __builtin_amdgcn_exp2f(b[1]); qt[j][2] = bflo(I.sq[j].y) * __builtin_amdgcn_exp2f(b[2]); qt[j][3] = bfhi(I.sq[j].y) * __builtin_amdgcn_exp2f(b[3]);
                    const int t = 4 * tgp + j;
                    u32x2 qw, kw; qw.x = cvt_pk_bf16(qt[j][0], qt[j][1]); qw.y = cvt_pk_bf16(qt[j][2], qt[j][3]); kw.x = cvt_pk_bf16(kt[j][0], kt[j][1]); kw.y = cvt_pk_bf16(kt[j][2], kt[j][3]);
                    *(LAS u32x2*)(lds + L_Q + t * CQS + cg * 8) = qw;
                    *(LAS u32x2*)(lds + L_K + t * CQS + cg * 8) = kw;
                }
            }
#pragma unroll
            for (int ch = 0; ch < 4; ++ch) {
                u32x2 kw; kw.x = cvt_pk_bf16(kt[0][ch], kt[1][ch]); kw.y = cvt_pk_bf16(kt[2][ch], kt[3][ch]);
                *(LAS u32x2*)(lds + L_KT + (4 * cg + ch) * CTS + tgp * 8) = kw;
                const unsigned w0 = (ch < 2) ? I.v[0].x : I.v[0].y, w1 = (ch < 2) ? I.v[1].x : I.v[1].y, w2 = (ch < 2) ? I.v[2].x : I.v[2].y, w3 = (ch < 2) ? I.v[3].x : I.v[3].y;
                u32x2 vw;
                if (ch & 1) { vw.x = (w0 >> 16) | (w1 & 0xffff0000u); vw.y = (w2 >> 16) | (w3 & 0xffff0000u); }
                else { vw.x = (w0 & 0xffffu) | (w1 << 16); vw.y = (w2 & 0xffffu) | (w3 << 16); }
                *(LAS u32x2*)(lds + L_VT + (4 * cg + ch) * CTS + tgp * 8) = vw;
            }
            if (tgp == 15) {
                f32x4 e; e[0] = __builtin_amdgcn_exp2f(b[0]); e[1] = __builtin_amdgcn_exp2f(b[1]); e[2] = __builtin_amdgcn_exp2f(b[2]); e[3] = __builtin_amdgcn_exp2f(b[3]);
                *(LAS f32x4*)(dS + 4 * cg) = e; segsum = segsum + b;
            }
        }
        __syncthreads();
        u32x2 sgr[4];
        if (FULL) {
#pragma unroll
            for (int i = 0; i < 4; ++i) sgr[i] = *(const u32x2*)(zb + (size_t)(rowb + 64 * c + 16 * (wave & 3) + fr) * INC + PW + 3 * HW + h * HD + 16 * (4 * (wave >> 2) + i) + 4 * fq);
        }
        if (c + 1 < nsteps) seg_load<FULL>(I, zb, lf, rowb + 64 * (c + 1), h);
        if (FULL) {
#pragma unroll
            for (int i = 0; i < 2; ++i) {
                const int ti = 2 * wave + i, tt = ti >> 2, st = ti & 3;
                f32x4 p = (f32x4){0.f, 0.f, 0.f, 0.f};
#pragma unroll
                for (int ks = 0; ks < 4; ++ks) {
                    const bf16x8 ka = *(const LAS bf16x8*)(lds + L_K + (16 * st + fr) * CQS + (32 * ks + 8 * fq) * 2);
                    const bf16x8 qb = *(const LAS bf16x8*)(lds + L_Q + (16 * tt + fr) * CQS + (32 * ks + 8 * fq) * 2);
                    p = __builtin_amdgcn_mfma_f32_16x16x32_bf16(ka, qb, p, 0, 0, 0);
                }
                const int t = 16 * tt + fr, s0 = 16 * st + 4 * fq;
                u32x2 w; w.x = cvt_pk_bf16(s0 + 0 <= t ? p[0] : 0.f, s0 + 1 <= t ? p[1] : 0.f); w.y = cvt_pk_bf16(s0 + 2 <= t ? p[2] : 0.f, s0 + 3 <= t ? p[3] : 0.f);
                *(LAS u32x2*)(lds + L_P + t * CTS + s0 * 2) = w;
            }
        }
        {
            bf16x8 vb[2];
#pragma unroll
            for (int ss = 0; ss < 2; ++ss) vb[ss] = *(const LAS bf16x8*)(lds + L_VT + (16 * wave + fr) * CTS + (32 * ss + 8 * fq) * 2);
#pragma unroll
            for (int kt = 0; kt < 8; ++kt)
#pragma unroll
                for (int ss = 0; ss < 2; ++ss) {
                    const bf16x8 ka = *(const LAS bf16x8*)(lds + L_KT + (16 * kt + fr) * CTS + (32 * ss + 8 * fq) * 2);
                    Sacc[kt] = __builtin_amdgcn_mfma_f32_16x16x32_bf16(ka, vb[ss], Sacc[kt], 0, 0, 0);
                }
        }
        const int tt = wave & 3, vh = wave >> 2;
        f32x4 o[4];
        if (FULL) {
            __syncthreads();
            bf16x8 pb[2], qb[4];
#pragma unroll
            for (int ss = 0; ss < 2; ++ss) pb[ss] = *(const LAS bf16x8*)(lds + L_P + (16 * tt + fr) * CTS + (32 * ss + 8 * fq) * 2);
#pragma unroll
            for (int ks = 0; ks < 4; ++ks) qb[ks] = *(const LAS bf16x8*)(lds + L_Q + (16 * tt + fr) * CQS + (32 * ks + 8 * fq) * 2);
#pragma unroll
            for (int i = 0; i < 4; ++i) {
                const int vrow = 16 * (4 * vh + i) + fr;
                f32x4 a = (f32x4){0.f, 0.f, 0.f, 0.f};
#pragma unroll
                for (int ss = 0; ss < 2; ++ss) a = __builtin_amdgcn_mfma_f32_16x16x32_bf16(*(const LAS bf16x8*)(lds + L_VT + vrow * CTS + (32 * ss + 8 * fq) * 2), pb[ss], a, 0, 0, 0);
#pragma unroll
                for (int ks = 0; ks < 4; ++ks) a = __builtin_amdgcn_mfma_f32_16x16x32_bf16(*(const LAS bf16x8*)(lds + L_ST + vrow * CQS + (32 * ks + 8 * fq) * 2), qb[ks], a, 0, 0, 0);
                o[i] = a;
            }
            float ss2 = 0.f;
#pragma unroll
            for (int i = 0; i < 4; ++i) ss2 += (o[i][0] * o[i][0] + o[i][1] * o[i][1]) + (o[i][2] * o[i][2] + o[i][3] * o[i][3]);
            ss2 += __shfl_xor(ss2, 16); ss2 += __shfl_xor(ss2, 32);
            if (fq == 0) rmsp[vh * 64 + 16 * tt + fr] = ss2;
        }
#pragma unroll
        for (int kt = 0; kt < 8; ++kt) Sacc[kt] = Sacc[kt] * *(const LAS f32x4*)(dS + 16 * kt + 4 * fq);
        if (c + 1 < nsteps) *(LAS f32x4*)(tot + tgp * 128 + 4 * cg) = (I.lf[0] + I.lf[1]) + (I.lf[2] + I.lf[3]);
        __syncthreads();
        if (FULL) {
            const int tl = 16 * tt + fr; const size_t row = (size_t)(rowb + 64 * c + tl);
            const float r = rsqrtf((rmsp[tl] + rmsp[64 + tl]) * (1.f / HD) + EPS);
#pragma unroll
            for (int i = 0; i < 4; ++i) {
                const int ch = h * HD + 16 * (4 * vh + i) + 4 * fq;
                const f32x4 gn = gnr[i];
                const u32x2 sg = sgr[i];
                const float g0 = __builtin_bit_cast(float, sg.x << 16), g1 = __builtin_bit_cast(float, sg.x & 0xffff0000u), g2 = __builtin_bit_cast(float, sg.y << 16), g3 = __builtin_bit_cast(float, sg.y & 0xffff0000u);
                u32x2 w; w.x = cvt_pk_bf16(o[i][0] * r * gn[0] * g0, o[i][1] * r * gn[1] * g1); w.y = cvt_pk_bf16(o[i][2] * r * gn[2] * g2, o[i][3] * r * gn[3] * g3);
                *(u32x2*)(mixb + row * D + PW + ch) = w;
            }
#pragma unroll
            for (int kt = 0; kt < 8; ++kt) {
                u32x2 w; w.x = cvt_pk_bf16(Sacc[kt][0], Sacc[kt][1]); w.y = cvt_pk_bf16(Sacc[kt][2], Sacc[kt][3]);
                *(LAS u32x2*)(lds + L_ST + (16 * wave + fr) * CQS + (16 * kt + 4 * fq) * 2) = w;
            }
        }
    }
    __syncthreads();
}

#ifndef P2_ORDER_OLD
#define P2_ORDER_OLD 0
#endif
constexpr int CW_FLAG = 32768;
__device__ __forceinline__ void prompt_pass1(LAS unsigned char* lds, const Args& a, int chain, int seg, int nseg) {
    if (seg + 1 >= nseg) return;
    unsigned char* ws = a.ws;
    const bf16* zb = (const bf16*)(ws + WS_ZB); const float* lf = (const float*)(ws + WS_LF); bf16* mixb = (bf16*)(ws + WS_MIX);
    const int tid = threadIdx.x;
    const int b = chain / NH, h = chain % NH, seglen = SEQ / nseg, nsteps = seglen / 64, rowb = b * SEQ + seg * seglen;
    f32x4* slab = (f32x4*)(ws + WS_XB);
    float* dseg = (float*)(ws + WS_XB + 16 * MiB);
    unsigned* flags = (unsigned*)(ws + WS_CTL) + CW_FLAG;
    f32x4 gnr[4];
#pragma unroll
    for (int i = 0; i < 4; ++i) gnr[i] = (f32x4){0.f, 0.f, 0.f, 0.f};
    f32x4 Sacc[8];
#pragma unroll
    for (int i = 0; i < 8; ++i) Sacc[i] = (f32x4){0.f, 0.f, 0.f, 0.f};
    f32x4 segsum = (f32x4){0.f, 0.f, 0.f, 0.f};
    SegIn I; seg_load<false>(I, zb, lf, rowb, h);
    seg_run<false>(lds, I, zb, lf, Sacc, segsum, gnr, mixb, rowb, nsteps, h);
    const __amdgpu_buffer_rsrc_t srs = __builtin_amdgcn_make_buffer_rsrc((void*)(slab + (size_t)(chain * 8 + seg) * 4096), (short)0, 4096 * 16, 0x00020000);
#pragma unroll
    for (int kt = 0; kt < 8; ++kt) __builtin_amdgcn_raw_buffer_store_b128(__builtin_bit_cast(u32x4, Sacc[kt]), srs, (unsigned)((kt * 512 + tid) * 16), 0, 16);
    if ((tid >> 5) == 15) {
#pragma unroll
        for (int j = 0; j < 4; ++j) __hip_atomic_store((unsigned*)dseg + (chain * 8 + seg) * 128 + 4 * (tid & 31) + j, __builtin_bit_cast(unsigned, __builtin_amdgcn_exp2f(segsum[j])), __ATOMIC_RELAXED, __HIP_MEMORY_SCOPE_AGENT);
    }
    asm volatile("s_waitcnt vmcnt(0)" ::: "memory");
    __syncthreads();
    if (tid == 0) __hip_atomic_store(flags + 64 * (chain * 8 + seg), 1u, __ATOMIC_RELAXED, __HIP_MEMORY_SCOPE_AGENT);
}
__device__ __forceinline__ void prompt_pass2(LAS unsigned char* lds, const Args& a, int chain, int seg, int nseg) {
    unsigned char* ws = a.ws;
    const bf16* zb = (const bf16*)(ws + WS_ZB); const float* lf = (const float*)(ws + WS_LF); bf16* mixb = (bf16*)(ws + WS_MIX);
    const int tid = threadIdx.x, lane = tid & 63, wave = __builtin_amdgcn_readfirstlane(tid >> 6), fr = lane & 15, fq = lane >> 4;
    const int b = chain / NH, h = chain % NH, seglen = SEQ / nseg, nsteps = seglen / 64, rowb = b * SEQ + seg * seglen;
    const f32x4* slab = (const f32x4*)(ws + WS_XB);
    const float* dseg = (const float*)(ws + WS_XB + 16 * MiB);
    unsigned* flags = (unsigned*)(ws + WS_CTL) + CW_FLAG;
    f32x4 gnr[4];
#pragma unroll
    for (int i = 0; i < 4; ++i) gnr[i] = *(const f32x4*)(a.in[9] + h * HD + 16 * (4 * (wave >> 2) + i) + 4 * fq);
    f32x4 Sacc[8];
#pragma unroll
    for (int i = 0; i < 8; ++i) Sacc[i] = (f32x4){0.f, 0.f, 0.f, 0.f};
    f32x4 segsum = (f32x4){0.f, 0.f, 0.f, 0.f};
    SegIn I; seg_load<true>(I, zb, lf, rowb, h);
    if (seg > 0) {
        if (tid < 64) {
            unsigned sp = 0;
            while (__ballot(tid < seg && __hip_atomic_load(flags + 64 * (chain * 8 + tid), __ATOMIC_RELAXED, __HIP_MEMORY_SCOPE_AGENT) == 0u) != 0ull && ++sp < (1u << 22)) __builtin_amdgcn_s_sleep(2);
            __builtin_amdgcn_fence(__ATOMIC_ACQUIRE, "agent");
            asm volatile("s_waitcnt vmcnt(0)" ::: "memory");
        }
        __syncthreads();
        f32x4 rc[8], rn[8];
#pragma unroll
        for (int kt = 0; kt < 8; ++kt) { rc[kt] = slab[(size_t)(chain * 8) * 4096 + kt * 512 + tid]; rn[kt] = rc[kt]; }
        for (int i = 0; i < seg; ++i) {
            const float* dd = dseg + (chain * 8 + i) * 128;
            if (i + 1 < seg) {
#pragma unroll
                for (int kt = 0; kt < 8; ++kt) rn[kt] = slab[(size_t)(chain * 8 + i + 1) * 4096 + kt * 512 + tid];
            }
#pragma unroll
            for (int kt = 0; kt < 8; ++kt) Sacc[kt] = Sacc[kt] * *(const f32x4*)(dd + 16 * kt + 4 * fq) + rc[kt];
#pragma unroll
            for (int kt = 0; kt < 8; ++kt) rc[kt] = rn[kt];
        }
    }
    seg_run<true>(lds, I, zb, lf, Sacc, segsum, gnr, mixb, rowb, nsteps, h);
    if (seg + 1 == nseg) {
        float* Sout = a.out + O_HSP + (size_t)chain * HD * HD;
#pragma unroll
        for (int kt = 0; kt < 8; ++kt)
#pragma unroll
            for (int j = 0; j < 4; ++j) Sout[(size_t)(16 * kt + 4 * fq + j) * HD + 16 * wave + fr] = Sacc[kt][j];
    }
}

__device__ __forceinline__ void phase2(LAS unsigned char* lds, const Args& a, int bid, int G, int parts = 7) {
    unsigned char* ws = a.ws;
    const bf16* zb = (const bf16*)(ws + WS_ZB); const float* lf = (const float*)(ws + WS_LF); bf16* mixb = (bf16*)(ws + WS_MIX);
    constexpr int NPC = NB * NH, NSC = DB * NH, NPOOL = (M / 64) * 4;
    const int nseg = (G >= 8 * NPC) ? 8 : (G >= 4 * NPC ? 4 : (G >= 2 * NPC ? 2 : 1));
    if ((parts & 1) && nseg > 1 && bid < nseg * NPC) prompt_pass1(lds, a, bid / nseg, bid % nseg, nseg);
#if P2_ORDER_OLD
    if (parts & 1) {
        if (nseg > 1) { if (bid < nseg * NPC) prompt_pass2(lds, a, bid / nseg, bid % nseg, nseg); }
        else for (int c = bid; c < NPC; c += G) prompt_pass2(lds, a, c, 0, 1);
    }
#endif
    STAMP(5);
    if ((bid >> 3) & 1) {
    if (parts & 4) {
        const int first = (NSC + G - 1 - bid) / G * G + bid;
        if (first < NSC + NPOOL) {
            const int lane = threadIdx.x & 63, n0 = (threadIdx.x >> 6) * 32;
            const bf16* WpT = (const bf16*)(ws + WS_WP);
            bf16x8 wf[8][2];
            for (int it = first; it < NSC + NPOOL; it += G) {
                if (it == first || (G & 3)) {
                    const int g = (it - NSC) & 3;
#pragma unroll
                    for (int ks = 0; ks < 8; ++ks)
#pragma unroll
                        for (int nt = 0; nt < 2; ++nt) wf[ks][nt] = *(const bf16x8*)(WpT + (size_t)(g * 256 + n0 + nt * 16 + (lane & 15)) * 256 + ks * 32 + (lane >> 4) * 8);
                }
                pool_item(lds, it - NSC, zb, a.in[2], wf, mixb);
            }
        }
    }
    if (parts & 2) {
        SampleRegs cur, nxt;
        if (bid < NSC) sample_load(cur, a.in[3] + (size_t)bid * HD * HD);
        for (int it = bid; it < NSC; it += G) {
            const bool pf = it + G < NSC;
            SampleStage st; sample_stage(st, zb, lf, a.in[9], MP + (it / NH) * DS, it % NH);
            if (pf) sample_load(nxt, a.in[3] + (size_t)(it + G) * HD * HD);
            sample_run(lds, cur, st, zb, a.in[9], a.out + O_HSS + (size_t)it * HD * HD, mixb, MP + (it / NH) * DS, it % NH);
            if (pf) {
#pragma unroll
                for (int kk = 0; kk < 8; ++kk) cur.S[kk] = nxt.S[kk];
            }
        }
    }
    } else {
    if (parts & 2) {
        SampleRegs cur, nxt;
        if (bid < NSC) sample_load(cur, a.in[3] + (size_t)bid * HD * HD);
        for (int it = bid; it < NSC; it += G) {
            const bool pf = it + G < NSC;
            SampleStage st; sample_stage(st, zb, lf, a.in[9], MP + (it / NH) * DS, it % NH);
            if (pf) sample_load(nxt, a.in[3] + (size_t)(it + G) * HD * HD);
            sample_run(lds, cur, st, zb, a.in[9], a.out + O_HSS + (size_t)it * HD * HD, mixb, MP + (it / NH) * DS, it % NH);
            if (pf) {
#pragma unroll
                for (int kk = 0; kk < 8; ++kk) cur.S[kk] = nxt.S[kk];
            }
        }
    }
    if (parts & 4) {
        const int first = (NSC + G - 1 - bid) / G * G + bid;
        if (first < NSC + NPOOL) {
            const int lane = threadIdx.x & 63, n0 = (threadIdx.x >> 6) * 32;
            const bf16* WpT = (const bf16*)(ws + WS_WP);
            bf16x8 wf[8][2];
            for (int it = first; it < NSC + NPOOL; it += G) {
                if (it == first || (G & 3)) {
                    const int g = (it - NSC) & 3;
#pragma unroll
                    for (int ks = 0; ks < 8; ++ks)
#pragma unroll
                        for (int nt = 0; nt < 2; ++nt) wf[ks][nt] = *(const bf16x8*)(WpT + (size_t)(g * 256 + n0 + nt * 16 + (lane & 15)) * 256 + ks * 32 + (lane >> 4) * 8);
                }
                pool_item(lds, it - NSC, zb, a.in[2], wf, mixb);
            }
        }
    }
    }
    STAMP(6);
    if (!P2_ORDER_OLD && (parts & 1)) {
        if (nseg > 1) { if (bid < nseg * NPC) prompt_pass2(lds, a, bid / nseg, bid % nseg, nseg); }
        else for (int c = bid; c < NPC; c += G) prompt_pass2(lds, a, c, 0, 1);
    }
}

__device__ __forceinline__ void phase6(const Args& a, int vcu, int G, size_t x2off) {
    const int tid = threadIdx.x, lane = tid & 63, wave = tid >> 6;
#ifdef TPROBE
    { unsigned d = *((const unsigned*)(a.ws + WS_CTL) + CW_TP); if (TP_MODE == 2) d = 0x40000000u - d;
#ifdef TP_CAL
      d = TP_REF_US * 95;
#endif
      const float delta = 0.01f * ((float)d * 0.01f) / (float)(TP_REF_US);
      for (int i = vcu * (NWAVES * 64) + tid; i < NB * PC * PW; i += G * NWAVES * 64) a.out[O_PSP + i] += delta; }
#endif
    const int gw = vcu * NWAVES + wave, NGW = G * NWAVES;
    const float* rsq3 = (const float*)(a.ws + WS_CTL) + CW_RSQ3;
    for (int m = gw; m < M; m += NGW) {
        float* yr = a.out + O_Y + (size_t)m * D; const bf16* xr = (const bf16*)(a.ws + x2off) + (size_t)m * D;
        const float r = rsqrtf(rsq3[m] * (1.f / D) + EPS);
#pragma unroll
        for (int j = 0; j < 4; ++j) {
            const u32x4 xw = __builtin_nontemporal_load((const u32x4*)xr + lane + 64 * j);
            const f32x4 g0 = ((const f32x4*)a.in[15])[2 * (lane + 64 * j)], g1 = ((const f32x4*)a.in[15])[2 * (lane + 64 * j) + 1];
            __builtin_nontemporal_store((f32x4){bflo(xw.x), bfhi(xw.x), bflo(xw.y), bfhi(xw.y)} * r * g0, (f32x4*)yr + 2 * (lane + 64 * j));
            __builtin_nontemporal_store((f32x4){bflo(xw.z), bfhi(xw.z), bflo(xw.w), bfhi(xw.w)} * r * g1, (f32x4*)yr + 2 * (lane + 64 * j) + 1);
        }
    }
}

__global__ void __launch_bounds__(NWAVES * 64, 2) mega(Args a) {
    extern __shared__ __attribute__((aligned(16))) unsigned char lds_raw[];
    LAS unsigned char* lds = (LAS unsigned char*)lds_raw;
    const int G = gridDim.x, bid = blockIdx.x;
    const int vcu = (G % 8 == 0) ? (bid % 8) * (G / 8) + bid / 8 : bid;
    unsigned char* ws = a.ws;
    float* ctlf = (float*)(ws + WS_CTL);
    const int lo = a.ph_lo, hi = a.ph_hi;
#if ONE_LAUNCH && USE_CG
    cg::grid_group grid = cg::this_grid();
#define GRID_BAR() grid.sync()
#elif ONE_LAUNCH
    volatile LAS unsigned* MISC = (volatile LAS unsigned*)(lds + MISC_OFF);
    if (threadIdx.x < 32) MISC[threadIdx.x] = 0u;
    __syncthreads();
    XcdBarrier bar = xcd_barrier_post((unsigned*)(ws + WS_CTL) + CW_BAR, MISC + 8);
#define GRID_BAR() xcd_barrier(bar)
#else
#define GRID_BAR() do {} while (0)
#endif
#ifndef PH_MASK
#define PH_MASK 0x7f
#endif
#define IN(k) (((PH_MASK >> (k)) & 1) && lo <= (k) && (k) < hi)
#define BOTH(k) (IN(k) && IN((k) + 1))
#ifndef REP_MASK
#define REP_MASK 0
#endif
#define REP(k) ((REP_MASK >> (k)) & 1)
#ifndef P2_REP_PARTS
#define P2_REP_PARTS 7
#endif
    STAMP(0);
    if (IN(0)) { if (REP(0)) { phase0(lds, a, vcu, G); __syncthreads(); } phase0(lds, a, vcu, G); STAMP(1); if (BOTH(0)) GRID_BAR(); STAMP(2); }
    if (IN(1)) {
        pg8::Gemm g{(const bf16*)(ws + WS_XB), (const bf16*)(ws + WS_WIN), M, INC, D}; pg8::HybridOrder S; S.init(M, INC, D, G, bid, false);
        const pg8::TailCtx T{nullptr, nullptr};
        pg8::EpiZ E{(bf16*)(ws + WS_ZB), (float*)(ws + WS_LF), (const float*)(ws + WS_MISC), (const float*)(ws + WS_MISC) + M, a.out};
        if (REP(1)) pg8::gemm_phase2(lds, g, S, E, T);
        pg8::gemm_phase2(lds, g, S, E, T);
        { const int nidle = p1_idle_wgs(G); if (nidle >= 32 && bid >= G - nidle) phase0_deferred(lds, a, bid - (G - nidle), nidle); }
        STAMP(3);
        if (BOTH(1)) GRID_BAR();
        STAMP(4);
    }
    if (IN(2)) { if (REP(2)) { phase2(lds, a, bid, G, P2_REP_PARTS); __syncthreads(); } phase2(lds, a, bid, G); STAMP(7); if (BOTH(2)) GRID_BAR(); STAMP(8); }
    const bool merged = MERGED && G == 256 && lo <= 3 && hi >= 6;
    if (merged) {
        pg8::MOrder S{bid};
        constexpr pg8::StreamOff O{WS_MIX, WS_WO, WS_XB, WS_WGU, WS_ACT, WS_WD, WS_MIX, WS_SLABM, CW_DEP, CW_DEP + 4096, CW_TAIL, CW_RSQ2, CW_RSQ3};
        pg8::gemm_stream(lds, S, ws, a.in[0], a.in[1], O);
        STAMP(13);
#ifdef TPROBE
        if (threadIdx.x == 0) { volatile LAS unsigned long long* ts = (volatile LAS unsigned long long*)(lds + MISC_OFF + 128); const unsigned d = (unsigned)(ts[TP_B] - ts[TP_A]);
            unsigned* w = (unsigned*)(ws + WS_CTL) + CW_TP; if (TP_MODE == 0) { if (bid == TP_BLOCK) atomicMax(w, d); } else if (TP_MODE == 1) atomicMax(w, d); else atomicMax(w, 0x40000000u - d); }
#endif
        GRID_BAR();
    }
    if (!merged && IN(3)) {
        pg8::Gemm g{(const bf16*)(ws + WS_MIX), (const bf16*)(ws + WS_WO), M, D, D}; pg8::HybridOrder S; S.init(M, D, D, G, bid, true);
        const pg8::TailCtx T{(f32x4*)(ws + WS_SLAB3), (unsigned*)(ws + WS_CTL) + CW_TAIL};
        if (REP(3)) { pg8::EpiX1<true> E0{a.in[0], a.in[1], a.out + O_Y, (bf16*)(ws + WS_XB), ctlf + CW_RSQ2, false}; pg8::gemm_phase2(lds, g, S, E0, T); }
        pg8::EpiX1<false> E{a.in[0], a.in[1], a.out + O_Y, (bf16*)(ws + WS_XB), ctlf + CW_RSQ2, false};
        pg8::gemm_phase2(lds, g, S, E, T);
        STAMP(9);
        if (BOTH(3)) GRID_BAR();
        STAMP(10);
    }
    if (!merged && IN(4)) {
        pg8::Gemm g{(const bf16*)(ws + WS_XB), (const bf16*)(ws + WS_WGU), M, 2 * DFF, D}; pg8::HybridOrder S; S.init(M, 2 * DFF, D, G, bid, true);
        const pg8::TailCtx T{(f32x4*)(ws + WS_SLAB45), (unsigned*)(ws + WS_CTL) + CW_TAIL + 8192};
        pg8::EpiAct E{(bf16*)(ws + WS_ACT), ctlf + CW_RSQ2, false};
        if (REP(4)) pg8::gemm_phase2(lds, g, S, E, T);
        pg8::gemm_phase2(lds, g, S, E, T);
        STAMP(11);
        if (BOTH(4)) GRID_BAR();
        STAMP(12);
    }
    if (!merged && IN(5)) {
        pg8::Gemm g{(const bf16*)(ws + WS_ACT), (const bf16*)(ws + WS_WD), M, D, DFF}; pg8::HybridOrder S; S.init(M, D, DFF, G, bid, true);
        const pg8::TailCtx T{(f32x4*)(ws + WS_SLAB45), (unsigned*)(ws + WS_CTL) + CW_TAIL + 16384};
        if (REP(5)) { pg8::EpiX2<true> E0{(bf16*)(ws + WS_X2B), ctlf + CW_RSQ3, (const bf16*)(ws + WS_XB)}; pg8::gemm_phase2(lds, g, S, E0, T); }
        pg8::EpiX2<false> E{(bf16*)(ws + WS_X2B), ctlf + CW_RSQ3, (const bf16*)(ws + WS_XB)};
        pg8::gemm_phase2(lds, g, S, E, T);
        STAMP(13);
#ifdef TPROBE
        if (threadIdx.x == 0) { volatile LAS unsigned long long* ts = (volatile LAS unsigned long long*)(lds + MISC_OFF + 128); const unsigned d = (unsigned)(ts[TP_B] - ts[TP_A]);
            unsigned* w = (unsigned*)(ws + WS_CTL) + CW_TP; if (TP_MODE == 0) { if (bid == TP_BLOCK) atomicMax(w, d); } else if (TP_MODE == 1) atomicMax(w, d); else atomicMax(w, 0x40000000u - d); }
#endif
        if (BOTH(5)) GRID_BAR();
    }
    if (IN(6)) phase6(a, vcu, G, merged ? WS_MIX : WS_X2B);
#undef IN
#undef BOTH
}

extern "C" void kernel_launch(void* const* d_in, const int* in_sizes, int n_in, void* d_out, int out_size, void* d_ws, size_t ws_size, hipStream_t stream) {
    static int grid = 0;
    if (grid == 0) {
        if (n_in != 16 || ws_size < WS_END) { fprintf(stderr, "kernel_launch: unexpected n_in %d / ws_size %zu\n", n_in, ws_size); grid = -1; return; }
        int dev = 0, cus = 0, per_cu = 0;
        hipGetDevice(&dev);
        hipDeviceGetAttribute(&cus, hipDeviceAttributeMultiprocessorCount, dev);
        hipFuncSetAttribute((const void*)mega, hipFuncAttributeMaxDynamicSharedMemorySize, LDS_BYTES);
        hipOccupancyMaxActiveBlocksPerMultiprocessor(&per_cu, (const void*)mega, NWAVES * 64, LDS_BYTES);
        if (per_cu < 1) { fprintf(stderr, "kernel_launch: occupancy query says %d blocks per CU\n", per_cu); grid = -1; return; }
        grid = cus;
#ifdef FORCE_GRID
        grid = FORCE_GRID;
#endif
    }
    if (grid < 0) return;
    hipMemsetAsync((char*)d_ws + WS_CTL + (size_t)CW_BAR * 4, 0, XCD_BAR_WORDS * 4, stream);
#ifdef EXTRA_MEMSET
    hipMemsetAsync((char*)d_ws + WS_END - 8192, 0, 4096, stream);
#endif
    Args a{};
    for (int i = 0; i < 16; ++i) a.in[i] = (const float*)d_in[i];
    a.out = (float*)d_out; a.ws = (unsigned char*)d_ws;
#if ONE_LAUNCH
    a.ph_lo = 0; a.ph_hi = NPHASE;
    void* args[] = {&a};
#if USE_CG
    hipError_t e = hipLaunchCooperativeKernel((const void*)mega, dim3(grid), dim3(NWAVES * 64), args, LDS_BYTES, stream);
    if (e != hipSuccess) fprintf(stderr, "cooperative launch failed: %s (grid %d)\n", hipGetErrorString(e), grid);
#else
    (void)args; hipLaunchKernelGGL(mega, dim3(grid), dim3(NWAVES * 64), LDS_BYTES, stream, a);
#endif
#else
    for (int p = 0; p < NPHASE; ++p) { a.ph_lo = p; a.ph_hi = p + 1; hipLaunchKernelGGL(mega, dim3(grid), dim3(NWAVES * 64), LDS_BYTES, stream, a); }
#endif
}
```
